# Optimizing an MI355X kernel written in HIP

```python
import jax
import jax.numpy as jnp
from jax import lax
import numpy as np

D_MODEL = 2048
BATCH = 2
SEQ = 4096
DEPTH = 1

M_HEADS = 4
A_HEADS = 8
M_V_DIM = D_MODEL // 2 // M_HEADS
M_QK_DIM = M_V_DIM // 2
A_HEAD_DIM = D_MODEL // 2 // A_HEADS
M_CHUNK = 64
CONV_WIDTH = 4
GATE_CAP = 15.0
ATTN_PATTERNS = ((128, 1), (512, 4), (2048, 16))
ROPE_THETA = 10000.0
NORM_EPS = 1e-6
D_FF = ((8 * D_MODEL + 3 * 256 - 1) // (3 * 256)) * 256
M_QK_WIDTH = M_HEADS * M_QK_DIM
M_V_WIDTH = M_HEADS * M_V_DIM
A_WIDTH = A_HEADS * A_HEAD_DIM
MIX_WIDTH = M_V_WIDTH + A_WIDTH
SPLIT_SIZES = (M_QK_WIDTH, M_QK_WIDTH, M_V_WIDTH, M_V_WIDTH, M_HEADS, M_HEADS, A_WIDTH, A_WIDTH, A_WIDTH)
IN_WIDTH = 2 * M_QK_WIDTH + 2 * M_V_WIDTH + 2 * M_HEADS + 3 * A_WIDTH

kernel_name = "hymba_mlstm_dilated_swa_swiglu"


def rms_norm(x, w):
    xf = x.astype(jnp.float32)
    y = xf * lax.rsqrt(jnp.mean(xf * xf, axis=-1, keepdims=True) + NORM_EPS)
    return y * w.astype(jnp.float32)


def to_heads(t, n_heads):
    b, s, _ = t.shape
    return t.reshape(b, s, n_heads, -1).transpose(0, 2, 1, 3)


def from_heads(t):
    b, h, s, d = t.shape
    return t.transpose(0, 2, 1, 3).reshape(b, s, h * d)


def soft_cap(z):
    return GATE_CAP * jnp.tanh(z / GATE_CAP)


def causal_short_conv(x, w, b):
    k_width = w.shape[0]
    s = x.shape[1]
    xp = jnp.pad(x, ((0, 0), (k_width - 1, 0), (0, 0)))
    y = b
    for j in range(k_width):
        y = y + w[j] * xp[:, j:j + s]
    return y


def rope_tables(s, dim):
    inv_freq = ROPE_THETA ** (-jnp.arange(0, dim, 2, dtype=jnp.float32) / dim)
    ang = jnp.arange(s, dtype=jnp.float32)[:, None] * inv_freq[None, :]
    return jnp.cos(ang), jnp.sin(ang)


def apply_rope(x, cos, sin):
    half = x.shape[-1] // 2
    x1, x2 = x[..., :half], x[..., half:]
    return jnp.concatenate([x1 * cos - x2 * sin, x2 * cos + x1 * sin], axis=-1)


def mlstm_chunkwise(q, k, v, i_pre, f_pre):
    b, h, s, dk = q.shape
    dv = v.shape[-1]
    L = M_CHUNK
    nc = s // L
    q = q.reshape(b, h, nc, L, dk) * (dk ** -0.5)
    k = k.reshape(b, h, nc, L, dk)
    v = v.reshape(b, h, nc, L, dv)
    log_i = i_pre.reshape(b, h, nc, L)
    log_f = jax.nn.log_sigmoid(f_pre).reshape(b, h, nc, L)
    cum_f = jnp.cumsum(log_f, axis=-1)
    g = cum_f[..., -1]
    a = g[..., None] - cum_f + log_i
    m_loc = jnp.max(a, axis=-1)
    w_state = jnp.exp(a - m_loc[..., None])
    kv_c = jnp.einsum('bhcl,bhcld,bhcle->bhcde', w_state, k, v)
    n_c = jnp.einsum('bhcl,bhcld->bhcd', w_state, k)

    def step(carry, inp):
        c_st, n_st, m_st = carry
        kv, nn, ml, gg = inp
        m_new = jnp.maximum(gg + m_st, ml)
        s_old = jnp.exp(gg + m_st - m_new)
        s_new = jnp.exp(ml - m_new)
        c_new = s_old[..., None, None] * c_st + s_new[..., None, None] * kv
        n_new = s_old[..., None] * n_st + s_new[..., None] * nn
        return (c_new, n_new, m_new), (c_st, n_st, m_st)

    init = (jnp.zeros((b, h, dk, dv), jnp.float32), jnp.zeros((b, h, dk), jnp.float32),
            jnp.zeros((b, h), jnp.float32))
    xs = (jnp.moveaxis(kv_c, 2, 0), jnp.moveaxis(n_c, 2, 0), jnp.moveaxis(m_loc, 2, 0), jnp.moveaxis(g, 2, 0))
    _, (c_prev, n_prev, m_prev) = lax.scan(step, init, xs)
    c_prev = jnp.moveaxis(c_prev, 0, 2)
    n_prev = jnp.moveaxis(n_prev, 0, 2)
    m_prev = jnp.moveaxis(m_prev, 0, 2)

    causal = jnp.tril(jnp.ones((L, L), dtype=bool))
    d_log = cum_f[..., :, None] - cum_f[..., None, :] + log_i[..., None, :]
    d_log = jnp.where(causal, d_log, -jnp.inf)
    inter_log = cum_f + m_prev[..., None]
    m_t = jnp.maximum(inter_log, jnp.max(d_log, axis=-1))
    p_intra = jnp.exp(d_log - m_t[..., None])
    w_inter = jnp.exp(inter_log - m_t)
    s_qk = jnp.einsum('bhctd,bhcsd->bhcts', q, k) * p_intra
    num = (w_inter[..., None] * jnp.einsum('bhctd,bhcde->bhcte', q, c_prev)
           + jnp.einsum('bhcts,bhcse->bhcte', s_qk, v))
    den = w_inter * jnp.einsum('bhctd,bhcd->bhct', q, n_prev) + jnp.sum(s_qk, axis=-1)
    out = num / jnp.maximum(jnp.abs(den), jnp.exp(-m_t))[..., None]
    return out.reshape(b, h, s, dv)


def dilated_window_attention(q, k, v, window, dilation):
    b, h, s, dh = q.shape
    w_sub = window // dilation
    L = s // dilation
    nb = -(-L // w_sub)
    lp = nb * w_sub

    def to_sub(t):
        t = t.reshape(b, h, L, dilation, dh).transpose(0, 1, 3, 2, 4)
        return jnp.pad(t, ((0, 0), (0, 0), (0, 0), (0, lp - L), (0, 0)))

    def band(t):
        t = jnp.pad(t, ((0, 0), (0, 0), (0, 0), (w_sub, 0), (0, 0))).reshape(b, h, dilation, nb + 1, w_sub, dh)
        return jnp.concatenate([t[:, :, :, :-1], t[:, :, :, 1:]], axis=4)

    qb = to_sub(q).reshape(b, h, dilation, nb, w_sub, dh)
    kb = band(to_sub(k))
    vb = band(to_sub(v))
    scores = jnp.einsum('bhrnqd,bhrnkd->bhrnqk', qb, kb) * (dh ** -0.5)
    qi = jnp.arange(w_sub)[:, None]
    kj = jnp.arange(2 * w_sub)[None, :]
    blk = jnp.arange(nb)[:, None, None]
    dist = qi + w_sub - kj
    valid = (dist >= 0) & (dist <= w_sub) & (blk * w_sub + kj - w_sub >= 0)
    scores = jnp.where(valid, scores, -jnp.inf)
    m = jnp.max(scores, axis=-1, keepdims=True)
    p = jnp.exp(scores - m)
    den = jnp.sum(p, axis=-1)
    o = jnp.einsum('bhrnqk,bhrnkd->bhrnqd', p, vb) / den[..., None]
    lse = m[..., 0] + jnp.log(den)
    o = o.reshape(b, h, dilation, lp, dh)[:, :, :, :L].transpose(0, 1, 3, 2, 4).reshape(b, h, s, dh)
    lse = lse.reshape(b, h, dilation, lp)[:, :, :, :L].transpose(0, 1, 3, 2).reshape(b, h, s)
    return o, lse


def setup_inputs(seed: int = 0) -> dict:
    key = jax.random.key(seed)
    ks = jax.random.split(key, 20)
    f32 = jnp.float32

    def nrm(k, shape, scale):
        return jax.random.normal(k, shape, f32) * scale

    return {
        "x": nrm(ks[0], (BATCH, SEQ, D_MODEL), 1.0),
        "norm1_w": 1.0 + nrm(ks[1], (DEPTH, D_MODEL), 0.02),
        "w_in": nrm(ks[2], (DEPTH, D_MODEL, IN_WIDTH), D_MODEL ** -0.5),
        "conv_w": nrm(ks[3], (DEPTH, CONV_WIDTH, 2 * M_QK_WIDTH), CONV_WIDTH ** -0.5),
        "conv_b": nrm(ks[4], (DEPTH, 2 * M_QK_WIDTH), 0.01),
        "igate_b": nrm(ks[5], (DEPTH, M_HEADS), 0.1),
        "fgate_b": jnp.linspace(3.0, 6.0, M_HEADS, dtype=f32) + nrm(ks[6], (DEPTH, M_HEADS), 0.1),
        "q_norm_w": 1.0 + nrm(ks[7], (DEPTH, A_HEAD_DIM), 0.02),
        "k_norm_w": 1.0 + nrm(ks[8], (DEPTH, A_HEAD_DIM), 0.02),
        "mlstm_norm_w": 1.0 + nrm(ks[9], (DEPTH, M_HEADS, M_V_DIM), 0.02),
        "attn_norm_w": 1.0 + nrm(ks[10], (DEPTH, A_HEADS, A_HEAD_DIM), 0.02),
        "w_out": nrm(ks[11], (DEPTH, MIX_WIDTH, D_MODEL), MIX_WIDTH ** -0.5),
        "norm2_w": 1.0 + nrm(ks[12], (DEPTH, D_MODEL), 0.02),
        "w_gate": nrm(ks[13], (DEPTH, D_MODEL, D_FF), D_MODEL ** -0.5),
        "w_up": nrm(ks[14], (DEPTH, D_MODEL, D_FF), D_MODEL ** -0.5),
        "w_down": nrm(ks[15], (DEPTH, D_FF, D_MODEL), D_FF ** -0.5),
    }


def reference(x, norm1_w, w_in, conv_w, conv_b, igate_b, fgate_b, q_norm_w, k_norm_w,
              mlstm_norm_w, attn_norm_w, w_out, norm2_w, w_gate, w_up, w_down):
    dtype = x.dtype
    s = x.shape[1]
    cos, sin = rope_tables(s, A_HEAD_DIM)
    split_points = np.cumsum(SPLIT_SIZES)[:-1].tolist()
    h = x
    for l in range(DEPTH):
        u = rms_norm(h, norm1_w[l]).astype(dtype)
        proj = jnp.matmul(u, w_in[l]).astype(jnp.float32)
        mq, mk, mv, mo, mi, mf, aq, ak, av = jnp.split(proj, split_points, axis=-1)

        qk = jax.nn.silu(causal_short_conv(jnp.concatenate([mq, mk], axis=-1),
                                           conv_w[l].astype(jnp.float32), conv_b[l].astype(jnp.float32)))
        mq, mk = qk[..., :M_QK_WIDTH], qk[..., M_QK_WIDTH:]
        i_pre = soft_cap(mi + igate_b[l].astype(jnp.float32)).transpose(0, 2, 1)
        f_pre = soft_cap(mf + fgate_b[l].astype(jnp.float32)).transpose(0, 2, 1)
        hm = mlstm_chunkwise(to_heads(mq, M_HEADS), to_heads(mk, M_HEADS), to_heads(mv, M_HEADS), i_pre, f_pre)
        hm = rms_norm(hm, mlstm_norm_w[l][:, None, :])
        hm = from_heads(hm) * jax.nn.sigmoid(mo)

        qa = apply_rope(rms_norm(to_heads(aq, A_HEADS), q_norm_w[l]), cos, sin)
        ka = apply_rope(rms_norm(to_heads(ak, A_HEADS), k_norm_w[l]), cos, sin)
        va = to_heads(av, A_HEADS)
        outs = []
        lses = []
        for window, dilation in ATTN_PATTERNS:
            o_p, lse_p = dilated_window_attention(qa, ka, va, window, dilation)
            outs.append(o_p)
            lses.append(lse_p)
        alpha = jax.nn.softmax(jnp.stack(lses, axis=0), axis=0)
        ha = jnp.einsum('pbhs,pbhsd->bhsd', alpha, jnp.stack(outs, axis=0))
        ha = from_heads(rms_norm(ha, attn_norm_w[l][:, None, :]))

        mix = jnp.concatenate([hm, ha], axis=-1).astype(dtype)
        h = h + jnp.matmul(mix, w_out[l])

        u2 = rms_norm(h, norm2_w[l]).astype(dtype)
        ff = jax.nn.silu(jnp.matmul(u2, w_gate[l])) * jnp.matmul(u2, w_up[l])
        h = h + jnp.matmul(ff, w_down[l])
    return h.astype(dtype)
```

```cpp
#include <hip/hip_runtime.h>
#include <cstdio>
#include <cstdint>

#define LAS __attribute__((address_space(3)))
#define GAS __attribute__((address_space(1)))
typedef unsigned short bf16;
typedef short bf16x8 __attribute__((ext_vector_type(8)));
typedef short s16x4 __attribute__((ext_vector_type(4)));
typedef float f32x4 __attribute__((ext_vector_type(4)));
typedef float f32x2 __attribute__((ext_vector_type(2)));
typedef unsigned u32x4 __attribute__((ext_vector_type(4)));
typedef unsigned u32x2 __attribute__((ext_vector_type(2)));
typedef __bf16 bf16x2_t __attribute__((ext_vector_type(2)));

constexpr int BATCH = 2, SEQ = 4096, DM = 2048, MTOK = BATCH * SEQ;
constexpr int INW = 6152, NPROJ = 6144, DFF = 5632, NGU = 2 * DFF;
constexpr int PC_MQ = 0, PC_MK = 512, PC_MO = 1024, PC_MV = 2048, PC_AQ = 3072, PC_AK = 4096, PC_AV = 5120;
constexpr float NORM_EPS = 1e-6f;
constexpr int NWAVES = 8;

constexpr size_t MiB = 1u << 20;
constexpr size_t WS_CTL = 0, CTL_ZERO_BYTES = 1 * MiB;
constexpr size_t WS_GLI = 1 * MiB;
constexpr size_t WS_GLF = WS_GLI + 128 * 1024;
constexpr size_t WS_SUMSQ = WS_GLF + 128 * 1024;
constexpr size_t WS_MSC = WS_SUMSQ + 32 * 1024;
constexpr size_t WS_NC = WS_MSC + 8 * 1024;
constexpr size_t WS_COS = 2 * MiB, WS_SIN = 3 * MiB;
constexpr size_t WS_WIN = 6 * MiB;
constexpr size_t WS_KV = 6 * MiB;
constexpr size_t WS_U = 30 * MiB;
constexpr size_t WS_PROJ = 62 * MiB;
constexpr size_t WS_WOUT = 158 * MiB;
constexpr size_t WS_WGU = 166 * MiB;
constexpr size_t WS_WDN = 210 * MiB;
constexpr size_t WS_END = 232 * MiB;
constexpr int CW_BAR = 4096;

constexpr int RING_BYTES = 131072;
constexpr int MISC_OFF = RING_BYTES;
constexpr int LDS_BYTES = 147456;

__device__ __forceinline__ unsigned cvtpk(float lo, float hi) { f32x2 v = {lo, hi}; bf16x2_t b = __builtin_convertvector(v, bf16x2_t); return __builtin_bit_cast(unsigned, b); }
__device__ __forceinline__ float bf_lo(unsigned w) { return __uint_as_float(w << 16); }
__device__ __forceinline__ float bf_hi(unsigned w) { return __uint_as_float(w & 0xffff0000u); }
__device__ __forceinline__ void unpack8(u32x4 w, float* f) { f[0] = bf_lo(w.x); f[1] = bf_hi(w.x); f[2] = bf_lo(w.y); f[3] = bf_hi(w.y); f[4] = bf_lo(w.z); f[5] = bf_hi(w.z); f[6] = bf_lo(w.w); f[7] = bf_hi(w.w); }
__device__ __forceinline__ u32x4 pack8(const float* f) { u32x4 w; w.x = cvtpk(f[0], f[1]); w.y = cvtpk(f[2], f[3]); w.z = cvtpk(f[4], f[5]); w.w = cvtpk(f[6], f[7]); return w; }
__device__ __forceinline__ float wave_sum(float v) {
#pragma unroll
    for (int o = 1; o < 64; o <<= 1) v += __shfl_xor(v, o);
    return v;
}
__device__ __forceinline__ float wave_max(float v) {
#pragma unroll
    for (int o = 1; o < 64; o <<= 1) v = fmaxf(v, __shfl_xor(v, o));
    return v;
}
__device__ __forceinline__ s16x4 vtr(const LAS unsigned char* p) { return __builtin_bit_cast(s16x4, __builtin_amdgcn_ds_read_tr16_b64_v4i16((LAS s16x4*)p)); }
__device__ __forceinline__ bf16x8 cat4(s16x4 a, s16x4 b) { return (bf16x8){a[0], a[1], a[2], a[3], b[0], b[1], b[2], b[3]}; }
#define LDS_WAIT() asm volatile("s_waitcnt lgkmcnt(0)" ::: "memory")
#define VM_WAIT() asm volatile("s_waitcnt vmcnt(0)" ::: "memory")
#define SBAR() __builtin_amdgcn_sched_barrier(0)
#define MFMA16(a, b, c) __builtin_amdgcn_mfma_f32_16x16x32_bf16((a), (b), (c), 0, 0, 0)

namespace pg8 {
constexpr int BM = 256, BK = 64, HALF = 128, HTB = HALF * BK * 2, STAGE_BYTES = 8 * HTB, NXCD = 8, WGM = 8;
__host__ __device__ __forceinline__ int lds_byte(int r, int c) { const int st = (r >> 4) * 2 + (c >> 5), rr = r & 15, cc = c & 31, ob = rr * 64 + cc * 2; return st * 1024 + (ob ^ (((ob >> 9) & 1) << 5)); }
__host__ __device__ __forceinline__ void stage_rc(int b, int& R, int& C) { const int st = b / 1024, sb = b % 1024, swz = sb ^ (((sb >> 9) & 1) << 5); R = (st >> 1) * 16 + swz / 64; C = (st & 1) * 32 + (swz % 64) / 2; }
__host__ __device__ __forceinline__ int perm32(int rho) { const int n = rho >> 4, i = rho & 15; return 8 * (i >> 2) + 4 * n + (i & 3); }
struct Unit { int pm, pn; };
struct Gemm { const bf16* A; const bf16* Bt; int M, N, K, lda; };
struct StaticOrder {
    int nM, nN, nwg, G, c;
    __device__ void init(int M, int N, int G_, int c_) { nM = M / BM; nN = N / BM; nwg = nM * nN; G = G_; c = c_; }
    __device__ bool next(int i, Unit& u) const {
        const long L = (long)i * G + c; if (L >= nwg) return false;
        int wgid = (int)L; { const int q = nwg / NXCD, r = nwg % NXCD, xcd = wgid % NXCD, off = wgid / NXCD; wgid = (xcd < r ? xcd * (q + 1) : r * (q + 1) + (xcd - r) * q) + off; }
        const int nig = WGM * nN, gid = wgid / nig, fm = gid * WGM, gsz = (nM - fm) < WGM ? (nM - fm) : WGM;
        u.pm = fm + ((wgid % nig) % gsz); u.pn = (wgid % nig) / gsz; return true;
    }
};
struct EpiBf16 {
    static constexpr bool PERM = true;
    bf16* O; int ldc;
    __device__ __forceinline__ void operator()(const f32x4 (&acc)[2][2][4][2], const Unit& u, int wr, int wc, int fr, int fq) const {
        const int row0 = u.pm * BM + wr * 64 + fr, col0 = u.pn * BM + wc * 32 + 8 * fq;
#pragma unroll
        for (int ai = 0; ai < 2; ++ai)
#pragma unroll
            for (int m = 0; m < 4; ++m) { bf16* rowp = O + (size_t)(row0 + ai * HALF + m * 16) * ldc + col0;
#pragma unroll
                for (int bj = 0; bj < 2; ++bj) { const f32x4 v0 = acc[ai][bj][m][0], v1 = acc[ai][bj][m][1];
                    u32x4 w; w.x = cvtpk(v0[0], v0[1]); w.y = cvtpk(v0[2], v0[3]); w.z = cvtpk(v1[0], v1[1]); w.w = cvtpk(v1[2], v1[3]);
                    *(u32x4*)(rowp + bj * HALF) = w; } }
    }
};
struct EpiRes1 {
    static constexpr bool PERM = false;
    const float* xres; float* out; bf16* h1b; float* sumsq; int ldc;
    __device__ __forceinline__ void operator()(const f32x4 (&acc)[2][2][4][2], const Unit& u, int wr, int wc, int fr, int fq) const {
        const int col0 = u.pn * BM + wc * 32 + 4 * fq;
#pragma unroll
        for (int ai = 0; ai < 2; ++ai)
#pragma unroll
            for (int m = 0; m < 4; ++m) { const int row = u.pm * BM + ai * HALF + wr * 64 + m * 16 + fr; const size_t off = (size_t)row * ldc + col0; float ss = 0.f;
#pragma unroll
                for (int bj = 0; bj < 2; ++bj)
#pragma unroll
                    for (int n = 0; n < 2; ++n) { const size_t o2 = off + bj * HALF + n * 16; const f32x4 h = *(const f32x4*)(xres + o2) + acc[ai][bj][m][n];
                        *(f32x4*)(out + o2) = h; u32x2 w; w.x = cvtpk(h[0], h[1]); w.y = cvtpk(h[2], h[3]); *(u32x2*)(h1b + o2) = w;
                        ss += (h[0] * h[0] + h[1] * h[1]) + (h[2] * h[2] + h[3] * h[3]); }
                ss += __shfl_xor(ss, 16); ss += __shfl_xor(ss, 32);
                if (fq == 0) atomicAdd(sumsq + row, ss); }
    }
};
struct EpiSwiGLU {
    static constexpr bool PERM = true;
    bf16* O; int ldc; const float* sumsq;
    __device__ __forceinline__ void operator()(const f32x4 (&acc)[2][2][4][2], const Unit& u, int wr, int wc, int fr, int fq) const {
        const int col0 = u.pn * HALF + wc * 32 + 8 * fq;
#pragma unroll
        for (int ai = 0; ai < 2; ++ai)
#pragma unroll
            for (int m = 0; m < 4; ++m) { const int row = u.pm * BM + ai * HALF + wr * 64 + m * 16 + fr;
                const float rs = 1.0f / sqrtf(sumsq[row] * (1.0f / DM) + NORM_EPS);
                float f[8];
#pragma unroll
                for (int n = 0; n < 2; ++n)
#pragma unroll
                    for (int j = 0; j < 4; ++j) { const float g = acc[ai][0][m][n][j] * rs, up = acc[ai][1][m][n][j] * rs; f[n * 4 + j] = g / (1.0f + __expf(-g)) * up; }
                *(u32x4*)(O + (size_t)row * ldc + col0) = pack8(f); }
    }
};
struct EpiRes2 {
    static constexpr bool PERM = false;
    float* out; int ldc;
    __device__ __forceinline__ void operator()(const f32x4 (&acc)[2][2][4][2], const Unit& u, int wr, int wc, int fr, int fq) const {
        const int col0 = u.pn * BM + wc * 32 + 4 * fq;
#pragma unroll
        for (int ai = 0; ai < 2; ++ai)
#pragma unroll
            for (int m = 0; m < 4; ++m) { const size_t off = (size_t)(u.pm * BM + ai * HALF + wr * 64 + m * 16 + fr) * ldc + col0;
#pragma unroll
                for (int bj = 0; bj < 2; ++bj)
#pragma unroll
                    for (int n = 0; n < 2; ++n) { const size_t o2 = off + bj * HALF + n * 16; *(f32x4*)(out + o2) = *(const f32x4*)(out + o2) + acc[ai][bj][m][n]; } }
    }
};

template <class Epi, bool ALIGN_EPI>
__device__ __forceinline__ void gemm_phase(LAS unsigned char* lds, const Gemm g, const StaticOrder& S, const Epi& E) {
    const int tid = threadIdx.x, wid = __builtin_amdgcn_readfirstlane(tid >> 6), lane = tid & 63, wr = wid >> 2, wc = wid & 3, fr = lane & 15, fq = lane >> 4;
    const int K = g.K, nt = K / BK;
    unsigned voffA[2], voffB[2];
#pragma unroll
    for (int i = 0; i < 2; ++i) { int R, C; stage_rc(tid * 16 + i * 8192, R, C); const int Rb = Epi::PERM ? ((R & ~31) + perm32(R & 31)) : R;
        voffA[i] = (unsigned)(R * g.lda + C) * 2u; voffB[i] = (unsigned)(Rb * K + C) * 2u; }
    const size_t kstep = (size_t)(BK * 2);
    const size_t hstepA = (size_t)HALF * g.lda * 2, hstepB = (size_t)HALF * K * 2;
    const size_t tstepA = 2 * hstepA, tstepB = 2 * hstepB;
    const unsigned ldsw = (unsigned)wid * 1024u;
    const int aoff = lds_byte(wr * 64 + fr, fq * 8), boff = lds_byte(wc * 32 + fr, fq * 8);
#define PG8_SA(b, h) (((b) * 2 + (h)) * HTB)
#define PG8_SB(b, h) ((4 + (b) * 2 + (h)) * HTB)
#define PG8_STAGE(bufoff, gbase, voff) do { _Pragma("unroll") for (int _i = 0; _i < 2; ++_i) \
        __builtin_amdgcn_global_load_lds((const unsigned*)((const char*)(gbase) + (voff)[_i]), (LAS unsigned*)(lds + (bufoff) + ldsw + _i * 8192), 16, 0, 0); } while (0)
#define PG8_LDA(dst, b, h) do { _Pragma("unroll") for (int m = 0; m < 4; ++m) _Pragma("unroll") for (int k = 0; k < 2; ++k) dst[m][k] = *(const LAS bf16x8*)(lds + PG8_SA(b, h) + aoff + m * 2048 + k * 1024); } while (0)
#define PG8_LDB(dst, b, h) do { _Pragma("unroll") for (int n = 0; n < 2; ++n) _Pragma("unroll") for (int k = 0; k < 2; ++k) dst[n][k] = *(const LAS bf16x8*)(lds + PG8_SB(b, h) + boff + n * 2048 + k * 1024); } while (0)
#define PG8_MMA(ai, bj, At, Bt) do { __builtin_amdgcn_s_setprio(1); _Pragma("unroll") for (int m = 0; m < 4; ++m) _Pragma("unroll") for (int n = 0; n < 2; ++n) _Pragma("unroll") for (int k = 0; k < 2; ++k) \
        acc[ai][bj][m][n] = __builtin_amdgcn_mfma_f32_16x16x32_bf16(Bt[n][k], At[m][k], acc[ai][bj][m][n], 0, 0, 0); __builtin_amdgcn_s_setprio(0); } while (0)
#define PG8_WAIT_V(n) asm volatile("s_waitcnt vmcnt(" #n ")" ::: "memory")
#define PG8_WAIT_L(n) asm volatile("s_waitcnt lgkmcnt(" #n ")" ::: "memory")
#define PG8_BAR __builtin_amdgcn_s_barrier()
#define PG8_SCHED __builtin_amdgcn_sched_barrier(0)
    Unit cur, nxt; int ui = 0;
    if (!S.next(0, cur)) return;
    f32x4 acc[2][2][4][2];
#pragma unroll
    for (int a = 0; a < 2; ++a)
#pragma unroll
        for (int b = 0; b < 2; ++b)
#pragma unroll
            for (int m = 0; m < 4; ++m)
#pragma unroll
                for (int n = 0; n < 2; ++n) acc[a][b][m][n] = (f32x4){0.f, 0.f, 0.f, 0.f};
    bf16x8 At[4][2], B0[2][2], B1[2][2];
    const char* cA = (const char*)g.A + (size_t)cur.pm * tstepA; const char* cB = (const char*)g.Bt + (size_t)cur.pn * tstepB;
    PG8_STAGE(PG8_SB(0, 0), cB, voffB); PG8_STAGE(PG8_SB(0, 1), cB + hstepB, voffB); PG8_STAGE(PG8_SA(0, 0), cA, voffA); PG8_STAGE(PG8_SA(0, 1), cA + hstepA, voffA);
    if (wr == 1) PG8_BAR;
    PG8_WAIT_V(2); PG8_BAR;
    PG8_STAGE(PG8_SB(1, 0), cB + kstep, voffB); PG8_STAGE(PG8_SA(1, 0), cA + kstep, voffA); PG8_STAGE(PG8_SB(1, 1), cB + hstepB + kstep, voffB);
    PG8_WAIT_V(6); PG8_BAR;
    for (;;) {
        const bool has_next = S.next(ui + 1, nxt);
        const char* nA = has_next ? (const char*)g.A + (size_t)nxt.pm * tstepA : cA; const char* nB = has_next ? (const char*)g.Bt + (size_t)nxt.pn * tstepB : cB;
        for (int t = 0; t < nt; t += 2) {
            const bool last = (t == nt - 2);
            const char* a1 = cA + (size_t)(t + 1) * kstep;
            const char* a2 = last ? nA : cA + (size_t)(t + 2) * kstep; const char* b2 = last ? nB : cB + (size_t)(t + 2) * kstep;
            const char* a3 = a2 + kstep; const char* b3 = b2 + kstep;
            PG8_LDB(B0, 0, 0); PG8_LDB(B1, 0, 1); PG8_SCHED; PG8_LDA(At, 0, 0); PG8_STAGE(PG8_SA(1, 1), a1 + hstepA, voffA);
            PG8_WAIT_V(8); PG8_WAIT_L(0); PG8_BAR; PG8_MMA(0, 0, At, B0); PG8_MMA(0, 1, At, B1); PG8_BAR; PG8_SCHED;
            PG8_LDA(At, 0, 1); PG8_STAGE(PG8_SB(0, 0), b2, voffB); PG8_STAGE(PG8_SB(0, 1), b2 + hstepB, voffB); PG8_STAGE(PG8_SA(0, 0), a2, voffA);
            PG8_WAIT_V(8); PG8_WAIT_L(0); PG8_BAR; PG8_MMA(1, 0, At, B0); PG8_MMA(1, 1, At, B1); PG8_BAR; PG8_SCHED;
            PG8_LDB(B0, 1, 0); PG8_LDB(B1, 1, 1); PG8_SCHED; PG8_LDA(At, 1, 0); PG8_STAGE(PG8_SA(0, 1), a2 + hstepA, voffA);
            PG8_WAIT_V(8); PG8_WAIT_L(0); PG8_BAR; PG8_MMA(0, 0, At, B0); PG8_MMA(0, 1, At, B1); PG8_BAR; PG8_SCHED;
            PG8_LDA(At, 1, 1); PG8_STAGE(PG8_SB(1, 0), b3, voffB); PG8_STAGE(PG8_SB(1, 1), b3 + hstepB, voffB); PG8_STAGE(PG8_SA(1, 0), a3, voffA);
            PG8_WAIT_V(8); PG8_WAIT_L(0); PG8_BAR; PG8_MMA(1, 0, At, B0); PG8_MMA(1, 1, At, B1); PG8_BAR; PG8_SCHED;
        }
        if constexpr (ALIGN_EPI) { if (wr == 0) PG8_BAR; }
        E(acc, cur, wr, wc, fr, fq);
        if (!has_next) break;
#pragma unroll
        for (int a = 0; a < 2; ++a)
#pragma unroll
            for (int b = 0; b < 2; ++b)
#pragma unroll
                for (int m = 0; m < 4; ++m)
#pragma unroll
                    for (int n = 0; n < 2; ++n) acc[a][b][m][n] = (f32x4){0.f, 0.f, 0.f, 0.f};
        cur = nxt; cA = nA; cB = nB; ++ui;
        if constexpr (ALIGN_EPI) { if (wr == 1) PG8_BAR; }
    }
    PG8_WAIT_V(0);
    if constexpr (!ALIGN_EPI) { if (wr == 0) PG8_BAR; }
    PG8_BAR;
#undef PG8_SA
#undef PG8_SB
#undef PG8_STAGE
#undef PG8_LDA
#undef PG8_LDB
#undef PG8_MMA
#undef PG8_WAIT_V
#undef PG8_WAIT_L
#undef PG8_BAR
#undef PG8_SCHED
}
}

#define XB_TMO      128
#define XB_XCNT(j)  (256  + 64 * (j))
#define XB_XSUB(j)  (1280 + 64 * (j))
#define XB_XGEN(j)  (2304 + 64 * (j))
#define XB_TOP      3328
#define XB_TOPGEN   3392
#define XCD_BAR_WORDS 3456
#define XB_SPIN_CAP (1u << 18)
__device__ __forceinline__ unsigned xb_ld(unsigned* p)              { return __hip_atomic_load(p, __ATOMIC_RELAXED, __HIP_MEMORY_SCOPE_AGENT); }
__device__ __forceinline__ unsigned xb_add(unsigned* p, unsigned v) { return __hip_atomic_fetch_add(p, v, __ATOMIC_RELAXED, __HIP_MEMORY_SCOPE_AGENT); }
__device__ __forceinline__ unsigned xb_xcc_id() { return (unsigned)__builtin_amdgcn_s_getreg((3 << 11) | 20) & 0xFu; }
#define XB_SPIN(cond, bar) do { unsigned _sp = 0; while (cond) { __builtin_amdgcn_s_sleep(1); \
    if ((++_sp & 255u) == 0u) { if (xb_ld(&(bar)[XB_TMO])) break; if (_sp > XB_SPIN_CAP) { atomicAdd(&(bar)[XB_TMO], 1u); break; } } } } while (0)
struct XcdBarrier { unsigned* bar; unsigned x; volatile LAS unsigned* st; };
__device__ __forceinline__ XcdBarrier xcd_barrier_post(unsigned* bar, volatile LAS unsigned* st) {
    XcdBarrier b; b.bar = bar; b.x = xb_xcc_id(); b.st = st;
    if (threadIdx.x == 0) (void)xb_add(&bar[XB_XCNT(b.x)], 1u);
    return b;
}
__device__ __forceinline__ void xcd_barrier_complete(unsigned* bar, unsigned x, unsigned& nloc, unsigned& nx) {
    const unsigned G = gridDim.x * gridDim.y * gridDim.z;
    unsigned sum, cnt, mine, sp = 0u;
    for (;;) {
        sum = 0u; cnt = 0u; mine = 0u;
#pragma unroll
        for (unsigned j = 0; j < 16; ++j) { const unsigned c = xb_ld(&bar[XB_XCNT(j)]); sum += c; cnt += (c > 0u) ? 1u : 0u; mine = (j == x) ? c : mine; }
        if (sum == G) break;
        __builtin_amdgcn_s_sleep(1);
        if ((++sp & 255u) == 0u) { if (xb_ld(&bar[XB_TMO])) break; if (sp > XB_SPIN_CAP) { atomicAdd(&bar[XB_TMO], 1u); break; } }
    }
    nloc = mine > 0u ? mine : 1u; nx = cnt > 0u ? cnt : 1u;
}
__device__ __forceinline__ void xcd_barrier(const XcdBarrier& b) {
    asm volatile("s_waitcnt vmcnt(0)" ::: "memory");
    __syncthreads();
    if (threadIdx.x == 0) {
        unsigned* bar = b.bar;
        __builtin_amdgcn_s_waitcnt(0);
        unsigned nloc = b.st[0], nx = b.st[1];
        if (nloc == 0u) { xcd_barrier_complete(bar, b.x, nloc, nx); b.st[0] = nloc; b.st[1] = nx; }
        const unsigned old = xb_add(&bar[XB_XSUB(b.x)], 1u);
        const unsigned gen = old / nloc;
        if (old + 1u == (gen + 1u) * nloc) {
            __builtin_amdgcn_fence(__ATOMIC_RELEASE, "agent");
            asm volatile("s_waitcnt vmcnt(0)" ::: "memory");
            const unsigned og = xb_add(&bar[XB_TOP], 1u);
            const unsigned tg = og / nx;
            if (og + 1u == (tg + 1u) * nx) xb_add(&bar[XB_TOPGEN], 1u);
            else XB_SPIN(xb_ld(&bar[XB_TOPGEN]) == tg, bar);
            __builtin_amdgcn_fence(__ATOMIC_ACQUIRE, "agent");
            xb_add(&bar[XB_XGEN(b.x)], 1u);
            asm volatile("s_waitcnt vmcnt(0)" ::: "memory");
        } else {
            XB_SPIN(xb_ld(&bar[XB_XGEN(b.x)]) == gen, bar);
            __builtin_amdgcn_fence(__ATOMIC_ACQUIRE, "agent");
            asm volatile("s_waitcnt vmcnt(0)" ::: "memory");
        }
    }
    __syncthreads();
}

struct Args {
    const float* x; const float* norm1_w; const float* w_in; const float* conv_w; const float* conv_b; const float* igate_b; const float* fgate_b;
    const float* q_norm_w; const float* k_norm_w; const float* mlstm_norm_w; const float* attn_norm_w; const float* w_out; const float* norm2_w;
    const float* w_gate; const float* w_up; const float* w_down;
    float* out; unsigned char* ws;
};

__device__ __forceinline__ void p0_transpose_item(const float* W, int ldw, int K, bf16* WT, int nsrc0, int ndst0, int k0, const float* kscale, LAS float* scr, int lane) {
#pragma unroll 8
    for (int i = 0; i < 32; ++i) { const int kk = 2 * i + (lane >> 5); float v = W[(size_t)(k0 + kk) * ldw + nsrc0 + (lane & 31)]; if (kscale) v *= kscale[k0 + kk]; scr[kk * 33 + (lane & 31)] = v; }
    LDS_WAIT(); asm volatile("" ::: "memory");
    const int c = lane & 7;
#pragma unroll
    for (int j = 0; j < 4; ++j) { const int n = (lane >> 3) + 8 * j; const LAS float* s = scr + (8 * c) * 33 + n;
        u32x4 o; o.x = cvtpk(s[0 * 33], s[1 * 33]); o.y = cvtpk(s[2 * 33], s[3 * 33]); o.z = cvtpk(s[4 * 33], s[5 * 33]); o.w = cvtpk(s[6 * 33], s[7 * 33]);
        *(u32x4*)(WT + (size_t)(ndst0 + n) * K + k0 + 8 * c) = o; }
    LDS_WAIT(); asm volatile("" ::: "memory");
}
__device__ __forceinline__ int win_src_col(int nd) {
    if (nd < 1024) return nd;
    if (nd < 2048) return nd + 1024;
    if (nd < 3072) return nd - 1024;
    return nd + 8;
}


__device__ __forceinline__ float scan_add64(float v, int lane) {
#pragma unroll
    for (int o = 1; o < 64; o <<= 1) { const float t = __shfl_up(v, o); if (lane >= o) v += t; }
    return v;
}
__device__ __forceinline__ float scan_max64(float v, int lane) {
#pragma unroll
    for (int o = 1; o < 64; o <<= 1) { const float t = __shfl_up(v, o); if (lane >= o) v = fmaxf(v, t); }
    return v;
}
template <bool ROWW>
__device__ __forceinline__ void conv_tile(const bf16* proj, const float* conv_w, const float* conv_b, int b, int c, int col0, int ch0, float rscale, float wlane, LAS unsigned char* tile, int tid) {
    const int rr = tid >> 4, cc = (tid & 15) * 8;
    float w[4][8], bb[8];
#pragma unroll
    for (int j = 0; j < 4; ++j) { const f32x4 w0 = *(const f32x4*)(conv_w + j * 1024 + ch0 + cc), w1 = *(const f32x4*)(conv_w + j * 1024 + ch0 + cc + 4);
        w[j][0] = w0[0]; w[j][1] = w0[1]; w[j][2] = w0[2]; w[j][3] = w0[3]; w[j][4] = w1[0]; w[j][5] = w1[1]; w[j][6] = w1[2]; w[j][7] = w1[3]; }
    { const f32x4 b0 = *(const f32x4*)(conv_b + ch0 + cc), b1 = *(const f32x4*)(conv_b + ch0 + cc + 4);
      bb[0] = b0[0]; bb[1] = b0[1]; bb[2] = b0[2]; bb[3] = b0[3]; bb[4] = b1[0]; bb[5] = b1[1]; bb[6] = b1[2]; bb[7] = b1[3]; }
#pragma unroll
    for (int half = 0; half < 2; ++half) {
        const int l = rr + 32 * half, t = c * 64 + l;
        float y[8];
#pragma unroll
        for (int e = 0; e < 8; ++e) y[e] = bb[e];
#pragma unroll
        for (int j = 0; j < 4; ++j) { const int tt = t - 3 + j;
            if (tt >= 0) { const u32x4 raw = *(const u32x4*)(proj + (size_t)(b * SEQ + tt) * NPROJ + col0 + cc); float x[8]; unpack8(raw, x);
#pragma unroll
                for (int e = 0; e < 8; ++e) y[e] += w[j][e] * x[e]; } }
        float sc = rscale;
        if (ROWW) sc *= __shfl(wlane, l);
#pragma unroll
        for (int e = 0; e < 8; ++e) y[e] = y[e] / (1.0f + __expf(-y[e])) * sc;
        *(LAS u32x4*)(tile + l * 288 + cc * 2) = pack8(y);
    }
}
__device__ __forceinline__ void v_tile(const bf16* proj, int b, int c, int h, LAS unsigned char* tile, int tid) {
#pragma unroll
    for (int p = 0; p < 4; ++p) { const int row = p * 16 + (tid >> 5), ch = tid & 31;
        const u32x4 v = *(const u32x4*)(proj + (size_t)(b * SEQ + c * 64 + row) * NPROJ + PC_MV + h * 256 + ch * 8);
        *(LAS u32x4*)(tile + row * 544 + ch * 16) = v; }
}

__device__ __forceinline__ void attn_group(bf16* proj, const float* rcos, const float* rsin, const float* qnw, const float* anw, int b, int h, int T0, int r, LAS unsigned char* vlds, int lane) {
    const int j = lane & 15, g = lane >> 4, qp = j >> 2, p = lane & 3;
    const int tq = T0 + r + 16 * j;
    bf16* qrow = proj + (size_t)(b * SEQ + tq) * NPROJ + PC_AQ + h * 128;
    bf16x8 qf[4];
    {
        float q[4][8]; float ss = 0.f;
#pragma unroll
        for (int ks = 0; ks < 4; ++ks) { const u32x4 raw = *(const u32x4*)(qrow + 32 * ks + 8 * g); unpack8(raw, q[ks]);
#pragma unroll
            for (int e = 0; e < 8; ++e) ss += q[ks][e] * q[ks][e]; }
        ss += __shfl_xor(ss, 16); ss += __shfl_xor(ss, 32);
        const float rq = 1.0f / sqrtf(ss * (1.0f / 128.0f) + NORM_EPS);
#pragma unroll
        for (int ks = 0; ks < 2; ++ks) {
            const int c0 = 32 * ks + 8 * g;
#pragma unroll
            for (int e4 = 0; e4 < 2; ++e4) {
                const f32x4 cs = *(const f32x4*)(rcos + tq * 64 + c0 + 4 * e4), sn = *(const f32x4*)(rsin + tq * 64 + c0 + 4 * e4);
                const f32x4 w1 = *(const f32x4*)(qnw + c0 + 4 * e4), w2 = *(const f32x4*)(qnw + 64 + c0 + 4 * e4);
#pragma unroll
                for (int e = 0; e < 4; ++e) { const float y1 = q[ks][4 * e4 + e] * rq * w1[e], y2 = q[ks + 2][4 * e4 + e] * rq * w2[e];
                    q[ks][4 * e4 + e] = y1 * cs[e] - y2 * sn[e]; q[ks + 2][4 * e4 + e] = y2 * cs[e] + y1 * sn[e]; }
            }
        }
#pragma unroll
        for (int ks = 0; ks < 4; ++ks) { const u32x4 w = pack8(q[ks]); qf[ks] = __builtin_bit_cast(bf16x8, w); }
    }
    float m_run = -1e30f, l_run = 0.f;
    f32x4 o[8];
#pragma unroll
    for (int nf = 0; nf < 8; ++nf) o[nf] = (f32x4){0.f, 0.f, 0.f, 0.f};
    const float SC = 0.08838834764831845f * 1.4426950408889634f;
    const float NEG = -__builtin_inff();
    const bf16* kbase = proj + (size_t)b * SEQ * NPROJ + PC_AK + h * 128 + 8 * g;
    const bf16* vbase = proj + (size_t)b * SEQ * NPROJ + PC_AV + h * 128 + 8 * j;
#pragma unroll 1
    for (int si = 0; si < 3; ++si) {
        const int d = (si == 0) ? 1 : (si == 1 ? 4 : 16), s = 16 / d;
        const int kstart = T0 + r - 128 * d;
        const int ntile = (129 + 15 * s + 31) >> 5;
        int tt0 = 0; { const int need = -kstart - 31 * d; if (need > 0) tt0 = (need + 32 * d - 1) / (32 * d); }
#pragma unroll 1
        for (int tt = tt0; tt < ntile; ++tt) {
            const int i0 = 32 * tt;
            bf16x8 kf[2][4];
#pragma unroll
            for (int kfi = 0; kfi < 2; ++kfi) { int tok = kstart + (i0 + 16 * kfi + j) * d; tok = tok < 0 ? 0 : (tok > SEQ - 1 ? SEQ - 1 : tok);
                const bf16* kr = kbase + (size_t)tok * NPROJ;
#pragma unroll
                for (int ks = 0; ks < 4; ++ks) kf[kfi][ks] = *(const bf16x8*)(kr + 32 * ks); }
#pragma unroll
            for (int it = 0; it < 8; ++it) { const int row = it * 4 + g; int tok = kstart + (i0 + row) * d; tok = tok < 0 ? 0 : (tok > SEQ - 1 ? SEQ - 1 : tok);
                const u32x4 v = *(const u32x4*)(vbase + (size_t)tok * NPROJ);
                *(LAS u32x4*)(vlds + row * 288 + j * 16) = v; }
            f32x4 s0 = {0.f, 0.f, 0.f, 0.f}, s1 = {0.f, 0.f, 0.f, 0.f};
#pragma unroll
            for (int ks = 0; ks < 4; ++ks) { s0 = MFMA16(kf[0][ks], qf[ks], s0); s1 = MFMA16(kf[1][ks], qf[ks], s1); }
            float x[8]; float tmax = NEG;
#pragma unroll
            for (int e = 0; e < 8; ++e) { const int i = i0 + 16 * (e >> 2) + 4 * g + (e & 3); const float sv = (e < 4) ? s0[e & 3] : s1[e & 3];
                const bool valid = (i >= s * j) && (i <= s * j + 128) && (kstart + i * d >= 0);
                x[e] = valid ? sv * SC : NEG; tmax = fmaxf(tmax, x[e]); }
            tmax = fmaxf(tmax, __shfl_xor(tmax, 16)); tmax = fmaxf(tmax, __shfl_xor(tmax, 32));
            const float m_new = fmaxf(m_run, tmax);
            const float alpha = __builtin_amdgcn_exp2f(m_run - m_new);
            float ps = 0.f;
#pragma unroll
            for (int e = 0; e < 8; ++e) { x[e] = __builtin_amdgcn_exp2f(x[e] - m_new); ps += x[e]; }
            l_run = l_run * alpha + ps; m_run = m_new;
#pragma unroll
            for (int nf = 0; nf < 8; ++nf) o[nf] = o[nf] * alpha;
            const u32x4 pw = pack8(x); const bf16x8 pb = __builtin_bit_cast(bf16x8, pw);
            LDS_WAIT(); SBAR();
#pragma unroll
            for (int nf = 0; nf < 8; ++nf) {
                const s16x4 a0 = vtr(vlds + (4 * g + qp) * 288 + (16 * nf + 4 * p) * 2), a1 = vtr(vlds + (16 + 4 * g + qp) * 288 + (16 * nf + 4 * p) * 2);
                o[nf] = MFMA16(cat4(a0, a1), pb, o[nf]); }
            LDS_WAIT(); SBAR();
        }
    }
    l_run += __shfl_xor(l_run, 16); l_run += __shfl_xor(l_run, 32);
    const float inv = 1.0f / l_run; float ss = 0.f;
#pragma unroll
    for (int nf = 0; nf < 8; ++nf) { o[nf] = o[nf] * inv; ss += (o[nf][0] * o[nf][0] + o[nf][1] * o[nf][1]) + (o[nf][2] * o[nf][2] + o[nf][3] * o[nf][3]); }
    ss += __shfl_xor(ss, 16); ss += __shfl_xor(ss, 32);
    const float rn = 1.0f / sqrtf(ss * (1.0f / 128.0f) + NORM_EPS);
#pragma unroll
    for (int nf = 0; nf < 8; ++nf) { const int e = 16 * nf + 4 * g; const f32x4 w = *(const f32x4*)(anw + h * 128 + e); const f32x4 v = o[nf] * rn * w;
        u32x2 ww; ww.x = cvtpk(v[0], v[1]); ww.y = cvtpk(v[2], v[3]); *(u32x2*)(qrow + e) = ww; }
}

__global__ void __launch_bounds__(NWAVES * 64, 2) hymba_fwd(Args a) {
    extern __shared__ __attribute__((aligned(16))) unsigned char lds_raw[];
    LAS unsigned char* lds = (LAS unsigned char*)lds_raw;
    volatile LAS unsigned* MISC = (volatile LAS unsigned*)(lds + MISC_OFF);
    const int tid = threadIdx.x, lane = tid & 63, wave = __builtin_amdgcn_readfirstlane(tid >> 6);
    const int G = gridDim.x; const int bx = blockIdx.x; const int vcu = (G % 8 == 0) ? (bx % 8) * (G / 8) + bx / 8 : bx;
    unsigned char* ws = a.ws;
    unsigned* ctl = (unsigned*)(ws + WS_CTL);
    float* gli = (float*)(ws + WS_GLI); float* glf = (float*)(ws + WS_GLF); float* sumsq = (float*)(ws + WS_SUMSQ);
    float* msc_g = (float*)(ws + WS_MSC); float* msc_ml = msc_g + 512; float* msc_mp = msc_g + 1024;
    float* ncb = (float*)(ws + WS_NC);
    float* rcos = (float*)(ws + WS_COS); float* rsin = (float*)(ws + WS_SIN);
    bf16* WinT = (bf16*)(ws + WS_WIN); bf16* kvT = (bf16*)(ws + WS_KV); bf16* Ub = (bf16*)(ws + WS_U); bf16* H1b = (bf16*)(ws + WS_U);
    bf16* proj = (bf16*)(ws + WS_PROJ); bf16* FF = (bf16*)(ws + WS_PROJ);
    bf16* WoutT = (bf16*)(ws + WS_WOUT); bf16* WguT = (bf16*)(ws + WS_WGU); bf16* WdnT = (bf16*)(ws + WS_WDN);

    for (int u = tid; u < (LDS_BYTES - MISC_OFF) / 4; u += NWAVES * 64) ((LAS unsigned*)(lds + MISC_OFF))[u] = 0u;
    __syncthreads();
    XcdBarrier bar = xcd_barrier_post(ctl + CW_BAR, MISC + 8);
    const int gw = vcu * NWAVES + wave, NGW = G * NWAVES;
    const int gt = vcu * (NWAVES * 64) + tid, NGT = G * NWAVES * 64;

    {
        for (int i = gt; i < MTOK; i += NGT) sumsq[i] = 0.f;
        for (int i = gt; i < SEQ * 64; i += NGT) {
            const int pos = i >> 6, fi = i & 63;
            const float invf = (float)exp2(-(double)fi * (13.287712379549449 / 64.0));
            const float ang = (float)pos * invf;
            const double rev = (double)ang * 0.15915494309189535; const double fr_ = rev - rint(rev);
            const float ar = (float)(fr_ * 6.283185307179586);
            rcos[i] = cosf(ar); rsin[i] = sinf(ar);
        }
        LAS float* scr = (LAS float*)(lds + wave * 16384);
        constexpr int I_IN = (DM / 64) * (NPROJ / 32), I_OUT = (DM / 64) * (DM / 32), I_GU = (DM / 64) * (NGU / 32), I_DN = (DFF / 64) * (DM / 32);
        constexpr int NITEMS = I_IN + I_OUT + I_GU + I_DN;
        for (int it = gw; it < NITEMS; it += NGW) {
            int r = it;
            if (r < I_IN) { const int nblk = NPROJ / 32, kb = r / nblk, nb = r % nblk; p0_transpose_item(a.w_in, INW, DM, WinT, win_src_col(nb * 32), nb * 32, kb * 64, nullptr, scr, lane); continue; } r -= I_IN;
            if (r < I_OUT) { const int nblk = DM / 32, kb = r / nblk, nb = r % nblk; p0_transpose_item(a.w_out, DM, DM, WoutT, nb * 32, nb * 32, kb * 64, nullptr, scr, lane); continue; } r -= I_OUT;
            if (r < I_GU) { const int nblk = NGU / 32, kb = r / nblk, nb = r % nblk; const int nd = nb * 32, pn = nd >> 8, j = nd & 255;
                const float* W = (j < 128) ? a.w_gate : a.w_up; const int ns = pn * 128 + (j & 127);
                p0_transpose_item(W, DFF, DM, WguT, ns, nd, kb * 64, a.norm2_w, scr, lane); continue; } r -= I_GU;
            { const int nblk = DM / 32, kb = r / nblk, nb = r % nblk; p0_transpose_item(a.w_down, DM, DFF, WdnT, nb * 32, nb * 32, kb * 64, nullptr, scr, lane); }
        }
        __syncthreads();
        LAS float* wg = (LAS float*)lds;
        for (int k = tid; k < DM; k += NWAVES * 64) { const f32x4 g0 = *(const f32x4*)(a.w_in + (size_t)k * INW + 3072), g1 = *(const f32x4*)(a.w_in + (size_t)k * INW + 3076);
            wg[0 * DM + k] = g0[0]; wg[1 * DM + k] = g0[1]; wg[2 * DM + k] = g0[2]; wg[3 * DM + k] = g0[3];
            wg[4 * DM + k] = g1[0]; wg[5 * DM + k] = g1[1]; wg[6 * DM + k] = g1[2]; wg[7 * DM + k] = g1[3]; }
        __syncthreads();
        for (int m = gw; m < MTOK; m += NGW) {
            const f32x4* xr = (const f32x4*)(a.x + (size_t)m * DM) + lane; const f32x4* wr_ = (const f32x4*)a.norm1_w + lane;
            f32x4 v[8]; float s = 0.f;
#pragma unroll
            for (int j = 0; j < 8; ++j) { v[j] = xr[64 * j]; s += (v[j][0] * v[j][0] + v[j][1] * v[j][1]) + (v[j][2] * v[j][2] + v[j][3] * v[j][3]); }
            const float rstd = 1.0f / sqrtf(wave_sum(s) * (1.0f / DM) + NORM_EPS);
            u32x2* o8 = (u32x2*)(Ub + (size_t)m * DM) + lane;
#pragma unroll
            for (int j = 0; j < 8; ++j) { v[j] = v[j] * rstd * wr_[64 * j]; u32x2 w; w.x = cvtpk(v[j][0], v[j][1]); w.y = cvtpk(v[j][2], v[j][3]); o8[64 * j] = w; }
            float z = 0.f;
#pragma unroll 1
            for (int gi = 0; gi < 8; ++gi) { float t = 0.f;
#pragma unroll
                for (int j = 0; j < 8; ++j) { const f32x4 w4 = *(const LAS f32x4*)(wg + gi * DM + 256 * j + 4 * lane); t += (v[j][0] * w4[0] + v[j][1] * w4[1]) + (v[j][2] * w4[2] + v[j][3] * w4[3]); }
                t = wave_sum(t); z = (lane == gi) ? t : z; }
            if (lane < 8) {
                const int hh = lane & 3;
                if (lane < 4) { gli[m * 4 + hh] = 15.0f * tanhf((z + a.igate_b[hh]) * (1.0f / 15.0f)); }
                else { const float fp = 15.0f * tanhf((z + a.fgate_b[hh]) * (1.0f / 15.0f)); glf[m * 4 + hh] = -log1pf(expf(-fp)); }
            }
        }
    }
    xcd_barrier(bar);

    {
        pg8::Gemm g{Ub, WinT, MTOK, NPROJ, DM, DM}; pg8::StaticOrder S; S.init(MTOK, NPROJ, G, bx);
        pg8::EpiBf16 E{proj, NPROJ};
        pg8::gemm_phase<pg8::EpiBf16, true>(lds, g, S, E);
    }
    xcd_barrier(bar);

    {
        for (int idx = gt >> 4; idx < MTOK * 8; idx += NGT >> 4) {
            const int m = idx >> 3, hh = idx & 7, c0 = 4 * (tid & 15), pos = m & (SEQ - 1);
            bf16* kp = proj + (size_t)m * NPROJ + PC_AK + hh * 128;
            const u32x2 r1 = *(const u32x2*)(kp + c0), r2 = *(const u32x2*)(kp + 64 + c0);
            float x1[4] = {bf_lo(r1.x), bf_hi(r1.x), bf_lo(r1.y), bf_hi(r1.y)}, x2[4] = {bf_lo(r2.x), bf_hi(r2.x), bf_lo(r2.y), bf_hi(r2.y)};
            float ss = 0.f;
#pragma unroll
            for (int e = 0; e < 4; ++e) ss += x1[e] * x1[e] + x2[e] * x2[e];
            ss += __shfl_xor(ss, 1); ss += __shfl_xor(ss, 2); ss += __shfl_xor(ss, 4); ss += __shfl_xor(ss, 8);
            const float rk = 1.0f / sqrtf(ss * (1.0f / 128.0f) + NORM_EPS);
            const f32x4 cs = *(const f32x4*)(rcos + pos * 64 + c0), sn = *(const f32x4*)(rsin + pos * 64 + c0);
            const f32x4 w1 = *(const f32x4*)(a.k_norm_w + c0), w2 = *(const f32x4*)(a.k_norm_w + 64 + c0);
            float o1[4], o2[4];
#pragma unroll
            for (int e = 0; e < 4; ++e) { const float y1 = x1[e] * rk * w1[e], y2 = x2[e] * rk * w2[e]; o1[e] = y1 * cs[e] - y2 * sn[e]; o2[e] = y2 * cs[e] + y1 * sn[e]; }
            u32x2 wv; wv.x = cvtpk(o1[0], o1[1]); wv.y = cvtpk(o1[2], o1[3]); *(u32x2*)(kp + c0) = wv;
            wv.x = cvtpk(o2[0], o2[1]); wv.y = cvtpk(o2[2], o2[3]); *(u32x2*)(kp + 64 + c0) = wv;
        }
        LAS unsigned char* KW = lds; LAS unsigned char* VT = lds + 18432;
        const int g = lane >> 4, qp = (lane & 15) >> 2, p = lane & 3;
        for (int u = vcu; u < 512; u += G) {
            const int b = u >> 8, h = (u >> 6) & 3, c = u & 63;
            const int tok = b * SEQ + c * 64 + lane;
            const float li = gli[tok * 4 + h], lf = glf[tok * 4 + h];
            const float cf = scan_add64(lf, lane);
            const float gsum = __shfl(cf, 63);
            const float av = gsum - cf + li;
            const float ml = wave_max(av);
            const float wst = __expf(av - ml);
            if (tid == 0) { msc_g[u] = gsum; msc_ml[u] = ml; }
            conv_tile<true>(proj, a.conv_w, a.conv_b, b, c, PC_MK + h * 128, 512 + h * 128, 1.0f, wst, KW, tid);
            v_tile(proj, b, c, h, VT, tid);
            __syncthreads();
            f32x4 acc[8][2];
#pragma unroll
            for (int df = 0; df < 8; ++df) { acc[df][0] = (f32x4){0.f, 0.f, 0.f, 0.f}; acc[df][1] = (f32x4){0.f, 0.f, 0.f, 0.f}; }
#pragma unroll
            for (int kk = 0; kk < 2; ++kk) {
                bf16x8 bfr[2];
#pragma unroll
                for (int ef = 0; ef < 2; ++ef) { const int col = 32 * wave + 16 * ef + 4 * p;
                    bfr[ef] = cat4(vtr(VT + (32 * kk + 4 * g + qp) * 544 + col * 2), vtr(VT + (32 * kk + 16 + 4 * g + qp) * 544 + col * 2)); }
#pragma unroll
                for (int df = 0; df < 8; ++df) { const int col = 16 * df + 4 * p;
                    const bf16x8 af = cat4(vtr(KW + (32 * kk + 4 * g + qp) * 288 + col * 2), vtr(KW + (32 * kk + 16 + 4 * g + qp) * 288 + col * 2));
                    acc[df][0] = MFMA16(af, bfr[0], acc[df][0]); acc[df][1] = MFMA16(af, bfr[1], acc[df][1]); }
            }
#pragma unroll
            for (int ef = 0; ef < 2; ++ef) { const int e = 32 * wave + 16 * ef + (lane & 15);
#pragma unroll
                for (int df = 0; df < 8; ++df) { const f32x4 v = acc[df][ef]; u32x2 w; w.x = cvtpk(v[0], v[1]); w.y = cvtpk(v[2], v[3]);
                    *(u32x2*)(kvT + ((size_t)u * 256 + e) * 128 + 16 * df + 4 * g) = w; } }
            if (tid < 128) { float nsum = 0.f;
#pragma unroll 8
                for (int l = 0; l < 64; ++l) nsum += __uint_as_float((unsigned)(*(const LAS unsigned short*)(KW + l * 288 + tid * 2)) << 16);
                ncb[u * 128 + tid] = nsum; }
            __syncthreads();
        }
    }
    xcd_barrier(bar);

    {
        for (int id = gt; id < 8 * 16384; id += NGT) {
            const int bh = id >> 14, pi = id & 16383;
            unsigned* base = (unsigned*)kvT + (size_t)bh * 64 * 16384 + pi;
            float c0 = 0.f, c1 = 0.f, m = 0.f;
#pragma unroll 1
            for (int cb = 0; cb < 64; cb += 8) {
                unsigned xv[8];
#pragma unroll
                for (int i = 0; i < 8; ++i) xv[i] = base[(size_t)(cb + i) * 16384];
#pragma unroll
                for (int i = 0; i < 8; ++i) {
                    const float gg = msc_g[bh * 64 + cb + i], ml = msc_ml[bh * 64 + cb + i];
                    const float mn = fmaxf(gg + m, ml), so = __expf(gg + m - mn), sn = __expf(ml - mn);
                    base[(size_t)(cb + i) * 16384] = cvtpk(c0, c1);
                    c0 = so * c0 + sn * bf_lo(xv[i]); c1 = so * c1 + sn * bf_hi(xv[i]); m = mn;
                }
            }
        }
        for (int id = gt; id < 8 * 128; id += NGT) {
            const int bh = id >> 7, dd = id & 127; float n = 0.f, m = 0.f;
#pragma unroll 1
            for (int c = 0; c < 64; ++c) {
                const float gg = msc_g[bh * 64 + c], ml = msc_ml[bh * 64 + c];
                const float mn = fmaxf(gg + m, ml), so = __expf(gg + m - mn), sn = __expf(ml - mn);
                const float x = ncb[(bh * 64 + c) * 128 + dd]; ncb[(bh * 64 + c) * 128 + dd] = n;
                if (dd == 0) msc_mp[bh * 64 + c] = m;
                n = so * n + sn * x; m = mn;
            }
        }
        for (int u = vcu; u < 256; u += G) {
            const int b = u >> 7, tile = (u >> 3) & 15, h = u & 7;
            LAS unsigned char* vl = lds + wave * 9216;
            attn_group(proj, rcos, rsin, a.q_norm_w, a.attn_norm_w, b, h, tile * 256, wave, vl, lane);
            attn_group(proj, rcos, rsin, a.q_norm_w, a.attn_norm_w, b, h, tile * 256, wave + 8, vl, lane);
        }
    }
    xcd_barrier(bar);

    {
        LAS unsigned char* QT = lds; LAS unsigned char* KT = lds + 18432; LAS unsigned char* VT = lds + 36864;
        LAS float* NP = (LAS float*)(lds + 71680); LAS float* XCH = (LAS float*)(lds + 72192);
        const int j = lane & 15, g = lane >> 4, qp = j >> 2, p = lane & 3;
        const int tf = wave & 3, eh = wave >> 2;
        for (int u = vcu; u < 512; u += G) {
            const int b = u >> 8, h = (u >> 6) & 3, c = u & 63;
            const int tok = b * SEQ + c * 64 + lane;
            const float li = gli[tok * 4 + h], lf = glf[tok * 4 + h];
            const float cf = scan_add64(lf, lane);
            const float bvec = li - cf;
            const float pm = scan_max64(bvec, lane);
            const float mprev = msc_mp[u];
            const float Mv = fmaxf(mprev, pm);
            const float wiv = __expf(mprev - Mv), emtv = __expf(-cf - Mv);
            conv_tile<false>(proj, a.conv_w, a.conv_b, b, c, PC_MQ + h * 128, h * 128, 0.08838834764831845f, 0.f, QT, tid);
            conv_tile<false>(proj, a.conv_w, a.conv_b, b, c, PC_MK + h * 128, 512 + h * 128, 1.0f, 0.f, KT, tid);
            v_tile(proj, b, c, h, VT, tid);
            if (tid < 128) NP[tid] = ncb[u * 128 + tid];
            __syncthreads();
            const int t = 16 * tf + j;
            const float M_t = __shfl(Mv, t), wi_t = __shfl(wiv, t), emt_t = __shfl(emtv, t);
            bf16x8 qf[4];
#pragma unroll
            for (int ks = 0; ks < 4; ++ks) qf[ks] = *(const LAS bf16x8*)(QT + t * 288 + (32 * ks + 8 * g) * 2);
            float sp[4][4]; float rowsum = 0.f;
#pragma unroll
            for (int sf = 0; sf < 4; ++sf) {
                f32x4 sa = {0.f, 0.f, 0.f, 0.f};
                if (sf <= tf) {
#pragma unroll
                    for (int ks = 0; ks < 4; ++ks) { const bf16x8 kfr = *(const LAS bf16x8*)(KT + (16 * sf + j) * 288 + (32 * ks + 8 * g) * 2); sa = MFMA16(kfr, qf[ks], sa); }
                }
#pragma unroll
                for (int rg = 0; rg < 4; ++rg) { const int sidx = 16 * sf + 4 * g + rg; const float bs = __shfl(bvec, sidx);
                    const float pv = (sidx <= t) ? __expf(bs - M_t) : 0.f; sp[sf][rg] = sa[rg] * pv; rowsum += sp[sf][rg]; }
            }
            bf16x8 pb[2];
#pragma unroll
            for (int kk = 0; kk < 2; ++kk) { float tmp[8] = {sp[2 * kk][0], sp[2 * kk][1], sp[2 * kk][2], sp[2 * kk][3], sp[2 * kk + 1][0], sp[2 * kk + 1][1], sp[2 * kk + 1][2], sp[2 * kk + 1][3]};
                const u32x4 w = pack8(tmp); pb[kk] = __builtin_bit_cast(bf16x8, w); }
            f32x4 ai[8], ae[8];
#pragma unroll
            for (int ef = 0; ef < 8; ++ef) { ai[ef] = (f32x4){0.f, 0.f, 0.f, 0.f}; ae[ef] = (f32x4){0.f, 0.f, 0.f, 0.f}; }
#pragma unroll
            for (int kk = 0; kk < 2; ++kk) {
                if (kk == 0 || tf >= 2) {
#pragma unroll
                    for (int ef = 0; ef < 8; ++ef) { const int col = 128 * eh + 16 * ef + 4 * p;
                        const bf16x8 af = cat4(vtr(VT + (32 * kk + 4 * g + qp) * 544 + col * 2), vtr(VT + (32 * kk + 16 + 4 * g + qp) * 544 + col * 2));
                        ai[ef] = MFMA16(af, pb[kk], ai[ef]); }
                }
            }
            const bf16* cp = kvT + ((size_t)u * 256 + 128 * eh + j) * 128 + 8 * g;
#pragma unroll
            for (int ef = 0; ef < 8; ++ef) {
#pragma unroll
                for (int ks = 0; ks < 4; ++ks) { const bf16x8 cfr = *(const bf16x8*)(cp + (size_t)(16 * ef) * 128 + 32 * ks); ae[ef] = MFMA16(cfr, qf[ks], ae[ef]); }
            }
            float qn = 0.f;
#pragma unroll
            for (int ks = 0; ks < 4; ++ks) { float qv[8]; unpack8(__builtin_bit_cast(u32x4, qf[ks]), qv);
#pragma unroll
                for (int e = 0; e < 8; ++e) qn += qv[e] * NP[32 * ks + 8 * g + e]; }
            qn += __shfl_xor(qn, 16); qn += __shfl_xor(qn, 32);
            rowsum += __shfl_xor(rowsum, 16); rowsum += __shfl_xor(rowsum, 32);
            const float den = wi_t * qn + rowsum;
            const float dinv = 1.0f / fmaxf(fabsf(den), emt_t);
            float ssq = 0.f;
#pragma unroll
            for (int ef = 0; ef < 8; ++ef) { ai[ef] = (ae[ef] * wi_t + ai[ef]) * dinv; ssq += (ai[ef][0] * ai[ef][0] + ai[ef][1] * ai[ef][1]) + (ai[ef][2] * ai[ef][2] + ai[ef][3] * ai[ef][3]); }
            ssq += __shfl_xor(ssq, 16); ssq += __shfl_xor(ssq, 32);
            if (g == 0) XCH[eh * 64 + t] = ssq;
            __syncthreads();
            const float rn = 1.0f / sqrtf((XCH[t] + XCH[64 + t]) * (1.0f / 256.0f) + NORM_EPS);
            bf16* orow = proj + (size_t)(b * SEQ + c * 64 + t) * NPROJ;
#pragma unroll
            for (int ef = 0; ef < 8; ++ef) { const int e = 128 * eh + 16 * ef + 4 * g;
                const f32x4 nw = *(const f32x4*)(a.mlstm_norm_w + h * 256 + e);
                const u32x2 mo = *(const u32x2*)(orow + PC_MO + h * 256 + e);
                const float mof[4] = {bf_lo(mo.x), bf_hi(mo.x), bf_lo(mo.y), bf_hi(mo.y)};
                float r4[4];
#pragma unroll
                for (int e2 = 0; e2 < 4; ++e2) r4[e2] = ai[ef][e2] * rn * nw[e2] / (1.0f + __expf(-mof[e2]));
                u32x2 w; w.x = cvtpk(r4[0], r4[1]); w.y = cvtpk(r4[2], r4[3]); *(u32x2*)(orow + PC_MV + h * 256 + e) = w; }
            __syncthreads();
        }
    }
    xcd_barrier(bar);

    {
        pg8::Gemm g{proj + PC_MV, WoutT, MTOK, DM, DM, NPROJ}; pg8::StaticOrder S; S.init(MTOK, DM, G, bx);
        pg8::EpiRes1 E{a.x, a.out, H1b, sumsq, DM};
        pg8::gemm_phase<pg8::EpiRes1, false>(lds, g, S, E);
    }
    xcd_barrier(bar);

    {
        pg8::Gemm g{H1b, WguT, MTOK, NGU, DM, DM}; pg8::StaticOrder S; S.init(MTOK, NGU, G, bx);
        pg8::EpiSwiGLU E{FF, DFF, sumsq};
        pg8::gemm_phase<pg8::EpiSwiGLU, true>(lds, g, S, E);
    }
    xcd_barrier(bar);

    {
        pg8::Gemm g{FF, WdnT, MTOK, DM, DFF, DFF}; pg8::StaticOrder S; S.init(MTOK, DM, G, bx);
        pg8::EpiRes2 E{a.out, DM};
        pg8::gemm_phase<pg8::EpiRes2, false>(lds, g, S, E);
    }
}

extern "C" void kernel_launch(void* const* d_in, const int* in_sizes, int n_in, void* d_out, int out_size, void* d_ws, size_t ws_size, hipStream_t stream) {
    static int grid = 0;
    if (grid == 0) {
        if (n_in != 16 || in_sizes[0] != MTOK * DM || out_size != MTOK * DM || ws_size < WS_END) { fprintf(stderr, "kernel_launch: unexpected shapes (n_in %d in0 %d out %d ws %zu)\n", n_in, n_in > 0 ? in_sizes[0] : -1, out_size, ws_size); grid = -1; return; }
        int dev = 0, cus = 0;
        if (hipGetDevice(&dev) != hipSuccess || hipDeviceGetAttribute(&cus, hipDeviceAttributeMultiprocessorCount, dev) != hipSuccess || cus <= 0) cus = 256;
        if (hipFuncSetAttribute((const void*)hymba_fwd, hipFuncAttributeMaxDynamicSharedMemorySize, LDS_BYTES) != hipSuccess) { fprintf(stderr, "kernel_launch: hipFuncSetAttribute failed\n"); grid = -1; return; }
        (void)hipGetLastError();
        grid = cus;
    }
    if (grid < 0) return;
    if (hipMemsetAsync((char*)d_ws + WS_CTL, 0, CTL_ZERO_BYTES, stream) != hipSuccess) { fprintf(stderr, "kernel_launch: memset failed\n"); return; }
    Args a{};
    a.x = (const float*)d_in[0]; a.norm1_w = (const float*)d_in[1]; a.w_in = (const float*)d_in[2]; a.conv_w = (const float*)d_in[3]; a.conv_b = (const float*)d_in[4];
    a.igate_b = (const float*)d_in[5]; a.fgate_b = (const float*)d_in[6]; a.q_norm_w = (const float*)d_in[7]; a.k_norm_w = (const float*)d_in[8];
    a.mlstm_norm_w = (const float*)d_in[9]; a.attn_norm_w = (const float*)d_in[10]; a.w_out = (const float*)d_in[11]; a.norm2_w = (const float*)d_in[12];
    a.w_gate = (const float*)d_in[13]; a.w_up = (const float*)d_in[14]; a.w_down = (const float*)d_in[15];
    a.out = (float*)d_out; a.ws = (unsigned char*)d_ws;
    hipLaunchKernelGGL(hymba_fwd, dim3(grid), dim3(NWAVES * 64), LDS_BYTES, stream, a);
}
```

```cpp
#include <hip/hip_runtime.h>
#include <cstdio>
#include <cstdint>

#define LAS __attribute__((address_space(3)))
#define GAS __attribute__((address_space(1)))
typedef unsigned short bf16;
typedef short bf16x8 __attribute__((ext_vector_type(8)));
typedef short s16x4 __attribute__((ext_vector_type(4)));
typedef float f32x4 __attribute__((ext_vector_type(4)));
typedef float f32x2 __attribute__((ext_vector_type(2)));
typedef unsigned u32x4 __attribute__((ext_vector_type(4)));
typedef unsigned u32x2 __attribute__((ext_vector_type(2)));
typedef __bf16 bf16x2_t __attribute__((ext_vector_type(2)));

constexpr int BATCH = 2, SEQ = 4096, DM = 2048, MTOK = BATCH * SEQ;
constexpr int INW = 6152, NPROJ = 6144, DFF = 5632, NGU = 2 * DFF;
constexpr int PC_MQ = 0, PC_MK = 512, PC_MO = 1024, PC_MV = 2048, PC_AQ = 3072, PC_AK = 4096, PC_AV = 5120;
constexpr float NORM_EPS = 1e-6f;
constexpr int NWAVES = 8;

constexpr size_t MiB = 1u << 20;
constexpr size_t WS_CTL = 0, CTL_ZERO_BYTES = 1 * MiB;
constexpr size_t WS_GLI = 1 * MiB;
constexpr size_t WS_GLF = WS_GLI + 128 * 1024;
constexpr size_t WS_SUMSQ = WS_GLF + 128 * 1024;
constexpr size_t WS_MSC = WS_SUMSQ + 32 * 1024;
constexpr size_t WS_NC = WS_MSC + 8 * 1024;
constexpr size_t WS_COS = 2 * MiB, WS_SIN = 3 * MiB;
constexpr size_t WS_WIN = 6 * MiB;
constexpr size_t WS_KV = 6 * MiB;
constexpr size_t WS_U = 30 * MiB;
constexpr size_t WS_PROJ = 62 * MiB;
constexpr size_t WS_WOUT = 158 * MiB;
constexpr size_t WS_WGU = 166 * MiB;
constexpr size_t WS_WDN = 210 * MiB;
constexpr size_t WS_OP0 = 38 * MiB;
constexpr size_t WS_OP1 = 232 * MiB;
constexpr size_t WS_PL0 = 248 * MiB, WS_PL1 = WS_PL0 + 256 * 1024;
constexpr size_t WS_END = 249 * MiB;
constexpr int CW_BAR = 4096;

constexpr int RING_BYTES = 131072;
constexpr int MISC_OFF = RING_BYTES;
constexpr int LDS_BYTES = 147456;

__device__ __forceinline__ unsigned cvtpk(float lo, float hi) { f32x2 v = {lo, hi}; bf16x2_t b = __builtin_convertvector(v, bf16x2_t); return __builtin_bit_cast(unsigned, b); }
__device__ __forceinline__ float bf_lo(unsigned w) { return __uint_as_float(w << 16); }
__device__ __forceinline__ float bf_hi(unsigned w) { return __uint_as_float(w & 0xffff0000u); }
__device__ __forceinline__ void unpack8(u32x4 w, float* f) { f[0] = bf_lo(w.x); f[1] = bf_hi(w.x); f[2] = bf_lo(w.y); f[3] = bf_hi(w.y); f[4] = bf_lo(w.z); f[5] = bf_hi(w.z); f[6] = bf_lo(w.w); f[7] = bf_hi(w.w); }
__device__ __forceinline__ u32x4 pack8(const float* f) { u32x4 w; w.x = cvtpk(f[0], f[1]); w.y = cvtpk(f[2], f[3]); w.z = cvtpk(f[4], f[5]); w.w = cvtpk(f[6], f[7]); return w; }
__device__ __forceinline__ float wave_sum(float v) {
#pragma unroll
    for (int o = 1; o < 64; o <<= 1) v += __shfl_xor(v, o);
    return v;
}
__device__ __forceinline__ float wave_max(float v) {
#pragma unroll
    for (int o = 1; o < 64; o <<= 1) v = fmaxf(v, __shfl_xor(v, o));
    return v;
}
__device__ __forceinline__ s16x4 vtr(const LAS unsigned char* p) { return __builtin_bit_cast(s16x4, __builtin_amdgcn_ds_read_tr16_b64_v4i16((LAS s16x4*)p)); }
__device__ __forceinline__ bf16x8 cat4(s16x4 a, s16x4 b) { return (bf16x8){a[0], a[1], a[2], a[3], b[0], b[1], b[2], b[3]}; }
#define LDS_WAIT() asm volatile("s_waitcnt lgkmcnt(0)" ::: "memory")
#define VM_WAIT() asm volatile("s_waitcnt vmcnt(0)" ::: "memory")
#define SBAR() __builtin_amdgcn_sched_barrier(0)
#define MFMA16(a, b, c) __builtin_amdgcn_mfma_f32_16x16x32_bf16((a), (b), (c), 0, 0, 0)

namespace pg8 {
constexpr int BM = 256, BK = 64, HALF = 128, HTB = HALF * BK * 2, STAGE_BYTES = 8 * HTB, NXCD = 8, WGM = 8;
__host__ __device__ __forceinline__ int lds_byte(int r, int c) { const int st = (r >> 4) * 2 + (c >> 5), rr = r & 15, cc = c & 31, ob = rr * 64 + cc * 2; return st * 1024 + (ob ^ (((ob >> 9) & 1) << 5)); }
__host__ __device__ __forceinline__ void stage_rc(int b, int& R, int& C) { const int st = b / 1024, sb = b % 1024, swz = sb ^ (((sb >> 9) & 1) << 5); R = (st >> 1) * 16 + swz / 64; C = (st & 1) * 32 + (swz % 64) / 2; }
__host__ __device__ __forceinline__ int perm32(int rho) { const int n = rho >> 4, i = rho & 15; return 8 * (i >> 2) + 4 * n + (i & 3); }
struct Unit { int pm, pn; };
struct Gemm { const bf16* A; const bf16* Bt; int M, N, K, lda; };
struct StaticOrder {
    int nM, nN, nwg, G, c;
    __device__ void init(int M, int N, int G_, int c_) { nM = M / BM; nN = N / BM; nwg = nM * nN; G = G_; c = c_; }
    __device__ bool next(int i, Unit& u) const {
        const long L = (long)i * G + c; if (L >= nwg) return false;
        int wgid = (int)L; { const int q = nwg / NXCD, r = nwg % NXCD, xcd = wgid % NXCD, off = wgid / NXCD; wgid = (xcd < r ? xcd * (q + 1) : r * (q + 1) + (xcd - r) * q) + off; }
        const int nig = WGM * nN, gid = wgid / nig, fm = gid * WGM, gsz = (nM - fm) < WGM ? (nM - fm) : WGM;
        u.pm = fm + ((wgid % nig) % gsz); u.pn = (wgid % nig) / gsz; return true;
    }
};
struct EpiBf16 {
    static constexpr bool PERM = true;
    bf16* O; int ldc;
    __device__ __forceinline__ void operator()(const f32x4 (&acc)[2][2][4][2], const Unit& u, int wr, int wc, int fr, int fq) const {
        const int row0 = u.pm * BM + wr * 64 + fr, col0 = u.pn * BM + wc * 32 + 8 * fq;
#pragma unroll
        for (int ai = 0; ai < 2; ++ai)
#pragma unroll
            for (int m = 0; m < 4; ++m) { bf16* rowp = O + (size_t)(row0 + ai * HALF + m * 16) * ldc + col0;
#pragma unroll
                for (int bj = 0; bj < 2; ++bj) { const f32x4 v0 = acc[ai][bj][m][0], v1 = acc[ai][bj][m][1];
                    u32x4 w; w.x = cvtpk(v0[0], v0[1]); w.y = cvtpk(v0[2], v0[3]); w.z = cvtpk(v1[0], v1[1]); w.w = cvtpk(v1[2], v1[3]);
                    *(u32x4*)(rowp + bj * HALF) = w; } }
    }
};
struct EpiRes1 {
    static constexpr bool PERM = false;
    const float* xres; float* out; bf16* h1b; float* sumsq; int ldc; bool dry;
    __device__ __forceinline__ void operator()(const f32x4 (&acc)[2][2][4][2], const Unit& u, int wr, int wc, int fr, int fq) const {
        const int col0 = u.pn * BM + wc * 32 + 4 * fq;
#pragma unroll
        for (int ai = 0; ai < 2; ++ai)
#pragma unroll
            for (int m = 0; m < 4; ++m) { const int row = u.pm * BM + ai * HALF + wr * 64 + m * 16 + fr; const size_t off = (size_t)row * ldc + col0; float ss = 0.f;
#pragma unroll
                for (int bj = 0; bj < 2; ++bj)
#pragma unroll
                    for (int n = 0; n < 2; ++n) { const size_t o2 = off + bj * HALF + n * 16; const f32x4 h = *(const f32x4*)(xres + o2) + acc[ai][bj][m][n];
                        u32x2 w; w.x = cvtpk(h[0], h[1]); w.y = cvtpk(h[2], h[3]); if (!dry) { *(f32x4*)(out + o2) = h; *(u32x2*)(h1b + o2) = w; }
                        ss += (h[0] * h[0] + h[1] * h[1]) + (h[2] * h[2] + h[3] * h[3]); }
                ss += __shfl_xor(ss, 16); ss += __shfl_xor(ss, 32);
                if (fq == 0 && !dry) atomicAdd(sumsq + row, ss); }
    }
};
struct EpiSwiGLU {
    static constexpr bool PERM = true;
    bf16* O; int ldc; const float* sumsq;
    __device__ __forceinline__ void operator()(const f32x4 (&acc)[2][2][4][2], const Unit& u, int wr, int wc, int fr, int fq) const {
        const int col0 = u.pn * HALF + wc * 32 + 8 * fq;
#pragma unroll
        for (int ai = 0; ai < 2; ++ai)
#pragma unroll
            for (int m = 0; m < 4; ++m) { const int row = u.pm * BM + ai * HALF + wr * 64 + m * 16 + fr;
                const float rs = 1.0f / sqrtf(sumsq[row] * (1.0f / DM) + NORM_EPS);
                float f[8];
#pragma unroll
                for (int n = 0; n < 2; ++n)
#pragma unroll
                    for (int j = 0; j < 4; ++j) { const float g = acc[ai][0][m][n][j] * rs, up = acc[ai][1][m][n][j] * rs; f[n * 4 + j] = g / (1.0f + __expf(-g)) * up; }
                *(u32x4*)(O + (size_t)row * ldc + col0) = pack8(f); }
    }
};
struct EpiRes2 {
    static constexpr bool PERM = false;
    float* out; int ldc; bool dry;
    __device__ __forceinline__ void operator()(const f32x4 (&acc)[2][2][4][2], const Unit& u, int wr, int wc, int fr, int fq) const {
        const int col0 = u.pn * BM + wc * 32 + 4 * fq;
#pragma unroll
        for (int ai = 0; ai < 2; ++ai)
#pragma unroll
            for (int m = 0; m < 4; ++m) { const size_t off = (size_t)(u.pm * BM + ai * HALF + wr * 64 + m * 16 + fr) * ldc + col0;
#pragma unroll
                for (int bj = 0; bj < 2; ++bj)
#pragma unroll
                    for (int n = 0; n < 2; ++n) { const size_t o2 = off + bj * HALF + n * 16; const f32x4 r_ = *(const f32x4*)(out + o2) + acc[ai][bj][m][n]; if (!dry) *(f32x4*)(out + o2) = r_; } }
    }
};

template <class Epi, bool ALIGN_EPI>
__device__ __forceinline__ void gemm_phase(LAS unsigned char* lds, const Gemm g, const StaticOrder& S, const Epi& E) {
    const int tid = threadIdx.x, wid = __builtin_amdgcn_readfirstlane(tid >> 6), lane = tid & 63, wr = wid >> 2, wc = wid & 3, fr = lane & 15, fq = lane >> 4;
    const int K = g.K, nt = K / BK;
    unsigned voffA[2], voffB[2];
#pragma unroll
    for (int i = 0; i < 2; ++i) { int R, C; stage_rc(tid * 16 + i * 8192, R, C); const int Rb = Epi::PERM ? ((R & ~31) + perm32(R & 31)) : R;
        voffA[i] = (unsigned)(R * g.lda + C) * 2u; voffB[i] = (unsigned)(Rb * K + C) * 2u; }
    const size_t kstep = (size_t)(BK * 2);
    const size_t hstepA = (size_t)HALF * g.lda * 2, hstepB = (size_t)HALF * K * 2;
    const size_t tstepA = 2 * hstepA, tstepB = 2 * hstepB;
    const unsigned ldsw = (unsigned)wid * 1024u;
    const int aoff = lds_byte(wr * 64 + fr, fq * 8), boff = lds_byte(wc * 32 + fr, fq * 8);
#define PG8_SA(b, h) (((b) * 2 + (h)) * HTB)
#define PG8_SB(b, h) ((4 + (b) * 2 + (h)) * HTB)
#define PG8_STAGE(bufoff, gbase, voff) do { _Pragma("unroll") for (int _i = 0; _i < 2; ++_i) \
        __builtin_amdgcn_global_load_lds((const unsigned*)((const char*)(gbase) + (voff)[_i]), (LAS unsigned*)(lds + (bufoff) + ldsw + _i * 8192), 16, 0, 0); } while (0)
#define PG8_LDA(dst, b, h) do { _Pragma("unroll") for (int m = 0; m < 4; ++m) _Pragma("unroll") for (int k = 0; k < 2; ++k) dst[m][k] = *(const LAS bf16x8*)(lds + PG8_SA(b, h) + aoff + m * 2048 + k * 1024); } while (0)
#define PG8_LDB(dst, b, h) do { _Pragma("unroll") for (int n = 0; n < 2; ++n) _Pragma("unroll") for (int k = 0; k < 2; ++k) dst[n][k] = *(const LAS bf16x8*)(lds + PG8_SB(b, h) + boff + n * 2048 + k * 1024); } while (0)
#define PG8_MMA(ai, bj, At, Bt) do { __builtin_amdgcn_s_setprio(1); _Pragma("unroll") for (int m = 0; m < 4; ++m) _Pragma("unroll") for (int n = 0; n < 2; ++n) _Pragma("unroll") for (int k = 0; k < 2; ++k) \
        acc[ai][bj][m][n] = __builtin_amdgcn_mfma_f32_16x16x32_bf16(Bt[n][k], At[m][k], acc[ai][bj][m][n], 0, 0, 0); __builtin_amdgcn_s_setprio(0); } while (0)
#define PG8_WAIT_V(n) asm volatile("s_waitcnt vmcnt(" #n ")" ::: "memory")
#define PG8_WAIT_L(n) asm volatile("s_waitcnt lgkmcnt(" #n ")" ::: "memory")
#define PG8_BAR __builtin_amdgcn_s_barrier()
#define PG8_SCHED __builtin_amdgcn_sched_barrier(0)
    Unit cur, nxt; int ui = 0;
    if (!S.next(0, cur)) return;
    f32x4 acc[2][2][4][2];
#pragma unroll
    for (int a = 0; a < 2; ++a)
#pragma unroll
        for (int b = 0; b < 2; ++b)
#pragma unroll
            for (int m = 0; m < 4; ++m)
#pragma unroll
                for (int n = 0; n < 2; ++n) acc[a][b][m][n] = (f32x4){0.f, 0.f, 0.f, 0.f};
    bf16x8 At[4][2], B0[2][2], B1[2][2];
    const char* cA = (const char*)g.A + (size_t)cur.pm * tstepA; const char* cB = (const char*)g.Bt + (size_t)cur.pn * tstepB;
    PG8_STAGE(PG8_SB(0, 0), cB, voffB); PG8_STAGE(PG8_SB(0, 1), cB + hstepB, voffB); PG8_STAGE(PG8_SA(0, 0), cA, voffA); PG8_STAGE(PG8_SA(0, 1), cA + hstepA, voffA);
    if (wr == 1) PG8_BAR;
    PG8_WAIT_V(2); PG8_BAR;
    PG8_STAGE(PG8_SB(1, 0), cB + kstep, voffB); PG8_STAGE(PG8_SA(1, 0), cA + kstep, voffA); PG8_STAGE(PG8_SB(1, 1), cB + hstepB + kstep, voffB);
    PG8_WAIT_V(6); PG8_BAR;
    for (;;) {
        const bool has_next = S.next(ui + 1, nxt);
        const char* nA = has_next ? (const char*)g.A + (size_t)nxt.pm * tstepA : cA; const char* nB = has_next ? (const char*)g.Bt + (size_t)nxt.pn * tstepB : cB;
        for (int t = 0; t < nt; t += 2) {
            const bool last = (t == nt - 2);
            const char* a1 = cA + (size_t)(t + 1) * kstep;
            const char* a2 = last ? nA : cA + (size_t)(t + 2) * kstep; const char* b2 = last ? nB : cB + (size_t)(t + 2) * kstep;
            const char* a3 = a2 + kstep; const char* b3 = b2 + kstep;
            PG8_LDB(B0, 0, 0); PG8_LDB(B1, 0, 1); PG8_SCHED; PG8_LDA(At, 0, 0); PG8_STAGE(PG8_SA(1, 1), a1 + hstepA, voffA);
            PG8_WAIT_V(8); PG8_WAIT_L(0); PG8_BAR; PG8_MMA(0, 0, At, B0); PG8_MMA(0, 1, At, B1); PG8_BAR; PG8_SCHED;
            PG8_LDA(At, 0, 1); PG8_STAGE(PG8_SB(0, 0), b2, voffB); PG8_STAGE(PG8_SB(0, 1), b2 + hstepB, voffB); PG8_STAGE(PG8_SA(0, 0), a2, voffA);
            PG8_WAIT_V(8); PG8_WAIT_L(0); PG8_BAR; PG8_MMA(1, 0, At, B0); PG8_MMA(1, 1, At, B1); PG8_BAR; PG8_SCHED;
            PG8_LDB(B0, 1, 0); PG8_LDB(B1, 1, 1); PG8_SCHED; PG8_LDA(At, 1, 0); PG8_STAGE(PG8_SA(0, 1), a2 + hstepA, voffA);
            PG8_WAIT_V(8); PG8_WAIT_L(0); PG8_BAR; PG8_MMA(0, 0, At, B0); PG8_MMA(0, 1, At, B1); PG8_BAR; PG8_SCHED;
            PG8_LDA(At, 1, 1); PG8_STAGE(PG8_SB(1, 0), b3, voffB); PG8_STAGE(PG8_SB(1, 1), b3 + hstepB, voffB); PG8_STAGE(PG8_SA(1, 0), a3, voffA);
            PG8_WAIT_V(8); PG8_WAIT_L(0); PG8_BAR; PG8_MMA(1, 0, At, B0); PG8_MMA(1, 1, At, B1); PG8_BAR; PG8_SCHED;
        }
        if constexpr (ALIGN_EPI) { if (wr == 0) PG8_BAR; }
        E(acc, cur, wr, wc, fr, fq);
        if (!has_next) break;
#pragma unroll
        for (int a = 0; a < 2; ++a)
#pragma unroll
            for (int b = 0; b < 2; ++b)
#pragma unroll
                for (int m = 0; m < 4; ++m)
#pragma unroll
                    for (int n = 0; n < 2; ++n) acc[a][b][m][n] = (f32x4){0.f, 0.f, 0.f, 0.f};
        cur = nxt; cA = nA; cB = nB; ++ui;
        if constexpr (ALIGN_EPI) { if (wr == 1) PG8_BAR; }
    }
    PG8_WAIT_V(0);
    if constexpr (!ALIGN_EPI) { if (wr == 0) PG8_BAR; }
    PG8_BAR;
#undef PG8_SA
#undef PG8_SB
#undef PG8_STAGE
#undef PG8_LDA
#undef PG8_LDB
#undef PG8_MMA
#undef PG8_WAIT_V
#undef PG8_WAIT_L
#undef PG8_BAR
#undef PG8_SCHED
}
}

#define XB_TMO      128
#define XB_XCNT(j)  (256  + 64 * (j))
#define XB_XSUB(j)  (1280 + 64 * (j))
#define XB_XGEN(j)  (2304 + 64 * (j))
#define XB_TOP      3328
#define XB_TOPGEN   3392
#define XCD_BAR_WORDS 3456
#define XB_SPIN_CAP (1u << 18)
__device__ __forceinline__ unsigned xb_ld(unsigned* p)              { return __hip_atomic_load(p, __ATOMIC_RELAXED, __HIP_MEMORY_SCOPE_AGENT); }
__device__ __forceinline__ unsigned xb_add(unsigned* p, unsigned v) { return __hip_atomic_fetch_add(p, v, __ATOMIC_RELAXED, __HIP_MEMORY_SCOPE_AGENT); }
__device__ __forceinline__ unsigned xb_xcc_id() { return (unsigned)__builtin_amdgcn_s_getreg((3 << 11) | 20) & 0xFu; }
#define XB_SPIN(cond, bar) do { unsigned _sp = 0; while (cond) { __builtin_amdgcn_s_sleep(1); \
    if ((++_sp & 255u) == 0u) { if (xb_ld(&(bar)[XB_TMO])) break; if (_sp > XB_SPIN_CAP) { atomicAdd(&(bar)[XB_TMO], 1u); break; } } } } while (0)
struct XcdBarrier { unsigned* bar; unsigned x; volatile LAS unsigned* st; };
__device__ __forceinline__ XcdBarrier xcd_barrier_post(unsigned* bar, volatile LAS unsigned* st) {
    XcdBarrier b; b.bar = bar; b.x = xb_xcc_id(); b.st = st;
    if (threadIdx.x == 0) (void)xb_add(&bar[XB_XCNT(b.x)], 1u);
    return b;
}
__device__ __forceinline__ void xcd_barrier_complete(unsigned* bar, unsigned x, unsigned& nloc, unsigned& nx) {
    const unsigned G = gridDim.x * gridDim.y * gridDim.z;
    unsigned sum, cnt, mine, sp = 0u;
    for (;;) {
        sum = 0u; cnt = 0u; mine = 0u;
#pragma unroll
        for (unsigned j = 0; j < 16; ++j) { const unsigned c = xb_ld(&bar[XB_XCNT(j)]); sum += c; cnt += (c > 0u) ? 1u : 0u; mine = (j == x) ? c : mine; }
        if (sum == G) break;
        __builtin_amdgcn_s_sleep(1);
        if ((++sp & 255u) == 0u) { if (xb_ld(&bar[XB_TMO])) break; if (sp > XB_SPIN_CAP) { atomicAdd(&bar[XB_TMO], 1u); break; } }
    }
    nloc = mine > 0u ? mine : 1u; nx = cnt > 0u ? cnt : 1u;
}
__device__ __forceinline__ void xcd_barrier(const XcdBarrier& b) {
    asm volatile("s_waitcnt vmcnt(0)" ::: "memory");
    __syncthreads();
    if (threadIdx.x == 0) {
        unsigned* bar = b.bar;
        __builtin_amdgcn_s_waitcnt(0);
        unsigned nloc = b.st[0], nx = b.st[1];
        if (nloc == 0u) { xcd_barrier_complete(bar, b.x, nloc, nx); b.st[0] = nloc; b.st[1] = nx; }
        const unsigned old = xb_add(&bar[XB_XSUB(b.x)], 1u);
        const unsigned gen = old / nloc;
        if (old + 1u == (gen + 1u) * nloc) {
            __builtin_amdgcn_fence(__ATOMIC_RELEASE, "agent");
            asm volatile("s_waitcnt vmcnt(0)" ::: "memory");
            const unsigned og = xb_add(&bar[XB_TOP], 1u);
            const unsigned tg = og / nx;
            if (og + 1u == (tg + 1u) * nx) xb_add(&bar[XB_TOPGEN], 1u);
            else XB_SPIN(xb_ld(&bar[XB_TOPGEN]) == tg, bar);
            __builtin_amdgcn_fence(__ATOMIC_ACQUIRE, "agent");
            xb_add(&bar[XB_XGEN(b.x)], 1u);
            asm volatile("s_waitcnt vmcnt(0)" ::: "memory");
        } else {
            XB_SPIN(xb_ld(&bar[XB_XGEN(b.x)]) == gen, bar);
            __builtin_amdgcn_fence(__ATOMIC_ACQUIRE, "agent");
            asm volatile("s_waitcnt vmcnt(0)" ::: "memory");
        }
    }
    __syncthreads();
}

struct Args {
    const float* x; const float* norm1_w; const float* w_in; const float* conv_w; const float* conv_b; const float* igate_b; const float* fgate_b;
    const float* q_norm_w; const float* k_norm_w; const float* mlstm_norm_w; const float* attn_norm_w; const float* w_out; const float* norm2_w;
    const float* w_gate; const float* w_up; const float* w_down;
    float* out; unsigned char* ws; int dry; int pad;
};

struct TItem { const float* W; bf16* WT; const float* kscale; int ldw, K, nsrc0, ndst0, k0; };
__device__ __forceinline__ void titem_load(const TItem& t, f32x4 (&v)[8], int lane) {
    const float* src = t.W + (size_t)(t.k0 + (lane >> 3)) * t.ldw + t.nsrc0 + (lane & 7) * 4;
#pragma unroll
    for (int i = 0; i < 8; ++i) v[i] = *(const f32x4*)(src + (size_t)(8 * i) * t.ldw);
}
__device__ __forceinline__ void titem_finish(const TItem& t, const f32x4 (&v)[8], LAS float* scr, int lane) {
#pragma unroll
    for (int i = 0; i < 8; ++i) { const int kk = 8 * i + (lane >> 3); const float sc = t.kscale ? t.kscale[t.k0 + kk] : 1.0f; LAS float* d = scr + kk * 33 + (lane & 7) * 4;
        d[0] = v[i][0] * sc; d[1] = v[i][1] * sc; d[2] = v[i][2] * sc; d[3] = v[i][3] * sc; }
    LDS_WAIT(); asm volatile("" ::: "memory");
    const int c = lane & 7;
#pragma unroll
    for (int j = 0; j < 4; ++j) { const int n = (lane >> 3) + 8 * j; const LAS float* s = scr + (8 * c) * 33 + n;
        u32x4 o; o.x = cvtpk(s[0 * 33], s[1 * 33]); o.y = cvtpk(s[2 * 33], s[3 * 33]); o.z = cvtpk(s[4 * 33], s[5 * 33]); o.w = cvtpk(s[6 * 33], s[7 * 33]);
        *(u32x4*)(t.WT + (size_t)(t.ndst0 + n) * t.K + t.k0 + 8 * c) = o; }
    LDS_WAIT(); asm volatile("" ::: "memory");
}
__device__ __forceinline__ int win_src_col(int nd) {
    if (nd < 1024) return nd;
    if (nd < 2048) return nd + 1024;
    if (nd < 3072) return nd - 1024;
    return nd + 8;
}


__device__ __forceinline__ float scan_add64(float v, int lane) {
#pragma unroll
    for (int o = 1; o < 64; o <<= 1) { const float t = __shfl_up(v, o); if (lane >= o) v += t; }
    return v;
}
__device__ __forceinline__ float scan_max64(float v, int lane) {
#pragma unroll
    for (int o = 1; o < 64; o <<= 1) { const float t = __shfl_up(v, o); if (lane >= o) v = fmaxf(v, t); }
    return v;
}
template <bool ROWW>
__device__ __forceinline__ void conv_tile(const bf16* proj, const float* conv_w, const float* conv_b, int b, int c, int col0, int ch0, float rscale, float wlane, LAS unsigned char* tile, int tid) {
    const int rr = tid >> 4, cc = (tid & 15) * 8;
    float w[4][8], bb[8];
#pragma unroll
    for (int j = 0; j < 4; ++j) { const f32x4 w0 = *(const f32x4*)(conv_w + j * 1024 + ch0 + cc), w1 = *(const f32x4*)(conv_w + j * 1024 + ch0 + cc + 4);
        w[j][0] = w0[0]; w[j][1] = w0[1]; w[j][2] = w0[2]; w[j][3] = w0[3]; w[j][4] = w1[0]; w[j][5] = w1[1]; w[j][6] = w1[2]; w[j][7] = w1[3]; }
    { const f32x4 b0 = *(const f32x4*)(conv_b + ch0 + cc), b1 = *(const f32x4*)(conv_b + ch0 + cc + 4);
      bb[0] = b0[0]; bb[1] = b0[1]; bb[2] = b0[2]; bb[3] = b0[3]; bb[4] = b1[0]; bb[5] = b1[1]; bb[6] = b1[2]; bb[7] = b1[3]; }
#pragma unroll
    for (int half = 0; half < 2; ++half) {
        const int l = rr + 32 * half, t = c * 64 + l;
        float y[8];
#pragma unroll
        for (int e = 0; e < 8; ++e) y[e] = bb[e];
#pragma unroll
        for (int j = 0; j < 4; ++j) { const int tt = t - 3 + j;
            if (tt >= 0) { const u32x4 raw = *(const u32x4*)(proj + (size_t)(b * SEQ + tt) * NPROJ + col0 + cc); float x[8]; unpack8(raw, x);
#pragma unroll
                for (int e = 0; e < 8; ++e) y[e] += w[j][e] * x[e]; } }
        float sc = rscale;
        if (ROWW) sc *= __shfl(wlane, l);
#pragma unroll
        for (int e = 0; e < 8; ++e) y[e] = y[e] / (1.0f + __expf(-y[e])) * sc;
        *(LAS u32x4*)(tile + l * 288 + cc * 2) = pack8(y);
    }
}
__device__ __forceinline__ void v_tile(const bf16* proj, int b, int c, int h, LAS unsigned char* tile, int tid) {
#pragma unroll
    for (int p = 0; p < 4; ++p) { const int row = p * 16 + (tid >> 5), ch = tid & 31;
        const u32x4 v = *(const u32x4*)(proj + (size_t)(b * SEQ + c * 64 + row) * NPROJ + PC_MV + h * 256 + ch * 8);
        *(LAS u32x4*)(tile + row * 544 + ch * 16) = v; }
}

template <bool FINAL>
__device__ __forceinline__ void attn_unit(bf16* proj, const float* rcos, const float* rsin, const float* qnw, const float* anw, int b, int h, int d, int r, int n,
                                          LAS unsigned char* lds, bf16* po0, float* pl0, bf16* po1, float* pl1, int tid, int lane, int wave, bool dry) {
    const int j = lane & 15, g = lane >> 4, qp = j >> 2, p = lane & 3;
    const int qi = 16 * wave + j;
    const int tq = (128 * n + qi) * d + r;
    bf16* qrow = proj + (size_t)(b * SEQ + tq) * NPROJ + PC_AQ + h * 128;
    const int srow = tid >> 4, sch = tid & 15;
    const bf16* kcol = proj + (size_t)b * SEQ * NPROJ + PC_AK + h * 128 + sch * 8;
    const bf16* vcol = kcol + (PC_AV - PC_AK);
    const int kt0 = (n == 0) ? 4 : 0;
    const int sub0 = 128 * (n - 1) + srow;
    u32x4 rk[3], rv[3];
#define AT_ISSUE(t) do { if ((t) < 8) { const size_t tok_ = (size_t)((sub0 + 32 * (t)) * d + r); rk[(t) % 3] = *(const u32x4*)(kcol + tok_ * NPROJ); rv[(t) % 3] = *(const u32x4*)(vcol + tok_ * NPROJ); } } while (0)
#define AT_WRITE(t) do { LAS unsigned char* Kn_ = lds + ((t) & 1) * 18432; *(LAS u32x4*)(Kn_ + srow * 288 + sch * 16) = rk[(t) % 3]; *(LAS u32x4*)(Kn_ + 9216 + srow * 288 + sch * 16) = rv[(t) % 3]; } while (0)
#define WG_BAR() do { asm volatile("s_waitcnt lgkmcnt(0)" ::: "memory"); __builtin_amdgcn_s_barrier(); asm volatile("" ::: "memory"); } while (0)
    if (kt0 == 0) { AT_ISSUE(0); AT_ISSUE(1); AT_ISSUE(2); } else { AT_ISSUE(4); AT_ISSUE(5); AT_ISSUE(6); }
    bf16x8 qf[4];
    {
        float q[4][8]; float ss = 0.f;
#pragma unroll
        for (int ks = 0; ks < 4; ++ks) { const u32x4 raw = *(const u32x4*)(qrow + 32 * ks + 8 * g); unpack8(raw, q[ks]);
#pragma unroll
            for (int e = 0; e < 8; ++e) ss += q[ks][e] * q[ks][e]; }
        ss += __shfl_xor(ss, 16); ss += __shfl_xor(ss, 32);
        const float rq = 1.0f / sqrtf(ss * (1.0f / 128.0f) + NORM_EPS);
#pragma unroll
        for (int ks = 0; ks < 2; ++ks) {
            const int c0 = 32 * ks + 8 * g;
#pragma unroll
            for (int e4 = 0; e4 < 2; ++e4) {
                const f32x4 cs = *(const f32x4*)(rcos + tq * 64 + c0 + 4 * e4), sn = *(const f32x4*)(rsin + tq * 64 + c0 + 4 * e4);
                const f32x4 w1 = *(const f32x4*)(qnw + c0 + 4 * e4), w2 = *(const f32x4*)(qnw + 64 + c0 + 4 * e4);
#pragma unroll
                for (int e = 0; e < 4; ++e) { const float y1 = q[ks][4 * e4 + e] * rq * w1[e], y2 = q[ks + 2][4 * e4 + e] * rq * w2[e];
                    q[ks][4 * e4 + e] = y1 * cs[e] - y2 * sn[e]; q[ks + 2][4 * e4 + e] = y2 * cs[e] + y1 * sn[e]; }
            }
        }
#pragma unroll
        for (int ks = 0; ks < 4; ++ks) { const u32x4 w = pack8(q[ks]); qf[ks] = __builtin_bit_cast(bf16x8, w); }
    }
    if (kt0 == 0) AT_WRITE(0); else AT_WRITE(4);
    WG_BAR();
    float m_run = -1e30f, l_run = 0.f;
    f32x4 o[8];
#pragma unroll
    for (int nf = 0; nf < 8; ++nf) o[nf] = (f32x4){0.f, 0.f, 0.f, 0.f};
    const float SC = 0.08838834764831845f * 1.4426950408889634f;
    const float NEG = -__builtin_inff();
    const int wlo = wave >> 1;
#define AT_STEP(kt) do { if ((kt) >= kt0) { \
        LAS unsigned char* Kt = lds + ((kt) & 1) * 18432; LAS unsigned char* Vt = Kt + 9216; \
        AT_ISSUE((kt) + 3); \
        if ((kt) >= wlo && (kt) <= wlo + 4) { \
            f32x4 s0 = {0.f, 0.f, 0.f, 0.f}, s1 = {0.f, 0.f, 0.f, 0.f}; \
            _Pragma("unroll") for (int ks = 0; ks < 4; ++ks) { \
                const bf16x8 k0 = *(const LAS bf16x8*)(Kt + j * 288 + (32 * ks + 8 * g) * 2), k1 = *(const LAS bf16x8*)(Kt + (16 + j) * 288 + (32 * ks + 8 * g) * 2); \
                s0 = MFMA16(k0, qf[ks], s0); s1 = MFMA16(k1, qf[ks], s1); } \
            float x[8]; float tmax = NEG; \
            _Pragma("unroll") for (int e = 0; e < 8; ++e) { const int kj = 32 * (kt) + 16 * (e >> 2) + 4 * g + (e & 3); const float sv = (e < 4) ? s0[e & 3] : s1[e & 3]; \
                const bool valid = (kj >= qi) && (kj <= qi + 128); \
                x[e] = valid ? sv * SC : NEG; tmax = fmaxf(tmax, x[e]); } \
            tmax = fmaxf(tmax, __shfl_xor(tmax, 16)); tmax = fmaxf(tmax, __shfl_xor(tmax, 32)); \
            const float m_new = fmaxf(m_run, tmax); \
            const float alpha = __builtin_amdgcn_exp2f(m_run - m_new); \
            float ps = 0.f; \
            _Pragma("unroll") for (int e = 0; e < 8; ++e) { x[e] = __builtin_amdgcn_exp2f(x[e] - m_new); ps += x[e]; } \
            l_run = l_run * alpha + ps; m_run = m_new; \
            _Pragma("unroll") for (int nf = 0; nf < 8; ++nf) o[nf] = o[nf] * alpha; \
            const u32x4 pw = pack8(x); const bf16x8 pb = __builtin_bit_cast(bf16x8, pw); \
            _Pragma("unroll") for (int nf = 0; nf < 8; ++nf) { \
                const s16x4 a0 = vtr(Vt + (4 * g + qp) * 288 + (16 * nf + 4 * p) * 2), a1 = vtr(Vt + (16 + 4 * g + qp) * 288 + (16 * nf + 4 * p) * 2); \
                o[nf] = MFMA16(cat4(a0, a1), pb, o[nf]); } \
        } \
        if ((kt) + 1 < 8) AT_WRITE((kt) + 1); \
        WG_BAR(); } } while (0)
    AT_STEP(0); AT_STEP(1); AT_STEP(2); AT_STEP(3); AT_STEP(4); AT_STEP(5); AT_STEP(6); AT_STEP(7);
#undef AT_STEP
#undef AT_ISSUE
#undef AT_WRITE
    l_run += __shfl_xor(l_run, 16); l_run += __shfl_xor(l_run, 32);
    const float inv = 1.0f / l_run;
    const float lse2 = m_run + __log2f(l_run);
    const size_t trow = (size_t)(b * SEQ + tq);
    if (!FINAL) {
#pragma unroll
        for (int nf = 0; nf < 8; ++nf) { const f32x4 v = o[nf] * inv; u32x2 ww; ww.x = cvtpk(v[0], v[1]); ww.y = cvtpk(v[2], v[3]);
            if (!dry) *(u32x2*)(po0 + trow * 1024 + h * 128 + 16 * nf + 4 * g) = ww; }
        if (g == 0 && !dry) pl0[trow * 8 + h] = lse2;
    } else {
        const float l0 = pl0[trow * 8 + h], l1 = pl1[trow * 8 + h];
        const float M = fmaxf(lse2, fmaxf(l0, l1));
        const float w0 = __builtin_amdgcn_exp2f(l0 - M), w1 = __builtin_amdgcn_exp2f(l1 - M), wc = __builtin_amdgcn_exp2f(lse2 - M);
        const float wi_ = 1.0f / (w0 + w1 + wc); const float c0 = w0 * wi_, c1 = w1 * wi_, cc = wc * wi_ * inv;
        float ss = 0.f;
#pragma unroll
        for (int nf = 0; nf < 8; ++nf) { const int e = h * 128 + 16 * nf + 4 * g;
            const u32x2 a0 = *(const u32x2*)(po0 + trow * 1024 + e), a1 = *(const u32x2*)(po1 + trow * 1024 + e);
            f32x4 v = o[nf] * cc;
            v[0] += c0 * bf_lo(a0.x) + c1 * bf_lo(a1.x); v[1] += c0 * bf_hi(a0.x) + c1 * bf_hi(a1.x); v[2] += c0 * bf_lo(a0.y) + c1 * bf_lo(a1.y); v[3] += c0 * bf_hi(a0.y) + c1 * bf_hi(a1.y);
            o[nf] = v; ss += (v[0] * v[0] + v[1] * v[1]) + (v[2] * v[2] + v[3] * v[3]); }
        ss += __shfl_xor(ss, 16); ss += __shfl_xor(ss, 32);
        const float rn = 1.0f / sqrtf(ss * (1.0f / 128.0f) + NORM_EPS);
#pragma unroll
        for (int nf = 0; nf < 8; ++nf) { const int e = 16 * nf + 4 * g; const f32x4 w = *(const f32x4*)(anw + h * 128 + e); const f32x4 v = o[nf] * rn * w;
            u32x2 ww; ww.x = cvtpk(v[0], v[1]); ww.y = cvtpk(v[2], v[3]); if (!dry) *(u32x2*)(qrow + e) = ww; }
    }
}

#ifndef PROBE_PHASE
#define PROBE_PHASE -1
#endif
#define REP_BEGIN(k) for (int rep_ = (PROBE_PHASE == (k)) ? 0 : 1; rep_ < 2; ++rep_) { const bool dry = (rep_ == 0) && (a.dry != 0); (void)dry;
#define REP_END }

__global__ void __launch_bounds__(NWAVES * 64, 2) hymba_fwd(Args a) {
    extern __shared__ __attribute__((aligned(16))) unsigned char lds_raw[];
    LAS unsigned char* lds = (LAS unsigned char*)lds_raw;
    volatile LAS unsigned* MISC = (volatile LAS unsigned*)(lds + MISC_OFF);
    const int tid = threadIdx.x, lane = tid & 63, wave = __builtin_amdgcn_readfirstlane(tid >> 6);
    const int G = gridDim.x; const int bx = blockIdx.x; const int vcu = (G % 8 == 0) ? (bx % 8) * (G / 8) + bx / 8 : bx;
    unsigned char* ws = a.ws;
    unsigned* ctl = (unsigned*)(ws + WS_CTL);
    float* gli = (float*)(ws + WS_GLI); float* glf = (float*)(ws + WS_GLF); float* sumsq = (float*)(ws + WS_SUMSQ);
    float* msc_g = (float*)(ws + WS_MSC); float* msc_ml = msc_g + 512; float* msc_mp = msc_g + 1024;
    float* ncb = (float*)(ws + WS_NC);
    float* rcos = (float*)(ws + WS_COS); float* rsin = (float*)(ws + WS_SIN);
    bf16* WinT = (bf16*)(ws + WS_WIN); bf16* kvT = (bf16*)(ws + WS_KV); bf16* Ub = (bf16*)(ws + WS_U); bf16* H1b = (bf16*)(ws + WS_U);
    bf16* proj = (bf16*)(ws + WS_PROJ); bf16* FF = (bf16*)(ws + WS_PROJ);
    bf16* op0 = (bf16*)(ws + WS_OP0); bf16* op1 = (bf16*)(ws + WS_OP1); float* pl0 = (float*)(ws + WS_PL0); float* pl1 = (float*)(ws + WS_PL1);
    bf16* WoutT = (bf16*)(ws + WS_WOUT); bf16* WguT = (bf16*)(ws + WS_WGU); bf16* WdnT = (bf16*)(ws + WS_WDN);

    for (int u = tid; u < (LDS_BYTES - MISC_OFF) / 4; u += NWAVES * 64) ((LAS unsigned*)(lds + MISC_OFF))[u] = 0u;
    __syncthreads();
    XcdBarrier bar = xcd_barrier_post(ctl + CW_BAR, MISC + 8);
    const int gw = vcu * NWAVES + wave, NGW = G * NWAVES;
    const int gt = vcu * (NWAVES * 64) + tid, NGT = G * NWAVES * 64;

    REP_BEGIN(0)
        for (int i = gt; i < MTOK; i += NGT) sumsq[i] = 0.f;
        for (int i = gt; i < SEQ * 64; i += NGT) {
            const int pos = i >> 6, fi = i & 63;
            const float invf = (float)exp2(-(double)fi * (13.287712379549449 / 64.0));
            const float ang = (float)pos * invf;
            const double rev = (double)ang * 0.15915494309189535; const double fr_ = rev - rint(rev);
            const float ar = (float)(fr_ * 6.283185307179586);
            rcos[i] = cosf(ar); rsin[i] = sinf(ar);
        }
        {
            LAS float* scr = (LAS float*)(lds + wave * 16384);
            constexpr int I_IN = (DM / 64) * (NPROJ / 32), I_OUT = (DM / 64) * (DM / 32), I_GU = (DM / 64) * (NGU / 32), I_DN = (DFF / 64) * (DM / 32);
            constexpr int NITEMS = I_IN + I_OUT + I_GU + I_DN;
            auto decode = [&](int it) -> TItem {
                TItem t; int r = it;
                if (r < I_IN) { const int nblk = NPROJ / 32, kb = r / nblk, nb = r % nblk; t = TItem{a.w_in, WinT, nullptr, INW, DM, win_src_col(nb * 32), nb * 32, kb * 64}; return t; } r -= I_IN;
                if (r < I_OUT) { const int nblk = DM / 32, kb = r / nblk, nb = r % nblk; t = TItem{a.w_out, WoutT, nullptr, DM, DM, nb * 32, nb * 32, kb * 64}; return t; } r -= I_OUT;
                if (r < I_GU) { const int nblk = NGU / 32, kb = r / nblk, nb = r % nblk; const int nd = nb * 32, pn = nd >> 8, j = nd & 255;
                    t = TItem{(j < 128) ? a.w_gate : a.w_up, WguT, a.norm2_w, DFF, DM, pn * 128 + (j & 127), nd, kb * 64}; return t; } r -= I_GU;
                { const int nblk = DM / 32, kb = r / nblk, nb = r % nblk; t = TItem{a.w_down, WdnT, nullptr, DM, DFF, nb * 32, nb * 32, kb * 64}; return t; }
            };
            int it = gw;
            if (it < NITEMS) {
                TItem cur = decode(it); f32x4 vc[8]; titem_load(cur, vc, lane);
                for (;;) {
                    const int nx = it + NGW; const bool more = nx < NITEMS;
                    TItem nt = cur; f32x4 vn[8];
                    if (more) { nt = decode(nx); titem_load(nt, vn, lane); }
                    titem_finish(cur, vc, scr, lane);
                    if (!more) break;
                    cur = nt; it = nx;
#pragma unroll
                    for (int i = 0; i < 8; ++i) vc[i] = vn[i];
                }
            }
        }
        __syncthreads();
        LAS float* wg = (LAS float*)lds;
        for (int k = tid; k < DM; k += NWAVES * 64) { const f32x4 g0 = *(const f32x4*)(a.w_in + (size_t)k * INW + 3072), g1 = *(const f32x4*)(a.w_in + (size_t)k * INW + 3076);
            wg[0 * DM + k] = g0[0]; wg[1 * DM + k] = g0[1]; wg[2 * DM + k] = g0[2]; wg[3 * DM + k] = g0[3];
            wg[4 * DM + k] = g1[0]; wg[5 * DM + k] = g1[1]; wg[6 * DM + k] = g1[2]; wg[7 * DM + k] = g1[3]; }
        __syncthreads();
        for (int m = gw; m < MTOK; m += NGW) {
            const f32x4* xr = (const f32x4*)(a.x + (size_t)m * DM) + lane; const f32x4* wr_ = (const f32x4*)a.norm1_w + lane;
            f32x4 v[8]; float s = 0.f;
#pragma unroll
            for (int j = 0; j < 8; ++j) { v[j] = xr[64 * j]; s += (v[j][0] * v[j][0] + v[j][1] * v[j][1]) + (v[j][2] * v[j][2] + v[j][3] * v[j][3]); }
            const float rstd = 1.0f / sqrtf(wave_sum(s) * (1.0f / DM) + NORM_EPS);
            u32x2* o8 = (u32x2*)(Ub + (size_t)m * DM) + lane;
#pragma unroll
            for (int j = 0; j < 8; ++j) { v[j] = v[j] * rstd * wr_[64 * j]; u32x2 w; w.x = cvtpk(v[j][0], v[j][1]); w.y = cvtpk(v[j][2], v[j][3]); o8[64 * j] = w; }
            float z = 0.f;
#pragma unroll 1
            for (int gi = 0; gi < 8; ++gi) { float t = 0.f;
#pragma unroll
                for (int j = 0; j < 8; ++j) { const f32x4 w4 = *(const LAS f32x4*)(wg + gi * DM + 256 * j + 4 * lane); t += (v[j][0] * w4[0] + v[j][1] * w4[1]) + (v[j][2] * w4[2] + v[j][3] * w4[3]); }
                t = wave_sum(t); z = (lane == gi) ? t : z; }
            if (lane < 8) {
                const int hh = lane & 3;
                if (lane < 4) { gli[m * 4 + hh] = 15.0f * tanhf((z + a.igate_b[hh]) * (1.0f / 15.0f)); }
                else { const float fp = 15.0f * tanhf((z + a.fgate_b[hh]) * (1.0f / 15.0f)); glf[m * 4 + hh] = -log1pf(expf(-fp)); }
            }
        }
    REP_END
    xcd_barrier(bar);

    REP_BEGIN(1)
        pg8::Gemm g{Ub, WinT, MTOK, NPROJ, DM, DM}; pg8::StaticOrder S; S.init(MTOK, NPROJ, G, bx);
        pg8::EpiBf16 E{proj, NPROJ};
        pg8::gemm_phase<pg8::EpiBf16, true>(lds, g, S, E);
    REP_END
    xcd_barrier(bar);

    REP_BEGIN(2)
        for (int idx = gt >> 4; idx < MTOK * 8; idx += NGT >> 4) {
            const int m = idx >> 3, hh = idx & 7, c0 = 4 * (tid & 15), pos = m & (SEQ - 1);
            bf16* kp = proj + (size_t)m * NPROJ + PC_AK + hh * 128;
            const u32x2 r1 = *(const u32x2*)(kp + c0), r2 = *(const u32x2*)(kp + 64 + c0);
            float x1[4] = {bf_lo(r1.x), bf_hi(r1.x), bf_lo(r1.y), bf_hi(r1.y)}, x2[4] = {bf_lo(r2.x), bf_hi(r2.x), bf_lo(r2.y), bf_hi(r2.y)};
            float ss = 0.f;
#pragma unroll
            for (int e = 0; e < 4; ++e) ss += x1[e] * x1[e] + x2[e] * x2[e];
            ss += __shfl_xor(ss, 1); ss += __shfl_xor(ss, 2); ss += __shfl_xor(ss, 4); ss += __shfl_xor(ss, 8);
            const float rk = 1.0f / sqrtf(ss * (1.0f / 128.0f) + NORM_EPS);
            const f32x4 cs = *(const f32x4*)(rcos + pos * 64 + c0), sn = *(const f32x4*)(rsin + pos * 64 + c0);
            const f32x4 w1 = *(const f32x4*)(a.k_norm_w + c0), w2 = *(const f32x4*)(a.k_norm_w + 64 + c0);
            float o1[4], o2[4];
#pragma unroll
            for (int e = 0; e < 4; ++e) { const float y1 = x1[e] * rk * w1[e], y2 = x2[e] * rk * w2[e]; o1[e] = y1 * cs[e] - y2 * sn[e]; o2[e] = y2 * cs[e] + y1 * sn[e]; }
            u32x2 wv; wv.x = cvtpk(o1[0], o1[1]); wv.y = cvtpk(o1[2], o1[3]); if (!dry) *(u32x2*)(kp + c0) = wv;
            wv.x = cvtpk(o2[0], o2[1]); wv.y = cvtpk(o2[2], o2[3]); if (!dry) *(u32x2*)(kp + 64 + c0) = wv;
        }
        LAS unsigned char* KW = lds; LAS unsigned char* VT = lds + 18432;
        const int g = lane >> 4, qp = (lane & 15) >> 2, p = lane & 3;
        for (int u = vcu; u < 512; u += G) {
            const int b = u >> 8, h = (u >> 6) & 3, c = u & 63;
            const int tok = b * SEQ + c * 64 + lane;
            const float li = gli[tok * 4 + h], lf = glf[tok * 4 + h];
            const float cf = scan_add64(lf, lane);
            const float gsum = __shfl(cf, 63);
            const float av = gsum - cf + li;
            const float ml = wave_max(av);
            const float wst = __expf(av - ml);
            if (tid == 0) { msc_g[u] = gsum; msc_ml[u] = ml; }
            conv_tile<true>(proj, a.conv_w, a.conv_b, b, c, PC_MK + h * 128, 512 + h * 128, 1.0f, wst, KW, tid);
            v_tile(proj, b, c, h, VT, tid);
            __syncthreads();
            f32x4 acc[8][2];
#pragma unroll
            for (int df = 0; df < 8; ++df) { acc[df][0] = (f32x4){0.f, 0.f, 0.f, 0.f}; acc[df][1] = (f32x4){0.f, 0.f, 0.f, 0.f}; }
#pragma unroll
            for (int kk = 0; kk < 2; ++kk) {
                bf16x8 bfr[2];
#pragma unroll
                for (int ef = 0; ef < 2; ++ef) { const int col = 32 * wave + 16 * ef + 4 * p;
                    bfr[ef] = cat4(vtr(VT + (32 * kk + 4 * g + qp) * 544 + col * 2), vtr(VT + (32 * kk + 16 + 4 * g + qp) * 544 + col * 2)); }
#pragma unroll
                for (int df = 0; df < 8; ++df) { const int col = 16 * df + 4 * p;
                    const bf16x8 af = cat4(vtr(KW + (32 * kk + 4 * g + qp) * 288 + col * 2), vtr(KW + (32 * kk + 16 + 4 * g + qp) * 288 + col * 2));
                    acc[df][0] = MFMA16(af, bfr[0], acc[df][0]); acc[df][1] = MFMA16(af, bfr[1], acc[df][1]); }
            }
#pragma unroll
            for (int ef = 0; ef < 2; ++ef) { const int e = 32 * wave + 16 * ef + (lane & 15);
#pragma unroll
                for (int df = 0; df < 8; ++df) { const f32x4 v = acc[df][ef]; u32x2 w; w.x = cvtpk(v[0], v[1]); w.y = cvtpk(v[2], v[3]);
                    *(u32x2*)(kvT + ((size_t)u * 256 + e) * 128 + 16 * df + 4 * g) = w; } }
            if (tid < 128) { float nsum = 0.f;
#pragma unroll 8
                for (int l = 0; l < 64; ++l) nsum += __uint_as_float((unsigned)(*(const LAS unsigned short*)(KW + l * 288 + tid * 2)) << 16);
                ncb[u * 128 + tid] = nsum; }
            __syncthreads();
        }
    REP_END
    xcd_barrier(bar);

    REP_BEGIN(3)
        for (int id = gt; id < 8 * 16384; id += NGT) {
            const int bh = id >> 14, pi = id & 16383;
            unsigned* base = (unsigned*)kvT + (size_t)bh * 64 * 16384 + pi;
            float c0 = 0.f, c1 = 0.f, m = 0.f;
#pragma unroll 1
            for (int cb = 0; cb < 64; cb += 8) {
                unsigned xv[8];
#pragma unroll
                for (int i = 0; i < 8; ++i) xv[i] = base[(size_t)(cb + i) * 16384];
#pragma unroll
                for (int i = 0; i < 8; ++i) {
                    const float gg = msc_g[bh * 64 + cb + i], ml = msc_ml[bh * 64 + cb + i];
                    const float mn = fmaxf(gg + m, ml), so = __expf(gg + m - mn), sn = __expf(ml - mn);
                    if (!dry) base[(size_t)(cb + i) * 16384] = cvtpk(c0, c1);
                    c0 = so * c0 + sn * bf_lo(xv[i]); c1 = so * c1 + sn * bf_hi(xv[i]); m = mn;
                }
            }
        }
        for (int id = gt; id < 8 * 128; id += NGT) {
            const int bh = id >> 7, dd = id & 127; float n = 0.f, m = 0.f;
#pragma unroll 1
            for (int c = 0; c < 64; ++c) {
                const float gg = msc_g[bh * 64 + c], ml = msc_ml[bh * 64 + c];
                const float mn = fmaxf(gg + m, ml), so = __expf(gg + m - mn), sn = __expf(ml - mn);
                const float x = ncb[(bh * 64 + c) * 128 + dd]; if (!dry) ncb[(bh * 64 + c) * 128 + dd] = n;
                if (dd == 0) msc_mp[bh * 64 + c] = m;
                n = so * n + sn * x; m = mn;
            }
        }
    REP_END
    REP_BEGIN(4)
        for (int u = vcu; u < 1024; u += G) {
            int d, b, h, r, n;
            if (u < 512) { d = 4; b = u >> 8; h = (u >> 5) & 7; r = (u >> 3) & 3; n = u & 7; }
            else { const int v = u - 512; d = 16; b = v >> 8; h = (v >> 5) & 7; r = (v >> 1) & 15; n = (v ^ b) & 1; }
            attn_unit<false>(proj, rcos, rsin, a.q_norm_w, a.attn_norm_w, b, h, d, r, n, lds, (d == 4) ? op0 : op1, (d == 4) ? pl0 : pl1, nullptr, nullptr, tid, lane, wave, dry);
        }
    REP_END
    xcd_barrier(bar);

    REP_BEGIN(5)
        LAS unsigned char* QT = lds; LAS unsigned char* KT = lds + 18432; LAS unsigned char* VT = lds + 36864;
        LAS float* NP = (LAS float*)(lds + 71680); LAS float* XCH = (LAS float*)(lds + 72192);
        const int j = lane & 15, g = lane >> 4, qp = j >> 2, p = lane & 3;
        const int tf = wave & 3, eh = wave >> 2;
        for (int u = vcu; u < 512; u += G) {
            const int b = u >> 8, h = (u >> 6) & 3, c = u & 63;
            const int tok = b * SEQ + c * 64 + lane;
            const float li = gli[tok * 4 + h], lf = glf[tok * 4 + h];
            const float cf = scan_add64(lf, lane);
            const float bvec = li - cf;
            const float pm = scan_max64(bvec, lane);
            const float mprev = msc_mp[u];
            const float Mv = fmaxf(mprev, pm);
            const float wiv = __expf(mprev - Mv), emtv = __expf(-cf - Mv);
            conv_tile<false>(proj, a.conv_w, a.conv_b, b, c, PC_MQ + h * 128, h * 128, 0.08838834764831845f, 0.f, QT, tid);
            conv_tile<false>(proj, a.conv_w, a.conv_b, b, c, PC_MK + h * 128, 512 + h * 128, 1.0f, 0.f, KT, tid);
            v_tile(proj, b, c, h, VT, tid);
            if (tid < 128) NP[tid] = ncb[u * 128 + tid];
            __syncthreads();
            const int t = 16 * tf + j;
            const float M_t = __shfl(Mv, t), wi_t = __shfl(wiv, t), emt_t = __shfl(emtv, t);
            bf16x8 qf[4];
#pragma unroll
            for (int ks = 0; ks < 4; ++ks) qf[ks] = *(const LAS bf16x8*)(QT + t * 288 + (32 * ks + 8 * g) * 2);
            float sp[4][4]; float rowsum = 0.f;
#pragma unroll
            for (int sf = 0; sf < 4; ++sf) {
                f32x4 sa = {0.f, 0.f, 0.f, 0.f};
                if (sf <= tf) {
#pragma unroll
                    for (int ks = 0; ks < 4; ++ks) { const bf16x8 kfr = *(const LAS bf16x8*)(KT + (16 * sf + j) * 288 + (32 * ks + 8 * g) * 2); sa = MFMA16(kfr, qf[ks], sa); }
                }
#pragma unroll
                for (int rg = 0; rg < 4; ++rg) { const int sidx = 16 * sf + 4 * g + rg; const float bs = __shfl(bvec, sidx);
                    const float pv = (sidx <= t) ? __expf(bs - M_t) : 0.f; sp[sf][rg] = sa[rg] * pv; rowsum += sp[sf][rg]; }
            }
            bf16x8 pb[2];
#pragma unroll
            for (int kk = 0; kk < 2; ++kk) { float tmp[8] = {sp[2 * kk][0], sp[2 * kk][1], sp[2 * kk][2], sp[2 * kk][3], sp[2 * kk + 1][0], sp[2 * kk + 1][1], sp[2 * kk + 1][2], sp[2 * kk + 1][3]};
                const u32x4 w = pack8(tmp); pb[kk] = __builtin_bit_cast(bf16x8, w); }
            f32x4 ai[8], ae[8];
#pragma unroll
            for (int ef = 0; ef < 8; ++ef) { ai[ef] = (f32x4){0.f, 0.f, 0.f, 0.f}; ae[ef] = (f32x4){0.f, 0.f, 0.f, 0.f}; }
#pragma unroll
            for (int kk = 0; kk < 2; ++kk) {
                if (kk == 0 || tf >= 2) {
#pragma unroll
                    for (int ef = 0; ef < 8; ++ef) { const int col = 128 * eh + 16 * ef + 4 * p;
                        const bf16x8 af = cat4(vtr(VT + (32 * kk + 4 * g + qp) * 544 + col * 2), vtr(VT + (32 * kk + 16 + 4 * g + qp) * 544 + col * 2));
                        ai[ef] = MFMA16(af, pb[kk], ai[ef]); }
                }
            }
            const bf16* cp = kvT + ((size_t)u * 256 + 128 * eh + j) * 128 + 8 * g;
#pragma unroll
            for (int ef = 0; ef < 8; ++ef) {
#pragma unroll
                for (int ks = 0; ks < 4; ++ks) { const bf16x8 cfr = *(const bf16x8*)(cp + (size_t)(16 * ef) * 128 + 32 * ks); ae[ef] = MFMA16(cfr, qf[ks], ae[ef]); }
            }
            float qn = 0.f;
#pragma unroll
            for (int ks = 0; ks < 4; ++ks) { float qv[8]; unpack8(__builtin_bit_cast(u32x4, qf[ks]), qv);
#pragma unroll
                for (int e = 0; e < 8; ++e) qn += qv[e] * NP[32 * ks + 8 * g + e]; }
            qn += __shfl_xor(qn, 16); qn += __shfl_xor(qn, 32);
            rowsum += __shfl_xor(rowsum, 16); rowsum += __shfl_xor(rowsum, 32);
            const float den = wi_t * qn + rowsum;
            const float dinv = 1.0f / fmaxf(fabsf(den), emt_t);
            float ssq = 0.f;
#pragma unroll
            for (int ef = 0; ef < 8; ++ef) { ai[ef] = (ae[ef] * wi_t + ai[ef]) * dinv; ssq += (ai[ef][0] * ai[ef][0] + ai[ef][1] * ai[ef][1]) + (ai[ef][2] * ai[ef][2] + ai[ef][3] * ai[ef][3]); }
            ssq += __shfl_xor(ssq, 16); ssq += __shfl_xor(ssq, 32);
            if (g == 0) XCH[eh * 64 + t] = ssq;
            __syncthreads();
            const float rn = 1.0f / sqrtf((XCH[t] + XCH[64 + t]) * (1.0f / 256.0f) + NORM_EPS);
            bf16* orow = proj + (size_t)(b * SEQ + c * 64 + t) * NPROJ;
#pragma unroll
            for (int ef = 0; ef < 8; ++ef) { const int e = 128 * eh + 16 * ef + 4 * g;
                const f32x4 nw = *(const f32x4*)(a.mlstm_norm_w + h * 256 + e);
                const u32x2 mo = *(const u32x2*)(orow + PC_MO + h * 256 + e);
                const float mof[4] = {bf_lo(mo.x), bf_hi(mo.x), bf_lo(mo.y), bf_hi(mo.y)};
                float r4[4];
#pragma unroll
                for (int e2 = 0; e2 < 4; ++e2) r4[e2] = ai[ef][e2] * rn * nw[e2] / (1.0f + __expf(-mof[e2]));
                u32x2 w; w.x = cvtpk(r4[0], r4[1]); w.y = cvtpk(r4[2], r4[3]); if (!dry) *(u32x2*)(orow + PC_MV + h * 256 + e) = w; }
            __syncthreads();
        }
        for (int u = vcu; u < 512; u += G) {
            const int b = u >> 8, h = (u >> 5) & 7, n = u & 31;
            attn_unit<true>(proj, rcos, rsin, a.q_norm_w, a.attn_norm_w, b, h, 1, 0, n, lds, op0, pl0, op1, pl1, tid, lane, wave, dry);
        }
    REP_END
    xcd_barrier(bar);

    REP_BEGIN(6)
        pg8::Gemm g{proj + PC_MV, WoutT, MTOK, DM, DM, NPROJ}; pg8::StaticOrder S; S.init(MTOK, DM, G, bx);
        pg8::EpiRes1 E{a.x, a.out, H1b, sumsq, DM, dry};
        pg8::gemm_phase<pg8::EpiRes1, false>(lds, g, S, E);
    REP_END
    xcd_barrier(bar);

    REP_BEGIN(7)
        pg8::Gemm g{H1b, WguT, MTOK, NGU, DM, DM}; pg8::StaticOrder S; S.init(MTOK, NGU, G, bx);
        pg8::EpiSwiGLU E{FF, DFF, sumsq};
        pg8::gemm_phase<pg8::EpiSwiGLU, true>(lds, g, S, E);
    REP_END
    xcd_barrier(bar);

    REP_BEGIN(8)
        pg8::Gemm g{FF, WdnT, MTOK, DM, DFF, DFF}; pg8::StaticOrder S; S.init(MTOK, DM, G, bx);
        pg8::EpiRes2 E{a.out, DM, dry};
        pg8::gemm_phase<pg8::EpiRes2, false>(lds, g, S, E);
    REP_END
}

extern "C" void kernel_launch(void* const* d_in, const int* in_sizes, int n_in, void* d_out, int out_size, void* d_ws, size_t ws_size, hipStream_t stream) {
    static int grid = 0;
    if (grid == 0) {
        if (n_in != 16 || in_sizes[0] != MTOK * DM || out_size != MTOK * DM || ws_size < WS_END) { fprintf(stderr, "kernel_launch: unexpected shapes (n_in %d in0 %d out %d ws %zu)\n", n_in, n_in > 0 ? in_sizes[0] : -1, out_size, ws_size); grid = -1; return; }
        int dev = 0, cus = 0;
        if (hipGetDevice(&dev) != hipSuccess || hipDeviceGetAttribute(&cus, hipDeviceAttributeMultiprocessorCount, dev) != hipSuccess || cus <= 0) cus = 256;
        if (hipFuncSetAttribute((const void*)hymba_fwd, hipFuncAttributeMaxDynamicSharedMemorySize, LDS_BYTES) != hipSuccess) { fprintf(stderr, "kernel_launch: hipFuncSetAttribute failed\n"); grid = -1; return; }
        (void)hipGetLastError();
        grid = cus;
    }
    if (grid < 0) return;
    if (hipMemsetAsync((char*)d_ws + WS_CTL, 0, CTL_ZERO_BYTES, stream) != hipSuccess) { fprintf(stderr, "kernel_launch: memset failed\n"); return; }
    Args a{};
    a.x = (const float*)d_in[0]; a.norm1_w = (const float*)d_in[1]; a.w_in = (const float*)d_in[2]; a.conv_w = (const float*)d_in[3]; a.conv_b = (const float*)d_in[4];
    a.igate_b = (const float*)d_in[5]; a.fgate_b = (const float*)d_in[6]; a.q_norm_w = (const float*)d_in[7]; a.k_norm_w = (const float*)d_in[8];
    a.mlstm_norm_w = (const float*)d_in[9]; a.attn_norm_w = (const float*)d_in[10]; a.w_out = (const float*)d_in[11]; a.norm2_w = (const float*)d_in[12];
    a.w_gate = (const float*)d_in[13]; a.w_up = (const float*)d_in[14]; a.w_down = (const float*)d_in[15];
    a.out = (float*)d_out; a.ws = (unsigned char*)d_ws; a.dry = (PROBE_PHASE >= 0) ? 1 : 0;
    hipLaunchKernelGGL(hymba_fwd, dim3(grid), dim3(NWAVES * 64), LDS_BYTES, stream, a);
}
```

```cpp
#include <hip/hip_runtime.h>
#include <cstdio>
#include <cstdint>

#define LAS __attribute__((address_space(3)))
#define GAS __attribute__((address_space(1)))
typedef unsigned short bf16;
typedef short bf16x8 __attribute__((ext_vector_type(8)));
typedef short s16x4 __attribute__((ext_vector_type(4)));
typedef float f32x4 __attribute__((ext_vector_type(4)));
typedef float f32x2 __attribute__((ext_vector_type(2)));
typedef unsigned u32x4 __attribute__((ext_vector_type(4)));
typedef unsigned u32x2 __attribute__((ext_vector_type(2)));
typedef __bf16 bf16x2_t __attribute__((ext_vector_type(2)));

constexpr int BATCH = 2, SEQ = 4096, DM = 2048, MTOK = BATCH * SEQ;
constexpr int INW = 6152, NPROJ = 6144, DFF = 5632, NGU = 2 * DFF;
constexpr int PC_MQ = 0, PC_MK = 512, PC_MO = 1024, PC_MV = 2048, PC_AQ = 3072, PC_AK = 4096, PC_AV = 5120;
constexpr float NORM_EPS = 1e-6f;
constexpr int NWAVES = 8;

constexpr size_t MiB = 1u << 20;
constexpr size_t WS_CTL = 0, CTL_ZERO_BYTES = 1 * MiB;
constexpr size_t WS_GLI = 1 * MiB;
constexpr size_t WS_GLF = WS_GLI + 128 * 1024;
constexpr size_t WS_SUMSQ = WS_GLF + 128 * 1024;
constexpr size_t WS_MSC = WS_SUMSQ + 32 * 1024;
constexpr size_t WS_NC = WS_MSC + 8 * 1024;
constexpr size_t WS_COS = 2 * MiB, WS_SIN = 3 * MiB;
constexpr size_t WS_WIN = 6 * MiB;
constexpr size_t WS_KV = 6 * MiB;
constexpr size_t WS_U = 30 * MiB;
constexpr size_t WS_PROJ = 62 * MiB;
constexpr size_t WS_WOUT = 158 * MiB;
constexpr size_t WS_WGU = 166 * MiB;
constexpr size_t WS_WDN = 210 * MiB;
constexpr size_t WS_OP0 = 38 * MiB;
constexpr size_t WS_OP1 = 232 * MiB;
constexpr size_t WS_PL0 = 248 * MiB, WS_PL1 = WS_PL0 + 256 * 1024;
constexpr size_t WS_END = 249 * MiB;
constexpr int CW_BAR = 4096;

constexpr int RING_BYTES = 131072;
constexpr int MISC_OFF = RING_BYTES;
constexpr int LDS_BYTES = 147456;

__device__ __forceinline__ unsigned cvtpk(float lo, float hi) { f32x2 v = {lo, hi}; bf16x2_t b = __builtin_convertvector(v, bf16x2_t); return __builtin_bit_cast(unsigned, b); }
__device__ __forceinline__ float bf_lo(unsigned w) { return __uint_as_float(w << 16); }
__device__ __forceinline__ float bf_hi(unsigned w) { return __uint_as_float(w & 0xffff0000u); }
__device__ __forceinline__ void unpack8(u32x4 w, float* f) { f[0] = bf_lo(w.x); f[1] = bf_hi(w.x); f[2] = bf_lo(w.y); f[3] = bf_hi(w.y); f[4] = bf_lo(w.z); f[5] = bf_hi(w.z); f[6] = bf_lo(w.w); f[7] = bf_hi(w.w); }
__device__ __forceinline__ u32x4 pack8(const float* f) { u32x4 w; w.x = cvtpk(f[0], f[1]); w.y = cvtpk(f[2], f[3]); w.z = cvtpk(f[4], f[5]); w.w = cvtpk(f[6], f[7]); return w; }
__device__ __forceinline__ float wave_sum(float v) {
#pragma unroll
    for (int o = 1; o < 64; o <<= 1) v += __shfl_xor(v, o);
    return v;
}
__device__ __forceinline__ float wave_max(float v) {
#pragma unroll
    for (int o = 1; o < 64; o <<= 1) v = fmaxf(v, __shfl_xor(v, o));
    return v;
}
__device__ __forceinline__ s16x4 vtr(const LAS unsigned char* p) { return __builtin_bit_cast(s16x4, __builtin_amdgcn_ds_read_tr16_b64_v4i16((LAS s16x4*)p)); }
__device__ __forceinline__ bf16x8 cat4(s16x4 a, s16x4 b) { return (bf16x8){a[0], a[1], a[2], a[3], b[0], b[1], b[2], b[3]}; }
#define LDS_WAIT() asm volatile("s_waitcnt lgkmcnt(0)" ::: "memory")
#define VM_WAIT() asm volatile("s_waitcnt vmcnt(0)" ::: "memory")
#define SBAR() __builtin_amdgcn_sched_barrier(0)
#define MFMA16(a, b, c) __builtin_amdgcn_mfma_f32_16x16x32_bf16((a), (b), (c), 0, 0, 0)

namespace pg8 {
constexpr int BM = 256, BK = 64, HALF = 128, HTB = HALF * BK * 2, STAGE_BYTES = 8 * HTB, NXCD = 8, WGM = 8;
__host__ __device__ __forceinline__ int lds_byte(int r, int c) { const int st = (r >> 4) * 2 + (c >> 5), rr = r & 15, cc = c & 31, ob = rr * 64 + cc * 2; return st * 1024 + (ob ^ (((ob >> 9) & 1) << 5)); }
__host__ __device__ __forceinline__ void stage_rc(int b, int& R, int& C) { const int st = b / 1024, sb = b % 1024, swz = sb ^ (((sb >> 9) & 1) << 5); R = (st >> 1) * 16 + swz / 64; C = (st & 1) * 32 + (swz % 64) / 2; }
__host__ __device__ __forceinline__ int perm32(int rho) { const int n = rho >> 4, i = rho & 15; return 8 * (i >> 2) + 4 * n + (i & 3); }
struct Unit { int pm, pn; };
struct Gemm { const bf16* A; const bf16* Bt; int M, N, K, lda; };
struct StaticOrder {
    int nM, nN, nwg, G, c;
    __device__ void init(int M, int N, int G_, int c_) { nM = M / BM; nN = N / BM; nwg = nM * nN; G = G_; c = c_; }
    __device__ bool next(int i, Unit& u) const {
        const long L = (long)i * G + c; if (L >= nwg) return false;
        int wgid = (int)L; { const int q = nwg / NXCD, r = nwg % NXCD, xcd = wgid % NXCD, off = wgid / NXCD; wgid = (xcd < r ? xcd * (q + 1) : r * (q + 1) + (xcd - r) * q) + off; }
        const int nig = WGM * nN, gid = wgid / nig, fm = gid * WGM, gsz = (nM - fm) < WGM ? (nM - fm) : WGM;
        u.pm = fm + ((wgid % nig) % gsz); u.pn = (wgid % nig) / gsz; return true;
    }
};
struct EpiBf16 {
    static constexpr bool PERM = true, HAS_INIT = false;
    bf16* O; int ldc;
    __device__ __forceinline__ void operator()(const f32x4 (&acc)[2][2][4][2], const Unit& u, int wr, int wc, int fr, int fq) const {
        const int row0 = u.pm * BM + wr * 64 + fr, col0 = u.pn * BM + wc * 32 + 8 * fq;
#pragma unroll
        for (int ai = 0; ai < 2; ++ai)
#pragma unroll
            for (int m = 0; m < 4; ++m) { bf16* rowp = O + (size_t)(row0 + ai * HALF + m * 16) * ldc + col0;
#pragma unroll
                for (int bj = 0; bj < 2; ++bj) { const f32x4 v0 = acc[ai][bj][m][0], v1 = acc[ai][bj][m][1];
                    u32x4 w; w.x = cvtpk(v0[0], v0[1]); w.y = cvtpk(v0[2], v0[3]); w.z = cvtpk(v1[0], v1[1]); w.w = cvtpk(v1[2], v1[3]);
                    *(u32x4*)(rowp + bj * HALF) = w; } }
    }
};
struct EpiRes1 {
    static constexpr bool PERM = false, HAS_INIT = true;
    const float* xres; float* out; bf16* h1b; float* sumsq; int ldc; bool dry;
    __device__ __forceinline__ void init(f32x4 (&acc)[2][2][4][2], const Unit& u, int wr, int wc, int fr, int fq) const {
        const int col0 = u.pn * BM + wc * 32 + 4 * fq;
#pragma unroll
        for (int ai = 0; ai < 2; ++ai)
#pragma unroll
            for (int m = 0; m < 4; ++m) { const size_t off = (size_t)(u.pm * BM + ai * HALF + wr * 64 + m * 16 + fr) * ldc + col0;
#pragma unroll
                for (int bj = 0; bj < 2; ++bj)
#pragma unroll
                    for (int n = 0; n < 2; ++n) acc[ai][bj][m][n] = *(const f32x4*)(xres + off + bj * HALF + n * 16); }
    }
    __device__ __forceinline__ void operator()(const f32x4 (&acc)[2][2][4][2], const Unit& u, int wr, int wc, int fr, int fq) const {
        const int col0 = u.pn * BM + wc * 32 + 4 * fq;
#pragma unroll
        for (int ai = 0; ai < 2; ++ai)
#pragma unroll
            for (int m = 0; m < 4; ++m) { const int row = u.pm * BM + ai * HALF + wr * 64 + m * 16 + fr; const size_t off = (size_t)row * ldc + col0; float ss = 0.f;
#pragma unroll
                for (int bj = 0; bj < 2; ++bj)
#pragma unroll
                    for (int n = 0; n < 2; ++n) { const size_t o2 = off + bj * HALF + n * 16; const f32x4 h = acc[ai][bj][m][n];
                        u32x2 w; w.x = cvtpk(h[0], h[1]); w.y = cvtpk(h[2], h[3]); if (!dry) { *(f32x4*)(out + o2) = h; *(u32x2*)(h1b + o2) = w; }
                        ss += (h[0] * h[0] + h[1] * h[1]) + (h[2] * h[2] + h[3] * h[3]); }
                ss += __shfl_xor(ss, 16); ss += __shfl_xor(ss, 32);
                if (fq == 0 && !dry) atomicAdd(sumsq + row, ss); }
    }
};
struct EpiSwiGLU {
    static constexpr bool PERM = true, HAS_INIT = false;
    bf16* O; int ldc; const float* sumsq;
    __device__ __forceinline__ void operator()(const f32x4 (&acc)[2][2][4][2], const Unit& u, int wr, int wc, int fr, int fq) const {
        const int col0 = u.pn * HALF + wc * 32 + 8 * fq;
#pragma unroll
        for (int ai = 0; ai < 2; ++ai)
#pragma unroll
            for (int m = 0; m < 4; ++m) { const int row = u.pm * BM + ai * HALF + wr * 64 + m * 16 + fr;
                const float rs = 1.0f / sqrtf(sumsq[row] * (1.0f / DM) + NORM_EPS);
                float f[8];
#pragma unroll
                for (int n = 0; n < 2; ++n)
#pragma unroll
                    for (int j = 0; j < 4; ++j) { const float g = acc[ai][0][m][n][j] * rs, up = acc[ai][1][m][n][j] * rs; f[n * 4 + j] = g / (1.0f + __expf(-g)) * up; }
                *(u32x4*)(O + (size_t)row * ldc + col0) = pack8(f); }
    }
};
struct EpiRes2 {
    static constexpr bool PERM = false, HAS_INIT = true;
    float* out; int ldc; bool dry;
    __device__ __forceinline__ void init(f32x4 (&acc)[2][2][4][2], const Unit& u, int wr, int wc, int fr, int fq) const {
        const int col0 = u.pn * BM + wc * 32 + 4 * fq;
#pragma unroll
        for (int ai = 0; ai < 2; ++ai)
#pragma unroll
            for (int m = 0; m < 4; ++m) { const size_t off = (size_t)(u.pm * BM + ai * HALF + wr * 64 + m * 16 + fr) * ldc + col0;
#pragma unroll
                for (int bj = 0; bj < 2; ++bj)
#pragma unroll
                    for (int n = 0; n < 2; ++n) acc[ai][bj][m][n] = *(const f32x4*)(out + off + bj * HALF + n * 16); }
    }
    __device__ __forceinline__ void operator()(const f32x4 (&acc)[2][2][4][2], const Unit& u, int wr, int wc, int fr, int fq) const {
        const int col0 = u.pn * BM + wc * 32 + 4 * fq;
#pragma unroll
        for (int ai = 0; ai < 2; ++ai)
#pragma unroll
            for (int m = 0; m < 4; ++m) { const size_t off = (size_t)(u.pm * BM + ai * HALF + wr * 64 + m * 16 + fr) * ldc + col0;
#pragma unroll
                for (int bj = 0; bj < 2; ++bj)
#pragma unroll
                    for (int n = 0; n < 2; ++n) { if (!dry) *(f32x4*)(out + off + bj * HALF + n * 16) = acc[ai][bj][m][n]; } }
    }
};

template <class Epi, bool ALIGN_EPI>
__device__ __forceinline__ void gemm_phase(LAS unsigned char* lds, const Gemm g, const StaticOrder& S, const Epi& E) {
    int tid = threadIdx.x; asm volatile("" : "+v"(tid));
    const int wid = __builtin_amdgcn_readfirstlane(tid >> 6), lane = tid & 63, wr = wid >> 2, wc = wid & 3, fr = lane & 15, fq = lane >> 4;
    const int K = g.K, nt = K / BK;
    unsigned voffA[2], voffB[2];
#pragma unroll
    for (int i = 0; i < 2; ++i) { int R, C; stage_rc(tid * 16 + i * 8192, R, C); const int Rb = Epi::PERM ? ((R & ~31) + perm32(R & 31)) : R;
        voffA[i] = (unsigned)(R * g.lda + C) * 2u; voffB[i] = (unsigned)(Rb * K + C) * 2u; }
    const size_t kstep = (size_t)(BK * 2);
    const size_t hstepA = (size_t)HALF * g.lda * 2, hstepB = (size_t)HALF * K * 2;
    const size_t tstepA = 2 * hstepA, tstepB = 2 * hstepB;
    const unsigned ldsw = (unsigned)wid * 1024u;
    const int aoff = lds_byte(wr * 64 + fr, fq * 8), boff = lds_byte(wc * 32 + fr, fq * 8);
#define PG8_SA(b, h) (((b) * 2 + (h)) * HTB)
#define PG8_SB(b, h) ((4 + (b) * 2 + (h)) * HTB)
#define PG8_STAGE(bufoff, gbase, voff) do { _Pragma("unroll") for (int _i = 0; _i < 2; ++_i) \
        __builtin_amdgcn_global_load_lds((const unsigned*)((const char*)(gbase) + (voff)[_i]), (LAS unsigned*)(lds + (bufoff) + ldsw + _i * 8192), 16, 0, 0); } while (0)
#define PG8_LDA(dst, b, h) do { _Pragma("unroll") for (int m = 0; m < 4; ++m) _Pragma("unroll") for (int k = 0; k < 2; ++k) dst[m][k] = *(const LAS bf16x8*)(lds + PG8_SA(b, h) + aoff + m * 2048 + k * 1024); } while (0)
#define PG8_LDB(dst, b, h) do { _Pragma("unroll") for (int n = 0; n < 2; ++n) _Pragma("unroll") for (int k = 0; k < 2; ++k) dst[n][k] = *(const LAS bf16x8*)(lds + PG8_SB(b, h) + boff + n * 2048 + k * 1024); } while (0)
#define PG8_MMA(ai, bj, At, Bt) do { __builtin_amdgcn_s_setprio(1); _Pragma("unroll") for (int m = 0; m < 4; ++m) _Pragma("unroll") for (int n = 0; n < 2; ++n) _Pragma("unroll") for (int k = 0; k < 2; ++k) \
        acc[ai][bj][m][n] = __builtin_amdgcn_mfma_f32_16x16x32_bf16(Bt[n][k], At[m][k], acc[ai][bj][m][n], 0, 0, 0); __builtin_amdgcn_s_setprio(0); } while (0)
#define PG8_WAIT_V(n) asm volatile("s_waitcnt vmcnt(" #n ")" ::: "memory")
#define PG8_WAIT_L(n) asm volatile("s_waitcnt lgkmcnt(" #n ")" ::: "memory")
#define PG8_BAR __builtin_amdgcn_s_barrier()
#define PG8_SCHED __builtin_amdgcn_sched_barrier(0)
    Unit cur, nxt; int ui = 0;
    if (!S.next(0, cur)) return;
    f32x4 acc[2][2][4][2];
    if constexpr (Epi::HAS_INIT) { E.init(acc, cur, wr, wc, fr, fq); }
    else {
#pragma unroll
    for (int a = 0; a < 2; ++a)
#pragma unroll
        for (int b = 0; b < 2; ++b)
#pragma unroll
            for (int m = 0; m < 4; ++m)
#pragma unroll
                for (int n = 0; n < 2; ++n) acc[a][b][m][n] = (f32x4){0.f, 0.f, 0.f, 0.f};
    }
    bf16x8 At[4][2], B0[2][2], B1[2][2];
    const char* cA = (const char*)g.A + (size_t)cur.pm * tstepA; const char* cB = (const char*)g.Bt + (size_t)cur.pn * tstepB;
    PG8_STAGE(PG8_SB(0, 0), cB, voffB); PG8_STAGE(PG8_SB(0, 1), cB + hstepB, voffB); PG8_STAGE(PG8_SA(0, 0), cA, voffA); PG8_STAGE(PG8_SA(0, 1), cA + hstepA, voffA);
    if (wr == 1) PG8_BAR;
    PG8_WAIT_V(2); PG8_BAR;
    PG8_STAGE(PG8_SB(1, 0), cB + kstep, voffB); PG8_STAGE(PG8_SA(1, 0), cA + kstep, voffA); PG8_STAGE(PG8_SB(1, 1), cB + hstepB + kstep, voffB);
    PG8_WAIT_V(6); PG8_BAR;
    for (;;) {
        const bool has_next = S.next(ui + 1, nxt);
        const char* nA = has_next ? (const char*)g.A + (size_t)nxt.pm * tstepA : cA; const char* nB = has_next ? (const char*)g.Bt + (size_t)nxt.pn * tstepB : cB;
        for (int t = 0; t < nt; t += 2) {
            const bool last = (t == nt - 2);
            const char* a1 = cA + (size_t)(t + 1) * kstep;
            const char* a2 = last ? nA : cA + (size_t)(t + 2) * kstep; const char* b2 = last ? nB : cB + (size_t)(t + 2) * kstep;
            const char* a3 = a2 + kstep; const char* b3 = b2 + kstep;
            PG8_LDB(B0, 0, 0); PG8_LDB(B1, 0, 1); PG8_SCHED; PG8_LDA(At, 0, 0); PG8_STAGE(PG8_SA(1, 1), a1 + hstepA, voffA);
            PG8_WAIT_V(8); PG8_WAIT_L(0); PG8_BAR; PG8_MMA(0, 0, At, B0); PG8_MMA(0, 1, At, B1); PG8_BAR; PG8_SCHED;
            PG8_LDA(At, 0, 1); PG8_STAGE(PG8_SB(0, 0), b2, voffB); PG8_STAGE(PG8_SB(0, 1), b2 + hstepB, voffB); PG8_STAGE(PG8_SA(0, 0), a2, voffA);
            PG8_WAIT_V(8); PG8_WAIT_L(0); PG8_BAR; PG8_MMA(1, 0, At, B0); PG8_MMA(1, 1, At, B1); PG8_BAR; PG8_SCHED;
            PG8_LDB(B0, 1, 0); PG8_LDB(B1, 1, 1); PG8_SCHED; PG8_LDA(At, 1, 0); PG8_STAGE(PG8_SA(0, 1), a2 + hstepA, voffA);
            PG8_WAIT_V(8); PG8_WAIT_L(0); PG8_BAR; PG8_MMA(0, 0, At, B0); PG8_MMA(0, 1, At, B1); PG8_BAR; PG8_SCHED;
            PG8_LDA(At, 1, 1); PG8_STAGE(PG8_SB(1, 0), b3, voffB); PG8_STAGE(PG8_SB(1, 1), b3 + hstepB, voffB); PG8_STAGE(PG8_SA(1, 0), a3, voffA);
            PG8_WAIT_V(8); PG8_WAIT_L(0); PG8_BAR; PG8_MMA(1, 0, At, B0); PG8_MMA(1, 1, At, B1); PG8_BAR; PG8_SCHED;
        }
        if constexpr (ALIGN_EPI) { if (wr == 0) PG8_BAR; }
        E(acc, cur, wr, wc, fr, fq);
        if (!has_next) break;
        if constexpr (Epi::HAS_INIT) { E.init(acc, nxt, wr, wc, fr, fq); }
        else {
#pragma unroll
        for (int a = 0; a < 2; ++a)
#pragma unroll
            for (int b = 0; b < 2; ++b)
#pragma unroll
                for (int m = 0; m < 4; ++m)
#pragma unroll
                    for (int n = 0; n < 2; ++n) acc[a][b][m][n] = (f32x4){0.f, 0.f, 0.f, 0.f};
        }
        cur = nxt; cA = nA; cB = nB; ++ui;
        if constexpr (ALIGN_EPI) { if (wr == 1) PG8_BAR; }
    }
    PG8_WAIT_V(0);
    if constexpr (!ALIGN_EPI) { if (wr == 0) PG8_BAR; }
    PG8_BAR;
#undef PG8_SA
#undef PG8_SB
#undef PG8_STAGE
#undef PG8_LDA
#undef PG8_LDB
#undef PG8_MMA
#undef PG8_WAIT_V
#undef PG8_WAIT_L
#undef PG8_BAR
#undef PG8_SCHED
}
}

#define XB_TMO      128
#define XB_XCNT(j)  (256  + 64 * (j))
#define XB_XSUB(j)  (1280 + 64 * (j))
#define XB_XGEN(j)  (2304 + 64 * (j))
#define XB_TOP      3328
#define XB_TOPGEN   3392
#define XCD_BAR_WORDS 3456
#define XB_SPIN_CAP (1u << 18)
__device__ __forceinline__ unsigned xb_ld(unsigned* p)              { return __hip_atomic_load(p, __ATOMIC_RELAXED, __HIP_MEMORY_SCOPE_AGENT); }
__device__ __forceinline__ unsigned xb_add(unsigned* p, unsigned v) { return __hip_atomic_fetch_add(p, v, __ATOMIC_RELAXED, __HIP_MEMORY_SCOPE_AGENT); }
__device__ __forceinline__ unsigned xb_xcc_id() { return (unsigned)__builtin_amdgcn_s_getreg((3 << 11) | 20) & 0xFu; }
#define XB_SPIN(cond, bar) do { unsigned _sp = 0; while (cond) { __builtin_amdgcn_s_sleep(1); \
    if ((++_sp & 255u) == 0u) { if (xb_ld(&(bar)[XB_TMO])) break; if (_sp > XB_SPIN_CAP) { atomicAdd(&(bar)[XB_TMO], 1u); break; } } } } while (0)
struct XcdBarrier { unsigned* bar; unsigned x; volatile LAS unsigned* st; };
__device__ __forceinline__ XcdBarrier xcd_barrier_post(unsigned* bar, volatile LAS unsigned* st) {
    XcdBarrier b; b.bar = bar; b.x = xb_xcc_id(); b.st = st;
    if (threadIdx.x == 0) (void)xb_add(&bar[XB_XCNT(b.x)], 1u);
    return b;
}
__device__ __forceinline__ void xcd_barrier_complete(unsigned* bar, unsigned x, unsigned& nloc, unsigned& nx) {
    const unsigned G = gridDim.x * gridDim.y * gridDim.z;
    unsigned sum, cnt, mine, sp = 0u;
    for (;;) {
        sum = 0u; cnt = 0u; mine = 0u;
#pragma unroll
        for (unsigned j = 0; j < 16; ++j) { const unsigned c = xb_ld(&bar[XB_XCNT(j)]); sum += c; cnt += (c > 0u) ? 1u : 0u; mine = (j == x) ? c : mine; }
        if (sum == G) break;
        __builtin_amdgcn_s_sleep(1);
        if ((++sp & 255u) == 0u) { if (xb_ld(&bar[XB_TMO])) break; if (sp > XB_SPIN_CAP) { atomicAdd(&bar[XB_TMO], 1u); break; } }
    }
    nloc = mine > 0u ? mine : 1u; nx = cnt > 0u ? cnt : 1u;
}
__device__ __forceinline__ void xcd_barrier(const XcdBarrier& b) {
    asm volatile("s_waitcnt vmcnt(0)" ::: "memory");
    __syncthreads();
    if (threadIdx.x == 0) {
        unsigned* bar = b.bar;
        __builtin_amdgcn_s_waitcnt(0);
        unsigned nloc = b.st[0], nx = b.st[1];
        if (nloc == 0u) { xcd_barrier_complete(bar, b.x, nloc, nx); b.st[0] = nloc; b.st[1] = nx; }
        const unsigned old = xb_add(&bar[XB_XSUB(b.x)], 1u);
        const unsigned gen = old / nloc;
        if (old + 1u == (gen + 1u) * nloc) {
            __builtin_amdgcn_fence(__ATOMIC_RELEASE, "agent");
            asm volatile("s_waitcnt vmcnt(0)" ::: "memory");
            const unsigned og = xb_add(&bar[XB_TOP], 1u);
            const unsigned tg = og / nx;
            if (og + 1u == (tg + 1u) * nx) xb_add(&bar[XB_TOPGEN], 1u);
            else XB_SPIN(xb_ld(&bar[XB_TOPGEN]) == tg, bar);
            __builtin_amdgcn_fence(__ATOMIC_ACQUIRE, "agent");
            xb_add(&bar[XB_XGEN(b.x)], 1u);
            asm volatile("s_waitcnt vmcnt(0)" ::: "memory");
        } else {
            XB_SPIN(xb_ld(&bar[XB_XGEN(b.x)]) == gen, bar);
            __builtin_amdgcn_fence(__ATOMIC_ACQUIRE, "agent");
            asm volatile("s_waitcnt vmcnt(0)" ::: "memory");
        }
    }
    __syncthreads();
}

struct Args {
    const float* x; const float* norm1_w; const float* w_in; const float* conv_w; const float* conv_b; const float* igate_b; const float* fgate_b;
    const float* q_norm_w; const float* k_norm_w; const float* mlstm_norm_w; const float* attn_norm_w; const float* w_out; const float* norm2_w;
    const float* w_gate; const float* w_up; const float* w_down;
    float* out; unsigned char* ws; int dry; int pad;
};

struct TItem { const float* W; bf16* WT; const float* kscale; int ldw, K, nsrc0, ndst0, k0; };
__device__ __forceinline__ void titem_load(const TItem& t, f32x4 (&v)[8], int lane) {
    const float* src = t.W + (size_t)(t.k0 + (lane >> 3)) * t.ldw + t.nsrc0 + (lane & 7) * 4;
#pragma unroll
    for (int i = 0; i < 8; ++i) v[i] = *(const f32x4*)(src + (size_t)(8 * i) * t.ldw);
}
__device__ __forceinline__ void titem_finish(const TItem& t, const f32x4 (&v)[8], LAS float* scr, int lane) {
#pragma unroll
    for (int i = 0; i < 8; ++i) { const int kk = 8 * i + (lane >> 3); const float sc = t.kscale ? t.kscale[t.k0 + kk] : 1.0f; LAS float* d = scr + kk * 33 + (lane & 7) * 4;
        d[0] = v[i][0] * sc; d[1] = v[i][1] * sc; d[2] = v[i][2] * sc; d[3] = v[i][3] * sc; }
    LDS_WAIT(); asm volatile("" ::: "memory");
    const int c = lane & 7;
#pragma unroll
    for (int j = 0; j < 4; ++j) { const int n = (lane >> 3) + 8 * j; const LAS float* s = scr + (8 * c) * 33 + n;
        u32x4 o; o.x = cvtpk(s[0 * 33], s[1 * 33]); o.y = cvtpk(s[2 * 33], s[3 * 33]); o.z = cvtpk(s[4 * 33], s[5 * 33]); o.w = cvtpk(s[6 * 33], s[7 * 33]);
        *(u32x4*)(t.WT + (size_t)(t.ndst0 + n) * t.K + t.k0 + 8 * c) = o; }
    LDS_WAIT(); asm volatile("" ::: "memory");
}
__device__ __forceinline__ int win_src_col(int nd) {
    if (nd < 1024) return nd;
    if (nd < 2048) return nd + 1024;
    if (nd < 3072) return nd - 1024;
    return nd + 8;
}


__device__ __forceinline__ float scan_add64(float v, int lane) {
#pragma unroll
    for (int o = 1; o < 64; o <<= 1) { const float t = __shfl_up(v, o); if (lane >= o) v += t; }
    return v;
}
__device__ __forceinline__ float scan_max64(float v, int lane) {
#pragma unroll
    for (int o = 1; o < 64; o <<= 1) { const float t = __shfl_up(v, o); if (lane >= o) v = fmaxf(v, t); }
    return v;
}
template <bool ROWW>
__device__ __forceinline__ void conv_tile(const bf16* proj, const float* conv_w, const float* conv_b, int b, int c, int col0, int ch0, float rscale, float wlane, LAS unsigned char* tile, int tid) {
    const int rr = tid >> 4, cc = (tid & 15) * 8;
    float w[4][8], bb[8];
#pragma unroll
    for (int j = 0; j < 4; ++j) { const f32x4 w0 = *(const f32x4*)(conv_w + j * 1024 + ch0 + cc), w1 = *(const f32x4*)(conv_w + j * 1024 + ch0 + cc + 4);
        w[j][0] = w0[0]; w[j][1] = w0[1]; w[j][2] = w0[2]; w[j][3] = w0[3]; w[j][4] = w1[0]; w[j][5] = w1[1]; w[j][6] = w1[2]; w[j][7] = w1[3]; }
    { const f32x4 b0 = *(const f32x4*)(conv_b + ch0 + cc), b1 = *(const f32x4*)(conv_b + ch0 + cc + 4);
      bb[0] = b0[0]; bb[1] = b0[1]; bb[2] = b0[2]; bb[3] = b0[3]; bb[4] = b1[0]; bb[5] = b1[1]; bb[6] = b1[2]; bb[7] = b1[3]; }
#pragma unroll
    for (int half = 0; half < 2; ++half) {
        const int l = rr + 32 * half, t = c * 64 + l;
        float y[8];
#pragma unroll
        for (int e = 0; e < 8; ++e) y[e] = bb[e];
#pragma unroll
        for (int j = 0; j < 4; ++j) { const int tt = t - 3 + j;
            if (tt >= 0) { const u32x4 raw = *(const u32x4*)(proj + (size_t)(b * SEQ + tt) * NPROJ + col0 + cc); float x[8]; unpack8(raw, x);
#pragma unroll
                for (int e = 0; e < 8; ++e) y[e] += w[j][e] * x[e]; } }
        float sc = rscale;
        if (ROWW) sc *= __shfl(wlane, l);
#pragma unroll
        for (int e = 0; e < 8; ++e) y[e] = y[e] / (1.0f + __expf(-y[e])) * sc;
        *(LAS u32x4*)(tile + l * 288 + cc * 2) = pack8(y);
    }
}
__device__ __forceinline__ void v_tile(const bf16* proj, int b, int c, int h, LAS unsigned char* tile, int tid) {
#pragma unroll
    for (int p = 0; p < 4; ++p) { const int row = p * 16 + (tid >> 5), ch = tid & 31;
        const u32x4 v = *(const u32x4*)(proj + (size_t)(b * SEQ + c * 64 + row) * NPROJ + PC_MV + h * 256 + ch * 8);
        *(LAS u32x4*)(tile + row * 544 + ch * 16) = v; }
}

template <bool FINAL>
__device__ __forceinline__ void attn_unit(bf16* proj, const float* rcos, const float* rsin, const float* qnw, const float* anw, int b, int h, int d, int r, int n,
                                          LAS unsigned char* lds, bf16* po0, float* pl0, bf16* po1, float* pl1, int tid, int lane, int wave, bool dry) {
    const int j = lane & 15, g = lane >> 4, qp = j >> 2, p = lane & 3;
    const int qi = 16 * wave + j;
    const int tq = (128 * n + qi) * d + r;
    bf16* qrow = proj + (size_t)(b * SEQ + tq) * NPROJ + PC_AQ + h * 128;
    const int srow = tid >> 4, sch = tid & 15;
    const bf16* kcol = proj + (size_t)b * SEQ * NPROJ + PC_AK + h * 128 + sch * 8;
    const bf16* vcol = kcol + (PC_AV - PC_AK);
    const int kt0 = (n == 0) ? 4 : 0;
    const int sub0 = 128 * (n - 1) + srow;
    u32x4 rk[3], rv[3];
#define AT_ISSUE(t) do { if ((t) < 8) { const size_t tok_ = (size_t)((sub0 + 32 * (t)) * d + r); rk[(t) % 3] = *(const u32x4*)(kcol + tok_ * NPROJ); rv[(t) % 3] = *(const u32x4*)(vcol + tok_ * NPROJ); } } while (0)
#define AT_WRITE(t) do { LAS unsigned char* Kn_ = lds + ((t) & 1) * 18432; *(LAS u32x4*)(Kn_ + srow * 288 + sch * 16) = rk[(t) % 3]; *(LAS u32x4*)(Kn_ + 9216 + srow * 288 + sch * 16) = rv[(t) % 3]; } while (0)
#define WG_BAR() do { asm volatile("s_waitcnt lgkmcnt(0)" ::: "memory"); __builtin_amdgcn_s_barrier(); asm volatile("" ::: "memory"); } while (0)
    if (kt0 == 0) { AT_ISSUE(0); AT_ISSUE(1); AT_ISSUE(2); } else { AT_ISSUE(4); AT_ISSUE(5); AT_ISSUE(6); }
    bf16x8 qf[4];
    {
        float q[4][8]; float ss = 0.f;
#pragma unroll
        for (int ks = 0; ks < 4; ++ks) { const u32x4 raw = *(const u32x4*)(qrow + 32 * ks + 8 * g); unpack8(raw, q[ks]);
#pragma unroll
            for (int e = 0; e < 8; ++e) ss += q[ks][e] * q[ks][e]; }
        ss += __shfl_xor(ss, 16); ss += __shfl_xor(ss, 32);
        const float rq = 1.0f / sqrtf(ss * (1.0f / 128.0f) + NORM_EPS);
#pragma unroll
        for (int ks = 0; ks < 2; ++ks) {
            const int c0 = 32 * ks + 8 * g;
#pragma unroll
            for (int e4 = 0; e4 < 2; ++e4) {
                const f32x4 cs = *(const f32x4*)(rcos + tq * 64 + c0 + 4 * e4), sn = *(const f32x4*)(rsin + tq * 64 + c0 + 4 * e4);
                const f32x4 w1 = *(const f32x4*)(qnw + c0 + 4 * e4), w2 = *(const f32x4*)(qnw + 64 + c0 + 4 * e4);
#pragma unroll
                for (int e = 0; e < 4; ++e) { const float y1 = q[ks][4 * e4 + e] * rq * w1[e], y2 = q[ks + 2][4 * e4 + e] * rq * w2[e];
                    q[ks][4 * e4 + e] = y1 * cs[e] - y2 * sn[e]; q[ks + 2][4 * e4 + e] = y2 * cs[e] + y1 * sn[e]; }
            }
        }
#pragma unroll
        for (int ks = 0; ks < 4; ++ks) { const u32x4 w = pack8(q[ks]); qf[ks] = __builtin_bit_cast(bf16x8, w); }
    }
    if (kt0 == 0) AT_WRITE(0); else AT_WRITE(4);
    WG_BAR();
    float m_run = -1e30f, l_run = 0.f;
    f32x4 o[8];
#pragma unroll
    for (int nf = 0; nf < 8; ++nf) o[nf] = (f32x4){0.f, 0.f, 0.f, 0.f};
    const float SC = 0.08838834764831845f * 1.4426950408889634f;
    const float NEG = -__builtin_inff();
    const int wlo = wave >> 1;
#define AT_STEP(kt) do { if ((kt) >= kt0) { \
        LAS unsigned char* Kt = lds + ((kt) & 1) * 18432; LAS unsigned char* Vt = Kt + 9216; \
        AT_ISSUE((kt) + 3); \
        if ((kt) >= wlo && (kt) <= wlo + 4) { \
            f32x4 s0 = {0.f, 0.f, 0.f, 0.f}, s1 = {0.f, 0.f, 0.f, 0.f}; \
            _Pragma("unroll") for (int ks = 0; ks < 4; ++ks) { \
                const bf16x8 k0 = *(const LAS bf16x8*)(Kt + j * 288 + (32 * ks + 8 * g) * 2), k1 = *(const LAS bf16x8*)(Kt + (16 + j) * 288 + (32 * ks + 8 * g) * 2); \
                s0 = MFMA16(k0, qf[ks], s0); s1 = MFMA16(k1, qf[ks], s1); } \
            float x[8]; float tmax = NEG; \
            _Pragma("unroll") for (int e = 0; e < 8; ++e) { const int kj = 32 * (kt) + 16 * (e >> 2) + 4 * g + (e & 3); const float sv = (e < 4) ? s0[e & 3] : s1[e & 3]; \
                const bool valid = (kj >= qi) && (kj <= qi + 128); \
                x[e] = valid ? sv * SC : NEG; tmax = fmaxf(tmax, x[e]); } \
            tmax = fmaxf(tmax, __shfl_xor(tmax, 16)); tmax = fmaxf(tmax, __shfl_xor(tmax, 32)); \
            const float m_new = fmaxf(m_run, tmax); \
            const float alpha = __builtin_amdgcn_exp2f(m_run - m_new); \
            float ps = 0.f; \
            _Pragma("unroll") for (int e = 0; e < 8; ++e) { x[e] = __builtin_amdgcn_exp2f(x[e] - m_new); ps += x[e]; } \
            l_run = l_run * alpha + ps; m_run = m_new; \
            _Pragma("unroll") for (int nf = 0; nf < 8; ++nf) o[nf] = o[nf] * alpha; \
            const u32x4 pw = pack8(x); const bf16x8 pb = __builtin_bit_cast(bf16x8, pw); \
            _Pragma("unroll") for (int nf = 0; nf < 8; ++nf) { \
                const s16x4 a0 = vtr(Vt + (4 * g + qp) * 288 + (16 * nf + 4 * p) * 2), a1 = vtr(Vt + (16 + 4 * g + qp) * 288 + (16 * nf + 4 * p) * 2); \
                o[nf] = MFMA16(cat4(a0, a1), pb, o[nf]); } \
        } \
        if ((kt) + 1 < 8) AT_WRITE((kt) + 1); \
        WG_BAR(); } } while (0)
    AT_STEP(0); AT_STEP(1); AT_STEP(2); AT_STEP(3); AT_STEP(4); AT_STEP(5); AT_STEP(6); AT_STEP(7);
#undef AT_STEP
#undef AT_ISSUE
#undef AT_WRITE
    l_run += __shfl_xor(l_run, 16); l_run += __shfl_xor(l_run, 32);
    const float inv = 1.0f / l_run;
    const float lse2 = m_run + __log2f(l_run);
    const size_t trow = (size_t)(b * SEQ + tq);
    if (!FINAL) {
#pragma unroll
        for (int nf = 0; nf < 8; ++nf) { const f32x4 v = o[nf] * inv; u32x2 ww; ww.x = cvtpk(v[0], v[1]); ww.y = cvtpk(v[2], v[3]);
            if (!dry) *(u32x2*)(po0 + trow * 1024 + h * 128 + 16 * nf + 4 * g) = ww; }
        if (g == 0 && !dry) pl0[trow * 8 + h] = lse2;
    } else {
        const float l0 = pl0[trow * 8 + h], l1 = pl1[trow * 8 + h];
        const float M = fmaxf(lse2, fmaxf(l0, l1));
        const float w0 = __builtin_amdgcn_exp2f(l0 - M), w1 = __builtin_amdgcn_exp2f(l1 - M), wc = __builtin_amdgcn_exp2f(lse2 - M);
        const float wi_ = 1.0f / (w0 + w1 + wc); const float c0 = w0 * wi_, c1 = w1 * wi_, cc = wc * wi_ * inv;
        float ss = 0.f;
#pragma unroll
        for (int nf = 0; nf < 8; ++nf) { const int e = h * 128 + 16 * nf + 4 * g;
            const u32x2 a0 = *(const u32x2*)(po0 + trow * 1024 + e), a1 = *(const u32x2*)(po1 + trow * 1024 + e);
            f32x4 v = o[nf] * cc;
            v[0] += c0 * bf_lo(a0.x) + c1 * bf_lo(a1.x); v[1] += c0 * bf_hi(a0.x) + c1 * bf_hi(a1.x); v[2] += c0 * bf_lo(a0.y) + c1 * bf_lo(a1.y); v[3] += c0 * bf_hi(a0.y) + c1 * bf_hi(a1.y);
            o[nf] = v; ss += (v[0] * v[0] + v[1] * v[1]) + (v[2] * v[2] + v[3] * v[3]); }
        ss += __shfl_xor(ss, 16); ss += __shfl_xor(ss, 32);
        const float rn = 1.0f / sqrtf(ss * (1.0f / 128.0f) + NORM_EPS);
#pragma unroll
        for (int nf = 0; nf < 8; ++nf) { const int e = 16 * nf + 4 * g; const f32x4 w = *(const f32x4*)(anw + h * 128 + e); const f32x4 v = o[nf] * rn * w;
            u32x2 ww; ww.x = cvtpk(v[0], v[1]); ww.y = cvtpk(v[2], v[3]); if (!dry) *(u32x2*)(qrow + e) = ww; }
    }
}

#ifndef PROBE_PHASE
#define PROBE_PHASE -1
#endif
#define REP_BEGIN(k) for (int rep_ = (PROBE_PHASE == (k)) ? 0 : 1; rep_ < 2; ++rep_) { const bool dry = (rep_ == 0) && (a.dry != 0); (void)dry; \
    int tid = threadIdx.x; asm volatile("" : "+v"(tid)); const int lane = tid & 63, wave = __builtin_amdgcn_readfirstlane(tid >> 6); \
    const int gw = vcu * NWAVES + wave, gt = vcu * (NWAVES * 64) + tid; (void)lane; (void)wave; (void)gw; (void)gt;
#define REP_END }

__global__ void __launch_bounds__(NWAVES * 64, 2) hymba_fwd(Args a) {
    extern __shared__ __attribute__((aligned(16))) unsigned char lds_raw[];
    LAS unsigned char* lds = (LAS unsigned char*)lds_raw;
    volatile LAS unsigned* MISC = (volatile LAS unsigned*)(lds + MISC_OFF);
    const int tid = threadIdx.x, lane = tid & 63, wave = __builtin_amdgcn_readfirstlane(tid >> 6);
    const int G = gridDim.x; const int bx = blockIdx.x; const int vcu = (G % 8 == 0) ? (bx % 8) * (G / 8) + bx / 8 : bx;
    unsigned char* ws = a.ws;
    unsigned* ctl = (unsigned*)(ws + WS_CTL);
    float* gli = (float*)(ws + WS_GLI); float* glf = (float*)(ws + WS_GLF); float* sumsq = (float*)(ws + WS_SUMSQ);
    float* msc_g = (float*)(ws + WS_MSC); float* msc_ml = msc_g + 512; float* msc_mp = msc_g + 1024;
    float* ncb = (float*)(ws + WS_NC);
    float* rcos = (float*)(ws + WS_COS); float* rsin = (float*)(ws + WS_SIN);
    bf16* WinT = (bf16*)(ws + WS_WIN); bf16* kvT = (bf16*)(ws + WS_KV); bf16* Ub = (bf16*)(ws + WS_U); bf16* H1b = (bf16*)(ws + WS_U);
    bf16* proj = (bf16*)(ws + WS_PROJ); bf16* FF = (bf16*)(ws + WS_PROJ);
    bf16* op0 = (bf16*)(ws + WS_OP0); bf16* op1 = (bf16*)(ws + WS_OP1); float* pl0 = (float*)(ws + WS_PL0); float* pl1 = (float*)(ws + WS_PL1);
    bf16* WoutT = (bf16*)(ws + WS_WOUT); bf16* WguT = (bf16*)(ws + WS_WGU); bf16* WdnT = (bf16*)(ws + WS_WDN);

    for (int u = tid; u < (LDS_BYTES - MISC_OFF) / 4; u += NWAVES * 64) ((LAS unsigned*)(lds + MISC_OFF))[u] = 0u;
    __syncthreads();
    XcdBarrier bar = xcd_barrier_post(ctl + CW_BAR, MISC + 8);
    const int NGW = G * NWAVES, NGT = G * NWAVES * 64;

    REP_BEGIN(0)
        for (int i = gt; i < MTOK; i += NGT) sumsq[i] = 0.f;
        for (int i = gt; i < SEQ * 64; i += NGT) {
            const int pos = i >> 6, fi = i & 63;
            const float invf = (float)exp2(-(double)fi * (13.287712379549449 / 64.0));
            const float ang = (float)pos * invf;
            const double rev = (double)ang * 0.15915494309189535; const double fr_ = rev - rint(rev);
            const float ar = (float)(fr_ * 6.283185307179586);
            rcos[i] = cosf(ar); rsin[i] = sinf(ar);
        }
        {
            LAS float* scr = (LAS float*)(lds + wave * 16384);
            constexpr int I_IN = (DM / 64) * (NPROJ / 32), I_OUT = (DM / 64) * (DM / 32), I_GU = (DM / 64) * (NGU / 32), I_DN = (DFF / 64) * (DM / 32);
            constexpr int NITEMS = I_IN + I_OUT + I_GU;
            auto decode = [&](int it) -> TItem {
                TItem t; int r = it;
                if (r < I_IN) { const int nblk = NPROJ / 32, kb = r / nblk, nb = r % nblk; t = TItem{a.w_in, WinT, nullptr, INW, DM, win_src_col(nb * 32), nb * 32, kb * 64}; return t; } r -= I_IN;
                if (r < I_OUT) { const int nblk = DM / 32, kb = r / nblk, nb = r % nblk; t = TItem{a.w_out, WoutT, nullptr, DM, DM, nb * 32, nb * 32, kb * 64}; return t; } r -= I_OUT;
                { const int nblk = NGU / 32, kb = r / nblk, nb = r % nblk; const int nd = nb * 32, pn = nd >> 8, j = nd & 255;
                    t = TItem{(j < 128) ? a.w_gate : a.w_up, WguT, a.norm2_w, DFF, DM, pn * 128 + (j & 127), nd, kb * 64}; return t; }
            };
            int it = gw;
            if (it < NITEMS) {
                TItem cur = decode(it); f32x4 vc[8]; titem_load(cur, vc, lane);
                for (;;) {
                    const int nx = it + NGW; const bool more = nx < NITEMS;
                    TItem nt = cur; f32x4 vn[8];
                    if (more) { nt = decode(nx); titem_load(nt, vn, lane); }
                    titem_finish(cur, vc, scr, lane);
                    if (!more) break;
                    cur = nt; it = nx;
#pragma unroll
                    for (int i = 0; i < 8; ++i) vc[i] = vn[i];
                }
            }
        }
        __syncthreads();
        LAS float* wg = (LAS float*)lds;
        for (int k = tid; k < DM; k += NWAVES * 64) { const f32x4 g0 = *(const f32x4*)(a.w_in + (size_t)k * INW + 3072), g1 = *(const f32x4*)(a.w_in + (size_t)k * INW + 3076);
            wg[0 * DM + k] = g0[0]; wg[1 * DM + k] = g0[1]; wg[2 * DM + k] = g0[2]; wg[3 * DM + k] = g0[3];
            wg[4 * DM + k] = g1[0]; wg[5 * DM + k] = g1[1]; wg[6 * DM + k] = g1[2]; wg[7 * DM + k] = g1[3]; }
        __syncthreads();
        for (int m = gw; m < MTOK; m += NGW) {
            const f32x4* xr = (const f32x4*)(a.x + (size_t)m * DM) + lane; const f32x4* wr_ = (const f32x4*)a.norm1_w + lane;
            f32x4 v[8]; float s = 0.f;
#pragma unroll
            for (int j = 0; j < 8; ++j) { v[j] = xr[64 * j]; s += (v[j][0] * v[j][0] + v[j][1] * v[j][1]) + (v[j][2] * v[j][2] + v[j][3] * v[j][3]); }
            const float rstd = 1.0f / sqrtf(wave_sum(s) * (1.0f / DM) + NORM_EPS);
            u32x2* o8 = (u32x2*)(Ub + (size_t)m * DM) + lane;
#pragma unroll
            for (int j = 0; j < 8; ++j) { v[j] = v[j] * rstd * wr_[64 * j]; u32x2 w; w.x = cvtpk(v[j][0], v[j][1]); w.y = cvtpk(v[j][2], v[j][3]); o8[64 * j] = w; }
            float z = 0.f;
#pragma unroll 1
            for (int gi = 0; gi < 8; ++gi) { float t = 0.f;
#pragma unroll
                for (int j = 0; j < 8; ++j) { const f32x4 w4 = *(const LAS f32x4*)(wg + gi * DM + 256 * j + 4 * lane); t += (v[j][0] * w4[0] + v[j][1] * w4[1]) + (v[j][2] * w4[2] + v[j][3] * w4[3]); }
                t = wave_sum(t); z = (lane == gi) ? t : z; }
            if (lane < 8) {
                const int hh = lane & 3;
                if (lane < 4) { gli[m * 4 + hh] = 15.0f * tanhf((z + a.igate_b[hh]) * (1.0f / 15.0f)); }
                else { const float fp = 15.0f * tanhf((z + a.fgate_b[hh]) * (1.0f / 15.0f)); glf[m * 4 + hh] = -log1pf(expf(-fp)); }
            }
        }
    REP_END
    xcd_barrier(bar);

    REP_BEGIN(1)
        pg8::Gemm g{Ub, WinT, MTOK, NPROJ, DM, DM}; pg8::StaticOrder S; S.init(MTOK, NPROJ, G, bx);
        pg8::EpiBf16 E{proj, NPROJ};
        pg8::gemm_phase<pg8::EpiBf16, true>(lds, g, S, E);
    REP_END
    xcd_barrier(bar);

    REP_BEGIN(2)
        {
            const int c0 = 4 * (tid & 15), rstride = NGT >> 4;
            const f32x4 w1 = *(const f32x4*)(a.k_norm_w + c0), w2 = *(const f32x4*)(a.k_norm_w + 64 + c0);
            for (int idx0 = gt >> 4; idx0 < MTOK * 8; idx0 += 4 * rstride) {
                u32x2 r1[4], r2[4]; f32x4 cs[4], sn[4];
#pragma unroll
                for (int q = 0; q < 4; ++q) { const int idx = idx0 + q * rstride;
                    if (idx < MTOK * 8) { const int m = idx >> 3, hh = idx & 7, pos = m & (SEQ - 1); const bf16* kp = proj + (size_t)m * NPROJ + PC_AK + hh * 128;
                        r1[q] = *(const u32x2*)(kp + c0); r2[q] = *(const u32x2*)(kp + 64 + c0); cs[q] = *(const f32x4*)(rcos + pos * 64 + c0); sn[q] = *(const f32x4*)(rsin + pos * 64 + c0); } }
#pragma unroll
                for (int q = 0; q < 4; ++q) { const int idx = idx0 + q * rstride;
                    if (idx < MTOK * 8) { const int m = idx >> 3, hh = idx & 7; bf16* kp = proj + (size_t)m * NPROJ + PC_AK + hh * 128;
                        float x1[4] = {bf_lo(r1[q].x), bf_hi(r1[q].x), bf_lo(r1[q].y), bf_hi(r1[q].y)}, x2[4] = {bf_lo(r2[q].x), bf_hi(r2[q].x), bf_lo(r2[q].y), bf_hi(r2[q].y)};
                        float ss = 0.f;
#pragma unroll
                        for (int e = 0; e < 4; ++e) ss += x1[e] * x1[e] + x2[e] * x2[e];
                        ss += __shfl_xor(ss, 1); ss += __shfl_xor(ss, 2); ss += __shfl_xor(ss, 4); ss += __shfl_xor(ss, 8);
                        const float rk = 1.0f / sqrtf(ss * (1.0f / 128.0f) + NORM_EPS);
                        float o1[4], o2[4];
#pragma unroll
                        for (int e = 0; e < 4; ++e) { const float y1 = x1[e] * rk * w1[e], y2 = x2[e] * rk * w2[e]; o1[e] = y1 * cs[q][e] - y2 * sn[q][e]; o2[e] = y2 * cs[q][e] + y1 * sn[q][e]; }
                        u32x2 wv; wv.x = cvtpk(o1[0], o1[1]); wv.y = cvtpk(o1[2], o1[3]); if (!dry) *(u32x2*)(kp + c0) = wv;
                        wv.x = cvtpk(o2[0], o2[1]); wv.y = cvtpk(o2[2], o2[3]); if (!dry) *(u32x2*)(kp + 64 + c0) = wv; } }
            }
        }
        LAS unsigned char* KW = lds; LAS unsigned char* VT = lds + 18432;
        const int g = lane >> 4, qp = (lane & 15) >> 2, p = lane & 3;
        for (int u = vcu; u < 512; u += G) {
            const int b = u >> 8, h = (u >> 6) & 3, c = u & 63;
            const int tok = b * SEQ + c * 64 + lane;
            const float li = gli[tok * 4 + h], lf = glf[tok * 4 + h];
            const float cf = scan_add64(lf, lane);
            const float gsum = __shfl(cf, 63);
            const float av = gsum - cf + li;
            const float ml = wave_max(av);
            const float wst = __expf(av - ml);
            if (tid == 0) { msc_g[u] = gsum; msc_ml[u] = ml; }
            conv_tile<true>(proj, a.conv_w, a.conv_b, b, c, PC_MK + h * 128, 512 + h * 128, 1.0f, wst, KW, tid);
            v_tile(proj, b, c, h, VT, tid);
            __syncthreads();
            f32x4 acc[8][2];
#pragma unroll
            for (int df = 0; df < 8; ++df) { acc[df][0] = (f32x4){0.f, 0.f, 0.f, 0.f}; acc[df][1] = (f32x4){0.f, 0.f, 0.f, 0.f}; }
#pragma unroll
            for (int kk = 0; kk < 2; ++kk) {
                bf16x8 bfr[2];
#pragma unroll
                for (int ef = 0; ef < 2; ++ef) { const int col = 32 * wave + 16 * ef + 4 * p;
                    bfr[ef] = cat4(vtr(VT + (32 * kk + 4 * g + qp) * 544 + col * 2), vtr(VT + (32 * kk + 16 + 4 * g + qp) * 544 + col * 2)); }
#pragma unroll
                for (int df = 0; df < 8; ++df) { const int col = 16 * df + 4 * p;
                    const bf16x8 af = cat4(vtr(KW + (32 * kk + 4 * g + qp) * 288 + col * 2), vtr(KW + (32 * kk + 16 + 4 * g + qp) * 288 + col * 2));
                    acc[df][0] = MFMA16(af, bfr[0], acc[df][0]); acc[df][1] = MFMA16(af, bfr[1], acc[df][1]); }
            }
#pragma unroll
            for (int ef = 0; ef < 2; ++ef) { const int e = 32 * wave + 16 * ef + (lane & 15);
#pragma unroll
                for (int df = 0; df < 8; ++df) { const f32x4 v = acc[df][ef]; u32x2 w; w.x = cvtpk(v[0], v[1]); w.y = cvtpk(v[2], v[3]);
                    *(u32x2*)(kvT + ((size_t)u * 256 + e) * 128 + 16 * df + 4 * g) = w; } }
            if (tid < 128) { float nsum = 0.f;
#pragma unroll 8
                for (int l = 0; l < 64; ++l) nsum += __uint_as_float((unsigned)(*(const LAS unsigned short*)(KW + l * 288 + tid * 2)) << 16);
                ncb[u * 128 + tid] = nsum; }
            __syncthreads();
        }
    REP_END
    xcd_barrier(bar);

    REP_BEGIN(3)
        LAS float* sg = (LAS float*)lds; LAS float* sml = sg + 512;
        for (int i = tid; i < 512; i += NWAVES * 64) { sg[i] = msc_g[i]; sml[i] = msc_ml[i]; }
        __syncthreads();
        for (int id = gt; id < 8 * 16384; id += NGT) {
            const int bh = id >> 14, pi = id & 16383;
            unsigned* base = (unsigned*)kvT + (size_t)bh * 64 * 16384 + pi;
            float c0 = 0.f, c1 = 0.f, m = 0.f;
#pragma unroll 1
            for (int cb = 0; cb < 64; cb += 32) {
                unsigned xv[32];
#pragma unroll
                for (int i = 0; i < 32; ++i) xv[i] = base[(size_t)(cb + i) * 16384];
#pragma unroll
                for (int i = 0; i < 32; ++i) {
                    const float gg = sg[bh * 64 + cb + i], ml = sml[bh * 64 + cb + i];
                    const float mn = fmaxf(gg + m, ml), so = __expf(gg + m - mn), sn = __expf(ml - mn);
                    if (!dry) base[(size_t)(cb + i) * 16384] = cvtpk(c0, c1);
                    c0 = so * c0 + sn * bf_lo(xv[i]); c1 = so * c1 + sn * bf_hi(xv[i]); m = mn;
                }
            }
        }
        for (int id = gt; id < 8 * 128; id += NGT) {
            const int bh = id >> 7, dd = id & 127; float n = 0.f, m = 0.f;
            float* nb_ = ncb + (size_t)bh * 64 * 128 + dd;
#pragma unroll 1
            for (int cb = 0; cb < 64; cb += 32) {
                float xv[32];
#pragma unroll
                for (int i = 0; i < 32; ++i) xv[i] = nb_[(cb + i) * 128];
#pragma unroll
                for (int i = 0; i < 32; ++i) {
                    const float gg = sg[bh * 64 + cb + i], ml = sml[bh * 64 + cb + i];
                    const float mn = fmaxf(gg + m, ml), so = __expf(gg + m - mn), sn = __expf(ml - mn);
                    if (!dry) nb_[(cb + i) * 128] = n;
                    if (dd == 0) msc_mp[bh * 64 + cb + i] = m;
                    n = so * n + sn * xv[i]; m = mn;
                }
            }
        }
        __syncthreads();
    REP_END
    REP_BEGIN(4)
        for (int u = vcu; u < 1024; u += G) {
            int d, b, h, r, n;
            if (u < 512) { d = 4; b = u >> 8; h = (u >> 5) & 7; r = (u >> 3) & 3; n = u & 7; }
            else { const int v = u - 512; d = 16; b = v >> 8; h = (v >> 5) & 7; r = (v >> 1) & 15; n = (v ^ b) & 1; }
            attn_unit<false>(proj, rcos, rsin, a.q_norm_w, a.attn_norm_w, b, h, d, r, n, lds, (d == 4) ? op0 : op1, (d == 4) ? pl0 : pl1, nullptr, nullptr, tid, lane, wave, dry);
        }
    REP_END
    xcd_barrier(bar);

    REP_BEGIN(5)
        LAS unsigned char* QT = lds; LAS unsigned char* KT = lds + 18432; LAS unsigned char* VT = lds + 36864;
        LAS float* NP = (LAS float*)(lds + 71680); LAS float* XCH = (LAS float*)(lds + 72192);
        const int j = lane & 15, g = lane >> 4, qp = j >> 2, p = lane & 3;
        const int tf = wave & 3, eh = wave >> 2;
        for (int u = vcu; u < 512; u += G) {
            const int b = u >> 8, h = (u >> 6) & 3, c = u & 63;
            const int tok = b * SEQ + c * 64 + lane;
            const float li = gli[tok * 4 + h], lf = glf[tok * 4 + h];
            const float cf = scan_add64(lf, lane);
            const float bvec = li - cf;
            const float pm = scan_max64(bvec, lane);
            const float mprev = msc_mp[u];
            const float Mv = fmaxf(mprev, pm);
            const float wiv = __expf(mprev - Mv), emtv = __expf(-cf - Mv);
            const bf16* cp = kvT + ((size_t)u * 256 + 128 * eh + j) * 128 + 8 * g;
            bf16x8 cpre[4][4];
#pragma unroll
            for (int ef = 0; ef < 4; ++ef)
#pragma unroll
                for (int ks = 0; ks < 4; ++ks) cpre[ef][ks] = *(const bf16x8*)(cp + (size_t)(16 * ef) * 128 + 32 * ks);
            conv_tile<false>(proj, a.conv_w, a.conv_b, b, c, PC_MQ + h * 128, h * 128, 0.08838834764831845f, 0.f, QT, tid);
            conv_tile<false>(proj, a.conv_w, a.conv_b, b, c, PC_MK + h * 128, 512 + h * 128, 1.0f, 0.f, KT, tid);
            v_tile(proj, b, c, h, VT, tid);
            if (tid < 128) NP[tid] = ncb[u * 128 + tid];
            __syncthreads();
            const int t = 16 * tf + j;
            const float M_t = __shfl(Mv, t), wi_t = __shfl(wiv, t), emt_t = __shfl(emtv, t);
            bf16x8 qf[4];
#pragma unroll
            for (int ks = 0; ks < 4; ++ks) qf[ks] = *(const LAS bf16x8*)(QT + t * 288 + (32 * ks + 8 * g) * 2);
            float sp[4][4]; float rowsum = 0.f;
#pragma unroll
            for (int sf = 0; sf < 4; ++sf) {
                f32x4 sa = {0.f, 0.f, 0.f, 0.f};
#pragma unroll
                for (int ks = 0; ks < 4; ++ks) { const bf16x8 kfr = *(const LAS bf16x8*)(KT + (16 * sf + j) * 288 + (32 * ks + 8 * g) * 2); sa = MFMA16(kfr, qf[ks], sa); }
#pragma unroll
                for (int rg = 0; rg < 4; ++rg) { const int sidx = 16 * sf + 4 * g + rg; const float bs = __shfl(bvec, sidx);
                    const float pv = (sidx <= t) ? __expf(bs - M_t) : 0.f; sp[sf][rg] = sa[rg] * pv; rowsum += sp[sf][rg]; }
            }
            bf16x8 pb[2];
#pragma unroll
            for (int kk = 0; kk < 2; ++kk) { float tmp[8] = {sp[2 * kk][0], sp[2 * kk][1], sp[2 * kk][2], sp[2 * kk][3], sp[2 * kk + 1][0], sp[2 * kk + 1][1], sp[2 * kk + 1][2], sp[2 * kk + 1][3]};
                const u32x4 w = pack8(tmp); pb[kk] = __builtin_bit_cast(bf16x8, w); }
            f32x4 ai[8], ae[8];
#pragma unroll
            for (int ef = 0; ef < 8; ++ef) { ai[ef] = (f32x4){0.f, 0.f, 0.f, 0.f}; ae[ef] = (f32x4){0.f, 0.f, 0.f, 0.f}; }
#pragma unroll
            for (int kk = 0; kk < 2; ++kk) {
#pragma unroll
                for (int ef = 0; ef < 8; ++ef) { const int col = 128 * eh + 16 * ef + 4 * p;
                    const bf16x8 af = cat4(vtr(VT + (32 * kk + 4 * g + qp) * 544 + col * 2), vtr(VT + (32 * kk + 16 + 4 * g + qp) * 544 + col * 2));
                    ai[ef] = MFMA16(af, pb[kk], ai[ef]); }
            }
#pragma unroll
            for (int ef = 0; ef < 4; ++ef)
#pragma unroll
                for (int ks = 0; ks < 4; ++ks) ae[ef] = MFMA16(cpre[ef][ks], qf[ks], ae[ef]);
#pragma unroll
            for (int ef = 4; ef < 8; ++ef) {
#pragma unroll
                for (int ks = 0; ks < 4; ++ks) { const bf16x8 cfr = *(const bf16x8*)(cp + (size_t)(16 * ef) * 128 + 32 * ks); ae[ef] = MFMA16(cfr, qf[ks], ae[ef]); }
            }
            float qn = 0.f;
#pragma unroll
            for (int ks = 0; ks < 4; ++ks) { float qv[8]; unpack8(__builtin_bit_cast(u32x4, qf[ks]), qv);
#pragma unroll
                for (int e = 0; e < 8; ++e) qn += qv[e] * NP[32 * ks + 8 * g + e]; }
            qn += __shfl_xor(qn, 16); qn += __shfl_xor(qn, 32);
            rowsum += __shfl_xor(rowsum, 16); rowsum += __shfl_xor(rowsum, 32);
            const float den = wi_t * qn + rowsum;
            const float dinv = 1.0f / fmaxf(fabsf(den), emt_t);
            float ssq = 0.f;
#pragma unroll
            for (int ef = 0; ef < 8; ++ef) { ai[ef] = (ae[ef] * wi_t + ai[ef]) * dinv; ssq += (ai[ef][0] * ai[ef][0] + ai[ef][1] * ai[ef][1]) + (ai[ef][2] * ai[ef][2] + ai[ef][3] * ai[ef][3]); }
            ssq += __shfl_xor(ssq, 16); ssq += __shfl_xor(ssq, 32);
            if (g == 0) XCH[eh * 64 + t] = ssq;
            __syncthreads();
            const float rn = 1.0f / sqrtf((XCH[t] + XCH[64 + t]) * (1.0f / 256.0f) + NORM_EPS);
            bf16* orow = proj + (size_t)(b * SEQ + c * 64 + t) * NPROJ;
#pragma unroll
            for (int ef = 0; ef < 8; ++ef) { const int e = 128 * eh + 16 * ef + 4 * g;
                const f32x4 nw = *(const f32x4*)(a.mlstm_norm_w + h * 256 + e);
                const u32x2 mo = *(const u32x2*)(orow + PC_MO + h * 256 + e);
                const float mof[4] = {bf_lo(mo.x), bf_hi(mo.x), bf_lo(mo.y), bf_hi(mo.y)};
                float r4[4];
#pragma unroll
                for (int e2 = 0; e2 < 4; ++e2) r4[e2] = ai[ef][e2] * rn * nw[e2] / (1.0f + __expf(-mof[e2]));
                u32x2 w; w.x = cvtpk(r4[0], r4[1]); w.y = cvtpk(r4[2], r4[3]); if (!dry) *(u32x2*)(orow + PC_MV + h * 256 + e) = w; }
            __syncthreads();
        }
        for (int u = vcu; u < 512; u += G) {
            const int b = u >> 8, h = (u >> 5) & 7, n = u & 31;
            attn_unit<true>(proj, rcos, rsin, a.q_norm_w, a.attn_norm_w, b, h, 1, 0, n, lds, op0, pl0, op1, pl1, tid, lane, wave, dry);
        }
    REP_END
    xcd_barrier(bar);

    REP_BEGIN(6)
        pg8::Gemm g{proj + PC_MV, WoutT, MTOK, DM, DM, NPROJ}; pg8::StaticOrder S; S.init(MTOK, DM, G, bx);
        pg8::EpiRes1 E{a.x, a.out, H1b, sumsq, DM, dry};
        pg8::gemm_phase<pg8::EpiRes1, false>(lds, g, S, E);
    REP_END
    xcd_barrier(bar);

    REP_BEGIN(7)
        pg8::Gemm g{H1b, WguT, MTOK, NGU, DM, DM}; pg8::StaticOrder S; S.init(MTOK, NGU, G, bx);
        pg8::EpiSwiGLU E{FF, DFF, sumsq};
        pg8::gemm_phase<pg8::EpiSwiGLU, true>(lds, g, S, E);
        if (rep_ == 1) {
            const int nfull = (MTOK / 256) * (NGU / 256) - 5 * G;
            const int nidle = G - nfull;
            if (G == 256 ? (bx >= nfull) : true) {
                LAS float* scr = (LAS float*)(lds + wave * 16384);
                constexpr int I_DN = (DFF / 64) * (DM / 32);
                const int w0 = (G == 256) ? (bx - nfull) * NWAVES + wave : gw, nw = (G == 256) ? nidle * NWAVES : NGW;
                for (int it = w0; it < I_DN; it += nw) { const int nblk = DM / 32, kb = it / nblk, nb = it % nblk;
                    const TItem t{a.w_down, WdnT, nullptr, DM, DFF, nb * 32, nb * 32, kb * 64}; f32x4 v[8]; titem_load(t, v, lane); titem_finish(t, v, scr, lane); }
            }
        }
    REP_END
    xcd_barrier(bar);

    REP_BEGIN(8)
        pg8::Gemm g{FF, WdnT, MTOK, DM, DFF, DFF}; pg8::StaticOrder S; S.init(MTOK, DM, G, bx);
        pg8::EpiRes2 E{a.out, DM, dry};
        pg8::gemm_phase<pg8::EpiRes2, false>(lds, g, S, E);
    REP_END
}

extern "C" void kernel_launch(void* const* d_in, const int* in_sizes, int n_in, void* d_out, int out_size, void* d_ws, size_t ws_size, hipStream_t stream) {
    static int grid = 0;
    if (grid == 0) {
        if (n_in != 16 || in_sizes[0] != MTOK * DM || out_size != MTOK * DM || ws_size < WS_END) { fprintf(stderr, "kernel_launch: unexpected shapes (n_in %d in0 %d out %d ws %zu)\n", n_in, n_in > 0 ? in_sizes[0] : -1, out_size, ws_size); grid = -1; return; }
        int dev = 0, cus = 0;
        if (hipGetDevice(&dev) != hipSuccess || hipDeviceGetAttribute(&cus, hipDeviceAttributeMultiprocessorCount, dev) != hipSuccess || cus <= 0) cus = 256;
        if (hipFuncSetAttribute((const void*)hymba_fwd, hipFuncAttributeMaxDynamicSharedMemorySize, LDS_BYTES) != hipSuccess) { fprintf(stderr, "kernel_launch: hipFuncSetAttribute failed\n"); grid = -1; return; }
        (void)hipGetLastError();
        grid = cus;
    }
    if (grid < 0) return;
    if (hipMemsetAsync((char*)d_ws + WS_CTL, 0, CTL_ZERO_BYTES, stream) != hipSuccess) { fprintf(stderr, "kernel_launch: memset failed\n"); return; }
    Args a{};
    a.x = (const float*)d_in[0]; a.norm1_w = (const float*)d_in[1]; a.w_in = (const float*)d_in[2]; a.conv_w = (const float*)d_in[3]; a.conv_b = (const float*)d_in[4];
    a.igate_b = (const float*)d_in[5]; a.fgate_b = (const float*)d_in[6]; a.q_norm_w = (const float*)d_in[7]; a.k_norm_w = (const float*)d_in[8];
    a.mlstm_norm_w = (const float*)d_in[9]; a.attn_norm_w = (const float*)d_in[10]; a.w_out = (const float*)d_in[11]; a.norm2_w = (const float*)d_in[12];
    a.w_gate = (const float*)d_in[13]; a.w_up = (const float*)d_in[14]; a.w_down = (const float*)d_in[15];
    a.out = (float*)d_out; a.ws = (unsigned char*)d_ws; a.dry = (PROBE_PHASE >= 0) ? 1 : 0;
    hipLaunchKernelGGL(hymba_fwd, dim3(grid), dim3(NWAVES * 64), LDS_BYTES, stream, a);
}
```

```cpp
#include <hip/hip_runtime.h>
#include <cstdio>
#include <cstdint>

#define LAS __attribute__((address_space(3)))
#define GAS __attribute__((address_space(1)))
typedef unsigned short bf16;
typedef short bf16x8 __attribute__((ext_vector_type(8)));
typedef short s16x4 __attribute__((ext_vector_type(4)));
typedef float f32x4 __attribute__((ext_vector_type(4)));
typedef float f32x2 __attribute__((ext_vector_type(2)));
typedef unsigned u32x4 __attribute__((ext_vector_type(4)));
typedef unsigned u32x2 __attribute__((ext_vector_type(2)));
typedef __bf16 bf16x2_t __attribute__((ext_vector_type(2)));

constexpr int BATCH = 2, SEQ = 4096, DM = 2048, MTOK = BATCH * SEQ;
constexpr int INW = 6152, NPROJ = 6144, DFF = 5632, NGU = 2 * DFF;
constexpr int PC_MQ = 0, PC_MK = 512, PC_MO = 1024, PC_MV = 2048, PC_AQ = 3072, PC_AK = 4096, PC_AV = 5120;
constexpr float NORM_EPS = 1e-6f;
constexpr int NWAVES = 8;

constexpr size_t MiB = 1u << 20;
constexpr size_t WS_CTL = 0, CTL_ZERO_BYTES = 1 * MiB;
constexpr size_t WS_GLI = 1 * MiB;
constexpr size_t WS_GLF = WS_GLI + 128 * 1024;
constexpr size_t WS_SUMSQ = WS_GLF + 128 * 1024;
constexpr size_t WS_MSC = WS_SUMSQ + 32 * 1024;
constexpr size_t WS_NC = WS_MSC + 8 * 1024;
constexpr size_t WS_COS = 2 * MiB, WS_SIN = 3 * MiB;
constexpr size_t WS_WIN = 6 * MiB;
constexpr size_t WS_KV = 6 * MiB;
constexpr size_t WS_U = 30 * MiB;
constexpr size_t WS_PROJ = 62 * MiB;
constexpr size_t WS_WOUT = 158 * MiB;
constexpr size_t WS_WGU = 166 * MiB;
constexpr size_t WS_WDN = 210 * MiB;
constexpr size_t WS_OP0 = 38 * MiB;
constexpr size_t WS_OP1 = 232 * MiB;
constexpr size_t WS_PL0 = 248 * MiB, WS_PL1 = WS_PL0 + 256 * 1024;
constexpr size_t WS_END = 249 * MiB;
constexpr int CW_BAR = 4096;

constexpr int RING_BYTES = 131072;
constexpr int MISC_OFF = RING_BYTES;
constexpr int LDS_BYTES = 147456;

__device__ __forceinline__ unsigned cvtpk(float lo, float hi) { f32x2 v = {lo, hi}; bf16x2_t b = __builtin_convertvector(v, bf16x2_t); return __builtin_bit_cast(unsigned, b); }
__device__ __forceinline__ float bf_lo(unsigned w) { return __uint_as_float(w << 16); }
__device__ __forceinline__ float bf_hi(unsigned w) { return __uint_as_float(w & 0xffff0000u); }
__device__ __forceinline__ void unpack8(u32x4 w, float* f) { f[0] = bf_lo(w.x); f[1] = bf_hi(w.x); f[2] = bf_lo(w.y); f[3] = bf_hi(w.y); f[4] = bf_lo(w.z); f[5] = bf_hi(w.z); f[6] = bf_lo(w.w); f[7] = bf_hi(w.w); }
__device__ __forceinline__ u32x4 pack8(const float* f) { u32x4 w; w.x = cvtpk(f[0], f[1]); w.y = cvtpk(f[2], f[3]); w.z = cvtpk(f[4], f[5]); w.w = cvtpk(f[6], f[7]); return w; }
__device__ __forceinline__ float wave_sum(float v) {
#pragma unroll
    for (int o = 1; o < 64; o <<= 1) v += __shfl_xor(v, o);
    return v;
}
__device__ __forceinline__ float wave_max(float v) {
#pragma unroll
    for (int o = 1; o < 64; o <<= 1) v = fmaxf(v, __shfl_xor(v, o));
    return v;
}
__device__ __forceinline__ s16x4 vtr(const LAS unsigned char* p) { return __builtin_bit_cast(s16x4, __builtin_amdgcn_ds_read_tr16_b64_v4i16((LAS s16x4*)p)); }
__device__ __forceinline__ bf16x8 cat4(s16x4 a, s16x4 b) { return (bf16x8){a[0], a[1], a[2], a[3], b[0], b[1], b[2], b[3]}; }
#define LDS_WAIT() asm volatile("s_waitcnt lgkmcnt(0)" ::: "memory")
#define VM_WAIT() asm volatile("s_waitcnt vmcnt(0)" ::: "memory")
#define SBAR() __builtin_amdgcn_sched_barrier(0)
#define MFMA16(a, b, c) __builtin_amdgcn_mfma_f32_16x16x32_bf16((a), (b), (c), 0, 0, 0)

namespace pg8 {
constexpr int BM = 256, BK = 64, HALF = 128, HTB = HALF * BK * 2, STAGE_BYTES = 8 * HTB, NXCD = 8, WGM = 8;
__host__ __device__ __forceinline__ int lds_byte(int r, int c) { const int st = (r >> 4) * 2 + (c >> 5), rr = r & 15, cc = c & 31, ob = rr * 64 + cc * 2; return st * 1024 + (ob ^ (((ob >> 9) & 1) << 5)); }
__host__ __device__ __forceinline__ void stage_rc(int b, int& R, int& C) { const int st = b / 1024, sb = b % 1024, swz = sb ^ (((sb >> 9) & 1) << 5); R = (st >> 1) * 16 + swz / 64; C = (st & 1) * 32 + (swz % 64) / 2; }
__host__ __device__ __forceinline__ int perm32(int rho) { const int n = rho >> 4, i = rho & 15; return 8 * (i >> 2) + 4 * n + (i & 3); }
struct Unit { int pm, pn; };
struct Gemm { const bf16* A; const bf16* Bt; int M, N, K, lda; };
struct StaticOrder {
    int nM, nN, nwg, G, c;
    __device__ void init(int M, int N, int G_, int c_) { nM = M / BM; nN = N / BM; nwg = nM * nN; G = G_; c = c_; }
    __device__ bool next(int i, Unit& u) const {
        const long L = (long)i * G + c; if (L >= nwg) return false;
        int wgid = (int)L; { const int q = nwg / NXCD, r = nwg % NXCD, xcd = wgid % NXCD, off = wgid / NXCD; wgid = (xcd < r ? xcd * (q + 1) : r * (q + 1) + (xcd - r) * q) + off; }
        const int nig = WGM * nN, gid = wgid / nig, fm = gid * WGM, gsz = (nM - fm) < WGM ? (nM - fm) : WGM;
        u.pm = fm + ((wgid % nig) % gsz); u.pn = (wgid % nig) / gsz; return true;
    }
};
struct EpiBf16 {
    static constexpr bool PERM = true, HAS_INIT = false;
    bf16* O; int ldc;
    __device__ __forceinline__ void operator()(const f32x4 (&acc)[2][2][4][2], const Unit& u, int wr, int wc, int fr, int fq) const {
        const int row0 = u.pm * BM + wr * 64 + fr, col0 = u.pn * BM + wc * 32 + 8 * fq;
#pragma unroll
        for (int ai = 0; ai < 2; ++ai)
#pragma unroll
            for (int m = 0; m < 4; ++m) { bf16* rowp = O + (size_t)(row0 + ai * HALF + m * 16) * ldc + col0;
#pragma unroll
                for (int bj = 0; bj < 2; ++bj) { const f32x4 v0 = acc[ai][bj][m][0], v1 = acc[ai][bj][m][1];
                    u32x4 w; w.x = cvtpk(v0[0], v0[1]); w.y = cvtpk(v0[2], v0[3]); w.z = cvtpk(v1[0], v1[1]); w.w = cvtpk(v1[2], v1[3]);
                    *(u32x4*)(rowp + bj * HALF) = w; } }
    }
};
struct EpiRes1 {
    static constexpr bool PERM = false, HAS_INIT = true;
    const float* xres; float* out; bf16* h1b; float* sumsq; int ldc; bool dry;
    __device__ __forceinline__ void init(f32x4 (&acc)[2][2][4][2], const Unit& u, int wr, int wc, int fr, int fq) const {
        const int col0 = u.pn * BM + wc * 32 + 4 * fq;
#pragma unroll
        for (int ai = 0; ai < 2; ++ai)
#pragma unroll
            for (int m = 0; m < 4; ++m) { const size_t off = (size_t)(u.pm * BM + ai * HALF + wr * 64 + m * 16 + fr) * ldc + col0;
#pragma unroll
                for (int bj = 0; bj < 2; ++bj)
#pragma unroll
                    for (int n = 0; n < 2; ++n) acc[ai][bj][m][n] = *(const f32x4*)(xres + off + bj * HALF + n * 16); }
    }
    __device__ __forceinline__ void operator()(const f32x4 (&acc)[2][2][4][2], const Unit& u, int wr, int wc, int fr, int fq) const {
        const int col0 = u.pn * BM + wc * 32 + 4 * fq;
#pragma unroll
        for (int ai = 0; ai < 2; ++ai)
#pragma unroll
            for (int m = 0; m < 4; ++m) { const int row = u.pm * BM + ai * HALF + wr * 64 + m * 16 + fr; const size_t off = (size_t)row * ldc + col0; float ss = 0.f;
#pragma unroll
                for (int bj = 0; bj < 2; ++bj)
#pragma unroll
                    for (int n = 0; n < 2; ++n) { const size_t o2 = off + bj * HALF + n * 16; const f32x4 h = acc[ai][bj][m][n];
                        u32x2 w; w.x = cvtpk(h[0], h[1]); w.y = cvtpk(h[2], h[3]); if (!dry) { *(f32x4*)(out + o2) = h; *(u32x2*)(h1b + o2) = w; }
                        ss += (h[0] * h[0] + h[1] * h[1]) + (h[2] * h[2] + h[3] * h[3]); }
                ss += __shfl_xor(ss, 16); ss += __shfl_xor(ss, 32);
                if (fq == 0 && !dry) atomicAdd(sumsq + row, ss); }
    }
};
struct EpiSwiGLU {
    static constexpr bool PERM = true, HAS_INIT = false;
    bf16* O; int ldc; const float* sumsq;
    __device__ __forceinline__ void operator()(const f32x4 (&acc)[2][2][4][2], const Unit& u, int wr, int wc, int fr, int fq) const {
        const int col0 = u.pn * HALF + wc * 32 + 8 * fq;
#pragma unroll
        for (int ai = 0; ai < 2; ++ai)
#pragma unroll
            for (int m = 0; m < 4; ++m) { const int row = u.pm * BM + ai * HALF + wr * 64 + m * 16 + fr;
                const float rs = 1.0f / sqrtf(sumsq[row] * (1.0f / DM) + NORM_EPS);
                float f[8];
#pragma unroll
                for (int n = 0; n < 2; ++n)
#pragma unroll
                    for (int j = 0; j < 4; ++j) { const float g = acc[ai][0][m][n][j] * rs, up = acc[ai][1][m][n][j] * rs; f[n * 4 + j] = g / (1.0f + __expf(-g)) * up; }
                *(u32x4*)(O + (size_t)row * ldc + col0) = pack8(f); }
    }
};
struct EpiRes2 {
    static constexpr bool PERM = false, HAS_INIT = true;
    float* out; int ldc; bool dry;
    __device__ __forceinline__ void init(f32x4 (&acc)[2][2][4][2], const Unit& u, int wr, int wc, int fr, int fq) const {
        const int col0 = u.pn * BM + wc * 32 + 4 * fq;
#pragma unroll
        for (int ai = 0; ai < 2; ++ai)
#pragma unroll
            for (int m = 0; m < 4; ++m) { const size_t off = (size_t)(u.pm * BM + ai * HALF + wr * 64 + m * 16 + fr) * ldc + col0;
#pragma unroll
                for (int bj = 0; bj < 2; ++bj)
#pragma unroll
                    for (int n = 0; n < 2; ++n) acc[ai][bj][m][n] = *(const f32x4*)(out + off + bj * HALF + n * 16); }
    }
    __device__ __forceinline__ void operator()(const f32x4 (&acc)[2][2][4][2], const Unit& u, int wr, int wc, int fr, int fq) const {
        const int col0 = u.pn * BM + wc * 32 + 4 * fq;
#pragma unroll
        for (int ai = 0; ai < 2; ++ai)
#pragma unroll
            for (int m = 0; m < 4; ++m) { const size_t off = (size_t)(u.pm * BM + ai * HALF + wr * 64 + m * 16 + fr) * ldc + col0;
#pragma unroll
                for (int bj = 0; bj < 2; ++bj)
#pragma unroll
                    for (int n = 0; n < 2; ++n) { if (!dry) *(f32x4*)(out + off + bj * HALF + n * 16) = acc[ai][bj][m][n]; } }
    }
};

template <class Epi, bool ALIGN_EPI>
__device__ __forceinline__ void gemm_phase(LAS unsigned char* lds, const Gemm g, const StaticOrder& S, const Epi& E) {
    int tid = threadIdx.x; asm volatile("" : "+v"(tid));
    const int wid = __builtin_amdgcn_readfirstlane(tid >> 6), lane = tid & 63, wr = wid >> 2, wc = wid & 3, fr = lane & 15, fq = lane >> 4;
    const int K = g.K, nt = K / BK;
    unsigned voffA[2], voffB[2];
#pragma unroll
    for (int i = 0; i < 2; ++i) { int R, C; stage_rc(tid * 16 + i * 8192, R, C); const int Rb = Epi::PERM ? ((R & ~31) + perm32(R & 31)) : R;
        voffA[i] = (unsigned)(R * g.lda + C) * 2u; voffB[i] = (unsigned)(Rb * K + C) * 2u; }
    const size_t kstep = (size_t)(BK * 2);
    const size_t hstepA = (size_t)HALF * g.lda * 2, hstepB = (size_t)HALF * K * 2;
    const size_t tstepA = 2 * hstepA, tstepB = 2 * hstepB;
    const unsigned ldsw = (unsigned)wid * 1024u;
    const int aoff = lds_byte(wr * 64 + fr, fq * 8), boff = lds_byte(wc * 32 + fr, fq * 8);
#define PG8_SA(b, h) (((b) * 2 + (h)) * HTB)
#define PG8_SB(b, h) ((4 + (b) * 2 + (h)) * HTB)
#define PG8_STAGE(bufoff, gbase, voff) do { _Pragma("unroll") for (int _i = 0; _i < 2; ++_i) \
        __builtin_amdgcn_global_load_lds((const unsigned*)((const char*)(gbase) + (voff)[_i]), (LAS unsigned*)(lds + (bufoff) + ldsw + _i * 8192), 16, 0, 0); } while (0)
#define PG8_LDA(dst, b, h) do { _Pragma("unroll") for (int m = 0; m < 4; ++m) _Pragma("unroll") for (int k = 0; k < 2; ++k) dst[m][k] = *(const LAS bf16x8*)(lds + PG8_SA(b, h) + aoff + m * 2048 + k * 1024); } while (0)
#define PG8_LDB(dst, b, h) do { _Pragma("unroll") for (int n = 0; n < 2; ++n) _Pragma("unroll") for (int k = 0; k < 2; ++k) dst[n][k] = *(const LAS bf16x8*)(lds + PG8_SB(b, h) + boff + n * 2048 + k * 1024); } while (0)
#define PG8_MMA(ai, bj, At, Bt) do { __builtin_amdgcn_s_setprio(1); _Pragma("unroll") for (int m = 0; m < 4; ++m) _Pragma("unroll") for (int n = 0; n < 2; ++n) _Pragma("unroll") for (int k = 0; k < 2; ++k) \
        acc[ai][bj][m][n] = __builtin_amdgcn_mfma_f32_16x16x32_bf16(Bt[n][k], At[m][k], acc[ai][bj][m][n], 0, 0, 0); __builtin_amdgcn_s_setprio(0); } while (0)
#define PG8_WAIT_V(n) asm volatile("s_waitcnt vmcnt(" #n ")" ::: "memory")
#define PG8_WAIT_L(n) asm volatile("s_waitcnt lgkmcnt(" #n ")" ::: "memory")
#define PG8_BAR __builtin_amdgcn_s_barrier()
#define PG8_SCHED __builtin_amdgcn_sched_barrier(0)
    Unit cur, nxt; int ui = 0;
    if (!S.next(0, cur)) return;
    f32x4 acc[2][2][4][2];
    if constexpr (Epi::HAS_INIT) { E.init(acc, cur, wr, wc, fr, fq); }
    else {
#pragma unroll
    for (int a = 0; a < 2; ++a)
#pragma unroll
        for (int b = 0; b < 2; ++b)
#pragma unroll
            for (int m = 0; m < 4; ++m)
#pragma unroll
                for (int n = 0; n < 2; ++n) acc[a][b][m][n] = (f32x4){0.f, 0.f, 0.f, 0.f};
    }
    bf16x8 At[4][2], B0[2][2], B1[2][2];
    const char* cA = (const char*)g.A + (size_t)cur.pm * tstepA; const char* cB = (const char*)g.Bt + (size_t)cur.pn * tstepB;
    PG8_STAGE(PG8_SB(0, 0), cB, voffB); PG8_STAGE(PG8_SB(0, 1), cB + hstepB, voffB); PG8_STAGE(PG8_SA(0, 0), cA, voffA); PG8_STAGE(PG8_SA(0, 1), cA + hstepA, voffA);
    if (wr == 1) PG8_BAR;
    PG8_WAIT_V(2); PG8_BAR;
    PG8_STAGE(PG8_SB(1, 0), cB + kstep, voffB); PG8_STAGE(PG8_SA(1, 0), cA + kstep, voffA); PG8_STAGE(PG8_SB(1, 1), cB + hstepB + kstep, voffB);
    PG8_WAIT_V(6); PG8_BAR;
    for (;;) {
        const bool has_next = S.next(ui + 1, nxt);
        const char* nA = has_next ? (const char*)g.A + (size_t)nxt.pm * tstepA : cA; const char* nB = has_next ? (const char*)g.Bt + (size_t)nxt.pn * tstepB : cB;
        for (int t = 0; t < nt; t += 2) {
            const bool last = (t == nt - 2);
            const char* a1 = cA + (size_t)(t + 1) * kstep;
            const char* a2 = last ? nA : cA + (size_t)(t + 2) * kstep; const char* b2 = last ? nB : cB + (size_t)(t + 2) * kstep;
            const char* a3 = a2 + kstep; const char* b3 = b2 + kstep;
            PG8_LDB(B0, 0, 0); PG8_LDB(B1, 0, 1); PG8_SCHED; PG8_LDA(At, 0, 0); PG8_STAGE(PG8_SA(1, 1), a1 + hstepA, voffA);
            PG8_WAIT_V(8); PG8_WAIT_L(0); PG8_BAR; PG8_MMA(0, 0, At, B0); PG8_MMA(0, 1, At, B1); PG8_BAR; PG8_SCHED;
            PG8_LDA(At, 0, 1); PG8_STAGE(PG8_SB(0, 0), b2, voffB); PG8_STAGE(PG8_SB(0, 1), b2 + hstepB, voffB); PG8_STAGE(PG8_SA(0, 0), a2, voffA);
            PG8_WAIT_V(8); PG8_WAIT_L(0); PG8_BAR; PG8_MMA(1, 0, At, B0); PG8_MMA(1, 1, At, B1); PG8_BAR; PG8_SCHED;
            PG8_LDB(B0, 1, 0); PG8_LDB(B1, 1, 1); PG8_SCHED; PG8_LDA(At, 1, 0); PG8_STAGE(PG8_SA(0, 1), a2 + hstepA, voffA);
            PG8_WAIT_V(8); PG8_WAIT_L(0); PG8_BAR; PG8_MMA(0, 0, At, B0); PG8_MMA(0, 1, At, B1); PG8_BAR; PG8_SCHED;
            PG8_LDA(At, 1, 1); PG8_STAGE(PG8_SB(1, 0), b3, voffB); PG8_STAGE(PG8_SB(1, 1), b3 + hstepB, voffB); PG8_STAGE(PG8_SA(1, 0), a3, voffA);
            PG8_WAIT_V(8); PG8_WAIT_L(0); PG8_BAR; PG8_MMA(1, 0, At, B0); PG8_MMA(1, 1, At, B1); PG8_BAR; PG8_SCHED;
        }
        if constexpr (ALIGN_EPI) { if (wr == 0) PG8_BAR; }
        E(acc, cur, wr, wc, fr, fq);
        if (!has_next) break;
        if constexpr (Epi::HAS_INIT) { E.init(acc, nxt, wr, wc, fr, fq); }
        else {
#pragma unroll
        for (int a = 0; a < 2; ++a)
#pragma unroll
            for (int b = 0; b < 2; ++b)
#pragma unroll
                for (int m = 0; m < 4; ++m)
#pragma unroll
                    for (int n = 0; n < 2; ++n) acc[a][b][m][n] = (f32x4){0.f, 0.f, 0.f, 0.f};
        }
        cur = nxt; cA = nA; cB = nB; ++ui;
        if constexpr (ALIGN_EPI) { if (wr == 1) PG8_BAR; }
    }
    PG8_WAIT_V(0);
    if constexpr (!ALIGN_EPI) { if (wr == 0) PG8_BAR; }
    PG8_BAR;
#undef PG8_SA
#undef PG8_SB
#undef PG8_STAGE
#undef PG8_LDA
#undef PG8_LDB
#undef PG8_MMA
#undef PG8_WAIT_V
#undef PG8_WAIT_L
#undef PG8_BAR
#undef PG8_SCHED
}
}

#define XB_TMO      128
#define XB_XCNT(j)  (256  + 64 * (j))
#define XB_XSUB(j)  (1280 + 64 * (j))
#define XB_XGEN(j)  (2304 + 64 * (j))
#define XB_TOP      3328
#define XB_TOPGEN   3392
#define XCD_BAR_WORDS 3456
#define XB_SPIN_CAP (1u << 18)
__device__ __forceinline__ unsigned xb_ld(unsigned* p)              { return __hip_atomic_load(p, __ATOMIC_RELAXED, __HIP_MEMORY_SCOPE_AGENT); }
__device__ __forceinline__ unsigned xb_add(unsigned* p, unsigned v) { return __hip_atomic_fetch_add(p, v, __ATOMIC_RELAXED, __HIP_MEMORY_SCOPE_AGENT); }
__device__ __forceinline__ unsigned xb_xcc_id() { return (unsigned)__builtin_amdgcn_s_getreg((3 << 11) | 20) & 0xFu; }
#define XB_SPIN(cond, bar) do { unsigned _sp = 0; while (cond) { __builtin_amdgcn_s_sleep(1); \
    if ((++_sp & 255u) == 0u) { if (xb_ld(&(bar)[XB_TMO])) break; if (_sp > XB_SPIN_CAP) { atomicAdd(&(bar)[XB_TMO], 1u); break; } } } } while (0)
struct XcdBarrier { unsigned* bar; unsigned x; volatile LAS unsigned* st; };
__device__ __forceinline__ XcdBarrier xcd_barrier_post(unsigned* bar, volatile LAS unsigned* st) {
    XcdBarrier b; b.bar = bar; b.x = xb_xcc_id(); b.st = st;
    if (threadIdx.x == 0) (void)xb_add(&bar[XB_XCNT(b.x)], 1u);
    return b;
}
__device__ __forceinline__ void xcd_barrier_complete(unsigned* bar, unsigned x, unsigned& nloc, unsigned& nx) {
    const unsigned G = gridDim.x * gridDim.y * gridDim.z;
    unsigned sum, cnt, mine, sp = 0u;
    for (;;) {
        sum = 0u; cnt = 0u; mine = 0u;
#pragma unroll
        for (unsigned j = 0; j < 16; ++j) { const unsigned c = xb_ld(&bar[XB_XCNT(j)]); sum += c; cnt += (c > 0u) ? 1u : 0u; mine = (j == x) ? c : mine; }
        if (sum == G) break;
        __builtin_amdgcn_s_sleep(1);
        if ((++sp & 255u) == 0u) { if (xb_ld(&bar[XB_TMO])) break; if (sp > XB_SPIN_CAP) { atomicAdd(&bar[XB_TMO], 1u); break; } }
    }
    nloc = mine > 0u ? mine : 1u; nx = cnt > 0u ? cnt : 1u;
}
__device__ __forceinline__ void xcd_barrier(const XcdBarrier& b) {
    asm volatile("s_waitcnt vmcnt(0)" ::: "memory");
    __syncthreads();
    if (threadIdx.x == 0) {
        unsigned* bar = b.bar;
        __builtin_amdgcn_s_waitcnt(0);
        unsigned nloc = b.st[0], nx = b.st[1];
        if (nloc == 0u) { xcd_barrier_complete(bar, b.x, nloc, nx); b.st[0] = nloc; b.st[1] = nx; }
        const unsigned old = xb_add(&bar[XB_XSUB(b.x)], 1u);
        const unsigned gen = old / nloc;
        if (old + 1u == (gen + 1u) * nloc) {
            __builtin_amdgcn_fence(__ATOMIC_RELEASE, "agent");
            asm volatile("s_waitcnt vmcnt(0)" ::: "memory");
            const unsigned og = xb_add(&bar[XB_TOP], 1u);
            const unsigned tg = og / nx;
            if (og + 1u == (tg + 1u) * nx) xb_add(&bar[XB_TOPGEN], 1u);
            else XB_SPIN(xb_ld(&bar[XB_TOPGEN]) == tg, bar);
            __builtin_amdgcn_fence(__ATOMIC_ACQUIRE, "agent");
            xb_add(&bar[XB_XGEN(b.x)], 1u);
            asm volatile("s_waitcnt vmcnt(0)" ::: "memory");
        } else {
            XB_SPIN(xb_ld(&bar[XB_XGEN(b.x)]) == gen, bar);
            __builtin_amdgcn_fence(__ATOMIC_ACQUIRE, "agent");
            asm volatile("s_waitcnt vmcnt(0)" ::: "memory");
        }
    }
    __syncthreads();
}

struct Args {
    const float* x; const float* norm1_w; const float* w_in; const float* conv_w; const float* conv_b; const float* igate_b; const float* fgate_b;
    const float* q_norm_w; const float* k_norm_w; const float* mlstm_norm_w; const float* attn_norm_w; const float* w_out; const float* norm2_w;
    const float* w_gate; const float* w_up; const float* w_down;
    float* out; unsigned char* ws; int dry; int pad;
};

struct TItem { const float* W; bf16* WT; const float* kscale; int ldw, K, nsrc0, ndst0, k0; };
__device__ __forceinline__ void titem_load(const TItem& t, f32x4 (&v)[8], int lane) {
    const float* src = t.W + (size_t)(t.k0 + (lane >> 3)) * t.ldw + t.nsrc0 + (lane & 7) * 4;
#pragma unroll
    for (int i = 0; i < 8; ++i) v[i] = *(const f32x4*)(src + (size_t)(8 * i) * t.ldw);
}
__device__ __forceinline__ void titem_finish(const TItem& t, const f32x4 (&v)[8], LAS float* scr, int lane) {
#pragma unroll
    for (int i = 0; i < 8; ++i) { const int kk = 8 * i + (lane >> 3); const float sc = t.kscale ? t.kscale[t.k0 + kk] : 1.0f; LAS float* d = scr + kk * 33 + (lane & 7) * 4;
        d[0] = v[i][0] * sc; d[1] = v[i][1] * sc; d[2] = v[i][2] * sc; d[3] = v[i][3] * sc; }
    LDS_WAIT(); asm volatile("" ::: "memory");
    const int c = lane & 7;
#pragma unroll
    for (int j = 0; j < 4; ++j) { const int n = (lane >> 3) + 8 * j; const LAS float* s = scr + (8 * c) * 33 + n;
        u32x4 o; o.x = cvtpk(s[0 * 33], s[1 * 33]); o.y = cvtpk(s[2 * 33], s[3 * 33]); o.z = cvtpk(s[4 * 33], s[5 * 33]); o.w = cvtpk(s[6 * 33], s[7 * 33]);
        *(u32x4*)(t.WT + (size_t)(t.ndst0 + n) * t.K + t.k0 + 8 * c) = o; }
    LDS_WAIT(); asm volatile("" ::: "memory");
}
__device__ __forceinline__ int win_src_col(int nd) {
    if (nd < 1024) return nd;
    if (nd < 2048) return nd + 1024;
    if (nd < 3072) return nd - 1024;
    return nd + 8;
}


__device__ __forceinline__ float scan_add64(float v, int lane) {
#pragma unroll
    for (int o = 1; o < 64; o <<= 1) { const float t = __shfl_up(v, o); if (lane >= o) v += t; }
    return v;
}
__device__ __forceinline__ float scan_max64(float v, int lane) {
#pragma unroll
    for (int o = 1; o < 64; o <<= 1) { const float t = __shfl_up(v, o); if (lane >= o) v = fmaxf(v, t); }
    return v;
}
template <bool ROWW>
__device__ __forceinline__ void conv_tile(const bf16* proj, const float* conv_w, const float* conv_b, int b, int c, int col0, int ch0, float rscale, float wlane, LAS unsigned char* tile, int tid) {
    const int rr = tid >> 4, cc = (tid & 15) * 8;
    float w[4][8], bb[8];
#pragma unroll
    for (int j = 0; j < 4; ++j) { const f32x4 w0 = *(const f32x4*)(conv_w + j * 1024 + ch0 + cc), w1 = *(const f32x4*)(conv_w + j * 1024 + ch0 + cc + 4);
        w[j][0] = w0[0]; w[j][1] = w0[1]; w[j][2] = w0[2]; w[j][3] = w0[3]; w[j][4] = w1[0]; w[j][5] = w1[1]; w[j][6] = w1[2]; w[j][7] = w1[3]; }
    { const f32x4 b0 = *(const f32x4*)(conv_b + ch0 + cc), b1 = *(const f32x4*)(conv_b + ch0 + cc + 4);
      bb[0] = b0[0]; bb[1] = b0[1]; bb[2] = b0[2]; bb[3] = b0[3]; bb[4] = b1[0]; bb[5] = b1[1]; bb[6] = b1[2]; bb[7] = b1[3]; }
#pragma unroll
    for (int half = 0; half < 2; ++half) {
        const int l = rr + 32 * half, t = c * 64 + l;
        float y[8];
#pragma unroll
        for (int e = 0; e < 8; ++e) y[e] = bb[e];
#pragma unroll
        for (int j = 0; j < 4; ++j) { const int tt = t - 3 + j;
            if (tt >= 0) { const u32x4 raw = *(const u32x4*)(proj + (size_t)(b * SEQ + tt) * NPROJ + col0 + cc); float x[8]; unpack8(raw, x);
#pragma unroll
                for (int e = 0; e < 8; ++e) y[e] += w[j][e] * x[e]; } }
        float sc = rscale;
        if (ROWW) sc *= __shfl(wlane, l);
#pragma unroll
        for (int e = 0; e < 8; ++e) y[e] = y[e] / (1.0f + __expf(-y[e])) * sc;
        *(LAS u32x4*)(tile + l * 288 + cc * 2) = pack8(y);
    }
}
__device__ __forceinline__ void v_tile(const bf16* proj, int b, int c, int h, LAS unsigned char* tile, int tid) {
#pragma unroll
    for (int p = 0; p < 4; ++p) { const int row = p * 16 + (tid >> 5), ch = tid & 31;
        const u32x4 v = *(const u32x4*)(proj + (size_t)(b * SEQ + c * 64 + row) * NPROJ + PC_MV + h * 256 + ch * 8);
        *(LAS u32x4*)(tile + row * 544 + ch * 16) = v; }
}

__device__ __forceinline__ void q_prep(const bf16* qrow, const float* rcos, const float* rsin, const float* qnw, int tq, int g, bf16x8 (&qf)[4]) {
    float q[4][8]; float ss = 0.f;
#pragma unroll
    for (int ks = 0; ks < 4; ++ks) { const u32x4 raw = *(const u32x4*)(qrow + 32 * ks + 8 * g); unpack8(raw, q[ks]);
#pragma unroll
        for (int e = 0; e < 8; ++e) ss += q[ks][e] * q[ks][e]; }
    ss += __shfl_xor(ss, 16); ss += __shfl_xor(ss, 32);
    const float rq = 1.0f / sqrtf(ss * (1.0f / 128.0f) + NORM_EPS);
#pragma unroll
    for (int ks = 0; ks < 2; ++ks) {
        const int c0 = 32 * ks + 8 * g;
#pragma unroll
        for (int e4 = 0; e4 < 2; ++e4) {
            const f32x4 cs = *(const f32x4*)(rcos + tq * 64 + c0 + 4 * e4), sn = *(const f32x4*)(rsin + tq * 64 + c0 + 4 * e4);
            const f32x4 w1 = *(const f32x4*)(qnw + c0 + 4 * e4), w2 = *(const f32x4*)(qnw + 64 + c0 + 4 * e4);
#pragma unroll
            for (int e = 0; e < 4; ++e) { const float y1 = q[ks][4 * e4 + e] * rq * w1[e], y2 = q[ks + 2][4 * e4 + e] * rq * w2[e];
                q[ks][4 * e4 + e] = y1 * cs[e] - y2 * sn[e]; q[ks + 2][4 * e4 + e] = y2 * cs[e] + y1 * sn[e]; }
        }
    }
#pragma unroll
    for (int ks = 0; ks < 4; ++ks) { const u32x4 w = pack8(q[ks]); qf[ks] = __builtin_bit_cast(bf16x8, w); }
}
struct AUnit { int b, h, d, r, n; bf16* po0; float* pl0; };
template <bool FINAL>
__device__ __forceinline__ void attn_pair(bf16* proj, const float* rcos, const float* rsin, const float* qnw, const float* anw, const AUnit& ua, const AUnit& ub,
                                          LAS unsigned char* lds_all, bf16* po1, float* pl1, int tid_in, bool dry) {
    int tid = tid_in; asm volatile("" : "+v"(tid));
    const int lane = tid & 63, wave = __builtin_amdgcn_readfirstlane(tid >> 6);
    const int team = wave >> 2, w4 = wave & 3;
    const int b = team ? ub.b : ua.b, h = team ? ub.h : ua.h, d = team ? ub.d : ua.d, r = team ? ub.r : ua.r, n = team ? ub.n : ua.n;
    bf16* po0 = team ? ub.po0 : ua.po0; float* pl0 = team ? ub.pl0 : ua.pl0;
    LAS unsigned char* lds = lds_all + team * 36864;
    const int j = lane & 15, g = lane >> 4, qp = j >> 2, p = lane & 3;
    const int tt = tid & 255, srow = tt >> 4, sch = tt & 15;
    const bf16* kcol = proj + (size_t)b * SEQ * NPROJ + PC_AK + h * 128 + sch * 8;
    const bf16* vcol = kcol + (PC_AV - PC_AK);
    const int kt0 = (n == 0) ? 4 : 0;
    const int sub0 = 128 * (n - 1) + srow;
    u32x4 rk[2][2], rv[2][2];
#define AT_ISSUE(set, t) do { if ((t) < 8) { _Pragma("unroll") for (int hh_ = 0; hh_ < 2; ++hh_) { const size_t tok_ = (size_t)((sub0 + 32 * (t) + 16 * hh_) * d + r); \
        rk[set][hh_] = *(const u32x4*)(kcol + tok_ * NPROJ); rv[set][hh_] = *(const u32x4*)(vcol + tok_ * NPROJ); } } } while (0)
#define AT_WRITE(set, t) do { LAS unsigned char* Kn_ = lds + ((t) & 1) * 18432; _Pragma("unroll") for (int hh_ = 0; hh_ < 2; ++hh_) { \
        *(LAS u32x4*)(Kn_ + (srow + 16 * hh_) * 288 + sch * 16) = rk[set][hh_]; *(LAS u32x4*)(Kn_ + 9216 + (srow + 16 * hh_) * 288 + sch * 16) = rv[set][hh_]; } } while (0)
#define WG_BAR() do { asm volatile("s_waitcnt lgkmcnt(0)" ::: "memory"); __builtin_amdgcn_s_barrier(); asm volatile("" ::: "memory"); } while (0)
    AT_ISSUE(0, kt0); AT_ISSUE(1, kt0 + 1);
    bf16x8 qf[2][4]; int qi[2]; int tq[2];
    qi[0] = 32 * w4 + j; qi[1] = qi[0] + 16; tq[0] = (128 * n + qi[0]) * d + r; tq[1] = (128 * n + qi[1]) * d + r;
#pragma unroll
    for (int gi = 0; gi < 2; ++gi) { const bf16* qrow = proj + (size_t)(b * SEQ + tq[gi]) * NPROJ + PC_AQ + h * 128 + 8 * g;
#pragma unroll
        for (int ks = 0; ks < 4; ++ks) qf[gi][ks] = *(const bf16x8*)(qrow + 32 * ks); }
    AT_WRITE(0, kt0);
    for (int kb_ = 0; kb_ < kt0; ++kb_) WG_BAR();
    WG_BAR();
    float m_run[2] = {-1e30f, -1e30f}, l_run[2] = {0.f, 0.f};
    f32x4 o[2][8];
#pragma unroll
    for (int gi = 0; gi < 2; ++gi)
#pragma unroll
        for (int nf = 0; nf < 8; ++nf) o[gi][nf] = (f32x4){0.f, 0.f, 0.f, 0.f};
    const float SC = 0.08838834764831845f * 1.4426950408889634f;
    const float NEG = -__builtin_inff();
#define AT_STEP(kt, setn, setw) do { \
        LAS unsigned char* Kt = lds + ((kt) & 1) * 18432; LAS unsigned char* Vt = Kt + 9216; \
        AT_ISSUE(setn, (kt) + 2); \
        if ((kt) >= w4 && (kt) <= w4 + 4) { \
            f32x4 sA[2], sB[2]; sA[0] = (f32x4){0.f, 0.f, 0.f, 0.f}; sA[1] = sA[0]; sB[0] = sA[0]; sB[1] = sA[0]; \
            _Pragma("unroll") for (int ks = 0; ks < 4; ++ks) { \
                const bf16x8 k0 = *(const LAS bf16x8*)(Kt + j * 288 + (32 * ks + 8 * g) * 2), k1 = *(const LAS bf16x8*)(Kt + (16 + j) * 288 + (32 * ks + 8 * g) * 2); \
                sA[0] = MFMA16(k0, qf[0][ks], sA[0]); sB[0] = MFMA16(k1, qf[0][ks], sB[0]); sA[1] = MFMA16(k0, qf[1][ks], sA[1]); sB[1] = MFMA16(k1, qf[1][ks], sB[1]); } \
            bf16x8 pb[2]; \
            _Pragma("unroll") for (int gi = 0; gi < 2; ++gi) { \
                const f32x4 s0 = sA[gi], s1 = sB[gi]; \
                float x[8]; float tmax = NEG; \
                _Pragma("unroll") for (int e = 0; e < 8; ++e) { const int kj = 32 * (kt) + 16 * (e >> 2) + 4 * g + (e & 3); const float sv = (e < 4) ? s0[e & 3] : s1[e & 3]; \
                    const bool valid = (kj >= qi[gi]) && (kj <= qi[gi] + 128); \
                    x[e] = valid ? sv * SC : NEG; tmax = fmaxf(tmax, x[e]); } \
                tmax = fmaxf(tmax, __shfl_xor(tmax, 16)); tmax = fmaxf(tmax, __shfl_xor(tmax, 32)); \
                const float m_new = fmaxf(m_run[gi], tmax); \
                const float alpha = __builtin_amdgcn_exp2f(m_run[gi] - m_new); \
                float ps = 0.f; \
                _Pragma("unroll") for (int e = 0; e < 8; ++e) { x[e] = __builtin_amdgcn_exp2f(x[e] - m_new); ps += x[e]; } \
                l_run[gi] = l_run[gi] * alpha + ps; m_run[gi] = m_new; \
                _Pragma("unroll") for (int nf = 0; nf < 8; ++nf) o[gi][nf] = o[gi][nf] * alpha; \
                const u32x4 pw = pack8(x); pb[gi] = __builtin_bit_cast(bf16x8, pw); } \
            _Pragma("unroll") for (int nf = 0; nf < 8; ++nf) { \
                const s16x4 a0 = vtr(Vt + (4 * g + qp) * 288 + (16 * nf + 4 * p) * 2), a1 = vtr(Vt + (16 + 4 * g + qp) * 288 + (16 * nf + 4 * p) * 2); \
                const bf16x8 vf = cat4(a0, a1); \
                o[0][nf] = MFMA16(vf, pb[0], o[0][nf]); o[1][nf] = MFMA16(vf, pb[1], o[1][nf]); } \
        } \
        if ((kt) + 1 < 8) AT_WRITE(setw, (kt) + 1); \
        WG_BAR(); } while (0)
#pragma unroll 1
    for (int kt = kt0; kt < 8; kt += 2) { AT_STEP(kt, 0, 1); AT_STEP(kt + 1, 1, 0); }
#undef AT_STEP
#undef AT_ISSUE
#undef AT_WRITE
#pragma unroll
    for (int gi = 0; gi < 2; ++gi) {
        float lr = l_run[gi]; lr += __shfl_xor(lr, 16); lr += __shfl_xor(lr, 32);
        const float inv = 1.0f / lr;
        const float lse2 = m_run[gi] + __log2f(lr);
        const size_t trow = (size_t)(b * SEQ + tq[gi]);
        if (!FINAL) {
#pragma unroll
            for (int nf = 0; nf < 8; ++nf) { const f32x4 v = o[gi][nf] * inv; u32x2 ww; ww.x = cvtpk(v[0], v[1]); ww.y = cvtpk(v[2], v[3]);
                if (!dry) *(u32x2*)(po0 + trow * 1024 + h * 128 + 16 * nf + 4 * g) = ww; }
            if (g == 0 && !dry) pl0[trow * 8 + h] = lse2;
        } else {
            bf16* qrow = proj + trow * NPROJ + PC_AQ + h * 128;
            const float l0 = pl0[trow * 8 + h], l1 = pl1[trow * 8 + h];
            const float M = fmaxf(lse2, fmaxf(l0, l1));
            const float w0 = __builtin_amdgcn_exp2f(l0 - M), w1 = __builtin_amdgcn_exp2f(l1 - M), wc = __builtin_amdgcn_exp2f(lse2 - M);
            const float wi_ = 1.0f / (w0 + w1 + wc); const float c0 = w0 * wi_, c1 = w1 * wi_, cc = wc * wi_ * inv;
            float ss = 0.f;
#pragma unroll
            for (int nf = 0; nf < 8; ++nf) { const int e = h * 128 + 16 * nf + 4 * g;
                const u32x2 a0 = *(const u32x2*)(po0 + trow * 1024 + e), a1 = *(const u32x2*)(po1 + trow * 1024 + e);
                f32x4 v = o[gi][nf] * cc;
                v[0] += c0 * bf_lo(a0.x) + c1 * bf_lo(a1.x); v[1] += c0 * bf_hi(a0.x) + c1 * bf_hi(a1.x); v[2] += c0 * bf_lo(a0.y) + c1 * bf_lo(a1.y); v[3] += c0 * bf_hi(a0.y) + c1 * bf_hi(a1.y);
                o[gi][nf] = v; ss += (v[0] * v[0] + v[1] * v[1]) + (v[2] * v[2] + v[3] * v[3]); }
            ss += __shfl_xor(ss, 16); ss += __shfl_xor(ss, 32);
            const float rn = 1.0f / sqrtf(ss * (1.0f / 128.0f) + NORM_EPS);
#pragma unroll
            for (int nf = 0; nf < 8; ++nf) { const int e = 16 * nf + 4 * g; const f32x4 w = *(const f32x4*)(anw + h * 128 + e); const f32x4 v = o[gi][nf] * rn * w;
                u32x2 ww; ww.x = cvtpk(v[0], v[1]); ww.y = cvtpk(v[2], v[3]); if (!dry) *(u32x2*)(qrow + e) = ww; }
        }
    }
}

#ifndef PROBE_PHASE
#define PROBE_PHASE -1
#endif
#define REP_BEGIN(k) for (int rep_ = (PROBE_PHASE == (k)) ? 0 : 1; rep_ < 2; ++rep_) { const bool dry = (rep_ == 0) && (a.dry != 0); (void)dry; \
    int tid = threadIdx.x; asm volatile("" : "+v"(tid)); const int lane = tid & 63, wave = __builtin_amdgcn_readfirstlane(tid >> 6); \
    const int gw = vcu * NWAVES + wave, gt = vcu * (NWAVES * 64) + tid; (void)lane; (void)wave; (void)gw; (void)gt;
#define REP_END }

__global__ void __launch_bounds__(NWAVES * 64, 2) hymba_fwd(Args a) {
    extern __shared__ __attribute__((aligned(16))) unsigned char lds_raw[];
    LAS unsigned char* lds = (LAS unsigned char*)lds_raw;
    volatile LAS unsigned* MISC = (volatile LAS unsigned*)(lds + MISC_OFF);
    const int tid = threadIdx.x, lane = tid & 63, wave = __builtin_amdgcn_readfirstlane(tid >> 6);
    const int G = gridDim.x; const int bx = blockIdx.x; const int vcu = (G % 8 == 0) ? (bx % 8) * (G / 8) + bx / 8 : bx;
    unsigned char* ws = a.ws;
    unsigned* ctl = (unsigned*)(ws + WS_CTL);
    float* gli = (float*)(ws + WS_GLI); float* glf = (float*)(ws + WS_GLF); float* sumsq = (float*)(ws + WS_SUMSQ);
    float* msc_g = (float*)(ws + WS_MSC); float* msc_ml = msc_g + 512; float* msc_mp = msc_g + 1024;
    float* ncb = (float*)(ws + WS_NC);
    float* rcos = (float*)(ws + WS_COS); float* rsin = (float*)(ws + WS_SIN);
    bf16* WinT = (bf16*)(ws + WS_WIN); bf16* kvT = (bf16*)(ws + WS_KV); bf16* Ub = (bf16*)(ws + WS_U); bf16* H1b = (bf16*)(ws + WS_U);
    bf16* proj = (bf16*)(ws + WS_PROJ); bf16* FF = (bf16*)(ws + WS_PROJ);
    bf16* op0 = (bf16*)(ws + WS_OP0); bf16* op1 = (bf16*)(ws + WS_OP1); float* pl0 = (float*)(ws + WS_PL0); float* pl1 = (float*)(ws + WS_PL1);
    bf16* WoutT = (bf16*)(ws + WS_WOUT); bf16* WguT = (bf16*)(ws + WS_WGU); bf16* WdnT = (bf16*)(ws + WS_WDN);

    for (int u = tid; u < (LDS_BYTES - MISC_OFF) / 4; u += NWAVES * 64) ((LAS unsigned*)(lds + MISC_OFF))[u] = 0u;
    __syncthreads();
    XcdBarrier bar = xcd_barrier_post(ctl + CW_BAR, MISC + 8);
    const int NGW = G * NWAVES, NGT = G * NWAVES * 64;

    REP_BEGIN(0)
        for (int i = gt; i < MTOK; i += NGT) sumsq[i] = 0.f;
        for (int i = gt; i < SEQ * 64; i += NGT) {
            const int pos = i >> 6, fi = i & 63;
            const float invf = (float)exp2(-(double)fi * (13.287712379549449 / 64.0));
            const float ang = (float)pos * invf;
            const double rev = (double)ang * 0.15915494309189535; const double fr_ = rev - rint(rev);
            const float ar = (float)(fr_ * 6.283185307179586);
            rcos[i] = cosf(ar); rsin[i] = sinf(ar);
        }
        {
            LAS float* scr = (LAS float*)(lds + wave * 16384);
            constexpr int I_IN = (DM / 64) * (NPROJ / 32), I_OUT = (DM / 64) * (DM / 32), I_GU = (DM / 64) * (NGU / 32), I_DN = (DFF / 64) * (DM / 32);
            constexpr int NITEMS = I_IN + I_OUT + I_GU;
            auto decode = [&](int it) -> TItem {
                TItem t; int r = it;
                if (r < I_IN) { const int nblk = NPROJ / 32, kb = r / nblk, nb = r % nblk; t = TItem{a.w_in, WinT, nullptr, INW, DM, win_src_col(nb * 32), nb * 32, kb * 64}; return t; } r -= I_IN;
                if (r < I_OUT) { const int nblk = DM / 32, kb = r / nblk, nb = r % nblk; t = TItem{a.w_out, WoutT, nullptr, DM, DM, nb * 32, nb * 32, kb * 64}; return t; } r -= I_OUT;
                { const int nblk = NGU / 32, kb = r / nblk, nb = r % nblk; const int nd = nb * 32, pn = nd >> 8, j = nd & 255;
                    t = TItem{(j < 128) ? a.w_gate : a.w_up, WguT, a.norm2_w, DFF, DM, pn * 128 + (j & 127), nd, kb * 64}; return t; }
            };
            int it = gw;
            if (it < NITEMS) {
                TItem cur = decode(it); f32x4 vc[8]; titem_load(cur, vc, lane);
                for (;;) {
                    const int nx = it + NGW; const bool more = nx < NITEMS;
                    TItem nt = cur; f32x4 vn[8];
                    if (more) { nt = decode(nx); titem_load(nt, vn, lane); }
                    titem_finish(cur, vc, scr, lane);
                    if (!more) break;
                    cur = nt; it = nx;
#pragma unroll
                    for (int i = 0; i < 8; ++i) vc[i] = vn[i];
                }
            }
        }
        __syncthreads();
        LAS float* wg = (LAS float*)lds;
        for (int k = tid; k < DM; k += NWAVES * 64) { const f32x4 g0 = *(const f32x4*)(a.w_in + (size_t)k * INW + 3072), g1 = *(const f32x4*)(a.w_in + (size_t)k * INW + 3076);
            wg[0 * DM + k] = g0[0]; wg[1 * DM + k] = g0[1]; wg[2 * DM + k] = g0[2]; wg[3 * DM + k] = g0[3];
            wg[4 * DM + k] = g1[0]; wg[5 * DM + k] = g1[1]; wg[6 * DM + k] = g1[2]; wg[7 * DM + k] = g1[3]; }
        __syncthreads();
        for (int m = gw; m < MTOK; m += NGW) {
            const f32x4* xr = (const f32x4*)(a.x + (size_t)m * DM) + lane; const f32x4* wr_ = (const f32x4*)a.norm1_w + lane;
            f32x4 v[8]; float s = 0.f;
#pragma unroll
            for (int j = 0; j < 8; ++j) { v[j] = xr[64 * j]; s += (v[j][0] * v[j][0] + v[j][1] * v[j][1]) + (v[j][2] * v[j][2] + v[j][3] * v[j][3]); }
            const float rstd = 1.0f / sqrtf(wave_sum(s) * (1.0f / DM) + NORM_EPS);
            u32x2* o8 = (u32x2*)(Ub + (size_t)m * DM) + lane;
#pragma unroll
            for (int j = 0; j < 8; ++j) { v[j] = v[j] * rstd * wr_[64 * j]; u32x2 w; w.x = cvtpk(v[j][0], v[j][1]); w.y = cvtpk(v[j][2], v[j][3]); o8[64 * j] = w; }
            float z = 0.f;
#pragma unroll 1
            for (int gi = 0; gi < 8; ++gi) { float t = 0.f;
#pragma unroll
                for (int j = 0; j < 8; ++j) { const f32x4 w4 = *(const LAS f32x4*)(wg + gi * DM + 256 * j + 4 * lane); t += (v[j][0] * w4[0] + v[j][1] * w4[1]) + (v[j][2] * w4[2] + v[j][3] * w4[3]); }
                t = wave_sum(t); z = (lane == gi) ? t : z; }
            if (lane < 8) {
                const int hh = lane & 3;
                if (lane < 4) { gli[m * 4 + hh] = 15.0f * tanhf((z + a.igate_b[hh]) * (1.0f / 15.0f)); }
                else { const float fp = 15.0f * tanhf((z + a.fgate_b[hh]) * (1.0f / 15.0f)); glf[m * 4 + hh] = -log1pf(expf(-fp)); }
            }
        }
    REP_END
    xcd_barrier(bar);

    REP_BEGIN(1)
        pg8::Gemm g{Ub, WinT, MTOK, NPROJ, DM, DM}; pg8::StaticOrder S; S.init(MTOK, NPROJ, G, bx);
        pg8::EpiBf16 E{proj, NPROJ};
        pg8::gemm_phase<pg8::EpiBf16, true>(lds, g, S, E);
    REP_END
    xcd_barrier(bar);

    REP_BEGIN(2)
        {
            const int c0 = 4 * (tid & 15), rstride = NGT >> 4;
            for (int which = 0; which < 2; ++which) {
                const float* nw = which ? a.k_norm_w : a.q_norm_w; const int colb = which ? PC_AK : PC_AQ;
                const f32x4 w1 = *(const f32x4*)(nw + c0), w2 = *(const f32x4*)(nw + 64 + c0);
                for (int idx0 = gt >> 4; idx0 < MTOK * 8; idx0 += 4 * rstride) {
                    u32x2 r1[4], r2[4]; f32x4 cs[4], sn[4];
#pragma unroll
                    for (int q = 0; q < 4; ++q) { const int idx = idx0 + q * rstride;
                        if (idx < MTOK * 8) { const int m = idx >> 3, hh = idx & 7, pos = m & (SEQ - 1); const bf16* kp = proj + (size_t)m * NPROJ + colb + hh * 128;
                            r1[q] = *(const u32x2*)(kp + c0); r2[q] = *(const u32x2*)(kp + 64 + c0); cs[q] = *(const f32x4*)(rcos + pos * 64 + c0); sn[q] = *(const f32x4*)(rsin + pos * 64 + c0); } }
#pragma unroll
                    for (int q = 0; q < 4; ++q) { const int idx = idx0 + q * rstride;
                        if (idx < MTOK * 8) { const int m = idx >> 3, hh = idx & 7; bf16* kp = proj + (size_t)m * NPROJ + colb + hh * 128;
                            float x1[4] = {bf_lo(r1[q].x), bf_hi(r1[q].x), bf_lo(r1[q].y), bf_hi(r1[q].y)}, x2[4] = {bf_lo(r2[q].x), bf_hi(r2[q].x), bf_lo(r2[q].y), bf_hi(r2[q].y)};
                            float ss = 0.f;
#pragma unroll
                            for (int e = 0; e < 4; ++e) ss += x1[e] * x1[e] + x2[e] * x2[e];
                            ss += __shfl_xor(ss, 1); ss += __shfl_xor(ss, 2); ss += __shfl_xor(ss, 4); ss += __shfl_xor(ss, 8);
                            const float rk = 1.0f / sqrtf(ss * (1.0f / 128.0f) + NORM_EPS);
                            float o1[4], o2[4];
#pragma unroll
                            for (int e = 0; e < 4; ++e) { const float y1 = x1[e] * rk * w1[e], y2 = x2[e] * rk * w2[e]; o1[e] = y1 * cs[q][e] - y2 * sn[q][e]; o2[e] = y2 * cs[q][e] + y1 * sn[q][e]; }
                            u32x2 wv; wv.x = cvtpk(o1[0], o1[1]); wv.y = cvtpk(o1[2], o1[3]); if (!dry) *(u32x2*)(kp + c0) = wv;
                            wv.x = cvtpk(o2[0], o2[1]); wv.y = cvtpk(o2[2], o2[3]); if (!dry) *(u32x2*)(kp + 64 + c0) = wv; } }
                }
            }
        }
        LAS unsigned char* KW = lds; LAS unsigned char* VT = lds + 18432;
        const int g = lane >> 4, qp = (lane & 15) >> 2, p = lane & 3;
        for (int u = vcu; u < 512; u += G) {
            const int b = u >> 8, h = (u >> 6) & 3, c = u & 63;
            const int tok = b * SEQ + c * 64 + lane;
            const float li = gli[tok * 4 + h], lf = glf[tok * 4 + h];
            const float cf = scan_add64(lf, lane);
            const float gsum = __shfl(cf, 63);
            const float av = gsum - cf + li;
            const float ml = wave_max(av);
            const float wst = __expf(av - ml);
            if (tid == 0) { msc_g[u] = gsum; msc_ml[u] = ml; }
            conv_tile<true>(proj, a.conv_w, a.conv_b, b, c, PC_MK + h * 128, 512 + h * 128, 1.0f, wst, KW, tid);
            v_tile(proj, b, c, h, VT, tid);
            __syncthreads();
            f32x4 acc[8][2];
#pragma unroll
            for (int df = 0; df < 8; ++df) { acc[df][0] = (f32x4){0.f, 0.f, 0.f, 0.f}; acc[df][1] = (f32x4){0.f, 0.f, 0.f, 0.f}; }
#pragma unroll
            for (int kk = 0; kk < 2; ++kk) {
                bf16x8 bfr[2];
#pragma unroll
                for (int ef = 0; ef < 2; ++ef) { const int col = 32 * wave + 16 * ef + 4 * p;
                    bfr[ef] = cat4(vtr(VT + (32 * kk + 4 * g + qp) * 544 + col * 2), vtr(VT + (32 * kk + 16 + 4 * g + qp) * 544 + col * 2)); }
#pragma unroll
                for (int df = 0; df < 8; ++df) { const int col = 16 * df + 4 * p;
                    const bf16x8 af = cat4(vtr(KW + (32 * kk + 4 * g + qp) * 288 + col * 2), vtr(KW + (32 * kk + 16 + 4 * g + qp) * 288 + col * 2));
                    acc[df][0] = MFMA16(af, bfr[0], acc[df][0]); acc[df][1] = MFMA16(af, bfr[1], acc[df][1]); }
            }
#pragma unroll
            for (int ef = 0; ef < 2; ++ef) { const int e = 32 * wave + 16 * ef + (lane & 15);
#pragma unroll
                for (int df = 0; df < 8; ++df) { const f32x4 v = acc[df][ef]; u32x2 w; w.x = cvtpk(v[0], v[1]); w.y = cvtpk(v[2], v[3]);
                    *(u32x2*)(kvT + ((size_t)u * 256 + e) * 128 + 16 * df + 4 * g) = w; } }
            if (tid < 128) { float nsum = 0.f;
#pragma unroll 8
                for (int l = 0; l < 64; ++l) nsum += __uint_as_float((unsigned)(*(const LAS unsigned short*)(KW + l * 288 + tid * 2)) << 16);
                ncb[u * 128 + tid] = nsum; }
            __syncthreads();
        }
    REP_END
    xcd_barrier(bar);

    REP_BEGIN(3)
        LAS float* sg = (LAS float*)lds; LAS float* sml = sg + 512;
        for (int i = tid; i < 512; i += NWAVES * 64) { sg[i] = msc_g[i]; sml[i] = msc_ml[i]; }
        __syncthreads();
        for (int id = gt; id < 8 * 16384; id += NGT) {
            const int bh = id >> 14, pi = id & 16383;
            unsigned* base = (unsigned*)kvT + (size_t)bh * 64 * 16384 + pi;
            float c0 = 0.f, c1 = 0.f, m = 0.f;
#pragma unroll 1
            for (int cb = 0; cb < 64; cb += 32) {
                unsigned xv[32];
#pragma unroll
                for (int i = 0; i < 32; ++i) xv[i] = base[(size_t)(cb + i) * 16384];
#pragma unroll
                for (int i = 0; i < 32; ++i) {
                    const float gg = sg[bh * 64 + cb + i], ml = sml[bh * 64 + cb + i];
                    const float mn = fmaxf(gg + m, ml), so = __expf(gg + m - mn), sn = __expf(ml - mn);
                    if (!dry) base[(size_t)(cb + i) * 16384] = cvtpk(c0, c1);
                    c0 = so * c0 + sn * bf_lo(xv[i]); c1 = so * c1 + sn * bf_hi(xv[i]); m = mn;
                }
            }
        }
        for (int id = gt; id < 8 * 128; id += NGT) {
            const int bh = id >> 7, dd = id & 127; float n = 0.f, m = 0.f;
            float* nb_ = ncb + (size_t)bh * 64 * 128 + dd;
#pragma unroll 1
            for (int cb = 0; cb < 64; cb += 32) {
                float xv[32];
#pragma unroll
                for (int i = 0; i < 32; ++i) xv[i] = nb_[(cb + i) * 128];
#pragma unroll
                for (int i = 0; i < 32; ++i) {
                    const float gg = sg[bh * 64 + cb + i], ml = sml[bh * 64 + cb + i];
                    const float mn = fmaxf(gg + m, ml), so = __expf(gg + m - mn), sn = __expf(ml - mn);
                    if (!dry) nb_[(cb + i) * 128] = n;
                    if (dd == 0) msc_mp[bh * 64 + cb + i] = m;
                    n = so * n + sn * xv[i]; m = mn;
                }
            }
        }
        __syncthreads();
    REP_END
    REP_BEGIN(4)
        for (int pidx = vcu; pidx < 512; pidx += G) {
            AUnit ua, ub;
            { const int u = pidx; ua = AUnit{u >> 8, (u >> 5) & 7, 4, (u >> 3) & 3, u & 7, op0, pl0}; }
            { const int v = pidx; const int bb = v >> 8; ub = AUnit{bb, (v >> 5) & 7, 16, (v >> 1) & 15, (v ^ bb) & 1, op1, pl1}; }
            attn_pair<false>(proj, rcos, rsin, a.q_norm_w, a.attn_norm_w, ua, ub, lds, nullptr, nullptr, tid, dry);
        }
    REP_END
    xcd_barrier(bar);

    REP_BEGIN(5)
        LAS unsigned char* QT = lds; LAS unsigned char* KT = lds + 18432; LAS unsigned char* VT = lds + 36864;
        LAS float* NP = (LAS float*)(lds + 71680); LAS float* XCH = (LAS float*)(lds + 72192);
        const int j = lane & 15, g = lane >> 4, qp = j >> 2, p = lane & 3;
        const int tf = wave & 3, eh = wave >> 2;
        for (int u = vcu; u < 512; u += G) {
            const int b = u >> 8, h = (u >> 6) & 3, c = u & 63;
            const int tok = b * SEQ + c * 64 + lane;
            const float li = gli[tok * 4 + h], lf = glf[tok * 4 + h];
            const float cf = scan_add64(lf, lane);
            const float bvec = li - cf;
            const float pm = scan_max64(bvec, lane);
            const float mprev = msc_mp[u];
            const float Mv = fmaxf(mprev, pm);
            const float wiv = __expf(mprev - Mv), emtv = __expf(-cf - Mv);
            const bf16* cp = kvT + ((size_t)u * 256 + 128 * eh + j) * 128 + 8 * g;
            bf16x8 cpre[4][4];
#pragma unroll
            for (int ef = 0; ef < 4; ++ef)
#pragma unroll
                for (int ks = 0; ks < 4; ++ks) cpre[ef][ks] = *(const bf16x8*)(cp + (size_t)(16 * ef) * 128 + 32 * ks);
            conv_tile<false>(proj, a.conv_w, a.conv_b, b, c, PC_MQ + h * 128, h * 128, 0.08838834764831845f, 0.f, QT, tid);
            conv_tile<false>(proj, a.conv_w, a.conv_b, b, c, PC_MK + h * 128, 512 + h * 128, 1.0f, 0.f, KT, tid);
            v_tile(proj, b, c, h, VT, tid);
            if (tid < 128) NP[tid] = ncb[u * 128 + tid];
            __syncthreads();
            const int t = 16 * tf + j;
            const float M_t = __shfl(Mv, t), wi_t = __shfl(wiv, t), emt_t = __shfl(emtv, t);
            bf16x8 qf[4];
#pragma unroll
            for (int ks = 0; ks < 4; ++ks) qf[ks] = *(const LAS bf16x8*)(QT + t * 288 + (32 * ks + 8 * g) * 2);
            float sp[4][4]; float rowsum = 0.f;
#pragma unroll
            for (int sf = 0; sf < 4; ++sf) {
                f32x4 sa = {0.f, 0.f, 0.f, 0.f};
#pragma unroll
                for (int ks = 0; ks < 4; ++ks) { const bf16x8 kfr = *(const LAS bf16x8*)(KT + (16 * sf + j) * 288 + (32 * ks + 8 * g) * 2); sa = MFMA16(kfr, qf[ks], sa); }
#pragma unroll
                for (int rg = 0; rg < 4; ++rg) { const int sidx = 16 * sf + 4 * g + rg; const float bs = __shfl(bvec, sidx);
                    const float pv = (sidx <= t) ? __expf(bs - M_t) : 0.f; sp[sf][rg] = sa[rg] * pv; rowsum += sp[sf][rg]; }
            }
            bf16x8 pb[2];
#pragma unroll
            for (int kk = 0; kk < 2; ++kk) { float tmp[8] = {sp[2 * kk][0], sp[2 * kk][1], sp[2 * kk][2], sp[2 * kk][3], sp[2 * kk + 1][0], sp[2 * kk + 1][1], sp[2 * kk + 1][2], sp[2 * kk + 1][3]};
                const u32x4 w = pack8(tmp); pb[kk] = __builtin_bit_cast(bf16x8, w); }
            f32x4 ai[8], ae[8];
#pragma unroll
            for (int ef = 0; ef < 8; ++ef) { ai[ef] = (f32x4){0.f, 0.f, 0.f, 0.f}; ae[ef] = (f32x4){0.f, 0.f, 0.f, 0.f}; }
#pragma unroll
            for (int kk = 0; kk < 2; ++kk) {
#pragma unroll
                for (int ef = 0; ef < 8; ++ef) { const int col = 128 * eh + 16 * ef + 4 * p;
                    const bf16x8 af = cat4(vtr(VT + (32 * kk + 4 * g + qp) * 544 + col * 2), vtr(VT + (32 * kk + 16 + 4 * g + qp) * 544 + col * 2));
                    ai[ef] = MFMA16(af, pb[kk], ai[ef]); }
            }
#pragma unroll
            for (int ef = 0; ef < 4; ++ef)
#pragma unroll
                for (int ks = 0; ks < 4; ++ks) ae[ef] = MFMA16(cpre[ef][ks], qf[ks], ae[ef]);
#pragma unroll
            for (int ef = 4; ef < 8; ++ef) {
#pragma unroll
                for (int ks = 0; ks < 4; ++ks) { const bf16x8 cfr = *(const bf16x8*)(cp + (size_t)(16 * ef) * 128 + 32 * ks); ae[ef] = MFMA16(cfr, qf[ks], ae[ef]); }
            }
            float qn = 0.f;
#pragma unroll
            for (int ks = 0; ks < 4; ++ks) { float qv[8]; unpack8(__builtin_bit_cast(u32x4, qf[ks]), qv);
#pragma unroll
                for (int e = 0; e < 8; ++e) qn += qv[e] * NP[32 * ks + 8 * g + e]; }
            qn += __shfl_xor(qn, 16); qn += __shfl_xor(qn, 32);
            rowsum += __shfl_xor(rowsum, 16); rowsum += __shfl_xor(rowsum, 32);
            const float den = wi_t * qn + rowsum;
            const float dinv = 1.0f / fmaxf(fabsf(den), emt_t);
            float ssq = 0.f;
#pragma unroll
            for (int ef = 0; ef < 8; ++ef) { ai[ef] = (ae[ef] * wi_t + ai[ef]) * dinv; ssq += (ai[ef][0] * ai[ef][0] + ai[ef][1] * ai[ef][1]) + (ai[ef][2] * ai[ef][2] + ai[ef][3] * ai[ef][3]); }
            ssq += __shfl_xor(ssq, 16); ssq += __shfl_xor(ssq, 32);
            if (g == 0) XCH[eh * 64 + t] = ssq;
            __syncthreads();
            const float rn = 1.0f / sqrtf((XCH[t] + XCH[64 + t]) * (1.0f / 256.0f) + NORM_EPS);
            bf16* orow = proj + (size_t)(b * SEQ + c * 64 + t) * NPROJ;
#pragma unroll
            for (int ef = 0; ef < 8; ++ef) { const int e = 128 * eh + 16 * ef + 4 * g;
                const f32x4 nw = *(const f32x4*)(a.mlstm_norm_w + h * 256 + e);
                const u32x2 mo = *(const u32x2*)(orow + PC_MO + h * 256 + e);
                const float mof[4] = {bf_lo(mo.x), bf_hi(mo.x), bf_lo(mo.y), bf_hi(mo.y)};
                float r4[4];
#pragma unroll
                for (int e2 = 0; e2 < 4; ++e2) r4[e2] = ai[ef][e2] * rn * nw[e2] / (1.0f + __expf(-mof[e2]));
                u32x2 w; w.x = cvtpk(r4[0], r4[1]); w.y = cvtpk(r4[2], r4[3]); if (!dry) *(u32x2*)(orow + PC_MV + h * 256 + e) = w; }
            __syncthreads();
        }
        for (int pidx = vcu; pidx < 256; pidx += G) {
            const AUnit ua{0, (pidx >> 5) & 7, 1, 0, pidx & 31, op0, pl0}, ub{1, (pidx >> 5) & 7, 1, 0, pidx & 31, op0, pl0};
            attn_pair<true>(proj, rcos, rsin, a.q_norm_w, a.attn_norm_w, ua, ub, lds, op1, pl1, tid, dry);
        }
    REP_END
    xcd_barrier(bar);

    REP_BEGIN(6)
        pg8::Gemm g{proj + PC_MV, WoutT, MTOK, DM, DM, NPROJ}; pg8::StaticOrder S; S.init(MTOK, DM, G, bx);
        pg8::EpiRes1 E{a.x, a.out, H1b, sumsq, DM, dry};
        pg8::gemm_phase<pg8::EpiRes1, false>(lds, g, S, E);
    REP_END
    xcd_barrier(bar);

    REP_BEGIN(7)
        pg8::Gemm g{H1b, WguT, MTOK, NGU, DM, DM}; pg8::StaticOrder S; S.init(MTOK, NGU, G, bx);
        pg8::EpiSwiGLU E{FF, DFF, sumsq};
        pg8::gemm_phase<pg8::EpiSwiGLU, true>(lds, g, S, E);
        if (rep_ == 1) {
            const int nfull = (MTOK / 256) * (NGU / 256) - 5 * G;
            const int nidle = G - nfull;
            if (G == 256 ? (bx >= nfull) : true) {
                LAS float* scr = (LAS float*)(lds + wave * 16384);
                constexpr int I_DN = (DFF / 64) * (DM / 32);
                const int w0 = (G == 256) ? (bx - nfull) * NWAVES + wave : gw, nw = (G == 256) ? nidle * NWAVES : NGW;
                for (int it = w0; it < I_DN; it += nw) { const int nblk = DM / 32, kb = it / nblk, nb = it % nblk;
                    const TItem t{a.w_down, WdnT, nullptr, DM, DFF, nb * 32, nb * 32, kb * 64}; f32x4 v[8]; titem_load(t, v, lane); titem_finish(t, v, scr, lane); }
            }
        }
    REP_END
    xcd_barrier(bar);

    REP_BEGIN(8)
        pg8::Gemm g{FF, WdnT, MTOK, DM, DFF, DFF}; pg8::StaticOrder S; S.init(MTOK, DM, G, bx);
        pg8::EpiRes2 E{a.out, DM, dry};
        pg8::gemm_phase<pg8::EpiRes2, false>(lds, g, S, E);
    REP_END
}

extern "C" void kernel_launch(void* const* d_in, const int* in_sizes, int n_in, void* d_out, int out_size, void* d_ws, size_t ws_size, hipStream_t stream) {
    static int grid = 0;
    if (grid == 0) {
        if (n_in != 16 || in_sizes[0] != MTOK * DM || out_size != MTOK * DM || ws_size < WS_END) { fprintf(stderr, "kernel_launch: unexpected shapes (n_in %d in0 %d out %d ws %zu)\n", n_in, n_in > 0 ? in_sizes[0] : -1, out_size, ws_size); grid = -1; return; }
        int dev = 0, cus = 0;
        if (hipGetDevice(&dev) != hipSuccess || hipDeviceGetAttribute(&cus, hipDeviceAttributeMultiprocessorCount, dev) != hipSuccess || cus <= 0) cus = 256;
        if (hipFuncSetAttribute((const void*)hymba_fwd, hipFuncAttributeMaxDynamicSharedMemorySize, LDS_BYTES) != hipSuccess) { fprintf(stderr, "kernel_launch: hipFuncSetAttribute failed\n"); grid = -1; return; }
        (void)hipGetLastError();
        grid = cus;
    }
    if (grid < 0) return;
    if (hipMemsetAsync((char*)d_ws + WS_CTL, 0, CTL_ZERO_BYTES, stream) != hipSuccess) { fprintf(stderr, "kernel_launch: memset failed\n"); return; }
    Args a{};
    a.x = (const float*)d_in[0]; a.norm1_w = (const float*)d_in[1]; a.w_in = (const float*)d_in[2]; a.conv_w = (const float*)d_in[3]; a.conv_b = (const float*)d_in[4];
    a.igate_b = (const float*)d_in[5]; a.fgate_b = (const float*)d_in[6]; a.q_norm_w = (const float*)d_in[7]; a.k_norm_w = (const float*)d_in[8];
    a.mlstm_norm_w = (const float*)d_in[9]; a.attn_norm_w = (const float*)d_in[10]; a.w_out = (const float*)d_in[11]; a.norm2_w = (const float*)d_in[12];
    a.w_gate = (const float*)d_in[13]; a.w_up = (const float*)d_in[14]; a.w_down = (const float*)d_in[15];
    a.out = (float*)d_out; a.ws = (unsigned char*)d_ws; a.dry = (PROBE_PHASE >= 0) ? 1 : 0;
    hipLaunchKernelGGL(hymba_fwd, dim3(grid), dim3(NWAVES * 64), LDS_BYTES, stream, a);
}
```

```cpp
#include <hip/hip_runtime.h>
#include <cstdio>
#include <cstdint>

#define LAS __attribute__((address_space(3)))
#define GAS __attribute__((address_space(1)))
typedef unsigned short bf16;
typedef short bf16x8 __attribute__((ext_vector_type(8)));
typedef short s16x4 __attribute__((ext_vector_type(4)));
typedef float f32x4 __attribute__((ext_vector_type(4)));
typedef float f32x2 __attribute__((ext_vector_type(2)));
typedef unsigned u32x4 __attribute__((ext_vector_type(4)));
typedef unsigned u32x2 __attribute__((ext_vector_type(2)));
typedef __bf16 bf16x2_t __attribute__((ext_vector_type(2)));

constexpr int BATCH = 2, SEQ = 4096, DM = 2048, MTOK = BATCH * SEQ;
constexpr int INW = 6152, NPROJ = 6144, DFF = 5632, NGU = 2 * DFF;
constexpr int PC_MQ = 0, PC_MK = 512, PC_MO = 1024, PC_MV = 2048, PC_AQ = 3072, PC_AK = 4096, PC_AV = 5120;
constexpr float NORM_EPS = 1e-6f;
constexpr int NWAVES = 8;

constexpr size_t MiB = 1u << 20;
constexpr size_t WS_CTL = 0, CTL_ZERO_BYTES = 1 * MiB;
constexpr size_t WS_GLI = 1 * MiB;
constexpr size_t WS_GLF = WS_GLI + 128 * 1024;
constexpr size_t WS_SUMSQ = WS_GLF + 128 * 1024;
constexpr size_t WS_MSC = WS_SUMSQ + 32 * 1024;
constexpr size_t WS_NC = WS_MSC + 8 * 1024;
constexpr size_t WS_COS = 2 * MiB, WS_SIN = 3 * MiB;
constexpr size_t WS_WIN = 6 * MiB;
constexpr size_t WS_KV = 6 * MiB;
constexpr size_t WS_U = 30 * MiB;
constexpr size_t WS_PROJ = 62 * MiB;
constexpr size_t WS_WOUT = 158 * MiB;
constexpr size_t WS_WGU = 166 * MiB;
constexpr size_t WS_WDN = 210 * MiB;
constexpr size_t WS_OP0 = 38 * MiB;
constexpr size_t WS_OP1 = 232 * MiB;
constexpr size_t WS_PL0 = 248 * MiB, WS_PL1 = WS_PL0 + 256 * 1024;
constexpr size_t WS_END = 249 * MiB;
constexpr int CW_BAR = 4096;

constexpr int RING_BYTES = 131072;
constexpr int MISC_OFF = 147456 - 256;
constexpr int LDS_BYTES = 147456;

__device__ __forceinline__ unsigned cvtpk(float lo, float hi) { f32x2 v = {lo, hi}; bf16x2_t b = __builtin_convertvector(v, bf16x2_t); return __builtin_bit_cast(unsigned, b); }
__device__ __forceinline__ float bf_lo(unsigned w) { return __uint_as_float(w << 16); }
__device__ __forceinline__ float bf_hi(unsigned w) { return __uint_as_float(w & 0xffff0000u); }
__device__ __forceinline__ void unpack8(u32x4 w, float* f) { f[0] = bf_lo(w.x); f[1] = bf_hi(w.x); f[2] = bf_lo(w.y); f[3] = bf_hi(w.y); f[4] = bf_lo(w.z); f[5] = bf_hi(w.z); f[6] = bf_lo(w.w); f[7] = bf_hi(w.w); }
__device__ __forceinline__ u32x4 pack8(const float* f) { u32x4 w; w.x = cvtpk(f[0], f[1]); w.y = cvtpk(f[2], f[3]); w.z = cvtpk(f[4], f[5]); w.w = cvtpk(f[6], f[7]); return w; }
__device__ __forceinline__ float wave_sum(float v) {
#pragma unroll
    for (int o = 1; o < 64; o <<= 1) v += __shfl_xor(v, o);
    return v;
}
__device__ __forceinline__ float wave_max(float v) {
#pragma unroll
    for (int o = 1; o < 64; o <<= 1) v = fmaxf(v, __shfl_xor(v, o));
    return v;
}
__device__ __forceinline__ s16x4 vtr(const LAS unsigned char* p) { return __builtin_bit_cast(s16x4, __builtin_amdgcn_ds_read_tr16_b64_v4i16((LAS s16x4*)p)); }
__device__ __forceinline__ bf16x8 cat4(s16x4 a, s16x4 b) { return (bf16x8){a[0], a[1], a[2], a[3], b[0], b[1], b[2], b[3]}; }
#define LDS_WAIT() asm volatile("s_waitcnt lgkmcnt(0)" ::: "memory")
#define VM_WAIT() asm volatile("s_waitcnt vmcnt(0)" ::: "memory")
#define SBAR() __builtin_amdgcn_sched_barrier(0)
#define MFMA16(a, b, c) __builtin_amdgcn_mfma_f32_16x16x32_bf16((a), (b), (c), 0, 0, 0)

namespace pg8 {
constexpr int BM = 256, BK = 64, HALF = 128, HTB = HALF * BK * 2, STAGE_BYTES = 8 * HTB, NXCD = 8, WGM = 8;
__host__ __device__ __forceinline__ int lds_byte(int r, int c) { const int st = (r >> 4) * 2 + (c >> 5), rr = r & 15, cc = c & 31, ob = rr * 64 + cc * 2; return st * 1024 + (ob ^ (((ob >> 9) & 1) << 5)); }
__host__ __device__ __forceinline__ void stage_rc(int b, int& R, int& C) { const int st = b / 1024, sb = b % 1024, swz = sb ^ (((sb >> 9) & 1) << 5); R = (st >> 1) * 16 + swz / 64; C = (st & 1) * 32 + (swz % 64) / 2; }
__host__ __device__ __forceinline__ int perm32(int rho) { const int n = rho >> 4, i = rho & 15; return 8 * (i >> 2) + 4 * n + (i & 3); }
struct Unit { int pm, pn; };
struct Gemm { const bf16* A; const bf16* Bt; int M, N, K, lda; };
struct StaticOrder {
    int nM, nN, nwg, G, c;
    __device__ void init(int M, int N, int G_, int c_) { nM = M / BM; nN = N / BM; nwg = nM * nN; G = G_; c = c_; }
    __device__ bool next(int i, Unit& u) const {
        const long L = (long)i * G + c; if (L >= nwg) return false;
        int wgid = (int)L; { const int q = nwg / NXCD, r = nwg % NXCD, xcd = wgid % NXCD, off = wgid / NXCD; wgid = (xcd < r ? xcd * (q + 1) : r * (q + 1) + (xcd - r) * q) + off; }
        const int nig = WGM * nN, gid = wgid / nig, fm = gid * WGM, gsz = (nM - fm) < WGM ? (nM - fm) : WGM;
        u.pm = fm + ((wgid % nig) % gsz); u.pn = (wgid % nig) / gsz; return true;
    }
};
struct EpiBf16 {
    static constexpr bool PERM = true, HAS_INIT = false;
    bf16* O; int ldc;
    __device__ __forceinline__ void operator()(const f32x4 (&acc)[2][2][4][2], const Unit& u, int wr, int wc, int fr, int fq) const {
        const int row0 = u.pm * BM + wr * 64 + fr, col0 = u.pn * BM + wc * 32 + 8 * fq;
#pragma unroll
        for (int ai = 0; ai < 2; ++ai)
#pragma unroll
            for (int m = 0; m < 4; ++m) { bf16* rowp = O + (size_t)(row0 + ai * HALF + m * 16) * ldc + col0;
#pragma unroll
                for (int bj = 0; bj < 2; ++bj) { const f32x4 v0 = acc[ai][bj][m][0], v1 = acc[ai][bj][m][1];
                    u32x4 w; w.x = cvtpk(v0[0], v0[1]); w.y = cvtpk(v0[2], v0[3]); w.z = cvtpk(v1[0], v1[1]); w.w = cvtpk(v1[2], v1[3]);
                    *(u32x4*)(rowp + bj * HALF) = w; } }
    }
};
struct EpiRes1 {
    static constexpr bool PERM = false, HAS_INIT = true;
    const float* xres; float* out; bf16* h1b; float* sumsq; int ldc; bool dry;
    __device__ __forceinline__ void init(f32x4 (&acc)[2][2][4][2], const Unit& u, int wr, int wc, int fr, int fq) const {
        const int col0 = u.pn * BM + wc * 32 + 4 * fq;
#pragma unroll
        for (int ai = 0; ai < 2; ++ai)
#pragma unroll
            for (int m = 0; m < 4; ++m) { const size_t off = (size_t)(u.pm * BM + ai * HALF + wr * 64 + m * 16 + fr) * ldc + col0;
#pragma unroll
                for (int bj = 0; bj < 2; ++bj)
#pragma unroll
                    for (int n = 0; n < 2; ++n) acc[ai][bj][m][n] = *(const f32x4*)(xres + off + bj * HALF + n * 16); }
    }
    __device__ __forceinline__ void operator()(const f32x4 (&acc)[2][2][4][2], const Unit& u, int wr, int wc, int fr, int fq) const {
        const int col0 = u.pn * BM + wc * 32 + 4 * fq;
#pragma unroll
        for (int ai = 0; ai < 2; ++ai)
#pragma unroll
            for (int m = 0; m < 4; ++m) { const int row = u.pm * BM + ai * HALF + wr * 64 + m * 16 + fr; const size_t off = (size_t)row * ldc + col0; float ss = 0.f;
#pragma unroll
                for (int bj = 0; bj < 2; ++bj)
#pragma unroll
                    for (int n = 0; n < 2; ++n) { const size_t o2 = off + bj * HALF + n * 16; const f32x4 h = acc[ai][bj][m][n];
                        u32x2 w; w.x = cvtpk(h[0], h[1]); w.y = cvtpk(h[2], h[3]); if (!dry) { *(u32x2*)(h1b + o2) = w; }
                        ss += (h[0] * h[0] + h[1] * h[1]) + (h[2] * h[2] + h[3] * h[3]); }
                ss += __shfl_xor(ss, 16); ss += __shfl_xor(ss, 32);
                if (fq == 0 && !dry) atomicAdd(sumsq + row, ss); }
    }
};
struct EpiSwiGLU {
    static constexpr bool PERM = true, HAS_INIT = false;
    bf16* O; int ldc; const float* sumsq;
    __device__ __forceinline__ void operator()(const f32x4 (&acc)[2][2][4][2], const Unit& u, int wr, int wc, int fr, int fq) const {
        const int col0 = u.pn * HALF + wc * 32 + 8 * fq;
#pragma unroll
        for (int ai = 0; ai < 2; ++ai)
#pragma unroll
            for (int m = 0; m < 4; ++m) { const int row = u.pm * BM + ai * HALF + wr * 64 + m * 16 + fr;
                const float rs = 1.0f / sqrtf(sumsq[row] * (1.0f / DM) + NORM_EPS);
                float f[8];
#pragma unroll
                for (int n = 0; n < 2; ++n)
#pragma unroll
                    for (int j = 0; j < 4; ++j) { const float g = acc[ai][0][m][n][j] * rs, up = acc[ai][1][m][n][j] * rs; f[n * 4 + j] = g / (1.0f + __expf(-g)) * up; }
                *(u32x4*)(O + (size_t)row * ldc + col0) = pack8(f); }
    }
};
struct EpiRes2 {
    static constexpr bool PERM = false, HAS_INIT = true;
    const bf16* h1b; float* out; int ldc; bool dry;
    __device__ __forceinline__ void init(f32x4 (&acc)[2][2][4][2], const Unit& u, int wr, int wc, int fr, int fq) const {
        const int col0 = u.pn * BM + wc * 32 + 4 * fq;
#pragma unroll
        for (int ai = 0; ai < 2; ++ai)
#pragma unroll
            for (int m = 0; m < 4; ++m) { const size_t off = (size_t)(u.pm * BM + ai * HALF + wr * 64 + m * 16 + fr) * ldc + col0;
#pragma unroll
                for (int bj = 0; bj < 2; ++bj)
#pragma unroll
                    for (int n = 0; n < 2; ++n) { const u32x2 w = *(const u32x2*)(h1b + off + bj * HALF + n * 16); acc[ai][bj][m][n] = (f32x4){bf_lo(w.x), bf_hi(w.x), bf_lo(w.y), bf_hi(w.y)}; } }
    }
    __device__ __forceinline__ void operator()(const f32x4 (&acc)[2][2][4][2], const Unit& u, int wr, int wc, int fr, int fq) const {
        const int col0 = u.pn * BM + wc * 32 + 4 * fq;
#pragma unroll
        for (int ai = 0; ai < 2; ++ai)
#pragma unroll
            for (int m = 0; m < 4; ++m) { const size_t off = (size_t)(u.pm * BM + ai * HALF + wr * 64 + m * 16 + fr) * ldc + col0;
#pragma unroll
                for (int bj = 0; bj < 2; ++bj)
#pragma unroll
                    for (int n = 0; n < 2; ++n) { if (!dry) *(f32x4*)(out + off + bj * HALF + n * 16) = acc[ai][bj][m][n]; } }
    }
};

template <class Epi, bool ALIGN_EPI>
__device__ __forceinline__ void gemm_phase(LAS unsigned char* lds, const Gemm g, const StaticOrder& S, const Epi& E) {
    int tid = threadIdx.x; asm volatile("" : "+v"(tid));
    const int wid = __builtin_amdgcn_readfirstlane(tid >> 6), lane = tid & 63, wr = wid >> 2, wc = wid & 3, fr = lane & 15, fq = lane >> 4;
    const int K = g.K, nt = K / BK;
    unsigned voffA[2], voffB[2];
#pragma unroll
    for (int i = 0; i < 2; ++i) { int R, C; stage_rc(tid * 16 + i * 8192, R, C); const int Rb = Epi::PERM ? ((R & ~31) + perm32(R & 31)) : R;
        voffA[i] = (unsigned)(R * g.lda + C) * 2u; voffB[i] = (unsigned)(Rb * K + C) * 2u; }
    const size_t kstep = (size_t)(BK * 2);
    const size_t hstepA = (size_t)HALF * g.lda * 2, hstepB = (size_t)HALF * K * 2;
    const size_t tstepA = 2 * hstepA, tstepB = 2 * hstepB;
    const unsigned ldsw = (unsigned)wid * 1024u;
    const int aoff = lds_byte(wr * 64 + fr, fq * 8), boff = lds_byte(wc * 32 + fr, fq * 8);
#define PG8_SA(b, h) (((b) * 2 + (h)) * HTB)
#define PG8_SB(b, h) ((4 + (b) * 2 + (h)) * HTB)
#define PG8_STAGE(bufoff, gbase, voff) do { _Pragma("unroll") for (int _i = 0; _i < 2; ++_i) \
        __builtin_amdgcn_global_load_lds((const unsigned*)((const char*)(gbase) + (voff)[_i]), (LAS unsigned*)(lds + (bufoff) + ldsw + _i * 8192), 16, 0, 0); } while (0)
#define PG8_LDA(dst, b, h) do { _Pragma("unroll") for (int m = 0; m < 4; ++m) _Pragma("unroll") for (int k = 0; k < 2; ++k) dst[m][k] = *(const LAS bf16x8*)(lds + PG8_SA(b, h) + aoff + m * 2048 + k * 1024); } while (0)
#define PG8_LDB(dst, b, h) do { _Pragma("unroll") for (int n = 0; n < 2; ++n) _Pragma("unroll") for (int k = 0; k < 2; ++k) dst[n][k] = *(const LAS bf16x8*)(lds + PG8_SB(b, h) + boff + n * 2048 + k * 1024); } while (0)
#define PG8_MMA(ai, bj, At, Bt) do { __builtin_amdgcn_s_setprio(1); _Pragma("unroll") for (int m = 0; m < 4; ++m) _Pragma("unroll") for (int n = 0; n < 2; ++n) _Pragma("unroll") for (int k = 0; k < 2; ++k) \
        acc[ai][bj][m][n] = __builtin_amdgcn_mfma_f32_16x16x32_bf16(Bt[n][k], At[m][k], acc[ai][bj][m][n], 0, 0, 0); __builtin_amdgcn_s_setprio(0); } while (0)
#define PG8_WAIT_V(n) asm volatile("s_waitcnt vmcnt(" #n ")" ::: "memory")
#define PG8_WAIT_L(n) asm volatile("s_waitcnt lgkmcnt(" #n ")" ::: "memory")
#define PG8_BAR __builtin_amdgcn_s_barrier()
#define PG8_SCHED __builtin_amdgcn_sched_barrier(0)
    Unit cur, nxt; int ui = 0;
    if (!S.next(0, cur)) return;
    f32x4 acc[2][2][4][2];
    if constexpr (Epi::HAS_INIT) { E.init(acc, cur, wr, wc, fr, fq); }
    else {
#pragma unroll
    for (int a = 0; a < 2; ++a)
#pragma unroll
        for (int b = 0; b < 2; ++b)
#pragma unroll
            for (int m = 0; m < 4; ++m)
#pragma unroll
                for (int n = 0; n < 2; ++n) acc[a][b][m][n] = (f32x4){0.f, 0.f, 0.f, 0.f};
    }
    bf16x8 At[4][2], B0[2][2], B1[2][2];
    const char* cA = (const char*)g.A + (size_t)cur.pm * tstepA; const char* cB = (const char*)g.Bt + (size_t)cur.pn * tstepB;
    PG8_STAGE(PG8_SB(0, 0), cB, voffB); PG8_STAGE(PG8_SB(0, 1), cB + hstepB, voffB); PG8_STAGE(PG8_SA(0, 0), cA, voffA); PG8_STAGE(PG8_SA(0, 1), cA + hstepA, voffA);
    if (wr == 1) PG8_BAR;
    PG8_WAIT_V(2); PG8_BAR;
    PG8_STAGE(PG8_SB(1, 0), cB + kstep, voffB); PG8_STAGE(PG8_SA(1, 0), cA + kstep, voffA); PG8_STAGE(PG8_SB(1, 1), cB + hstepB + kstep, voffB);
    PG8_WAIT_V(6); PG8_BAR;
    for (;;) {
        const bool has_next = S.next(ui + 1, nxt);
        const char* nA = has_next ? (const char*)g.A + (size_t)nxt.pm * tstepA : cA; const char* nB = has_next ? (const char*)g.Bt + (size_t)nxt.pn * tstepB : cB;
        for (int t = 0; t < nt; t += 2) {
            const bool last = (t == nt - 2);
            const char* a1 = cA + (size_t)(t + 1) * kstep;
            const char* a2 = last ? nA : cA + (size_t)(t + 2) * kstep; const char* b2 = last ? nB : cB + (size_t)(t + 2) * kstep;
            const char* a3 = a2 + kstep; const char* b3 = b2 + kstep;
            PG8_LDB(B0, 0, 0); PG8_LDB(B1, 0, 1); PG8_SCHED; PG8_LDA(At, 0, 0); PG8_STAGE(PG8_SA(1, 1), a1 + hstepA, voffA);
            PG8_WAIT_V(8); PG8_WAIT_L(0); PG8_BAR; PG8_MMA(0, 0, At, B0); PG8_MMA(0, 1, At, B1); PG8_BAR; PG8_SCHED;
            PG8_LDA(At, 0, 1); PG8_STAGE(PG8_SB(0, 0), b2, voffB); PG8_STAGE(PG8_SB(0, 1), b2 + hstepB, voffB); PG8_STAGE(PG8_SA(0, 0), a2, voffA);
            PG8_WAIT_V(8); PG8_WAIT_L(0); PG8_BAR; PG8_MMA(1, 0, At, B0); PG8_MMA(1, 1, At, B1); PG8_BAR; PG8_SCHED;
            PG8_LDB(B0, 1, 0); PG8_LDB(B1, 1, 1); PG8_SCHED; PG8_LDA(At, 1, 0); PG8_STAGE(PG8_SA(0, 1), a2 + hstepA, voffA);
            PG8_WAIT_V(8); PG8_WAIT_L(0); PG8_BAR; PG8_MMA(0, 0, At, B0); PG8_MMA(0, 1, At, B1); PG8_BAR; PG8_SCHED;
            PG8_LDA(At, 1, 1); PG8_STAGE(PG8_SB(1, 0), b3, voffB); PG8_STAGE(PG8_SB(1, 1), b3 + hstepB, voffB); PG8_STAGE(PG8_SA(1, 0), a3, voffA);
            PG8_WAIT_V(8); PG8_WAIT_L(0); PG8_BAR; PG8_MMA(1, 0, At, B0); PG8_MMA(1, 1, At, B1); PG8_BAR; PG8_SCHED;
        }
        if constexpr (ALIGN_EPI) { if (wr == 0) PG8_BAR; }
        E(acc, cur, wr, wc, fr, fq);
        if (!has_next) break;
        if constexpr (Epi::HAS_INIT) { E.init(acc, nxt, wr, wc, fr, fq); }
        else {
#pragma unroll
        for (int a = 0; a < 2; ++a)
#pragma unroll
            for (int b = 0; b < 2; ++b)
#pragma unroll
                for (int m = 0; m < 4; ++m)
#pragma unroll
                    for (int n = 0; n < 2; ++n) acc[a][b][m][n] = (f32x4){0.f, 0.f, 0.f, 0.f};
        }
        cur = nxt; cA = nA; cB = nB; ++ui;
        if constexpr (ALIGN_EPI) { if (wr == 1) PG8_BAR; }
    }
    PG8_WAIT_V(0);
    if constexpr (!ALIGN_EPI) { if (wr == 0) PG8_BAR; }
    PG8_BAR;
#undef PG8_SA
#undef PG8_SB
#undef PG8_STAGE
#undef PG8_LDA
#undef PG8_LDB
#undef PG8_MMA
#undef PG8_WAIT_V
#undef PG8_WAIT_L
#undef PG8_BAR
#undef PG8_SCHED
}
}

#define XB_TMO      128
#define XB_XCNT(j)  (256  + 64 * (j))
#define XB_XSUB(j)  (1280 + 64 * (j))
#define XB_XGEN(j)  (2304 + 64 * (j))
#define XB_TOP      3328
#define XB_TOPGEN   3392
#define XCD_BAR_WORDS 3456
#define XB_SPIN_CAP (1u << 18)
__device__ __forceinline__ unsigned xb_ld(unsigned* p)              { return __hip_atomic_load(p, __ATOMIC_RELAXED, __HIP_MEMORY_SCOPE_AGENT); }
__device__ __forceinline__ unsigned xb_add(unsigned* p, unsigned v) { return __hip_atomic_fetch_add(p, v, __ATOMIC_RELAXED, __HIP_MEMORY_SCOPE_AGENT); }
__device__ __forceinline__ unsigned xb_xcc_id() { return (unsigned)__builtin_amdgcn_s_getreg((3 << 11) | 20) & 0xFu; }
#define XB_SPIN(cond, bar) do { unsigned _sp = 0; while (cond) { __builtin_amdgcn_s_sleep(1); \
    if ((++_sp & 255u) == 0u) { if (xb_ld(&(bar)[XB_TMO])) break; if (_sp > XB_SPIN_CAP) { atomicAdd(&(bar)[XB_TMO], 1u); break; } } } } while (0)
struct XcdBarrier { unsigned* bar; unsigned x; volatile LAS unsigned* st; };
__device__ __forceinline__ XcdBarrier xcd_barrier_post(unsigned* bar, volatile LAS unsigned* st) {
    XcdBarrier b; b.bar = bar; b.x = xb_xcc_id(); b.st = st;
    if (threadIdx.x == 0) (void)xb_add(&bar[XB_XCNT(b.x)], 1u);
    return b;
}
__device__ __forceinline__ void xcd_barrier_complete(unsigned* bar, unsigned x, unsigned& nloc, unsigned& nx) {
    const unsigned G = gridDim.x * gridDim.y * gridDim.z;
    unsigned sum, cnt, mine, sp = 0u;
    for (;;) {
        sum = 0u; cnt = 0u; mine = 0u;
#pragma unroll
        for (unsigned j = 0; j < 16; ++j) { const unsigned c = xb_ld(&bar[XB_XCNT(j)]); sum += c; cnt += (c > 0u) ? 1u : 0u; mine = (j == x) ? c : mine; }
        if (sum == G) break;
        __builtin_amdgcn_s_sleep(1);
        if ((++sp & 255u) == 0u) { if (xb_ld(&bar[XB_TMO])) break; if (sp > XB_SPIN_CAP) { atomicAdd(&bar[XB_TMO], 1u); break; } }
    }
    nloc = mine > 0u ? mine : 1u; nx = cnt > 0u ? cnt : 1u;
}
__device__ __forceinline__ void xcd_barrier(const XcdBarrier& b) {
    asm volatile("s_waitcnt vmcnt(0)" ::: "memory");
    __syncthreads();
    if (threadIdx.x == 0) {
        unsigned* bar = b.bar;
        __builtin_amdgcn_s_waitcnt(0);
        unsigned nloc = b.st[0], nx = b.st[1];
        if (nloc == 0u) { xcd_barrier_complete(bar, b.x, nloc, nx); b.st[0] = nloc; b.st[1] = nx; }
        const unsigned old = xb_add(&bar[XB_XSUB(b.x)], 1u);
        const unsigned gen = old / nloc;
        if (old + 1u == (gen + 1u) * nloc) {
            __builtin_amdgcn_fence(__ATOMIC_RELEASE, "agent");
            asm volatile("s_waitcnt vmcnt(0)" ::: "memory");
            const unsigned og = xb_add(&bar[XB_TOP], 1u);
            const unsigned tg = og / nx;
            if (og + 1u == (tg + 1u) * nx) xb_add(&bar[XB_TOPGEN], 1u);
            else XB_SPIN(xb_ld(&bar[XB_TOPGEN]) == tg, bar);
            __builtin_amdgcn_fence(__ATOMIC_ACQUIRE, "agent");
            xb_add(&bar[XB_XGEN(b.x)], 1u);
            asm volatile("s_waitcnt vmcnt(0)" ::: "memory");
        } else {
            XB_SPIN(xb_ld(&bar[XB_XGEN(b.x)]) == gen, bar);
            __builtin_amdgcn_fence(__ATOMIC_ACQUIRE, "agent");
            asm volatile("s_waitcnt vmcnt(0)" ::: "memory");
        }
    }
    __syncthreads();
}

struct Args {
    const float* x; const float* norm1_w; const float* w_in; const float* conv_w; const float* conv_b; const float* igate_b; const float* fgate_b;
    const float* q_norm_w; const float* k_norm_w; const float* mlstm_norm_w; const float* attn_norm_w; const float* w_out; const float* norm2_w;
    const float* w_gate; const float* w_up; const float* w_down;
    float* out; unsigned char* ws; int dry; int pad;
};

struct TItem { const float* W; bf16* WT; const float* kscale; int ldw, K, nsrc0, ndst0, k0; };
__device__ __forceinline__ void titem_load(const TItem& t, f32x4 (&v)[8], int lane) {
    const float* src = t.W + (size_t)(t.k0 + (lane >> 3)) * t.ldw + t.nsrc0 + (lane & 7) * 4;
#pragma unroll
    for (int i = 0; i < 8; ++i) v[i] = *(const f32x4*)(src + (size_t)(8 * i) * t.ldw);
}
__device__ __forceinline__ void titem_finish(const TItem& t, const f32x4 (&v)[8], LAS float* scr, int lane) {
#pragma unroll
    for (int i = 0; i < 8; ++i) { const int kk = 8 * i + (lane >> 3); const float sc = t.kscale ? t.kscale[t.k0 + kk] : 1.0f; LAS float* d = scr + kk * 33 + (lane & 7) * 4;
        d[0] = v[i][0] * sc; d[1] = v[i][1] * sc; d[2] = v[i][2] * sc; d[3] = v[i][3] * sc; }
    LDS_WAIT(); asm volatile("" ::: "memory");
    const int c = lane & 7;
#pragma unroll
    for (int j = 0; j < 4; ++j) { const int n = (lane >> 3) + 8 * j; const LAS float* s = scr + (8 * c) * 33 + n;
        u32x4 o; o.x = cvtpk(s[0 * 33], s[1 * 33]); o.y = cvtpk(s[2 * 33], s[3 * 33]); o.z = cvtpk(s[4 * 33], s[5 * 33]); o.w = cvtpk(s[6 * 33], s[7 * 33]);
        *(u32x4*)(t.WT + (size_t)(t.ndst0 + n) * t.K + t.k0 + 8 * c) = o; }
    LDS_WAIT(); asm volatile("" ::: "memory");
}
__device__ __forceinline__ int win_src_col(int nd) {
    if (nd < 1024) return nd;
    if (nd < 2048) return nd + 1024;
    if (nd < 3072) return nd - 1024;
    return nd + 8;
}


__device__ __forceinline__ float scan_add64(float v, int lane) {
#pragma unroll
    for (int o = 1; o < 64; o <<= 1) { const float t = __shfl_up(v, o); if (lane >= o) v += t; }
    return v;
}
__device__ __forceinline__ float scan_max64(float v, int lane) {
#pragma unroll
    for (int o = 1; o < 64; o <<= 1) { const float t = __shfl_up(v, o); if (lane >= o) v = fmaxf(v, t); }
    return v;
}
template <bool ROWW>
__device__ __forceinline__ void conv_tile(const bf16* proj, const float* conv_w, const float* conv_b, int b, int c, int col0, int ch0, float rscale, float wlane, LAS unsigned char* tile, int tid) {
    const int rr = tid >> 4, cc = (tid & 15) * 8;
    float w[4][8], bb[8];
#pragma unroll
    for (int j = 0; j < 4; ++j) { const f32x4 w0 = *(const f32x4*)(conv_w + j * 1024 + ch0 + cc), w1 = *(const f32x4*)(conv_w + j * 1024 + ch0 + cc + 4);
        w[j][0] = w0[0]; w[j][1] = w0[1]; w[j][2] = w0[2]; w[j][3] = w0[3]; w[j][4] = w1[0]; w[j][5] = w1[1]; w[j][6] = w1[2]; w[j][7] = w1[3]; }
    { const f32x4 b0 = *(const f32x4*)(conv_b + ch0 + cc), b1 = *(const f32x4*)(conv_b + ch0 + cc + 4);
      bb[0] = b0[0]; bb[1] = b0[1]; bb[2] = b0[2]; bb[3] = b0[3]; bb[4] = b1[0]; bb[5] = b1[1]; bb[6] = b1[2]; bb[7] = b1[3]; }
#pragma unroll
    for (int half = 0; half < 2; ++half) {
        const int l = rr + 32 * half, t = c * 64 + l;
        float y[8];
#pragma unroll
        for (int e = 0; e < 8; ++e) y[e] = bb[e];
#pragma unroll
        for (int j = 0; j < 4; ++j) { const int tt = t - 3 + j;
            if (tt >= 0) { const u32x4 raw = *(const u32x4*)(proj + (size_t)(b * SEQ + tt) * NPROJ + col0 + cc); float x[8]; unpack8(raw, x);
#pragma unroll
                for (int e = 0; e < 8; ++e) y[e] += w[j][e] * x[e]; } }
        float sc = rscale;
        if (ROWW) sc *= __shfl(wlane, l);
#pragma unroll
        for (int e = 0; e < 8; ++e) y[e] = y[e] / (1.0f + __expf(-y[e])) * sc;
        *(LAS u32x4*)(tile + l * 288 + cc * 2) = pack8(y);
    }
}
__device__ __forceinline__ void v_tile(const bf16* proj, int b, int c, int h, LAS unsigned char* tile, int tid) {
#pragma unroll
    for (int p = 0; p < 4; ++p) { const int row = p * 16 + (tid >> 5), ch = tid & 31;
        const u32x4 v = *(const u32x4*)(proj + (size_t)(b * SEQ + c * 64 + row) * NPROJ + PC_MV + h * 256 + ch * 8);
        *(LAS u32x4*)(tile + row * 544 + ch * 16) = v; }
}

__device__ __forceinline__ void q_prep(const bf16* qrow, const float* rcos, const float* rsin, const float* qnw, int tq, int g, bf16x8 (&qf)[4]) {
    float q[4][8]; float ss = 0.f;
#pragma unroll
    for (int ks = 0; ks < 4; ++ks) { const u32x4 raw = *(const u32x4*)(qrow + 32 * ks + 8 * g); unpack8(raw, q[ks]);
#pragma unroll
        for (int e = 0; e < 8; ++e) ss += q[ks][e] * q[ks][e]; }
    ss += __shfl_xor(ss, 16); ss += __shfl_xor(ss, 32);
    const float rq = 1.0f / sqrtf(ss * (1.0f / 128.0f) + NORM_EPS);
#pragma unroll
    for (int ks = 0; ks < 2; ++ks) {
        const int c0 = 32 * ks + 8 * g;
#pragma unroll
        for (int e4 = 0; e4 < 2; ++e4) {
            const f32x4 cs = *(const f32x4*)(rcos + tq * 64 + c0 + 4 * e4), sn = *(const f32x4*)(rsin + tq * 64 + c0 + 4 * e4);
            const f32x4 w1 = *(const f32x4*)(qnw + c0 + 4 * e4), w2 = *(const f32x4*)(qnw + 64 + c0 + 4 * e4);
#pragma unroll
            for (int e = 0; e < 4; ++e) { const float y1 = q[ks][4 * e4 + e] * rq * w1[e], y2 = q[ks + 2][4 * e4 + e] * rq * w2[e];
                q[ks][4 * e4 + e] = y1 * cs[e] - y2 * sn[e]; q[ks + 2][4 * e4 + e] = y2 * cs[e] + y1 * sn[e]; }
        }
    }
#pragma unroll
    for (int ks = 0; ks < 4; ++ks) { const u32x4 w = pack8(q[ks]); qf[ks] = __builtin_bit_cast(bf16x8, w); }
}
struct AUnit { int b, h, d, r, n; bf16* po0; float* pl0; };
template <bool FINAL>
__device__ __forceinline__ void attn_pair(bf16* proj, const float* rcos, const float* rsin, const float* qnw, const float* anw, const AUnit& ua, const AUnit& ub,
                                          LAS unsigned char* lds_all, bf16* po1, float* pl1, int tid_in, bool dry) {
    int tid = tid_in; asm volatile("" : "+v"(tid));
    const int lane = tid & 63, wave = __builtin_amdgcn_readfirstlane(tid >> 6);
    const int team = wave >> 2, w4 = wave & 3;
    const int b = team ? ub.b : ua.b, h = team ? ub.h : ua.h, d = team ? ub.d : ua.d, r = team ? ub.r : ua.r, n = team ? ub.n : ua.n;
    bf16* po0 = team ? ub.po0 : ua.po0; float* pl0 = team ? ub.pl0 : ua.pl0;
    LAS unsigned char* lds = lds_all + team * 36864;
    const int j = lane & 15, g = lane >> 4, qp = j >> 2, p = lane & 3;
    const int tt = tid & 255, srow = tt >> 4, sch = tt & 15;
    const bf16* kcol = proj + (size_t)b * SEQ * NPROJ + PC_AK + h * 128 + sch * 8;
    const bf16* vcol = kcol + (PC_AV - PC_AK);
    const int kt0 = (n == 0) ? 4 : 0;
    const int sub0 = 128 * (n - 1) + srow;
    u32x4 rk[2][2], rv[2][2];
#define AT_ISSUE(set, t) do { if ((t) < 8) { _Pragma("unroll") for (int hh_ = 0; hh_ < 2; ++hh_) { const size_t tok_ = (size_t)((sub0 + 32 * (t) + 16 * hh_) * d + r); \
        rk[set][hh_] = *(const u32x4*)(kcol + tok_ * NPROJ); rv[set][hh_] = *(const u32x4*)(vcol + tok_ * NPROJ); } } } while (0)
#define AT_WRITE(set, t) do { LAS unsigned char* Kn_ = lds + ((t) & 1) * 18432; _Pragma("unroll") for (int hh_ = 0; hh_ < 2; ++hh_) { \
        *(LAS u32x4*)(Kn_ + (srow + 16 * hh_) * 288 + sch * 16) = rk[set][hh_]; *(LAS u32x4*)(Kn_ + 9216 + (srow + 16 * hh_) * 288 + sch * 16) = rv[set][hh_]; } } while (0)
#define WG_BAR() do { asm volatile("s_waitcnt lgkmcnt(0)" ::: "memory"); __builtin_amdgcn_s_barrier(); asm volatile("" ::: "memory"); } while (0)
    AT_ISSUE(0, kt0); AT_ISSUE(1, kt0 + 1);
    bf16x8 qf[2][4]; int qi[2]; int tq[2];
    qi[0] = 32 * w4 + j; qi[1] = qi[0] + 16; tq[0] = (128 * n + qi[0]) * d + r; tq[1] = (128 * n + qi[1]) * d + r;
#pragma unroll
    for (int gi = 0; gi < 2; ++gi) { const bf16* qrow = proj + (size_t)(b * SEQ + tq[gi]) * NPROJ + PC_AQ + h * 128 + 8 * g;
#pragma unroll
        for (int ks = 0; ks < 4; ++ks) qf[gi][ks] = *(const bf16x8*)(qrow + 32 * ks); }
    AT_WRITE(0, kt0);
    for (int kb_ = 0; kb_ < kt0; ++kb_) WG_BAR();
    WG_BAR();
    float m_run[2] = {-1e30f, -1e30f}, l_run[2] = {0.f, 0.f};
    f32x4 o[2][8];
    if (FINAL) {
#pragma unroll
        for (int gi = 0; gi < 2; ++gi) { const size_t trow = (size_t)(b * SEQ + tq[gi]);
            const float l0 = pl0[trow * 8 + h], l1 = pl1[trow * 8 + h]; const float m0 = fmaxf(l0, l1);
            const float a0 = __builtin_amdgcn_exp2f(l0 - m0), a1 = __builtin_amdgcn_exp2f(l1 - m0);
            m_run[gi] = m0; l_run[gi] = (g == 0) ? a0 + a1 : 0.f;
            const bf16* p0 = po0 + trow * 1024 + h * 128 + g * 32; const bf16* p1 = po1 + trow * 1024 + h * 128 + g * 32;
#pragma unroll
            for (int np = 0; np < 4; ++np) { const u32x4 x0 = *(const u32x4*)(p0 + 8 * np), x1 = *(const u32x4*)(p1 + 8 * np); float f0[8], f1[8]; unpack8(x0, f0); unpack8(x1, f1);
#pragma unroll
                for (int e = 0; e < 4; ++e) { o[gi][2 * np][e] = a0 * f0[e] + a1 * f1[e]; o[gi][2 * np + 1][e] = a0 * f0[4 + e] + a1 * f1[4 + e]; } }
        }
    } else {
#pragma unroll
        for (int gi = 0; gi < 2; ++gi)
#pragma unroll
            for (int nf = 0; nf < 8; ++nf) o[gi][nf] = (f32x4){0.f, 0.f, 0.f, 0.f};
    }
    const float SC = 0.08838834764831845f * 1.4426950408889634f;
    const float NEG = -__builtin_inff();
#define AT_STEP(kt, setn, setw) do { \
        LAS unsigned char* Kt = lds + ((kt) & 1) * 18432; LAS unsigned char* Vt = Kt + 9216; \
        AT_ISSUE(setn, (kt) + 2); \
        if ((kt) >= w4 && (kt) <= w4 + 4) { \
            f32x4 sA[2], sB[2]; sA[0] = (f32x4){0.f, 0.f, 0.f, 0.f}; sA[1] = sA[0]; sB[0] = sA[0]; sB[1] = sA[0]; \
            _Pragma("unroll") for (int ks = 0; ks < 4; ++ks) { \
                const bf16x8 k0 = *(const LAS bf16x8*)(Kt + j * 288 + (32 * ks + 8 * g) * 2), k1 = *(const LAS bf16x8*)(Kt + (16 + j) * 288 + (32 * ks + 8 * g) * 2); \
                sA[0] = MFMA16(k0, qf[0][ks], sA[0]); sB[0] = MFMA16(k1, qf[0][ks], sB[0]); sA[1] = MFMA16(k0, qf[1][ks], sA[1]); sB[1] = MFMA16(k1, qf[1][ks], sB[1]); } \
            bf16x8 pb[2]; \
            _Pragma("unroll") for (int gi = 0; gi < 2; ++gi) { \
                const f32x4 s0 = sA[gi], s1 = sB[gi]; \
                float x[8]; float tmax = NEG; \
                _Pragma("unroll") for (int e = 0; e < 8; ++e) { const int kj = 32 * (kt) + 16 * (e >> 2) + 4 * g + (e & 3); const float sv = (e < 4) ? s0[e & 3] : s1[e & 3]; \
                    const bool valid = (kj >= qi[gi]) && (kj <= qi[gi] + 128); \
                    x[e] = valid ? sv * SC : NEG; tmax = fmaxf(tmax, x[e]); } \
                tmax = fmaxf(tmax, __shfl_xor(tmax, 16)); tmax = fmaxf(tmax, __shfl_xor(tmax, 32)); \
                const float m_new = fmaxf(m_run[gi], tmax); \
                const float alpha = __builtin_amdgcn_exp2f(m_run[gi] - m_new); \
                float ps = 0.f; \
                _Pragma("unroll") for (int e = 0; e < 8; ++e) { x[e] = __builtin_amdgcn_exp2f(x[e] - m_new); ps += x[e]; } \
                l_run[gi] = l_run[gi] * alpha + ps; m_run[gi] = m_new; \
                _Pragma("unroll") for (int nf = 0; nf < 8; ++nf) o[gi][nf] = o[gi][nf] * alpha; \
                const u32x4 pw = pack8(x); pb[gi] = __builtin_bit_cast(bf16x8, pw); } \
            _Pragma("unroll") for (int nf = 0; nf < 8; ++nf) { \
                const s16x4 a0 = vtr(Vt + (4 * g + qp) * 288 + (16 * nf + 4 * p) * 2), a1 = vtr(Vt + (16 + 4 * g + qp) * 288 + (16 * nf + 4 * p) * 2); \
                const bf16x8 vf = cat4(a0, a1); \
                o[0][nf] = MFMA16(vf, pb[0], o[0][nf]); o[1][nf] = MFMA16(vf, pb[1], o[1][nf]); } \
        } \
        if ((kt) + 1 < 8) AT_WRITE(setw, (kt) + 1); \
        WG_BAR(); } while (0)
#pragma unroll 1
    for (int kt = kt0; kt < 8; kt += 2) { AT_STEP(kt, 0, 1); AT_STEP(kt + 1, 1, 0); }
#undef AT_STEP
#undef AT_ISSUE
#undef AT_WRITE
#pragma unroll
    for (int gi = 0; gi < 2; ++gi) {
        float lr = l_run[gi]; lr += __shfl_xor(lr, 16); lr += __shfl_xor(lr, 32);
        const float inv = 1.0f / lr;
        const float lse2 = m_run[gi] + __log2f(lr);
        const size_t trow = (size_t)(b * SEQ + tq[gi]);
        if (!FINAL) {
            bf16* pp = po0 + trow * 1024 + h * 128 + g * 32;
#pragma unroll
            for (int np = 0; np < 4; ++np) { const f32x4 va = o[gi][2 * np] * inv, vb = o[gi][2 * np + 1] * inv; u32x4 ww; ww.x = cvtpk(va[0], va[1]); ww.y = cvtpk(va[2], va[3]); ww.z = cvtpk(vb[0], vb[1]); ww.w = cvtpk(vb[2], vb[3]);
                if (!dry) *(u32x4*)(pp + 8 * np) = ww; }
            if (g == 0 && !dry) pl0[trow * 8 + h] = lse2;
        } else {
            bf16* qrow = proj + trow * NPROJ + PC_AQ + h * 128;
            float ss = 0.f;
#pragma unroll
            for (int nf = 0; nf < 8; ++nf) { const f32x4 v = o[gi][nf] * inv; o[gi][nf] = v; ss += (v[0] * v[0] + v[1] * v[1]) + (v[2] * v[2] + v[3] * v[3]); }
            ss += __shfl_xor(ss, 16); ss += __shfl_xor(ss, 32);
            const float rn = 1.0f / sqrtf(ss * (1.0f / 128.0f) + NORM_EPS);
#pragma unroll
            for (int nf = 0; nf < 8; ++nf) { const int e = 16 * nf + 4 * g; const f32x4 w = *(const f32x4*)(anw + h * 128 + e); const f32x4 v = o[gi][nf] * rn * w;
                u32x2 ww; ww.x = cvtpk(v[0], v[1]); ww.y = cvtpk(v[2], v[3]); if (!dry) *(u32x2*)(qrow + e) = ww; }
        }
    }
}

#ifndef PROBE_PHASE
#define PROBE_PHASE -1
#endif
#define REP_BEGIN(k) for (int rep_ = (PROBE_PHASE == (k)) ? 0 : 1; rep_ < 2; ++rep_) { const bool dry = (rep_ == 0) && (a.dry != 0); (void)dry; \
    int tid = threadIdx.x; asm volatile("" : "+v"(tid)); const int lane = tid & 63, wave = __builtin_amdgcn_readfirstlane(tid >> 6); \
    const int gw = vcu * NWAVES + wave, gt = vcu * (NWAVES * 64) + tid; (void)lane; (void)wave; (void)gw; (void)gt;
#define REP_END }

__global__ void __launch_bounds__(NWAVES * 64, 2) hymba_fwd(Args a) {
    extern __shared__ __attribute__((aligned(16))) unsigned char lds_raw[];
    LAS unsigned char* lds = (LAS unsigned char*)lds_raw;
    volatile LAS unsigned* MISC = (volatile LAS unsigned*)(lds + MISC_OFF);
    const int tid = threadIdx.x, lane = tid & 63, wave = __builtin_amdgcn_readfirstlane(tid >> 6);
    const int G = gridDim.x; const int bx = blockIdx.x; const int vcu = (G % 8 == 0) ? (bx % 8) * (G / 8) + bx / 8 : bx;
    unsigned char* ws = a.ws;
    unsigned* ctl = (unsigned*)(ws + WS_CTL);
    float* gli = (float*)(ws + WS_GLI); float* glf = (float*)(ws + WS_GLF); float* sumsq = (float*)(ws + WS_SUMSQ);
    float* msc_g = (float*)(ws + WS_MSC); float* msc_ml = msc_g + 512; float* msc_mp = msc_g + 1024;
    float* ncb = (float*)(ws + WS_NC);
    float* rcos = (float*)(ws + WS_COS); float* rsin = (float*)(ws + WS_SIN);
    bf16* WinT = (bf16*)(ws + WS_WIN); bf16* kvT = (bf16*)(ws + WS_KV); bf16* Ub = (bf16*)(ws + WS_U); bf16* H1b = (bf16*)(ws + WS_U);
    bf16* proj = (bf16*)(ws + WS_PROJ); bf16* FF = (bf16*)(ws + WS_PROJ);
    bf16* op0 = (bf16*)(ws + WS_OP0); bf16* op1 = (bf16*)(ws + WS_OP1); float* pl0 = (float*)(ws + WS_PL0); float* pl1 = (float*)(ws + WS_PL1);
    bf16* WoutT = (bf16*)(ws + WS_WOUT); bf16* WguT = (bf16*)(ws + WS_WGU); bf16* WdnT = (bf16*)(ws + WS_WDN);

    for (int u = tid; u < (LDS_BYTES - MISC_OFF) / 4; u += NWAVES * 64) ((LAS unsigned*)(lds + MISC_OFF))[u] = 0u;
    __syncthreads();
    XcdBarrier bar = xcd_barrier_post(ctl + CW_BAR, MISC + 8);
    const int NGW = G * NWAVES, NGT = G * NWAVES * 64;

    REP_BEGIN(0)
        for (int i = gt; i < MTOK; i += NGT) sumsq[i] = 0.f;
        for (int i = gt; i < SEQ * 64; i += NGT) {
            const int pos = i >> 6, fi = i & 63;
            const float invf = (float)exp2(-(double)fi * (13.287712379549449 / 64.0));
            const float ang = (float)pos * invf;
            const double rev = (double)ang * 0.15915494309189535; const double fr_ = rev - rint(rev);
            const float ar = (float)(fr_ * 6.283185307179586);
            rcos[i] = cosf(ar); rsin[i] = sinf(ar);
        }
        {
            LAS float* scr = (LAS float*)(lds + wave * 16384);
            constexpr int I_IN = (DM / 64) * (NPROJ / 32), I_OUT = (DM / 64) * (DM / 32), I_GU = (DM / 64) * (NGU / 32), I_DN = (DFF / 64) * (DM / 32);
            constexpr int NITEMS = I_IN + I_OUT + I_GU;
            auto decode = [&](int it) -> TItem {
                TItem t; int r = it;
                if (r < I_IN) { const int nblk = NPROJ / 32, kb = r / nblk, nb = r % nblk; t = TItem{a.w_in, WinT, nullptr, INW, DM, win_src_col(nb * 32), nb * 32, kb * 64}; return t; } r -= I_IN;
                if (r < I_OUT) { const int nblk = DM / 32, kb = r / nblk, nb = r % nblk; t = TItem{a.w_out, WoutT, nullptr, DM, DM, nb * 32, nb * 32, kb * 64}; return t; } r -= I_OUT;
                { const int nblk = NGU / 32, kb = r / nblk, nb = r % nblk; const int nd = nb * 32, pn = nd >> 8, j = nd & 255;
                    t = TItem{(j < 128) ? a.w_gate : a.w_up, WguT, a.norm2_w, DFF, DM, pn * 128 + (j & 127), nd, kb * 64}; return t; }
            };
            int it = gw;
            if (it < NITEMS) {
                TItem cur = decode(it); f32x4 vc[8]; titem_load(cur, vc, lane);
                for (;;) {
                    const int nx = it + NGW; const bool more = nx < NITEMS;
                    TItem nt = cur; f32x4 vn[8];
                    if (more) { nt = decode(nx); titem_load(nt, vn, lane); }
                    titem_finish(cur, vc, scr, lane);
                    if (!more) break;
                    cur = nt; it = nx;
#pragma unroll
                    for (int i = 0; i < 8; ++i) vc[i] = vn[i];
                }
            }
        }
        __syncthreads();
        LAS float* wg = (LAS float*)lds;
        for (int k = tid; k < DM; k += NWAVES * 64) { const f32x4 g0 = *(const f32x4*)(a.w_in + (size_t)k * INW + 3072), g1 = *(const f32x4*)(a.w_in + (size_t)k * INW + 3076);
            wg[0 * DM + k] = g0[0]; wg[1 * DM + k] = g0[1]; wg[2 * DM + k] = g0[2]; wg[3 * DM + k] = g0[3];
            wg[4 * DM + k] = g1[0]; wg[5 * DM + k] = g1[1]; wg[6 * DM + k] = g1[2]; wg[7 * DM + k] = g1[3]; }
        __syncthreads();
        for (int m = gw; m < MTOK; m += NGW) {
            const f32x4* xr = (const f32x4*)(a.x + (size_t)m * DM) + lane; const f32x4* wr_ = (const f32x4*)a.norm1_w + lane;
            f32x4 v[8]; float s = 0.f;
#pragma unroll
            for (int j = 0; j < 8; ++j) { v[j] = xr[64 * j]; s += (v[j][0] * v[j][0] + v[j][1] * v[j][1]) + (v[j][2] * v[j][2] + v[j][3] * v[j][3]); }
            const float rstd = 1.0f / sqrtf(wave_sum(s) * (1.0f / DM) + NORM_EPS);
            u32x2* o8 = (u32x2*)(Ub + (size_t)m * DM) + lane;
#pragma unroll
            for (int j = 0; j < 8; ++j) { v[j] = v[j] * rstd * wr_[64 * j]; u32x2 w; w.x = cvtpk(v[j][0], v[j][1]); w.y = cvtpk(v[j][2], v[j][3]); o8[64 * j] = w; }
            float z = 0.f;
#pragma unroll 1
            for (int gi = 0; gi < 8; ++gi) { float t = 0.f;
#pragma unroll
                for (int j = 0; j < 8; ++j) { const f32x4 w4 = *(const LAS f32x4*)(wg + gi * DM + 256 * j + 4 * lane); t += (v[j][0] * w4[0] + v[j][1] * w4[1]) + (v[j][2] * w4[2] + v[j][3] * w4[3]); }
                t = wave_sum(t); z = (lane == gi) ? t : z; }
            if (lane < 8) {
                const int hh = lane & 3;
                if (lane < 4) { gli[m * 4 + hh] = 15.0f * tanhf((z + a.igate_b[hh]) * (1.0f / 15.0f)); }
                else { const float fp = 15.0f * tanhf((z + a.fgate_b[hh]) * (1.0f / 15.0f)); glf[m * 4 + hh] = -log1pf(expf(-fp)); }
            }
        }
    REP_END
    xcd_barrier(bar);

    REP_BEGIN(1)
        pg8::Gemm g{Ub, WinT, MTOK, NPROJ, DM, DM}; pg8::StaticOrder S; S.init(MTOK, NPROJ, G, bx);
        pg8::EpiBf16 E{proj, NPROJ};
        pg8::gemm_phase<pg8::EpiBf16, true>(lds, g, S, E);
    REP_END
    xcd_barrier(bar);

    REP_BEGIN(2)
        {
            const int c0 = 4 * (tid & 15), rstride = NGT >> 4;
            for (int which = 0; which < 2; ++which) {
                const float* nw = which ? a.k_norm_w : a.q_norm_w; const int colb = which ? PC_AK : PC_AQ;
                const f32x4 w1 = *(const f32x4*)(nw + c0), w2 = *(const f32x4*)(nw + 64 + c0);
                for (int idx0 = gt >> 4; idx0 < MTOK * 8; idx0 += 4 * rstride) {
                    u32x2 r1[4], r2[4]; f32x4 cs[4], sn[4];
#pragma unroll
                    for (int q = 0; q < 4; ++q) { const int idx = idx0 + q * rstride;
                        if (idx < MTOK * 8) { const int m = idx >> 3, hh = idx & 7, pos = m & (SEQ - 1); const bf16* kp = proj + (size_t)m * NPROJ + colb + hh * 128;
                            r1[q] = *(const u32x2*)(kp + c0); r2[q] = *(const u32x2*)(kp + 64 + c0); cs[q] = *(const f32x4*)(rcos + pos * 64 + c0); sn[q] = *(const f32x4*)(rsin + pos * 64 + c0); } }
#pragma unroll
                    for (int q = 0; q < 4; ++q) { const int idx = idx0 + q * rstride;
                        if (idx < MTOK * 8) { const int m = idx >> 3, hh = idx & 7; bf16* kp = proj + (size_t)m * NPROJ + colb + hh * 128;
                            float x1[4] = {bf_lo(r1[q].x), bf_hi(r1[q].x), bf_lo(r1[q].y), bf_hi(r1[q].y)}, x2[4] = {bf_lo(r2[q].x), bf_hi(r2[q].x), bf_lo(r2[q].y), bf_hi(r2[q].y)};
                            float ss = 0.f;
#pragma unroll
                            for (int e = 0; e < 4; ++e) ss += x1[e] * x1[e] + x2[e] * x2[e];
                            ss += __shfl_xor(ss, 1); ss += __shfl_xor(ss, 2); ss += __shfl_xor(ss, 4); ss += __shfl_xor(ss, 8);
                            const float rk = 1.0f / sqrtf(ss * (1.0f / 128.0f) + NORM_EPS);
                            float o1[4], o2[4];
#pragma unroll
                            for (int e = 0; e < 4; ++e) { const float y1 = x1[e] * rk * w1[e], y2 = x2[e] * rk * w2[e]; o1[e] = y1 * cs[q][e] - y2 * sn[q][e]; o2[e] = y2 * cs[q][e] + y1 * sn[q][e]; }
                            u32x2 wv; wv.x = cvtpk(o1[0], o1[1]); wv.y = cvtpk(o1[2], o1[3]); if (!dry) *(u32x2*)(kp + c0) = wv;
                            wv.x = cvtpk(o2[0], o2[1]); wv.y = cvtpk(o2[2], o2[3]); if (!dry) *(u32x2*)(kp + 64 + c0) = wv; } }
                }
            }
        }
        LAS unsigned char* KW = lds; LAS unsigned char* VT = lds + 18432;
        const int g = lane >> 4, qp = (lane & 15) >> 2, p = lane & 3;
        for (int u = vcu; u < 512; u += G) {
            const int b = u >> 8, h = (u >> 6) & 3, c = u & 63;
            const int tok = b * SEQ + c * 64 + lane;
            const float li = gli[tok * 4 + h], lf = glf[tok * 4 + h];
            const float cf = scan_add64(lf, lane);
            const float gsum = __shfl(cf, 63);
            const float av = gsum - cf + li;
            const float ml = wave_max(av);
            const float wst = __expf(av - ml);
            if (tid == 0) { msc_g[u] = gsum; msc_ml[u] = ml; }
            conv_tile<true>(proj, a.conv_w, a.conv_b, b, c, PC_MK + h * 128, 512 + h * 128, 1.0f, wst, KW, tid);
            v_tile(proj, b, c, h, VT, tid);
            __syncthreads();
            f32x4 acc[8][2];
#pragma unroll
            for (int df = 0; df < 8; ++df) { acc[df][0] = (f32x4){0.f, 0.f, 0.f, 0.f}; acc[df][1] = (f32x4){0.f, 0.f, 0.f, 0.f}; }
#pragma unroll
            for (int kk = 0; kk < 2; ++kk) {
                bf16x8 bfr[2];
#pragma unroll
                for (int ef = 0; ef < 2; ++ef) { const int col = 32 * wave + 16 * ef + 4 * p;
                    bfr[ef] = cat4(vtr(VT + (32 * kk + 4 * g + qp) * 544 + col * 2), vtr(VT + (32 * kk + 16 + 4 * g + qp) * 544 + col * 2)); }
#pragma unroll
                for (int df = 0; df < 8; ++df) { const int col = 16 * df + 4 * p;
                    const bf16x8 af = cat4(vtr(KW + (32 * kk + 4 * g + qp) * 288 + col * 2), vtr(KW + (32 * kk + 16 + 4 * g + qp) * 288 + col * 2));
                    acc[df][0] = MFMA16(af, bfr[0], acc[df][0]); acc[df][1] = MFMA16(af, bfr[1], acc[df][1]); }
            }
#pragma unroll
            for (int ef = 0; ef < 2; ++ef) { const int e = 32 * wave + 16 * ef + (lane & 15);
#pragma unroll
                for (int df = 0; df < 8; ++df) { const f32x4 v = acc[df][ef]; u32x2 w; w.x = cvtpk(v[0], v[1]); w.y = cvtpk(v[2], v[3]);
                    *(u32x2*)(kvT + ((size_t)u * 256 + e) * 128 + 16 * df + 4 * g) = w; } }
            if (tid < 128) { float nsum = 0.f;
#pragma unroll 8
                for (int l = 0; l < 64; ++l) nsum += __uint_as_float((unsigned)(*(const LAS unsigned short*)(KW + l * 288 + tid * 2)) << 16);
                ncb[u * 128 + tid] = nsum; }
            __syncthreads();
        }
    REP_END
    xcd_barrier(bar);

    REP_BEGIN(3)
        LAS float* sg = (LAS float*)lds; LAS float* sml = sg + 512;
        for (int i = tid; i < 512; i += NWAVES * 64) { sg[i] = msc_g[i]; sml[i] = msc_ml[i]; }
        __syncthreads();
        for (int id = gt; id < 8 * 16384; id += NGT) {
            const int bh = id >> 14, pi = id & 16383;
            unsigned* base = (unsigned*)kvT + (size_t)bh * 64 * 16384 + pi;
            float c0 = 0.f, c1 = 0.f, m = 0.f;
#pragma unroll 1
            for (int cb = 0; cb < 64; cb += 32) {
                unsigned xv[32];
#pragma unroll
                for (int i = 0; i < 32; ++i) xv[i] = base[(size_t)(cb + i) * 16384];
#pragma unroll
                for (int i = 0; i < 32; ++i) {
                    const float gg = sg[bh * 64 + cb + i], ml = sml[bh * 64 + cb + i];
                    const float mn = fmaxf(gg + m, ml), so = __expf(gg + m - mn), sn = __expf(ml - mn);
                    if (!dry) base[(size_t)(cb + i) * 16384] = cvtpk(c0, c1);
                    c0 = so * c0 + sn * bf_lo(xv[i]); c1 = so * c1 + sn * bf_hi(xv[i]); m = mn;
                }
            }
        }
        for (int id = gt; id < 8 * 128; id += NGT) {
            const int bh = id >> 7, dd = id & 127; float n = 0.f, m = 0.f;
            float* nb_ = ncb + (size_t)bh * 64 * 128 + dd;
#pragma unroll 1
            for (int cb = 0; cb < 64; cb += 32) {
                float xv[32];
#pragma unroll
                for (int i = 0; i < 32; ++i) xv[i] = nb_[(cb + i) * 128];
#pragma unroll
                for (int i = 0; i < 32; ++i) {
                    const float gg = sg[bh * 64 + cb + i], ml = sml[bh * 64 + cb + i];
                    const float mn = fmaxf(gg + m, ml), so = __expf(gg + m - mn), sn = __expf(ml - mn);
                    if (!dry) nb_[(cb + i) * 128] = n;
                    if (dd == 0) msc_mp[bh * 64 + cb + i] = m;
                    n = so * n + sn * xv[i]; m = mn;
                }
            }
        }
        __syncthreads();
    REP_END
    REP_BEGIN(4)
        for (int pidx = vcu; pidx < 512; pidx += G) {
            AUnit ua, ub;
            { const int u = pidx; ua = AUnit{u >> 8, (u >> 5) & 7, 4, (u >> 3) & 3, u & 7, op0, pl0}; }
            { const int v = pidx; const int bb = v >> 8; ub = AUnit{bb, (v >> 5) & 7, 16, (v >> 1) & 15, (v ^ bb) & 1, op1, pl1}; }
            attn_pair<false>(proj, rcos, rsin, a.q_norm_w, a.attn_norm_w, ua, ub, lds, nullptr, nullptr, tid, dry);
        }
    REP_END
    xcd_barrier(bar);

    REP_BEGIN(5)
        LAS unsigned char* QT = lds; LAS unsigned char* KT = lds + 18432; LAS unsigned char* VT = lds + 36864;
        LAS float* NP = (LAS float*)(lds + 71680); LAS float* XCH = (LAS float*)(lds + 72192); LAS unsigned char* CP = lds + 72704;
        const int j = lane & 15, g = lane >> 4, qp = j >> 2, p = lane & 3;
        const int tf = wave & 3, eh = wave >> 2;
        for (int u = vcu; u < 512; u += G) {
            const int b = u >> 8, h = (u >> 6) & 3, c = u & 63;
            const int tok = b * SEQ + c * 64 + lane;
            const float li = gli[tok * 4 + h], lf = glf[tok * 4 + h];
            const float cf = scan_add64(lf, lane);
            const float bvec = li - cf;
            const float pm = scan_max64(bvec, lane);
            const float mprev = msc_mp[u];
            const float Mv = fmaxf(mprev, pm);
            const float wiv = __expf(mprev - Mv), emtv = __expf(-cf - Mv);
            {
                const bf16* csrc = kvT + (size_t)u * 256 * 128 + (size_t)(tid >> 4) * 128 + (tid & 15) * 8;
                u32x4 cv[8];
#pragma unroll
                for (int it = 0; it < 8; ++it) cv[it] = *(const u32x4*)(csrc + (size_t)it * 32 * 128);
#pragma unroll
                for (int it = 0; it < 8; ++it) *(LAS u32x4*)(CP + (it * 32 + (tid >> 4)) * 288 + (tid & 15) * 16) = cv[it];
            }
            const int t_ = 16 * (wave & 3) + j;
            const bf16* orow_ = proj + (size_t)(b * SEQ + c * 64 + t_) * NPROJ;
            u32x2 mo_pre[8];
#pragma unroll
            for (int ef = 0; ef < 8; ++ef) mo_pre[ef] = *(const u32x2*)(orow_ + PC_MO + h * 256 + 128 * eh + 16 * ef + 4 * g);
            conv_tile<false>(proj, a.conv_w, a.conv_b, b, c, PC_MQ + h * 128, h * 128, 0.08838834764831845f, 0.f, QT, tid);
            conv_tile<false>(proj, a.conv_w, a.conv_b, b, c, PC_MK + h * 128, 512 + h * 128, 1.0f, 0.f, KT, tid);
            v_tile(proj, b, c, h, VT, tid);
            if (tid < 128) NP[tid] = ncb[u * 128 + tid];
            __syncthreads();
            const int t = 16 * tf + j;
            const float M_t = __shfl(Mv, t), wi_t = __shfl(wiv, t), emt_t = __shfl(emtv, t);
            bf16x8 qf[4];
#pragma unroll
            for (int ks = 0; ks < 4; ++ks) qf[ks] = *(const LAS bf16x8*)(QT + t * 288 + (32 * ks + 8 * g) * 2);
            float sp[4][4]; float rowsum = 0.f;
#pragma unroll
            for (int sf = 0; sf < 4; ++sf) {
                f32x4 sa = {0.f, 0.f, 0.f, 0.f};
#pragma unroll
                for (int ks = 0; ks < 4; ++ks) { const bf16x8 kfr = *(const LAS bf16x8*)(KT + (16 * sf + j) * 288 + (32 * ks + 8 * g) * 2); sa = MFMA16(kfr, qf[ks], sa); }
#pragma unroll
                for (int rg = 0; rg < 4; ++rg) { const int sidx = 16 * sf + 4 * g + rg; const float bs = __shfl(bvec, sidx);
                    const float pv = (sidx <= t) ? __expf(bs - M_t) : 0.f; sp[sf][rg] = sa[rg] * pv; rowsum += sp[sf][rg]; }
            }
            bf16x8 pb[2];
#pragma unroll
            for (int kk = 0; kk < 2; ++kk) { float tmp[8] = {sp[2 * kk][0], sp[2 * kk][1], sp[2 * kk][2], sp[2 * kk][3], sp[2 * kk + 1][0], sp[2 * kk + 1][1], sp[2 * kk + 1][2], sp[2 * kk + 1][3]};
                const u32x4 w = pack8(tmp); pb[kk] = __builtin_bit_cast(bf16x8, w); }
            f32x4 ai[8], ae[8];
#pragma unroll
            for (int ef = 0; ef < 8; ++ef) { ai[ef] = (f32x4){0.f, 0.f, 0.f, 0.f}; ae[ef] = (f32x4){0.f, 0.f, 0.f, 0.f}; }
#pragma unroll
            for (int kk = 0; kk < 2; ++kk) {
#pragma unroll
                for (int ef = 0; ef < 8; ++ef) { const int col = 128 * eh + 16 * ef + 4 * p;
                    const bf16x8 af = cat4(vtr(VT + (32 * kk + 4 * g + qp) * 544 + col * 2), vtr(VT + (32 * kk + 16 + 4 * g + qp) * 544 + col * 2));
                    ai[ef] = MFMA16(af, pb[kk], ai[ef]); }
            }
#pragma unroll
            for (int ef = 0; ef < 8; ++ef) {
#pragma unroll
                for (int ks = 0; ks < 4; ++ks) { const bf16x8 cfr = *(const LAS bf16x8*)(CP + (128 * eh + 16 * ef + j) * 288 + (32 * ks + 8 * g) * 2); ae[ef] = MFMA16(cfr, qf[ks], ae[ef]); }
            }
            float qn = 0.f;
#pragma unroll
            for (int ks = 0; ks < 4; ++ks) { float qv[8]; unpack8(__builtin_bit_cast(u32x4, qf[ks]), qv);
#pragma unroll
                for (int e = 0; e < 8; ++e) qn += qv[e] * NP[32 * ks + 8 * g + e]; }
            qn += __shfl_xor(qn, 16); qn += __shfl_xor(qn, 32);
            rowsum += __shfl_xor(rowsum, 16); rowsum += __shfl_xor(rowsum, 32);
            const float den = wi_t * qn + rowsum;
            const float dinv = 1.0f / fmaxf(fabsf(den), emt_t);
            float ssq = 0.f;
#pragma unroll
            for (int ef = 0; ef < 8; ++ef) { ai[ef] = (ae[ef] * wi_t + ai[ef]) * dinv; ssq += (ai[ef][0] * ai[ef][0] + ai[ef][1] * ai[ef][1]) + (ai[ef][2] * ai[ef][2] + ai[ef][3] * ai[ef][3]); }
            ssq += __shfl_xor(ssq, 16); ssq += __shfl_xor(ssq, 32);
            if (g == 0) XCH[eh * 64 + t] = ssq;
            __syncthreads();
            const float rn = 1.0f / sqrtf((XCH[t] + XCH[64 + t]) * (1.0f / 256.0f) + NORM_EPS);
            bf16* orow = proj + (size_t)(b * SEQ + c * 64 + t) * NPROJ;
#pragma unroll
            for (int ef = 0; ef < 8; ++ef) { const int e = 128 * eh + 16 * ef + 4 * g;
                const f32x4 nw = *(const f32x4*)(a.mlstm_norm_w + h * 256 + e);
                const u32x2 mo = mo_pre[ef];
                const float mof[4] = {bf_lo(mo.x), bf_hi(mo.x), bf_lo(mo.y), bf_hi(mo.y)};
                float r4[4];
#pragma unroll
                for (int e2 = 0; e2 < 4; ++e2) r4[e2] = ai[ef][e2] * rn * nw[e2] / (1.0f + __expf(-mof[e2]));
                u32x2 w; w.x = cvtpk(r4[0], r4[1]); w.y = cvtpk(r4[2], r4[3]); if (!dry) *(u32x2*)(orow + PC_MV + h * 256 + e) = w; }
            __syncthreads();
        }
        for (int pidx = vcu; pidx < 256; pidx += G) {
            const AUnit ua{0, (pidx >> 5) & 7, 1, 0, pidx & 31, op0, pl0}, ub{1, (pidx >> 5) & 7, 1, 0, pidx & 31, op0, pl0};
            attn_pair<true>(proj, rcos, rsin, a.q_norm_w, a.attn_norm_w, ua, ub, lds, op1, pl1, tid, dry);
        }
    REP_END
    xcd_barrier(bar);

    REP_BEGIN(6)
        pg8::Gemm g{proj + PC_MV, WoutT, MTOK, DM, DM, NPROJ}; pg8::StaticOrder S; S.init(MTOK, DM, G, bx);
        pg8::EpiRes1 E{a.x, a.out, H1b, sumsq, DM, dry};
        pg8::gemm_phase<pg8::EpiRes1, false>(lds, g, S, E);
    REP_END
    xcd_barrier(bar);

    REP_BEGIN(7)
        pg8::Gemm g{H1b, WguT, MTOK, NGU, DM, DM}; pg8::StaticOrder S; S.init(MTOK, NGU, G, bx);
        pg8::EpiSwiGLU E{FF, DFF, sumsq};
        pg8::gemm_phase<pg8::EpiSwiGLU, true>(lds, g, S, E);
        if (rep_ == 1) {
            const int nfull = (MTOK / 256) * (NGU / 256) - 5 * G;
            const int nidle = G - nfull;
            if (G == 256 ? (bx >= nfull) : true) {
                LAS float* scr = (LAS float*)(lds + wave * 16384);
                constexpr int I_DN = (DFF / 64) * (DM / 32);
                const int w0 = (G == 256) ? (bx - nfull) * NWAVES + wave : gw, nw = (G == 256) ? nidle * NWAVES : NGW;
                for (int it = w0; it < I_DN; it += nw) { const int nblk = DM / 32, kb = it / nblk, nb = it % nblk;
                    const TItem t{a.w_down, WdnT, nullptr, DM, DFF, nb * 32, nb * 32, kb * 64}; f32x4 v[8]; titem_load(t, v, lane); titem_finish(t, v, scr, lane); }
            }
        }
    REP_END
    xcd_barrier(bar);

    REP_BEGIN(8)
        pg8::Gemm g{FF, WdnT, MTOK, DM, DFF, DFF}; pg8::StaticOrder S; S.init(MTOK, DM, G, bx);
        pg8::EpiRes2 E{H1b, a.out, DM, dry};
        pg8::gemm_phase<pg8::EpiRes2, false>(lds, g, S, E);
    REP_END
}

extern "C" void kernel_launch(void* const* d_in, const int* in_sizes, int n_in, void* d_out, int out_size, void* d_ws, size_t ws_size, hipStream_t stream) {
    static int grid = 0;
    if (grid == 0) {
        if (n_in != 16 || in_sizes[0] != MTOK * DM || out_size != MTOK * DM || ws_size < WS_END) { fprintf(stderr, "kernel_launch: unexpected shapes (n_in %d in0 %d out %d ws %zu)\n", n_in, n_in > 0 ? in_sizes[0] : -1, out_size, ws_size); grid = -1; return; }
        int dev = 0, cus = 0;
        if (hipGetDevice(&dev) != hipSuccess || hipDeviceGetAttribute(&cus, hipDeviceAttributeMultiprocessorCount, dev) != hipSuccess || cus <= 0) cus = 256;
        if (hipFuncSetAttribute((const void*)hymba_fwd, hipFuncAttributeMaxDynamicSharedMemorySize, LDS_BYTES) != hipSuccess) { fprintf(stderr, "kernel_launch: hipFuncSetAttribute failed\n"); grid = -1; return; }
        (void)hipGetLastError();
        grid = cus;
    }
    if (grid < 0) return;
    if (hipMemsetAsync((char*)d_ws + WS_CTL, 0, CTL_ZERO_BYTES, stream) != hipSuccess) { fprintf(stderr, "kernel_launch: memset failed\n"); return; }
    Args a{};
    a.x = (const float*)d_in[0]; a.norm1_w = (const float*)d_in[1]; a.w_in = (const float*)d_in[2]; a.conv_w = (const float*)d_in[3]; a.conv_b = (const float*)d_in[4];
    a.igate_b = (const float*)d_in[5]; a.fgate_b = (const float*)d_in[6]; a.q_norm_w = (const float*)d_in[7]; a.k_norm_w = (const float*)d_in[8];
    a.mlstm_norm_w = (const float*)d_in[9]; a.attn_norm_w = (const float*)d_in[10]; a.w_out = (const float*)d_in[11]; a.norm2_w = (const float*)d_in[12];
    a.w_gate = (const float*)d_in[13]; a.w_up = (const float*)d_in[14]; a.w_down = (const float*)d_in[15];
    a.out = (float*)d_out; a.ws = (unsigned char*)d_ws; a.dry = (PROBE_PHASE >= 0) ? 1 : 0;
    hipLaunchKernelGGL(hymba_fwd, dim3(grid), dim3(NWAVES * 64), LDS_BYTES, stream, a);
}
```

```cpp
#include <hip/hip_runtime.h>
#include <cstdio>
#include <cstdint>

#define LAS __attribute__((address_space(3)))
#define GAS __attribute__((address_space(1)))
typedef unsigned short bf16;
typedef short bf16x8 __attribute__((ext_vector_type(8)));
typedef short s16x4 __attribute__((ext_vector_type(4)));
typedef float f32x4 __attribute__((ext_vector_type(4)));
typedef float f32x2 __attribute__((ext_vector_type(2)));
typedef unsigned u32x4 __attribute__((ext_vector_type(4)));
typedef unsigned u32x2 __attribute__((ext_vector_type(2)));
typedef __bf16 bf16x2_t __attribute__((ext_vector_type(2)));

constexpr int BATCH = 2, SEQ = 4096, DM = 2048, MTOK = BATCH * SEQ;
constexpr int INW = 6152, NPROJ = 6144, DFF = 5632, NGU = 2 * DFF;
constexpr int PC_MQ = 0, PC_MK = 512, PC_MO = 1024, PC_MV = 2048, PC_AQ = 3072, PC_AK = 4096, PC_AV = 5120;
constexpr float NORM_EPS = 1e-6f;
constexpr int NWAVES = 8;

constexpr size_t MiB = 1u << 20;
constexpr size_t WS_CTL = 0, CTL_ZERO_BYTES = 1 * MiB;
constexpr size_t WS_GLI = 1 * MiB;
constexpr size_t WS_GLF = WS_GLI + 128 * 1024;
constexpr size_t WS_SUMSQ = WS_GLF + 128 * 1024;
constexpr size_t WS_MSC = WS_SUMSQ + 32 * 1024;
constexpr size_t WS_NC = WS_MSC + 8 * 1024;
constexpr size_t WS_COS = 2 * MiB, WS_SIN = 3 * MiB;
constexpr size_t WS_WIN = 6 * MiB;
constexpr size_t WS_KV = 6 * MiB;
constexpr size_t WS_U = 30 * MiB;
constexpr size_t WS_PROJ = 62 * MiB;
constexpr size_t WS_WOUT = 158 * MiB;
constexpr size_t WS_WGU = 166 * MiB;
constexpr size_t WS_WDN = 210 * MiB;
constexpr size_t WS_OP0 = 38 * MiB;
constexpr size_t WS_OP1 = 232 * MiB;
constexpr size_t WS_PL0 = 248 * MiB, WS_PL1 = WS_PL0 + 256 * 1024;
constexpr size_t WS_END = 249 * MiB;
constexpr int CW_BAR = 4096;

constexpr int RING_BYTES = 131072;
constexpr int MISC_OFF = 147456 - 256;
constexpr int LDS_BYTES = 147456;

__device__ __forceinline__ unsigned cvtpk(float lo, float hi) { f32x2 v = {lo, hi}; bf16x2_t b = __builtin_convertvector(v, bf16x2_t); return __builtin_bit_cast(unsigned, b); }
__device__ __forceinline__ float bf_lo(unsigned w) { return __uint_as_float(w << 16); }
__device__ __forceinline__ float bf_hi(unsigned w) { return __uint_as_float(w & 0xffff0000u); }
__device__ __forceinline__ void unpack8(u32x4 w, float* f) { f[0] = bf_lo(w.x); f[1] = bf_hi(w.x); f[2] = bf_lo(w.y); f[3] = bf_hi(w.y); f[4] = bf_lo(w.z); f[5] = bf_hi(w.z); f[6] = bf_lo(w.w); f[7] = bf_hi(w.w); }
__device__ __forceinline__ u32x4 pack8(const float* f) { u32x4 w; w.x = cvtpk(f[0], f[1]); w.y = cvtpk(f[2], f[3]); w.z = cvtpk(f[4], f[5]); w.w = cvtpk(f[6], f[7]); return w; }
__device__ __forceinline__ float wave_sum(float v) {
#pragma unroll
    for (int o = 1; o < 64; o <<= 1) v += __shfl_xor(v, o);
    return v;
}
__device__ __forceinline__ float wave_max(float v) {
#pragma unroll
    for (int o = 1; o < 64; o <<= 1) v = fmaxf(v, __shfl_xor(v, o));
    return v;
}
__device__ __forceinline__ s16x4 vtr(const LAS unsigned char* p) { return __builtin_bit_cast(s16x4, __builtin_amdgcn_ds_read_tr16_b64_v4i16((LAS s16x4*)p)); }
__device__ __forceinline__ bf16x8 cat4(s16x4 a, s16x4 b) { return (bf16x8){a[0], a[1], a[2], a[3], b[0], b[1], b[2], b[3]}; }
#define LDS_WAIT() asm volatile("s_waitcnt lgkmcnt(0)" ::: "memory")
#define VM_WAIT() asm volatile("s_waitcnt vmcnt(0)" ::: "memory")
#define SBAR() __builtin_amdgcn_sched_barrier(0)
#define MFMA16(a, b, c) __builtin_amdgcn_mfma_f32_16x16x32_bf16((a), (b), (c), 0, 0, 0)

namespace pg8 {
constexpr int BM = 256, BK = 64, HALF = 128, HTB = HALF * BK * 2, STAGE_BYTES = 8 * HTB, NXCD = 8, WGM = 8;
__host__ __device__ __forceinline__ int lds_byte(int r, int c) { const int st = (r >> 4) * 2 + (c >> 5), rr = r & 15, cc = c & 31, ob = rr * 64 + cc * 2; return st * 1024 + (ob ^ (((ob >> 9) & 1) << 5)); }
__host__ __device__ __forceinline__ void stage_rc(int b, int& R, int& C) { const int st = b / 1024, sb = b % 1024, swz = sb ^ (((sb >> 9) & 1) << 5); R = (st >> 1) * 16 + swz / 64; C = (st & 1) * 32 + (swz % 64) / 2; }
__host__ __device__ __forceinline__ int perm32(int rho) { const int n = rho >> 4, i = rho & 15; return 8 * (i >> 2) + 4 * n + (i & 3); }
struct Unit { int pm, pn; };
struct Gemm { const bf16* A; const bf16* Bt; int M, N, K, lda; };
struct StaticOrder {
    int nM, nN, nwg, G, c;
    __device__ void init(int M, int N, int G_, int c_) { nM = M / BM; nN = N / BM; nwg = nM * nN; G = G_; c = c_; }
    __device__ bool next(int i, Unit& u) const {
        const long L = (long)i * G + c; if (L >= nwg) return false;
        int wgid = (int)L; { const int q = nwg / NXCD, r = nwg % NXCD, xcd = wgid % NXCD, off = wgid / NXCD; wgid = (xcd < r ? xcd * (q + 1) : r * (q + 1) + (xcd - r) * q) + off; }
        const int nig = WGM * nN, gid = wgid / nig, fm = gid * WGM, gsz = (nM - fm) < WGM ? (nM - fm) : WGM;
        u.pm = fm + ((wgid % nig) % gsz); u.pn = (wgid % nig) / gsz; return true;
    }
};
struct EpiBf16 {
    static constexpr bool PERM = true, HAS_INIT = false;
    bf16* O; int ldc;
    __device__ __forceinline__ void operator()(const f32x4 (&acc)[2][2][4][2], const Unit& u, int wr, int wc, int fr, int fq) const {
        const int row0 = u.pm * BM + wr * 64 + fr, col0 = u.pn * BM + wc * 32 + 8 * fq;
#pragma unroll
        for (int ai = 0; ai < 2; ++ai)
#pragma unroll
            for (int m = 0; m < 4; ++m) { bf16* rowp = O + (size_t)(row0 + ai * HALF + m * 16) * ldc + col0;
#pragma unroll
                for (int bj = 0; bj < 2; ++bj) { const f32x4 v0 = acc[ai][bj][m][0], v1 = acc[ai][bj][m][1];
                    u32x4 w; w.x = cvtpk(v0[0], v0[1]); w.y = cvtpk(v0[2], v0[3]); w.z = cvtpk(v1[0], v1[1]); w.w = cvtpk(v1[2], v1[3]);
                    *(u32x4*)(rowp + bj * HALF) = w; } }
    }
};
struct EpiRes1 {
    static constexpr bool PERM = false, HAS_INIT = true;
    const float* xres; float* out; bf16* h1b; float* sumsq; int ldc; bool dry;
    __device__ __forceinline__ void init(f32x4 (&acc)[2][2][4][2], const Unit& u, int wr, int wc, int fr, int fq) const {
        const int col0 = u.pn * BM + wc * 32 + 4 * fq;
#pragma unroll
        for (int ai = 0; ai < 2; ++ai)
#pragma unroll
            for (int m = 0; m < 4; ++m) { const size_t off = (size_t)(u.pm * BM + ai * HALF + wr * 64 + m * 16 + fr) * ldc + col0;
#pragma unroll
                for (int bj = 0; bj < 2; ++bj)
#pragma unroll
                    for (int n = 0; n < 2; ++n) acc[ai][bj][m][n] = *(const f32x4*)(xres + off + bj * HALF + n * 16); }
    }
    __device__ __forceinline__ void operator()(const f32x4 (&acc)[2][2][4][2], const Unit& u, int wr, int wc, int fr, int fq) const {
        const int col0 = u.pn * BM + wc * 32 + 4 * fq;
#pragma unroll
        for (int ai = 0; ai < 2; ++ai)
#pragma unroll
            for (int m = 0; m < 4; ++m) { const int row = u.pm * BM + ai * HALF + wr * 64 + m * 16 + fr; const size_t off = (size_t)row * ldc + col0; float ss = 0.f;
#pragma unroll
                for (int bj = 0; bj < 2; ++bj)
#pragma unroll
                    for (int n = 0; n < 2; ++n) { const size_t o2 = off + bj * HALF + n * 16; const f32x4 h = acc[ai][bj][m][n];
                        u32x2 w; w.x = cvtpk(h[0], h[1]); w.y = cvtpk(h[2], h[3]); if (!dry) { *(u32x2*)(h1b + o2) = w; }
                        ss += (h[0] * h[0] + h[1] * h[1]) + (h[2] * h[2] + h[3] * h[3]); }
                ss += __shfl_xor(ss, 16); ss += __shfl_xor(ss, 32);
                if (fq == 0 && !dry) atomicAdd(sumsq + row, ss); }
    }
};
struct EpiSwiGLU {
    static constexpr bool PERM = true, HAS_INIT = false;
    bf16* O; int ldc; const float* sumsq;
    __device__ __forceinline__ void operator()(const f32x4 (&acc)[2][2][4][2], const Unit& u, int wr, int wc, int fr, int fq) const {
        const int col0 = u.pn * HALF + wc * 32 + 8 * fq;
#pragma unroll
        for (int ai = 0; ai < 2; ++ai)
#pragma unroll
            for (int m = 0; m < 4; ++m) { const int row = u.pm * BM + ai * HALF + wr * 64 + m * 16 + fr;
                const float rs = 1.0f / sqrtf(sumsq[row] * (1.0f / DM) + NORM_EPS);
                float f[8];
#pragma unroll
                for (int n = 0; n < 2; ++n)
#pragma unroll
                    for (int j = 0; j < 4; ++j) { const float g = acc[ai][0][m][n][j] * rs, up = acc[ai][1][m][n][j] * rs; f[n * 4 + j] = g / (1.0f + __expf(-g)) * up; }
                *(u32x4*)(O + (size_t)row * ldc + col0) = pack8(f); }
    }
};
struct EpiRes2 {
    static constexpr bool PERM = false, HAS_INIT = true;
    const bf16* h1b; float* out; int ldc; bool dry;
    __device__ __forceinline__ void init(f32x4 (&acc)[2][2][4][2], const Unit& u, int wr, int wc, int fr, int fq) const {
        const int col0 = u.pn * BM + wc * 32 + 4 * fq;
#pragma unroll
        for (int ai = 0; ai < 2; ++ai)
#pragma unroll
            for (int m = 0; m < 4; ++m) { const size_t off = (size_t)(u.pm * BM + ai * HALF + wr * 64 + m * 16 + fr) * ldc + col0;
#pragma unroll
                for (int bj = 0; bj < 2; ++bj)
#pragma unroll
                    for (int n = 0; n < 2; ++n) { const u32x2 w = *(const u32x2*)(h1b + off + bj * HALF + n * 16); acc[ai][bj][m][n] = (f32x4){bf_lo(w.x), bf_hi(w.x), bf_lo(w.y), bf_hi(w.y)}; } }
    }
    __device__ __forceinline__ void operator()(const f32x4 (&acc)[2][2][4][2], const Unit& u, int wr, int wc, int fr, int fq) const {
        const int col0 = u.pn * BM + wc * 32 + 4 * fq;
#pragma unroll
        for (int ai = 0; ai < 2; ++ai)
#pragma unroll
            for (int m = 0; m < 4; ++m) { const size_t off = (size_t)(u.pm * BM + ai * HALF + wr * 64 + m * 16 + fr) * ldc + col0;
#pragma unroll
                for (int bj = 0; bj < 2; ++bj)
#pragma unroll
                    for (int n = 0; n < 2; ++n) { if (!dry) *(f32x4*)(out + off + bj * HALF + n * 16) = acc[ai][bj][m][n]; } }
    }
};

template <class Epi, bool ALIGN_EPI>
__device__ __forceinline__ void gemm_phase(LAS unsigned char* lds, const Gemm g, const StaticOrder& S, const Epi& E) {
    int tid = threadIdx.x; asm volatile("" : "+v"(tid));
    const int wid = __builtin_amdgcn_readfirstlane(tid >> 6), lane = tid & 63, wr = wid >> 2, wc = wid & 3, fr = lane & 15, fq = lane >> 4;
    const int K = g.K, nt = K / BK;
    unsigned voffA[2], voffB[2];
#pragma unroll
    for (int i = 0; i < 2; ++i) { int R, C; stage_rc(tid * 16 + i * 8192, R, C); const int Rb = Epi::PERM ? ((R & ~31) + perm32(R & 31)) : R;
        voffA[i] = (unsigned)(R * g.lda + C) * 2u; voffB[i] = (unsigned)(Rb * K + C) * 2u; }
    const size_t kstep = (size_t)(BK * 2);
    const size_t hstepA = (size_t)HALF * g.lda * 2, hstepB = (size_t)HALF * K * 2;
    const size_t tstepA = 2 * hstepA, tstepB = 2 * hstepB;
    const unsigned ldsw = (unsigned)wid * 1024u;
    const int aoff = lds_byte(wr * 64 + fr, fq * 8), boff = lds_byte(wc * 32 + fr, fq * 8);
#define PG8_SA(b, h) (((b) * 2 + (h)) * HTB)
#define PG8_SB(b, h) ((4 + (b) * 2 + (h)) * HTB)
#define PG8_STAGE(bufoff, gbase, voff) do { _Pragma("unroll") for (int _i = 0; _i < 2; ++_i) \
        __builtin_amdgcn_global_load_lds((const unsigned*)((const char*)(gbase) + (voff)[_i]), (LAS unsigned*)(lds + (bufoff) + ldsw + _i * 8192), 16, 0, 0); } while (0)
#define PG8_LDA(dst, b, h) do { _Pragma("unroll") for (int m = 0; m < 4; ++m) _Pragma("unroll") for (int k = 0; k < 2; ++k) dst[m][k] = *(const LAS bf16x8*)(lds + PG8_SA(b, h) + aoff + m * 2048 + k * 1024); } while (0)
#define PG8_LDB(dst, b, h) do { _Pragma("unroll") for (int n = 0; n < 2; ++n) _Pragma("unroll") for (int k = 0; k < 2; ++k) dst[n][k] = *(const LAS bf16x8*)(lds + PG8_SB(b, h) + boff + n * 2048 + k * 1024); } while (0)
#define PG8_MMA(ai, bj, At, Bt) do { __builtin_amdgcn_s_setprio(1); _Pragma("unroll") for (int m = 0; m < 4; ++m) _Pragma("unroll") for (int n = 0; n < 2; ++n) _Pragma("unroll") for (int k = 0; k < 2; ++k) \
        acc[ai][bj][m][n] = __builtin_amdgcn_mfma_f32_16x16x32_bf16(Bt[n][k], At[m][k], acc[ai][bj][m][n], 0, 0, 0); __builtin_amdgcn_s_setprio(0); } while (0)
#define PG8_WAIT_V(n) asm volatile("s_waitcnt vmcnt(" #n ")" ::: "memory")
#define PG8_WAIT_L(n) asm volatile("s_waitcnt lgkmcnt(" #n ")" ::: "memory")
#define PG8_BAR __builtin_amdgcn_s_barrier()
#define PG8_SCHED __builtin_amdgcn_sched_barrier(0)
    Unit cur, nxt; int ui = 0;
    if (!S.next(0, cur)) return;
    f32x4 acc[2][2][4][2];
    if constexpr (Epi::HAS_INIT) { E.init(acc, cur, wr, wc, fr, fq); }
    else {
#pragma unroll
    for (int a = 0; a < 2; ++a)
#pragma unroll
        for (int b = 0; b < 2; ++b)
#pragma unroll
            for (int m = 0; m < 4; ++m)
#pragma unroll
                for (int n = 0; n < 2; ++n) acc[a][b][m][n] = (f32x4){0.f, 0.f, 0.f, 0.f};
    }
    bf16x8 At[4][2], B0[2][2], B1[2][2];
    const char* cA = (const char*)g.A + (size_t)cur.pm * tstepA; const char* cB = (const char*)g.Bt + (size_t)cur.pn * tstepB;
    PG8_STAGE(PG8_SB(0, 0), cB, voffB); PG8_STAGE(PG8_SB(0, 1), cB + hstepB, voffB); PG8_STAGE(PG8_SA(0, 0), cA, voffA); PG8_STAGE(PG8_SA(0, 1), cA + hstepA, voffA);
    if (wr == 1) PG8_BAR;
    PG8_WAIT_V(2); PG8_BAR;
    PG8_STAGE(PG8_SB(1, 0), cB + kstep, voffB); PG8_STAGE(PG8_SA(1, 0), cA + kstep, voffA); PG8_STAGE(PG8_SB(1, 1), cB + hstepB + kstep, voffB);
    PG8_WAIT_V(6); PG8_BAR;
    for (;;) {
        const bool has_next = S.next(ui + 1, nxt);
        const char* nA = has_next ? (const char*)g.A + (size_t)nxt.pm * tstepA : cA; const char* nB = has_next ? (const char*)g.Bt + (size_t)nxt.pn * tstepB : cB;
        for (int t = 0; t < nt; t += 2) {
            const bool last = (t == nt - 2);
            const char* a1 = cA + (size_t)(t + 1) * kstep;
            const char* a2 = last ? nA : cA + (size_t)(t + 2) * kstep; const char* b2 = last ? nB : cB + (size_t)(t + 2) * kstep;
            const char* a3 = a2 + kstep; const char* b3 = b2 + kstep;
            PG8_LDB(B0, 0, 0); PG8_LDB(B1, 0, 1); PG8_SCHED; PG8_LDA(At, 0, 0); PG8_STAGE(PG8_SA(1, 1), a1 + hstepA, voffA);
            PG8_WAIT_V(8); PG8_WAIT_L(0); PG8_BAR; PG8_MMA(0, 0, At, B0); PG8_MMA(0, 1, At, B1); PG8_BAR; PG8_SCHED;
            PG8_LDA(At, 0, 1); PG8_STAGE(PG8_SB(0, 0), b2, voffB); PG8_STAGE(PG8_SB(0, 1), b2 + hstepB, voffB); PG8_STAGE(PG8_SA(0, 0), a2, voffA);
            PG8_WAIT_V(8); PG8_WAIT_L(0); PG8_BAR; PG8_MMA(1, 0, At, B0); PG8_MMA(1, 1, At, B1); PG8_BAR; PG8_SCHED;
            PG8_LDB(B0, 1, 0); PG8_LDB(B1, 1, 1); PG8_SCHED; PG8_LDA(At, 1, 0); PG8_STAGE(PG8_SA(0, 1), a2 + hstepA, voffA);
            PG8_WAIT_V(8); PG8_WAIT_L(0); PG8_BAR; PG8_MMA(0, 0, At, B0); PG8_MMA(0, 1, At, B1); PG8_BAR; PG8_SCHED;
            PG8_LDA(At, 1, 1); PG8_STAGE(PG8_SB(1, 0), b3, voffB); PG8_STAGE(PG8_SB(1, 1), b3 + hstepB, voffB); PG8_STAGE(PG8_SA(1, 0), a3, voffA);
            PG8_WAIT_V(8); PG8_WAIT_L(0); PG8_BAR; PG8_MMA(1, 0, At, B0); PG8_MMA(1, 1, At, B1); PG8_BAR; PG8_SCHED;
        }
        if constexpr (ALIGN_EPI) { if (wr == 0) PG8_BAR; }
        E(acc, cur, wr, wc, fr, fq);
        if (!has_next) break;
        if constexpr (Epi::HAS_INIT) { E.init(acc, nxt, wr, wc, fr, fq); }
        else {
#pragma unroll
        for (int a = 0; a < 2; ++a)
#pragma unroll
            for (int b = 0; b < 2; ++b)
#pragma unroll
                for (int m = 0; m < 4; ++m)
#pragma unroll
                    for (int n = 0; n < 2; ++n) acc[a][b][m][n] = (f32x4){0.f, 0.f, 0.f, 0.f};
        }
        cur = nxt; cA = nA; cB = nB; ++ui;
        if constexpr (ALIGN_EPI) { if (wr == 1) PG8_BAR; }
    }
    PG8_WAIT_V(0);
    if constexpr (!ALIGN_EPI) { if (wr == 0) PG8_BAR; }
    PG8_BAR;
#undef PG8_SA
#undef PG8_SB
#undef PG8_STAGE
#undef PG8_LDA
#undef PG8_LDB
#undef PG8_MMA
#undef PG8_WAIT_V
#undef PG8_WAIT_L
#undef PG8_BAR
#undef PG8_SCHED
}
}

#define XB_TMO      128
#define XB_XCNT(j)  (256  + 64 * (j))
#define XB_XSUB(j)  (1280 + 64 * (j))
#define XB_XGEN(j)  (2304 + 64 * (j))
#define XB_TOP      3328
#define XB_TOPGEN   3392
#define XCD_BAR_WORDS 3456
#define XB_SPIN_CAP (1u << 18)
__device__ __forceinline__ unsigned xb_ld(unsigned* p)              { return __hip_atomic_load(p, __ATOMIC_RELAXED, __HIP_MEMORY_SCOPE_AGENT); }
__device__ __forceinline__ unsigned xb_add(unsigned* p, unsigned v) { return __hip_atomic_fetch_add(p, v, __ATOMIC_RELAXED, __HIP_MEMORY_SCOPE_AGENT); }
__device__ __forceinline__ unsigned xb_xcc_id() { return (unsigned)__builtin_amdgcn_s_getreg((3 << 11) | 20) & 0xFu; }
#define XB_SPIN(cond, bar) do { unsigned _sp = 0; while (cond) { __builtin_amdgcn_s_sleep(1); \
    if ((++_sp & 255u) == 0u) { if (xb_ld(&(bar)[XB_TMO])) break; if (_sp > XB_SPIN_CAP) { atomicAdd(&(bar)[XB_TMO], 1u); break; } } } } while (0)
struct XcdBarrier { unsigned* bar; unsigned x; volatile LAS unsigned* st; };
__device__ __forceinline__ XcdBarrier xcd_barrier_post(unsigned* bar, volatile LAS unsigned* st) {
    XcdBarrier b; b.bar = bar; b.x = xb_xcc_id(); b.st = st;
    if (threadIdx.x == 0) (void)xb_add(&bar[XB_XCNT(b.x)], 1u);
    return b;
}
__device__ __forceinline__ void xcd_barrier_complete(unsigned* bar, unsigned x, unsigned& nloc, unsigned& nx) {
    const unsigned G = gridDim.x * gridDim.y * gridDim.z;
    unsigned sum, cnt, mine, sp = 0u;
    for (;;) {
        sum = 0u; cnt = 0u; mine = 0u;
#pragma unroll
        for (unsigned j = 0; j < 16; ++j) { const unsigned c = xb_ld(&bar[XB_XCNT(j)]); sum += c; cnt += (c > 0u) ? 1u : 0u; mine = (j == x) ? c : mine; }
        if (sum == G) break;
        __builtin_amdgcn_s_sleep(1);
        if ((++sp & 255u) == 0u) { if (xb_ld(&bar[XB_TMO])) break; if (sp > XB_SPIN_CAP) { atomicAdd(&bar[XB_TMO], 1u); break; } }
    }
    nloc = mine > 0u ? mine : 1u; nx = cnt > 0u ? cnt : 1u;
}
__device__ __forceinline__ void xcd_barrier(const XcdBarrier& b) {
    asm volatile("s_waitcnt vmcnt(0)" ::: "memory");
    __syncthreads();
    if (threadIdx.x == 0) {
        unsigned* bar = b.bar;
        __builtin_amdgcn_s_waitcnt(0);
        unsigned nloc = b.st[0], nx = b.st[1];
        if (nloc == 0u) { xcd_barrier_complete(bar, b.x, nloc, nx); b.st[0] = nloc; b.st[1] = nx; }
        const unsigned old = xb_add(&bar[XB_XSUB(b.x)], 1u);
        const unsigned gen = old / nloc;
        if (old + 1u == (gen + 1u) * nloc) {
            __builtin_amdgcn_fence(__ATOMIC_RELEASE, "agent");
            asm volatile("s_waitcnt vmcnt(0)" ::: "memory");
            const unsigned og = xb_add(&bar[XB_TOP], 1u);
            const unsigned tg = og / nx;
            if (og + 1u == (tg + 1u) * nx) xb_add(&bar[XB_TOPGEN], 1u);
            else XB_SPIN(xb_ld(&bar[XB_TOPGEN]) == tg, bar);
            __builtin_amdgcn_fence(__ATOMIC_ACQUIRE, "agent");
            xb_add(&bar[XB_XGEN(b.x)], 1u);
            asm volatile("s_waitcnt vmcnt(0)" ::: "memory");
        } else {
            XB_SPIN(xb_ld(&bar[XB_XGEN(b.x)]) == gen, bar);
            __builtin_amdgcn_fence(__ATOMIC_ACQUIRE, "agent");
            asm volatile("s_waitcnt vmcnt(0)" ::: "memory");
        }
    }
    __syncthreads();
}

struct Args {
    const float* x; const float* norm1_w; const float* w_in; const float* conv_w; const float* conv_b; const float* igate_b; const float* fgate_b;
    const float* q_norm_w; const float* k_norm_w; const float* mlstm_norm_w; const float* attn_norm_w; const float* w_out; const float* norm2_w;
    const float* w_gate; const float* w_up; const float* w_down;
    float* out; unsigned char* ws; int dry; int pad;
};

struct TItem { const float* W; bf16* WT; const float* kscale; int ldw, K, nsrc0, ndst0, k0; };
__device__ __forceinline__ void titem_load(const TItem& t, f32x4 (&v)[8], int lane) {
    const float* src = t.W + (size_t)(t.k0 + (lane >> 3)) * t.ldw + t.nsrc0 + (lane & 7) * 4;
#pragma unroll
    for (int i = 0; i < 8; ++i) v[i] = *(const f32x4*)(src + (size_t)(8 * i) * t.ldw);
}
__device__ __forceinline__ void titem_finish(const TItem& t, const f32x4 (&v)[8], LAS float* scr, int lane) {
#pragma unroll
    for (int i = 0; i < 8; ++i) { const int kk = 8 * i + (lane >> 3); const float sc = t.kscale ? t.kscale[t.k0 + kk] : 1.0f; LAS float* d = scr + kk * 33 + (lane & 7) * 4;
        d[0] = v[i][0] * sc; d[1] = v[i][1] * sc; d[2] = v[i][2] * sc; d[3] = v[i][3] * sc; }
    LDS_WAIT(); asm volatile("" ::: "memory");
    const int c = lane & 7;
#pragma unroll
    for (int j = 0; j < 4; ++j) { const int n = (lane >> 3) + 8 * j; const LAS float* s = scr + (8 * c) * 33 + n;
        u32x4 o; o.x = cvtpk(s[0 * 33], s[1 * 33]); o.y = cvtpk(s[2 * 33], s[3 * 33]); o.z = cvtpk(s[4 * 33], s[5 * 33]); o.w = cvtpk(s[6 * 33], s[7 * 33]);
        *(u32x4*)(t.WT + (size_t)(t.ndst0 + n) * t.K + t.k0 + 8 * c) = o; }
    LDS_WAIT(); asm volatile("" ::: "memory");
}
__device__ __forceinline__ int win_src_col(int nd) {
    if (nd < 1024) return nd;
    if (nd < 2048) return nd + 1024;
    if (nd < 3072) return nd - 1024;
    return nd + 8;
}


__device__ __forceinline__ float scan_add64(float v, int lane) {
#pragma unroll
    for (int o = 1; o < 64; o <<= 1) { const float t = __shfl_up(v, o); if (lane >= o) v += t; }
    return v;
}
__device__ __forceinline__ float scan_max64(float v, int lane) {
#pragma unroll
    for (int o = 1; o < 64; o <<= 1) { const float t = __shfl_up(v, o); if (lane >= o) v = fmaxf(v, t); }
    return v;
}
template <bool ROWW>
__device__ __forceinline__ void conv_tile(const bf16* proj, const float* conv_w, const float* conv_b, int b, int c, int col0, int ch0, float rscale, float wlane, LAS unsigned char* tile, int tid) {
    const int rr = tid >> 4, cc = (tid & 15) * 8;
    float w[4][8], bb[8];
#pragma unroll
    for (int j = 0; j < 4; ++j) { const f32x4 w0 = *(const f32x4*)(conv_w + j * 1024 + ch0 + cc), w1 = *(const f32x4*)(conv_w + j * 1024 + ch0 + cc + 4);
        w[j][0] = w0[0]; w[j][1] = w0[1]; w[j][2] = w0[2]; w[j][3] = w0[3]; w[j][4] = w1[0]; w[j][5] = w1[1]; w[j][6] = w1[2]; w[j][7] = w1[3]; }
    { const f32x4 b0 = *(const f32x4*)(conv_b + ch0 + cc), b1 = *(const f32x4*)(conv_b + ch0 + cc + 4);
      bb[0] = b0[0]; bb[1] = b0[1]; bb[2] = b0[2]; bb[3] = b0[3]; bb[4] = b1[0]; bb[5] = b1[1]; bb[6] = b1[2]; bb[7] = b1[3]; }
#pragma unroll
    for (int half = 0; half < 2; ++half) {
        const int l = rr + 32 * half, t = c * 64 + l;
        float y[8];
#pragma unroll
        for (int e = 0; e < 8; ++e) y[e] = bb[e];
#pragma unroll
        for (int j = 0; j < 4; ++j) { const int tt = t - 3 + j;
            if (tt >= 0) { const u32x4 raw = *(const u32x4*)(proj + (size_t)(b * SEQ + tt) * NPROJ + col0 + cc); float x[8]; unpack8(raw, x);
#pragma unroll
                for (int e = 0; e < 8; ++e) y[e] += w[j][e] * x[e]; } }
        float sc = rscale;
        if (ROWW) sc *= __shfl(wlane, l);
#pragma unroll
        for (int e = 0; e < 8; ++e) y[e] = y[e] / (1.0f + __expf(-y[e])) * sc;
        *(LAS u32x4*)(tile + l * 288 + cc * 2) = pack8(y);
    }
}
__device__ __forceinline__ void v_tile(const bf16* proj, int b, int c, int h, LAS unsigned char* tile, int tid) {
#pragma unroll
    for (int p = 0; p < 4; ++p) { const int row = p * 16 + (tid >> 5), ch = tid & 31;
        const u32x4 v = *(const u32x4*)(proj + (size_t)(b * SEQ + c * 64 + row) * NPROJ + PC_MV + h * 256 + ch * 8);
        *(LAS u32x4*)(tile + row * 544 + ch * 16) = v; }
}

__device__ __forceinline__ void q_prep(const bf16* qrow, const float* rcos, const float* rsin, const float* qnw, int tq, int g, bf16x8 (&qf)[4]) {
    float q[4][8]; float ss = 0.f;
#pragma unroll
    for (int ks = 0; ks < 4; ++ks) { const u32x4 raw = *(const u32x4*)(qrow + 32 * ks + 8 * g); unpack8(raw, q[ks]);
#pragma unroll
        for (int e = 0; e < 8; ++e) ss += q[ks][e] * q[ks][e]; }
    ss += __shfl_xor(ss, 16); ss += __shfl_xor(ss, 32);
    const float rq = 1.0f / sqrtf(ss * (1.0f / 128.0f) + NORM_EPS);
#pragma unroll
    for (int ks = 0; ks < 2; ++ks) {
        const int c0 = 32 * ks + 8 * g;
#pragma unroll
        for (int e4 = 0; e4 < 2; ++e4) {
            const f32x4 cs = *(const f32x4*)(rcos + tq * 64 + c0 + 4 * e4), sn = *(const f32x4*)(rsin + tq * 64 + c0 + 4 * e4);
            const f32x4 w1 = *(const f32x4*)(qnw + c0 + 4 * e4), w2 = *(const f32x4*)(qnw + 64 + c0 + 4 * e4);
#pragma unroll
            for (int e = 0; e < 4; ++e) { const float y1 = q[ks][4 * e4 + e] * rq * w1[e], y2 = q[ks + 2][4 * e4 + e] * rq * w2[e];
                q[ks][4 * e4 + e] = y1 * cs[e] - y2 * sn[e]; q[ks + 2][4 * e4 + e] = y2 * cs[e] + y1 * sn[e]; }
        }
    }
#pragma unroll
    for (int ks = 0; ks < 4; ++ks) { const u32x4 w = pack8(q[ks]); qf[ks] = __builtin_bit_cast(bf16x8, w); }
}
struct AUnit { int b, h, d, r, n; bf16* po0; float* pl0; };
template <bool FINAL>
__device__ __forceinline__ void attn_pair(bf16* proj, const float* rcos, const float* rsin, const float* qnw, const float* anw, const AUnit& ua, const AUnit& ub,
                                          LAS unsigned char* lds_all, bf16* po1, float* pl1, int tid_in, bool dry) {
    int tid = tid_in; asm volatile("" : "+v"(tid));
    const int lane = tid & 63, wave = __builtin_amdgcn_readfirstlane(tid >> 6);
    const int team = wave >> 2, w4 = wave & 3;
    const int b = team ? ub.b : ua.b, h = team ? ub.h : ua.h, d = team ? ub.d : ua.d, r = team ? ub.r : ua.r, n = team ? ub.n : ua.n;
    bf16* po0 = team ? ub.po0 : ua.po0; float* pl0 = team ? ub.pl0 : ua.pl0;
    LAS unsigned char* lds = lds_all + team * 36864;
    const int j = lane & 15, g = lane >> 4, qp = j >> 2, p = lane & 3;
    const int tt = tid & 255, srow = tt >> 4, sch = tt & 15;
    const bf16* kcol = proj + (size_t)b * SEQ * NPROJ + PC_AK + h * 128 + sch * 8;
    const bf16* vcol = kcol + (PC_AV - PC_AK);
    const int kt0 = (n == 0) ? 4 : 0;
    const int sub0 = 128 * (n - 1) + srow;
    u32x4 rk[2][2], rv[2][2];
#define AT_ISSUE(set, t) do { if ((t) < 8) { _Pragma("unroll") for (int hh_ = 0; hh_ < 2; ++hh_) { const size_t tok_ = (size_t)((sub0 + 32 * (t) + 16 * hh_) * d + r); \
        rk[set][hh_] = *(const u32x4*)(kcol + tok_ * NPROJ); rv[set][hh_] = *(const u32x4*)(vcol + tok_ * NPROJ); } } } while (0)
#define AT_WRITE(set, t) do { LAS unsigned char* Kn_ = lds + ((t) & 1) * 18432; _Pragma("unroll") for (int hh_ = 0; hh_ < 2; ++hh_) { \
        *(LAS u32x4*)(Kn_ + (srow + 16 * hh_) * 288 + sch * 16) = rk[set][hh_]; *(LAS u32x4*)(Kn_ + 9216 + (srow + 16 * hh_) * 288 + sch * 16) = rv[set][hh_]; } } while (0)
#define WG_BAR() do { asm volatile("s_waitcnt lgkmcnt(0)" ::: "memory"); __builtin_amdgcn_s_barrier(); asm volatile("" ::: "memory"); } while (0)
    AT_ISSUE(0, kt0); AT_ISSUE(1, kt0 + 1);
    bf16x8 qf[2][4]; int qi[2]; int tq[2];
    const int G0 = w4, G1 = 7 - w4;
    qi[0] = 16 * G0 + j; qi[1] = 16 * G1 + j; tq[0] = (128 * n + qi[0]) * d + r; tq[1] = (128 * n + qi[1]) * d + r;
    const int lo0 = G0 >> 1, lo1 = G1 >> 1;
#pragma unroll
    for (int gi = 0; gi < 2; ++gi) { const bf16* qrow = proj + (size_t)(b * SEQ + tq[gi]) * NPROJ + PC_AQ + h * 128 + 8 * g;
#pragma unroll
        for (int ks = 0; ks < 4; ++ks) qf[gi][ks] = *(const bf16x8*)(qrow + 32 * ks); }
    AT_WRITE(0, kt0);
    for (int kb_ = 0; kb_ < kt0; ++kb_) WG_BAR();
    WG_BAR();
    float m_run[2] = {-1e30f, -1e30f}, l_run[2] = {0.f, 0.f};
    f32x4 o[2][8];
    if (FINAL) {
#pragma unroll
        for (int gi = 0; gi < 2; ++gi) { const size_t trow = (size_t)(b * SEQ + tq[gi]);
            const float l0 = pl0[trow * 8 + h], l1 = pl1[trow * 8 + h]; const float m0 = fmaxf(l0, l1);
            const float a0 = __builtin_amdgcn_exp2f(l0 - m0), a1 = __builtin_amdgcn_exp2f(l1 - m0);
            m_run[gi] = m0; l_run[gi] = (g == 0) ? a0 + a1 : 0.f;
            const bf16* p0 = po0 + trow * 1024 + h * 128 + g * 32; const bf16* p1 = po1 + trow * 1024 + h * 128 + g * 32;
#pragma unroll
            for (int np = 0; np < 4; ++np) { const u32x4 x0 = *(const u32x4*)(p0 + 8 * np), x1 = *(const u32x4*)(p1 + 8 * np); float f0[8], f1[8]; unpack8(x0, f0); unpack8(x1, f1);
#pragma unroll
                for (int e = 0; e < 4; ++e) { o[gi][2 * np][e] = a0 * f0[e] + a1 * f1[e]; o[gi][2 * np + 1][e] = a0 * f0[4 + e] + a1 * f1[4 + e]; } }
        }
    } else {
#pragma unroll
        for (int gi = 0; gi < 2; ++gi)
#pragma unroll
            for (int nf = 0; nf < 8; ++nf) o[gi][nf] = (f32x4){0.f, 0.f, 0.f, 0.f};
    }
    const float SC = 0.08838834764831845f * 1.4426950408889634f;
    const float NEG = -__builtin_inff();
#define AT_SM(gi, kt, s0, s1) do { \
                float x[8]; float tmax = NEG; \
                _Pragma("unroll") for (int e = 0; e < 8; ++e) { const int kj = 32 * (kt) + 16 * (e >> 2) + 4 * g + (e & 3); const float sv = (e < 4) ? s0[e & 3] : s1[e & 3]; \
                    const bool valid = (kj >= qi[gi]) && (kj <= qi[gi] + 128); \
                    x[e] = valid ? sv * SC : NEG; tmax = fmaxf(tmax, x[e]); } \
                tmax = fmaxf(tmax, __shfl_xor(tmax, 16)); tmax = fmaxf(tmax, __shfl_xor(tmax, 32)); \
                const float m_new = fmaxf(m_run[gi], tmax); \
                const float alpha = __builtin_amdgcn_exp2f(m_run[gi] - m_new); \
                float ps = 0.f; \
                _Pragma("unroll") for (int e = 0; e < 8; ++e) { x[e] = __builtin_amdgcn_exp2f(x[e] - m_new); ps += x[e]; } \
                l_run[gi] = l_run[gi] * alpha + ps; m_run[gi] = m_new; \
                _Pragma("unroll") for (int nf = 0; nf < 8; ++nf) o[gi][nf] = o[gi][nf] * alpha; \
                const u32x4 pw = pack8(x); pb[gi] = __builtin_bit_cast(bf16x8, pw); } while (0)
#define AT_ONE(gi, kt) do { \
            f32x4 sA = {0.f, 0.f, 0.f, 0.f}, sB = {0.f, 0.f, 0.f, 0.f}; \
            _Pragma("unroll") for (int ks = 0; ks < 4; ++ks) { \
                const bf16x8 k0 = *(const LAS bf16x8*)(Kt + j * 288 + (32 * ks + 8 * g) * 2), k1 = *(const LAS bf16x8*)(Kt + (16 + j) * 288 + (32 * ks + 8 * g) * 2); \
                sA = MFMA16(k0, qf[gi][ks], sA); sB = MFMA16(k1, qf[gi][ks], sB); } \
            bf16x8 pb[2]; AT_SM(gi, kt, sA, sB); \
            _Pragma("unroll") for (int nf = 0; nf < 8; ++nf) { \
                const s16x4 a0 = vtr(Vt + (4 * g + qp) * 288 + (16 * nf + 4 * p) * 2), a1 = vtr(Vt + (16 + 4 * g + qp) * 288 + (16 * nf + 4 * p) * 2); \
                o[gi][nf] = MFMA16(cat4(a0, a1), pb[gi], o[gi][nf]); } } while (0)
#define AT_STEP(kt, setn, setw) do { \
        LAS unsigned char* Kt = lds + ((kt) & 1) * 18432; LAS unsigned char* Vt = Kt + 9216; \
        AT_ISSUE(setn, (kt) + 2); \
        const bool act0 = (kt) >= lo0 && (kt) <= lo0 + 4, act1 = (kt) >= lo1 && (kt) <= lo1 + 4; \
        if (act0 && act1) { \
            f32x4 sA[2], sB[2]; sA[0] = (f32x4){0.f, 0.f, 0.f, 0.f}; sA[1] = sA[0]; sB[0] = sA[0]; sB[1] = sA[0]; \
            _Pragma("unroll") for (int ks = 0; ks < 4; ++ks) { \
                const bf16x8 k0 = *(const LAS bf16x8*)(Kt + j * 288 + (32 * ks + 8 * g) * 2), k1 = *(const LAS bf16x8*)(Kt + (16 + j) * 288 + (32 * ks + 8 * g) * 2); \
                sA[0] = MFMA16(k0, qf[0][ks], sA[0]); sB[0] = MFMA16(k1, qf[0][ks], sB[0]); sA[1] = MFMA16(k0, qf[1][ks], sA[1]); sB[1] = MFMA16(k1, qf[1][ks], sB[1]); } \
            bf16x8 pb[2]; \
            AT_SM(0, kt, sA[0], sB[0]); AT_SM(1, kt, sA[1], sB[1]); \
            _Pragma("unroll") for (int nf = 0; nf < 8; ++nf) { \
                const s16x4 a0 = vtr(Vt + (4 * g + qp) * 288 + (16 * nf + 4 * p) * 2), a1 = vtr(Vt + (16 + 4 * g + qp) * 288 + (16 * nf + 4 * p) * 2); \
                const bf16x8 vf = cat4(a0, a1); \
                o[0][nf] = MFMA16(vf, pb[0], o[0][nf]); o[1][nf] = MFMA16(vf, pb[1], o[1][nf]); } \
        } else if (act0) { AT_ONE(0, kt); } else if (act1) { AT_ONE(1, kt); } \
        if ((kt) + 1 < 8) AT_WRITE(setw, (kt) + 1); \
        WG_BAR(); } while (0)
#pragma unroll 1
    for (int kt = kt0; kt < 8; kt += 2) { AT_STEP(kt, 0, 1); AT_STEP(kt + 1, 1, 0); }
#undef AT_STEP
#undef AT_ONE
#undef AT_SM
#undef AT_ISSUE
#undef AT_WRITE
#pragma unroll
    for (int gi = 0; gi < 2; ++gi) {
        float lr = l_run[gi]; lr += __shfl_xor(lr, 16); lr += __shfl_xor(lr, 32);
        const float inv = 1.0f / lr;
        const float lse2 = m_run[gi] + __log2f(lr);
        const size_t trow = (size_t)(b * SEQ + tq[gi]);
        if (!FINAL) {
            bf16* pp = po0 + trow * 1024 + h * 128 + g * 32;
#pragma unroll
            for (int np = 0; np < 4; ++np) { const f32x4 va = o[gi][2 * np] * inv, vb = o[gi][2 * np + 1] * inv; u32x4 ww; ww.x = cvtpk(va[0], va[1]); ww.y = cvtpk(va[2], va[3]); ww.z = cvtpk(vb[0], vb[1]); ww.w = cvtpk(vb[2], vb[3]);
                if (!dry) *(u32x4*)(pp + 8 * np) = ww; }
            if (g == 0 && !dry) pl0[trow * 8 + h] = lse2;
        } else {
            bf16* qrow = proj + trow * NPROJ + PC_AQ + h * 128;
            float ss = 0.f;
#pragma unroll
            for (int nf = 0; nf < 8; ++nf) { const f32x4 v = o[gi][nf] * inv; o[gi][nf] = v; ss += (v[0] * v[0] + v[1] * v[1]) + (v[2] * v[2] + v[3] * v[3]); }
            ss += __shfl_xor(ss, 16); ss += __shfl_xor(ss, 32);
            const float rn = 1.0f / sqrtf(ss * (1.0f / 128.0f) + NORM_EPS);
#pragma unroll
            for (int nf = 0; nf < 8; ++nf) { const int e = 16 * nf + 4 * g; const f32x4 w = *(const f32x4*)(anw + h * 128 + e); const f32x4 v = o[gi][nf] * rn * w;
                u32x2 ww; ww.x = cvtpk(v[0], v[1]); ww.y = cvtpk(v[2], v[3]); if (!dry) *(u32x2*)(qrow + e) = ww; }
        }
    }
}

#ifndef PROBE_PHASE
#define PROBE_PHASE -1
#endif
#define REP_BEGIN(k) for (int rep_ = (PROBE_PHASE == (k)) ? 0 : 1; rep_ < 2; ++rep_) { const bool dry = (rep_ == 0) && (a.dry != 0); (void)dry; \
    int tid = threadIdx.x; asm volatile("" : "+v"(tid)); const int lane = tid & 63, wave = __builtin_amdgcn_readfirstlane(tid >> 6); \
    const int gw = vcu * NWAVES + wave, gt = vcu * (NWAVES * 64) + tid; (void)lane; (void)wave; (void)gw; (void)gt;
#define REP_END }

__global__ void __launch_bounds__(NWAVES * 64, 2) hymba_fwd(Args a) {
    extern __shared__ __attribute__((aligned(16))) unsigned char lds_raw[];
    LAS unsigned char* lds = (LAS unsigned char*)lds_raw;
    volatile LAS unsigned* MISC = (volatile LAS unsigned*)(lds + MISC_OFF);
    const int tid = threadIdx.x, lane = tid & 63, wave = __builtin_amdgcn_readfirstlane(tid >> 6);
    const int G = gridDim.x; const int bx = blockIdx.x; const int vcu = (G % 8 == 0) ? (bx % 8) * (G / 8) + bx / 8 : bx;
    unsigned char* ws = a.ws;
    unsigned* ctl = (unsigned*)(ws + WS_CTL);
    float* gli = (float*)(ws + WS_GLI); float* glf = (float*)(ws + WS_GLF); float* sumsq = (float*)(ws + WS_SUMSQ);
    float* msc_g = (float*)(ws + WS_MSC); float* msc_ml = msc_g + 512; float* msc_mp = msc_g + 1024;
    float* ncb = (float*)(ws + WS_NC);
    float* rcos = (float*)(ws + WS_COS); float* rsin = (float*)(ws + WS_SIN);
    bf16* WinT = (bf16*)(ws + WS_WIN); bf16* kvT = (bf16*)(ws + WS_KV); bf16* Ub = (bf16*)(ws + WS_U); bf16* H1b = (bf16*)(ws + WS_U);
    bf16* proj = (bf16*)(ws + WS_PROJ); bf16* FF = (bf16*)(ws + WS_PROJ);
    bf16* op0 = (bf16*)(ws + WS_OP0); bf16* op1 = (bf16*)(ws + WS_OP1); float* pl0 = (float*)(ws + WS_PL0); float* pl1 = (float*)(ws + WS_PL1);
    bf16* WoutT = (bf16*)(ws + WS_WOUT); bf16* WguT = (bf16*)(ws + WS_WGU); bf16* WdnT = (bf16*)(ws + WS_WDN);

    for (int u = tid; u < (LDS_BYTES - MISC_OFF) / 4; u += NWAVES * 64) ((LAS unsigned*)(lds + MISC_OFF))[u] = 0u;
    __syncthreads();
    XcdBarrier bar = xcd_barrier_post(ctl + CW_BAR, MISC + 8);
    const int NGW = G * NWAVES, NGT = G * NWAVES * 64;

    REP_BEGIN(0)
        for (int i = gt; i < MTOK; i += NGT) sumsq[i] = 0.f;
        for (int i = gt; i < SEQ * 64; i += NGT) {
            const int pos = i >> 6, fi = i & 63;
            const float invf = (float)exp2(-(double)fi * (13.287712379549449 / 64.0));
            const float ang = (float)pos * invf;
            const double rev = (double)ang * 0.15915494309189535; const double fr_ = rev - rint(rev);
            const float ar = (float)(fr_ * 6.283185307179586);
            rcos[i] = cosf(ar); rsin[i] = sinf(ar);
        }
        {
            LAS float* scr = (LAS float*)(lds + wave * 16384);
            constexpr int I_IN = (DM / 64) * (NPROJ / 32), I_OUT = (DM / 64) * (DM / 32), I_GU = (DM / 64) * (NGU / 32), I_DN = (DFF / 64) * (DM / 32);
            constexpr int NITEMS = I_IN + I_OUT + I_GU;
            auto decode = [&](int it) -> TItem {
                TItem t; int r = it;
                if (r < I_IN) { const int nblk = NPROJ / 32, kb = r / nblk, nb = r % nblk; t = TItem{a.w_in, WinT, nullptr, INW, DM, win_src_col(nb * 32), nb * 32, kb * 64}; return t; } r -= I_IN;
                if (r < I_OUT) { const int nblk = DM / 32, kb = r / nblk, nb = r % nblk; t = TItem{a.w_out, WoutT, nullptr, DM, DM, nb * 32, nb * 32, kb * 64}; return t; } r -= I_OUT;
                { const int nblk = NGU / 32, kb = r / nblk, nb = r % nblk; const int nd = nb * 32, pn = nd >> 8, j = nd & 255;
                    t = TItem{(j < 128) ? a.w_gate : a.w_up, WguT, a.norm2_w, DFF, DM, pn * 128 + (j & 127), nd, kb * 64}; return t; }
            };
            int it = gw;
            if (it < NITEMS) {
                TItem cur = decode(it); f32x4 vc[8]; titem_load(cur, vc, lane);
                for (;;) {
                    const int nx = it + NGW; const bool more = nx < NITEMS;
                    TItem nt = cur; f32x4 vn[8];
                    if (more) { nt = decode(nx); titem_load(nt, vn, lane); }
                    titem_finish(cur, vc, scr, lane);
                    if (!more) break;
                    cur = nt; it = nx;
#pragma unroll
                    for (int i = 0; i < 8; ++i) vc[i] = vn[i];
                }
            }
        }
        __syncthreads();
        LAS float* wg = (LAS float*)lds;
        for (int k = tid; k < DM; k += NWAVES * 64) { const f32x4 g0 = *(const f32x4*)(a.w_in + (size_t)k * INW + 3072), g1 = *(const f32x4*)(a.w_in + (size_t)k * INW + 3076);
            wg[0 * DM + k] = g0[0]; wg[1 * DM + k] = g0[1]; wg[2 * DM + k] = g0[2]; wg[3 * DM + k] = g0[3];
            wg[4 * DM + k] = g1[0]; wg[5 * DM + k] = g1[1]; wg[6 * DM + k] = g1[2]; wg[7 * DM + k] = g1[3]; }
        __syncthreads();
        for (int m = gw; m < MTOK; m += NGW) {
            const f32x4* xr = (const f32x4*)(a.x + (size_t)m * DM) + lane; const f32x4* wr_ = (const f32x4*)a.norm1_w + lane;
            f32x4 v[8]; float s = 0.f;
#pragma unroll
            for (int j = 0; j < 8; ++j) { v[j] = xr[64 * j]; s += (v[j][0] * v[j][0] + v[j][1] * v[j][1]) + (v[j][2] * v[j][2] + v[j][3] * v[j][3]); }
            const float rstd = 1.0f / sqrtf(wave_sum(s) * (1.0f / DM) + NORM_EPS);
            u32x2* o8 = (u32x2*)(Ub + (size_t)m * DM) + lane;
#pragma unroll
            for (int j = 0; j < 8; ++j) { v[j] = v[j] * rstd * wr_[64 * j]; u32x2 w; w.x = cvtpk(v[j][0], v[j][1]); w.y = cvtpk(v[j][2], v[j][3]); o8[64 * j] = w; }
            float z = 0.f;
#pragma unroll 1
            for (int gi = 0; gi < 8; ++gi) { float t = 0.f;
#pragma unroll
                for (int j = 0; j < 8; ++j) { const f32x4 w4 = *(const LAS f32x4*)(wg + gi * DM + 256 * j + 4 * lane); t += (v[j][0] * w4[0] + v[j][1] * w4[1]) + (v[j][2] * w4[2] + v[j][3] * w4[3]); }
                t = wave_sum(t); z = (lane == gi) ? t : z; }
            if (lane < 8) {
                const int hh = lane & 3;
                if (lane < 4) { gli[m * 4 + hh] = 15.0f * tanhf((z + a.igate_b[hh]) * (1.0f / 15.0f)); }
                else { const float fp = 15.0f * tanhf((z + a.fgate_b[hh]) * (1.0f / 15.0f)); glf[m * 4 + hh] = -log1pf(expf(-fp)); }
            }
        }
    REP_END
    xcd_barrier(bar);

    REP_BEGIN(1)
        pg8::Gemm g{Ub, WinT, MTOK, NPROJ, DM, DM}; pg8::StaticOrder S; S.init(MTOK, NPROJ, G, bx);
        pg8::EpiBf16 E{proj, NPROJ};
        pg8::gemm_phase<pg8::EpiBf16, true>(lds, g, S, E);
    REP_END
    xcd_barrier(bar);

    REP_BEGIN(2)
        {
            const int c0 = 4 * (tid & 15), rstride = NGT >> 4;
            for (int which = 0; which < 2; ++which) {
                const float* nw = which ? a.k_norm_w : a.q_norm_w; const int colb = which ? PC_AK : PC_AQ;
                const f32x4 w1 = *(const f32x4*)(nw + c0), w2 = *(const f32x4*)(nw + 64 + c0);
                for (int idx0 = gt >> 4; idx0 < MTOK * 8; idx0 += 4 * rstride) {
                    u32x2 r1[4], r2[4]; f32x4 cs[4], sn[4];
#pragma unroll
                    for (int q = 0; q < 4; ++q) { const int idx = idx0 + q * rstride;
                        if (idx < MTOK * 8) { const int m = idx >> 3, hh = idx & 7, pos = m & (SEQ - 1); const bf16* kp = proj + (size_t)m * NPROJ + colb + hh * 128;
                            r1[q] = *(const u32x2*)(kp + c0); r2[q] = *(const u32x2*)(kp + 64 + c0); cs[q] = *(const f32x4*)(rcos + pos * 64 + c0); sn[q] = *(const f32x4*)(rsin + pos * 64 + c0); } }
#pragma unroll
                    for (int q = 0; q < 4; ++q) { const int idx = idx0 + q * rstride;
                        if (idx < MTOK * 8) { const int m = idx >> 3, hh = idx & 7; bf16* kp = proj + (size_t)m * NPROJ + colb + hh * 128;
                            float x1[4] = {bf_lo(r1[q].x), bf_hi(r1[q].x), bf_lo(r1[q].y), bf_hi(r1[q].y)}, x2[4] = {bf_lo(r2[q].x), bf_hi(r2[q].x), bf_lo(r2[q].y), bf_hi(r2[q].y)};
                            float ss = 0.f;
#pragma unroll
                            for (int e = 0; e < 4; ++e) ss += x1[e] * x1[e] + x2[e] * x2[e];
                            ss += __shfl_xor(ss, 1); ss += __shfl_xor(ss, 2); ss += __shfl_xor(ss, 4); ss += __shfl_xor(ss, 8);
                            const float rk = 1.0f / sqrtf(ss * (1.0f / 128.0f) + NORM_EPS);
                            float o1[4], o2[4];
#pragma unroll
                            for (int e = 0; e < 4; ++e) { const float y1 = x1[e] * rk * w1[e], y2 = x2[e] * rk * w2[e]; o1[e] = y1 * cs[q][e] - y2 * sn[q][e]; o2[e] = y2 * cs[q][e] + y1 * sn[q][e]; }
                            u32x2 wv; wv.x = cvtpk(o1[0], o1[1]); wv.y = cvtpk(o1[2], o1[3]); if (!dry) *(u32x2*)(kp + c0) = wv;
                            wv.x = cvtpk(o2[0], o2[1]); wv.y = cvtpk(o2[2], o2[3]); if (!dry) *(u32x2*)(kp + 64 + c0) = wv; } }
                }
            }
        }
        LAS unsigned char* KW = lds; LAS unsigned char* VT = lds + 18432;
        const int g = lane >> 4, qp = (lane & 15) >> 2, p = lane & 3;
        for (int u = vcu; u < 512; u += G) {
            const int b = u >> 8, h = (u >> 6) & 3, c = u & 63;
            const int tok = b * SEQ + c * 64 + lane;
            const float li = gli[tok * 4 + h], lf = glf[tok * 4 + h];
            const float cf = scan_add64(lf, lane);
            const float gsum = __shfl(cf, 63);
            const float av = gsum - cf + li;
            const float ml = wave_max(av);
            const float wst = __expf(av - ml);
            if (tid == 0) { msc_g[u] = gsum; msc_ml[u] = ml; }
            conv_tile<true>(proj, a.conv_w, a.conv_b, b, c, PC_MK + h * 128, 512 + h * 128, 1.0f, wst, KW, tid);
            v_tile(proj, b, c, h, VT, tid);
            __syncthreads();
            f32x4 acc[8][2];
#pragma unroll
            for (int df = 0; df < 8; ++df) { acc[df][0] = (f32x4){0.f, 0.f, 0.f, 0.f}; acc[df][1] = (f32x4){0.f, 0.f, 0.f, 0.f}; }
#pragma unroll
            for (int kk = 0; kk < 2; ++kk) {
                bf16x8 bfr[2];
#pragma unroll
                for (int ef = 0; ef < 2; ++ef) { const int col = 32 * wave + 16 * ef + 4 * p;
                    bfr[ef] = cat4(vtr(VT + (32 * kk + 4 * g + qp) * 544 + col * 2), vtr(VT + (32 * kk + 16 + 4 * g + qp) * 544 + col * 2)); }
#pragma unroll
                for (int df = 0; df < 8; ++df) { const int col = 16 * df + 4 * p;
                    const bf16x8 af = cat4(vtr(KW + (32 * kk + 4 * g + qp) * 288 + col * 2), vtr(KW + (32 * kk + 16 + 4 * g + qp) * 288 + col * 2));
                    acc[df][0] = MFMA16(af, bfr[0], acc[df][0]); acc[df][1] = MFMA16(af, bfr[1], acc[df][1]); }
            }
#pragma unroll
            for (int ef = 0; ef < 2; ++ef) { const int e = 32 * wave + 16 * ef + (lane & 15);
#pragma unroll
                for (int df = 0; df < 8; ++df) { const f32x4 v = acc[df][ef]; u32x2 w; w.x = cvtpk(v[0], v[1]); w.y = cvtpk(v[2], v[3]);
                    *(u32x2*)(kvT + ((size_t)u * 256 + e) * 128 + 16 * df + 4 * g) = w; } }
            if (tid < 128) { float nsum = 0.f;
#pragma unroll 8
                for (int l = 0; l < 64; ++l) nsum += __uint_as_float((unsigned)(*(const LAS unsigned short*)(KW + l * 288 + tid * 2)) << 16);
                ncb[u * 128 + tid] = nsum; }
            __syncthreads();
        }
    REP_END
    xcd_barrier(bar);

    REP_BEGIN(3)
        LAS float* sg = (LAS float*)lds; LAS float* sml = sg + 512;
        for (int i = tid; i < 512; i += NWAVES * 64) { sg[i] = msc_g[i]; sml[i] = msc_ml[i]; }
        __syncthreads();
        for (int id = gt; id < 8 * 16384; id += NGT) {
            const int bh = id >> 14, pi = id & 16383;
            unsigned* base = (unsigned*)kvT + (size_t)bh * 64 * 16384 + pi;
            float c0 = 0.f, c1 = 0.f, m = 0.f;
#pragma unroll 1
            for (int cb = 0; cb < 64; cb += 32) {
                unsigned xv[32];
#pragma unroll
                for (int i = 0; i < 32; ++i) xv[i] = base[(size_t)(cb + i) * 16384];
#pragma unroll
                for (int i = 0; i < 32; ++i) {
                    const float gg = sg[bh * 64 + cb + i], ml = sml[bh * 64 + cb + i];
                    const float mn = fmaxf(gg + m, ml), so = __expf(gg + m - mn), sn = __expf(ml - mn);
                    if (!dry) base[(size_t)(cb + i) * 16384] = cvtpk(c0, c1);
                    c0 = so * c0 + sn * bf_lo(xv[i]); c1 = so * c1 + sn * bf_hi(xv[i]); m = mn;
                }
            }
        }
        for (int id = gt; id < 8 * 128; id += NGT) {
            const int bh = id >> 7, dd = id & 127; float n = 0.f, m = 0.f;
            float* nb_ = ncb + (size_t)bh * 64 * 128 + dd;
#pragma unroll 1
            for (int cb = 0; cb < 64; cb += 32) {
                float xv[32];
#pragma unroll
                for (int i = 0; i < 32; ++i) xv[i] = nb_[(cb + i) * 128];
#pragma unroll
                for (int i = 0; i < 32; ++i) {
                    const float gg = sg[bh * 64 + cb + i], ml = sml[bh * 64 + cb + i];
                    const float mn = fmaxf(gg + m, ml), so = __expf(gg + m - mn), sn = __expf(ml - mn);
                    if (!dry) nb_[(cb + i) * 128] = n;
                    if (dd == 0) msc_mp[bh * 64 + cb + i] = m;
                    n = so * n + sn * xv[i]; m = mn;
                }
            }
        }
        __syncthreads();
    REP_END
    REP_BEGIN(4)
        for (int pidx = vcu; pidx < 512; pidx += G) {
            AUnit ua, ub;
            { const int u = pidx; ua = AUnit{u >> 8, (u >> 5) & 7, 4, (u >> 3) & 3, u & 7, op0, pl0}; }
            { const int v = pidx; const int bb = v >> 8; ub = AUnit{bb, (v >> 5) & 7, 16, (v >> 1) & 15, (v ^ bb) & 1, op1, pl1}; }
            attn_pair<false>(proj, rcos, rsin, a.q_norm_w, a.attn_norm_w, ua, ub, lds, nullptr, nullptr, tid, dry);
        }
    REP_END
    xcd_barrier(bar);

    REP_BEGIN(5)
        LAS unsigned char* QT = lds; LAS unsigned char* KT = lds + 18432; LAS unsigned char* VT = lds + 36864;
        LAS float* NP = (LAS float*)(lds + 71680); LAS float* XCH = (LAS float*)(lds + 72192); LAS unsigned char* CP = lds + 72704;
        const int j = lane & 15, g = lane >> 4, qp = j >> 2, p = lane & 3;
        const int tf = wave & 3, eh = wave >> 2;
        for (int u = vcu; u < 512; u += G) {
            const int b = u >> 8, h = (u >> 6) & 3, c = u & 63;
            const int tok = b * SEQ + c * 64 + lane;
            const float li = gli[tok * 4 + h], lf = glf[tok * 4 + h];
            const float cf = scan_add64(lf, lane);
            const float bvec = li - cf;
            const float pm = scan_max64(bvec, lane);
            const float mprev = msc_mp[u];
            const float Mv = fmaxf(mprev, pm);
            const float wiv = __expf(mprev - Mv), emtv = __expf(-cf - Mv);
            {
                const bf16* csrc = kvT + (size_t)u * 256 * 128 + (size_t)(tid >> 4) * 128 + (tid & 15) * 8;
                u32x4 cv[8];
#pragma unroll
                for (int it = 0; it < 8; ++it) cv[it] = *(const u32x4*)(csrc + (size_t)it * 32 * 128);
#pragma unroll
                for (int it = 0; it < 8; ++it) *(LAS u32x4*)(CP + (it * 32 + (tid >> 4)) * 288 + (tid & 15) * 16) = cv[it];
            }
            const int t_ = 16 * (wave & 3) + j;
            const bf16* orow_ = proj + (size_t)(b * SEQ + c * 64 + t_) * NPROJ;
            u32x2 mo_pre[8];
#pragma unroll
            for (int ef = 0; ef < 8; ++ef) mo_pre[ef] = *(const u32x2*)(orow_ + PC_MO + h * 256 + 128 * eh + 16 * ef + 4 * g);
            conv_tile<false>(proj, a.conv_w, a.conv_b, b, c, PC_MQ + h * 128, h * 128, 0.08838834764831845f, 0.f, QT, tid);
            conv_tile<false>(proj, a.conv_w, a.conv_b, b, c, PC_MK + h * 128, 512 + h * 128, 1.0f, 0.f, KT, tid);
            v_tile(proj, b, c, h, VT, tid);
            if (tid < 128) NP[tid] = ncb[u * 128 + tid];
            __syncthreads();
            const int t = 16 * tf + j;
            const float M_t = __shfl(Mv, t), wi_t = __shfl(wiv, t), emt_t = __shfl(emtv, t);
            bf16x8 qf[4];
#pragma unroll
            for (int ks = 0; ks < 4; ++ks) qf[ks] = *(const LAS bf16x8*)(QT + t * 288 + (32 * ks + 8 * g) * 2);
            float sp[4][4]; float rowsum = 0.f;
#pragma unroll
            for (int sf = 0; sf < 4; ++sf) {
                f32x4 sa = {0.f, 0.f, 0.f, 0.f};
#pragma unroll
                for (int ks = 0; ks < 4; ++ks) { const bf16x8 kfr = *(const LAS bf16x8*)(KT + (16 * sf + j) * 288 + (32 * ks + 8 * g) * 2); sa = MFMA16(kfr, qf[ks], sa); }
#pragma unroll
                for (int rg = 0; rg < 4; ++rg) { const int sidx = 16 * sf + 4 * g + rg; const float bs = __shfl(bvec, sidx);
                    const float pv = (sidx <= t) ? __expf(bs - M_t) : 0.f; sp[sf][rg] = sa[rg] * pv; rowsum += sp[sf][rg]; }
            }
            bf16x8 pb[2];
#pragma unroll
            for (int kk = 0; kk < 2; ++kk) { float tmp[8] = {sp[2 * kk][0], sp[2 * kk][1], sp[2 * kk][2], sp[2 * kk][3], sp[2 * kk + 1][0], sp[2 * kk + 1][1], sp[2 * kk + 1][2], sp[2 * kk + 1][3]};
                const u32x4 w = pack8(tmp); pb[kk] = __builtin_bit_cast(bf16x8, w); }
            f32x4 ai[8], ae[8];
#pragma unroll
            for (int ef = 0; ef < 8; ++ef) { ai[ef] = (f32x4){0.f, 0.f, 0.f, 0.f}; ae[ef] = (f32x4){0.f, 0.f, 0.f, 0.f}; }
#pragma unroll
            for (int kk = 0; kk < 2; ++kk) {
#pragma unroll
                for (int ef = 0; ef < 8; ++ef) { const int col = 128 * eh + 16 * ef + 4 * p;
                    const bf16x8 af = cat4(vtr(VT + (32 * kk + 4 * g + qp) * 544 + col * 2), vtr(VT + (32 * kk + 16 + 4 * g + qp) * 544 + col * 2));
                    ai[ef] = MFMA16(af, pb[kk], ai[ef]); }
            }
#pragma unroll
            for (int ef = 0; ef < 8; ++ef) {
#pragma unroll
                for (int ks = 0; ks < 4; ++ks) { const bf16x8 cfr = *(const LAS bf16x8*)(CP + (128 * eh + 16 * ef + j) * 288 + (32 * ks + 8 * g) * 2); ae[ef] = MFMA16(cfr, qf[ks], ae[ef]); }
            }
            float qn = 0.f;
#pragma unroll
            for (int ks = 0; ks < 4; ++ks) { float qv[8]; unpack8(__builtin_bit_cast(u32x4, qf[ks]), qv);
#pragma unroll
                for (int e = 0; e < 8; ++e) qn += qv[e] * NP[32 * ks + 8 * g + e]; }
            qn += __shfl_xor(qn, 16); qn += __shfl_xor(qn, 32);
            rowsum += __shfl_xor(rowsum, 16); rowsum += __shfl_xor(rowsum, 32);
            const float den = wi_t * qn + rowsum;
            const float dinv = 1.0f / fmaxf(fabsf(den), emt_t);
            float ssq = 0.f;
#pragma unroll
            for (int ef = 0; ef < 8; ++ef) { ai[ef] = (ae[ef] * wi_t + ai[ef]) * dinv; ssq += (ai[ef][0] * ai[ef][0] + ai[ef][1] * ai[ef][1]) + (ai[ef][2] * ai[ef][2] + ai[ef][3] * ai[ef][3]); }
            ssq += __shfl_xor(ssq, 16); ssq += __shfl_xor(ssq, 32);
            if (g == 0) XCH[eh * 64 + t] = ssq;
            __syncthreads();
            const float rn = 1.0f / sqrtf((XCH[t] + XCH[64 + t]) * (1.0f / 256.0f) + NORM_EPS);
            bf16* orow = proj + (size_t)(b * SEQ + c * 64 + t) * NPROJ;
#pragma unroll
            for (int ef = 0; ef < 8; ++ef) { const int e = 128 * eh + 16 * ef + 4 * g;
                const f32x4 nw = *(const f32x4*)(a.mlstm_norm_w + h * 256 + e);
                const u32x2 mo = mo_pre[ef];
                const float mof[4] = {bf_lo(mo.x), bf_hi(mo.x), bf_lo(mo.y), bf_hi(mo.y)};
                float r4[4];
#pragma unroll
                for (int e2 = 0; e2 < 4; ++e2) r4[e2] = ai[ef][e2] * rn * nw[e2] / (1.0f + __expf(-mof[e2]));
                u32x2 w; w.x = cvtpk(r4[0], r4[1]); w.y = cvtpk(r4[2], r4[3]); if (!dry) *(u32x2*)(orow + PC_MV + h * 256 + e) = w; }
            __syncthreads();
        }
        for (int pidx = vcu; pidx < 256; pidx += G) {
            const AUnit ua{0, (pidx >> 5) & 7, 1, 0, pidx & 31, op0, pl0}, ub{1, (pidx >> 5) & 7, 1, 0, pidx & 31, op0, pl0};
            attn_pair<true>(proj, rcos, rsin, a.q_norm_w, a.attn_norm_w, ua, ub, lds, op1, pl1, tid, dry);
        }
    REP_END
    xcd_barrier(bar);

    REP_BEGIN(6)
        pg8::Gemm g{proj + PC_MV, WoutT, MTOK, DM, DM, NPROJ}; pg8::StaticOrder S; S.init(MTOK, DM, G, bx);
        pg8::EpiRes1 E{a.x, a.out, H1b, sumsq, DM, dry};
        pg8::gemm_phase<pg8::EpiRes1, false>(lds, g, S, E);
    REP_END
    xcd_barrier(bar);

    REP_BEGIN(7)
        pg8::Gemm g{H1b, WguT, MTOK, NGU, DM, DM}; pg8::StaticOrder S; S.init(MTOK, NGU, G, bx);
        pg8::EpiSwiGLU E{FF, DFF, sumsq};
        pg8::gemm_phase<pg8::EpiSwiGLU, true>(lds, g, S, E);
        if (rep_ == 1) {
            const int nfull = (MTOK / 256) * (NGU / 256) - 5 * G;
            const int nidle = G - nfull;
            if (G == 256 ? (bx >= nfull) : true) {
                LAS float* scr = (LAS float*)(lds + wave * 16384);
                constexpr int I_DN = (DFF / 64) * (DM / 32);
                const int w0 = (G == 256) ? (bx - nfull) * NWAVES + wave : gw, nw = (G == 256) ? nidle * NWAVES : NGW;
                for (int it = w0; it < I_DN; it += nw) { const int nblk = DM / 32, kb = it / nblk, nb = it % nblk;
                    const TItem t{a.w_down, WdnT, nullptr, DM, DFF, nb * 32, nb * 32, kb * 64}; f32x4 v[8]; titem_load(t, v, lane); titem_finish(t, v, scr, lane); }
            }
        }
    REP_END
    xcd_barrier(bar);

    REP_BEGIN(8)
        pg8::Gemm g{FF, WdnT, MTOK, DM, DFF, DFF}; pg8::StaticOrder S; S.init(MTOK, DM, G, bx);
        pg8::EpiRes2 E{H1b, a.out, DM, dry};
        pg8::gemm_phase<pg8::EpiRes2, false>(lds, g, S, E);
    REP_END
}

extern "C" void kernel_launch(void* const* d_in, const int* in_sizes, int n_in, void* d_out, int out_size, void* d_ws, size_t ws_size, hipStream_t stream) {
    static int grid = 0;
    if (grid == 0) {
        if (n_in != 16 || in_sizes[0] != MTOK * DM || out_size != MTOK * DM || ws_size < WS_END) { fprintf(stderr, "kernel_launch: unexpected shapes (n_in %d in0 %d out %d ws %zu)\n", n_in, n_in > 0 ? in_sizes[0] : -1, out_size, ws_size); grid = -1; return; }
        int dev = 0, cus = 0;
        if (hipGetDevice(&dev) != hipSuccess || hipDeviceGetAttribute(&cus, hipDeviceAttributeMultiprocessorCount, dev) != hipSuccess || cus <= 0) cus = 256;
        if (hipFuncSetAttribute((const void*)hymba_fwd, hipFuncAttributeMaxDynamicSharedMemorySize, LDS_BYTES) != hipSuccess) { fprintf(stderr, "kernel_launch: hipFuncSetAttribute failed\n"); grid = -1; return; }
        (void)hipGetLastError();
        grid = cus;
    }
    if (grid < 0) return;
    if (hipMemsetAsync((char*)d_ws + WS_CTL, 0, CTL_ZERO_BYTES, stream) != hipSuccess) { fprintf(stderr, "kernel_launch: memset failed\n"); return; }
    Args a{};
    a.x = (const float*)d_in[0]; a.norm1_w = (const float*)d_in[1]; a.w_in = (const float*)d_in[2]; a.conv_w = (const float*)d_in[3]; a.conv_b = (const float*)d_in[4];
    a.igate_b = (const float*)d_in[5]; a.fgate_b = (const float*)d_in[6]; a.q_norm_w = (const float*)d_in[7]; a.k_norm_w = (const float*)d_in[8];
    a.mlstm_norm_w = (const float*)d_in[9]; a.attn_norm_w = (const float*)d_in[10]; a.w_out = (const float*)d_in[11]; a.norm2_w = (const float*)d_in[12];
    a.w_gate = (const float*)d_in[13]; a.w_up = (const float*)d_in[14]; a.w_down = (const float*)d_in[15];
    a.out = (float*)d_out; a.ws = (unsigned char*)d_ws; a.dry = (PROBE_PHASE >= 0) ? 1 : 0;
    hipLaunchKernelGGL(hymba_fwd, dim3(grid), dim3(NWAVES * 64), LDS_BYTES, stream, a);
}
```

```cpp
#include <hip/hip_runtime.h>
#include <cstdio>
#include <cstdint>

#define LAS __attribute__((address_space(3)))
#define GAS __attribute__((address_space(1)))
typedef unsigned short bf16;
typedef short bf16x8 __attribute__((ext_vector_type(8)));
typedef short s16x4 __attribute__((ext_vector_type(4)));
typedef float f32x4 __attribute__((ext_vector_type(4)));
typedef float f32x2 __attribute__((ext_vector_type(2)));
typedef unsigned u32x4 __attribute__((ext_vector_type(4)));
typedef unsigned u32x2 __attribute__((ext_vector_type(2)));
typedef __bf16 bf16x2_t __attribute__((ext_vector_type(2)));

constexpr int BATCH = 2, SEQ = 4096, DM = 2048, MTOK = BATCH * SEQ;
constexpr int INW = 6152, NPROJ = 6144, DFF = 5632, NGU = 2 * DFF;
constexpr int PC_MQ = 0, PC_MK = 512, PC_MO = 1024, PC_MV = 2048, PC_AQ = 3072, PC_AK = 4096, PC_AV = 5120;
constexpr float NORM_EPS = 1e-6f;
constexpr int NWAVES = 8;

constexpr size_t MiB = 1u << 20;
constexpr size_t WS_CTL = 0, CTL_ZERO_BYTES = 32 * 1024;
constexpr size_t WS_GLI = 1 * MiB;
constexpr size_t WS_GLF = WS_GLI + 128 * 1024;
constexpr size_t WS_SUMSQ = WS_GLF + 128 * 1024;
constexpr size_t WS_MSC = WS_SUMSQ + 32 * 1024;
constexpr size_t WS_NC = WS_MSC + 8 * 1024;
constexpr size_t WS_COS = 2 * MiB, WS_SIN = 3 * MiB;
constexpr size_t WS_WIN = 6 * MiB;
constexpr size_t WS_KV = 6 * MiB;
constexpr size_t WS_U = 30 * MiB;
constexpr size_t WS_PROJ = 62 * MiB;
constexpr size_t WS_WOUT = 158 * MiB;
constexpr size_t WS_WGU = 166 * MiB;
constexpr size_t WS_WDN = 210 * MiB;
constexpr size_t WS_OP0 = 38 * MiB;
constexpr size_t WS_OP1 = 232 * MiB;
constexpr size_t WS_PL0 = 248 * MiB, WS_PL1 = WS_PL0 + 256 * 1024;
constexpr size_t WS_END = 249 * MiB;
constexpr int CW_BAR = 4096;

constexpr int RING_BYTES = 131072;
constexpr int MISC_OFF = 147456 - 256;
constexpr int LDS_BYTES = 147456;

__device__ __forceinline__ unsigned cvtpk(float lo, float hi) { f32x2 v = {lo, hi}; bf16x2_t b = __builtin_convertvector(v, bf16x2_t); return __builtin_bit_cast(unsigned, b); }
__device__ __forceinline__ float bf_lo(unsigned w) { return __uint_as_float(w << 16); }
__device__ __forceinline__ float bf_hi(unsigned w) { return __uint_as_float(w & 0xffff0000u); }
__device__ __forceinline__ void unpack8(u32x4 w, float* f) { f[0] = bf_lo(w.x); f[1] = bf_hi(w.x); f[2] = bf_lo(w.y); f[3] = bf_hi(w.y); f[4] = bf_lo(w.z); f[5] = bf_hi(w.z); f[6] = bf_lo(w.w); f[7] = bf_hi(w.w); }
__device__ __forceinline__ u32x4 pack8(const float* f) { u32x4 w; w.x = cvtpk(f[0], f[1]); w.y = cvtpk(f[2], f[3]); w.z = cvtpk(f[4], f[5]); w.w = cvtpk(f[6], f[7]); return w; }
#define DPP_MOV_F(v, ctrl) __uint_as_float((unsigned)__builtin_amdgcn_mov_dpp((int)__float_as_uint(v), (ctrl), 0xf, 0xf, true))
__device__ __forceinline__ float row16_sum(float v) { v += DPP_MOV_F(v, 0xB1); v += DPP_MOV_F(v, 0x4E); v += DPP_MOV_F(v, 0x124); v += DPP_MOV_F(v, 0x128); return v; }
__device__ __forceinline__ float x16_sum(float v) { const auto r = __builtin_amdgcn_permlane16_swap(__float_as_uint(v), __float_as_uint(v), false, false); return __uint_as_float(r[0]) + __uint_as_float(r[1]); }
__device__ __forceinline__ float x32_sum(float v) { const auto r = __builtin_amdgcn_permlane32_swap(__float_as_uint(v), __float_as_uint(v), false, false); return __uint_as_float(r[0]) + __uint_as_float(r[1]); }
__device__ __forceinline__ float x16_max(float v) { const auto r = __builtin_amdgcn_permlane16_swap(__float_as_uint(v), __float_as_uint(v), false, false); return fmaxf(__uint_as_float(r[0]), __uint_as_float(r[1])); }
__device__ __forceinline__ float x32_max(float v) { const auto r = __builtin_amdgcn_permlane32_swap(__float_as_uint(v), __float_as_uint(v), false, false); return fmaxf(__uint_as_float(r[0]), __uint_as_float(r[1])); }
__device__ __forceinline__ float xg_sum(float v) { return x32_sum(x16_sum(v)); }
__device__ __forceinline__ float xg_max(float v) { return x32_max(x16_max(v)); }
__device__ __forceinline__ float wave_sum(float v) { return xg_sum(row16_sum(v)); }
__device__ __forceinline__ float wave_max(float v) {
#pragma unroll
    for (int o = 1; o < 64; o <<= 1) v = fmaxf(v, __shfl_xor(v, o));
    return v;
}
__device__ __forceinline__ s16x4 vtr(const LAS unsigned char* p) { return __builtin_bit_cast(s16x4, __builtin_amdgcn_ds_read_tr16_b64_v4i16((LAS s16x4*)p)); }
__device__ __forceinline__ bf16x8 cat4(s16x4 a, s16x4 b) { return (bf16x8){a[0], a[1], a[2], a[3], b[0], b[1], b[2], b[3]}; }
#define LDS_WAIT() asm volatile("s_waitcnt lgkmcnt(0)" ::: "memory")
#define VM_WAIT() asm volatile("s_waitcnt vmcnt(0)" ::: "memory")
#define SBAR() __builtin_amdgcn_sched_barrier(0)
#define MFMA16(a, b, c) __builtin_amdgcn_mfma_f32_16x16x32_bf16((a), (b), (c), 0, 0, 0)

namespace pg8 {
constexpr int BM = 256, BK = 64, HALF = 128, HTB = HALF * BK * 2, STAGE_BYTES = 8 * HTB, NXCD = 8, WGM = 8;
__host__ __device__ __forceinline__ int lds_byte(int r, int c) { const int st = (r >> 4) * 2 + (c >> 5), rr = r & 15, cc = c & 31, ob = rr * 64 + cc * 2; return st * 1024 + (ob ^ (((ob >> 9) & 1) << 5)); }
__host__ __device__ __forceinline__ void stage_rc(int b, int& R, int& C) { const int st = b / 1024, sb = b % 1024, swz = sb ^ (((sb >> 9) & 1) << 5); R = (st >> 1) * 16 + swz / 64; C = (st & 1) * 32 + (swz % 64) / 2; }
__host__ __device__ __forceinline__ int perm32(int rho) { const int n = rho >> 4, i = rho & 15; return 8 * (i >> 2) + 4 * n + (i & 3); }
struct Unit { int pm, pn; };
struct Gemm { const bf16* A; const bf16* Bt; int M, N, K, lda; };
struct StaticOrder {
    int nM, nN, nwg, G, c;
    __device__ void init(int M, int N, int G_, int c_) { nM = M / BM; nN = N / BM; nwg = nM * nN; G = G_; c = c_; }
    __device__ bool next(int i, Unit& u) const {
        const long L = (long)i * G + c; if (L >= nwg) return false;
        int wgid = (int)L; { const int q = nwg / NXCD, r = nwg % NXCD, xcd = wgid % NXCD, off = wgid / NXCD; wgid = (xcd < r ? xcd * (q + 1) : r * (q + 1) + (xcd - r) * q) + off; }
        const int nig = WGM * nN, gid = wgid / nig, fm = gid * WGM, gsz = (nM - fm) < WGM ? (nM - fm) : WGM;
        u.pm = fm + ((wgid % nig) % gsz); u.pn = (wgid % nig) / gsz; return true;
    }
};
struct EpiBf16 {
    static constexpr bool PERM = true, HAS_INIT = false;
    bf16* O; int ldc;
    __device__ __forceinline__ void operator()(const f32x4 (&acc)[2][2][4][2], const Unit& u, int wr, int wc, int fr, int fq) const {
        const int row0 = u.pm * BM + wr * 64 + fr, col0 = u.pn * BM + wc * 32 + 8 * fq;
#pragma unroll
        for (int ai = 0; ai < 2; ++ai)
#pragma unroll
            for (int m = 0; m < 4; ++m) { bf16* rowp = O + (size_t)(row0 + ai * HALF + m * 16) * ldc + col0;
#pragma unroll
                for (int bj = 0; bj < 2; ++bj) { const f32x4 v0 = acc[ai][bj][m][0], v1 = acc[ai][bj][m][1];
                    u32x4 w; w.x = cvtpk(v0[0], v0[1]); w.y = cvtpk(v0[2], v0[3]); w.z = cvtpk(v1[0], v1[1]); w.w = cvtpk(v1[2], v1[3]);
                    *(u32x4*)(rowp + bj * HALF) = w; } }
    }
};
struct EpiRes1 {
    static constexpr bool PERM = false, HAS_INIT = true;
    const float* xres; float* out; bf16* h1b; float* sumsq; int ldc; bool dry;
    __device__ __forceinline__ void init(f32x4 (&acc)[2][2][4][2], const Unit& u, int wr, int wc, int fr, int fq) const {
        const int col0 = u.pn * BM + wc * 32 + 4 * fq;
#pragma unroll
        for (int ai = 0; ai < 2; ++ai)
#pragma unroll
            for (int m = 0; m < 4; ++m) { const size_t off = (size_t)(u.pm * BM + ai * HALF + wr * 64 + m * 16 + fr) * ldc + col0;
#pragma unroll
                for (int bj = 0; bj < 2; ++bj)
#pragma unroll
                    for (int n = 0; n < 2; ++n) acc[ai][bj][m][n] = __builtin_nontemporal_load((const f32x4*)(xres + off + bj * HALF + n * 16)); }
    }
    __device__ __forceinline__ void operator()(const f32x4 (&acc)[2][2][4][2], const Unit& u, int wr, int wc, int fr, int fq) const {
        const int col0 = u.pn * BM + wc * 32 + 4 * fq;
#pragma unroll
        for (int ai = 0; ai < 2; ++ai)
#pragma unroll
            for (int m = 0; m < 4; ++m) { const int row = u.pm * BM + ai * HALF + wr * 64 + m * 16 + fr; const size_t off = (size_t)row * ldc + col0; float ss = 0.f;
#pragma unroll
                for (int bj = 0; bj < 2; ++bj)
#pragma unroll
                    for (int n = 0; n < 2; ++n) { const size_t o2 = off + bj * HALF + n * 16; const f32x4 h = acc[ai][bj][m][n];
                        u32x2 w; w.x = cvtpk(h[0], h[1]); w.y = cvtpk(h[2], h[3]); if (!dry) { *(u32x2*)(h1b + o2) = w; }
                        ss += (h[0] * h[0] + h[1] * h[1]) + (h[2] * h[2] + h[3] * h[3]); }
                ss = xg_sum(ss);
                if (fq == 0 && !dry) atomicAdd(sumsq + row, ss); }
    }
};
struct EpiSwiGLU {
    static constexpr bool PERM = true, HAS_INIT = false;
    bf16* O; int ldc; const float* sumsq;
    __device__ __forceinline__ void operator()(const f32x4 (&acc)[2][2][4][2], const Unit& u, int wr, int wc, int fr, int fq) const {
        const int col0 = u.pn * HALF + wc * 32 + 8 * fq;
#pragma unroll
        for (int ai = 0; ai < 2; ++ai)
#pragma unroll
            for (int m = 0; m < 4; ++m) { const int row = u.pm * BM + ai * HALF + wr * 64 + m * 16 + fr;
                const float rs = 1.0f / sqrtf(sumsq[row] * (1.0f / DM) + NORM_EPS);
                float f[8];
#pragma unroll
                for (int n = 0; n < 2; ++n)
#pragma unroll
                    for (int j = 0; j < 4; ++j) { const float g = acc[ai][0][m][n][j] * rs, up = acc[ai][1][m][n][j] * rs; f[n * 4 + j] = g / (1.0f + __expf(-g)) * up; }
                *(u32x4*)(O + (size_t)row * ldc + col0) = pack8(f); }
    }
};
struct EpiRes2 {
    static constexpr bool PERM = false, HAS_INIT = true;
    const bf16* h1b; float* out; int ldc; bool dry;
    __device__ __forceinline__ void init(f32x4 (&acc)[2][2][4][2], const Unit& u, int wr, int wc, int fr, int fq) const {
        const int col0 = u.pn * BM + wc * 32 + 4 * fq;
#pragma unroll
        for (int ai = 0; ai < 2; ++ai)
#pragma unroll
            for (int m = 0; m < 4; ++m) { const size_t off = (size_t)(u.pm * BM + ai * HALF + wr * 64 + m * 16 + fr) * ldc + col0;
#pragma unroll
                for (int bj = 0; bj < 2; ++bj)
#pragma unroll
                    for (int n = 0; n < 2; ++n) { const u32x2 w = __builtin_nontemporal_load((const u32x2*)(h1b + off + bj * HALF + n * 16)); acc[ai][bj][m][n] = (f32x4){bf_lo(w.x), bf_hi(w.x), bf_lo(w.y), bf_hi(w.y)}; } }
    }
    __device__ __forceinline__ void operator()(const f32x4 (&acc)[2][2][4][2], const Unit& u, int wr, int wc, int fr, int fq) const {
        const int col0 = u.pn * BM + wc * 32 + 4 * fq;
#pragma unroll
        for (int ai = 0; ai < 2; ++ai)
#pragma unroll
            for (int m = 0; m < 4; ++m) { const size_t off = (size_t)(u.pm * BM + ai * HALF + wr * 64 + m * 16 + fr) * ldc + col0;
#pragma unroll
                for (int bj = 0; bj < 2; ++bj)
#pragma unroll
                    for (int n = 0; n < 2; ++n) { if (!dry) __builtin_nontemporal_store(acc[ai][bj][m][n], (f32x4*)(out + off + bj * HALF + n * 16)); } }
    }
};

template <class Epi, bool ALIGN_EPI>
__device__ __forceinline__ void gemm_phase(LAS unsigned char* lds, const Gemm g, const StaticOrder& S, const Epi& E) {
    int tid = threadIdx.x; asm volatile("" : "+v"(tid));
    const int wid = __builtin_amdgcn_readfirstlane(tid >> 6), lane = tid & 63, wr = wid >> 2, wc = wid & 3, fr = lane & 15, fq = lane >> 4;
    const int K = g.K, nt = K / BK;
    unsigned voffA[2], voffB[2];
#pragma unroll
    for (int i = 0; i < 2; ++i) { int R, C; stage_rc(tid * 16 + i * 8192, R, C); const int Rb = Epi::PERM ? ((R & ~31) + perm32(R & 31)) : R;
        voffA[i] = (unsigned)(R * g.lda + C) * 2u; voffB[i] = (unsigned)(Rb * K + C) * 2u; }
    const size_t kstep = (size_t)(BK * 2);
    const size_t hstepA = (size_t)HALF * g.lda * 2, hstepB = (size_t)HALF * K * 2;
    const size_t tstepA = 2 * hstepA, tstepB = 2 * hstepB;
    const unsigned ldsw = (unsigned)wid * 1024u;
    const int aoff = lds_byte(wr * 64 + fr, fq * 8), boff = lds_byte(wc * 32 + fr, fq * 8);
#define PG8_SA(b, h) (((b) * 2 + (h)) * HTB)
#define PG8_SB(b, h) ((4 + (b) * 2 + (h)) * HTB)
#define PG8_STAGE(bufoff, gbase, voff) do { _Pragma("unroll") for (int _i = 0; _i < 2; ++_i) \
        __builtin_amdgcn_global_load_lds((const unsigned*)((const char*)(gbase) + (voff)[_i]), (LAS unsigned*)(lds + (bufoff) + ldsw + _i * 8192), 16, 0, 0); } while (0)
#define PG8_LDA(dst, b, h) do { _Pragma("unroll") for (int m = 0; m < 4; ++m) _Pragma("unroll") for (int k = 0; k < 2; ++k) dst[m][k] = *(const LAS bf16x8*)(lds + PG8_SA(b, h) + aoff + m * 2048 + k * 1024); } while (0)
#define PG8_LDB(dst, b, h) do { _Pragma("unroll") for (int n = 0; n < 2; ++n) _Pragma("unroll") for (int k = 0; k < 2; ++k) dst[n][k] = *(const LAS bf16x8*)(lds + PG8_SB(b, h) + boff + n * 2048 + k * 1024); } while (0)
#define PG8_MMA(ai, bj, At, Bt) do { __builtin_amdgcn_s_setprio(1); _Pragma("unroll") for (int m = 0; m < 4; ++m) _Pragma("unroll") for (int n = 0; n < 2; ++n) _Pragma("unroll") for (int k = 0; k < 2; ++k) \
        acc[ai][bj][m][n] = __builtin_amdgcn_mfma_f32_16x16x32_bf16(Bt[n][k], At[m][k], acc[ai][bj][m][n], 0, 0, 0); __builtin_amdgcn_s_setprio(0); } while (0)
#define PG8_WAIT_V(n) asm volatile("s_waitcnt vmcnt(" #n ")" ::: "memory")
#define PG8_WAIT_L(n) asm volatile("s_waitcnt lgkmcnt(" #n ")" ::: "memory")
#define PG8_BAR __builtin_amdgcn_s_barrier()
#define PG8_SCHED __builtin_amdgcn_sched_barrier(0)
    Unit cur, nxt; int ui = 0;
    if (!S.next(0, cur)) return;
    f32x4 acc[2][2][4][2];
    if constexpr (Epi::HAS_INIT) { E.init(acc, cur, wr, wc, fr, fq); }
    else {
#pragma unroll
    for (int a = 0; a < 2; ++a)
#pragma unroll
        for (int b = 0; b < 2; ++b)
#pragma unroll
            for (int m = 0; m < 4; ++m)
#pragma unroll
                for (int n = 0; n < 2; ++n) acc[a][b][m][n] = (f32x4){0.f, 0.f, 0.f, 0.f};
    }
    bf16x8 At[4][2], B0[2][2], B1[2][2];
    const char* cA = (const char*)g.A + (size_t)cur.pm * tstepA; const char* cB = (const char*)g.Bt + (size_t)cur.pn * tstepB;
    PG8_STAGE(PG8_SB(0, 0), cB, voffB); PG8_STAGE(PG8_SB(0, 1), cB + hstepB, voffB); PG8_STAGE(PG8_SA(0, 0), cA, voffA); PG8_STAGE(PG8_SA(0, 1), cA + hstepA, voffA);
    if (wr == 1) PG8_BAR;
    PG8_WAIT_V(2); PG8_BAR;
    PG8_STAGE(PG8_SB(1, 0), cB + kstep, voffB); PG8_STAGE(PG8_SA(1, 0), cA + kstep, voffA); PG8_STAGE(PG8_SB(1, 1), cB + hstepB + kstep, voffB);
    PG8_WAIT_V(6); PG8_BAR;
    for (;;) {
        const bool has_next = S.next(ui + 1, nxt);
        const char* nA = has_next ? (const char*)g.A + (size_t)nxt.pm * tstepA : cA; const char* nB = has_next ? (const char*)g.Bt + (size_t)nxt.pn * tstepB : cB;
        for (int t = 0; t < nt; t += 2) {
            const bool last = (t == nt - 2);
            const char* a1 = cA + (size_t)(t + 1) * kstep;
            const char* a2 = last ? nA : cA + (size_t)(t + 2) * kstep; const char* b2 = last ? nB : cB + (size_t)(t + 2) * kstep;
            const char* a3 = a2 + kstep; const char* b3 = b2 + kstep;
            PG8_LDB(B0, 0, 0); PG8_LDB(B1, 0, 1); PG8_SCHED; PG8_LDA(At, 0, 0); PG8_STAGE(PG8_SA(1, 1), a1 + hstepA, voffA);
            PG8_WAIT_V(8); PG8_WAIT_L(0); PG8_BAR; PG8_MMA(0, 0, At, B0); PG8_MMA(0, 1, At, B1); PG8_BAR; PG8_SCHED;
            PG8_LDA(At, 0, 1); PG8_STAGE(PG8_SB(0, 0), b2, voffB); PG8_STAGE(PG8_SB(0, 1), b2 + hstepB, voffB); PG8_STAGE(PG8_SA(0, 0), a2, voffA);
            PG8_WAIT_V(8); PG8_WAIT_L(0); PG8_BAR; PG8_MMA(1, 0, At, B0); PG8_MMA(1, 1, At, B1); PG8_BAR; PG8_SCHED;
            PG8_LDB(B0, 1, 0); PG8_LDB(B1, 1, 1); PG8_SCHED; PG8_LDA(At, 1, 0); PG8_STAGE(PG8_SA(0, 1), a2 + hstepA, voffA);
            PG8_WAIT_V(8); PG8_WAIT_L(0); PG8_BAR; PG8_MMA(0, 0, At, B0); PG8_MMA(0, 1, At, B1); PG8_BAR; PG8_SCHED;
            PG8_LDA(At, 1, 1); PG8_STAGE(PG8_SB(1, 0), b3, voffB); PG8_STAGE(PG8_SB(1, 1), b3 + hstepB, voffB); PG8_STAGE(PG8_SA(1, 0), a3, voffA);
            PG8_WAIT_V(8); PG8_WAIT_L(0); PG8_BAR; PG8_MMA(1, 0, At, B0); PG8_MMA(1, 1, At, B1); PG8_BAR; PG8_SCHED;
        }
        if constexpr (ALIGN_EPI) { if (wr == 0) PG8_BAR; }
        E(acc, cur, wr, wc, fr, fq);
        if (!has_next) break;
        if constexpr (Epi::HAS_INIT) { E.init(acc, nxt, wr, wc, fr, fq); }
        else {
#pragma unroll
        for (int a = 0; a < 2; ++a)
#pragma unroll
            for (int b = 0; b < 2; ++b)
#pragma unroll
                for (int m = 0; m < 4; ++m)
#pragma unroll
                    for (int n = 0; n < 2; ++n) acc[a][b][m][n] = (f32x4){0.f, 0.f, 0.f, 0.f};
        }
        cur = nxt; cA = nA; cB = nB; ++ui;
        if constexpr (ALIGN_EPI) { if (wr == 1) PG8_BAR; }
    }
    PG8_WAIT_V(0);
    if constexpr (!ALIGN_EPI) { if (wr == 0) PG8_BAR; }
    PG8_BAR;
#undef PG8_SA
#undef PG8_SB
#undef PG8_STAGE
#undef PG8_LDA
#undef PG8_LDB
#undef PG8_MMA
#undef PG8_WAIT_V
#undef PG8_WAIT_L
#undef PG8_BAR
#undef PG8_SCHED
}
}

#define XB_TMO      128
#define XB_XCNT(j)  (256  + 64 * (j))
#define XB_XSUB(j)  (1280 + 64 * (j))
#define XB_XGEN(j)  (2304 + 64 * (j))
#define XB_TOP      3328
#define XB_TOPGEN   3392
#define XCD_BAR_WORDS 3456
#define XB_SPIN_CAP (1u << 18)
__device__ __forceinline__ unsigned xb_ld(unsigned* p)              { return __hip_atomic_load(p, __ATOMIC_RELAXED, __HIP_MEMORY_SCOPE_AGENT); }
__device__ __forceinline__ unsigned xb_add(unsigned* p, unsigned v) { return __hip_atomic_fetch_add(p, v, __ATOMIC_RELAXED, __HIP_MEMORY_SCOPE_AGENT); }
__device__ __forceinline__ unsigned xb_xcc_id() { return (unsigned)__builtin_amdgcn_s_getreg((3 << 11) | 20) & 0xFu; }
#define XB_SPIN(cond, bar) do { unsigned _sp = 0; while (cond) { __builtin_amdgcn_s_sleep(1); \
    if ((++_sp & 255u) == 0u) { if (xb_ld(&(bar)[XB_TMO])) break; if (_sp > XB_SPIN_CAP) { atomicAdd(&(bar)[XB_TMO], 1u); break; } } } } while (0)
struct XcdBarrier { unsigned* bar; unsigned x; volatile LAS unsigned* st; };
__device__ __forceinline__ XcdBarrier xcd_barrier_post(unsigned* bar, volatile LAS unsigned* st) {
    XcdBarrier b; b.bar = bar; b.x = xb_xcc_id(); b.st = st;
    if (threadIdx.x == 0) (void)xb_add(&bar[XB_XCNT(b.x)], 1u);
    return b;
}
__device__ __forceinline__ void xcd_barrier_complete(unsigned* bar, unsigned x, unsigned& nloc, unsigned& nx) {
    const unsigned G = gridDim.x * gridDim.y * gridDim.z;
    unsigned sum, cnt, mine, sp = 0u;
    for (;;) {
        sum = 0u; cnt = 0u; mine = 0u;
#pragma unroll
        for (unsigned j = 0; j < 16; ++j) { const unsigned c = xb_ld(&bar[XB_XCNT(j)]); sum += c; cnt += (c > 0u) ? 1u : 0u; mine = (j == x) ? c : mine; }
        if (sum == G) break;
        __builtin_amdgcn_s_sleep(1);
        if ((++sp & 255u) == 0u) { if (xb_ld(&bar[XB_TMO])) break; if (sp > XB_SPIN_CAP) { atomicAdd(&bar[XB_TMO], 1u); break; } }
    }
    nloc = mine > 0u ? mine : 1u; nx = cnt > 0u ? cnt : 1u;
}
__device__ __forceinline__ void xcd_barrier(const XcdBarrier& b) {
    asm volatile("s_waitcnt vmcnt(0)" ::: "memory");
    __syncthreads();
    if (threadIdx.x == 0) {
        unsigned* bar = b.bar;
        __builtin_amdgcn_s_waitcnt(0);
        unsigned nloc = b.st[0], nx = b.st[1];
        if (nloc == 0u) { xcd_barrier_complete(bar, b.x, nloc, nx); b.st[0] = nloc; b.st[1] = nx; }
        const unsigned old = xb_add(&bar[XB_XSUB(b.x)], 1u);
        const unsigned gen = old / nloc;
        if (old + 1u == (gen + 1u) * nloc) {
            __builtin_amdgcn_fence(__ATOMIC_RELEASE, "agent");
            asm volatile("s_waitcnt vmcnt(0)" ::: "memory");
            const unsigned og = xb_add(&bar[XB_TOP], 1u);
            const unsigned tg = og / nx;
            if (og + 1u == (tg + 1u) * nx) xb_add(&bar[XB_TOPGEN], 1u);
            else XB_SPIN(xb_ld(&bar[XB_TOPGEN]) == tg, bar);
            __builtin_amdgcn_fence(__ATOMIC_ACQUIRE, "agent");
            xb_add(&bar[XB_XGEN(b.x)], 1u);
            asm volatile("s_waitcnt vmcnt(0)" ::: "memory");
        } else {
            XB_SPIN(xb_ld(&bar[XB_XGEN(b.x)]) == gen, bar);
            __builtin_amdgcn_fence(__ATOMIC_ACQUIRE, "agent");
            asm volatile("s_waitcnt vmcnt(0)" ::: "memory");
        }
    }
    __syncthreads();
}

struct Args {
    const float* x; const float* norm1_w; const float* w_in; const float* conv_w; const float* conv_b; const float* igate_b; const float* fgate_b;
    const float* q_norm_w; const float* k_norm_w; const float* mlstm_norm_w; const float* attn_norm_w; const float* w_out; const float* norm2_w;
    const float* w_gate; const float* w_up; const float* w_down;
    float* out; unsigned char* ws; int dry; int pad;
};

struct TItem { const float* W; bf16* WT; const float* kscale; int ldw, K, nsrc0, ndst0, k0; };
__device__ __forceinline__ void titem_load(const TItem& t, f32x4 (&v)[8], int lane) {
    const float* src = t.W + (size_t)(t.k0 + (lane >> 3)) * t.ldw + t.nsrc0 + (lane & 7) * 4;
#pragma unroll
    for (int i = 0; i < 8; ++i) v[i] = __builtin_nontemporal_load((const f32x4*)(src + (size_t)(8 * i) * t.ldw));
}
__device__ __forceinline__ void titem_finish(const TItem& t, const f32x4 (&v)[8], LAS float* scr, int lane) {
#pragma unroll
    for (int i = 0; i < 8; ++i) { const int kk = 8 * i + (lane >> 3); const float sc = t.kscale ? t.kscale[t.k0 + kk] : 1.0f; LAS float* d = scr + kk * 33 + (lane & 7) * 4;
        d[0] = v[i][0] * sc; d[1] = v[i][1] * sc; d[2] = v[i][2] * sc; d[3] = v[i][3] * sc; }
    LDS_WAIT(); asm volatile("" ::: "memory");
    const int c = lane & 7;
#pragma unroll
    for (int j = 0; j < 4; ++j) { const int n = (lane >> 3) + 8 * j; const LAS float* s = scr + (8 * c) * 33 + n;
        u32x4 o; o.x = cvtpk(s[0 * 33], s[1 * 33]); o.y = cvtpk(s[2 * 33], s[3 * 33]); o.z = cvtpk(s[4 * 33], s[5 * 33]); o.w = cvtpk(s[6 * 33], s[7 * 33]);
        *(u32x4*)(t.WT + (size_t)(t.ndst0 + n) * t.K + t.k0 + 8 * c) = o; }
    LDS_WAIT(); asm volatile("" ::: "memory");
}
__device__ __forceinline__ int win_src_col(int nd) {
    if (nd < 1024) return nd;
    if (nd < 2048) return nd + 1024;
    if (nd < 3072) return nd - 1024;
    return nd + 8;
}


__device__ __forceinline__ float scan_add64(float v, int lane) {
#pragma unroll
    for (int o = 1; o < 64; o <<= 1) { const float t = __shfl_up(v, o); if (lane >= o) v += t; }
    return v;
}
__device__ __forceinline__ float scan_max64(float v, int lane) {
#pragma unroll
    for (int o = 1; o < 64; o <<= 1) { const float t = __shfl_up(v, o); if (lane >= o) v = fmaxf(v, t); }
    return v;
}
template <bool ROWW>
__device__ __forceinline__ void conv_tile(const bf16* proj, const float* conv_w, const float* conv_b, int b, int c, int col0, int ch0, float rscale, float wlane, LAS unsigned char* tile, int tid) {
    const int rr = tid >> 4, cc = (tid & 15) * 8;
    float w[4][8], bb[8];
#pragma unroll
    for (int j = 0; j < 4; ++j) { const f32x4 w0 = *(const f32x4*)(conv_w + j * 1024 + ch0 + cc), w1 = *(const f32x4*)(conv_w + j * 1024 + ch0 + cc + 4);
        w[j][0] = w0[0]; w[j][1] = w0[1]; w[j][2] = w0[2]; w[j][3] = w0[3]; w[j][4] = w1[0]; w[j][5] = w1[1]; w[j][6] = w1[2]; w[j][7] = w1[3]; }
    { const f32x4 b0 = *(const f32x4*)(conv_b + ch0 + cc), b1 = *(const f32x4*)(conv_b + ch0 + cc + 4);
      bb[0] = b0[0]; bb[1] = b0[1]; bb[2] = b0[2]; bb[3] = b0[3]; bb[4] = b1[0]; bb[5] = b1[1]; bb[6] = b1[2]; bb[7] = b1[3]; }
#pragma unroll
    for (int half = 0; half < 2; ++half) {
        const int l = rr + 32 * half, t = c * 64 + l;
        float y[8];
#pragma unroll
        for (int e = 0; e < 8; ++e) y[e] = bb[e];
#pragma unroll
        for (int j = 0; j < 4; ++j) { const int tt = t - 3 + j;
            if (tt >= 0) { const u32x4 raw = *(const u32x4*)(proj + (size_t)(b * SEQ + tt) * NPROJ + col0 + cc); float x[8]; unpack8(raw, x);
#pragma unroll
                for (int e = 0; e < 8; ++e) y[e] += w[j][e] * x[e]; } }
        float sc = rscale;
        if (ROWW) sc *= __shfl(wlane, l);
#pragma unroll
        for (int e = 0; e < 8; ++e) y[e] = y[e] / (1.0f + __expf(-y[e])) * sc;
        *(LAS u32x4*)(tile + l * 288 + cc * 2) = pack8(y);
    }
}
__device__ __forceinline__ void v_tile(const bf16* proj, int b, int c, int h, LAS unsigned char* tile, int tid) {
#pragma unroll
    for (int p = 0; p < 4; ++p) { const int row = p * 16 + (tid >> 5), ch = tid & 31;
        const u32x4 v = *(const u32x4*)(proj + (size_t)(b * SEQ + c * 64 + row) * NPROJ + PC_MV + h * 256 + ch * 8);
        *(LAS u32x4*)(tile + row * 544 + ch * 16) = v; }
}

__device__ __forceinline__ void q_prep(const bf16* qrow, const float* rcos, const float* rsin, const float* qnw, int tq, int g, bf16x8 (&qf)[4]) {
    float q[4][8]; float ss = 0.f;
#pragma unroll
    for (int ks = 0; ks < 4; ++ks) { const u32x4 raw = *(const u32x4*)(qrow + 32 * ks + 8 * g); unpack8(raw, q[ks]);
#pragma unroll
        for (int e = 0; e < 8; ++e) ss += q[ks][e] * q[ks][e]; }
    ss = xg_sum(ss);
    const float rq = 1.0f / sqrtf(ss * (1.0f / 128.0f) + NORM_EPS);
#pragma unroll
    for (int ks = 0; ks < 2; ++ks) {
        const int c0 = 32 * ks + 8 * g;
#pragma unroll
        for (int e4 = 0; e4 < 2; ++e4) {
            const f32x4 cs = *(const f32x4*)(rcos + tq * 64 + c0 + 4 * e4), sn = *(const f32x4*)(rsin + tq * 64 + c0 + 4 * e4);
            const f32x4 w1 = *(const f32x4*)(qnw + c0 + 4 * e4), w2 = *(const f32x4*)(qnw + 64 + c0 + 4 * e4);
#pragma unroll
            for (int e = 0; e < 4; ++e) { const float y1 = q[ks][4 * e4 + e] * rq * w1[e], y2 = q[ks + 2][4 * e4 + e] * rq * w2[e];
                q[ks][4 * e4 + e] = y1 * cs[e] - y2 * sn[e]; q[ks + 2][4 * e4 + e] = y2 * cs[e] + y1 * sn[e]; }
        }
    }
#pragma unroll
    for (int ks = 0; ks < 4; ++ks) { const u32x4 w = pack8(q[ks]); qf[ks] = __builtin_bit_cast(bf16x8, w); }
}
struct AUnit { int b, h, d, r, n; bf16* po0; float* pl0; };
template <bool FINAL>
__device__ __forceinline__ void attn_pair(bf16* proj, const float* rcos, const float* rsin, const float* qnw, const float* anw, const AUnit& ua, const AUnit& ub,
                                          LAS unsigned char* lds_all, bf16* po1, float* pl1, int tid_in, bool dry) {
    int tid = tid_in; asm volatile("" : "+v"(tid));
    const int lane = tid & 63, wave = __builtin_amdgcn_readfirstlane(tid >> 6);
    const int team = wave >> 2, w4 = wave & 3;
    const int b = team ? ub.b : ua.b, h = team ? ub.h : ua.h, d = team ? ub.d : ua.d, r = team ? ub.r : ua.r, n = team ? ub.n : ua.n;
    bf16* po0 = team ? ub.po0 : ua.po0; float* pl0 = team ? ub.pl0 : ua.pl0;
    LAS unsigned char* lds = lds_all + team * 36864;
    const int j = lane & 15, g = lane >> 4, qp = j >> 2, p = lane & 3;
    const int tt = tid & 255, srow = tt >> 4, sch = tt & 15;
    const bf16* kcol = proj + (size_t)b * SEQ * NPROJ + PC_AK + h * 128 + sch * 8;
    const bf16* vcol = kcol + (PC_AV - PC_AK);
    const int kt0 = (n == 0) ? 4 : 0;
    const int sub0 = 128 * (n - 1) + srow;
    u32x4 rk[2][2], rv[2][2];
#define AT_ISSUE(set, t) do { if ((t) < 8) { _Pragma("unroll") for (int hh_ = 0; hh_ < 2; ++hh_) { const size_t tok_ = (size_t)((sub0 + 32 * (t) + 16 * hh_) * d + r); \
        rk[set][hh_] = *(const u32x4*)(kcol + tok_ * NPROJ); rv[set][hh_] = *(const u32x4*)(vcol + tok_ * NPROJ); } } } while (0)
#define AT_WRITE(set, t) do { LAS unsigned char* Kn_ = lds + ((t) & 1) * 18432; _Pragma("unroll") for (int hh_ = 0; hh_ < 2; ++hh_) { \
        *(LAS u32x4*)(Kn_ + (srow + 16 * hh_) * 288 + sch * 16) = rk[set][hh_]; *(LAS u32x4*)(Kn_ + 9216 + (srow + 16 * hh_) * 288 + sch * 16) = rv[set][hh_]; } } while (0)
#define WG_BAR() do { asm volatile("s_waitcnt lgkmcnt(0)" ::: "memory"); __builtin_amdgcn_s_barrier(); asm volatile("" ::: "memory"); } while (0)
    AT_ISSUE(0, kt0); AT_ISSUE(1, kt0 + 1);
    bf16x8 qf[2][4]; int qi[2]; int tq[2];
    const int G0 = w4, G1 = 7 - w4;
    qi[0] = 16 * G0 + j; qi[1] = 16 * G1 + j; tq[0] = (128 * n + qi[0]) * d + r; tq[1] = (128 * n + qi[1]) * d + r;
    const int lo0 = G0 >> 1, lo1 = G1 >> 1;
#pragma unroll
    for (int gi = 0; gi < 2; ++gi) { const bf16* qrow = proj + (size_t)(b * SEQ + tq[gi]) * NPROJ + PC_AQ + h * 128 + 8 * g;
#pragma unroll
        for (int ks = 0; ks < 4; ++ks) qf[gi][ks] = *(const bf16x8*)(qrow + 32 * ks); }
    AT_WRITE(0, kt0);
    for (int kb_ = 0; kb_ < kt0; ++kb_) WG_BAR();
    WG_BAR();
    float m_run[2] = {-1e30f, -1e30f}, l_run[2] = {0.f, 0.f};
    f32x4 o[2][8];
    if (FINAL) {
#pragma unroll
        for (int gi = 0; gi < 2; ++gi) { const size_t trow = (size_t)(b * SEQ + tq[gi]);
            const float l0 = pl0[trow * 8 + h], l1 = pl1[trow * 8 + h]; const float m0 = fmaxf(l0, l1);
            const float a0 = __builtin_amdgcn_exp2f(l0 - m0), a1 = __builtin_amdgcn_exp2f(l1 - m0);
            m_run[gi] = m0; l_run[gi] = (g == 0) ? a0 + a1 : 0.f;
            const bf16* p0 = po0 + trow * 1024 + h * 128 + g * 32; const bf16* p1 = po1 + trow * 1024 + h * 128 + g * 32;
#pragma unroll
            for (int np = 0; np < 4; ++np) { const u32x4 x0 = *(const u32x4*)(p0 + 8 * np), x1 = *(const u32x4*)(p1 + 8 * np); float f0[8], f1[8]; unpack8(x0, f0); unpack8(x1, f1);
#pragma unroll
                for (int e = 0; e < 4; ++e) { o[gi][2 * np][e] = a0 * f0[e] + a1 * f1[e]; o[gi][2 * np + 1][e] = a0 * f0[4 + e] + a1 * f1[4 + e]; } }
        }
    } else {
#pragma unroll
        for (int gi = 0; gi < 2; ++gi)
#pragma unroll
            for (int nf = 0; nf < 8; ++nf) o[gi][nf] = (f32x4){0.f, 0.f, 0.f, 0.f};
    }
    const float SC = 0.08838834764831845f * 1.4426950408889634f;
    const float NEG = -__builtin_inff();
#define AT_SM(gi, kt, s0, s1) do { \
                float x[8]; float tmax = NEG; \
                _Pragma("unroll") for (int e = 0; e < 8; ++e) { const int kj = 32 * (kt) + 16 * (e >> 2) + 4 * g + (e & 3); const float sv = (e < 4) ? s0[e & 3] : s1[e & 3]; \
                    const bool valid = (kj >= qi[gi]) && (kj <= qi[gi] + 128); \
                    x[e] = valid ? sv * SC : NEG; tmax = fmaxf(tmax, x[e]); } \
                tmax = xg_max(tmax); \
                const float m_new = fmaxf(m_run[gi], tmax); \
                const float alpha = __builtin_amdgcn_exp2f(m_run[gi] - m_new); \
                float ps = 0.f; \
                _Pragma("unroll") for (int e = 0; e < 8; ++e) { x[e] = __builtin_amdgcn_exp2f(x[e] - m_new); ps += x[e]; } \
                l_run[gi] = l_run[gi] * alpha + ps; m_run[gi] = m_new; \
                _Pragma("unroll") for (int nf = 0; nf < 8; ++nf) o[gi][nf] = o[gi][nf] * alpha; \
                const u32x4 pw = pack8(x); pb[gi] = __builtin_bit_cast(bf16x8, pw); } while (0)
#define AT_ONE(gi, kt) do { \
            f32x4 sA = {0.f, 0.f, 0.f, 0.f}, sB = {0.f, 0.f, 0.f, 0.f}; \
            _Pragma("unroll") for (int ks = 0; ks < 4; ++ks) { \
                const bf16x8 k0 = *(const LAS bf16x8*)(Kt + j * 288 + (32 * ks + 8 * g) * 2), k1 = *(const LAS bf16x8*)(Kt + (16 + j) * 288 + (32 * ks + 8 * g) * 2); \
                sA = MFMA16(k0, qf[gi][ks], sA); sB = MFMA16(k1, qf[gi][ks], sB); } \
            bf16x8 pb[2]; AT_SM(gi, kt, sA, sB); \
            _Pragma("unroll") for (int nf = 0; nf < 8; ++nf) { \
                const s16x4 a0 = vtr(Vt + (4 * g + qp) * 288 + (16 * nf + 4 * p) * 2), a1 = vtr(Vt + (16 + 4 * g + qp) * 288 + (16 * nf + 4 * p) * 2); \
                o[gi][nf] = MFMA16(cat4(a0, a1), pb[gi], o[gi][nf]); } } while (0)
#define AT_STEP(kt, setn, setw) do { \
        LAS unsigned char* Kt = lds + ((kt) & 1) * 18432; LAS unsigned char* Vt = Kt + 9216; \
        AT_ISSUE(setn, (kt) + 2); \
        const bool act0 = (kt) >= lo0 && (kt) <= lo0 + 4, act1 = (kt) >= lo1 && (kt) <= lo1 + 4; \
        if (act0 && act1) { \
            f32x4 sA[2], sB[2]; sA[0] = (f32x4){0.f, 0.f, 0.f, 0.f}; sA[1] = sA[0]; sB[0] = sA[0]; sB[1] = sA[0]; \
            _Pragma("unroll") for (int ks = 0; ks < 4; ++ks) { \
                const bf16x8 k0 = *(const LAS bf16x8*)(Kt + j * 288 + (32 * ks + 8 * g) * 2), k1 = *(const LAS bf16x8*)(Kt + (16 + j) * 288 + (32 * ks + 8 * g) * 2); \
                sA[0] = MFMA16(k0, qf[0][ks], sA[0]); sB[0] = MFMA16(k1, qf[0][ks], sB[0]); sA[1] = MFMA16(k0, qf[1][ks], sA[1]); sB[1] = MFMA16(k1, qf[1][ks], sB[1]); } \
            bf16x8 pb[2]; \
            AT_SM(0, kt, sA[0], sB[0]); AT_SM(1, kt, sA[1], sB[1]); \
            _Pragma("unroll") for (int nf = 0; nf < 8; ++nf) { \
                const s16x4 a0 = vtr(Vt + (4 * g + qp) * 288 + (16 * nf + 4 * p) * 2), a1 = vtr(Vt + (16 + 4 * g + qp) * 288 + (16 * nf + 4 * p) * 2); \
                const bf16x8 vf = cat4(a0, a1); \
                o[0][nf] = MFMA16(vf, pb[0], o[0][nf]); o[1][nf] = MFMA16(vf, pb[1], o[1][nf]); } \
        } else if (act0) { AT_ONE(0, kt); } else if (act1) { AT_ONE(1, kt); } \
        if ((kt) + 1 < 8) AT_WRITE(setw, (kt) + 1); \
        WG_BAR(); } while (0)
#pragma unroll 1
    for (int kt = kt0; kt < 8; kt += 2) { AT_STEP(kt, 0, 1); AT_STEP(kt + 1, 1, 0); }
#undef AT_STEP
#undef AT_ONE
#undef AT_SM
#undef AT_ISSUE
#undef AT_WRITE
#pragma unroll
    for (int gi = 0; gi < 2; ++gi) {
        float lr = l_run[gi]; lr = xg_sum(lr);
        const float inv = 1.0f / lr;
        const float lse2 = m_run[gi] + __log2f(lr);
        const size_t trow = (size_t)(b * SEQ + tq[gi]);
        if (!FINAL) {
            bf16* pp = po0 + trow * 1024 + h * 128 + g * 32;
#pragma unroll
            for (int np = 0; np < 4; ++np) { const f32x4 va = o[gi][2 * np] * inv, vb = o[gi][2 * np + 1] * inv; u32x4 ww; ww.x = cvtpk(va[0], va[1]); ww.y = cvtpk(va[2], va[3]); ww.z = cvtpk(vb[0], vb[1]); ww.w = cvtpk(vb[2], vb[3]);
                if (!dry) *(u32x4*)(pp + 8 * np) = ww; }
            if (g == 0 && !dry) pl0[trow * 8 + h] = lse2;
        } else {
            bf16* qrow = proj + trow * NPROJ + PC_AQ + h * 128;
            float ss = 0.f;
#pragma unroll
            for (int nf = 0; nf < 8; ++nf) { const f32x4 v = o[gi][nf] * inv; o[gi][nf] = v; ss += (v[0] * v[0] + v[1] * v[1]) + (v[2] * v[2] + v[3] * v[3]); }
            ss = xg_sum(ss);
            const float rn = 1.0f / sqrtf(ss * (1.0f / 128.0f) + NORM_EPS);
#pragma unroll
            for (int nf = 0; nf < 8; ++nf) { const int e = 16 * nf + 4 * g; const f32x4 w = *(const f32x4*)(anw + h * 128 + e); const f32x4 v = o[gi][nf] * rn * w;
                u32x2 ww; ww.x = cvtpk(v[0], v[1]); ww.y = cvtpk(v[2], v[3]); if (!dry) *(u32x2*)(qrow + e) = ww; }
        }
    }
}

#ifndef PROBE_PHASE
#define PROBE_PHASE -1
#endif
#define REP_BEGIN(k) for (int rep_ = (PROBE_PHASE == (k)) ? 0 : 1; rep_ < 2; ++rep_) { const bool dry = (rep_ == 0) && (a.dry != 0); (void)dry; \
    int tid = threadIdx.x; asm volatile("" : "+v"(tid)); const int lane = tid & 63, wave = __builtin_amdgcn_readfirstlane(tid >> 6); \
    const int gw = vcu * NWAVES + wave, gt = vcu * (NWAVES * 64) + tid; (void)lane; (void)wave; (void)gw; (void)gt;
#define REP_END }

__global__ void __launch_bounds__(NWAVES * 64, 2) hymba_fwd(Args a) {
    extern __shared__ __attribute__((aligned(16))) unsigned char lds_raw[];
    LAS unsigned char* lds = (LAS unsigned char*)lds_raw;
    volatile LAS unsigned* MISC = (volatile LAS unsigned*)(lds + MISC_OFF);
    const int tid = threadIdx.x, lane = tid & 63, wave = __builtin_amdgcn_readfirstlane(tid >> 6);
    const int G = gridDim.x; const int bx = blockIdx.x; const int vcu = (G % 8 == 0) ? (bx % 8) * (G / 8) + bx / 8 : bx;
    unsigned char* ws = a.ws;
    unsigned* ctl = (unsigned*)(ws + WS_CTL);
    float* gli = (float*)(ws + WS_GLI); float* glf = (float*)(ws + WS_GLF); float* sumsq = (float*)(ws + WS_SUMSQ);
    float* msc_g = (float*)(ws + WS_MSC); float* msc_ml = msc_g + 512; float* msc_mp = msc_g + 1024;
    float* ncb = (float*)(ws + WS_NC);
    float* rcos = (float*)(ws + WS_COS); float* rsin = (float*)(ws + WS_SIN);
    bf16* WinT = (bf16*)(ws + WS_WIN); bf16* kvT = (bf16*)(ws + WS_KV); bf16* Ub = (bf16*)(ws + WS_U); bf16* H1b = (bf16*)(ws + WS_U);
    bf16* proj = (bf16*)(ws + WS_PROJ); bf16* FF = (bf16*)(ws + WS_PROJ);
    bf16* op0 = (bf16*)(ws + WS_OP0); bf16* op1 = (bf16*)(ws + WS_OP1); float* pl0 = (float*)(ws + WS_PL0); float* pl1 = (float*)(ws + WS_PL1);
    bf16* WoutT = (bf16*)(ws + WS_WOUT); bf16* WguT = (bf16*)(ws + WS_WGU); bf16* WdnT = (bf16*)(ws + WS_WDN);

    for (int u = tid; u < (LDS_BYTES - MISC_OFF) / 4; u += NWAVES * 64) ((LAS unsigned*)(lds + MISC_OFF))[u] = 0u;
    __syncthreads();
    XcdBarrier bar = xcd_barrier_post(ctl + CW_BAR, MISC + 8);
    const int NGW = G * NWAVES, NGT = G * NWAVES * 64;

    REP_BEGIN(0)
        for (int i = gt; i < MTOK; i += NGT) sumsq[i] = 0.f;
        for (int i = gt; i < SEQ * 64; i += NGT) {
            const int pos = i >> 6, fi = i & 63;
            const float invf = (float)exp2(-(double)fi * (13.287712379549449 / 64.0));
            const float ang = (float)pos * invf;
            const double rev = (double)ang * 0.15915494309189535; const double fr_ = rev - rint(rev);
            const float ar = (float)(fr_ * 6.283185307179586);
            rcos[i] = cosf(ar); rsin[i] = sinf(ar);
        }
        {
            LAS float* scr = (LAS float*)(lds + wave * 16384);
            constexpr int I_IN = (DM / 64) * (NPROJ / 32), I_OUT = (DM / 64) * (DM / 32), I_GU = (DM / 64) * (NGU / 32), I_DN = (DFF / 64) * (DM / 32);
            constexpr int NITEMS = I_IN + I_OUT + I_GU;
            auto decode = [&](int it) -> TItem {
                TItem t; int r = it;
                if (r < I_IN) { const int nblk = NPROJ / 32, kb = r / nblk, nb = r % nblk; t = TItem{a.w_in, WinT, nullptr, INW, DM, win_src_col(nb * 32), nb * 32, kb * 64}; return t; } r -= I_IN;
                if (r < I_OUT) { const int nblk = DM / 32, kb = r / nblk, nb = r % nblk; t = TItem{a.w_out, WoutT, nullptr, DM, DM, nb * 32, nb * 32, kb * 64}; return t; } r -= I_OUT;
                { const int nblk = NGU / 32, kb = r / nblk, nb = r % nblk; const int nd = nb * 32, pn = nd >> 8, j = nd & 255;
                    t = TItem{(j < 128) ? a.w_gate : a.w_up, WguT, a.norm2_w, DFF, DM, pn * 128 + (j & 127), nd, kb * 64}; return t; }
            };
            int it = gw;
            if (it < NITEMS) {
                TItem cur = decode(it); f32x4 vc[8]; titem_load(cur, vc, lane);
                for (;;) {
                    const int nx = it + NGW; const bool more = nx < NITEMS;
                    TItem nt = cur; f32x4 vn[8];
                    if (more) { nt = decode(nx); titem_load(nt, vn, lane); }
                    titem_finish(cur, vc, scr, lane);
                    if (!more) break;
                    cur = nt; it = nx;
#pragma unroll
                    for (int i = 0; i < 8; ++i) vc[i] = vn[i];
                }
            }
        }
        __syncthreads();
        LAS float* wg = (LAS float*)lds;
        for (int k = tid; k < DM; k += NWAVES * 64) { const f32x4 g0 = *(const f32x4*)(a.w_in + (size_t)k * INW + 3072), g1 = *(const f32x4*)(a.w_in + (size_t)k * INW + 3076);
            wg[0 * DM + k] = g0[0]; wg[1 * DM + k] = g0[1]; wg[2 * DM + k] = g0[2]; wg[3 * DM + k] = g0[3];
            wg[4 * DM + k] = g1[0]; wg[5 * DM + k] = g1[1]; wg[6 * DM + k] = g1[2]; wg[7 * DM + k] = g1[3]; }
        __syncthreads();
        for (int m = gw; m < MTOK; m += NGW) {
            const f32x4* xr = (const f32x4*)(a.x + (size_t)m * DM) + lane; const f32x4* wr_ = (const f32x4*)a.norm1_w + lane;
            f32x4 v[8]; float s = 0.f;
#pragma unroll
            for (int j = 0; j < 8; ++j) { v[j] = __builtin_nontemporal_load(xr + 64 * j); s += (v[j][0] * v[j][0] + v[j][1] * v[j][1]) + (v[j][2] * v[j][2] + v[j][3] * v[j][3]); }
            const float rstd = 1.0f / sqrtf(wave_sum(s) * (1.0f / DM) + NORM_EPS);
            u32x2* o8 = (u32x2*)(Ub + (size_t)m * DM) + lane;
#pragma unroll
            for (int j = 0; j < 8; ++j) { v[j] = v[j] * rstd * wr_[64 * j]; u32x2 w; w.x = cvtpk(v[j][0], v[j][1]); w.y = cvtpk(v[j][2], v[j][3]); o8[64 * j] = w; }
            float z = 0.f;
#pragma unroll 1
            for (int gi = 0; gi < 8; ++gi) { float t = 0.f;
#pragma unroll
                for (int j = 0; j < 8; ++j) { const f32x4 w4 = *(const LAS f32x4*)(wg + gi * DM + 256 * j + 4 * lane); t += (v[j][0] * w4[0] + v[j][1] * w4[1]) + (v[j][2] * w4[2] + v[j][3] * w4[3]); }
                t = wave_sum(t); z = (lane == gi) ? t : z; }
            if (lane < 8) {
                const int hh = lane & 3;
                if (lane < 4) { gli[m * 4 + hh] = 15.0f * tanhf((z + a.igate_b[hh]) * (1.0f / 15.0f)); }
                else { const float fp = 15.0f * tanhf((z + a.fgate_b[hh]) * (1.0f / 15.0f)); glf[m * 4 + hh] = -log1pf(expf(-fp)); }
            }
        }
    REP_END
    xcd_barrier(bar);

    REP_BEGIN(1)
        pg8::Gemm g{Ub, WinT, MTOK, NPROJ, DM, DM}; pg8::StaticOrder S; S.init(MTOK, NPROJ, G, bx);
        pg8::EpiBf16 E{proj, NPROJ};
        pg8::gemm_phase<pg8::EpiBf16, true>(lds, g, S, E);
    REP_END
    xcd_barrier(bar);

    REP_BEGIN(2)
        {
            const int c0 = 4 * (tid & 15), rstride = NGT >> 4;
            for (int which = 0; which < 2; ++which) {
                const float* nw = which ? a.k_norm_w : a.q_norm_w; const int colb = which ? PC_AK : PC_AQ;
                const f32x4 w1 = *(const f32x4*)(nw + c0), w2 = *(const f32x4*)(nw + 64 + c0);
                for (int idx0 = gt >> 4; idx0 < MTOK * 8; idx0 += 4 * rstride) {
                    u32x2 r1[4], r2[4]; f32x4 cs[4], sn[4];
#pragma unroll
                    for (int q = 0; q < 4; ++q) { const int idx = idx0 + q * rstride;
                        if (idx < MTOK * 8) { const int m = idx >> 3, hh = idx & 7, pos = m & (SEQ - 1); const bf16* kp = proj + (size_t)m * NPROJ + colb + hh * 128;
                            r1[q] = *(const u32x2*)(kp + c0); r2[q] = *(const u32x2*)(kp + 64 + c0); cs[q] = *(const f32x4*)(rcos + pos * 64 + c0); sn[q] = *(const f32x4*)(rsin + pos * 64 + c0); } }
#pragma unroll
                    for (int q = 0; q < 4; ++q) { const int idx = idx0 + q * rstride;
                        if (idx < MTOK * 8) { const int m = idx >> 3, hh = idx & 7; bf16* kp = proj + (size_t)m * NPROJ + colb + hh * 128;
                            float x1[4] = {bf_lo(r1[q].x), bf_hi(r1[q].x), bf_lo(r1[q].y), bf_hi(r1[q].y)}, x2[4] = {bf_lo(r2[q].x), bf_hi(r2[q].x), bf_lo(r2[q].y), bf_hi(r2[q].y)};
                            float ss = 0.f;
#pragma unroll
                            for (int e = 0; e < 4; ++e) ss += x1[e] * x1[e] + x2[e] * x2[e];
                            ss = row16_sum(ss);
                            const float rk = 1.0f / sqrtf(ss * (1.0f / 128.0f) + NORM_EPS);
                            float o1[4], o2[4];
#pragma unroll
                            for (int e = 0; e < 4; ++e) { const float y1 = x1[e] * rk * w1[e], y2 = x2[e] * rk * w2[e]; o1[e] = y1 * cs[q][e] - y2 * sn[q][e]; o2[e] = y2 * cs[q][e] + y1 * sn[q][e]; }
                            u32x2 wv; wv.x = cvtpk(o1[0], o1[1]); wv.y = cvtpk(o1[2], o1[3]); if (!dry) *(u32x2*)(kp + c0) = wv;
                            wv.x = cvtpk(o2[0], o2[1]); wv.y = cvtpk(o2[2], o2[3]); if (!dry) *(u32x2*)(kp + 64 + c0) = wv; } }
                }
            }
        }
        LAS unsigned char* KW = lds; LAS unsigned char* VT = lds + 18432;
        const int g = lane >> 4, qp = (lane & 15) >> 2, p = lane & 3;
        for (int u = vcu; u < 512; u += G) {
            const int b = u >> 8, h = (u >> 6) & 3, c = u & 63;
            const int tok = b * SEQ + c * 64 + lane;
            const float li = gli[tok * 4 + h], lf = glf[tok * 4 + h];
            const float cf = scan_add64(lf, lane);
            const float gsum = __shfl(cf, 63);
            const float av = gsum - cf + li;
            const float ml = wave_max(av);
            const float wst = __expf(av - ml);
            if (tid == 0) { msc_g[u] = gsum; msc_ml[u] = ml; }
            conv_tile<true>(proj, a.conv_w, a.conv_b, b, c, PC_MK + h * 128, 512 + h * 128, 1.0f, wst, KW, tid);
            v_tile(proj, b, c, h, VT, tid);
            __syncthreads();
            f32x4 acc[8][2];
#pragma unroll
            for (int df = 0; df < 8; ++df) { acc[df][0] = (f32x4){0.f, 0.f, 0.f, 0.f}; acc[df][1] = (f32x4){0.f, 0.f, 0.f, 0.f}; }
#pragma unroll
            for (int kk = 0; kk < 2; ++kk) {
                bf16x8 bfr[2];
#pragma unroll
                for (int ef = 0; ef < 2; ++ef) { const int col = 32 * wave + 16 * ef + 4 * p;
                    bfr[ef] = cat4(vtr(VT + (32 * kk + 4 * g + qp) * 544 + col * 2), vtr(VT + (32 * kk + 16 + 4 * g + qp) * 544 + col * 2)); }
#pragma unroll
                for (int df = 0; df < 8; ++df) { const int col = 16 * df + 4 * p;
                    const bf16x8 af = cat4(vtr(KW + (32 * kk + 4 * g + qp) * 288 + col * 2), vtr(KW + (32 * kk + 16 + 4 * g + qp) * 288 + col * 2));
                    acc[df][0] = MFMA16(af, bfr[0], acc[df][0]); acc[df][1] = MFMA16(af, bfr[1], acc[df][1]); }
            }
#pragma unroll
            for (int ef = 0; ef < 2; ++ef) { const int e = 32 * wave + 16 * ef + (lane & 15);
#pragma unroll
                for (int df = 0; df < 8; ++df) { const f32x4 v = acc[df][ef]; u32x2 w; w.x = cvtpk(v[0], v[1]); w.y = cvtpk(v[2], v[3]);
                    *(u32x2*)(kvT + ((size_t)u * 256 + e) * 128 + 16 * df + 4 * g) = w; } }
            if (tid < 128) { float nsum = 0.f;
#pragma unroll 8
                for (int l = 0; l < 64; ++l) nsum += __uint_as_float((unsigned)(*(const LAS unsigned short*)(KW + l * 288 + tid * 2)) << 16);
                ncb[u * 128 + tid] = nsum; }
            __syncthreads();
        }
    REP_END
    xcd_barrier(bar);

    REP_BEGIN(3)
        LAS float* sg = (LAS float*)lds; LAS float* sml = sg + 512;
        for (int i = tid; i < 512; i += NWAVES * 64) { sg[i] = msc_g[i]; sml[i] = msc_ml[i]; }
        __syncthreads();
        for (int id = gt; id < 8 * 16384; id += NGT) {
            const int bh = id >> 14, pi = id & 16383;
            unsigned* base = (unsigned*)kvT + (size_t)bh * 64 * 16384 + pi;
            float c0 = 0.f, c1 = 0.f, m = 0.f;
#pragma unroll 1
            for (int cb = 0; cb < 64; cb += 32) {
                unsigned xv[32];
#pragma unroll
                for (int i = 0; i < 32; ++i) xv[i] = base[(size_t)(cb + i) * 16384];
#pragma unroll
                for (int i = 0; i < 32; ++i) {
                    const float gg = sg[bh * 64 + cb + i], ml = sml[bh * 64 + cb + i];
                    const float mn = fmaxf(gg + m, ml), so = __expf(gg + m - mn), sn = __expf(ml - mn);
                    if (!dry) base[(size_t)(cb + i) * 16384] = cvtpk(c0, c1);
                    c0 = so * c0 + sn * bf_lo(xv[i]); c1 = so * c1 + sn * bf_hi(xv[i]); m = mn;
                }
            }
        }
        for (int id = gt; id < 8 * 128; id += NGT) {
            const int bh = id >> 7, dd = id & 127; float n = 0.f, m = 0.f;
            float* nb_ = ncb + (size_t)bh * 64 * 128 + dd;
#pragma unroll 1
            for (int cb = 0; cb < 64; cb += 32) {
                float xv[32];
#pragma unroll
                for (int i = 0; i < 32; ++i) xv[i] = nb_[(cb + i) * 128];
#pragma unroll
                for (int i = 0; i < 32; ++i) {
                    const float gg = sg[bh * 64 + cb + i], ml = sml[bh * 64 + cb + i];
                    const float mn = fmaxf(gg + m, ml), so = __expf(gg + m - mn), sn = __expf(ml - mn);
                    if (!dry) nb_[(cb + i) * 128] = n;
                    if (dd == 0) msc_mp[bh * 64 + cb + i] = m;
                    n = so * n + sn * xv[i]; m = mn;
                }
            }
        }
        __syncthreads();
    REP_END
    REP_BEGIN(4)
        for (int pidx = vcu; pidx < 512; pidx += G) {
            AUnit ua, ub;
            { const int u = pidx; ua = AUnit{u >> 8, (u >> 5) & 7, 4, (u >> 3) & 3, u & 7, op0, pl0}; }
            { const int v = pidx; const int bb = v >> 8; ub = AUnit{bb, (v >> 5) & 7, 16, (v >> 1) & 15, (v ^ bb) & 1, op1, pl1}; }
            attn_pair<false>(proj, rcos, rsin, a.q_norm_w, a.attn_norm_w, ua, ub, lds, nullptr, nullptr, tid, dry);
        }
    REP_END
    xcd_barrier(bar);

    REP_BEGIN(5)
        LAS unsigned char* QT = lds; LAS unsigned char* KT = lds + 18432; LAS unsigned char* VT = lds + 36864;
        LAS float* NP = (LAS float*)(lds + 71680); LAS float* XCH = (LAS float*)(lds + 72192); LAS unsigned char* CP = lds + 72704;
        const int j = lane & 15, g = lane >> 4, qp = j >> 2, p = lane & 3;
        const int tf = wave & 3, eh = wave >> 2;
        for (int u = vcu; u < 512; u += G) {
            const int b = u >> 8, h = (u >> 6) & 3, c = u & 63;
            const int tok = b * SEQ + c * 64 + lane;
            const float li = gli[tok * 4 + h], lf = glf[tok * 4 + h];
            const float cf = scan_add64(lf, lane);
            const float bvec = li - cf;
            const float pm = scan_max64(bvec, lane);
            const float mprev = msc_mp[u];
            const float Mv = fmaxf(mprev, pm);
            const float wiv = __expf(mprev - Mv), emtv = __expf(-cf - Mv);
            {
                const bf16* csrc = kvT + (size_t)u * 256 * 128 + (size_t)(tid >> 4) * 128 + (tid & 15) * 8;
                u32x4 cv[8];
#pragma unroll
                for (int it = 0; it < 8; ++it) cv[it] = *(const u32x4*)(csrc + (size_t)it * 32 * 128);
#pragma unroll
                for (int it = 0; it < 8; ++it) *(LAS u32x4*)(CP + (it * 32 + (tid >> 4)) * 288 + (tid & 15) * 16) = cv[it];
            }
            const int t_ = 16 * (wave & 3) + j;
            const bf16* orow_ = proj + (size_t)(b * SEQ + c * 64 + t_) * NPROJ;
            u32x2 mo_pre[8];
#pragma unroll
            for (int ef = 0; ef < 8; ++ef) mo_pre[ef] = *(const u32x2*)(orow_ + PC_MO + h * 256 + 128 * eh + 16 * ef + 4 * g);
            conv_tile<false>(proj, a.conv_w, a.conv_b, b, c, PC_MQ + h * 128, h * 128, 0.08838834764831845f, 0.f, QT, tid);
            conv_tile<false>(proj, a.conv_w, a.conv_b, b, c, PC_MK + h * 128, 512 + h * 128, 1.0f, 0.f, KT, tid);
            v_tile(proj, b, c, h, VT, tid);
            if (tid < 128) NP[tid] = ncb[u * 128 + tid];
            __syncthreads();
            const int t = 16 * tf + j;
            const float M_t = __shfl(Mv, t), wi_t = __shfl(wiv, t), emt_t = __shfl(emtv, t);
            bf16x8 qf[4];
#pragma unroll
            for (int ks = 0; ks < 4; ++ks) qf[ks] = *(const LAS bf16x8*)(QT + t * 288 + (32 * ks + 8 * g) * 2);
            float sp[4][4]; float rowsum = 0.f;
#pragma unroll
            for (int sf = 0; sf < 4; ++sf) {
                f32x4 sa = {0.f, 0.f, 0.f, 0.f};
#pragma unroll
                for (int ks = 0; ks < 4; ++ks) { const bf16x8 kfr = *(const LAS bf16x8*)(KT + (16 * sf + j) * 288 + (32 * ks + 8 * g) * 2); sa = MFMA16(kfr, qf[ks], sa); }
#pragma unroll
                for (int rg = 0; rg < 4; ++rg) { const int sidx = 16 * sf + 4 * g + rg; const float bs = __shfl(bvec, sidx);
                    const float pv = (sidx <= t) ? __expf(bs - M_t) : 0.f; sp[sf][rg] = sa[rg] * pv; rowsum += sp[sf][rg]; }
            }
            bf16x8 pb[2];
#pragma unroll
            for (int kk = 0; kk < 2; ++kk) { float tmp[8] = {sp[2 * kk][0], sp[2 * kk][1], sp[2 * kk][2], sp[2 * kk][3], sp[2 * kk + 1][0], sp[2 * kk + 1][1], sp[2 * kk + 1][2], sp[2 * kk + 1][3]};
                const u32x4 w = pack8(tmp); pb[kk] = __builtin_bit_cast(bf16x8, w); }
            f32x4 ai[8], ae[8];
#pragma unroll
            for (int ef = 0; ef < 8; ++ef) { ai[ef] = (f32x4){0.f, 0.f, 0.f, 0.f}; ae[ef] = (f32x4){0.f, 0.f, 0.f, 0.f}; }
#pragma unroll
            for (int kk = 0; kk < 2; ++kk) {
#pragma unroll
                for (int ef = 0; ef < 8; ++ef) { const int col = 128 * eh + 16 * ef + 4 * p;
                    const bf16x8 af = cat4(vtr(VT + (32 * kk + 4 * g + qp) * 544 + col * 2), vtr(VT + (32 * kk + 16 + 4 * g + qp) * 544 + col * 2));
                    ai[ef] = MFMA16(af, pb[kk], ai[ef]); }
            }
#pragma unroll
            for (int ef = 0; ef < 8; ++ef) {
#pragma unroll
                for (int ks = 0; ks < 4; ++ks) { const bf16x8 cfr = *(const LAS bf16x8*)(CP + (128 * eh + 16 * ef + j) * 288 + (32 * ks + 8 * g) * 2); ae[ef] = MFMA16(cfr, qf[ks], ae[ef]); }
            }
            float qn = 0.f;
#pragma unroll
            for (int ks = 0; ks < 4; ++ks) { float qv[8]; unpack8(__builtin_bit_cast(u32x4, qf[ks]), qv);
#pragma unroll
                for (int e = 0; e < 8; ++e) qn += qv[e] * NP[32 * ks + 8 * g + e]; }
            qn = xg_sum(qn);
            rowsum = xg_sum(rowsum);
            const float den = wi_t * qn + rowsum;
            const float dinv = 1.0f / fmaxf(fabsf(den), emt_t);
            float ssq = 0.f;
#pragma unroll
            for (int ef = 0; ef < 8; ++ef) { ai[ef] = (ae[ef] * wi_t + ai[ef]) * dinv; ssq += (ai[ef][0] * ai[ef][0] + ai[ef][1] * ai[ef][1]) + (ai[ef][2] * ai[ef][2] + ai[ef][3] * ai[ef][3]); }
            ssq = xg_sum(ssq);
            if (g == 0) XCH[eh * 64 + t] = ssq;
            __syncthreads();
            const float rn = 1.0f / sqrtf((XCH[t] + XCH[64 + t]) * (1.0f / 256.0f) + NORM_EPS);
            bf16* orow = proj + (size_t)(b * SEQ + c * 64 + t) * NPROJ;
#pragma unroll
            for (int ef = 0; ef < 8; ++ef) { const int e = 128 * eh + 16 * ef + 4 * g;
                const f32x4 nw = *(const f32x4*)(a.mlstm_norm_w + h * 256 + e);
                const u32x2 mo = mo_pre[ef];
                const float mof[4] = {bf_lo(mo.x), bf_hi(mo.x), bf_lo(mo.y), bf_hi(mo.y)};
                float r4[4];
#pragma unroll
                for (int e2 = 0; e2 < 4; ++e2) r4[e2] = ai[ef][e2] * rn * nw[e2] / (1.0f + __expf(-mof[e2]));
                u32x2 w; w.x = cvtpk(r4[0], r4[1]); w.y = cvtpk(r4[2], r4[3]); if (!dry) *(u32x2*)(orow + PC_MV + h * 256 + e) = w; }
            __syncthreads();
        }
        for (int pidx = vcu; pidx < 256; pidx += G) {
            const AUnit ua{0, (pidx >> 5) & 7, 1, 0, pidx & 31, op0, pl0}, ub{1, (pidx >> 5) & 7, 1, 0, pidx & 31, op0, pl0};
            attn_pair<true>(proj, rcos, rsin, a.q_norm_w, a.attn_norm_w, ua, ub, lds, op1, pl1, tid, dry);
        }
    REP_END
    xcd_barrier(bar);

    REP_BEGIN(6)
        pg8::Gemm g{proj + PC_MV, WoutT, MTOK, DM, DM, NPROJ}; pg8::StaticOrder S; S.init(MTOK, DM, G, bx);
        pg8::EpiRes1 E{a.x, a.out, H1b, sumsq, DM, dry};
        pg8::gemm_phase<pg8::EpiRes1, false>(lds, g, S, E);
    REP_END
    xcd_barrier(bar);

    REP_BEGIN(7)
        pg8::Gemm g{H1b, WguT, MTOK, NGU, DM, DM}; pg8::StaticOrder S; S.init(MTOK, NGU, G, bx);
        pg8::EpiSwiGLU E{FF, DFF, sumsq};
        pg8::gemm_phase<pg8::EpiSwiGLU, true>(lds, g, S, E);
        if (rep_ == 1) {
            const int nfull = (MTOK / 256) * (NGU / 256) - 5 * G;
            const int nidle = G - nfull;
            if (G == 256 ? (bx >= nfull) : true) {
                LAS float* scr = (LAS float*)(lds + wave * 16384);
                constexpr int I_DN = (DFF / 64) * (DM / 32);
                const int w0 = (G == 256) ? (bx - nfull) * NWAVES + wave : gw, nw = (G == 256) ? nidle * NWAVES : NGW;
                for (int it = w0; it < I_DN; it += nw) { const int nblk = DM / 32, kb = it / nblk, nb = it % nblk;
                    const TItem t{a.w_down, WdnT, nullptr, DM, DFF, nb * 32, nb * 32, kb * 64}; f32x4 v[8]; titem_load(t, v, lane); titem_finish(t, v, scr, lane); }
            }
        }
    REP_END
    xcd_barrier(bar);

    REP_BEGIN(8)
        pg8::Gemm g{FF, WdnT, MTOK, DM, DFF, DFF}; pg8::StaticOrder S; S.init(MTOK, DM, G, bx);
        pg8::EpiRes2 E{H1b, a.out, DM, dry};
        pg8::gemm_phase<pg8::EpiRes2, false>(lds, g, S, E);
    REP_END
}

extern "C" void kernel_launch(void* const* d_in, const int* in_sizes, int n_in, void* d_out, int out_size, void* d_ws, size_t ws_size, hipStream_t stream) {
    static int grid = 0;
    if (grid == 0) {
        if (n_in != 16 || in_sizes[0] != MTOK * DM || out_size != MTOK * DM || ws_size < WS_END) { fprintf(stderr, "kernel_launch: unexpected shapes (n_in %d in0 %d out %d ws %zu)\n", n_in, n_in > 0 ? in_sizes[0] : -1, out_size, ws_size); grid = -1; return; }
        int dev = 0, cus = 0;
        if (hipGetDevice(&dev) != hipSuccess || hipDeviceGetAttribute(&cus, hipDeviceAttributeMultiprocessorCount, dev) != hipSuccess || cus <= 0) cus = 256;
        if (hipFuncSetAttribute((const void*)hymba_fwd, hipFuncAttributeMaxDynamicSharedMemorySize, LDS_BYTES) != hipSuccess) { fprintf(stderr, "kernel_launch: hipFuncSetAttribute failed\n"); grid = -1; return; }
        (void)hipGetLastError();
        grid = cus;
    }
    if (grid < 0) return;
    if (hipMemsetAsync((char*)d_ws + WS_CTL, 0, CTL_ZERO_BYTES, stream) != hipSuccess) { fprintf(stderr, "kernel_launch: memset failed\n"); return; }
    Args a{};
    a.x = (const float*)d_in[0]; a.norm1_w = (const float*)d_in[1]; a.w_in = (const float*)d_in[2]; a.conv_w = (const float*)d_in[3]; a.conv_b = (const float*)d_in[4];
    a.igate_b = (const float*)d_in[5]; a.fgate_b = (const float*)d_in[6]; a.q_norm_w = (const float*)d_in[7]; a.k_norm_w = (const float*)d_in[8];
    a.mlstm_norm_w = (const float*)d_in[9]; a.attn_norm_w = (const float*)d_in[10]; a.w_out = (const float*)d_in[11]; a.norm2_w = (const float*)d_in[12];
    a.w_gate = (const float*)d_in[13]; a.w_up = (const float*)d_in[14]; a.w_down = (const float*)d_in[15];
    a.out = (float*)d_out; a.ws = (unsigned char*)d_ws; a.dry = (PROBE_PHASE >= 0) ? 1 : 0;
    hipLaunchKernelGGL(hymba_fwd, dim3(grid), dim3(NWAVES * 64), LDS_BYTES, stream, a);
}
```

```cpp
#include <hip/hip_runtime.h>
#include <cstdio>
#include <cstdint>

#define LAS __attribute__((address_space(3)))
#define GAS __attribute__((address_space(1)))
typedef unsigned short bf16;
typedef short bf16x8 __attribute__((ext_vector_type(8)));
typedef short s16x4 __attribute__((ext_vector_type(4)));
typedef float f32x4 __attribute__((ext_vector_type(4)));
typedef float f32x2 __attribute__((ext_vector_type(2)));
typedef unsigned u32x4 __attribute__((ext_vector_type(4)));
typedef unsigned u32x2 __attribute__((ext_vector_type(2)));
typedef __bf16 bf16x2_t __attribute__((ext_vector_type(2)));

constexpr int BATCH = 2, SEQ = 4096, DM = 2048, MTOK = BATCH * SEQ;
constexpr int INW = 6152, NPROJ = 6144, DFF = 5632, NGU = 2 * DFF;
constexpr int PC_MQ = 0, PC_MK = 512, PC_MO = 1024, PC_MV = 2048, PC_AQ = 3072, PC_AK = 4096, PC_AV = 5120;
constexpr float NORM_EPS = 1e-6f;
constexpr int NWAVES = 8;

constexpr size_t MiB = 1u << 20;
constexpr size_t WS_CTL = 0, CTL_ZERO_BYTES = 32 * 1024;
constexpr size_t WS_GLI = 1 * MiB;
constexpr size_t WS_GLF = WS_GLI + 128 * 1024;
constexpr size_t WS_SUMSQ = WS_GLF + 128 * 1024;
constexpr size_t WS_MSC = WS_SUMSQ + 32 * 1024;
constexpr size_t WS_NC = WS_MSC + 8 * 1024;
constexpr size_t WS_COS = 2 * MiB, WS_SIN = 3 * MiB;
constexpr size_t WS_WIN = 6 * MiB;
constexpr size_t WS_KV = 6 * MiB;
constexpr size_t WS_U = 30 * MiB;
constexpr size_t WS_PROJ = 62 * MiB;
constexpr size_t WS_WOUT = 158 * MiB;
constexpr size_t WS_WGU = 166 * MiB;
constexpr size_t WS_WDN = 210 * MiB;
constexpr size_t WS_OP0 = 38 * MiB;
constexpr size_t WS_OP1 = 232 * MiB;
constexpr size_t WS_PL0 = 248 * MiB, WS_PL1 = WS_PL0 + 256 * 1024;
constexpr size_t WS_END = 249 * MiB;
constexpr int CW_BAR = 4096;

constexpr int RING_BYTES = 131072;
constexpr int MISC_OFF = 147456 - 256;
constexpr int LDS_BYTES = 147456;

__device__ __forceinline__ unsigned cvtpk(float lo, float hi) { f32x2 v = {lo, hi}; bf16x2_t b = __builtin_convertvector(v, bf16x2_t); return __builtin_bit_cast(unsigned, b); }
__device__ __forceinline__ float bf_lo(unsigned w) { return __uint_as_float(w << 16); }
__device__ __forceinline__ float bf_hi(unsigned w) { return __uint_as_float(w & 0xffff0000u); }
__device__ __forceinline__ void unpack8(u32x4 w, float* f) { f[0] = bf_lo(w.x); f[1] = bf_hi(w.x); f[2] = bf_lo(w.y); f[3] = bf_hi(w.y); f[4] = bf_lo(w.z); f[5] = bf_hi(w.z); f[6] = bf_lo(w.w); f[7] = bf_hi(w.w); }
__device__ __forceinline__ u32x4 pack8(const float* f) { u32x4 w; w.x = cvtpk(f[0], f[1]); w.y = cvtpk(f[2], f[3]); w.z = cvtpk(f[4], f[5]); w.w = cvtpk(f[6], f[7]); return w; }
#define DPP_MOV_F(v, ctrl) __uint_as_float((unsigned)__builtin_amdgcn_mov_dpp((int)__float_as_uint(v), (ctrl), 0xf, 0xf, true))
__device__ __forceinline__ float row16_sum(float v) { v += DPP_MOV_F(v, 0xB1); v += DPP_MOV_F(v, 0x4E); v += DPP_MOV_F(v, 0x124); v += DPP_MOV_F(v, 0x128); return v; }
__device__ __forceinline__ float x16_sum(float v) { const auto r = __builtin_amdgcn_permlane16_swap(__float_as_uint(v), __float_as_uint(v), false, false); return __uint_as_float(r[0]) + __uint_as_float(r[1]); }
__device__ __forceinline__ float x32_sum(float v) { const auto r = __builtin_amdgcn_permlane32_swap(__float_as_uint(v), __float_as_uint(v), false, false); return __uint_as_float(r[0]) + __uint_as_float(r[1]); }
__device__ __forceinline__ float x16_max(float v) { const auto r = __builtin_amdgcn_permlane16_swap(__float_as_uint(v), __float_as_uint(v), false, false); return fmaxf(__uint_as_float(r[0]), __uint_as_float(r[1])); }
__device__ __forceinline__ float x32_max(float v) { const auto r = __builtin_amdgcn_permlane32_swap(__float_as_uint(v), __float_as_uint(v), false, false); return fmaxf(__uint_as_float(r[0]), __uint_as_float(r[1])); }
__device__ __forceinline__ float xg_sum(float v) { return x32_sum(x16_sum(v)); }
__device__ __forceinline__ float xg_max(float v) { return x32_max(x16_max(v)); }
__device__ __forceinline__ float wave_sum(float v) { return xg_sum(row16_sum(v)); }
__device__ __forceinline__ float wave_max(float v) {
#pragma unroll
    for (int o = 1; o < 64; o <<= 1) v = fmaxf(v, __shfl_xor(v, o));
    return v;
}
__device__ __forceinline__ s16x4 vtr(const LAS unsigned char* p) { return __builtin_bit_cast(s16x4, __builtin_amdgcn_ds_read_tr16_b64_v4i16((LAS s16x4*)p)); }
__device__ __forceinline__ bf16x8 cat4(s16x4 a, s16x4 b) { return (bf16x8){a[0], a[1], a[2], a[3], b[0], b[1], b[2], b[3]}; }
#define LDS_WAIT() asm volatile("s_waitcnt lgkmcnt(0)" ::: "memory")
#define VM_WAIT() asm volatile("s_waitcnt vmcnt(0)" ::: "memory")
#define SBAR() __builtin_amdgcn_sched_barrier(0)
#define MFMA16(a, b, c) __builtin_amdgcn_mfma_f32_16x16x32_bf16((a), (b), (c), 0, 0, 0)

namespace pg8 {
constexpr int BM = 256, BK = 64, HALF = 128, HTB = HALF * BK * 2, STAGE_BYTES = 8 * HTB, NXCD = 8, WGM = 8;
__host__ __device__ __forceinline__ int lds_byte(int r, int c) { const int st = (r >> 4) * 2 + (c >> 5), rr = r & 15, cc = c & 31, ob = rr * 64 + cc * 2; return st * 1024 + (ob ^ (((ob >> 9) & 1) << 5)); }
__host__ __device__ __forceinline__ void stage_rc(int b, int& R, int& C) { const int st = b / 1024, sb = b % 1024, swz = sb ^ (((sb >> 9) & 1) << 5); R = (st >> 1) * 16 + swz / 64; C = (st & 1) * 32 + (swz % 64) / 2; }
__host__ __device__ __forceinline__ int perm32(int rho) { const int n = rho >> 4, i = rho & 15; return 8 * (i >> 2) + 4 * n + (i & 3); }
struct Unit { int pm, pn; };
struct Gemm { const bf16* A; const bf16* Bt; int M, N, K, lda; };
struct StaticOrder {
    int nM, nN, nwg, G, c;
    __device__ void init(int M, int N, int G_, int c_) { nM = M / BM; nN = N / BM; nwg = nM * nN; G = G_; c = c_; }
    __device__ bool next(int i, Unit& u) const {
        const long L = (long)i * G + c; if (L >= nwg) return false;
        int wgid = (int)L; { const int q = nwg / NXCD, r = nwg % NXCD, xcd = wgid % NXCD, off = wgid / NXCD; wgid = (xcd < r ? xcd * (q + 1) : r * (q + 1) + (xcd - r) * q) + off; }
        const int nig = WGM * nN, gid = wgid / nig, fm = gid * WGM, gsz = (nM - fm) < WGM ? (nM - fm) : WGM;
        u.pm = fm + ((wgid % nig) % gsz); u.pn = (wgid % nig) / gsz; return true;
    }
};
struct EpiBf16 {
    static constexpr bool PERM = true, HAS_INIT = false;
    bf16* O; int ldc;
    __device__ __forceinline__ void operator()(const f32x4 (&acc)[2][2][4][2], const Unit& u, int wr, int wc, int fr, int fq) const {
        const int row0 = u.pm * BM + wr * 64 + fr, col0 = u.pn * BM + wc * 32 + 8 * fq;
#pragma unroll
        for (int ai = 0; ai < 2; ++ai)
#pragma unroll
            for (int m = 0; m < 4; ++m) { bf16* rowp = O + (size_t)(row0 + ai * HALF + m * 16) * ldc + col0;
#pragma unroll
                for (int bj = 0; bj < 2; ++bj) { const f32x4 v0 = acc[ai][bj][m][0], v1 = acc[ai][bj][m][1];
                    u32x4 w; w.x = cvtpk(v0[0], v0[1]); w.y = cvtpk(v0[2], v0[3]); w.z = cvtpk(v1[0], v1[1]); w.w = cvtpk(v1[2], v1[3]);
                    *(u32x4*)(rowp + bj * HALF) = w; } }
    }
};
struct EpiRes1 {
    static constexpr bool PERM = false, HAS_INIT = true;
    const float* xres; float* out; bf16* h1b; float* sumsq; int ldc; bool dry;
    __device__ __forceinline__ void init(f32x4 (&acc)[2][2][4][2], const Unit& u, int wr, int wc, int fr, int fq) const {
        const int col0 = u.pn * BM + wc * 32 + 4 * fq;
#pragma unroll
        for (int ai = 0; ai < 2; ++ai)
#pragma unroll
            for (int m = 0; m < 4; ++m) { const size_t off = (size_t)(u.pm * BM + ai * HALF + wr * 64 + m * 16 + fr) * ldc + col0;
#pragma unroll
                for (int bj = 0; bj < 2; ++bj)
#pragma unroll
                    for (int n = 0; n < 2; ++n) acc[ai][bj][m][n] = __builtin_nontemporal_load((const f32x4*)(xres + off + bj * HALF + n * 16)); }
    }
    __device__ __forceinline__ void operator()(const f32x4 (&acc)[2][2][4][2], const Unit& u, int wr, int wc, int fr, int fq) const {
        const int col0 = u.pn * BM + wc * 32 + 4 * fq;
#pragma unroll
        for (int ai = 0; ai < 2; ++ai)
#pragma unroll
            for (int m = 0; m < 4; ++m) { const int row = u.pm * BM + ai * HALF + wr * 64 + m * 16 + fr; const size_t off = (size_t)row * ldc + col0; float ss = 0.f;
#pragma unroll
                for (int bj = 0; bj < 2; ++bj)
#pragma unroll
                    for (int n = 0; n < 2; ++n) { const size_t o2 = off + bj * HALF + n * 16; const f32x4 h = acc[ai][bj][m][n];
                        u32x2 w; w.x = cvtpk(h[0], h[1]); w.y = cvtpk(h[2], h[3]); if (!dry) { *(u32x2*)(h1b + o2) = w; }
                        ss += (h[0] * h[0] + h[1] * h[1]) + (h[2] * h[2] + h[3] * h[3]); }
                ss = xg_sum(ss);
                if (fq == 0 && !dry) atomicAdd(sumsq + row, ss); }
    }
};
struct EpiSwiGLU {
    static constexpr bool PERM = true, HAS_INIT = false;
    bf16* O; int ldc; const float* sumsq;
    __device__ __forceinline__ void operator()(const f32x4 (&acc)[2][2][4][2], const Unit& u, int wr, int wc, int fr, int fq) const {
        const int col0 = u.pn * HALF + wc * 32 + 8 * fq;
#pragma unroll
        for (int ai = 0; ai < 2; ++ai)
#pragma unroll
            for (int m = 0; m < 4; ++m) { const int row = u.pm * BM + ai * HALF + wr * 64 + m * 16 + fr;
                const float rs = __builtin_amdgcn_rsqf(sumsq[row] * (1.0f / DM) + NORM_EPS);
                float f[8];
#pragma unroll
                for (int n = 0; n < 2; ++n)
#pragma unroll
                    for (int j = 0; j < 4; ++j) { const float g = acc[ai][0][m][n][j] * rs, up = acc[ai][1][m][n][j] * rs; f[n * 4 + j] = g * __builtin_amdgcn_rcpf(1.0f + __expf(-g)) * up; }
                *(u32x4*)(O + (size_t)row * ldc + col0) = pack8(f); }
    }
};
struct EpiRes2 {
    static constexpr bool PERM = false, HAS_INIT = true;
    const bf16* h1b; float* out; int ldc; bool dry;
    __device__ __forceinline__ void init(f32x4 (&acc)[2][2][4][2], const Unit& u, int wr, int wc, int fr, int fq) const {
        const int col0 = u.pn * BM + wc * 32 + 4 * fq;
#pragma unroll
        for (int ai = 0; ai < 2; ++ai)
#pragma unroll
            for (int m = 0; m < 4; ++m) { const size_t off = (size_t)(u.pm * BM + ai * HALF + wr * 64 + m * 16 + fr) * ldc + col0;
#pragma unroll
                for (int bj = 0; bj < 2; ++bj)
#pragma unroll
                    for (int n = 0; n < 2; ++n) { const u32x2 w = __builtin_nontemporal_load((const u32x2*)(h1b + off + bj * HALF + n * 16)); acc[ai][bj][m][n] = (f32x4){bf_lo(w.x), bf_hi(w.x), bf_lo(w.y), bf_hi(w.y)}; } }
    }
    __device__ __forceinline__ void operator()(const f32x4 (&acc)[2][2][4][2], const Unit& u, int wr, int wc, int fr, int fq) const {
        const int col0 = u.pn * BM + wc * 32 + 4 * fq;
#pragma unroll
        for (int ai = 0; ai < 2; ++ai)
#pragma unroll
            for (int m = 0; m < 4; ++m) { const size_t off = (size_t)(u.pm * BM + ai * HALF + wr * 64 + m * 16 + fr) * ldc + col0;
#pragma unroll
                for (int bj = 0; bj < 2; ++bj)
#pragma unroll
                    for (int n = 0; n < 2; ++n) { if (!dry) __builtin_nontemporal_store(acc[ai][bj][m][n], (f32x4*)(out + off + bj * HALF + n * 16)); } }
    }
};

template <class Epi, bool ALIGN_EPI>
__device__ __forceinline__ void gemm_phase(LAS unsigned char* lds, const Gemm g, const StaticOrder& S, const Epi& E) {
    int tid = threadIdx.x; asm volatile("" : "+v"(tid));
    const int wid = __builtin_amdgcn_readfirstlane(tid >> 6), lane = tid & 63, wr = wid >> 2, wc = wid & 3, fr = lane & 15, fq = lane >> 4;
    const int K = g.K, nt = K / BK;
    unsigned voffA[2], voffB[2];
#pragma unroll
    for (int i = 0; i < 2; ++i) { int R, C; stage_rc(tid * 16 + i * 8192, R, C); const int Rb = Epi::PERM ? ((R & ~31) + perm32(R & 31)) : R;
        voffA[i] = (unsigned)(R * g.lda + C) * 2u; voffB[i] = (unsigned)(Rb * K + C) * 2u; }
    const size_t kstep = (size_t)(BK * 2);
    const size_t hstepA = (size_t)HALF * g.lda * 2, hstepB = (size_t)HALF * K * 2;
    const size_t tstepA = 2 * hstepA, tstepB = 2 * hstepB;
    const unsigned ldsw = (unsigned)wid * 1024u;
    const int aoff = lds_byte(wr * 64 + fr, fq * 8), boff = lds_byte(wc * 32 + fr, fq * 8);
#define PG8_SA(b, h) (((b) * 2 + (h)) * HTB)
#define PG8_SB(b, h) ((4 + (b) * 2 + (h)) * HTB)
#define PG8_STAGE(bufoff, gbase, voff) do { _Pragma("unroll") for (int _i = 0; _i < 2; ++_i) \
        __builtin_amdgcn_global_load_lds((const unsigned*)((const char*)(gbase) + (voff)[_i]), (LAS unsigned*)(lds + (bufoff) + ldsw + _i * 8192), 16, 0, 0); } while (0)
#define PG8_LDA(dst, b, h) do { _Pragma("unroll") for (int m = 0; m < 4; ++m) _Pragma("unroll") for (int k = 0; k < 2; ++k) dst[m][k] = *(const LAS bf16x8*)(lds + PG8_SA(b, h) + aoff + m * 2048 + k * 1024); } while (0)
#define PG8_LDB(dst, b, h) do { _Pragma("unroll") for (int n = 0; n < 2; ++n) _Pragma("unroll") for (int k = 0; k < 2; ++k) dst[n][k] = *(const LAS bf16x8*)(lds + PG8_SB(b, h) + boff + n * 2048 + k * 1024); } while (0)
#define PG8_MMA(ai, bj, At, Bt) do { __builtin_amdgcn_s_setprio(1); _Pragma("unroll") for (int m = 0; m < 4; ++m) _Pragma("unroll") for (int n = 0; n < 2; ++n) _Pragma("unroll") for (int k = 0; k < 2; ++k) \
        acc[ai][bj][m][n] = __builtin_amdgcn_mfma_f32_16x16x32_bf16(Bt[n][k], At[m][k], acc[ai][bj][m][n], 0, 0, 0); __builtin_amdgcn_s_setprio(0); } while (0)
#define PG8_WAIT_V(n) asm volatile("s_waitcnt vmcnt(" #n ")" ::: "memory")
#define PG8_WAIT_L(n) asm volatile("s_waitcnt lgkmcnt(" #n ")" ::: "memory")
#define PG8_BAR __builtin_amdgcn_s_barrier()
#define PG8_SCHED __builtin_amdgcn_sched_barrier(0)
    Unit cur, nxt; int ui = 0;
    if (!S.next(0, cur)) return;
    f32x4 acc[2][2][4][2];
    if constexpr (Epi::HAS_INIT) { E.init(acc, cur, wr, wc, fr, fq); }
    else {
#pragma unroll
    for (int a = 0; a < 2; ++a)
#pragma unroll
        for (int b = 0; b < 2; ++b)
#pragma unroll
            for (int m = 0; m < 4; ++m)
#pragma unroll
                for (int n = 0; n < 2; ++n) acc[a][b][m][n] = (f32x4){0.f, 0.f, 0.f, 0.f};
    }
    bf16x8 At[4][2], B0[2][2], B1[2][2];
    const char* cA = (const char*)g.A + (size_t)cur.pm * tstepA; const char* cB = (const char*)g.Bt + (size_t)cur.pn * tstepB;
    PG8_STAGE(PG8_SB(0, 0), cB, voffB); PG8_STAGE(PG8_SB(0, 1), cB + hstepB, voffB); PG8_STAGE(PG8_SA(0, 0), cA, voffA); PG8_STAGE(PG8_SA(0, 1), cA + hstepA, voffA);
    if (wr == 1) PG8_BAR;
    PG8_WAIT_V(2); PG8_BAR;
    PG8_STAGE(PG8_SB(1, 0), cB + kstep, voffB); PG8_STAGE(PG8_SA(1, 0), cA + kstep, voffA); PG8_STAGE(PG8_SB(1, 1), cB + hstepB + kstep, voffB);
    PG8_WAIT_V(6); PG8_BAR;
    for (;;) {
        const bool has_next = S.next(ui + 1, nxt);
        const char* nA = has_next ? (const char*)g.A + (size_t)nxt.pm * tstepA : cA; const char* nB = has_next ? (const char*)g.Bt + (size_t)nxt.pn * tstepB : cB;
        for (int t = 0; t < nt; t += 2) {
            const bool last = (t == nt - 2);
            const char* a1 = cA + (size_t)(t + 1) * kstep;
            const char* a2 = last ? nA : cA + (size_t)(t + 2) * kstep; const char* b2 = last ? nB : cB + (size_t)(t + 2) * kstep;
            const char* a3 = a2 + kstep; const char* b3 = b2 + kstep;
            PG8_LDB(B0, 0, 0); PG8_LDB(B1, 0, 1); PG8_SCHED; PG8_LDA(At, 0, 0); PG8_STAGE(PG8_SA(1, 1), a1 + hstepA, voffA);
            PG8_WAIT_V(8); PG8_WAIT_L(0); PG8_BAR; PG8_MMA(0, 0, At, B0); PG8_MMA(0, 1, At, B1); PG8_BAR; PG8_SCHED;
            PG8_LDA(At, 0, 1); PG8_STAGE(PG8_SB(0, 0), b2, voffB); PG8_STAGE(PG8_SB(0, 1), b2 + hstepB, voffB); PG8_STAGE(PG8_SA(0, 0), a2, voffA);
            PG8_WAIT_V(8); PG8_WAIT_L(0); PG8_BAR; PG8_MMA(1, 0, At, B0); PG8_MMA(1, 1, At, B1); PG8_BAR; PG8_SCHED;
            PG8_LDB(B0, 1, 0); PG8_LDB(B1, 1, 1); PG8_SCHED; PG8_LDA(At, 1, 0); PG8_STAGE(PG8_SA(0, 1), a2 + hstepA, voffA);
            PG8_WAIT_V(8); PG8_WAIT_L(0); PG8_BAR; PG8_MMA(0, 0, At, B0); PG8_MMA(0, 1, At, B1); PG8_BAR; PG8_SCHED;
            PG8_LDA(At, 1, 1); PG8_STAGE(PG8_SB(1, 0), b3, voffB); PG8_STAGE(PG8_SB(1, 1), b3 + hstepB, voffB); PG8_STAGE(PG8_SA(1, 0), a3, voffA);
            PG8_WAIT_V(8); PG8_WAIT_L(0); PG8_BAR; PG8_MMA(1, 0, At, B0); PG8_MMA(1, 1, At, B1); PG8_BAR; PG8_SCHED;
        }
        if constexpr (ALIGN_EPI) { if (wr == 0) PG8_BAR; }
        E(acc, cur, wr, wc, fr, fq);
        if (!has_next) break;
        if constexpr (Epi::HAS_INIT) { E.init(acc, nxt, wr, wc, fr, fq); }
        else {
#pragma unroll
        for (int a = 0; a < 2; ++a)
#pragma unroll
            for (int b = 0; b < 2; ++b)
#pragma unroll
                for (int m = 0; m < 4; ++m)
#pragma unroll
                    for (int n = 0; n < 2; ++n) acc[a][b][m][n] = (f32x4){0.f, 0.f, 0.f, 0.f};
        }
        cur = nxt; cA = nA; cB = nB; ++ui;
        if constexpr (ALIGN_EPI) { if (wr == 1) PG8_BAR; }
    }
    PG8_WAIT_V(0);
    if constexpr (!ALIGN_EPI) { if (wr == 0) PG8_BAR; }
    PG8_BAR;
#undef PG8_SA
#undef PG8_SB
#undef PG8_STAGE
#undef PG8_LDA
#undef PG8_LDB
#undef PG8_MMA
#undef PG8_WAIT_V
#undef PG8_WAIT_L
#undef PG8_BAR
#undef PG8_SCHED
}
}

#define XB_TMO      128
#define XB_XCNT(j)  (256  + 64 * (j))
#define XB_XSUB(j)  (1280 + 64 * (j))
#define XB_XGEN(j)  (2304 + 64 * (j))
#define XB_TOP      3328
#define XB_TOPGEN   3392
#define XCD_BAR_WORDS 3456
#define XB_SPIN_CAP (1u << 18)
__device__ __forceinline__ unsigned xb_ld(unsigned* p)              { return __hip_atomic_load(p, __ATOMIC_RELAXED, __HIP_MEMORY_SCOPE_AGENT); }
__device__ __forceinline__ unsigned xb_add(unsigned* p, unsigned v) { return __hip_atomic_fetch_add(p, v, __ATOMIC_RELAXED, __HIP_MEMORY_SCOPE_AGENT); }
__device__ __forceinline__ unsigned xb_xcc_id() { return (unsigned)__builtin_amdgcn_s_getreg((3 << 11) | 20) & 0xFu; }
#define XB_SPIN(cond, bar) do { unsigned _sp = 0; while (cond) { __builtin_amdgcn_s_sleep(1); \
    if ((++_sp & 255u) == 0u) { if (xb_ld(&(bar)[XB_TMO])) break; if (_sp > XB_SPIN_CAP) { atomicAdd(&(bar)[XB_TMO], 1u); break; } } } } while (0)
struct XcdBarrier { unsigned* bar; unsigned x; volatile LAS unsigned* st; };
__device__ __forceinline__ XcdBarrier xcd_barrier_post(unsigned* bar, volatile LAS unsigned* st) {
    XcdBarrier b; b.bar = bar; b.x = xb_xcc_id(); b.st = st;
    if (threadIdx.x == 0) (void)xb_add(&bar[XB_XCNT(b.x)], 1u);
    return b;
}
__device__ __forceinline__ void xcd_barrier_complete(unsigned* bar, unsigned x, unsigned& nloc, unsigned& nx) {
    const unsigned G = gridDim.x * gridDim.y * gridDim.z;
    unsigned sum, cnt, mine, sp = 0u;
    for (;;) {
        sum = 0u; cnt = 0u; mine = 0u;
#pragma unroll
        for (unsigned j = 0; j < 16; ++j) { const unsigned c = xb_ld(&bar[XB_XCNT(j)]); sum += c; cnt += (c > 0u) ? 1u : 0u; mine = (j == x) ? c : mine; }
        if (sum == G) break;
        __builtin_amdgcn_s_sleep(1);
        if ((++sp & 255u) == 0u) { if (xb_ld(&bar[XB_TMO])) break; if (sp > XB_SPIN_CAP) { atomicAdd(&bar[XB_TMO], 1u); break; } }
    }
    nloc = mine > 0u ? mine : 1u; nx = cnt > 0u ? cnt : 1u;
}
__device__ __forceinline__ void xcd_barrier(const XcdBarrier& b) {
    asm volatile("s_waitcnt vmcnt(0)" ::: "memory");
    __syncthreads();
    if (threadIdx.x == 0) {
        unsigned* bar = b.bar;
        __builtin_amdgcn_s_waitcnt(0);
        unsigned nloc = b.st[0], nx = b.st[1];
        if (nloc == 0u) { xcd_barrier_complete(bar, b.x, nloc, nx); b.st[0] = nloc; b.st[1] = nx; }
        const unsigned old = xb_add(&bar[XB_XSUB(b.x)], 1u);
        const unsigned gen = old / nloc;
        if (old + 1u == (gen + 1u) * nloc) {
            __builtin_amdgcn_fence(__ATOMIC_RELEASE, "agent");
            asm volatile("s_waitcnt vmcnt(0)" ::: "memory");
            const unsigned og = xb_add(&bar[XB_TOP], 1u);
            const unsigned tg = og / nx;
            if (og + 1u == (tg + 1u) * nx) xb_add(&bar[XB_TOPGEN], 1u);
            else XB_SPIN(xb_ld(&bar[XB_TOPGEN]) == tg, bar);
            __builtin_amdgcn_fence(__ATOMIC_ACQUIRE, "agent");
            xb_add(&bar[XB_XGEN(b.x)], 1u);
            asm volatile("s_waitcnt vmcnt(0)" ::: "memory");
        } else {
            XB_SPIN(xb_ld(&bar[XB_XGEN(b.x)]) == gen, bar);
            __builtin_amdgcn_fence(__ATOMIC_ACQUIRE, "agent");
            asm volatile("s_waitcnt vmcnt(0)" ::: "memory");
        }
    }
    __syncthreads();
}

struct Args {
    const float* x; const float* norm1_w; const float* w_in; const float* conv_w; const float* conv_b; const float* igate_b; const float* fgate_b;
    const float* q_norm_w; const float* k_norm_w; const float* mlstm_norm_w; const float* attn_norm_w; const float* w_out; const float* norm2_w;
    const float* w_gate; const float* w_up; const float* w_down;
    float* out; unsigned char* ws; int dry; int pad;
};

struct TItem { const float* W; bf16* WT; const float* kscale; int ldw, K, nsrc0, ndst0, k0; };
__device__ __forceinline__ void titem_load(const TItem& t, f32x4 (&v)[8], int lane) {
    const float* src = t.W + (size_t)(t.k0 + (lane >> 3)) * t.ldw + t.nsrc0 + (lane & 7) * 4;
#pragma unroll
    for (int i = 0; i < 8; ++i) v[i] = __builtin_nontemporal_load((const f32x4*)(src + (size_t)(8 * i) * t.ldw));
}
__device__ __forceinline__ void titem_finish(const TItem& t, const f32x4 (&v)[8], LAS float* scr, int lane) {
#pragma unroll
    for (int i = 0; i < 8; ++i) { const int kk = 8 * i + (lane >> 3); const float sc = t.kscale ? t.kscale[t.k0 + kk] : 1.0f; LAS float* d = scr + kk * 33 + (lane & 7) * 4;
        d[0] = v[i][0] * sc; d[1] = v[i][1] * sc; d[2] = v[i][2] * sc; d[3] = v[i][3] * sc; }
    LDS_WAIT(); asm volatile("" ::: "memory");
    const int c = lane & 7;
#pragma unroll
    for (int j = 0; j < 4; ++j) { const int n = (lane >> 3) + 8 * j; const LAS float* s = scr + (8 * c) * 33 + n;
        u32x4 o; o.x = cvtpk(s[0 * 33], s[1 * 33]); o.y = cvtpk(s[2 * 33], s[3 * 33]); o.z = cvtpk(s[4 * 33], s[5 * 33]); o.w = cvtpk(s[6 * 33], s[7 * 33]);
        *(u32x4*)(t.WT + (size_t)(t.ndst0 + n) * t.K + t.k0 + 8 * c) = o; }
    LDS_WAIT(); asm volatile("" ::: "memory");
}
__device__ __forceinline__ int win_src_col(int nd) {
    if (nd < 1024) return nd;
    if (nd < 2048) return nd + 1024;
    if (nd < 3072) return nd - 1024;
    return nd + 8;
}


__device__ __forceinline__ float scan_add64(float v, int lane) {
#pragma unroll
    for (int o = 1; o < 64; o <<= 1) { const float t = __shfl_up(v, o); if (lane >= o) v += t; }
    return v;
}
__device__ __forceinline__ float scan_max64(float v, int lane) {
#pragma unroll
    for (int o = 1; o < 64; o <<= 1) { const float t = __shfl_up(v, o); if (lane >= o) v = fmaxf(v, t); }
    return v;
}
template <bool ROWW>
__device__ __forceinline__ void conv_tile(const bf16* proj, const float* conv_w, const float* conv_b, int b, int c, int col0, int ch0, float rscale, float wlane, LAS unsigned char* tile, int tid) {
    const int rr = tid >> 4, cc = (tid & 15) * 8;
    float w[4][8], bb[8];
#pragma unroll
    for (int j = 0; j < 4; ++j) { const f32x4 w0 = *(const f32x4*)(conv_w + j * 1024 + ch0 + cc), w1 = *(const f32x4*)(conv_w + j * 1024 + ch0 + cc + 4);
        w[j][0] = w0[0]; w[j][1] = w0[1]; w[j][2] = w0[2]; w[j][3] = w0[3]; w[j][4] = w1[0]; w[j][5] = w1[1]; w[j][6] = w1[2]; w[j][7] = w1[3]; }
    { const f32x4 b0 = *(const f32x4*)(conv_b + ch0 + cc), b1 = *(const f32x4*)(conv_b + ch0 + cc + 4);
      bb[0] = b0[0]; bb[1] = b0[1]; bb[2] = b0[2]; bb[3] = b0[3]; bb[4] = b1[0]; bb[5] = b1[1]; bb[6] = b1[2]; bb[7] = b1[3]; }
#pragma unroll
    for (int half = 0; half < 2; ++half) {
        const int l = rr + 32 * half, t = c * 64 + l;
        float y[8];
#pragma unroll
        for (int e = 0; e < 8; ++e) y[e] = bb[e];
#pragma unroll
        for (int j = 0; j < 4; ++j) { const int tt = t - 3 + j;
            if (tt >= 0) { const u32x4 raw = *(const u32x4*)(proj + (size_t)(b * SEQ + tt) * NPROJ + col0 + cc); float x[8]; unpack8(raw, x);
#pragma unroll
                for (int e = 0; e < 8; ++e) y[e] += w[j][e] * x[e]; } }
        float sc = rscale;
        if (ROWW) sc *= __shfl(wlane, l);
#pragma unroll
        for (int e = 0; e < 8; ++e) y[e] = y[e] * __builtin_amdgcn_rcpf(1.0f + __expf(-y[e])) * sc;
        *(LAS u32x4*)(tile + l * 288 + cc * 2) = pack8(y);
    }
}
__device__ __forceinline__ void v_tile(const bf16* proj, int b, int c, int h, LAS unsigned char* tile, int tid) {
#pragma unroll
    for (int p = 0; p < 4; ++p) { const int row = p * 16 + (tid >> 5), ch = tid & 31;
        const u32x4 v = *(const u32x4*)(proj + (size_t)(b * SEQ + c * 64 + row) * NPROJ + PC_MV + h * 256 + ch * 8);
        *(LAS u32x4*)(tile + row * 544 + ch * 16) = v; }
}

__device__ __forceinline__ void q_prep(const bf16* qrow, const float* rcos, const float* rsin, const float* qnw, int tq, int g, bf16x8 (&qf)[4]) {
    float q[4][8]; float ss = 0.f;
#pragma unroll
    for (int ks = 0; ks < 4; ++ks) { const u32x4 raw = *(const u32x4*)(qrow + 32 * ks + 8 * g); unpack8(raw, q[ks]);
#pragma unroll
        for (int e = 0; e < 8; ++e) ss += q[ks][e] * q[ks][e]; }
    ss = xg_sum(ss);
    const float rq = __builtin_amdgcn_rsqf(ss * (1.0f / 128.0f) + NORM_EPS);
#pragma unroll
    for (int ks = 0; ks < 2; ++ks) {
        const int c0 = 32 * ks + 8 * g;
#pragma unroll
        for (int e4 = 0; e4 < 2; ++e4) {
            const f32x4 cs = *(const f32x4*)(rcos + tq * 64 + c0 + 4 * e4), sn = *(const f32x4*)(rsin + tq * 64 + c0 + 4 * e4);
            const f32x4 w1 = *(const f32x4*)(qnw + c0 + 4 * e4), w2 = *(const f32x4*)(qnw + 64 + c0 + 4 * e4);
#pragma unroll
            for (int e = 0; e < 4; ++e) { const float y1 = q[ks][4 * e4 + e] * rq * w1[e], y2 = q[ks + 2][4 * e4 + e] * rq * w2[e];
                q[ks][4 * e4 + e] = y1 * cs[e] - y2 * sn[e]; q[ks + 2][4 * e4 + e] = y2 * cs[e] + y1 * sn[e]; }
        }
    }
#pragma unroll
    for (int ks = 0; ks < 4; ++ks) { const u32x4 w = pack8(q[ks]); qf[ks] = __builtin_bit_cast(bf16x8, w); }
}
struct AUnit { int b, h, d, r, n; bf16* po0; float* pl0; };
template <bool FINAL>
__device__ __forceinline__ void attn_pair(bf16* proj, const float* rcos, const float* rsin, const float* qnw, const float* anw, const AUnit& ua, const AUnit& ub,
                                          LAS unsigned char* lds_all, bf16* po1, float* pl1, int tid_in, bool dry) {
    int tid = tid_in; asm volatile("" : "+v"(tid));
    const int lane = tid & 63, wave = __builtin_amdgcn_readfirstlane(tid >> 6);
    const int team = wave >> 2, w4 = wave & 3;
    const int b = team ? ub.b : ua.b, h = team ? ub.h : ua.h, d = team ? ub.d : ua.d, r = team ? ub.r : ua.r, n = team ? ub.n : ua.n;
    bf16* po0 = team ? ub.po0 : ua.po0; float* pl0 = team ? ub.pl0 : ua.pl0;
    LAS unsigned char* lds = lds_all + team * 36864;
    const int j = lane & 15, g = lane >> 4, qp = j >> 2, p = lane & 3;
    const int tt = tid & 255, srow = tt >> 4, sch = tt & 15;
    const bf16* kcol = proj + (size_t)b * SEQ * NPROJ + PC_AK + h * 128 + sch * 8;
    const bf16* vcol = kcol + (PC_AV - PC_AK);
    const int kt0 = (n == 0) ? 4 : 0;
    const int sub0 = 128 * (n - 1) + srow;
    u32x4 rk[2][2], rv[2][2];
#define AT_ISSUE(set, t) do { if ((t) < 8) { _Pragma("unroll") for (int hh_ = 0; hh_ < 2; ++hh_) { const size_t tok_ = (size_t)((sub0 + 32 * (t) + 16 * hh_) * d + r); \
        rk[set][hh_] = *(const u32x4*)(kcol + tok_ * NPROJ); rv[set][hh_] = *(const u32x4*)(vcol + tok_ * NPROJ); } } } while (0)
#define AT_WRITE(set, t) do { LAS unsigned char* Kn_ = lds + ((t) & 1) * 18432; _Pragma("unroll") for (int hh_ = 0; hh_ < 2; ++hh_) { \
        *(LAS u32x4*)(Kn_ + (srow + 16 * hh_) * 288 + sch * 16) = rk[set][hh_]; *(LAS u32x4*)(Kn_ + 9216 + (srow + 16 * hh_) * 288 + sch * 16) = rv[set][hh_]; } } while (0)
#define WG_BAR() do { asm volatile("s_waitcnt lgkmcnt(0)" ::: "memory"); __builtin_amdgcn_s_barrier(); asm volatile("" ::: "memory"); } while (0)
    AT_ISSUE(0, kt0); AT_ISSUE(1, kt0 + 1);
    bf16x8 qf[2][4]; int qi[2]; int tq[2];
    const int G0 = w4, G1 = 7 - w4;
    qi[0] = 16 * G0 + j; qi[1] = 16 * G1 + j; tq[0] = (128 * n + qi[0]) * d + r; tq[1] = (128 * n + qi[1]) * d + r;
    const int lo0 = G0 >> 1, lo1 = G1 >> 1;
#pragma unroll
    for (int gi = 0; gi < 2; ++gi) { const bf16* qrow = proj + (size_t)(b * SEQ + tq[gi]) * NPROJ + PC_AQ + h * 128 + 8 * g;
#pragma unroll
        for (int ks = 0; ks < 4; ++ks) qf[gi][ks] = *(const bf16x8*)(qrow + 32 * ks); }
    AT_WRITE(0, kt0);
    for (int kb_ = 0; kb_ < kt0; ++kb_) WG_BAR();
    WG_BAR();
    float m_run[2] = {-1e30f, -1e30f}, l_run[2] = {0.f, 0.f};
    f32x4 o[2][8];
    if (FINAL) {
#pragma unroll
        for (int gi = 0; gi < 2; ++gi) { const size_t trow = (size_t)(b * SEQ + tq[gi]);
            const float l0 = pl0[trow * 8 + h], l1 = pl1[trow * 8 + h]; const float m0 = fmaxf(l0, l1);
            const float a0 = __builtin_amdgcn_exp2f(l0 - m0), a1 = __builtin_amdgcn_exp2f(l1 - m0);
            m_run[gi] = m0; l_run[gi] = (g == 0) ? a0 + a1 : 0.f;
            const bf16* p0 = po0 + trow * 1024 + h * 128 + g * 32; const bf16* p1 = po1 + trow * 1024 + h * 128 + g * 32;
#pragma unroll
            for (int np = 0; np < 4; ++np) { const u32x4 x0 = *(const u32x4*)(p0 + 8 * np), x1 = *(const u32x4*)(p1 + 8 * np); float f0[8], f1[8]; unpack8(x0, f0); unpack8(x1, f1);
#pragma unroll
                for (int e = 0; e < 4; ++e) { o[gi][2 * np][e] = a0 * f0[e] + a1 * f1[e]; o[gi][2 * np + 1][e] = a0 * f0[4 + e] + a1 * f1[4 + e]; } }
        }
    } else {
#pragma unroll
        for (int gi = 0; gi < 2; ++gi)
#pragma unroll
            for (int nf = 0; nf < 8; ++nf) o[gi][nf] = (f32x4){0.f, 0.f, 0.f, 0.f};
    }
    const float SC = 0.08838834764831845f * 1.4426950408889634f;
    const float NEG = -__builtin_inff();
#define AT_SM(gi, kt, s0, s1) do { \
                float x[8]; float tmax = NEG; \
                _Pragma("unroll") for (int e = 0; e < 8; ++e) { const int kj = 32 * (kt) + 16 * (e >> 2) + 4 * g + (e & 3); const float sv = (e < 4) ? s0[e & 3] : s1[e & 3]; \
                    const bool valid = (kj >= qi[gi]) && (kj <= qi[gi] + 128); \
                    x[e] = valid ? sv * SC : NEG; tmax = fmaxf(tmax, x[e]); } \
                tmax = xg_max(tmax); \
                const float m_new = fmaxf(m_run[gi], tmax); \
                const float alpha = __builtin_amdgcn_exp2f(m_run[gi] - m_new); \
                float ps = 0.f; \
                _Pragma("unroll") for (int e = 0; e < 8; ++e) { x[e] = __builtin_amdgcn_exp2f(x[e] - m_new); ps += x[e]; } \
                l_run[gi] = l_run[gi] * alpha + ps; m_run[gi] = m_new; \
                _Pragma("unroll") for (int nf = 0; nf < 8; ++nf) o[gi][nf] = o[gi][nf] * alpha; \
                const u32x4 pw = pack8(x); pb[gi] = __builtin_bit_cast(bf16x8, pw); } while (0)
#define AT_ONE(gi, kt) do { \
            f32x4 sA = {0.f, 0.f, 0.f, 0.f}, sB = {0.f, 0.f, 0.f, 0.f}; \
            _Pragma("unroll") for (int ks = 0; ks < 4; ++ks) { \
                const bf16x8 k0 = *(const LAS bf16x8*)(Kt + j * 288 + (32 * ks + 8 * g) * 2), k1 = *(const LAS bf16x8*)(Kt + (16 + j) * 288 + (32 * ks + 8 * g) * 2); \
                sA = MFMA16(k0, qf[gi][ks], sA); sB = MFMA16(k1, qf[gi][ks], sB); } \
            bf16x8 pb[2]; AT_SM(gi, kt, sA, sB); \
            _Pragma("unroll") for (int nf = 0; nf < 8; ++nf) { \
                const s16x4 a0 = vtr(Vt + (4 * g + qp) * 288 + (16 * nf + 4 * p) * 2), a1 = vtr(Vt + (16 + 4 * g + qp) * 288 + (16 * nf + 4 * p) * 2); \
                o[gi][nf] = MFMA16(cat4(a0, a1), pb[gi], o[gi][nf]); } } while (0)
#define AT_STEP(kt, setn, setw) do { \
        LAS unsigned char* Kt = lds + ((kt) & 1) * 18432; LAS unsigned char* Vt = Kt + 9216; \
        AT_ISSUE(setn, (kt) + 2); \
        const bool act0 = (kt) >= lo0 && (kt) <= lo0 + 4, act1 = (kt) >= lo1 && (kt) <= lo1 + 4; \
        if (act0 && act1) { \
            f32x4 sA[2], sB[2]; sA[0] = (f32x4){0.f, 0.f, 0.f, 0.f}; sA[1] = sA[0]; sB[0] = sA[0]; sB[1] = sA[0]; \
            _Pragma("unroll") for (int ks = 0; ks < 4; ++ks) { \
                const bf16x8 k0 = *(const LAS bf16x8*)(Kt + j * 288 + (32 * ks + 8 * g) * 2), k1 = *(const LAS bf16x8*)(Kt + (16 + j) * 288 + (32 * ks + 8 * g) * 2); \
                sA[0] = MFMA16(k0, qf[0][ks], sA[0]); sB[0] = MFMA16(k1, qf[0][ks], sB[0]); sA[1] = MFMA16(k0, qf[1][ks], sA[1]); sB[1] = MFMA16(k1, qf[1][ks], sB[1]); } \
            bf16x8 pb[2]; \
            AT_SM(0, kt, sA[0], sB[0]); AT_SM(1, kt, sA[1], sB[1]); \
            _Pragma("unroll") for (int nf = 0; nf < 8; ++nf) { \
                const s16x4 a0 = vtr(Vt + (4 * g + qp) * 288 + (16 * nf + 4 * p) * 2), a1 = vtr(Vt + (16 + 4 * g + qp) * 288 + (16 * nf + 4 * p) * 2); \
                const bf16x8 vf = cat4(a0, a1); \
                o[0][nf] = MFMA16(vf, pb[0], o[0][nf]); o[1][nf] = MFMA16(vf, pb[1], o[1][nf]); } \
        } else if (act0) { AT_ONE(0, kt); } else if (act1) { AT_ONE(1, kt); } \
        if ((kt) + 1 < 8) AT_WRITE(setw, (kt) + 1); \
        WG_BAR(); } while (0)
#pragma unroll 1
    for (int kt = kt0; kt < 8; kt += 2) { AT_STEP(kt, 0, 1); AT_STEP(kt + 1, 1, 0); }
#undef AT_STEP
#undef AT_ONE
#undef AT_SM
#undef AT_ISSUE
#undef AT_WRITE
#pragma unroll
    for (int gi = 0; gi < 2; ++gi) {
        float lr = l_run[gi]; lr = xg_sum(lr);
        const float inv = __builtin_amdgcn_rcpf(lr);
        const float lse2 = m_run[gi] + __log2f(lr);
        const size_t trow = (size_t)(b * SEQ + tq[gi]);
        if (!FINAL) {
            bf16* pp = po0 + trow * 1024 + h * 128 + g * 32;
#pragma unroll
            for (int np = 0; np < 4; ++np) { const f32x4 va = o[gi][2 * np] * inv, vb = o[gi][2 * np + 1] * inv; u32x4 ww; ww.x = cvtpk(va[0], va[1]); ww.y = cvtpk(va[2], va[3]); ww.z = cvtpk(vb[0], vb[1]); ww.w = cvtpk(vb[2], vb[3]);
                if (!dry) *(u32x4*)(pp + 8 * np) = ww; }
            if (g == 0 && !dry) pl0[trow * 8 + h] = lse2;
        } else {
            bf16* qrow = proj + trow * NPROJ + PC_AQ + h * 128;
            float ss = 0.f;
#pragma unroll
            for (int nf = 0; nf < 8; ++nf) { const f32x4 v = o[gi][nf] * inv; o[gi][nf] = v; ss += (v[0] * v[0] + v[1] * v[1]) + (v[2] * v[2] + v[3] * v[3]); }
            ss = xg_sum(ss);
            const float rn = __builtin_amdgcn_rsqf(ss * (1.0f / 128.0f) + NORM_EPS);
#pragma unroll
            for (int nf = 0; nf < 8; ++nf) { const int e = 16 * nf + 4 * g; const f32x4 w = *(const f32x4*)(anw + h * 128 + e); const f32x4 v = o[gi][nf] * rn * w;
                u32x2 ww; ww.x = cvtpk(v[0], v[1]); ww.y = cvtpk(v[2], v[3]); if (!dry) *(u32x2*)(qrow + e) = ww; }
        }
    }
}

#ifndef PROBE_PHASE
#define PROBE_PHASE -1
#endif
#define REP_BEGIN(k) for (int rep_ = (PROBE_PHASE == (k)) ? 0 : 1; rep_ < 2; ++rep_) { const bool dry = (rep_ == 0) && (a.dry != 0); (void)dry; \
    int tid = threadIdx.x; asm volatile("" : "+v"(tid)); const int lane = tid & 63, wave = __builtin_amdgcn_readfirstlane(tid >> 6); \
    const int gw = vcu * NWAVES + wave, gt = vcu * (NWAVES * 64) + tid; (void)lane; (void)wave; (void)gw; (void)gt;
#define REP_END }

__global__ void __launch_bounds__(NWAVES * 64, 2) hymba_fwd(Args a) {
    extern __shared__ __attribute__((aligned(16))) unsigned char lds_raw[];
    LAS unsigned char* lds = (LAS unsigned char*)lds_raw;
    volatile LAS unsigned* MISC = (volatile LAS unsigned*)(lds + MISC_OFF);
    const int tid = threadIdx.x, lane = tid & 63, wave = __builtin_amdgcn_readfirstlane(tid >> 6);
    const int G = gridDim.x; const int bx = blockIdx.x; const int vcu = (G % 8 == 0) ? (bx % 8) * (G / 8) + bx / 8 : bx;
    unsigned char* ws = a.ws;
    unsigned* ctl = (unsigned*)(ws + WS_CTL);
    float* gli = (float*)(ws + WS_GLI); float* glf = (float*)(ws + WS_GLF); float* sumsq = (float*)(ws + WS_SUMSQ);
    float* msc_g = (float*)(ws + WS_MSC); float* msc_ml = msc_g + 512; float* msc_mp = msc_g + 1024;
    float* ncb = (float*)(ws + WS_NC);
    float* rcos = (float*)(ws + WS_COS); float* rsin = (float*)(ws + WS_SIN);
    bf16* WinT = (bf16*)(ws + WS_WIN); bf16* kvT = (bf16*)(ws + WS_KV); bf16* Ub = (bf16*)(ws + WS_U); bf16* H1b = (bf16*)(ws + WS_U);
    bf16* proj = (bf16*)(ws + WS_PROJ); bf16* FF = (bf16*)(ws + WS_PROJ);
    bf16* op0 = (bf16*)(ws + WS_OP0); bf16* op1 = (bf16*)(ws + WS_OP1); float* pl0 = (float*)(ws + WS_PL0); float* pl1 = (float*)(ws + WS_PL1);
    bf16* WoutT = (bf16*)(ws + WS_WOUT); bf16* WguT = (bf16*)(ws + WS_WGU); bf16* WdnT = (bf16*)(ws + WS_WDN);

    for (int u = tid; u < (LDS_BYTES - MISC_OFF) / 4; u += NWAVES * 64) ((LAS unsigned*)(lds + MISC_OFF))[u] = 0u;
    __syncthreads();
    XcdBarrier bar = xcd_barrier_post(ctl + CW_BAR, MISC + 8);
    const int NGW = G * NWAVES, NGT = G * NWAVES * 64;

    REP_BEGIN(0)
        for (int i = gt; i < MTOK; i += NGT) sumsq[i] = 0.f;
        for (int i = gt; i < SEQ * 64; i += NGT) {
            const int pos = i >> 6, fi = i & 63;
            const float invf = (float)exp2(-(double)fi * (13.287712379549449 / 64.0));
            const float ang = (float)pos * invf;
            const double rev = (double)ang * 0.15915494309189535; const double fr_ = rev - rint(rev);
            const float ar = (float)(fr_ * 6.283185307179586);
            rcos[i] = cosf(ar); rsin[i] = sinf(ar);
        }
        {
            LAS float* scr = (LAS float*)(lds + wave * 16384);
            constexpr int I_IN = (DM / 64) * (NPROJ / 32), I_OUT = (DM / 64) * (DM / 32), I_GU = (DM / 64) * (NGU / 32), I_DN = (DFF / 64) * (DM / 32);
            constexpr int NITEMS = I_IN + I_OUT + I_GU;
            auto decode = [&](int it) -> TItem {
                TItem t; int r = it;
                if (r < I_IN) { const int nblk = NPROJ / 32, kb = r / nblk, nb = r % nblk; t = TItem{a.w_in, WinT, nullptr, INW, DM, win_src_col(nb * 32), nb * 32, kb * 64}; return t; } r -= I_IN;
                if (r < I_OUT) { const int nblk = DM / 32, kb = r / nblk, nb = r % nblk; t = TItem{a.w_out, WoutT, nullptr, DM, DM, nb * 32, nb * 32, kb * 64}; return t; } r -= I_OUT;
                { const int nblk = NGU / 32, kb = r / nblk, nb = r % nblk; const int nd = nb * 32, pn = nd >> 8, j = nd & 255;
                    t = TItem{(j < 128) ? a.w_gate : a.w_up, WguT, a.norm2_w, DFF, DM, pn * 128 + (j & 127), nd, kb * 64}; return t; }
            };
            int it = gw;
            if (it < NITEMS) {
                TItem cur = decode(it); f32x4 vc[8]; titem_load(cur, vc, lane);
                for (;;) {
                    const int nx = it + NGW; const bool more = nx < NITEMS;
                    TItem nt = cur; f32x4 vn[8];
                    if (more) { nt = decode(nx); titem_load(nt, vn, lane); }
                    titem_finish(cur, vc, scr, lane);
                    if (!more) break;
                    cur = nt; it = nx;
#pragma unroll
                    for (int i = 0; i < 8; ++i) vc[i] = vn[i];
                }
            }
        }
        __syncthreads();
        LAS float* wg = (LAS float*)lds;
        for (int k = tid; k < DM; k += NWAVES * 64) { const f32x4 g0 = *(const f32x4*)(a.w_in + (size_t)k * INW + 3072), g1 = *(const f32x4*)(a.w_in + (size_t)k * INW + 3076);
            wg[0 * DM + k] = g0[0]; wg[1 * DM + k] = g0[1]; wg[2 * DM + k] = g0[2]; wg[3 * DM + k] = g0[3];
            wg[4 * DM + k] = g1[0]; wg[5 * DM + k] = g1[1]; wg[6 * DM + k] = g1[2]; wg[7 * DM + k] = g1[3]; }
        __syncthreads();
        for (int m = gw; m < MTOK; m += NGW) {
            const f32x4* xr = (const f32x4*)(a.x + (size_t)m * DM) + lane; const f32x4* wr_ = (const f32x4*)a.norm1_w + lane;
            f32x4 v[8]; float s = 0.f;
#pragma unroll
            for (int j = 0; j < 8; ++j) { v[j] = __builtin_nontemporal_load(xr + 64 * j); s += (v[j][0] * v[j][0] + v[j][1] * v[j][1]) + (v[j][2] * v[j][2] + v[j][3] * v[j][3]); }
            const float rstd = __builtin_amdgcn_rsqf(wave_sum(s) * (1.0f / DM) + NORM_EPS);
            u32x2* o8 = (u32x2*)(Ub + (size_t)m * DM) + lane;
#pragma unroll
            for (int j = 0; j < 8; ++j) { v[j] = v[j] * rstd * wr_[64 * j]; u32x2 w; w.x = cvtpk(v[j][0], v[j][1]); w.y = cvtpk(v[j][2], v[j][3]); o8[64 * j] = w; }
            float z = 0.f;
#pragma unroll 1
            for (int gi = 0; gi < 8; ++gi) { float t = 0.f;
#pragma unroll
                for (int j = 0; j < 8; ++j) { const f32x4 w4 = *(const LAS f32x4*)(wg + gi * DM + 256 * j + 4 * lane); t += (v[j][0] * w4[0] + v[j][1] * w4[1]) + (v[j][2] * w4[2] + v[j][3] * w4[3]); }
                t = wave_sum(t); z = (lane == gi) ? t : z; }
            if (lane < 8) {
                const int hh = lane & 3;
                if (lane < 4) { gli[m * 4 + hh] = 15.0f * tanhf((z + a.igate_b[hh]) * (1.0f / 15.0f)); }
                else { const float fp = 15.0f * tanhf((z + a.fgate_b[hh]) * (1.0f / 15.0f)); glf[m * 4 + hh] = -log1pf(expf(-fp)); }
            }
        }
    REP_END
    xcd_barrier(bar);

    REP_BEGIN(1)
        pg8::Gemm g{Ub, WinT, MTOK, NPROJ, DM, DM}; pg8::StaticOrder S; S.init(MTOK, NPROJ, G, bx);
        pg8::EpiBf16 E{proj, NPROJ};
        pg8::gemm_phase<pg8::EpiBf16, true>(lds, g, S, E);
    REP_END
    xcd_barrier(bar);

    REP_BEGIN(2)
        {
            const int c0 = 4 * (tid & 15), rstride = NGT >> 4;
            for (int which = 0; which < 2; ++which) {
                const float* nw = which ? a.k_norm_w : a.q_norm_w; const int colb = which ? PC_AK : PC_AQ;
                const f32x4 w1 = *(const f32x4*)(nw + c0), w2 = *(const f32x4*)(nw + 64 + c0);
                for (int idx0 = gt >> 4; idx0 < MTOK * 8; idx0 += 4 * rstride) {
                    u32x2 r1[4], r2[4]; f32x4 cs[4], sn[4];
#pragma unroll
                    for (int q = 0; q < 4; ++q) { const int idx = idx0 + q * rstride;
                        if (idx < MTOK * 8) { const int m = idx >> 3, hh = idx & 7, pos = m & (SEQ - 1); const bf16* kp = proj + (size_t)m * NPROJ + colb + hh * 128;
                            r1[q] = *(const u32x2*)(kp + c0); r2[q] = *(const u32x2*)(kp + 64 + c0); cs[q] = *(const f32x4*)(rcos + pos * 64 + c0); sn[q] = *(const f32x4*)(rsin + pos * 64 + c0); } }
#pragma unroll
                    for (int q = 0; q < 4; ++q) { const int idx = idx0 + q * rstride;
                        if (idx < MTOK * 8) { const int m = idx >> 3, hh = idx & 7; bf16* kp = proj + (size_t)m * NPROJ + colb + hh * 128;
                            float x1[4] = {bf_lo(r1[q].x), bf_hi(r1[q].x), bf_lo(r1[q].y), bf_hi(r1[q].y)}, x2[4] = {bf_lo(r2[q].x), bf_hi(r2[q].x), bf_lo(r2[q].y), bf_hi(r2[q].y)};
                            float ss = 0.f;
#pragma unroll
                            for (int e = 0; e < 4; ++e) ss += x1[e] * x1[e] + x2[e] * x2[e];
                            ss = row16_sum(ss);
                            const float rk = __builtin_amdgcn_rsqf(ss * (1.0f / 128.0f) + NORM_EPS);
                            float o1[4], o2[4];
#pragma unroll
                            for (int e = 0; e < 4; ++e) { const float y1 = x1[e] * rk * w1[e], y2 = x2[e] * rk * w2[e]; o1[e] = y1 * cs[q][e] - y2 * sn[q][e]; o2[e] = y2 * cs[q][e] + y1 * sn[q][e]; }
                            u32x2 wv; wv.x = cvtpk(o1[0], o1[1]); wv.y = cvtpk(o1[2], o1[3]); if (!dry) *(u32x2*)(kp + c0) = wv;
                            wv.x = cvtpk(o2[0], o2[1]); wv.y = cvtpk(o2[2], o2[3]); if (!dry) *(u32x2*)(kp + 64 + c0) = wv; } }
                }
            }
        }
        LAS unsigned char* KW = lds; LAS unsigned char* VT = lds + 18432;
        const int g = lane >> 4, qp = (lane & 15) >> 2, p = lane & 3;
        for (int u = vcu; u < 512; u += G) {
            const int b = u >> 8, h = (u >> 6) & 3, c = u & 63;
            const int tok = b * SEQ + c * 64 + lane;
            const float li = gli[tok * 4 + h], lf = glf[tok * 4 + h];
            const float cf = scan_add64(lf, lane);
            const float gsum = __shfl(cf, 63);
            const float av = gsum - cf + li;
            const float ml = wave_max(av);
            const float wst = __expf(av - ml);
            if (tid == 0) { msc_g[u] = gsum; msc_ml[u] = ml; }
            conv_tile<true>(proj, a.conv_w, a.conv_b, b, c, PC_MK + h * 128, 512 + h * 128, 1.0f, wst, KW, tid);
            v_tile(proj, b, c, h, VT, tid);
            __syncthreads();
            f32x4 acc[8][2];
#pragma unroll
            for (int df = 0; df < 8; ++df) { acc[df][0] = (f32x4){0.f, 0.f, 0.f, 0.f}; acc[df][1] = (f32x4){0.f, 0.f, 0.f, 0.f}; }
#pragma unroll
            for (int kk = 0; kk < 2; ++kk) {
                bf16x8 bfr[2];
#pragma unroll
                for (int ef = 0; ef < 2; ++ef) { const int col = 32 * wave + 16 * ef + 4 * p;
                    bfr[ef] = cat4(vtr(VT + (32 * kk + 4 * g + qp) * 544 + col * 2), vtr(VT + (32 * kk + 16 + 4 * g + qp) * 544 + col * 2)); }
#pragma unroll
                for (int df = 0; df < 8; ++df) { const int col = 16 * df + 4 * p;
                    const bf16x8 af = cat4(vtr(KW + (32 * kk + 4 * g + qp) * 288 + col * 2), vtr(KW + (32 * kk + 16 + 4 * g + qp) * 288 + col * 2));
                    acc[df][0] = MFMA16(af, bfr[0], acc[df][0]); acc[df][1] = MFMA16(af, bfr[1], acc[df][1]); }
            }
#pragma unroll
            for (int ef = 0; ef < 2; ++ef) { const int e = 32 * wave + 16 * ef + (lane & 15);
#pragma unroll
                for (int df = 0; df < 8; ++df) { const f32x4 v = acc[df][ef]; u32x2 w; w.x = cvtpk(v[0], v[1]); w.y = cvtpk(v[2], v[3]);
                    *(u32x2*)(kvT + ((size_t)u * 256 + e) * 128 + 16 * df + 4 * g) = w; } }
            if (tid < 128) { float nsum = 0.f;
#pragma unroll 8
                for (int l = 0; l < 64; ++l) nsum += __uint_as_float((unsigned)(*(const LAS unsigned short*)(KW + l * 288 + tid * 2)) << 16);
                ncb[u * 128 + tid] = nsum; }
            __syncthreads();
        }
    REP_END
    xcd_barrier(bar);

    REP_BEGIN(3)
        LAS float* sg = (LAS float*)lds; LAS float* sml = sg + 512;
        for (int i = tid; i < 512; i += NWAVES * 64) { sg[i] = msc_g[i]; sml[i] = msc_ml[i]; }
        __syncthreads();
        for (int id = gt; id < 8 * 16384; id += NGT) {
            const int bh = id >> 14, pi = id & 16383;
            unsigned* base = (unsigned*)kvT + (size_t)bh * 64 * 16384 + pi;
            float c0 = 0.f, c1 = 0.f, m = 0.f;
#pragma unroll 1
            for (int cb = 0; cb < 64; cb += 32) {
                unsigned xv[32];
#pragma unroll
                for (int i = 0; i < 32; ++i) xv[i] = base[(size_t)(cb + i) * 16384];
#pragma unroll
                for (int i = 0; i < 32; ++i) {
                    const float gg = sg[bh * 64 + cb + i], ml = sml[bh * 64 + cb + i];
                    const float mn = fmaxf(gg + m, ml), so = __expf(gg + m - mn), sn = __expf(ml - mn);
                    if (!dry) base[(size_t)(cb + i) * 16384] = cvtpk(c0, c1);
                    c0 = so * c0 + sn * bf_lo(xv[i]); c1 = so * c1 + sn * bf_hi(xv[i]); m = mn;
                }
            }
        }
        for (int id = gt; id < 8 * 128; id += NGT) {
            const int bh = id >> 7, dd = id & 127; float n = 0.f, m = 0.f;
            float* nb_ = ncb + (size_t)bh * 64 * 128 + dd;
#pragma unroll 1
            for (int cb = 0; cb < 64; cb += 32) {
                float xv[32];
#pragma unroll
                for (int i = 0; i < 32; ++i) xv[i] = nb_[(cb + i) * 128];
#pragma unroll
                for (int i = 0; i < 32; ++i) {
                    const float gg = sg[bh * 64 + cb + i], ml = sml[bh * 64 + cb + i];
                    const float mn = fmaxf(gg + m, ml), so = __expf(gg + m - mn), sn = __expf(ml - mn);
                    if (!dry) nb_[(cb + i) * 128] = n;
                    if (dd == 0) msc_mp[bh * 64 + cb + i] = m;
                    n = so * n + sn * xv[i]; m = mn;
                }
            }
        }
        __syncthreads();
    REP_END
    REP_BEGIN(4)
        for (int pidx = vcu; pidx < 512; pidx += G) {
            AUnit ua, ub;
            { const int u = pidx; ua = AUnit{u >> 8, (u >> 5) & 7, 4, (u >> 3) & 3, u & 7, op0, pl0}; }
            { const int v = pidx; const int bb = v >> 8; ub = AUnit{bb, (v >> 5) & 7, 16, (v >> 1) & 15, (v ^ bb) & 1, op1, pl1}; }
            attn_pair<false>(proj, rcos, rsin, a.q_norm_w, a.attn_norm_w, ua, ub, lds, nullptr, nullptr, tid, dry);
        }
    REP_END
    xcd_barrier(bar);

    REP_BEGIN(5)
        LAS unsigned char* QT = lds; LAS unsigned char* KT = lds + 18432; LAS unsigned char* VT = lds + 36864;
        LAS float* NP = (LAS float*)(lds + 71680); LAS float* XCH = (LAS float*)(lds + 72192); LAS unsigned char* CP = lds + 72704;
        const int j = lane & 15, g = lane >> 4, qp = j >> 2, p = lane & 3;
        const int tf = wave & 3, eh = wave >> 2;
        for (int u = vcu; u < 512; u += G) {
            const int b = u >> 8, h = (u >> 6) & 3, c = u & 63;
            const int tok = b * SEQ + c * 64 + lane;
            const float li = gli[tok * 4 + h], lf = glf[tok * 4 + h];
            const float cf = scan_add64(lf, lane);
            const float bvec = li - cf;
            const float pm = scan_max64(bvec, lane);
            const float mprev = msc_mp[u];
            const float Mv = fmaxf(mprev, pm);
            const float wiv = __expf(mprev - Mv), emtv = __expf(-cf - Mv);
            {
                const bf16* csrc = kvT + (size_t)u * 256 * 128 + (size_t)(tid >> 4) * 128 + (tid & 15) * 8;
                u32x4 cv[8];
#pragma unroll
                for (int it = 0; it < 8; ++it) cv[it] = *(const u32x4*)(csrc + (size_t)it * 32 * 128);
#pragma unroll
                for (int it = 0; it < 8; ++it) *(LAS u32x4*)(CP + (it * 32 + (tid >> 4)) * 288 + (tid & 15) * 16) = cv[it];
            }
            const int t_ = 16 * (wave & 3) + j;
            const bf16* orow_ = proj + (size_t)(b * SEQ + c * 64 + t_) * NPROJ;
            u32x2 mo_pre[8];
#pragma unroll
            for (int ef = 0; ef < 8; ++ef) mo_pre[ef] = *(const u32x2*)(orow_ + PC_MO + h * 256 + 128 * eh + 16 * ef + 4 * g);
            conv_tile<false>(proj, a.conv_w, a.conv_b, b, c, PC_MQ + h * 128, h * 128, 0.08838834764831845f, 0.f, QT, tid);
            conv_tile<false>(proj, a.conv_w, a.conv_b, b, c, PC_MK + h * 128, 512 + h * 128, 1.0f, 0.f, KT, tid);
            v_tile(proj, b, c, h, VT, tid);
            if (tid < 128) NP[tid] = ncb[u * 128 + tid];
            __syncthreads();
            const int t = 16 * tf + j;
            const float M_t = __shfl(Mv, t), wi_t = __shfl(wiv, t), emt_t = __shfl(emtv, t);
            bf16x8 qf[4];
#pragma unroll
            for (int ks = 0; ks < 4; ++ks) qf[ks] = *(const LAS bf16x8*)(QT + t * 288 + (32 * ks + 8 * g) * 2);
            float sp[4][4]; float rowsum = 0.f;
#pragma unroll
            for (int sf = 0; sf < 4; ++sf) {
                f32x4 sa = {0.f, 0.f, 0.f, 0.f};
#pragma unroll
                for (int ks = 0; ks < 4; ++ks) { const bf16x8 kfr = *(const LAS bf16x8*)(KT + (16 * sf + j) * 288 + (32 * ks + 8 * g) * 2); sa = MFMA16(kfr, qf[ks], sa); }
#pragma unroll
                for (int rg = 0; rg < 4; ++rg) { const int sidx = 16 * sf + 4 * g + rg; const float bs = __shfl(bvec, sidx);
                    const float pv = (sidx <= t) ? __expf(bs - M_t) : 0.f; sp[sf][rg] = sa[rg] * pv; rowsum += sp[sf][rg]; }
            }
            bf16x8 pb[2];
#pragma unroll
            for (int kk = 0; kk < 2; ++kk) { float tmp[8] = {sp[2 * kk][0], sp[2 * kk][1], sp[2 * kk][2], sp[2 * kk][3], sp[2 * kk + 1][0], sp[2 * kk + 1][1], sp[2 * kk + 1][2], sp[2 * kk + 1][3]};
                const u32x4 w = pack8(tmp); pb[kk] = __builtin_bit_cast(bf16x8, w); }
            f32x4 ai[8], ae[8];
#pragma unroll
            for (int ef = 0; ef < 8; ++ef) { ai[ef] = (f32x4){0.f, 0.f, 0.f, 0.f}; ae[ef] = (f32x4){0.f, 0.f, 0.f, 0.f}; }
#pragma unroll
            for (int kk = 0; kk < 2; ++kk) {
#pragma unroll
                for (int ef = 0; ef < 8; ++ef) { const int col = 128 * eh + 16 * ef + 4 * p;
                    const bf16x8 af = cat4(vtr(VT + (32 * kk + 4 * g + qp) * 544 + col * 2), vtr(VT + (32 * kk + 16 + 4 * g + qp) * 544 + col * 2));
                    ai[ef] = MFMA16(af, pb[kk], ai[ef]); }
            }
#pragma unroll
            for (int ef = 0; ef < 8; ++ef) {
#pragma unroll
                for (int ks = 0; ks < 4; ++ks) { const bf16x8 cfr = *(const LAS bf16x8*)(CP + (128 * eh + 16 * ef + j) * 288 + (32 * ks + 8 * g) * 2); ae[ef] = MFMA16(cfr, qf[ks], ae[ef]); }
            }
            float qn = 0.f;
#pragma unroll
            for (int ks = 0; ks < 4; ++ks) { float qv[8]; unpack8(__builtin_bit_cast(u32x4, qf[ks]), qv);
#pragma unroll
                for (int e = 0; e < 8; ++e) qn += qv[e] * NP[32 * ks + 8 * g + e]; }
            qn = xg_sum(qn);
            rowsum = xg_sum(rowsum);
            const float den = wi_t * qn + rowsum;
            const float dinv = __builtin_amdgcn_rcpf(fmaxf(fabsf(den), emt_t));
            float ssq = 0.f;
#pragma unroll
            for (int ef = 0; ef < 8; ++ef) { ai[ef] = (ae[ef] * wi_t + ai[ef]) * dinv; ssq += (ai[ef][0] * ai[ef][0] + ai[ef][1] * ai[ef][1]) + (ai[ef][2] * ai[ef][2] + ai[ef][3] * ai[ef][3]); }
            ssq = xg_sum(ssq);
            if (g == 0) XCH[eh * 64 + t] = ssq;
            __syncthreads();
            const float rn = __builtin_amdgcn_rsqf((XCH[t] + XCH[64 + t]) * (1.0f / 256.0f) + NORM_EPS);
            bf16* orow = proj + (size_t)(b * SEQ + c * 64 + t) * NPROJ;
#pragma unroll
            for (int ef = 0; ef < 8; ++ef) { const int e = 128 * eh + 16 * ef + 4 * g;
                const f32x4 nw = *(const f32x4*)(a.mlstm_norm_w + h * 256 + e);
                const u32x2 mo = mo_pre[ef];
                const float mof[4] = {bf_lo(mo.x), bf_hi(mo.x), bf_lo(mo.y), bf_hi(mo.y)};
                float r4[4];
#pragma unroll
                for (int e2 = 0; e2 < 4; ++e2) r4[e2] = ai[ef][e2] * rn * nw[e2] * __builtin_amdgcn_rcpf(1.0f + __expf(-mof[e2]));
                u32x2 w; w.x = cvtpk(r4[0], r4[1]); w.y = cvtpk(r4[2], r4[3]); if (!dry) *(u32x2*)(orow + PC_MV + h * 256 + e) = w; }
            __syncthreads();
        }
        for (int pidx = vcu; pidx < 256; pidx += G) {
            const AUnit ua{0, (pidx >> 5) & 7, 1, 0, pidx & 31, op0, pl0}, ub{1, (pidx >> 5) & 7, 1, 0, pidx & 31, op0, pl0};
            attn_pair<true>(proj, rcos, rsin, a.q_norm_w, a.attn_norm_w, ua, ub, lds, op1, pl1, tid, dry);
        }
    REP_END
    xcd_barrier(bar);

    REP_BEGIN(6)
        pg8::Gemm g{proj + PC_MV, WoutT, MTOK, DM, DM, NPROJ}; pg8::StaticOrder S; S.init(MTOK, DM, G, bx);
        pg8::EpiRes1 E{a.x, a.out, H1b, sumsq, DM, dry};
        pg8::gemm_phase<pg8::EpiRes1, false>(lds, g, S, E);
    REP_END
    xcd_barrier(bar);

    REP_BEGIN(7)
        pg8::Gemm g{H1b, WguT, MTOK, NGU, DM, DM}; pg8::StaticOrder S; S.init(MTOK, NGU, G, bx);
        pg8::EpiSwiGLU E{FF, DFF, sumsq};
        pg8::gemm_phase<pg8::EpiSwiGLU, true>(lds, g, S, E);
        if (rep_ == 1) {
            const int nfull = (MTOK / 256) * (NGU / 256) - 5 * G;
            const int nidle = G - nfull;
            if (G == 256 ? (bx >= nfull) : true) {
                LAS float* scr = (LAS float*)(lds + wave * 16384);
                constexpr int I_DN = (DFF / 64) * (DM / 32);
                const int w0 = (G == 256) ? (bx - nfull) * NWAVES + wave : gw, nw = (G == 256) ? nidle * NWAVES : NGW;
                for (int it = w0; it < I_DN; it += nw) { const int nblk = DM / 32, kb = it / nblk, nb = it % nblk;
                    const TItem t{a.w_down, WdnT, nullptr, DM, DFF, nb * 32, nb * 32, kb * 64}; f32x4 v[8]; titem_load(t, v, lane); titem_finish(t, v, scr, lane); }
            }
        }
    REP_END
    xcd_barrier(bar);

    REP_BEGIN(8)
        pg8::Gemm g{FF, WdnT, MTOK, DM, DFF, DFF}; pg8::StaticOrder S; S.init(MTOK, DM, G, bx);
        pg8::EpiRes2 E{H1b, a.out, DM, dry};
        pg8::gemm_phase<pg8::EpiRes2, false>(lds, g, S, E);
    REP_END
}

extern "C" void kernel_launch(void* const* d_in, const int* in_sizes, int n_in, void* d_out, int out_size, void* d_ws, size_t ws_size, hipStream_t stream) {
    static int grid = 0;
    if (grid == 0) {
        if (n_in != 16 || in_sizes[0] != MTOK * DM || out_size != MTOK * DM || ws_size < WS_END) { fprintf(stderr, "kernel_launch: unexpected shapes (n_in %d in0 %d out %d ws %zu)\n", n_in, n_in > 0 ? in_sizes[0] : -1, out_size, ws_size); grid = -1; return; }
        int dev = 0, cus = 0;
        if (hipGetDevice(&dev) != hipSuccess || hipDeviceGetAttribute(&cus, hipDeviceAttributeMultiprocessorCount, dev) != hipSuccess || cus <= 0) cus = 256;
        if (hipFuncSetAttribute((const void*)hymba_fwd, hipFuncAttributeMaxDynamicSharedMemorySize, LDS_BYTES) != hipSuccess) { fprintf(stderr, "kernel_launch: hipFuncSetAttribute failed\n"); grid = -1; return; }
        (void)hipGetLastError();
        grid = cus;
    }
    if (grid < 0) return;
    if (hipMemsetAsync((char*)d_ws + WS_CTL, 0, CTL_ZERO_BYTES, stream) != hipSuccess) { fprintf(stderr, "kernel_launch: memset failed\n"); return; }
    Args a{};
    a.x = (const float*)d_in[0]; a.norm1_w = (const float*)d_in[1]; a.w_in = (const float*)d_in[2]; a.conv_w = (const float*)d_in[3]; a.conv_b = (const float*)d_in[4];
    a.igate_b = (const float*)d_in[5]; a.fgate_b = (const float*)d_in[6]; a.q_norm_w = (const float*)d_in[7]; a.k_norm_w = (const float*)d_in[8];
    a.mlstm_norm_w = (const float*)d_in[9]; a.attn_norm_w = (const float*)d_in[10]; a.w_out = (const float*)d_in[11]; a.norm2_w = (const float*)d_in[12];
    a.w_gate = (const float*)d_in[13]; a.w_up = (const float*)d_in[14]; a.w_down = (const float*)d_in[15];
    a.out = (float*)d_out; a.ws = (unsigned char*)d_ws; a.dry = (PROBE_PHASE >= 0) ? 1 : 0;
    hipLaunchKernelGGL(hymba_fwd, dim3(grid), dim3(NWAVES * 64), LDS_BYTES, stream, a);
}
```

```cpp
#include <hip/hip_runtime.h>
#include <cstdio>
#include <cstdint>

#define LAS __attribute__((address_space(3)))
#define GAS __attribute__((address_space(1)))
typedef unsigned short bf16;
typedef short bf16x8 __attribute__((ext_vector_type(8)));
typedef short s16x4 __attribute__((ext_vector_type(4)));
typedef float f32x4 __attribute__((ext_vector_type(4)));
typedef float f32x2 __attribute__((ext_vector_type(2)));
typedef unsigned u32x4 __attribute__((ext_vector_type(4)));
typedef unsigned u32x2 __attribute__((ext_vector_type(2)));
typedef __bf16 bf16x2_t __attribute__((ext_vector_type(2)));

constexpr int BATCH = 2, SEQ = 4096, DM = 2048, MTOK = BATCH * SEQ;
constexpr int INW = 6152, NPROJ = 6144, DFF = 5632, NGU = 2 * DFF;
constexpr int PC_MQ = 0, PC_MK = 512, PC_MO = 1024, PC_MV = 2048, PC_AQ = 3072, PC_AK = 4096, PC_AV = 5120;
constexpr float NORM_EPS = 1e-6f;
constexpr int NWAVES = 8;

constexpr size_t MiB = 1u << 20;
constexpr size_t WS_CTL = 0, CTL_ZERO_BYTES = 32 * 1024;
constexpr size_t WS_GLI = 1 * MiB;
constexpr size_t WS_GLF = WS_GLI + 128 * 1024;
constexpr size_t WS_SUMSQ = WS_GLF + 128 * 1024;
constexpr size_t WS_MSC = WS_SUMSQ + 32 * 1024;
constexpr size_t WS_NC = WS_MSC + 8 * 1024;
constexpr size_t WS_COS = 2 * MiB, WS_SIN = 3 * MiB;
constexpr size_t WS_WIN = 6 * MiB;
constexpr size_t WS_KV = 6 * MiB;
constexpr size_t WS_U = 30 * MiB;
constexpr size_t WS_PROJ = 62 * MiB;
constexpr size_t WS_WOUT = 158 * MiB;
constexpr size_t WS_WGU = 166 * MiB;
constexpr size_t WS_WDN = 210 * MiB;
constexpr size_t WS_OP0 = 38 * MiB;
constexpr size_t WS_OP1 = 232 * MiB;
constexpr size_t WS_PL0 = 248 * MiB, WS_PL1 = WS_PL0 + 256 * 1024;
constexpr size_t WS_END = 249 * MiB;
constexpr int CW_BAR = 4096;

constexpr int RING_BYTES = 131072;
constexpr int MISC_OFF = 147456 - 256;
constexpr int LDS_BYTES = 147456;

__device__ __forceinline__ unsigned cvtpk(float lo, float hi) { f32x2 v = {lo, hi}; bf16x2_t b = __builtin_convertvector(v, bf16x2_t); return __builtin_bit_cast(unsigned, b); }
__device__ __forceinline__ float bf_lo(unsigned w) { return __uint_as_float(w << 16); }
__device__ __forceinline__ float bf_hi(unsigned w) { return __uint_as_float(w & 0xffff0000u); }
__device__ __forceinline__ void unpack8(u32x4 w, float* f) { f[0] = bf_lo(w.x); f[1] = bf_hi(w.x); f[2] = bf_lo(w.y); f[3] = bf_hi(w.y); f[4] = bf_lo(w.z); f[5] = bf_hi(w.z); f[6] = bf_lo(w.w); f[7] = bf_hi(w.w); }
__device__ __forceinline__ u32x4 pack8(const float* f) { u32x4 w; w.x = cvtpk(f[0], f[1]); w.y = cvtpk(f[2], f[3]); w.z = cvtpk(f[4], f[5]); w.w = cvtpk(f[6], f[7]); return w; }
#define DPP_MOV_F(v, ctrl) __uint_as_float((unsigned)__builtin_amdgcn_mov_dpp((int)__float_as_uint(v), (ctrl), 0xf, 0xf, true))
__device__ __forceinline__ float row16_sum(float v) { v += DPP_MOV_F(v, 0xB1); v += DPP_MOV_F(v, 0x4E); v += DPP_MOV_F(v, 0x124); v += DPP_MOV_F(v, 0x128); return v; }
__device__ __forceinline__ float x16_sum(float v) { const auto r = __builtin_amdgcn_permlane16_swap(__float_as_uint(v), __float_as_uint(v), false, false); return __uint_as_float(r[0]) + __uint_as_float(r[1]); }
__device__ __forceinline__ float x32_sum(float v) { const auto r = __builtin_amdgcn_permlane32_swap(__float_as_uint(v), __float_as_uint(v), false, false); return __uint_as_float(r[0]) + __uint_as_float(r[1]); }
__device__ __forceinline__ float x16_max(float v) { const auto r = __builtin_amdgcn_permlane16_swap(__float_as_uint(v), __float_as_uint(v), false, false); return fmaxf(__uint_as_float(r[0]), __uint_as_float(r[1])); }
__device__ __forceinline__ float x32_max(float v) { const auto r = __builtin_amdgcn_permlane32_swap(__float_as_uint(v), __float_as_uint(v), false, false); return fmaxf(__uint_as_float(r[0]), __uint_as_float(r[1])); }
__device__ __forceinline__ float xg_sum(float v) { return x32_sum(x16_sum(v)); }
__device__ __forceinline__ float xg_max(float v) { return x32_max(x16_max(v)); }
__device__ __forceinline__ float wave_sum(float v) { return xg_sum(row16_sum(v)); }
__device__ __forceinline__ float wave_max(float v) {
#pragma unroll
    for (int o = 1; o < 64; o <<= 1) v = fmaxf(v, __shfl_xor(v, o));
    return v;
}
__device__ __forceinline__ s16x4 vtr(const LAS unsigned char* p) { return __builtin_bit_cast(s16x4, __builtin_amdgcn_ds_read_tr16_b64_v4i16((LAS s16x4*)p)); }
__device__ __forceinline__ bf16x8 cat4(s16x4 a, s16x4 b) { return (bf16x8){a[0], a[1], a[2], a[3], b[0], b[1], b[2], b[3]}; }
#define LDS_WAIT() asm volatile("s_waitcnt lgkmcnt(0)" ::: "memory")
#define VM_WAIT() asm volatile("s_waitcnt vmcnt(0)" ::: "memory")
#define SBAR() __builtin_amdgcn_sched_barrier(0)
#define MFMA16(a, b, c) __builtin_amdgcn_mfma_f32_16x16x32_bf16((a), (b), (c), 0, 0, 0)

namespace pg8 {
constexpr int BM = 256, BK = 64, HALF = 128, HTB = HALF * BK * 2, STAGE_BYTES = 8 * HTB, NXCD = 8, WGM = 8;
__host__ __device__ __forceinline__ int lds_byte(int r, int c) { const int st = (r >> 4) * 2 + (c >> 5), rr = r & 15, cc = c & 31, ob = rr * 64 + cc * 2; return st * 1024 + (ob ^ (((ob >> 9) & 1) << 5)); }
__host__ __device__ __forceinline__ void stage_rc(int b, int& R, int& C) { const int st = b / 1024, sb = b % 1024, swz = sb ^ (((sb >> 9) & 1) << 5); R = (st >> 1) * 16 + swz / 64; C = (st & 1) * 32 + (swz % 64) / 2; }
__host__ __device__ __forceinline__ int perm32(int rho) { const int n = rho >> 4, i = rho & 15; return 8 * (i >> 2) + 4 * n + (i & 3); }
struct Unit { int pm, pn, ord; };
struct Gemm { const bf16* A; const bf16* Bt; int M, N, K, lda; };
struct StaticOrder {
    int nM, nN, nwg, G, c;
    __device__ void init(int M, int N, int G_, int c_) { nM = M / BM; nN = N / BM; nwg = nM * nN; G = G_; c = c_; }
    __device__ bool next(int i, Unit& u) const {
        const long L = (long)i * G + c; if (L >= nwg) return false; u.ord = i;
        int wgid = (int)L; { const int q = nwg / NXCD, r = nwg % NXCD, xcd = wgid % NXCD, off = wgid / NXCD; wgid = (xcd < r ? xcd * (q + 1) : r * (q + 1) + (xcd - r) * q) + off; }
        const int nig = WGM * nN, gid = wgid / nig, fm = gid * WGM, gsz = (nM - fm) < WGM ? (nM - fm) : WGM;
        u.pm = fm + ((wgid % nig) % gsz); u.pn = (wgid % nig) / gsz; return true;
    }
};
struct EpiBf16 {
    static constexpr bool PERM = true, HAS_INIT = false;
    bf16* O; int ldc;
    __device__ __forceinline__ void operator()(const f32x4 (&acc)[2][2][4][2], const Unit& u, int wr, int wc, int fr, int fq) const {
        const int row0 = u.pm * BM + wr * 64 + fr, col0 = u.pn * BM + wc * 32 + 8 * fq;
#pragma unroll
        for (int ai = 0; ai < 2; ++ai)
#pragma unroll
            for (int m = 0; m < 4; ++m) { bf16* rowp = O + (size_t)(row0 + ai * HALF + m * 16) * ldc + col0;
#pragma unroll
                for (int bj = 0; bj < 2; ++bj) { const f32x4 v0 = acc[ai][bj][m][0], v1 = acc[ai][bj][m][1];
                    u32x4 w; w.x = cvtpk(v0[0], v0[1]); w.y = cvtpk(v0[2], v0[3]); w.z = cvtpk(v1[0], v1[1]); w.w = cvtpk(v1[2], v1[3]);
                    *(u32x4*)(rowp + bj * HALF) = w; } }
    }
};
struct EpiRes1 {
    static constexpr bool PERM = false, HAS_INIT = true;
    const float* xres; float* out; bf16* h1b; float* sumsq; int ldc; bool dry;
    __device__ __forceinline__ void init(f32x4 (&acc)[2][2][4][2], const Unit& u, int wr, int wc, int fr, int fq) const {
        const int col0 = u.pn * BM + wc * 32 + 4 * fq;
#pragma unroll
        for (int ai = 0; ai < 2; ++ai)
#pragma unroll
            for (int m = 0; m < 4; ++m) { const size_t off = (size_t)(u.pm * BM + ai * HALF + wr * 64 + m * 16 + fr) * ldc + col0;
#pragma unroll
                for (int bj = 0; bj < 2; ++bj)
#pragma unroll
                    for (int n = 0; n < 2; ++n) acc[ai][bj][m][n] = __builtin_nontemporal_load((const f32x4*)(xres + off + bj * HALF + n * 16)); }
    }
    __device__ __forceinline__ void operator()(const f32x4 (&acc)[2][2][4][2], const Unit& u, int wr, int wc, int fr, int fq) const {
        const int col0 = u.pn * BM + wc * 32 + 4 * fq;
#pragma unroll
        for (int ai = 0; ai < 2; ++ai)
#pragma unroll
            for (int m = 0; m < 4; ++m) { const int row = u.pm * BM + ai * HALF + wr * 64 + m * 16 + fr; const size_t off = (size_t)row * ldc + col0; float ss = 0.f;
#pragma unroll
                for (int bj = 0; bj < 2; ++bj)
#pragma unroll
                    for (int n = 0; n < 2; ++n) { const size_t o2 = off + bj * HALF + n * 16; const f32x4 h = acc[ai][bj][m][n];
                        u32x2 w; w.x = cvtpk(h[0], h[1]); w.y = cvtpk(h[2], h[3]); if (!dry) { *(u32x2*)(h1b + o2) = w; }
                        ss += (h[0] * h[0] + h[1] * h[1]) + (h[2] * h[2] + h[3] * h[3]); }
                ss = xg_sum(ss);
                if (fq == 0 && !dry) atomicAdd(sumsq + row, ss); }
    }
};
struct EpiSwiGLU {
    static constexpr bool PERM = true, HAS_INIT = false;
    bf16* O; int ldc; const LAS float* rsl; const float* sumsq;
    __device__ __forceinline__ void operator()(const f32x4 (&acc)[2][2][4][2], const Unit& u, int wr, int wc, int fr, int fq) const {
        const int col0 = u.pn * HALF + wc * 32 + 8 * fq;
#pragma unroll
        for (int ai = 0; ai < 2; ++ai)
#pragma unroll
            for (int m = 0; m < 4; ++m) { const int rl = ai * HALF + wr * 64 + m * 16 + fr; const int row = u.pm * BM + rl;
                const float rs = (u.ord < 8) ? rsl[u.ord * 256 + rl] : __builtin_amdgcn_rsqf(sumsq[row] * (1.0f / DM) + NORM_EPS);
                float f[8];
#pragma unroll
                for (int n = 0; n < 2; ++n)
#pragma unroll
                    for (int j = 0; j < 4; ++j) { const float g = acc[ai][0][m][n][j] * rs, up = acc[ai][1][m][n][j] * rs; f[n * 4 + j] = g * __builtin_amdgcn_rcpf(1.0f + __expf(-g)) * up; }
                *(u32x4*)(O + (size_t)row * ldc + col0) = pack8(f); }
    }
};
struct EpiRes2 {
    static constexpr bool PERM = false, HAS_INIT = true;
    const bf16* h1b; float* out; int ldc; bool dry;
    __device__ __forceinline__ void init(f32x4 (&acc)[2][2][4][2], const Unit& u, int wr, int wc, int fr, int fq) const {
        const int col0 = u.pn * BM + wc * 32 + 4 * fq;
#pragma unroll
        for (int ai = 0; ai < 2; ++ai)
#pragma unroll
            for (int m = 0; m < 4; ++m) { const size_t off = (size_t)(u.pm * BM + ai * HALF + wr * 64 + m * 16 + fr) * ldc + col0;
#pragma unroll
                for (int bj = 0; bj < 2; ++bj)
#pragma unroll
                    for (int n = 0; n < 2; ++n) { const u32x2 w = __builtin_nontemporal_load((const u32x2*)(h1b + off + bj * HALF + n * 16)); acc[ai][bj][m][n] = (f32x4){bf_lo(w.x), bf_hi(w.x), bf_lo(w.y), bf_hi(w.y)}; } }
    }
    __device__ __forceinline__ void operator()(const f32x4 (&acc)[2][2][4][2], const Unit& u, int wr, int wc, int fr, int fq) const {
        const int col0 = u.pn * BM + wc * 32 + 4 * fq;
#pragma unroll
        for (int ai = 0; ai < 2; ++ai)
#pragma unroll
            for (int m = 0; m < 4; ++m) { const size_t off = (size_t)(u.pm * BM + ai * HALF + wr * 64 + m * 16 + fr) * ldc + col0;
#pragma unroll
                for (int bj = 0; bj < 2; ++bj)
#pragma unroll
                    for (int n = 0; n < 2; ++n) { if (!dry) __builtin_nontemporal_store(acc[ai][bj][m][n], (f32x4*)(out + off + bj * HALF + n * 16)); } }
    }
};

template <class Epi, bool ALIGN_EPI>
__device__ __forceinline__ void gemm_phase(LAS unsigned char* lds, const Gemm g, const StaticOrder& S, const Epi& E) {
    int tid = threadIdx.x; asm volatile("" : "+v"(tid));
    const int wid = __builtin_amdgcn_readfirstlane(tid >> 6), lane = tid & 63, wr = wid >> 2, wc = wid & 3, fr = lane & 15, fq = lane >> 4;
    const int K = g.K, nt = K / BK;
    unsigned voffA[2], voffB[2];
#pragma unroll
    for (int i = 0; i < 2; ++i) { int R, C; stage_rc(tid * 16 + i * 8192, R, C); const int Rb = Epi::PERM ? ((R & ~31) + perm32(R & 31)) : R;
        voffA[i] = (unsigned)(R * g.lda + C) * 2u; voffB[i] = (unsigned)(Rb * K + C) * 2u; }
    const size_t kstep = (size_t)(BK * 2);
    const size_t hstepA = (size_t)HALF * g.lda * 2, hstepB = (size_t)HALF * K * 2;
    const size_t tstepA = 2 * hstepA, tstepB = 2 * hstepB;
    const unsigned ldsw = (unsigned)wid * 1024u;
    const int aoff = lds_byte(wr * 64 + fr, fq * 8), boff = lds_byte(wc * 32 + fr, fq * 8);
#define PG8_SA(b, h) (((b) * 2 + (h)) * HTB)
#define PG8_SB(b, h) ((4 + (b) * 2 + (h)) * HTB)
#define PG8_STAGE(bufoff, gbase, voff) do { _Pragma("unroll") for (int _i = 0; _i < 2; ++_i) \
        __builtin_amdgcn_global_load_lds((const unsigned*)((const char*)(gbase) + (voff)[_i]), (LAS unsigned*)(lds + (bufoff) + ldsw + _i * 8192), 16, 0, 0); } while (0)
#define PG8_LDA(dst, b, h) do { _Pragma("unroll") for (int m = 0; m < 4; ++m) _Pragma("unroll") for (int k = 0; k < 2; ++k) dst[m][k] = *(const LAS bf16x8*)(lds + PG8_SA(b, h) + aoff + m * 2048 + k * 1024); } while (0)
#define PG8_LDB(dst, b, h) do { _Pragma("unroll") for (int n = 0; n < 2; ++n) _Pragma("unroll") for (int k = 0; k < 2; ++k) dst[n][k] = *(const LAS bf16x8*)(lds + PG8_SB(b, h) + boff + n * 2048 + k * 1024); } while (0)
#define PG8_MMA(ai, bj, At, Bt) do { __builtin_amdgcn_s_setprio(1); _Pragma("unroll") for (int m = 0; m < 4; ++m) _Pragma("unroll") for (int n = 0; n < 2; ++n) _Pragma("unroll") for (int k = 0; k < 2; ++k) \
        acc[ai][bj][m][n] = __builtin_amdgcn_mfma_f32_16x16x32_bf16(Bt[n][k], At[m][k], acc[ai][bj][m][n], 0, 0, 0); __builtin_amdgcn_s_setprio(0); } while (0)
#define PG8_WAIT_V(n) asm volatile("s_waitcnt vmcnt(" #n ")" ::: "memory")
#define PG8_WAIT_L(n) asm volatile("s_waitcnt lgkmcnt(" #n ")" ::: "memory")
#define PG8_BAR __builtin_amdgcn_s_barrier()
#define PG8_SCHED __builtin_amdgcn_sched_barrier(0)
    Unit cur, nxt; int ui = 0;
    if (!S.next(0, cur)) return;
    f32x4 acc[2][2][4][2];
    if constexpr (Epi::HAS_INIT) { E.init(acc, cur, wr, wc, fr, fq); }
    else {
#pragma unroll
    for (int a = 0; a < 2; ++a)
#pragma unroll
        for (int b = 0; b < 2; ++b)
#pragma unroll
            for (int m = 0; m < 4; ++m)
#pragma unroll
                for (int n = 0; n < 2; ++n) acc[a][b][m][n] = (f32x4){0.f, 0.f, 0.f, 0.f};
    }
    bf16x8 At[4][2], B0[2][2], B1[2][2];
    const char* cA = (const char*)g.A + (size_t)cur.pm * tstepA; const char* cB = (const char*)g.Bt + (size_t)cur.pn * tstepB;
    PG8_STAGE(PG8_SB(0, 0), cB, voffB); PG8_STAGE(PG8_SB(0, 1), cB + hstepB, voffB); PG8_STAGE(PG8_SA(0, 0), cA, voffA); PG8_STAGE(PG8_SA(0, 1), cA + hstepA, voffA);
    if (wr == 1) PG8_BAR;
    PG8_WAIT_V(2); PG8_BAR;
    PG8_STAGE(PG8_SB(1, 0), cB + kstep, voffB); PG8_STAGE(PG8_SA(1, 0), cA + kstep, voffA); PG8_STAGE(PG8_SB(1, 1), cB + hstepB + kstep, voffB);
    PG8_WAIT_V(6); PG8_BAR;
    for (;;) {
        const bool has_next = S.next(ui + 1, nxt);
        const char* nA = has_next ? (const char*)g.A + (size_t)nxt.pm * tstepA : cA; const char* nB = has_next ? (const char*)g.Bt + (size_t)nxt.pn * tstepB : cB;
        for (int t = 0; t < nt; t += 2) {
            const bool last = (t == nt - 2);
            const char* a1 = cA + (size_t)(t + 1) * kstep;
            const char* a2 = last ? nA : cA + (size_t)(t + 2) * kstep; const char* b2 = last ? nB : cB + (size_t)(t + 2) * kstep;
            const char* a3 = a2 + kstep; const char* b3 = b2 + kstep;
            PG8_LDB(B0, 0, 0); PG8_LDB(B1, 0, 1); PG8_SCHED; PG8_LDA(At, 0, 0); PG8_STAGE(PG8_SA(1, 1), a1 + hstepA, voffA);
            PG8_WAIT_V(8); PG8_WAIT_L(0); PG8_BAR; PG8_MMA(0, 0, At, B0); PG8_MMA(0, 1, At, B1); PG8_BAR; PG8_SCHED;
            PG8_LDA(At, 0, 1); PG8_STAGE(PG8_SB(0, 0), b2, voffB); PG8_STAGE(PG8_SB(0, 1), b2 + hstepB, voffB); PG8_STAGE(PG8_SA(0, 0), a2, voffA);
            PG8_WAIT_V(8); PG8_WAIT_L(0); PG8_BAR; PG8_MMA(1, 0, At, B0); PG8_MMA(1, 1, At, B1); PG8_BAR; PG8_SCHED;
            PG8_LDB(B0, 1, 0); PG8_LDB(B1, 1, 1); PG8_SCHED; PG8_LDA(At, 1, 0); PG8_STAGE(PG8_SA(0, 1), a2 + hstepA, voffA);
            PG8_WAIT_V(8); PG8_WAIT_L(0); PG8_BAR; PG8_MMA(0, 0, At, B0); PG8_MMA(0, 1, At, B1); PG8_BAR; PG8_SCHED;
            PG8_LDA(At, 1, 1); PG8_STAGE(PG8_SB(1, 0), b3, voffB); PG8_STAGE(PG8_SB(1, 1), b3 + hstepB, voffB); PG8_STAGE(PG8_SA(1, 0), a3, voffA);
            PG8_WAIT_V(8); PG8_WAIT_L(0); PG8_BAR; PG8_MMA(1, 0, At, B0); PG8_MMA(1, 1, At, B1); PG8_BAR; PG8_SCHED;
        }
        if constexpr (ALIGN_EPI) { if (wr == 0) PG8_BAR; }
        E(acc, cur, wr, wc, fr, fq);
        if (!has_next) break;
        if constexpr (Epi::HAS_INIT) { E.init(acc, nxt, wr, wc, fr, fq); }
        else {
#pragma unroll
        for (int a = 0; a < 2; ++a)
#pragma unroll
            for (int b = 0; b < 2; ++b)
#pragma unroll
                for (int m = 0; m < 4; ++m)
#pragma unroll
                    for (int n = 0; n < 2; ++n) acc[a][b][m][n] = (f32x4){0.f, 0.f, 0.f, 0.f};
        }
        cur = nxt; cA = nA; cB = nB; ++ui;
        if constexpr (ALIGN_EPI) { if (wr == 1) PG8_BAR; }
    }
    PG8_WAIT_V(0);
    if constexpr (!ALIGN_EPI) { if (wr == 0) PG8_BAR; }
    PG8_BAR;
#undef PG8_SA
#undef PG8_SB
#undef PG8_STAGE
#undef PG8_LDA
#undef PG8_LDB
#undef PG8_MMA
#undef PG8_WAIT_V
#undef PG8_WAIT_L
#undef PG8_BAR
#undef PG8_SCHED
}
}

#define XB_TMO      128
#define XB_XCNT(j)  (256  + 64 * (j))
#define XB_XSUB(j)  (1280 + 64 * (j))
#define XB_XGEN(j)  (2304 + 64 * (j))
#define XB_TOP      3328
#define XB_TOPGEN   3392
#define XCD_BAR_WORDS 3456
#define XB_SPIN_CAP (1u << 18)
__device__ __forceinline__ unsigned xb_ld(unsigned* p)              { return __hip_atomic_load(p, __ATOMIC_RELAXED, __HIP_MEMORY_SCOPE_AGENT); }
__device__ __forceinline__ unsigned xb_add(unsigned* p, unsigned v) { return __hip_atomic_fetch_add(p, v, __ATOMIC_RELAXED, __HIP_MEMORY_SCOPE_AGENT); }
__device__ __forceinline__ unsigned xb_xcc_id() { return (unsigned)__builtin_amdgcn_s_getreg((3 << 11) | 20) & 0xFu; }
#define XB_SPIN(cond, bar) do { unsigned _sp = 0; while (cond) { __builtin_amdgcn_s_sleep(1); \
    if ((++_sp & 255u) == 0u) { if (xb_ld(&(bar)[XB_TMO])) break; if (_sp > XB_SPIN_CAP) { atomicAdd(&(bar)[XB_TMO], 1u); break; } } } } while (0)
struct XcdBarrier { unsigned* bar; unsigned x; volatile LAS unsigned* st; };
__device__ __forceinline__ XcdBarrier xcd_barrier_post(unsigned* bar, volatile LAS unsigned* st) {
    XcdBarrier b; b.bar = bar; b.x = xb_xcc_id(); b.st = st;
    if (threadIdx.x == 0) (void)xb_add(&bar[XB_XCNT(b.x)], 1u);
    return b;
}
__device__ __forceinline__ void xcd_barrier_complete(unsigned* bar, unsigned x, unsigned& nloc, unsigned& nx) {
    const unsigned G = gridDim.x * gridDim.y * gridDim.z;
    unsigned sum, cnt, mine, sp = 0u;
    for (;;) {
        sum = 0u; cnt = 0u; mine = 0u;
#pragma unroll
        for (unsigned j = 0; j < 16; ++j) { const unsigned c = xb_ld(&bar[XB_XCNT(j)]); sum += c; cnt += (c > 0u) ? 1u : 0u; mine = (j == x) ? c : mine; }
        if (sum == G) break;
        __builtin_amdgcn_s_sleep(1);
        if ((++sp & 255u) == 0u) { if (xb_ld(&bar[XB_TMO])) break; if (sp > XB_SPIN_CAP) { atomicAdd(&bar[XB_TMO], 1u); break; } }
    }
    nloc = mine > 0u ? mine : 1u; nx = cnt > 0u ? cnt : 1u;
}
__device__ __forceinline__ void xcd_barrier(const XcdBarrier& b) {
    asm volatile("s_waitcnt vmcnt(0)" ::: "memory");
    __syncthreads();
    if (threadIdx.x == 0) {
        unsigned* bar = b.bar;
        __builtin_amdgcn_s_waitcnt(0);
        unsigned nloc = b.st[0], nx = b.st[1];
        if (nloc == 0u) { xcd_barrier_complete(bar, b.x, nloc, nx); b.st[0] = nloc; b.st[1] = nx; }
        const unsigned old = xb_add(&bar[XB_XSUB(b.x)], 1u);
        const unsigned gen = old / nloc;
        if (old + 1u == (gen + 1u) * nloc) {
            __builtin_amdgcn_fence(__ATOMIC_RELEASE, "agent");
            asm volatile("s_waitcnt vmcnt(0)" ::: "memory");
            const unsigned og = xb_add(&bar[XB_TOP], 1u);
            const unsigned tg = og / nx;
            if (og + 1u == (tg + 1u) * nx) xb_add(&bar[XB_TOPGEN], 1u);
            else XB_SPIN(xb_ld(&bar[XB_TOPGEN]) == tg, bar);
            __builtin_amdgcn_fence(__ATOMIC_ACQUIRE, "agent");
            xb_add(&bar[XB_XGEN(b.x)], 1u);
            asm volatile("s_waitcnt vmcnt(0)" ::: "memory");
        } else {
            XB_SPIN(xb_ld(&bar[XB_XGEN(b.x)]) == gen, bar);
            __builtin_amdgcn_fence(__ATOMIC_ACQUIRE, "agent");
            asm volatile("s_waitcnt vmcnt(0)" ::: "memory");
        }
    }
    __syncthreads();
}

struct Args {
    const float* x; const float* norm1_w; const float* w_in; const float* conv_w; const float* conv_b; const float* igate_b; const float* fgate_b;
    const float* q_norm_w; const float* k_norm_w; const float* mlstm_norm_w; const float* attn_norm_w; const float* w_out; const float* norm2_w;
    const float* w_gate; const float* w_up; const float* w_down;
    float* out; unsigned char* ws; int dry; int pad;
};

struct TItem { const float* W; bf16* WT; const float* kscale; int ldw, K, nsrc0, ndst0, k0; };
__device__ __forceinline__ void titem_load(const TItem& t, f32x4 (&v)[8], int lane) {
    const float* src = t.W + (size_t)(t.k0 + (lane >> 3)) * t.ldw + t.nsrc0 + (lane & 7) * 4;
#pragma unroll
    for (int i = 0; i < 8; ++i) v[i] = __builtin_nontemporal_load((const f32x4*)(src + (size_t)(8 * i) * t.ldw));
}
__device__ __forceinline__ void titem_finish(const TItem& t, const f32x4 (&v)[8], LAS float* scr, int lane) {
#pragma unroll
    for (int i = 0; i < 8; ++i) { const int kk = 8 * i + (lane >> 3); const float sc = t.kscale ? t.kscale[t.k0 + kk] : 1.0f; LAS float* d = scr + kk * 33 + (lane & 7) * 4;
        d[0] = v[i][0] * sc; d[1] = v[i][1] * sc; d[2] = v[i][2] * sc; d[3] = v[i][3] * sc; }
    LDS_WAIT(); asm volatile("" ::: "memory");
    const int c = lane & 7;
#pragma unroll
    for (int j = 0; j < 4; ++j) { const int n = (lane >> 3) + 8 * j; const LAS float* s = scr + (8 * c) * 33 + n;
        u32x4 o; o.x = cvtpk(s[0 * 33], s[1 * 33]); o.y = cvtpk(s[2 * 33], s[3 * 33]); o.z = cvtpk(s[4 * 33], s[5 * 33]); o.w = cvtpk(s[6 * 33], s[7 * 33]);
        *(u32x4*)(t.WT + (size_t)(t.ndst0 + n) * t.K + t.k0 + 8 * c) = o; }
    LDS_WAIT(); asm volatile("" ::: "memory");
}
__device__ __forceinline__ int win_src_col(int nd) {
    if (nd < 1024) return nd;
    if (nd < 2048) return nd + 1024;
    if (nd < 3072) return nd - 1024;
    return nd + 8;
}


__device__ __forceinline__ float scan_add64(float v, int lane) {
#pragma unroll
    for (int o = 1; o < 64; o <<= 1) { const float t = __shfl_up(v, o); if (lane >= o) v += t; }
    return v;
}
__device__ __forceinline__ float scan_max64(float v, int lane) {
#pragma unroll
    for (int o = 1; o < 64; o <<= 1) { const float t = __shfl_up(v, o); if (lane >= o) v = fmaxf(v, t); }
    return v;
}
template <bool ROWW>
__device__ __forceinline__ void conv_tile(const bf16* proj, const float* conv_w, const float* conv_b, int b, int c, int col0, int ch0, float rscale, float wlane, LAS unsigned char* tile, int tid) {
    const int rr = tid >> 4, cc = (tid & 15) * 8;
    float w[4][8], bb[8];
#pragma unroll
    for (int j = 0; j < 4; ++j) { const f32x4 w0 = *(const f32x4*)(conv_w + j * 1024 + ch0 + cc), w1 = *(const f32x4*)(conv_w + j * 1024 + ch0 + cc + 4);
        w[j][0] = w0[0]; w[j][1] = w0[1]; w[j][2] = w0[2]; w[j][3] = w0[3]; w[j][4] = w1[0]; w[j][5] = w1[1]; w[j][6] = w1[2]; w[j][7] = w1[3]; }
    { const f32x4 b0 = *(const f32x4*)(conv_b + ch0 + cc), b1 = *(const f32x4*)(conv_b + ch0 + cc + 4);
      bb[0] = b0[0]; bb[1] = b0[1]; bb[2] = b0[2]; bb[3] = b0[3]; bb[4] = b1[0]; bb[5] = b1[1]; bb[6] = b1[2]; bb[7] = b1[3]; }
#pragma unroll
    for (int half = 0; half < 2; ++half) {
        const int l = rr + 32 * half, t = c * 64 + l;
        float y[8];
#pragma unroll
        for (int e = 0; e < 8; ++e) y[e] = bb[e];
#pragma unroll
        for (int j = 0; j < 4; ++j) { const int tt = t - 3 + j;
            if (tt >= 0) { const u32x4 raw = *(const u32x4*)(proj + (size_t)(b * SEQ + tt) * NPROJ + col0 + cc); float x[8]; unpack8(raw, x);
#pragma unroll
                for (int e = 0; e < 8; ++e) y[e] += w[j][e] * x[e]; } }
        float sc = rscale;
        if (ROWW) sc *= __shfl(wlane, l);
#pragma unroll
        for (int e = 0; e < 8; ++e) y[e] = y[e] * __builtin_amdgcn_rcpf(1.0f + __expf(-y[e])) * sc;
        *(LAS u32x4*)(tile + l * 288 + cc * 2) = pack8(y);
    }
}
__device__ __forceinline__ void v_tile(const bf16* proj, int b, int c, int h, LAS unsigned char* tile, int tid) {
#pragma unroll
    for (int p = 0; p < 4; ++p) { const int row = p * 16 + (tid >> 5), ch = tid & 31;
        const u32x4 v = *(const u32x4*)(proj + (size_t)(b * SEQ + c * 64 + row) * NPROJ + PC_MV + h * 256 + ch * 8);
        *(LAS u32x4*)(tile + row * 544 + ch * 16) = v; }
}

__device__ __forceinline__ void q_prep(const bf16* qrow, const float* rcos, const float* rsin, const float* qnw, int tq, int g, bf16x8 (&qf)[4]) {
    float q[4][8]; float ss = 0.f;
#pragma unroll
    for (int ks = 0; ks < 4; ++ks) { const u32x4 raw = *(const u32x4*)(qrow + 32 * ks + 8 * g); unpack8(raw, q[ks]);
#pragma unroll
        for (int e = 0; e < 8; ++e) ss += q[ks][e] * q[ks][e]; }
    ss = xg_sum(ss);
    const float rq = __builtin_amdgcn_rsqf(ss * (1.0f / 128.0f) + NORM_EPS);
#pragma unroll
    for (int ks = 0; ks < 2; ++ks) {
        const int c0 = 32 * ks + 8 * g;
#pragma unroll
        for (int e4 = 0; e4 < 2; ++e4) {
            const f32x4 cs = *(const f32x4*)(rcos + tq * 64 + c0 + 4 * e4), sn = *(const f32x4*)(rsin + tq * 64 + c0 + 4 * e4);
            const f32x4 w1 = *(const f32x4*)(qnw + c0 + 4 * e4), w2 = *(const f32x4*)(qnw + 64 + c0 + 4 * e4);
#pragma unroll
            for (int e = 0; e < 4; ++e) { const float y1 = q[ks][4 * e4 + e] * rq * w1[e], y2 = q[ks + 2][4 * e4 + e] * rq * w2[e];
                q[ks][4 * e4 + e] = y1 * cs[e] - y2 * sn[e]; q[ks + 2][4 * e4 + e] = y2 * cs[e] + y1 * sn[e]; }
        }
    }
#pragma unroll
    for (int ks = 0; ks < 4; ++ks) { const u32x4 w = pack8(q[ks]); qf[ks] = __builtin_bit_cast(bf16x8, w); }
}
struct AUnit { int b, h, d, r, n; bf16* po0; float* pl0; };
template <bool FINAL>
__device__ __forceinline__ void attn_pair(bf16* proj, const float* rcos, const float* rsin, const float* qnw, const float* anw, const AUnit& ua, const AUnit& ub,
                                          LAS unsigned char* lds_all, bf16* po1, float* pl1, int tid_in, bool dry) {
    int tid = tid_in; asm volatile("" : "+v"(tid));
    const int lane = tid & 63, wave = __builtin_amdgcn_readfirstlane(tid >> 6);
    const int team = wave >> 2, w4 = wave & 3;
    const int b = team ? ub.b : ua.b, h = team ? ub.h : ua.h, d = team ? ub.d : ua.d, r = team ? ub.r : ua.r, n = team ? ub.n : ua.n;
    bf16* po0 = team ? ub.po0 : ua.po0; float* pl0 = team ? ub.pl0 : ua.pl0;
    LAS unsigned char* lds = lds_all + team * 36864;
    const int j = lane & 15, g = lane >> 4, qp = j >> 2, p = lane & 3;
    const int tt = tid & 255, srow = tt >> 4, sch = tt & 15;
    const bf16* kcol = proj + (size_t)b * SEQ * NPROJ + PC_AK + h * 128 + sch * 8;
    const bf16* vcol = kcol + (PC_AV - PC_AK);
    const int kt0 = (n == 0) ? 4 : 0;
    const int sub0 = 128 * (n - 1) + srow;
    u32x4 rk[2][2], rv[2][2];
#define AT_ISSUE(set, t) do { if ((t) < 8) { _Pragma("unroll") for (int hh_ = 0; hh_ < 2; ++hh_) { const size_t tok_ = (size_t)((sub0 + 32 * (t) + 16 * hh_) * d + r); \
        rk[set][hh_] = *(const u32x4*)(kcol + tok_ * NPROJ); rv[set][hh_] = *(const u32x4*)(vcol + tok_ * NPROJ); } } } while (0)
#define AT_WRITE(set, t) do { LAS unsigned char* Kn_ = lds + ((t) & 1) * 18432; _Pragma("unroll") for (int hh_ = 0; hh_ < 2; ++hh_) { \
        *(LAS u32x4*)(Kn_ + (srow + 16 * hh_) * 288 + sch * 16) = rk[set][hh_]; *(LAS u32x4*)(Kn_ + 9216 + (srow + 16 * hh_) * 288 + sch * 16) = rv[set][hh_]; } } while (0)
#define WG_BAR() do { asm volatile("s_waitcnt lgkmcnt(0)" ::: "memory"); __builtin_amdgcn_s_barrier(); asm volatile("" ::: "memory"); } while (0)
    AT_ISSUE(0, kt0); AT_ISSUE(1, kt0 + 1);
    bf16x8 qf[2][4]; int qi[2]; int tq[2];
    const int G0 = w4, G1 = 7 - w4;
    qi[0] = 16 * G0 + j; qi[1] = 16 * G1 + j; tq[0] = (128 * n + qi[0]) * d + r; tq[1] = (128 * n + qi[1]) * d + r;
    const int lo0 = G0 >> 1, lo1 = G1 >> 1;
#pragma unroll
    for (int gi = 0; gi < 2; ++gi) { const bf16* qrow = proj + (size_t)(b * SEQ + tq[gi]) * NPROJ + PC_AQ + h * 128 + 8 * g;
#pragma unroll
        for (int ks = 0; ks < 4; ++ks) qf[gi][ks] = *(const bf16x8*)(qrow + 32 * ks); }
    AT_WRITE(0, kt0);
    for (int kb_ = 0; kb_ < kt0; ++kb_) WG_BAR();
    WG_BAR();
    float m_run[2] = {-1e30f, -1e30f}, l_run[2] = {0.f, 0.f};
    f32x4 o[2][8];
    if (FINAL) {
#pragma unroll
        for (int gi = 0; gi < 2; ++gi) { const size_t trow = (size_t)(b * SEQ + tq[gi]);
            const float l0 = pl0[trow * 8 + h], l1 = pl1[trow * 8 + h]; const float m0 = fmaxf(l0, l1);
            const float a0 = __builtin_amdgcn_exp2f(l0 - m0), a1 = __builtin_amdgcn_exp2f(l1 - m0);
            m_run[gi] = m0; l_run[gi] = (g == 0) ? a0 + a1 : 0.f;
            const bf16* p0 = po0 + trow * 1024 + h * 128 + g * 32; const bf16* p1 = po1 + trow * 1024 + h * 128 + g * 32;
#pragma unroll
            for (int np = 0; np < 4; ++np) { const u32x4 x0 = *(const u32x4*)(p0 + 8 * np), x1 = *(const u32x4*)(p1 + 8 * np); float f0[8], f1[8]; unpack8(x0, f0); unpack8(x1, f1);
#pragma unroll
                for (int e = 0; e < 4; ++e) { o[gi][2 * np][e] = a0 * f0[e] + a1 * f1[e]; o[gi][2 * np + 1][e] = a0 * f0[4 + e] + a1 * f1[4 + e]; } }
        }
    } else {
#pragma unroll
        for (int gi = 0; gi < 2; ++gi)
#pragma unroll
            for (int nf = 0; nf < 8; ++nf) o[gi][nf] = (f32x4){0.f, 0.f, 0.f, 0.f};
    }
    const float SC = 0.08838834764831845f * 1.4426950408889634f;
    const float NEG = -__builtin_inff();
#define AT_SM(gi, kt, s0, s1) do { \
                float x[8]; float tmax = NEG; \
                _Pragma("unroll") for (int e = 0; e < 8; ++e) { const int kj = 32 * (kt) + 16 * (e >> 2) + 4 * g + (e & 3); const float sv = (e < 4) ? s0[e & 3] : s1[e & 3]; \
                    const bool valid = (kj >= qi[gi]) && (kj <= qi[gi] + 128); \
                    x[e] = valid ? sv * SC : NEG; tmax = fmaxf(tmax, x[e]); } \
                tmax = xg_max(tmax); \
                const float m_new = fmaxf(m_run[gi], tmax); \
                const float alpha = __builtin_amdgcn_exp2f(m_run[gi] - m_new); \
                float ps = 0.f; \
                _Pragma("unroll") for (int e = 0; e < 8; ++e) { x[e] = __builtin_amdgcn_exp2f(x[e] - m_new); ps += x[e]; } \
                l_run[gi] = l_run[gi] * alpha + ps; m_run[gi] = m_new; \
                _Pragma("unroll") for (int nf = 0; nf < 8; ++nf) o[gi][nf] = o[gi][nf] * alpha; \
                const u32x4 pw = pack8(x); pb[gi] = __builtin_bit_cast(bf16x8, pw); } while (0)
#define AT_ONE(gi, kt) do { \
            f32x4 sA = {0.f, 0.f, 0.f, 0.f}, sB = {0.f, 0.f, 0.f, 0.f}; \
            _Pragma("unroll") for (int ks = 0; ks < 4; ++ks) { \
                const bf16x8 k0 = *(const LAS bf16x8*)(Kt + j * 288 + (32 * ks + 8 * g) * 2), k1 = *(const LAS bf16x8*)(Kt + (16 + j) * 288 + (32 * ks + 8 * g) * 2); \
                sA = MFMA16(k0, qf[gi][ks], sA); sB = MFMA16(k1, qf[gi][ks], sB); } \
            bf16x8 pb[2]; AT_SM(gi, kt, sA, sB); \
            _Pragma("unroll") for (int nf = 0; nf < 8; ++nf) { \
                const s16x4 a0 = vtr(Vt + (4 * g + qp) * 288 + (16 * nf + 4 * p) * 2), a1 = vtr(Vt + (16 + 4 * g + qp) * 288 + (16 * nf + 4 * p) * 2); \
                o[gi][nf] = MFMA16(cat4(a0, a1), pb[gi], o[gi][nf]); } } while (0)
#define AT_STEP(kt, setn, setw) do { \
        LAS unsigned char* Kt = lds + ((kt) & 1) * 18432; LAS unsigned char* Vt = Kt + 9216; \
        AT_ISSUE(setn, (kt) + 2); \
        const bool act0 = (kt) >= lo0 && (kt) <= lo0 + 4, act1 = (kt) >= lo1 && (kt) <= lo1 + 4; \
        if (act0 && act1) { \
            f32x4 sA[2], sB[2]; sA[0] = (f32x4){0.f, 0.f, 0.f, 0.f}; sA[1] = sA[0]; sB[0] = sA[0]; sB[1] = sA[0]; \
            _Pragma("unroll") for (int ks = 0; ks < 4; ++ks) { \
                const bf16x8 k0 = *(const LAS bf16x8*)(Kt + j * 288 + (32 * ks + 8 * g) * 2), k1 = *(const LAS bf16x8*)(Kt + (16 + j) * 288 + (32 * ks + 8 * g) * 2); \
                sA[0] = MFMA16(k0, qf[0][ks], sA[0]); sB[0] = MFMA16(k1, qf[0][ks], sB[0]); sA[1] = MFMA16(k0, qf[1][ks], sA[1]); sB[1] = MFMA16(k1, qf[1][ks], sB[1]); } \
            bf16x8 pb[2]; \
            AT_SM(0, kt, sA[0], sB[0]); AT_SM(1, kt, sA[1], sB[1]); \
            _Pragma("unroll") for (int nf = 0; nf < 8; ++nf) { \
                const s16x4 a0 = vtr(Vt + (4 * g + qp) * 288 + (16 * nf + 4 * p) * 2), a1 = vtr(Vt + (16 + 4 * g + qp) * 288 + (16 * nf + 4 * p) * 2); \
                const bf16x8 vf = cat4(a0, a1); \
                o[0][nf] = MFMA16(vf, pb[0], o[0][nf]); o[1][nf] = MFMA16(vf, pb[1], o[1][nf]); } \
        } else if (act0) { AT_ONE(0, kt); } else if (act1) { AT_ONE(1, kt); } \
        if ((kt) + 1 < 8) AT_WRITE(setw, (kt) + 1); \
        WG_BAR(); } while (0)
#pragma unroll 1
    for (int kt = kt0; kt < 8; kt += 2) { AT_STEP(kt, 0, 1); AT_STEP(kt + 1, 1, 0); }
#undef AT_STEP
#undef AT_ONE
#undef AT_SM
#undef AT_ISSUE
#undef AT_WRITE
#pragma unroll
    for (int gi = 0; gi < 2; ++gi) {
        float lr = l_run[gi]; lr = xg_sum(lr);
        const float inv = __builtin_amdgcn_rcpf(lr);
        const float lse2 = m_run[gi] + __log2f(lr);
        const size_t trow = (size_t)(b * SEQ + tq[gi]);
        if (!FINAL) {
            bf16* pp = po0 + trow * 1024 + h * 128 + g * 32;
#pragma unroll
            for (int np = 0; np < 4; ++np) { const f32x4 va = o[gi][2 * np] * inv, vb = o[gi][2 * np + 1] * inv; u32x4 ww; ww.x = cvtpk(va[0], va[1]); ww.y = cvtpk(va[2], va[3]); ww.z = cvtpk(vb[0], vb[1]); ww.w = cvtpk(vb[2], vb[3]);
                if (!dry) *(u32x4*)(pp + 8 * np) = ww; }
            if (g == 0 && !dry) pl0[trow * 8 + h] = lse2;
        } else {
            bf16* qrow = proj + trow * NPROJ + PC_AQ + h * 128;
            float ss = 0.f;
#pragma unroll
            for (int nf = 0; nf < 8; ++nf) { const f32x4 v = o[gi][nf] * inv; o[gi][nf] = v; ss += (v[0] * v[0] + v[1] * v[1]) + (v[2] * v[2] + v[3] * v[3]); }
            ss = xg_sum(ss);
            const float rn = __builtin_amdgcn_rsqf(ss * (1.0f / 128.0f) + NORM_EPS);
#pragma unroll
            for (int nf = 0; nf < 8; ++nf) { const int e = 16 * nf + 4 * g; const f32x4 w = *(const f32x4*)(anw + h * 128 + e); const f32x4 v = o[gi][nf] * rn * w;
                u32x2 ww; ww.x = cvtpk(v[0], v[1]); ww.y = cvtpk(v[2], v[3]); if (!dry) *(u32x2*)(qrow + e) = ww; }
        }
    }
}

#ifndef PROBE_PHASE
#define PROBE_PHASE -1
#endif
#define REP_BEGIN(k) for (int rep_ = (PROBE_PHASE == (k)) ? 0 : 1; rep_ < 2; ++rep_) { const bool dry = (rep_ == 0) && (a.dry != 0); (void)dry; \
    int tid = threadIdx.x; asm volatile("" : "+v"(tid)); const int lane = tid & 63, wave = __builtin_amdgcn_readfirstlane(tid >> 6); \
    const int gw = vcu * NWAVES + wave, gt = vcu * (NWAVES * 64) + tid; (void)lane; (void)wave; (void)gw; (void)gt;
#define REP_END }

__global__ void __launch_bounds__(NWAVES * 64, 2) hymba_fwd(Args a) {
    extern __shared__ __attribute__((aligned(16))) unsigned char lds_raw[];
    LAS unsigned char* lds = (LAS unsigned char*)lds_raw;
    volatile LAS unsigned* MISC = (volatile LAS unsigned*)(lds + MISC_OFF);
    const int tid = threadIdx.x, lane = tid & 63, wave = __builtin_amdgcn_readfirstlane(tid >> 6);
    const int G = gridDim.x; const int bx = blockIdx.x; const int vcu = (G % 8 == 0) ? (bx % 8) * (G / 8) + bx / 8 : bx;
    unsigned char* ws = a.ws;
    unsigned* ctl = (unsigned*)(ws + WS_CTL);
    float* gli = (float*)(ws + WS_GLI); float* glf = (float*)(ws + WS_GLF); float* sumsq = (float*)(ws + WS_SUMSQ);
    float* msc_g = (float*)(ws + WS_MSC); float* msc_ml = msc_g + 512; float* msc_mp = msc_g + 1024;
    float* ncb = (float*)(ws + WS_NC);
    float* rcos = (float*)(ws + WS_COS); float* rsin = (float*)(ws + WS_SIN);
    bf16* WinT = (bf16*)(ws + WS_WIN); bf16* kvT = (bf16*)(ws + WS_KV); bf16* Ub = (bf16*)(ws + WS_U); bf16* H1b = (bf16*)(ws + WS_U);
    bf16* proj = (bf16*)(ws + WS_PROJ); bf16* FF = (bf16*)(ws + WS_PROJ);
    bf16* op0 = (bf16*)(ws + WS_OP0); bf16* op1 = (bf16*)(ws + WS_OP1); float* pl0 = (float*)(ws + WS_PL0); float* pl1 = (float*)(ws + WS_PL1);
    bf16* WoutT = (bf16*)(ws + WS_WOUT); bf16* WguT = (bf16*)(ws + WS_WGU); bf16* WdnT = (bf16*)(ws + WS_WDN);

    for (int u = tid; u < (LDS_BYTES - MISC_OFF) / 4; u += NWAVES * 64) ((LAS unsigned*)(lds + MISC_OFF))[u] = 0u;
    __syncthreads();
    XcdBarrier bar = xcd_barrier_post(ctl + CW_BAR, MISC + 8);
    const int NGW = G * NWAVES, NGT = G * NWAVES * 64;

    REP_BEGIN(0)
        for (int i = gt; i < MTOK; i += NGT) sumsq[i] = 0.f;
        for (int i = gt; i < SEQ * 64; i += NGT) {
            const int pos = i >> 6, fi = i & 63;
            const float invf = (float)exp2(-(double)fi * (13.287712379549449 / 64.0));
            const float ang = (float)pos * invf;
            const double rev = (double)ang * 0.15915494309189535; const double fr_ = rev - rint(rev);
            const float ar = (float)(fr_ * 6.283185307179586);
            rcos[i] = cosf(ar); rsin[i] = sinf(ar);
        }
        {
            LAS float* scr = (LAS float*)(lds + wave * 16384);
            constexpr int I_IN = (DM / 64) * (NPROJ / 32), I_OUT = (DM / 64) * (DM / 32), I_GU = (DM / 64) * (NGU / 32), I_DN = (DFF / 64) * (DM / 32);
            constexpr int NITEMS = I_IN + I_OUT + I_GU;
            auto decode = [&](int it) -> TItem {
                TItem t; int r = it;
                if (r < I_IN) { const int nblk = NPROJ / 32, kb = r / nblk, nb = r % nblk; t = TItem{a.w_in, WinT, nullptr, INW, DM, win_src_col(nb * 32), nb * 32, kb * 64}; return t; } r -= I_IN;
                if (r < I_OUT) { const int nblk = DM / 32, kb = r / nblk, nb = r % nblk; t = TItem{a.w_out, WoutT, nullptr, DM, DM, nb * 32, nb * 32, kb * 64}; return t; } r -= I_OUT;
                { const int nblk = NGU / 32, kb = r / nblk, nb = r % nblk; const int nd = nb * 32, pn = nd >> 8, j = nd & 255;
                    t = TItem{(j < 128) ? a.w_gate : a.w_up, WguT, a.norm2_w, DFF, DM, pn * 128 + (j & 127), nd, kb * 64}; return t; }
            };
            int it = gw;
            if (it < NITEMS) {
                TItem cur = decode(it); f32x4 vc[8]; titem_load(cur, vc, lane);
                for (;;) {
                    const int nx = it + NGW; const bool more = nx < NITEMS;
                    TItem nt = cur; f32x4 vn[8];
                    if (more) { nt = decode(nx); titem_load(nt, vn, lane); }
                    titem_finish(cur, vc, scr, lane);
                    if (!more) break;
                    cur = nt; it = nx;
#pragma unroll
                    for (int i = 0; i < 8; ++i) vc[i] = vn[i];
                }
            }
        }
        __syncthreads();
        LAS float* wg = (LAS float*)lds;
        for (int k = tid; k < DM; k += NWAVES * 64) { const f32x4 g0 = *(const f32x4*)(a.w_in + (size_t)k * INW + 3072), g1 = *(const f32x4*)(a.w_in + (size_t)k * INW + 3076);
            wg[0 * DM + k] = g0[0]; wg[1 * DM + k] = g0[1]; wg[2 * DM + k] = g0[2]; wg[3 * DM + k] = g0[3];
            wg[4 * DM + k] = g1[0]; wg[5 * DM + k] = g1[1]; wg[6 * DM + k] = g1[2]; wg[7 * DM + k] = g1[3]; }
        __syncthreads();
        for (int m = gw; m < MTOK; m += NGW) {
            const f32x4* xr = (const f32x4*)(a.x + (size_t)m * DM) + lane; const f32x4* wr_ = (const f32x4*)a.norm1_w + lane;
            f32x4 v[8]; float s = 0.f;
#pragma unroll
            for (int j = 0; j < 8; ++j) { v[j] = __builtin_nontemporal_load(xr + 64 * j); s += (v[j][0] * v[j][0] + v[j][1] * v[j][1]) + (v[j][2] * v[j][2] + v[j][3] * v[j][3]); }
            const float rstd = __builtin_amdgcn_rsqf(wave_sum(s) * (1.0f / DM) + NORM_EPS);
            u32x2* o8 = (u32x2*)(Ub + (size_t)m * DM) + lane;
#pragma unroll
            for (int j = 0; j < 8; ++j) { v[j] = v[j] * rstd * wr_[64 * j]; u32x2 w; w.x = cvtpk(v[j][0], v[j][1]); w.y = cvtpk(v[j][2], v[j][3]); o8[64 * j] = w; }
            float z = 0.f;
#pragma unroll 1
            for (int gi = 0; gi < 8; ++gi) { float t = 0.f;
#pragma unroll
                for (int j = 0; j < 8; ++j) { const f32x4 w4 = *(const LAS f32x4*)(wg + gi * DM + 256 * j + 4 * lane); t += (v[j][0] * w4[0] + v[j][1] * w4[1]) + (v[j][2] * w4[2] + v[j][3] * w4[3]); }
                t = wave_sum(t); z = (lane == gi) ? t : z; }
            if (lane < 8) {
                const int hh = lane & 3;
                if (lane < 4) { gli[m * 4 + hh] = 15.0f * tanhf((z + a.igate_b[hh]) * (1.0f / 15.0f)); }
                else { const float fp = 15.0f * tanhf((z + a.fgate_b[hh]) * (1.0f / 15.0f)); glf[m * 4 + hh] = -log1pf(expf(-fp)); }
            }
        }
    REP_END
    xcd_barrier(bar);

    REP_BEGIN(1)
        pg8::Gemm g{Ub, WinT, MTOK, NPROJ, DM, DM}; pg8::StaticOrder S; S.init(MTOK, NPROJ, G, bx);
        pg8::EpiBf16 E{proj, NPROJ};
        pg8::gemm_phase<pg8::EpiBf16, true>(lds, g, S, E);
    REP_END
    xcd_barrier(bar);

    REP_BEGIN(2)
        {
            const int c0 = 4 * (tid & 15), rstride = NGT >> 4;
            for (int which = 0; which < 2; ++which) {
                const float* nw = which ? a.k_norm_w : a.q_norm_w; const int colb = which ? PC_AK : PC_AQ;
                const f32x4 w1 = *(const f32x4*)(nw + c0), w2 = *(const f32x4*)(nw + 64 + c0);
                for (int idx0 = gt >> 4; idx0 < MTOK * 8; idx0 += 4 * rstride) {
                    u32x2 r1[4], r2[4]; f32x4 cs[4], sn[4];
#pragma unroll
                    for (int q = 0; q < 4; ++q) { const int idx = idx0 + q * rstride;
                        if (idx < MTOK * 8) { const int m = idx >> 3, hh = idx & 7, pos = m & (SEQ - 1); const bf16* kp = proj + (size_t)m * NPROJ + colb + hh * 128;
                            r1[q] = *(const u32x2*)(kp + c0); r2[q] = *(const u32x2*)(kp + 64 + c0); cs[q] = *(const f32x4*)(rcos + pos * 64 + c0); sn[q] = *(const f32x4*)(rsin + pos * 64 + c0); } }
#pragma unroll
                    for (int q = 0; q < 4; ++q) { const int idx = idx0 + q * rstride;
                        if (idx < MTOK * 8) { const int m = idx >> 3, hh = idx & 7; bf16* kp = proj + (size_t)m * NPROJ + colb + hh * 128;
                            float x1[4] = {bf_lo(r1[q].x), bf_hi(r1[q].x), bf_lo(r1[q].y), bf_hi(r1[q].y)}, x2[4] = {bf_lo(r2[q].x), bf_hi(r2[q].x), bf_lo(r2[q].y), bf_hi(r2[q].y)};
                            float ss = 0.f;
#pragma unroll
                            for (int e = 0; e < 4; ++e) ss += x1[e] * x1[e] + x2[e] * x2[e];
                            ss = row16_sum(ss);
                            const float rk = __builtin_amdgcn_rsqf(ss * (1.0f / 128.0f) + NORM_EPS);
                            float o1[4], o2[4];
#pragma unroll
                            for (int e = 0; e < 4; ++e) { const float y1 = x1[e] * rk * w1[e], y2 = x2[e] * rk * w2[e]; o1[e] = y1 * cs[q][e] - y2 * sn[q][e]; o2[e] = y2 * cs[q][e] + y1 * sn[q][e]; }
                            u32x2 wv; wv.x = cvtpk(o1[0], o1[1]); wv.y = cvtpk(o1[2], o1[3]); if (!dry) *(u32x2*)(kp + c0) = wv;
                            wv.x = cvtpk(o2[0], o2[1]); wv.y = cvtpk(o2[2], o2[3]); if (!dry) *(u32x2*)(kp + 64 + c0) = wv; } }
                }
            }
        }
        LAS unsigned char* KW = lds; LAS unsigned char* VT = lds + 18432;
        const int g = lane >> 4, qp = (lane & 15) >> 2, p = lane & 3;
        for (int u = vcu; u < 512; u += G) {
            const int b = u >> 8, h = (u >> 6) & 3, c = u & 63;
            const int tok = b * SEQ + c * 64 + lane;
            const float li = gli[tok * 4 + h], lf = glf[tok * 4 + h];
            const float cf = scan_add64(lf, lane);
            const float gsum = __shfl(cf, 63);
            const float av = gsum - cf + li;
            const float ml = wave_max(av);
            const float wst = __expf(av - ml);
            if (tid == 0) { msc_g[u] = gsum; msc_ml[u] = ml; }
            conv_tile<true>(proj, a.conv_w, a.conv_b, b, c, PC_MK + h * 128, 512 + h * 128, 1.0f, wst, KW, tid);
            v_tile(proj, b, c, h, VT, tid);
            __syncthreads();
            f32x4 acc[8][2];
#pragma unroll
            for (int df = 0; df < 8; ++df) { acc[df][0] = (f32x4){0.f, 0.f, 0.f, 0.f}; acc[df][1] = (f32x4){0.f, 0.f, 0.f, 0.f}; }
#pragma unroll
            for (int kk = 0; kk < 2; ++kk) {
                bf16x8 bfr[2];
#pragma unroll
                for (int ef = 0; ef < 2; ++ef) { const int col = 32 * wave + 16 * ef + 4 * p;
                    bfr[ef] = cat4(vtr(VT + (32 * kk + 4 * g + qp) * 544 + col * 2), vtr(VT + (32 * kk + 16 + 4 * g + qp) * 544 + col * 2)); }
#pragma unroll
                for (int df = 0; df < 8; ++df) { const int col = 16 * df + 4 * p;
                    const bf16x8 af = cat4(vtr(KW + (32 * kk + 4 * g + qp) * 288 + col * 2), vtr(KW + (32 * kk + 16 + 4 * g + qp) * 288 + col * 2));
                    acc[df][0] = MFMA16(af, bfr[0], acc[df][0]); acc[df][1] = MFMA16(af, bfr[1], acc[df][1]); }
            }
#pragma unroll
            for (int ef = 0; ef < 2; ++ef) { const int e = 32 * wave + 16 * ef + (lane & 15);
#pragma unroll
                for (int df = 0; df < 8; ++df) { const f32x4 v = acc[df][ef]; u32x2 w; w.x = cvtpk(v[0], v[1]); w.y = cvtpk(v[2], v[3]);
                    *(u32x2*)(kvT + ((size_t)u * 256 + e) * 128 + 16 * df + 4 * g) = w; } }
            if (tid < 128) { float nsum = 0.f;
#pragma unroll 8
                for (int l = 0; l < 64; ++l) nsum += __uint_as_float((unsigned)(*(const LAS unsigned short*)(KW + l * 288 + tid * 2)) << 16);
                ncb[u * 128 + tid] = nsum; }
            __syncthreads();
        }
    REP_END
    xcd_barrier(bar);

    REP_BEGIN(3)
        LAS float* sg = (LAS float*)lds; LAS float* sml = sg + 512;
        for (int i = tid; i < 512; i += NWAVES * 64) { sg[i] = msc_g[i]; sml[i] = msc_ml[i]; }
        __syncthreads();
        for (int id = gt; id < 8 * 16384; id += NGT) {
            const int bh = id >> 14, pi = id & 16383;
            unsigned* base = (unsigned*)kvT + (size_t)bh * 64 * 16384 + pi;
            float c0 = 0.f, c1 = 0.f, m = 0.f;
#pragma unroll 1
            for (int cb = 0; cb < 64; cb += 32) {
                unsigned xv[32];
#pragma unroll
                for (int i = 0; i < 32; ++i) xv[i] = base[(size_t)(cb + i) * 16384];
#pragma unroll
                for (int i = 0; i < 32; ++i) {
                    const float gg = sg[bh * 64 + cb + i], ml = sml[bh * 64 + cb + i];
                    const float mn = fmaxf(gg + m, ml), so = __expf(gg + m - mn), sn = __expf(ml - mn);
                    if (!dry) base[(size_t)(cb + i) * 16384] = cvtpk(c0, c1);
                    c0 = so * c0 + sn * bf_lo(xv[i]); c1 = so * c1 + sn * bf_hi(xv[i]); m = mn;
                }
            }
        }
        for (int id = gt; id < 8 * 128; id += NGT) {
            const int bh = id >> 7, dd = id & 127; float n = 0.f, m = 0.f;
            float* nb_ = ncb + (size_t)bh * 64 * 128 + dd;
#pragma unroll 1
            for (int cb = 0; cb < 64; cb += 32) {
                float xv[32];
#pragma unroll
                for (int i = 0; i < 32; ++i) xv[i] = nb_[(cb + i) * 128];
#pragma unroll
                for (int i = 0; i < 32; ++i) {
                    const float gg = sg[bh * 64 + cb + i], ml = sml[bh * 64 + cb + i];
                    const float mn = fmaxf(gg + m, ml), so = __expf(gg + m - mn), sn = __expf(ml - mn);
                    if (!dry) nb_[(cb + i) * 128] = n;
                    if (dd == 0) msc_mp[bh * 64 + cb + i] = m;
                    n = so * n + sn * xv[i]; m = mn;
                }
            }
        }
        __syncthreads();
    REP_END
    REP_BEGIN(4)
        for (int pidx = vcu; pidx < 512; pidx += G) {
            AUnit ua, ub;
            { const int u = pidx; ua = AUnit{u >> 8, (u >> 5) & 7, 4, (u >> 3) & 3, u & 7, op0, pl0}; }
            { const int v = pidx; const int bb = v >> 8; ub = AUnit{bb, (v >> 5) & 7, 16, (v >> 1) & 15, (v ^ bb) & 1, op1, pl1}; }
            attn_pair<false>(proj, rcos, rsin, a.q_norm_w, a.attn_norm_w, ua, ub, lds, nullptr, nullptr, tid, dry);
        }
    REP_END
    xcd_barrier(bar);

    REP_BEGIN(5)
        LAS unsigned char* QT = lds; LAS unsigned char* KT = lds + 18432; LAS unsigned char* VT = lds + 36864;
        LAS float* NP = (LAS float*)(lds + 71680); LAS float* XCH = (LAS float*)(lds + 72192); LAS unsigned char* CP = lds + 72704;
        const int j = lane & 15, g = lane >> 4, qp = j >> 2, p = lane & 3;
        const int tf = wave & 3, eh = wave >> 2;
        for (int u = vcu; u < 512; u += G) {
            const int b = u >> 8, h = (u >> 6) & 3, c = u & 63;
            const int tok = b * SEQ + c * 64 + lane;
            const float li = gli[tok * 4 + h], lf = glf[tok * 4 + h];
            const float cf = scan_add64(lf, lane);
            const float bvec = li - cf;
            const float pm = scan_max64(bvec, lane);
            const float mprev = msc_mp[u];
            const float Mv = fmaxf(mprev, pm);
            const float wiv = __expf(mprev - Mv), emtv = __expf(-cf - Mv);
            {
                const bf16* csrc = kvT + (size_t)u * 256 * 128 + (size_t)(tid >> 4) * 128 + (tid & 15) * 8;
                u32x4 cv[8];
#pragma unroll
                for (int it = 0; it < 8; ++it) cv[it] = *(const u32x4*)(csrc + (size_t)it * 32 * 128);
#pragma unroll
                for (int it = 0; it < 8; ++it) *(LAS u32x4*)(CP + (it * 32 + (tid >> 4)) * 288 + (tid & 15) * 16) = cv[it];
            }
            const int t_ = 16 * (wave & 3) + j;
            const bf16* orow_ = proj + (size_t)(b * SEQ + c * 64 + t_) * NPROJ;
            u32x2 mo_pre[8];
#pragma unroll
            for (int ef = 0; ef < 8; ++ef) mo_pre[ef] = *(const u32x2*)(orow_ + PC_MO + h * 256 + 128 * eh + 16 * ef + 4 * g);
            conv_tile<false>(proj, a.conv_w, a.conv_b, b, c, PC_MQ + h * 128, h * 128, 0.08838834764831845f, 0.f, QT, tid);
            conv_tile<false>(proj, a.conv_w, a.conv_b, b, c, PC_MK + h * 128, 512 + h * 128, 1.0f, 0.f, KT, tid);
            v_tile(proj, b, c, h, VT, tid);
            if (tid < 128) NP[tid] = ncb[u * 128 + tid];
            __syncthreads();
            const int t = 16 * tf + j;
            const float M_t = __shfl(Mv, t), wi_t = __shfl(wiv, t), emt_t = __shfl(emtv, t);
            bf16x8 qf[4];
#pragma unroll
            for (int ks = 0; ks < 4; ++ks) qf[ks] = *(const LAS bf16x8*)(QT + t * 288 + (32 * ks + 8 * g) * 2);
            float sp[4][4]; float rowsum = 0.f;
#pragma unroll
            for (int sf = 0; sf < 4; ++sf) {
                f32x4 sa = {0.f, 0.f, 0.f, 0.f};
#pragma unroll
                for (int ks = 0; ks < 4; ++ks) { const bf16x8 kfr = *(const LAS bf16x8*)(KT + (16 * sf + j) * 288 + (32 * ks + 8 * g) * 2); sa = MFMA16(kfr, qf[ks], sa); }
#pragma unroll
                for (int rg = 0; rg < 4; ++rg) { const int sidx = 16 * sf + 4 * g + rg; const float bs = __shfl(bvec, sidx);
                    const float pv = (sidx <= t) ? __expf(bs - M_t) : 0.f; sp[sf][rg] = sa[rg] * pv; rowsum += sp[sf][rg]; }
            }
            bf16x8 pb[2];
#pragma unroll
            for (int kk = 0; kk < 2; ++kk) { float tmp[8] = {sp[2 * kk][0], sp[2 * kk][1], sp[2 * kk][2], sp[2 * kk][3], sp[2 * kk + 1][0], sp[2 * kk + 1][1], sp[2 * kk + 1][2], sp[2 * kk + 1][3]};
                const u32x4 w = pack8(tmp); pb[kk] = __builtin_bit_cast(bf16x8, w); }
            f32x4 ai[8], ae[8];
#pragma unroll
            for (int ef = 0; ef < 8; ++ef) { ai[ef] = (f32x4){0.f, 0.f, 0.f, 0.f}; ae[ef] = (f32x4){0.f, 0.f, 0.f, 0.f}; }
#pragma unroll
            for (int kk = 0; kk < 2; ++kk) {
#pragma unroll
                for (int ef = 0; ef < 8; ++ef) { const int col = 128 * eh + 16 * ef + 4 * p;
                    const bf16x8 af = cat4(vtr(VT + (32 * kk + 4 * g + qp) * 544 + col * 2), vtr(VT + (32 * kk + 16 + 4 * g + qp) * 544 + col * 2));
                    ai[ef] = MFMA16(af, pb[kk], ai[ef]); }
            }
#pragma unroll
            for (int ef = 0; ef < 8; ++ef) {
#pragma unroll
                for (int ks = 0; ks < 4; ++ks) { const bf16x8 cfr = *(const LAS bf16x8*)(CP + (128 * eh + 16 * ef + j) * 288 + (32 * ks + 8 * g) * 2); ae[ef] = MFMA16(cfr, qf[ks], ae[ef]); }
            }
            float qn = 0.f;
#pragma unroll
            for (int ks = 0; ks < 4; ++ks) { float qv[8]; unpack8(__builtin_bit_cast(u32x4, qf[ks]), qv);
#pragma unroll
                for (int e = 0; e < 8; ++e) qn += qv[e] * NP[32 * ks + 8 * g + e]; }
            qn = xg_sum(qn);
            rowsum = xg_sum(rowsum);
            const float den = wi_t * qn + rowsum;
            const float dinv = __builtin_amdgcn_rcpf(fmaxf(fabsf(den), emt_t));
            float ssq = 0.f;
#pragma unroll
            for (int ef = 0; ef < 8; ++ef) { ai[ef] = (ae[ef] * wi_t + ai[ef]) * dinv; ssq += (ai[ef][0] * ai[ef][0] + ai[ef][1] * ai[ef][1]) + (ai[ef][2] * ai[ef][2] + ai[ef][3] * ai[ef][3]); }
            ssq = xg_sum(ssq);
            if (g == 0) XCH[eh * 64 + t] = ssq;
            __syncthreads();
            const float rn = __builtin_amdgcn_rsqf((XCH[t] + XCH[64 + t]) * (1.0f / 256.0f) + NORM_EPS);
            bf16* orow = proj + (size_t)(b * SEQ + c * 64 + t) * NPROJ;
#pragma unroll
            for (int ef = 0; ef < 8; ++ef) { const int e = 128 * eh + 16 * ef + 4 * g;
                const f32x4 nw = *(const f32x4*)(a.mlstm_norm_w + h * 256 + e);
                const u32x2 mo = mo_pre[ef];
                const float mof[4] = {bf_lo(mo.x), bf_hi(mo.x), bf_lo(mo.y), bf_hi(mo.y)};
                float r4[4];
#pragma unroll
                for (int e2 = 0; e2 < 4; ++e2) r4[e2] = ai[ef][e2] * rn * nw[e2] * __builtin_amdgcn_rcpf(1.0f + __expf(-mof[e2]));
                u32x2 w; w.x = cvtpk(r4[0], r4[1]); w.y = cvtpk(r4[2], r4[3]); if (!dry) *(u32x2*)(orow + PC_MV + h * 256 + e) = w; }
            __syncthreads();
        }
        for (int pidx = vcu; pidx < 256; pidx += G) {
            const AUnit ua{0, (pidx >> 5) & 7, 1, 0, pidx & 31, op0, pl0}, ub{1, (pidx >> 5) & 7, 1, 0, pidx & 31, op0, pl0};
            attn_pair<true>(proj, rcos, rsin, a.q_norm_w, a.attn_norm_w, ua, ub, lds, op1, pl1, tid, dry);
        }
    REP_END
    xcd_barrier(bar);

    REP_BEGIN(6)
        pg8::Gemm g{proj + PC_MV, WoutT, MTOK, DM, DM, NPROJ}; pg8::StaticOrder S; S.init(MTOK, DM, G, bx);
        pg8::EpiRes1 E{a.x, a.out, H1b, sumsq, DM, dry};
        pg8::gemm_phase<pg8::EpiRes1, false>(lds, g, S, E);
    REP_END
    xcd_barrier(bar);

    REP_BEGIN(7)
        pg8::Gemm g{H1b, WguT, MTOK, NGU, DM, DM}; pg8::StaticOrder S; S.init(MTOK, NGU, G, bx);
        LAS float* rsl = (LAS float*)(lds + RING_BYTES);
        { pg8::Unit uu; for (int i = 0; i < 8 && S.next(i, uu); ++i) if (tid < 256) rsl[i * 256 + tid] = __builtin_amdgcn_rsqf(sumsq[uu.pm * 256 + tid] * (1.0f / DM) + NORM_EPS); }
        __syncthreads();
        pg8::EpiSwiGLU E{FF, DFF, rsl, sumsq};
        pg8::gemm_phase<pg8::EpiSwiGLU, true>(lds, g, S, E);
        if (rep_ == 1) {
            const int nfull = (MTOK / 256) * (NGU / 256) - 5 * G;
            const int nidle = G - nfull;
            if (G == 256 ? (bx >= nfull) : true) {
                LAS float* scr = (LAS float*)(lds + wave * 16384);
                constexpr int I_DN = (DFF / 64) * (DM / 32);
                const int w0 = (G == 256) ? (bx - nfull) * NWAVES + wave : gw, nw = (G == 256) ? nidle * NWAVES : NGW;
                for (int it = w0; it < I_DN; it += nw) { const int nblk = DM / 32, kb = it / nblk, nb = it % nblk;
                    const TItem t{a.w_down, WdnT, nullptr, DM, DFF, nb * 32, nb * 32, kb * 64}; f32x4 v[8]; titem_load(t, v, lane); titem_finish(t, v, scr, lane); }
            }
        }
    REP_END
    xcd_barrier(bar);

    REP_BEGIN(8)
        pg8::Gemm g{FF, WdnT, MTOK, DM, DFF, DFF}; pg8::StaticOrder S; S.init(MTOK, DM, G, bx);
        pg8::EpiRes2 E{H1b, a.out, DM, dry};
        pg8::gemm_phase<pg8::EpiRes2, false>(lds, g, S, E);
    REP_END
}

extern "C" void kernel_launch(void* const* d_in, const int* in_sizes, int n_in, void* d_out, int out_size, void* d_ws, size_t ws_size, hipStream_t stream) {
    static int grid = 0;
    if (grid == 0) {
        if (n_in != 16 || in_sizes[0] != MTOK * DM || out_size != MTOK * DM || ws_size < WS_END) { fprintf(stderr, "kernel_launch: unexpected shapes (n_in %d in0 %d out %d ws %zu)\n", n_in, n_in > 0 ? in_sizes[0] : -1, out_size, ws_size); grid = -1; return; }
        int dev = 0, cus = 0;
        if (hipGetDevice(&dev) != hipSuccess || hipDeviceGetAttribute(&cus, hipDeviceAttributeMultiprocessorCount, dev) != hipSuccess || cus <= 0) cus = 256;
        if (hipFuncSetAttribute((const void*)hymba_fwd, hipFuncAttributeMaxDynamicSharedMemorySize, LDS_BYTES) != hipSuccess) { fprintf(stderr, "kernel_launch: hipFuncSetAttribute failed\n"); grid = -1; return; }
        (void)hipGetLastError();
        grid = cus;
    }
    if (grid < 0) return;
    if (hipMemsetAsync((char*)d_ws + WS_CTL, 0, CTL_ZERO_BYTES, stream) != hipSuccess) { fprintf(stderr, "kernel_launch: memset failed\n"); return; }
    Args a{};
    a.x = (const float*)d_in[0]; a.norm1_w = (const float*)d_in[1]; a.w_in = (const float*)d_in[2]; a.conv_w = (const float*)d_in[3]; a.conv_b = (const float*)d_in[4];
    a.igate_b = (const float*)d_in[5]; a.fgate_b = (const float*)d_in[6]; a.q_norm_w = (const float*)d_in[7]; a.k_norm_w = (const float*)d_in[8];
    a.mlstm_norm_w = (const float*)d_in[9]; a.attn_norm_w = (const float*)d_in[10]; a.w_out = (const float*)d_in[11]; a.norm2_w = (const float*)d_in[12];
    a.w_gate = (const float*)d_in[13]; a.w_up = (const float*)d_in[14]; a.w_down = (const float*)d_in[15];
    a.out = (float*)d_out; a.ws = (unsigned char*)d_ws; a.dry = (PROBE_PHASE >= 0) ? 1 : 0;
    hipLaunchKernelGGL(hymba_fwd, dim3(grid), dim3(NWAVES * 64), LDS_BYTES, stream, a);
}
```

```cpp
#include <hip/hip_runtime.h>
#include <cstdio>
#include <cstdint>

#define LAS __attribute__((address_space(3)))
#define GAS __attribute__((address_space(1)))
typedef unsigned short bf16;
typedef short bf16x8 __attribute__((ext_vector_type(8)));
typedef short s16x4 __attribute__((ext_vector_type(4)));
typedef float f32x4 __attribute__((ext_vector_type(4)));
typedef float f32x2 __attribute__((ext_vector_type(2)));
typedef unsigned u32x4 __attribute__((ext_vector_type(4)));
typedef unsigned u32x2 __attribute__((ext_vector_type(2)));
typedef __bf16 bf16x2_t __attribute__((ext_vector_type(2)));

constexpr int BATCH = 2, SEQ = 4096, DM = 2048, MTOK = BATCH * SEQ;
constexpr int INW = 6152, NPROJ = 6144, DFF = 5632, NGU = 2 * DFF;
constexpr int PC_MQ = 0, PC_MK = 512, PC_MO = 1024, PC_MV = 2048, PC_AQ = 3072, PC_AK = 4096, PC_AV = 5120;
constexpr float NORM_EPS = 1e-6f;
constexpr int NWAVES = 8;

constexpr size_t MiB = 1u << 20;
constexpr size_t WS_CTL = 0, CTL_ZERO_BYTES = 32 * 1024;
constexpr size_t WS_GLI = 1 * MiB;
constexpr size_t WS_GLF = WS_GLI + 128 * 1024;
constexpr size_t WS_SUMSQ = WS_GLF + 128 * 1024;
constexpr size_t WS_MSC = WS_SUMSQ + 32 * 1024;
constexpr size_t WS_NC = WS_MSC + 8 * 1024;
constexpr size_t WS_COS = 2 * MiB, WS_SIN = 3 * MiB;
constexpr size_t WS_WIN = 6 * MiB;
constexpr size_t WS_KV = 6 * MiB;
constexpr size_t WS_U = 30 * MiB;
constexpr size_t WS_PROJ = 62 * MiB;
constexpr size_t WS_WOUT = 158 * MiB;
constexpr size_t WS_WGU = 166 * MiB;
constexpr size_t WS_WDN = 210 * MiB;
constexpr size_t WS_OP0 = 38 * MiB;
constexpr size_t WS_OP1 = 232 * MiB;
constexpr size_t WS_PL0 = 248 * MiB, WS_PL1 = WS_PL0 + 256 * 1024;
constexpr size_t WS_END = 249 * MiB;
constexpr int CW_BAR = 4096;

constexpr int RING_BYTES = 131072;
constexpr int MISC_OFF = 147456 - 256;
constexpr int LDS_BYTES = 147456;

__device__ __forceinline__ unsigned cvtpk(float lo, float hi) { f32x2 v = {lo, hi}; bf16x2_t b = __builtin_convertvector(v, bf16x2_t); return __builtin_bit_cast(unsigned, b); }
__device__ __forceinline__ float bf_lo(unsigned w) { return __uint_as_float(w << 16); }
__device__ __forceinline__ float bf_hi(unsigned w) { return __uint_as_float(w & 0xffff0000u); }
__device__ __forceinline__ void unpack8(u32x4 w, float* f) { f[0] = bf_lo(w.x); f[1] = bf_hi(w.x); f[2] = bf_lo(w.y); f[3] = bf_hi(w.y); f[4] = bf_lo(w.z); f[5] = bf_hi(w.z); f[6] = bf_lo(w.w); f[7] = bf_hi(w.w); }
__device__ __forceinline__ u32x4 pack8(const float* f) { u32x4 w; w.x = cvtpk(f[0], f[1]); w.y = cvtpk(f[2], f[3]); w.z = cvtpk(f[4], f[5]); w.w = cvtpk(f[6], f[7]); return w; }
#define DPP_MOV_F(v, ctrl) __uint_as_float((unsigned)__builtin_amdgcn_mov_dpp((int)__float_as_uint(v), (ctrl), 0xf, 0xf, true))
__device__ __forceinline__ float row16_sum(float v) { v += DPP_MOV_F(v, 0xB1); v += DPP_MOV_F(v, 0x4E); v += DPP_MOV_F(v, 0x124); v += DPP_MOV_F(v, 0x128); return v; }
__device__ __forceinline__ float x16_sum(float v) { const auto r = __builtin_amdgcn_permlane16_swap(__float_as_uint(v), __float_as_uint(v), false, false); return __uint_as_float(r[0]) + __uint_as_float(r[1]); }
__device__ __forceinline__ float x32_sum(float v) { const auto r = __builtin_amdgcn_permlane32_swap(__float_as_uint(v), __float_as_uint(v), false, false); return __uint_as_float(r[0]) + __uint_as_float(r[1]); }
__device__ __forceinline__ float x16_max(float v) { const auto r = __builtin_amdgcn_permlane16_swap(__float_as_uint(v), __float_as_uint(v), false, false); return fmaxf(__uint_as_float(r[0]), __uint_as_float(r[1])); }
__device__ __forceinline__ float x32_max(float v) { const auto r = __builtin_amdgcn_permlane32_swap(__float_as_uint(v), __float_as_uint(v), false, false); return fmaxf(__uint_as_float(r[0]), __uint_as_float(r[1])); }
__device__ __forceinline__ float xg_sum(float v) { return x32_sum(x16_sum(v)); }
__device__ __forceinline__ float xg_max(float v) { return x32_max(x16_max(v)); }
__device__ __forceinline__ float wave_sum(float v) { return xg_sum(row16_sum(v)); }
__device__ __forceinline__ float wave_max(float v) {
#pragma unroll
    for (int o = 1; o < 64; o <<= 1) v = fmaxf(v, __shfl_xor(v, o));
    return v;
}
__device__ __forceinline__ s16x4 vtr(const LAS unsigned char* p) { return __builtin_bit_cast(s16x4, __builtin_amdgcn_ds_read_tr16_b64_v4i16((LAS s16x4*)p)); }
__device__ __forceinline__ bf16x8 cat4(s16x4 a, s16x4 b) { return (bf16x8){a[0], a[1], a[2], a[3], b[0], b[1], b[2], b[3]}; }
#define LDS_WAIT() asm volatile("s_waitcnt lgkmcnt(0)" ::: "memory")
#define VM_WAIT() asm volatile("s_waitcnt vmcnt(0)" ::: "memory")
#define SBAR() __builtin_amdgcn_sched_barrier(0)
#define MFMA16(a, b, c) __builtin_amdgcn_mfma_f32_16x16x32_bf16((a), (b), (c), 0, 0, 0)

namespace pg8 {
constexpr int BM = 256, BK = 64, HALF = 128, HTB = HALF * BK * 2, STAGE_BYTES = 8 * HTB, NXCD = 8, WGM = 8;
__host__ __device__ __forceinline__ int lds_byte(int r, int c) { const int st = (r >> 4) * 2 + (c >> 5), rr = r & 15, cc = c & 31, ob = rr * 64 + cc * 2; return st * 1024 + (ob ^ (((ob >> 9) & 1) << 5)); }
__host__ __device__ __forceinline__ void stage_rc(int b, int& R, int& C) { const int st = b / 1024, sb = b % 1024, swz = sb ^ (((sb >> 9) & 1) << 5); R = (st >> 1) * 16 + swz / 64; C = (st & 1) * 32 + (swz % 64) / 2; }
__host__ __device__ __forceinline__ int perm32(int rho) { const int n = rho >> 4, i = rho & 15; return 8 * (i >> 2) + 4 * n + (i & 3); }
struct Unit { int pm, pn, ord; };
struct Gemm { const bf16* A; const bf16* Bt; int M, N, K, lda; };
struct StaticOrder {
    int nM, nN, nwg, G, c;
    __device__ void init(int M, int N, int G_, int c_) { nM = M / BM; nN = N / BM; nwg = nM * nN; G = G_; c = c_; }
    __device__ bool next(int i, Unit& u) const {
        const long L = (long)i * G + c; if (L >= nwg) return false; u.ord = i;
        int wgid = (int)L; { const int q = nwg / NXCD, r = nwg % NXCD, xcd = wgid % NXCD, off = wgid / NXCD; wgid = (xcd < r ? xcd * (q + 1) : r * (q + 1) + (xcd - r) * q) + off; }
        const int nig = WGM * nN, gid = wgid / nig, fm = gid * WGM, gsz = (nM - fm) < WGM ? (nM - fm) : WGM;
        u.pm = fm + ((wgid % nig) % gsz); u.pn = (wgid % nig) / gsz; return true;
    }
};
struct EpiBf16 {
    static constexpr bool PERM = true, HAS_INIT = false;
    bf16* O; int ldc;
    __device__ __forceinline__ void operator()(const f32x4 (&acc)[2][2][4][2], const Unit& u, int wr, int wc, int fr, int fq) const {
        const int row0 = u.pm * BM + wr * 64 + fr, col0 = u.pn * BM + wc * 32 + 8 * fq;
#pragma unroll
        for (int ai = 0; ai < 2; ++ai)
#pragma unroll
            for (int m = 0; m < 4; ++m) { bf16* rowp = O + (size_t)(row0 + ai * HALF + m * 16) * ldc + col0;
#pragma unroll
                for (int bj = 0; bj < 2; ++bj) { const f32x4 v0 = acc[ai][bj][m][0], v1 = acc[ai][bj][m][1];
                    u32x4 w; w.x = cvtpk(v0[0], v0[1]); w.y = cvtpk(v0[2], v0[3]); w.z = cvtpk(v1[0], v1[1]); w.w = cvtpk(v1[2], v1[3]);
                    *(u32x4*)(rowp + bj * HALF) = w; } }
    }
};
struct EpiRes1 {
    static constexpr bool PERM = false, HAS_INIT = true;
    const float* xres; float* out; bf16* h1b; float* sumsq; int ldc; bool dry;
    __device__ __forceinline__ void init(f32x4 (&acc)[2][2][4][2], const Unit& u, int wr, int wc, int fr, int fq) const {
        const int col0 = u.pn * BM + wc * 32 + 4 * fq;
#pragma unroll
        for (int ai = 0; ai < 2; ++ai)
#pragma unroll
            for (int m = 0; m < 4; ++m) { const size_t off = (size_t)(u.pm * BM + ai * HALF + wr * 64 + m * 16 + fr) * ldc + col0;
#pragma unroll
                for (int bj = 0; bj < 2; ++bj)
#pragma unroll
                    for (int n = 0; n < 2; ++n) acc[ai][bj][m][n] = __builtin_nontemporal_load((const f32x4*)(xres + off + bj * HALF + n * 16)); }
    }
    __device__ __forceinline__ void operator()(const f32x4 (&acc)[2][2][4][2], const Unit& u, int wr, int wc, int fr, int fq) const {
        const int col0 = u.pn * BM + wc * 32 + 4 * fq;
#pragma unroll
        for (int ai = 0; ai < 2; ++ai)
#pragma unroll
            for (int m = 0; m < 4; ++m) { const int row = u.pm * BM + ai * HALF + wr * 64 + m * 16 + fr; const size_t off = (size_t)row * ldc + col0; float ss = 0.f;
#pragma unroll
                for (int bj = 0; bj < 2; ++bj)
#pragma unroll
                    for (int n = 0; n < 2; ++n) { const size_t o2 = off + bj * HALF + n * 16; const f32x4 h = acc[ai][bj][m][n];
                        u32x2 w; w.x = cvtpk(h[0], h[1]); w.y = cvtpk(h[2], h[3]); if (!dry) { *(u32x2*)(h1b + o2) = w; }
                        ss += (h[0] * h[0] + h[1] * h[1]) + (h[2] * h[2] + h[3] * h[3]); }
                ss = xg_sum(ss);
                if (fq == 0 && !dry) atomicAdd(sumsq + row, ss); }
    }
};
struct EpiSwiGLU {
    static constexpr bool PERM = true, HAS_INIT = false;
    bf16* O; int ldc; const LAS float* rsl; const float* sumsq;
    __device__ __forceinline__ void operator()(const f32x4 (&acc)[2][2][4][2], const Unit& u, int wr, int wc, int fr, int fq) const {
        const int col0 = u.pn * HALF + wc * 32 + 8 * fq;
#pragma unroll
        for (int ai = 0; ai < 2; ++ai)
#pragma unroll
            for (int m = 0; m < 4; ++m) { const int rl = ai * HALF + wr * 64 + m * 16 + fr; const int row = u.pm * BM + rl;
                const float rs = (u.ord < 8) ? rsl[u.ord * 256 + rl] : __builtin_amdgcn_rsqf(sumsq[row] * (1.0f / DM) + NORM_EPS);
                float f[8];
#pragma unroll
                for (int n = 0; n < 2; ++n)
#pragma unroll
                    for (int j = 0; j < 4; ++j) { const float g = acc[ai][0][m][n][j] * rs, up = acc[ai][1][m][n][j] * rs; f[n * 4 + j] = g * __builtin_amdgcn_rcpf(1.0f + __expf(-g)) * up; }
                *(u32x4*)(O + (size_t)row * ldc + col0) = pack8(f); }
    }
};
struct EpiRes2 {
    static constexpr bool PERM = false, HAS_INIT = true;
    const bf16* h1b; float* out; int ldc; bool dry;
    __device__ __forceinline__ void init(f32x4 (&acc)[2][2][4][2], const Unit& u, int wr, int wc, int fr, int fq) const {
        const int col0 = u.pn * BM + wc * 32 + 4 * fq;
#pragma unroll
        for (int ai = 0; ai < 2; ++ai)
#pragma unroll
            for (int m = 0; m < 4; ++m) { const size_t off = (size_t)(u.pm * BM + ai * HALF + wr * 64 + m * 16 + fr) * ldc + col0;
#pragma unroll
                for (int bj = 0; bj < 2; ++bj)
#pragma unroll
                    for (int n = 0; n < 2; ++n) { const u32x2 w = __builtin_nontemporal_load((const u32x2*)(h1b + off + bj * HALF + n * 16)); acc[ai][bj][m][n] = (f32x4){bf_lo(w.x), bf_hi(w.x), bf_lo(w.y), bf_hi(w.y)}; } }
    }
    __device__ __forceinline__ void operator()(const f32x4 (&acc)[2][2][4][2], const Unit& u, int wr, int wc, int fr, int fq) const {
        const int col0 = u.pn * BM + wc * 32 + 4 * fq;
#pragma unroll
        for (int ai = 0; ai < 2; ++ai)
#pragma unroll
            for (int m = 0; m < 4; ++m) { const size_t off = (size_t)(u.pm * BM + ai * HALF + wr * 64 + m * 16 + fr) * ldc + col0;
#pragma unroll
                for (int bj = 0; bj < 2; ++bj)
#pragma unroll
                    for (int n = 0; n < 2; ++n) { if (!dry) __builtin_nontemporal_store(acc[ai][bj][m][n], (f32x4*)(out + off + bj * HALF + n * 16)); } }
    }
};

template <class Epi, bool ALIGN_EPI>
__device__ __forceinline__ void gemm_phase(LAS unsigned char* lds, const Gemm g, const StaticOrder& S, const Epi& E) {
    int tid = threadIdx.x; asm volatile("" : "+v"(tid));
    const int wid = __builtin_amdgcn_readfirstlane(tid >> 6), lane = tid & 63, wr = wid >> 2, wc = wid & 3, fr = lane & 15, fq = lane >> 4;
    const int K = g.K, nt = K / BK;
    unsigned voffA[2], voffB[2];
#pragma unroll
    for (int i = 0; i < 2; ++i) { int R, C; stage_rc(tid * 16 + i * 8192, R, C); const int Rb = Epi::PERM ? ((R & ~31) + perm32(R & 31)) : R;
        voffA[i] = (unsigned)(R * g.lda + C) * 2u; voffB[i] = (unsigned)(Rb * K + C) * 2u; }
    const size_t kstep = (size_t)(BK * 2);
    const size_t hstepA = (size_t)HALF * g.lda * 2, hstepB = (size_t)HALF * K * 2;
    const size_t tstepA = 2 * hstepA, tstepB = 2 * hstepB;
    const unsigned ldsw = (unsigned)wid * 1024u;
    const int aoff = lds_byte(wr * 64 + fr, fq * 8), boff = lds_byte(wc * 32 + fr, fq * 8);
#define PG8_SA(b, h) (((b) * 2 + (h)) * HTB)
#define PG8_SB(b, h) ((4 + (b) * 2 + (h)) * HTB)
#define PG8_STAGE(bufoff, gbase, voff) do { _Pragma("unroll") for (int _i = 0; _i < 2; ++_i) \
        __builtin_amdgcn_global_load_lds((const unsigned*)((const char*)(gbase) + (voff)[_i]), (LAS unsigned*)(lds + (bufoff) + ldsw + _i * 8192), 16, 0, 0); } while (0)
#define PG8_LDA(dst, b, h) do { _Pragma("unroll") for (int m = 0; m < 4; ++m) _Pragma("unroll") for (int k = 0; k < 2; ++k) dst[m][k] = *(const LAS bf16x8*)(lds + PG8_SA(b, h) + aoff + m * 2048 + k * 1024); } while (0)
#define PG8_LDB(dst, b, h) do { _Pragma("unroll") for (int n = 0; n < 2; ++n) _Pragma("unroll") for (int k = 0; k < 2; ++k) dst[n][k] = *(const LAS bf16x8*)(lds + PG8_SB(b, h) + boff + n * 2048 + k * 1024); } while (0)
#define PG8_MMA(ai, bj, At, Bt) do { __builtin_amdgcn_s_setprio(1); _Pragma("unroll") for (int m = 0; m < 4; ++m) _Pragma("unroll") for (int n = 0; n < 2; ++n) _Pragma("unroll") for (int k = 0; k < 2; ++k) \
        acc[ai][bj][m][n] = __builtin_amdgcn_mfma_f32_16x16x32_bf16(Bt[n][k], At[m][k], acc[ai][bj][m][n], 0, 0, 0); __builtin_amdgcn_s_setprio(0); } while (0)
#define PG8_WAIT_V(n) asm volatile("s_waitcnt vmcnt(" #n ")" ::: "memory")
#define PG8_WAIT_L(n) asm volatile("s_waitcnt lgkmcnt(" #n ")" ::: "memory")
#define PG8_BAR __builtin_amdgcn_s_barrier()
#define PG8_SCHED __builtin_amdgcn_sched_barrier(0)
    Unit cur, nxt; int ui = 0;
    if (!S.next(0, cur)) return;
    f32x4 acc[2][2][4][2];
    if constexpr (Epi::HAS_INIT) { E.init(acc, cur, wr, wc, fr, fq); }
    else {
#pragma unroll
    for (int a = 0; a < 2; ++a)
#pragma unroll
        for (int b = 0; b < 2; ++b)
#pragma unroll
            for (int m = 0; m < 4; ++m)
#pragma unroll
                for (int n = 0; n < 2; ++n) acc[a][b][m][n] = (f32x4){0.f, 0.f, 0.f, 0.f};
    }
    bf16x8 At[4][2], B0[2][2], B1[2][2];
    const char* cA = (const char*)g.A + (size_t)cur.pm * tstepA; const char* cB = (const char*)g.Bt + (size_t)cur.pn * tstepB;
    PG8_STAGE(PG8_SB(0, 0), cB, voffB); PG8_STAGE(PG8_SB(0, 1), cB + hstepB, voffB); PG8_STAGE(PG8_SA(0, 0), cA, voffA); PG8_STAGE(PG8_SA(0, 1), cA + hstepA, voffA);
    if (wr == 1) PG8_BAR;
    PG8_WAIT_V(2); PG8_BAR;
    PG8_STAGE(PG8_SB(1, 0), cB + kstep, voffB); PG8_STAGE(PG8_SA(1, 0), cA + kstep, voffA); PG8_STAGE(PG8_SB(1, 1), cB + hstepB + kstep, voffB);
    PG8_WAIT_V(6); PG8_BAR;
    for (;;) {
        const bool has_next = S.next(ui + 1, nxt);
        const char* nA = has_next ? (const char*)g.A + (size_t)nxt.pm * tstepA : cA; const char* nB = has_next ? (const char*)g.Bt + (size_t)nxt.pn * tstepB : cB;
        for (int t = 0; t < nt; t += 2) {
            const bool last = (t == nt - 2);
            const char* a1 = cA + (size_t)(t + 1) * kstep;
            const char* a2 = last ? nA : cA + (size_t)(t + 2) * kstep; const char* b2 = last ? nB : cB + (size_t)(t + 2) * kstep;
            const char* a3 = a2 + kstep; const char* b3 = b2 + kstep;
            PG8_LDB(B0, 0, 0); PG8_LDB(B1, 0, 1); PG8_SCHED; PG8_LDA(At, 0, 0); PG8_STAGE(PG8_SA(1, 1), a1 + hstepA, voffA);
            PG8_WAIT_V(8); PG8_WAIT_L(0); PG8_BAR; PG8_MMA(0, 0, At, B0); PG8_MMA(0, 1, At, B1); PG8_BAR; PG8_SCHED;
            PG8_LDA(At, 0, 1); PG8_STAGE(PG8_SB(0, 0), b2, voffB); PG8_STAGE(PG8_SB(0, 1), b2 + hstepB, voffB); PG8_STAGE(PG8_SA(0, 0), a2, voffA);
            PG8_WAIT_V(8); PG8_WAIT_L(0); PG8_BAR; PG8_MMA(1, 0, At, B0); PG8_MMA(1, 1, At, B1); PG8_BAR; PG8_SCHED;
            PG8_LDB(B0, 1, 0); PG8_LDB(B1, 1, 1); PG8_SCHED; PG8_LDA(At, 1, 0); PG8_STAGE(PG8_SA(0, 1), a2 + hstepA, voffA);
            PG8_WAIT_V(8); PG8_WAIT_L(0); PG8_BAR; PG8_MMA(0, 0, At, B0); PG8_MMA(0, 1, At, B1); PG8_BAR; PG8_SCHED;
            PG8_LDA(At, 1, 1); PG8_STAGE(PG8_SB(1, 0), b3, voffB); PG8_STAGE(PG8_SB(1, 1), b3 + hstepB, voffB); PG8_STAGE(PG8_SA(1, 0), a3, voffA);
            PG8_WAIT_V(8); PG8_WAIT_L(0); PG8_BAR; PG8_MMA(1, 0, At, B0); PG8_MMA(1, 1, At, B1); PG8_BAR; PG8_SCHED;
        }
        if constexpr (ALIGN_EPI) { if (wr == 0) PG8_BAR; }
        E(acc, cur, wr, wc, fr, fq);
        if (!has_next) break;
        if constexpr (Epi::HAS_INIT) { E.init(acc, nxt, wr, wc, fr, fq); }
        else {
#pragma unroll
        for (int a = 0; a < 2; ++a)
#pragma unroll
            for (int b = 0; b < 2; ++b)
#pragma unroll
                for (int m = 0; m < 4; ++m)
#pragma unroll
                    for (int n = 0; n < 2; ++n) acc[a][b][m][n] = (f32x4){0.f, 0.f, 0.f, 0.f};
        }
        cur = nxt; cA = nA; cB = nB; ++ui;
        if constexpr (ALIGN_EPI) { if (wr == 1) PG8_BAR; }
    }
    PG8_WAIT_V(0);
    if constexpr (!ALIGN_EPI) { if (wr == 0) PG8_BAR; }
    PG8_BAR;
#undef PG8_SA
#undef PG8_SB
#undef PG8_STAGE
#undef PG8_LDA
#undef PG8_LDB
#undef PG8_MMA
#undef PG8_WAIT_V
#undef PG8_WAIT_L
#undef PG8_BAR
#undef PG8_SCHED
}
}

#define XB_TMO      128
#define XB_XCNT(j)  (256  + 64 * (j))
#define XB_XSUB(j)  (1280 + 64 * (j))
#define XB_XGEN(j)  (2304 + 64 * (j))
#define XB_TOP      3328
#define XB_TOPGEN   3392
#define XCD_BAR_WORDS 3456
#define XB_SPIN_CAP (1u << 18)
__device__ __forceinline__ unsigned xb_ld(unsigned* p)              { return __hip_atomic_load(p, __ATOMIC_RELAXED, __HIP_MEMORY_SCOPE_AGENT); }
__device__ __forceinline__ unsigned xb_add(unsigned* p, unsigned v) { return __hip_atomic_fetch_add(p, v, __ATOMIC_RELAXED, __HIP_MEMORY_SCOPE_AGENT); }
__device__ __forceinline__ unsigned xb_xcc_id() { return (unsigned)__builtin_amdgcn_s_getreg((3 << 11) | 20) & 0xFu; }
#define XB_SPIN(cond, bar) do { unsigned _sp = 0; while (cond) { __builtin_amdgcn_s_sleep(1); \
    if ((++_sp & 255u) == 0u) { if (xb_ld(&(bar)[XB_TMO])) break; if (_sp > XB_SPIN_CAP) { atomicAdd(&(bar)[XB_TMO], 1u); break; } } } } while (0)
struct XcdBarrier { unsigned* bar; unsigned x; volatile LAS unsigned* st; };
__device__ __forceinline__ XcdBarrier xcd_barrier_post(unsigned* bar, volatile LAS unsigned* st) {
    XcdBarrier b; b.bar = bar; b.x = xb_xcc_id(); b.st = st;
    if (threadIdx.x == 0) (void)xb_add(&bar[XB_XCNT(b.x)], 1u);
    return b;
}
__device__ __forceinline__ void xcd_barrier_complete(unsigned* bar, unsigned x, unsigned& nloc, unsigned& nx) {
    const unsigned G = gridDim.x * gridDim.y * gridDim.z;
    unsigned sum, cnt, mine, sp = 0u;
    for (;;) {
        sum = 0u; cnt = 0u; mine = 0u;
#pragma unroll
        for (unsigned j = 0; j < 16; ++j) { const unsigned c = xb_ld(&bar[XB_XCNT(j)]); sum += c; cnt += (c > 0u) ? 1u : 0u; mine = (j == x) ? c : mine; }
        if (sum == G) break;
        __builtin_amdgcn_s_sleep(1);
        if ((++sp & 255u) == 0u) { if (xb_ld(&bar[XB_TMO])) break; if (sp > XB_SPIN_CAP) { atomicAdd(&bar[XB_TMO], 1u); break; } }
    }
    nloc = mine > 0u ? mine : 1u; nx = cnt > 0u ? cnt : 1u;
}
__device__ __forceinline__ void xcd_barrier(const XcdBarrier& b) {
    asm volatile("s_waitcnt vmcnt(0)" ::: "memory");
    __syncthreads();
    if (threadIdx.x == 0) {
        unsigned* bar = b.bar;
        __builtin_amdgcn_s_waitcnt(0);
        unsigned nloc = b.st[0], nx = b.st[1];
        if (nloc == 0u) { xcd_barrier_complete(bar, b.x, nloc, nx); b.st[0] = nloc; b.st[1] = nx; }
        const unsigned old = xb_add(&bar[XB_XSUB(b.x)], 1u);
        const unsigned gen = old / nloc;
        if (old + 1u == (gen + 1u) * nloc) {
            __builtin_amdgcn_fence(__ATOMIC_RELEASE, "agent");
            asm volatile("s_waitcnt vmcnt(0)" ::: "memory");
            const unsigned og = xb_add(&bar[XB_TOP], 1u);
            const unsigned tg = og / nx;
            if (og + 1u == (tg + 1u) * nx) xb_add(&bar[XB_TOPGEN], 1u);
            else XB_SPIN(xb_ld(&bar[XB_TOPGEN]) == tg, bar);
            __builtin_amdgcn_fence(__ATOMIC_ACQUIRE, "agent");
            xb_add(&bar[XB_XGEN(b.x)], 1u);
            asm volatile("s_waitcnt vmcnt(0)" ::: "memory");
        } else {
            XB_SPIN(xb_ld(&bar[XB_XGEN(b.x)]) == gen, bar);
            __builtin_amdgcn_fence(__ATOMIC_ACQUIRE, "agent");
            asm volatile("s_waitcnt vmcnt(0)" ::: "memory");
        }
    }
    __syncthreads();
}

struct Args {
    const float* x; const float* norm1_w; const float* w_in; const float* conv_w; const float* conv_b; const float* igate_b; const float* fgate_b;
    const float* q_norm_w; const float* k_norm_w; const float* mlstm_norm_w; const float* attn_norm_w; const float* w_out; const float* norm2_w;
    const float* w_gate; const float* w_up; const float* w_down;
    float* out; unsigned char* ws; int dry; int pad;
};

struct TItem { const float* W; bf16* WT; const float* kscale; int ldw, K, nsrc0, ndst0, k0; };
__device__ __forceinline__ void titem_load(const TItem& t, f32x4 (&v)[8], int lane) {
    const float* src = t.W + (size_t)(t.k0 + (lane >> 3)) * t.ldw + t.nsrc0 + (lane & 7) * 4;
#pragma unroll
    for (int i = 0; i < 8; ++i) v[i] = __builtin_nontemporal_load((const f32x4*)(src + (size_t)(8 * i) * t.ldw));
}
__device__ __forceinline__ void titem_finish(const TItem& t, const f32x4 (&v)[8], LAS float* scr, int lane) {
#pragma unroll
    for (int i = 0; i < 8; ++i) { const int kk = 8 * i + (lane >> 3); const float sc = t.kscale ? t.kscale[t.k0 + kk] : 1.0f; LAS float* d = scr + kk * 33 + (lane & 7) * 4;
        d[0] = v[i][0] * sc; d[1] = v[i][1] * sc; d[2] = v[i][2] * sc; d[3] = v[i][3] * sc; }
    LDS_WAIT(); asm volatile("" ::: "memory");
    const int c = lane & 7;
#pragma unroll
    for (int j = 0; j < 4; ++j) { const int n = (lane >> 3) + 8 * j; const LAS float* s = scr + (8 * c) * 33 + n;
        u32x4 o; o.x = cvtpk(s[0 * 33], s[1 * 33]); o.y = cvtpk(s[2 * 33], s[3 * 33]); o.z = cvtpk(s[4 * 33], s[5 * 33]); o.w = cvtpk(s[6 * 33], s[7 * 33]);
        *(u32x4*)(t.WT + (size_t)(t.ndst0 + n) * t.K + t.k0 + 8 * c) = o; }
    LDS_WAIT(); asm volatile("" ::: "memory");
}
__device__ __forceinline__ int win_src_col(int nd) {
    if (nd < 1024) return nd;
    if (nd < 2048) return nd + 1024;
    if (nd < 3072) return nd - 1024;
    return nd + 8;
}


__device__ __forceinline__ float scan_add64(float v, int lane) {
#pragma unroll
    for (int o = 1; o < 64; o <<= 1) { const float t = __shfl_up(v, o); if (lane >= o) v += t; }
    return v;
}
__device__ __forceinline__ float scan_max64(float v, int lane) {
#pragma unroll
    for (int o = 1; o < 64; o <<= 1) { const float t = __shfl_up(v, o); if (lane >= o) v = fmaxf(v, t); }
    return v;
}
template <bool ROWW>
__device__ __forceinline__ void conv_tile(const bf16* proj, const float* conv_w, const float* conv_b, int b, int c, int col0, int ch0, float rscale, float wlane, LAS unsigned char* tile, int tid) {
    const int rr = tid >> 4, cc = (tid & 15) * 8;
    float w[4][8], bb[8];
#pragma unroll
    for (int j = 0; j < 4; ++j) { const f32x4 w0 = *(const f32x4*)(conv_w + j * 1024 + ch0 + cc), w1 = *(const f32x4*)(conv_w + j * 1024 + ch0 + cc + 4);
        w[j][0] = w0[0]; w[j][1] = w0[1]; w[j][2] = w0[2]; w[j][3] = w0[3]; w[j][4] = w1[0]; w[j][5] = w1[1]; w[j][6] = w1[2]; w[j][7] = w1[3]; }
    { const f32x4 b0 = *(const f32x4*)(conv_b + ch0 + cc), b1 = *(const f32x4*)(conv_b + ch0 + cc + 4);
      bb[0] = b0[0]; bb[1] = b0[1]; bb[2] = b0[2]; bb[3] = b0[3]; bb[4] = b1[0]; bb[5] = b1[1]; bb[6] = b1[2]; bb[7] = b1[3]; }
#pragma unroll
    for (int half = 0; half < 2; ++half) {
        const int l = rr + 32 * half, t = c * 64 + l;
        float y[8];
#pragma unroll
        for (int e = 0; e < 8; ++e) y[e] = bb[e];
#pragma unroll
        for (int j = 0; j < 4; ++j) { const int tt = t - 3 + j;
            if (tt >= 0) { const u32x4 raw = *(const u32x4*)(proj + (size_t)(b * SEQ + tt) * NPROJ + col0 + cc); float x[8]; unpack8(raw, x);
#pragma unroll
                for (int e = 0; e < 8; ++e) y[e] += w[j][e] * x[e]; } }
        float sc = rscale;
        if (ROWW) sc *= __shfl(wlane, l);
#pragma unroll
        for (int e = 0; e < 8; ++e) y[e] = y[e] * __builtin_amdgcn_rcpf(1.0f + __expf(-y[e])) * sc;
        *(LAS u32x4*)(tile + l * 288 + cc * 2) = pack8(y);
    }
}
__device__ __forceinline__ void v_tile(const bf16* proj, int b, int c, int h, LAS unsigned char* tile, int tid) {
#pragma unroll
    for (int p = 0; p < 4; ++p) { const int row = p * 16 + (tid >> 5), ch = tid & 31;
        const u32x4 v = *(const u32x4*)(proj + (size_t)(b * SEQ + c * 64 + row) * NPROJ + PC_MV + h * 256 + ch * 8);
        *(LAS u32x4*)(tile + row * 544 + ch * 16) = v; }
}

__device__ __forceinline__ void q_prep(const bf16* qrow, const float* rcos, const float* rsin, const float* qnw, int tq, int g, bf16x8 (&qf)[4]) {
    float q[4][8]; float ss = 0.f;
#pragma unroll
    for (int ks = 0; ks < 4; ++ks) { const u32x4 raw = *(const u32x4*)(qrow + 32 * ks + 8 * g); unpack8(raw, q[ks]);
#pragma unroll
        for (int e = 0; e < 8; ++e) ss += q[ks][e] * q[ks][e]; }
    ss = xg_sum(ss);
    const float rq = __builtin_amdgcn_rsqf(ss * (1.0f / 128.0f) + NORM_EPS);
#pragma unroll
    for (int ks = 0; ks < 2; ++ks) {
        const int c0 = 32 * ks + 8 * g;
#pragma unroll
        for (int e4 = 0; e4 < 2; ++e4) {
            const f32x4 cs = *(const f32x4*)(rcos + tq * 64 + c0 + 4 * e4), sn = *(const f32x4*)(rsin + tq * 64 + c0 + 4 * e4);
            const f32x4 w1 = *(const f32x4*)(qnw + c0 + 4 * e4), w2 = *(const f32x4*)(qnw + 64 + c0 + 4 * e4);
#pragma unroll
            for (int e = 0; e < 4; ++e) { const float y1 = q[ks][4 * e4 + e] * rq * w1[e], y2 = q[ks + 2][4 * e4 + e] * rq * w2[e];
                q[ks][4 * e4 + e] = y1 * cs[e] - y2 * sn[e]; q[ks + 2][4 * e4 + e] = y2 * cs[e] + y1 * sn[e]; }
        }
    }
#pragma unroll
    for (int ks = 0; ks < 4; ++ks) { const u32x4 w = pack8(q[ks]); qf[ks] = __builtin_bit_cast(bf16x8, w); }
}
struct AUnit { int b, h, d, r, n; bf16* po0; float* pl0; };
template <bool FINAL>
__device__ __forceinline__ void attn_pair(bf16* proj, const float* rcos, const float* rsin, const float* qnw, const float* anw, const AUnit& ua, const AUnit& ub,
                                          LAS unsigned char* lds_all, bf16* po1, float* pl1, int tid_in, bool dry) {
    int tid = tid_in; asm volatile("" : "+v"(tid));
    const int lane = tid & 63, wave = __builtin_amdgcn_readfirstlane(tid >> 6);
    const int team = wave >> 2, w4 = wave & 3;
    const int b = team ? ub.b : ua.b, h = team ? ub.h : ua.h, d = team ? ub.d : ua.d, r = team ? ub.r : ua.r, n = team ? ub.n : ua.n;
    bf16* po0 = team ? ub.po0 : ua.po0; float* pl0 = team ? ub.pl0 : ua.pl0;
    LAS unsigned char* lds = lds_all + team * 36864;
    const int j = lane & 15, g = lane >> 4, qp = j >> 2, p = lane & 3;
    const int tt = tid & 255, srow = tt >> 4, sch = tt & 15;
    const bf16* kcol = proj + (size_t)b * SEQ * NPROJ + PC_AK + h * 128 + sch * 8;
    const bf16* vcol = kcol + (PC_AV - PC_AK);
    const int kt0 = (n == 0) ? 4 : 0;
    const int sub0 = 128 * (n - 1) + srow;
    u32x4 rk[2][2], rv[2][2];
#define AT_ISSUE(set, t) do { if ((t) < 8) { _Pragma("unroll") for (int hh_ = 0; hh_ < 2; ++hh_) { const size_t tok_ = (size_t)((sub0 + 32 * (t) + 16 * hh_) * d + r); \
        rk[set][hh_] = *(const u32x4*)(kcol + tok_ * NPROJ); rv[set][hh_] = *(const u32x4*)(vcol + tok_ * NPROJ); } } } while (0)
#define AT_WRITE(set, t) do { LAS unsigned char* Kn_ = lds + ((t) & 1) * 18432; _Pragma("unroll") for (int hh_ = 0; hh_ < 2; ++hh_) { \
        *(LAS u32x4*)(Kn_ + (srow + 16 * hh_) * 288 + sch * 16) = rk[set][hh_]; *(LAS u32x4*)(Kn_ + 9216 + (srow + 16 * hh_) * 288 + sch * 16) = rv[set][hh_]; } } while (0)
#define WG_BAR() do { asm volatile("s_waitcnt lgkmcnt(0)" ::: "memory"); __builtin_amdgcn_s_barrier(); asm volatile("" ::: "memory"); } while (0)
    AT_ISSUE(0, kt0); AT_ISSUE(1, kt0 + 1);
    bf16x8 qf[2][4]; int qi[2]; int tq[2];
    const int G0 = w4, G1 = 7 - w4;
    qi[0] = 16 * G0 + j; qi[1] = 16 * G1 + j; tq[0] = (128 * n + qi[0]) * d + r; tq[1] = (128 * n + qi[1]) * d + r;
    const int lo0 = G0 >> 1, lo1 = G1 >> 1;
#pragma unroll
    for (int gi = 0; gi < 2; ++gi) { const bf16* qrow = proj + (size_t)(b * SEQ + tq[gi]) * NPROJ + PC_AQ + h * 128 + 8 * g;
#pragma unroll
        for (int ks = 0; ks < 4; ++ks) qf[gi][ks] = *(const bf16x8*)(qrow + 32 * ks); }
    AT_WRITE(0, kt0);
    for (int kb_ = 0; kb_ < kt0; ++kb_) WG_BAR();
    WG_BAR();
    float m_run[2] = {-1e30f, -1e30f}, l_run[2] = {0.f, 0.f};
    f32x4 o[2][8];
    if (FINAL) {
#pragma unroll
        for (int gi = 0; gi < 2; ++gi) { const size_t trow = (size_t)(b * SEQ + tq[gi]);
            const float l0 = pl0[trow * 8 + h], l1 = pl1[trow * 8 + h]; const float m0 = fmaxf(l0, l1);
            const float a0 = __builtin_amdgcn_exp2f(l0 - m0), a1 = __builtin_amdgcn_exp2f(l1 - m0);
            m_run[gi] = m0; l_run[gi] = (g == 0) ? a0 + a1 : 0.f;
            const bf16* p0 = po0 + trow * 1024 + h * 128 + g * 8; const bf16* p1 = po1 + trow * 1024 + h * 128 + g * 8;
#pragma unroll
            for (int np = 0; np < 4; ++np) { const u32x4 x0 = *(const u32x4*)(p0 + 32 * np), x1 = *(const u32x4*)(p1 + 32 * np); float f0[8], f1[8]; unpack8(x0, f0); unpack8(x1, f1);
#pragma unroll
                for (int e = 0; e < 4; ++e) { o[gi][2 * np][e] = a0 * f0[e] + a1 * f1[e]; o[gi][2 * np + 1][e] = a0 * f0[4 + e] + a1 * f1[4 + e]; } }
        }
    } else {
#pragma unroll
        for (int gi = 0; gi < 2; ++gi)
#pragma unroll
            for (int nf = 0; nf < 8; ++nf) o[gi][nf] = (f32x4){0.f, 0.f, 0.f, 0.f};
    }
    const float SC = 0.08838834764831845f * 1.4426950408889634f;
    const float NEG = -__builtin_inff();
#define AT_SM(gi, kt, s0, s1) do { \
                float x[8]; float tmax = NEG; \
                _Pragma("unroll") for (int e = 0; e < 8; ++e) { const int kj = 32 * (kt) + 16 * (e >> 2) + 4 * g + (e & 3); const float sv = (e < 4) ? s0[e & 3] : s1[e & 3]; \
                    const bool valid = (kj >= qi[gi]) && (kj <= qi[gi] + 128); \
                    x[e] = valid ? sv * SC : NEG; tmax = fmaxf(tmax, x[e]); } \
                tmax = xg_max(tmax); \
                const float m_new = fmaxf(m_run[gi], tmax); \
                const float alpha = __builtin_amdgcn_exp2f(m_run[gi] - m_new); \
                float ps = 0.f; \
                _Pragma("unroll") for (int e = 0; e < 8; ++e) { x[e] = __builtin_amdgcn_exp2f(x[e] - m_new); ps += x[e]; } \
                l_run[gi] = l_run[gi] * alpha + ps; m_run[gi] = m_new; \
                _Pragma("unroll") for (int nf = 0; nf < 8; ++nf) o[gi][nf] = o[gi][nf] * alpha; \
                const u32x4 pw = pack8(x); pb[gi] = __builtin_bit_cast(bf16x8, pw); } while (0)
#define AT_ONE(gi, kt) do { \
            f32x4 sA = {0.f, 0.f, 0.f, 0.f}, sB = {0.f, 0.f, 0.f, 0.f}; \
            _Pragma("unroll") for (int ks = 0; ks < 4; ++ks) { \
                const bf16x8 k0 = *(const LAS bf16x8*)(Kt + j * 288 + (32 * ks + 8 * g) * 2), k1 = *(const LAS bf16x8*)(Kt + (16 + j) * 288 + (32 * ks + 8 * g) * 2); \
                sA = MFMA16(k0, qf[gi][ks], sA); sB = MFMA16(k1, qf[gi][ks], sB); } \
            bf16x8 pb[2]; AT_SM(gi, kt, sA, sB); \
            _Pragma("unroll") for (int nf = 0; nf < 8; ++nf) { \
                const s16x4 a0 = vtr(Vt + (4 * g + qp) * 288 + (16 * nf + 4 * p) * 2), a1 = vtr(Vt + (16 + 4 * g + qp) * 288 + (16 * nf + 4 * p) * 2); \
                o[gi][nf] = MFMA16(cat4(a0, a1), pb[gi], o[gi][nf]); } } while (0)
#define AT_STEP(kt, setn, setw) do { \
        LAS unsigned char* Kt = lds + ((kt) & 1) * 18432; LAS unsigned char* Vt = Kt + 9216; \
        AT_ISSUE(setn, (kt) + 2); \
        const bool act0 = (kt) >= lo0 && (kt) <= lo0 + 4, act1 = (kt) >= lo1 && (kt) <= lo1 + 4; \
        if (act0 && act1) { \
            f32x4 sA[2], sB[2]; sA[0] = (f32x4){0.f, 0.f, 0.f, 0.f}; sA[1] = sA[0]; sB[0] = sA[0]; sB[1] = sA[0]; \
            _Pragma("unroll") for (int ks = 0; ks < 4; ++ks) { \
                const bf16x8 k0 = *(const LAS bf16x8*)(Kt + j * 288 + (32 * ks + 8 * g) * 2), k1 = *(const LAS bf16x8*)(Kt + (16 + j) * 288 + (32 * ks + 8 * g) * 2); \
                sA[0] = MFMA16(k0, qf[0][ks], sA[0]); sB[0] = MFMA16(k1, qf[0][ks], sB[0]); sA[1] = MFMA16(k0, qf[1][ks], sA[1]); sB[1] = MFMA16(k1, qf[1][ks], sB[1]); } \
            bf16x8 pb[2]; \
            AT_SM(0, kt, sA[0], sB[0]); AT_SM(1, kt, sA[1], sB[1]); \
            _Pragma("unroll") for (int nf = 0; nf < 8; ++nf) { \
                const s16x4 a0 = vtr(Vt + (4 * g + qp) * 288 + (16 * nf + 4 * p) * 2), a1 = vtr(Vt + (16 + 4 * g + qp) * 288 + (16 * nf + 4 * p) * 2); \
                const bf16x8 vf = cat4(a0, a1); \
                o[0][nf] = MFMA16(vf, pb[0], o[0][nf]); o[1][nf] = MFMA16(vf, pb[1], o[1][nf]); } \
        } else if (act0) { AT_ONE(0, kt); } else if (act1) { AT_ONE(1, kt); } \
        if ((kt) + 1 < 8) AT_WRITE(setw, (kt) + 1); \
        WG_BAR(); } while (0)
#pragma unroll 1
    for (int kt = kt0; kt < 8; kt += 2) { AT_STEP(kt, 0, 1); AT_STEP(kt + 1, 1, 0); }
#undef AT_STEP
#undef AT_ONE
#undef AT_SM
#undef AT_ISSUE
#undef AT_WRITE
#pragma unroll
    for (int gi = 0; gi < 2; ++gi) {
        float lr = l_run[gi]; lr = xg_sum(lr);
        const float inv = __builtin_amdgcn_rcpf(lr);
        const float lse2 = m_run[gi] + __log2f(lr);
        const size_t trow = (size_t)(b * SEQ + tq[gi]);
        if (!FINAL) {
            bf16* pp = po0 + trow * 1024 + h * 128 + g * 8;
#pragma unroll
            for (int np = 0; np < 4; ++np) { const f32x4 va = o[gi][2 * np] * inv, vb = o[gi][2 * np + 1] * inv; u32x4 ww; ww.x = cvtpk(va[0], va[1]); ww.y = cvtpk(va[2], va[3]); ww.z = cvtpk(vb[0], vb[1]); ww.w = cvtpk(vb[2], vb[3]);
                if (!dry) *(u32x4*)(pp + 32 * np) = ww; }
            if (g == 0 && !dry) pl0[trow * 8 + h] = lse2;
        } else {
            bf16* qrow = proj + trow * NPROJ + PC_AQ + h * 128;
            float ss = 0.f;
#pragma unroll
            for (int nf = 0; nf < 8; ++nf) { const f32x4 v = o[gi][nf] * inv; o[gi][nf] = v; ss += (v[0] * v[0] + v[1] * v[1]) + (v[2] * v[2] + v[3] * v[3]); }
            ss = xg_sum(ss);
            const float rn = __builtin_amdgcn_rsqf(ss * (1.0f / 128.0f) + NORM_EPS);
#pragma unroll
            for (int nf = 0; nf < 8; ++nf) { const int e = 16 * nf + 4 * g; const f32x4 w = *(const f32x4*)(anw + h * 128 + e); const f32x4 v = o[gi][nf] * rn * w;
                u32x2 ww; ww.x = cvtpk(v[0], v[1]); ww.y = cvtpk(v[2], v[3]); if (!dry) *(u32x2*)(qrow + e) = ww; }
        }
    }
}

#ifndef PROBE_PHASE
#define PROBE_PHASE -1
#endif
#define REP_BEGIN(k) for (int rep_ = (PROBE_PHASE == (k)) ? 0 : 1; rep_ < 2; ++rep_) { const bool dry = (rep_ == 0) && (a.dry != 0); (void)dry; \
    int tid = threadIdx.x; asm volatile("" : "+v"(tid)); const int lane = tid & 63, wave = __builtin_amdgcn_readfirstlane(tid >> 6); \
    const int gw = vcu * NWAVES + wave, gt = vcu * (NWAVES * 64) + tid; (void)lane; (void)wave; (void)gw; (void)gt;
#define REP_END }

__global__ void __launch_bounds__(NWAVES * 64, 2) hymba_fwd(Args a) {
    extern __shared__ __attribute__((aligned(16))) unsigned char lds_raw[];
    LAS unsigned char* lds = (LAS unsigned char*)lds_raw;
    volatile LAS unsigned* MISC = (volatile LAS unsigned*)(lds + MISC_OFF);
    const int tid = threadIdx.x, lane = tid & 63, wave = __builtin_amdgcn_readfirstlane(tid >> 6);
    const int G = gridDim.x; const int bx = blockIdx.x; const int vcu = (G % 8 == 0) ? (bx % 8) * (G / 8) + bx / 8 : bx;
    unsigned char* ws = a.ws;
    unsigned* ctl = (unsigned*)(ws + WS_CTL);
    float* gli = (float*)(ws + WS_GLI); float* glf = (float*)(ws + WS_GLF); float* sumsq = (float*)(ws + WS_SUMSQ);
    float* msc_g = (float*)(ws + WS_MSC); float* msc_ml = msc_g + 512; float* msc_mp = msc_g + 1024;
    float* ncb = (float*)(ws + WS_NC);
    float* rcos = (float*)(ws + WS_COS); float* rsin = (float*)(ws + WS_SIN);
    bf16* WinT = (bf16*)(ws + WS_WIN); bf16* kvT = (bf16*)(ws + WS_KV); bf16* Ub = (bf16*)(ws + WS_U); bf16* H1b = (bf16*)(ws + WS_U);
    bf16* proj = (bf16*)(ws + WS_PROJ); bf16* FF = (bf16*)(ws + WS_PROJ);
    bf16* op0 = (bf16*)(ws + WS_OP0); bf16* op1 = (bf16*)(ws + WS_OP1); float* pl0 = (float*)(ws + WS_PL0); float* pl1 = (float*)(ws + WS_PL1);
    bf16* WoutT = (bf16*)(ws + WS_WOUT); bf16* WguT = (bf16*)(ws + WS_WGU); bf16* WdnT = (bf16*)(ws + WS_WDN);

    for (int u = tid; u < (LDS_BYTES - MISC_OFF) / 4; u += NWAVES * 64) ((LAS unsigned*)(lds + MISC_OFF))[u] = 0u;
    __syncthreads();
    XcdBarrier bar = xcd_barrier_post(ctl + CW_BAR, MISC + 8);
    const int NGW = G * NWAVES, NGT = G * NWAVES * 64;

    REP_BEGIN(0)
        for (int i = gt; i < MTOK; i += NGT) sumsq[i] = 0.f;
        for (int i = gt; i < SEQ * 64; i += NGT) {
            const int pos = i >> 6, fi = i & 63;
            const float invf = (float)exp2(-(double)fi * (13.287712379549449 / 64.0));
            const float ang = (float)pos * invf;
            const double rev = (double)ang * 0.15915494309189535; const double fr_ = rev - rint(rev);
            const float ar = (float)(fr_ * 6.283185307179586);
            rcos[i] = cosf(ar); rsin[i] = sinf(ar);
        }
        {
            LAS float* scr = (LAS float*)(lds + wave * 16384);
            constexpr int I_IN = (DM / 64) * (NPROJ / 32), I_OUT = (DM / 64) * (DM / 32), I_GU = (DM / 64) * (NGU / 32), I_DN = (DFF / 64) * (DM / 32);
            constexpr int NITEMS = I_IN + I_OUT + I_GU;
            auto decode = [&](int it) -> TItem {
                TItem t; int r = it;
                if (r < I_IN) { const int nblk = NPROJ / 32, kb = r / nblk, nb = r % nblk; t = TItem{a.w_in, WinT, nullptr, INW, DM, win_src_col(nb * 32), nb * 32, kb * 64}; return t; } r -= I_IN;
                if (r < I_OUT) { const int nblk = DM / 32, kb = r / nblk, nb = r % nblk; t = TItem{a.w_out, WoutT, nullptr, DM, DM, nb * 32, nb * 32, kb * 64}; return t; } r -= I_OUT;
                { const int nblk = NGU / 32, kb = r / nblk, nb = r % nblk; const int nd = nb * 32, pn = nd >> 8, j = nd & 255;
                    t = TItem{(j < 128) ? a.w_gate : a.w_up, WguT, a.norm2_w, DFF, DM, pn * 128 + (j & 127), nd, kb * 64}; return t; }
            };
            int it = gw;
            if (it < NITEMS) {
                TItem cur = decode(it); f32x4 vc[8]; titem_load(cur, vc, lane);
                for (;;) {
                    const int nx = it + NGW; const bool more = nx < NITEMS;
                    TItem nt = cur; f32x4 vn[8];
                    if (more) { nt = decode(nx); titem_load(nt, vn, lane); }
                    titem_finish(cur, vc, scr, lane);
                    if (!more) break;
                    cur = nt; it = nx;
#pragma unroll
                    for (int i = 0; i < 8; ++i) vc[i] = vn[i];
                }
            }
        }
        __syncthreads();
        LAS float* wg = (LAS float*)lds;
        for (int k = tid; k < DM; k += NWAVES * 64) { const f32x4 g0 = *(const f32x4*)(a.w_in + (size_t)k * INW + 3072), g1 = *(const f32x4*)(a.w_in + (size_t)k * INW + 3076);
            wg[0 * DM + k] = g0[0]; wg[1 * DM + k] = g0[1]; wg[2 * DM + k] = g0[2]; wg[3 * DM + k] = g0[3];
            wg[4 * DM + k] = g1[0]; wg[5 * DM + k] = g1[1]; wg[6 * DM + k] = g1[2]; wg[7 * DM + k] = g1[3]; }
        __syncthreads();
        for (int m = gw; m < MTOK; m += NGW) {
            const f32x4* xr = (const f32x4*)(a.x + (size_t)m * DM) + lane; const f32x4* wr_ = (const f32x4*)a.norm1_w + lane;
            f32x4 v[8]; float s = 0.f;
#pragma unroll
            for (int j = 0; j < 8; ++j) { v[j] = __builtin_nontemporal_load(xr + 64 * j); s += (v[j][0] * v[j][0] + v[j][1] * v[j][1]) + (v[j][2] * v[j][2] + v[j][3] * v[j][3]); }
            const float rstd = __builtin_amdgcn_rsqf(wave_sum(s) * (1.0f / DM) + NORM_EPS);
            u32x2* o8 = (u32x2*)(Ub + (size_t)m * DM) + lane;
#pragma unroll
            for (int j = 0; j < 8; ++j) { v[j] = v[j] * rstd * wr_[64 * j]; u32x2 w; w.x = cvtpk(v[j][0], v[j][1]); w.y = cvtpk(v[j][2], v[j][3]); o8[64 * j] = w; }
            float z = 0.f;
#pragma unroll 1
            for (int gi = 0; gi < 8; ++gi) { float t = 0.f;
#pragma unroll
                for (int j = 0; j < 8; ++j) { const f32x4 w4 = *(const LAS f32x4*)(wg + gi * DM + 256 * j + 4 * lane); t += (v[j][0] * w4[0] + v[j][1] * w4[1]) + (v[j][2] * w4[2] + v[j][3] * w4[3]); }
                t = wave_sum(t); z = (lane == gi) ? t : z; }
            if (lane < 8) {
                const int hh = lane & 3;
                if (lane < 4) { gli[m * 4 + hh] = 15.0f * tanhf((z + a.igate_b[hh]) * (1.0f / 15.0f)); }
                else { const float fp = 15.0f * tanhf((z + a.fgate_b[hh]) * (1.0f / 15.0f)); glf[m * 4 + hh] = -log1pf(expf(-fp)); }
            }
        }
    REP_END
    xcd_barrier(bar);

    REP_BEGIN(1)
        pg8::Gemm g{Ub, WinT, MTOK, NPROJ, DM, DM}; pg8::StaticOrder S; S.init(MTOK, NPROJ, G, bx);
        pg8::EpiBf16 E{proj, NPROJ};
        pg8::gemm_phase<pg8::EpiBf16, true>(lds, g, S, E);
    REP_END
    xcd_barrier(bar);

    REP_BEGIN(2)
        {
            const int c0 = 4 * (tid & 15), rstride = NGT >> 4;
            for (int which = 0; which < 2; ++which) {
                const float* nw = which ? a.k_norm_w : a.q_norm_w; const int colb = which ? PC_AK : PC_AQ;
                const f32x4 w1 = *(const f32x4*)(nw + c0), w2 = *(const f32x4*)(nw + 64 + c0);
                for (int idx0 = gt >> 4; idx0 < MTOK * 8; idx0 += 4 * rstride) {
                    u32x2 r1[4], r2[4]; f32x4 cs[4], sn[4];
#pragma unroll
                    for (int q = 0; q < 4; ++q) { const int idx = idx0 + q * rstride;
                        if (idx < MTOK * 8) { const int m = idx >> 3, hh = idx & 7, pos = m & (SEQ - 1); const bf16* kp = proj + (size_t)m * NPROJ + colb + hh * 128;
                            r1[q] = *(const u32x2*)(kp + c0); r2[q] = *(const u32x2*)(kp + 64 + c0); cs[q] = *(const f32x4*)(rcos + pos * 64 + c0); sn[q] = *(const f32x4*)(rsin + pos * 64 + c0); } }
#pragma unroll
                    for (int q = 0; q < 4; ++q) { const int idx = idx0 + q * rstride;
                        if (idx < MTOK * 8) { const int m = idx >> 3, hh = idx & 7; bf16* kp = proj + (size_t)m * NPROJ + colb + hh * 128;
                            float x1[4] = {bf_lo(r1[q].x), bf_hi(r1[q].x), bf_lo(r1[q].y), bf_hi(r1[q].y)}, x2[4] = {bf_lo(r2[q].x), bf_hi(r2[q].x), bf_lo(r2[q].y), bf_hi(r2[q].y)};
                            float ss = 0.f;
#pragma unroll
                            for (int e = 0; e < 4; ++e) ss += x1[e] * x1[e] + x2[e] * x2[e];
                            ss = row16_sum(ss);
                            const float rk = __builtin_amdgcn_rsqf(ss * (1.0f / 128.0f) + NORM_EPS);
                            float o1[4], o2[4];
#pragma unroll
                            for (int e = 0; e < 4; ++e) { const float y1 = x1[e] * rk * w1[e], y2 = x2[e] * rk * w2[e]; o1[e] = y1 * cs[q][e] - y2 * sn[q][e]; o2[e] = y2 * cs[q][e] + y1 * sn[q][e]; }
                            u32x2 wv; wv.x = cvtpk(o1[0], o1[1]); wv.y = cvtpk(o1[2], o1[3]); if (!dry) *(u32x2*)(kp + c0) = wv;
                            wv.x = cvtpk(o2[0], o2[1]); wv.y = cvtpk(o2[2], o2[3]); if (!dry) *(u32x2*)(kp + 64 + c0) = wv; } }
                }
            }
        }
        LAS unsigned char* KW = lds; LAS unsigned char* VT = lds + 18432;
        const int g = lane >> 4, qp = (lane & 15) >> 2, p = lane & 3;
        for (int u = vcu; u < 512; u += G) {
            const int b = u >> 8, h = (u >> 6) & 3, c = u & 63;
            const int tok = b * SEQ + c * 64 + lane;
            const float li = gli[tok * 4 + h], lf = glf[tok * 4 + h];
            const float cf = scan_add64(lf, lane);
            const float gsum = __shfl(cf, 63);
            const float av = gsum - cf + li;
            const float ml = wave_max(av);
            const float wst = __expf(av - ml);
            if (tid == 0) { msc_g[u] = gsum; msc_ml[u] = ml; }
            conv_tile<true>(proj, a.conv_w, a.conv_b, b, c, PC_MK + h * 128, 512 + h * 128, 1.0f, wst, KW, tid);
            v_tile(proj, b, c, h, VT, tid);
            __syncthreads();
            f32x4 acc[8][2];
#pragma unroll
            for (int df = 0; df < 8; ++df) { acc[df][0] = (f32x4){0.f, 0.f, 0.f, 0.f}; acc[df][1] = (f32x4){0.f, 0.f, 0.f, 0.f}; }
#pragma unroll
            for (int kk = 0; kk < 2; ++kk) {
                bf16x8 bfr[2];
#pragma unroll
                for (int ef = 0; ef < 2; ++ef) { const int col = 32 * wave + 16 * ef + 4 * p;
                    bfr[ef] = cat4(vtr(VT + (32 * kk + 4 * g + qp) * 544 + col * 2), vtr(VT + (32 * kk + 16 + 4 * g + qp) * 544 + col * 2)); }
#pragma unroll
                for (int df = 0; df < 8; ++df) { const int col = 16 * df + 4 * p;
                    const bf16x8 af = cat4(vtr(KW + (32 * kk + 4 * g + qp) * 288 + col * 2), vtr(KW + (32 * kk + 16 + 4 * g + qp) * 288 + col * 2));
                    acc[df][0] = MFMA16(af, bfr[0], acc[df][0]); acc[df][1] = MFMA16(af, bfr[1], acc[df][1]); }
            }
#pragma unroll
            for (int ef = 0; ef < 2; ++ef) { const int e = 32 * wave + 16 * ef + (lane & 15);
#pragma unroll
                for (int df = 0; df < 8; ++df) { const f32x4 v = acc[df][ef]; u32x2 w; w.x = cvtpk(v[0], v[1]); w.y = cvtpk(v[2], v[3]);
                    *(u32x2*)(kvT + ((size_t)u * 256 + e) * 128 + 16 * df + 4 * g) = w; } }
            if (tid < 128) { float nsum = 0.f;
#pragma unroll 8
                for (int l = 0; l < 64; ++l) nsum += __uint_as_float((unsigned)(*(const LAS unsigned short*)(KW + l * 288 + tid * 2)) << 16);
                ncb[u * 128 + tid] = nsum; }
            __syncthreads();
        }
    REP_END
    xcd_barrier(bar);

    REP_BEGIN(3)
        LAS float* sg = (LAS float*)lds; LAS float* sml = sg + 512;
        for (int i = tid; i < 512; i += NWAVES * 64) { sg[i] = msc_g[i]; sml[i] = msc_ml[i]; }
        __syncthreads();
        for (int id = gt; id < 8 * 16384; id += NGT) {
            const int bh = id >> 14, pi = id & 16383;
            unsigned* base = (unsigned*)kvT + (size_t)bh * 64 * 16384 + pi;
            float c0 = 0.f, c1 = 0.f, m = 0.f;
#pragma unroll 1
            for (int cb = 0; cb < 64; cb += 32) {
                unsigned xv[32];
#pragma unroll
                for (int i = 0; i < 32; ++i) xv[i] = base[(size_t)(cb + i) * 16384];
#pragma unroll
                for (int i = 0; i < 32; ++i) {
                    const float gg = sg[bh * 64 + cb + i], ml = sml[bh * 64 + cb + i];
                    const float mn = fmaxf(gg + m, ml), so = __expf(gg + m - mn), sn = __expf(ml - mn);
                    if (!dry) base[(size_t)(cb + i) * 16384] = cvtpk(c0, c1);
                    c0 = so * c0 + sn * bf_lo(xv[i]); c1 = so * c1 + sn * bf_hi(xv[i]); m = mn;
                }
            }
        }
        for (int id = gt; id < 8 * 128; id += NGT) {
            const int bh = id >> 7, dd = id & 127; float n = 0.f, m = 0.f;
            float* nb_ = ncb + (size_t)bh * 64 * 128 + dd;
#pragma unroll 1
            for (int cb = 0; cb < 64; cb += 32) {
                float xv[32];
#pragma unroll
                for (int i = 0; i < 32; ++i) xv[i] = nb_[(cb + i) * 128];
#pragma unroll
                for (int i = 0; i < 32; ++i) {
                    const float gg = sg[bh * 64 + cb + i], ml = sml[bh * 64 + cb + i];
                    const float mn = fmaxf(gg + m, ml), so = __expf(gg + m - mn), sn = __expf(ml - mn);
                    if (!dry) nb_[(cb + i) * 128] = n;
                    if (dd == 0) msc_mp[bh * 64 + cb + i] = m;
                    n = so * n + sn * xv[i]; m = mn;
                }
            }
        }
        __syncthreads();
    REP_END
    REP_BEGIN(4)
        for (int pidx = vcu; pidx < 512; pidx += G) {
            AUnit ua, ub;
            { const int u = pidx; ua = AUnit{u >> 8, (u >> 5) & 7, 4, (u >> 3) & 3, u & 7, op0, pl0}; }
            { const int v = pidx; const int bb = v >> 8; ub = AUnit{bb, (v >> 5) & 7, 16, (v >> 1) & 15, (v ^ bb) & 1, op1, pl1}; }
            attn_pair<false>(proj, rcos, rsin, a.q_norm_w, a.attn_norm_w, ua, ub, lds, nullptr, nullptr, tid, dry);
        }
    REP_END
    xcd_barrier(bar);

    REP_BEGIN(5)
        LAS unsigned char* QT = lds; LAS unsigned char* KT = lds + 18432; LAS unsigned char* VT = lds + 36864;
        LAS float* NP = (LAS float*)(lds + 71680); LAS float* XCH = (LAS float*)(lds + 72192); LAS unsigned char* CP = lds + 72704;
        const int j = lane & 15, g = lane >> 4, qp = j >> 2, p = lane & 3;
        const int tf = wave & 3, eh = wave >> 2;
        for (int u = vcu; u < 512; u += G) {
            const int b = u >> 8, h = (u >> 6) & 3, c = u & 63;
            const int tok = b * SEQ + c * 64 + lane;
            const float li = gli[tok * 4 + h], lf = glf[tok * 4 + h];
            const float cf = scan_add64(lf, lane);
            const float bvec = li - cf;
            const float pm = scan_max64(bvec, lane);
            const float mprev = msc_mp[u];
            const float Mv = fmaxf(mprev, pm);
            const float wiv = __expf(mprev - Mv), emtv = __expf(-cf - Mv);
            {
                const bf16* csrc = kvT + (size_t)u * 256 * 128 + (size_t)(tid >> 4) * 128 + (tid & 15) * 8;
                u32x4 cv[8];
#pragma unroll
                for (int it = 0; it < 8; ++it) cv[it] = *(const u32x4*)(csrc + (size_t)it * 32 * 128);
#pragma unroll
                for (int it = 0; it < 8; ++it) *(LAS u32x4*)(CP + (it * 32 + (tid >> 4)) * 288 + (tid & 15) * 16) = cv[it];
            }
            const int t_ = 16 * (wave & 3) + j;
            const bf16* orow_ = proj + (size_t)(b * SEQ + c * 64 + t_) * NPROJ;
            u32x2 mo_pre[8];
#pragma unroll
            for (int ef = 0; ef < 8; ++ef) mo_pre[ef] = *(const u32x2*)(orow_ + PC_MO + h * 256 + 128 * eh + 16 * ef + 4 * g);
            conv_tile<false>(proj, a.conv_w, a.conv_b, b, c, PC_MQ + h * 128, h * 128, 0.08838834764831845f, 0.f, QT, tid);
            conv_tile<false>(proj, a.conv_w, a.conv_b, b, c, PC_MK + h * 128, 512 + h * 128, 1.0f, 0.f, KT, tid);
            v_tile(proj, b, c, h, VT, tid);
            if (tid < 128) NP[tid] = ncb[u * 128 + tid];
            __syncthreads();
            const int t = 16 * tf + j;
            const float M_t = __shfl(Mv, t), wi_t = __shfl(wiv, t), emt_t = __shfl(emtv, t);
            bf16x8 qf[4];
#pragma unroll
            for (int ks = 0; ks < 4; ++ks) qf[ks] = *(const LAS bf16x8*)(QT + t * 288 + (32 * ks + 8 * g) * 2);
            float sp[4][4]; float rowsum = 0.f;
#pragma unroll
            for (int sf = 0; sf < 4; ++sf) {
                f32x4 sa = {0.f, 0.f, 0.f, 0.f};
#pragma unroll
                for (int ks = 0; ks < 4; ++ks) { const bf16x8 kfr = *(const LAS bf16x8*)(KT + (16 * sf + j) * 288 + (32 * ks + 8 * g) * 2); sa = MFMA16(kfr, qf[ks], sa); }
#pragma unroll
                for (int rg = 0; rg < 4; ++rg) { const int sidx = 16 * sf + 4 * g + rg; const float bs = __shfl(bvec, sidx);
                    const float pv = (sidx <= t) ? __expf(bs - M_t) : 0.f; sp[sf][rg] = sa[rg] * pv; rowsum += sp[sf][rg]; }
            }
            bf16x8 pb[2];
#pragma unroll
            for (int kk = 0; kk < 2; ++kk) { float tmp[8] = {sp[2 * kk][0], sp[2 * kk][1], sp[2 * kk][2], sp[2 * kk][3], sp[2 * kk + 1][0], sp[2 * kk + 1][1], sp[2 * kk + 1][2], sp[2 * kk + 1][3]};
                const u32x4 w = pack8(tmp); pb[kk] = __builtin_bit_cast(bf16x8, w); }
            f32x4 ai[8], ae[8];
#pragma unroll
            for (int ef = 0; ef < 8; ++ef) { ai[ef] = (f32x4){0.f, 0.f, 0.f, 0.f}; ae[ef] = (f32x4){0.f, 0.f, 0.f, 0.f}; }
#pragma unroll
            for (int kk = 0; kk < 2; ++kk) {
#pragma unroll
                for (int ef = 0; ef < 8; ++ef) { const int col = 128 * eh + 16 * ef + 4 * p;
                    const bf16x8 af = cat4(vtr(VT + (32 * kk + 4 * g + qp) * 544 + col * 2), vtr(VT + (32 * kk + 16 + 4 * g + qp) * 544 + col * 2));
                    ai[ef] = MFMA16(af, pb[kk], ai[ef]); }
            }
#pragma unroll
            for (int ef = 0; ef < 8; ++ef) {
#pragma unroll
                for (int ks = 0; ks < 4; ++ks) { const bf16x8 cfr = *(const LAS bf16x8*)(CP + (128 * eh + 16 * ef + j) * 288 + (32 * ks + 8 * g) * 2); ae[ef] = MFMA16(cfr, qf[ks], ae[ef]); }
            }
            float qn = 0.f;
#pragma unroll
            for (int ks = 0; ks < 4; ++ks) { float qv[8]; unpack8(__builtin_bit_cast(u32x4, qf[ks]), qv);
#pragma unroll
                for (int e = 0; e < 8; ++e) qn += qv[e] * NP[32 * ks + 8 * g + e]; }
            qn = xg_sum(qn);
            rowsum = xg_sum(rowsum);
            const float den = wi_t * qn + rowsum;
            const float dinv = __builtin_amdgcn_rcpf(fmaxf(fabsf(den), emt_t));
            float ssq = 0.f;
#pragma unroll
            for (int ef = 0; ef < 8; ++ef) { ai[ef] = (ae[ef] * wi_t + ai[ef]) * dinv; ssq += (ai[ef][0] * ai[ef][0] + ai[ef][1] * ai[ef][1]) + (ai[ef][2] * ai[ef][2] + ai[ef][3] * ai[ef][3]); }
            ssq = xg_sum(ssq);
            if (g == 0) XCH[eh * 64 + t] = ssq;
            __syncthreads();
            const float rn = __builtin_amdgcn_rsqf((XCH[t] + XCH[64 + t]) * (1.0f / 256.0f) + NORM_EPS);
            bf16* orow = proj + (size_t)(b * SEQ + c * 64 + t) * NPROJ;
#pragma unroll
            for (int ef = 0; ef < 8; ++ef) { const int e = 128 * eh + 16 * ef + 4 * g;
                const f32x4 nw = *(const f32x4*)(a.mlstm_norm_w + h * 256 + e);
                const u32x2 mo = mo_pre[ef];
                const float mof[4] = {bf_lo(mo.x), bf_hi(mo.x), bf_lo(mo.y), bf_hi(mo.y)};
                float r4[4];
#pragma unroll
                for (int e2 = 0; e2 < 4; ++e2) r4[e2] = ai[ef][e2] * rn * nw[e2] * __builtin_amdgcn_rcpf(1.0f + __expf(-mof[e2]));
                u32x2 w; w.x = cvtpk(r4[0], r4[1]); w.y = cvtpk(r4[2], r4[3]); if (!dry) *(u32x2*)(orow + PC_MV + h * 256 + e) = w; }
            __syncthreads();
        }
        for (int pidx = vcu; pidx < 256; pidx += G) {
            const AUnit ua{0, (pidx >> 5) & 7, 1, 0, pidx & 31, op0, pl0}, ub{1, (pidx >> 5) & 7, 1, 0, pidx & 31, op0, pl0};
            attn_pair<true>(proj, rcos, rsin, a.q_norm_w, a.attn_norm_w, ua, ub, lds, op1, pl1, tid, dry);
        }
    REP_END
    xcd_barrier(bar);

    REP_BEGIN(6)
        pg8::Gemm g{proj + PC_MV, WoutT, MTOK, DM, DM, NPROJ}; pg8::StaticOrder S; S.init(MTOK, DM, G, bx);
        pg8::EpiRes1 E{a.x, a.out, H1b, sumsq, DM, dry};
        pg8::gemm_phase<pg8::EpiRes1, false>(lds, g, S, E);
    REP_END
    xcd_barrier(bar);

    REP_BEGIN(7)
        pg8::Gemm g{H1b, WguT, MTOK, NGU, DM, DM}; pg8::StaticOrder S; S.init(MTOK, NGU, G, bx);
        LAS float* rsl = (LAS float*)(lds + RING_BYTES);
        { pg8::Unit uu; for (int i = 0; i < 8 && S.next(i, uu); ++i) if (tid < 256) rsl[i * 256 + tid] = __builtin_amdgcn_rsqf(sumsq[uu.pm * 256 + tid] * (1.0f / DM) + NORM_EPS); }
        __syncthreads();
        pg8::EpiSwiGLU E{FF, DFF, rsl, sumsq};
        pg8::gemm_phase<pg8::EpiSwiGLU, true>(lds, g, S, E);
        if (rep_ == 1) {
            const int nfull = (MTOK / 256) * (NGU / 256) - 5 * G;
            const int nidle = G - nfull;
            if (G == 256 ? (bx >= nfull) : true) {
                LAS float* scr = (LAS float*)(lds + wave * 16384);
                constexpr int I_DN = (DFF / 64) * (DM / 32);
                const int w0 = (G == 256) ? (bx - nfull) * NWAVES + wave : gw, nw = (G == 256) ? nidle * NWAVES : NGW;
                for (int it = w0; it < I_DN; it += nw) { const int nblk = DM / 32, kb = it / nblk, nb = it % nblk;
                    const TItem t{a.w_down, WdnT, nullptr, DM, DFF, nb * 32, nb * 32, kb * 64}; f32x4 v[8]; titem_load(t, v, lane); titem_finish(t, v, scr, lane); }
            }
        }
    REP_END
    xcd_barrier(bar);

    REP_BEGIN(8)
        pg8::Gemm g{FF, WdnT, MTOK, DM, DFF, DFF}; pg8::StaticOrder S; S.init(MTOK, DM, G, bx);
        pg8::EpiRes2 E{H1b, a.out, DM, dry};
        pg8::gemm_phase<pg8::EpiRes2, false>(lds, g, S, E);
    REP_END
}

extern "C" void kernel_launch(void* const* d_in, const int* in_sizes, int n_in, void* d_out, int out_size, void* d_ws, size_t ws_size, hipStream_t stream) {
    static int grid = 0;
    if (grid == 0) {
        if (n_in != 16 || in_sizes[0] != MTOK * DM || out_size != MTOK * DM || ws_size < WS_END) { fprintf(stderr, "kernel_launch: unexpected shapes (n_in %d in0 %d out %d ws %zu)\n", n_in, n_in > 0 ? in_sizes[0] : -1, out_size, ws_size); grid = -1; return; }
        int dev = 0, cus = 0;
        if (hipGetDevice(&dev) != hipSuccess || hipDeviceGetAttribute(&cus, hipDeviceAttributeMultiprocessorCount, dev) != hipSuccess || cus <= 0) cus = 256;
        if (hipFuncSetAttribute((const void*)hymba_fwd, hipFuncAttributeMaxDynamicSharedMemorySize, LDS_BYTES) != hipSuccess) { fprintf(stderr, "kernel_launch: hipFuncSetAttribute failed\n"); grid = -1; return; }
        (void)hipGetLastError();
        grid = cus;
    }
    if (grid < 0) return;
    if (hipMemsetAsync((char*)d_ws + WS_CTL, 0, CTL_ZERO_BYTES, stream) != hipSuccess) { fprintf(stderr, "kernel_launch: memset failed\n"); return; }
    Args a{};
    a.x = (const float*)d_in[0]; a.norm1_w = (const float*)d_in[1]; a.w_in = (const float*)d_in[2]; a.conv_w = (const float*)d_in[3]; a.conv_b = (const float*)d_in[4];
    a.igate_b = (const float*)d_in[5]; a.fgate_b = (const float*)d_in[6]; a.q_norm_w = (const float*)d_in[7]; a.k_norm_w = (const float*)d_in[8];
    a.mlstm_norm_w = (const float*)d_in[9]; a.attn_norm_w = (const float*)d_in[10]; a.w_out = (const float*)d_in[11]; a.norm2_w = (const float*)d_in[12];
    a.w_gate = (const float*)d_in[13]; a.w_up = (const float*)d_in[14]; a.w_down = (const float*)d_in[15];
    a.out = (float*)d_out; a.ws = (unsigned char*)d_ws; a.dry = (PROBE_PHASE >= 0) ? 1 : 0;
    hipLaunchKernelGGL(hymba_fwd, dim3(grid), dim3(NWAVES * 64), LDS_BYTES, stream, a);
}
```

```cpp
#include <hip/hip_runtime.h>
#include <cstdio>
#include <cstdint>

#define LAS __attribute__((address_space(3)))
#define GAS __attribute__((address_space(1)))
typedef unsigned short bf16;
typedef short bf16x8 __attribute__((ext_vector_type(8)));
typedef short s16x4 __attribute__((ext_vector_type(4)));
typedef float f32x4 __attribute__((ext_vector_type(4)));
typedef float f32x2 __attribute__((ext_vector_type(2)));
typedef unsigned u32x4 __attribute__((ext_vector_type(4)));
typedef unsigned u32x2 __attribute__((ext_vector_type(2)));
typedef __bf16 bf16x2_t __attribute__((ext_vector_type(2)));

constexpr int BATCH = 2, SEQ = 4096, DM = 2048, MTOK = BATCH * SEQ;
constexpr int INW = 6152, NPROJ = 6144, DFF = 5632, NGU = 2 * DFF;
constexpr int PC_MQ = 0, PC_MK = 512, PC_MO = 1024, PC_MV = 2048, PC_AQ = 3072, PC_AK = 4096, PC_AV = 5120;
constexpr float NORM_EPS = 1e-6f;
constexpr int NWAVES = 8;

constexpr size_t MiB = 1u << 20;
constexpr size_t WS_CTL = 0, CTL_ZERO_BYTES = 32 * 1024;
constexpr size_t WS_GLI = 1 * MiB;
constexpr size_t WS_GLF = WS_GLI + 128 * 1024;
constexpr size_t WS_SUMSQ = WS_GLF + 128 * 1024;
constexpr size_t WS_MSC = WS_SUMSQ + 32 * 1024;
constexpr size_t WS_NC = WS_MSC + 8 * 1024;
constexpr size_t WS_COS = 2 * MiB, WS_SIN = 3 * MiB;
constexpr size_t WS_WIN = 6 * MiB;
constexpr size_t WS_KV = 6 * MiB;
constexpr size_t WS_U = 30 * MiB;
constexpr size_t WS_PROJ = 62 * MiB;
constexpr size_t WS_WOUT = 158 * MiB;
constexpr size_t WS_WGU = 166 * MiB;
constexpr size_t WS_WDN = 210 * MiB;
constexpr size_t WS_OP0 = 38 * MiB;
constexpr size_t WS_OP1 = 232 * MiB;
constexpr size_t WS_PL0 = 248 * MiB, WS_PL1 = WS_PL0 + 256 * 1024;
constexpr size_t WS_END = 249 * MiB;
constexpr int CW_BAR = 4096;

constexpr int RING_BYTES = 131072;
constexpr int MISC_OFF = 147456 - 256;
constexpr int LDS_BYTES = 147456;

__device__ __forceinline__ unsigned cvtpk(float lo, float hi) { f32x2 v = {lo, hi}; bf16x2_t b = __builtin_convertvector(v, bf16x2_t); return __builtin_bit_cast(unsigned, b); }
__device__ __forceinline__ float bf_lo(unsigned w) { return __uint_as_float(w << 16); }
__device__ __forceinline__ float bf_hi(unsigned w) { return __uint_as_float(w & 0xffff0000u); }
__device__ __forceinline__ void unpack8(u32x4 w, float* f) { f[0] = bf_lo(w.x); f[1] = bf_hi(w.x); f[2] = bf_lo(w.y); f[3] = bf_hi(w.y); f[4] = bf_lo(w.z); f[5] = bf_hi(w.z); f[6] = bf_lo(w.w); f[7] = bf_hi(w.w); }
__device__ __forceinline__ u32x4 pack8(const float* f) { u32x4 w; w.x = cvtpk(f[0], f[1]); w.y = cvtpk(f[2], f[3]); w.z = cvtpk(f[4], f[5]); w.w = cvtpk(f[6], f[7]); return w; }
#define DPP_MOV_F(v, ctrl) __uint_as_float((unsigned)__builtin_amdgcn_mov_dpp((int)__float_as_uint(v), (ctrl), 0xf, 0xf, true))
__device__ __forceinline__ float row16_sum(float v) { v += DPP_MOV_F(v, 0xB1); v += DPP_MOV_F(v, 0x4E); v += DPP_MOV_F(v, 0x124); v += DPP_MOV_F(v, 0x128); return v; }
__device__ __forceinline__ float x16_sum(float v) { const auto r = __builtin_amdgcn_permlane16_swap(__float_as_uint(v), __float_as_uint(v), false, false); return __uint_as_float(r[0]) + __uint_as_float(r[1]); }
__device__ __forceinline__ float x32_sum(float v) { const auto r = __builtin_amdgcn_permlane32_swap(__float_as_uint(v), __float_as_uint(v), false, false); return __uint_as_float(r[0]) + __uint_as_float(r[1]); }
__device__ __forceinline__ float x16_max(float v) { const auto r = __builtin_amdgcn_permlane16_swap(__float_as_uint(v), __float_as_uint(v), false, false); return fmaxf(__uint_as_float(r[0]), __uint_as_float(r[1])); }
__device__ __forceinline__ float x32_max(float v) { const auto r = __builtin_amdgcn_permlane32_swap(__float_as_uint(v), __float_as_uint(v), false, false); return fmaxf(__uint_as_float(r[0]), __uint_as_float(r[1])); }
__device__ __forceinline__ float xg_sum(float v) { return x32_sum(x16_sum(v)); }
__device__ __forceinline__ float xg_max(float v) { return x32_max(x16_max(v)); }
__device__ __forceinline__ float wave_sum(float v) { return xg_sum(row16_sum(v)); }
__device__ __forceinline__ float wave_max(float v) {
#pragma unroll
    for (int o = 1; o < 64; o <<= 1) v = fmaxf(v, __shfl_xor(v, o));
    return v;
}
__device__ __forceinline__ s16x4 vtr(const LAS unsigned char* p) { return __builtin_bit_cast(s16x4, __builtin_amdgcn_ds_read_tr16_b64_v4i16((LAS s16x4*)p)); }
__device__ __forceinline__ bf16x8 cat4(s16x4 a, s16x4 b) { return (bf16x8){a[0], a[1], a[2], a[3], b[0], b[1], b[2], b[3]}; }
#define LDS_WAIT() asm volatile("s_waitcnt lgkmcnt(0)" ::: "memory")
#define VM_WAIT() asm volatile("s_waitcnt vmcnt(0)" ::: "memory")
#define SBAR() __builtin_amdgcn_sched_barrier(0)
#define MFMA16(a, b, c) __builtin_amdgcn_mfma_f32_16x16x32_bf16((a), (b), (c), 0, 0, 0)

namespace pg8 {
constexpr int BM = 256, BK = 64, HALF = 128, HTB = HALF * BK * 2, STAGE_BYTES = 8 * HTB, NXCD = 8, WGM = 8;
__host__ __device__ __forceinline__ int lds_byte(int r, int c) { const int st = (r >> 4) * 2 + (c >> 5), rr = r & 15, cc = c & 31, ob = rr * 64 + cc * 2; return st * 1024 + (ob ^ (((ob >> 9) & 1) << 5)); }
__host__ __device__ __forceinline__ void stage_rc(int b, int& R, int& C) { const int st = b / 1024, sb = b % 1024, swz = sb ^ (((sb >> 9) & 1) << 5); R = (st >> 1) * 16 + swz / 64; C = (st & 1) * 32 + (swz % 64) / 2; }
__host__ __device__ __forceinline__ int perm32(int rho) { const int n = rho >> 4, i = rho & 15; return 8 * (i >> 2) + 4 * n + (i & 3); }
struct Unit { int pm, pn, ord; };
struct Gemm { const bf16* A; const bf16* Bt; int M, N, K, lda; };
struct StaticOrder {
    int nM, nN, nwg, G, c;
    __device__ void init(int M, int N, int G_, int c_) { nM = M / BM; nN = N / BM; nwg = nM * nN; G = G_; c = c_; }
    __device__ bool next(int i, Unit& u) const {
        const long L = (long)i * G + c; if (L >= nwg) return false; u.ord = i;
        int wgid = (int)L; { const int q = nwg / NXCD, r = nwg % NXCD, xcd = wgid % NXCD, off = wgid / NXCD; wgid = (xcd < r ? xcd * (q + 1) : r * (q + 1) + (xcd - r) * q) + off; }
        const int nig = WGM * nN, gid = wgid / nig, fm = gid * WGM, gsz = (nM - fm) < WGM ? (nM - fm) : WGM;
        u.pm = fm + ((wgid % nig) % gsz); u.pn = (wgid % nig) / gsz; return true;
    }
};
struct EpiBf16 {
    static constexpr bool PERM = true, HAS_INIT = false;
    bf16* O; int ldc;
    __device__ __forceinline__ void operator()(const f32x4 (&acc)[2][2][4][2], const Unit& u, int wr, int wc, int fr, int fq) const {
        const int row0 = u.pm * BM + wr * 64 + fr, col0 = u.pn * BM + wc * 32 + 8 * fq;
#pragma unroll
        for (int ai = 0; ai < 2; ++ai)
#pragma unroll
            for (int m = 0; m < 4; ++m) { bf16* rowp = O + (size_t)(row0 + ai * HALF + m * 16) * ldc + col0;
#pragma unroll
                for (int bj = 0; bj < 2; ++bj) { const f32x4 v0 = acc[ai][bj][m][0], v1 = acc[ai][bj][m][1];
                    u32x4 w; w.x = cvtpk(v0[0], v0[1]); w.y = cvtpk(v0[2], v0[3]); w.z = cvtpk(v1[0], v1[1]); w.w = cvtpk(v1[2], v1[3]);
                    *(u32x4*)(rowp + bj * HALF) = w; } }
    }
};
struct EpiRes1 {
    static constexpr bool PERM = false, HAS_INIT = true;
    const float* xres; float* out; bf16* h1b; float* sumsq; int ldc; bool dry;
    __device__ __forceinline__ void init(f32x4 (&acc)[2][2][4][2], const Unit& u, int wr, int wc, int fr, int fq) const {
        const int col0 = u.pn * BM + wc * 32 + 4 * fq;
#pragma unroll
        for (int ai = 0; ai < 2; ++ai)
#pragma unroll
            for (int m = 0; m < 4; ++m) { const size_t off = (size_t)(u.pm * BM + ai * HALF + wr * 64 + m * 16 + fr) * ldc + col0;
#pragma unroll
                for (int bj = 0; bj < 2; ++bj)
#pragma unroll
                    for (int n = 0; n < 2; ++n) acc[ai][bj][m][n] = __builtin_nontemporal_load((const f32x4*)(xres + off + bj * HALF + n * 16)); }
    }
    __device__ __forceinline__ void operator()(const f32x4 (&acc)[2][2][4][2], const Unit& u, int wr, int wc, int fr, int fq) const {
        const int col0 = u.pn * BM + wc * 32 + 4 * fq;
#pragma unroll
        for (int ai = 0; ai < 2; ++ai)
#pragma unroll
            for (int m = 0; m < 4; ++m) { const int row = u.pm * BM + ai * HALF + wr * 64 + m * 16 + fr; const size_t off = (size_t)row * ldc + col0; float ss = 0.f;
#pragma unroll
                for (int bj = 0; bj < 2; ++bj)
#pragma unroll
                    for (int n = 0; n < 2; ++n) { const size_t o2 = off + bj * HALF + n * 16; const f32x4 h = acc[ai][bj][m][n];
                        u32x2 w; w.x = cvtpk(h[0], h[1]); w.y = cvtpk(h[2], h[3]); if (!dry) { *(u32x2*)(h1b + o2) = w; }
                        ss += (h[0] * h[0] + h[1] * h[1]) + (h[2] * h[2] + h[3] * h[3]); }
                ss = xg_sum(ss);
                if (fq == 0 && !dry) atomicAdd(sumsq + row, ss); }
    }
};
struct EpiSwiGLU {
    static constexpr bool PERM = true, HAS_INIT = false;
    bf16* O; int ldc; const LAS float* rsl; const float* sumsq;
    __device__ __forceinline__ void operator()(const f32x4 (&acc)[2][2][4][2], const Unit& u, int wr, int wc, int fr, int fq) const {
        const int col0 = u.pn * HALF + wc * 32 + 8 * fq;
#pragma unroll
        for (int ai = 0; ai < 2; ++ai)
#pragma unroll
            for (int m = 0; m < 4; ++m) { const int rl = ai * HALF + wr * 64 + m * 16 + fr; const int row = u.pm * BM + rl;
                const float rs = (u.ord < 8) ? rsl[u.ord * 256 + rl] : __builtin_amdgcn_rsqf(sumsq[row] * (1.0f / DM) + NORM_EPS);
                float f[8];
#pragma unroll
                for (int n = 0; n < 2; ++n)
#pragma unroll
                    for (int j = 0; j < 4; ++j) { const float g = acc[ai][0][m][n][j] * rs, up = acc[ai][1][m][n][j] * rs; f[n * 4 + j] = g * __builtin_amdgcn_rcpf(1.0f + __expf(-g)) * up; }
                *(u32x4*)(O + (size_t)row * ldc + col0) = pack8(f); }
    }
};
struct EpiRes2 {
    static constexpr bool PERM = false, HAS_INIT = true;
    const bf16* h1b; float* out; int ldc; bool dry;
    __device__ __forceinline__ void init(f32x4 (&acc)[2][2][4][2], const Unit& u, int wr, int wc, int fr, int fq) const {
        const int col0 = u.pn * BM + wc * 32 + 4 * fq;
#pragma unroll
        for (int ai = 0; ai < 2; ++ai)
#pragma unroll
            for (int m = 0; m < 4; ++m) { const size_t off = (size_t)(u.pm * BM + ai * HALF + wr * 64 + m * 16 + fr) * ldc + col0;
#pragma unroll
                for (int bj = 0; bj < 2; ++bj)
#pragma unroll
                    for (int n = 0; n < 2; ++n) { const u32x2 w = __builtin_nontemporal_load((const u32x2*)(h1b + off + bj * HALF + n * 16)); acc[ai][bj][m][n] = (f32x4){bf_lo(w.x), bf_hi(w.x), bf_lo(w.y), bf_hi(w.y)}; } }
    }
    __device__ __forceinline__ void operator()(const f32x4 (&acc)[2][2][4][2], const Unit& u, int wr, int wc, int fr, int fq) const {
        const int col0 = u.pn * BM + wc * 32 + 4 * fq;
#pragma unroll
        for (int ai = 0; ai < 2; ++ai)
#pragma unroll
            for (int m = 0; m < 4; ++m) { const size_t off = (size_t)(u.pm * BM + ai * HALF + wr * 64 + m * 16 + fr) * ldc + col0;
#pragma unroll
                for (int bj = 0; bj < 2; ++bj)
#pragma unroll
                    for (int n = 0; n < 2; ++n) { if (!dry) __builtin_nontemporal_store(acc[ai][bj][m][n], (f32x4*)(out + off + bj * HALF + n * 16)); } }
    }
};

template <class Epi, bool ALIGN_EPI>
__device__ __forceinline__ void gemm_phase(LAS unsigned char* lds, const Gemm g, const StaticOrder& S, const Epi& E) {
    int tid = threadIdx.x; asm volatile("" : "+v"(tid));
    const int wid = __builtin_amdgcn_readfirstlane(tid >> 6), lane = tid & 63, wr = wid >> 2, wc = wid & 3, fr = lane & 15, fq = lane >> 4;
    const int K = g.K, nt = K / BK;
    unsigned voffA[2], voffB[2];
#pragma unroll
    for (int i = 0; i < 2; ++i) { int R, C; stage_rc(tid * 16 + i * 8192, R, C); const int Rb = Epi::PERM ? ((R & ~31) + perm32(R & 31)) : R;
        voffA[i] = (unsigned)(R * g.lda + C) * 2u; voffB[i] = (unsigned)(Rb * K + C) * 2u; }
    const size_t kstep = (size_t)(BK * 2);
    const size_t hstepA = (size_t)HALF * g.lda * 2, hstepB = (size_t)HALF * K * 2;
    const size_t tstepA = 2 * hstepA, tstepB = 2 * hstepB;
    const unsigned ldsw = (unsigned)wid * 1024u;
    const int aoff = lds_byte(wr * 64 + fr, fq * 8), boff = lds_byte(wc * 32 + fr, fq * 8);
#define PG8_SA(b, h) (((b) * 2 + (h)) * HTB)
#define PG8_SB(b, h) ((4 + (b) * 2 + (h)) * HTB)
#define PG8_STAGE(bufoff, gbase, voff) do { _Pragma("unroll") for (int _i = 0; _i < 2; ++_i) \
        __builtin_amdgcn_global_load_lds((const unsigned*)((const char*)(gbase) + (voff)[_i]), (LAS unsigned*)(lds + (bufoff) + ldsw + _i * 8192), 16, 0, 0); } while (0)
#define PG8_LDA(dst, b, h) do { _Pragma("unroll") for (int m = 0; m < 4; ++m) _Pragma("unroll") for (int k = 0; k < 2; ++k) dst[m][k] = *(const LAS bf16x8*)(lds + PG8_SA(b, h) + aoff + m * 2048 + k * 1024); } while (0)
#define PG8_LDB(dst, b, h) do { _Pragma("unroll") for (int n = 0; n < 2; ++n) _Pragma("unroll") for (int k = 0; k < 2; ++k) dst[n][k] = *(const LAS bf16x8*)(lds + PG8_SB(b, h) + boff + n * 2048 + k * 1024); } while (0)
#define PG8_MMA(ai, bj, At, Bt) do { __builtin_amdgcn_s_setprio(1); _Pragma("unroll") for (int m = 0; m < 4; ++m) _Pragma("unroll") for (int n = 0; n < 2; ++n) _Pragma("unroll") for (int k = 0; k < 2; ++k) \
        acc[ai][bj][m][n] = __builtin_amdgcn_mfma_f32_16x16x32_bf16(Bt[n][k], At[m][k], acc[ai][bj][m][n], 0, 0, 0); __builtin_amdgcn_s_setprio(0); } while (0)
#define PG8_WAIT_V(n) asm volatile("s_waitcnt vmcnt(" #n ")" ::: "memory")
#define PG8_WAIT_L(n) asm volatile("s_waitcnt lgkmcnt(" #n ")" ::: "memory")
#define PG8_BAR __builtin_amdgcn_s_barrier()
#define PG8_SCHED __builtin_amdgcn_sched_barrier(0)
    Unit cur, nxt; int ui = 0;
    if (!S.next(0, cur)) return;
    f32x4 acc[2][2][4][2];
    if constexpr (Epi::HAS_INIT) { E.init(acc, cur, wr, wc, fr, fq); }
    else {
#pragma unroll
    for (int a = 0; a < 2; ++a)
#pragma unroll
        for (int b = 0; b < 2; ++b)
#pragma unroll
            for (int m = 0; m < 4; ++m)
#pragma unroll
                for (int n = 0; n < 2; ++n) acc[a][b][m][n] = (f32x4){0.f, 0.f, 0.f, 0.f};
    }
    bf16x8 At[4][2], B0[2][2], B1[2][2];
    const char* cA = (const char*)g.A + (size_t)cur.pm * tstepA; const char* cB = (const char*)g.Bt + (size_t)cur.pn * tstepB;
    PG8_STAGE(PG8_SB(0, 0), cB, voffB); PG8_STAGE(PG8_SB(0, 1), cB + hstepB, voffB); PG8_STAGE(PG8_SA(0, 0), cA, voffA); PG8_STAGE(PG8_SA(0, 1), cA + hstepA, voffA);
    if (wr == 1) PG8_BAR;
    PG8_WAIT_V(2); PG8_BAR;
    PG8_STAGE(PG8_SB(1, 0), cB + kstep, voffB); PG8_STAGE(PG8_SA(1, 0), cA + kstep, voffA); PG8_STAGE(PG8_SB(1, 1), cB + hstepB + kstep, voffB);
    PG8_WAIT_V(6); PG8_BAR;
    for (;;) {
        const bool has_next = S.next(ui + 1, nxt);
        const char* nA = has_next ? (const char*)g.A + (size_t)nxt.pm * tstepA : cA; const char* nB = has_next ? (const char*)g.Bt + (size_t)nxt.pn * tstepB : cB;
        for (int t = 0; t < nt; t += 2) {
            const bool last = (t == nt - 2);
            const char* a1 = cA + (size_t)(t + 1) * kstep;
            const char* a2 = last ? nA : cA + (size_t)(t + 2) * kstep; const char* b2 = last ? nB : cB + (size_t)(t + 2) * kstep;
            const char* a3 = a2 + kstep; const char* b3 = b2 + kstep;
            PG8_LDB(B0, 0, 0); PG8_LDB(B1, 0, 1); PG8_SCHED; PG8_LDA(At, 0, 0); PG8_STAGE(PG8_SA(1, 1), a1 + hstepA, voffA);
            PG8_WAIT_V(8); PG8_WAIT_L(0); PG8_BAR; PG8_MMA(0, 0, At, B0); PG8_MMA(0, 1, At, B1); PG8_BAR; PG8_SCHED;
            PG8_LDA(At, 0, 1); PG8_STAGE(PG8_SB(0, 0), b2, voffB); PG8_STAGE(PG8_SB(0, 1), b2 + hstepB, voffB); PG8_STAGE(PG8_SA(0, 0), a2, voffA);
            PG8_WAIT_V(8); PG8_WAIT_L(0); PG8_BAR; PG8_MMA(1, 0, At, B0); PG8_MMA(1, 1, At, B1); PG8_BAR; PG8_SCHED;
            PG8_LDB(B0, 1, 0); PG8_LDB(B1, 1, 1); PG8_SCHED; PG8_LDA(At, 1, 0); PG8_STAGE(PG8_SA(0, 1), a2 + hstepA, voffA);
            PG8_WAIT_V(8); PG8_WAIT_L(0); PG8_BAR; PG8_MMA(0, 0, At, B0); PG8_MMA(0, 1, At, B1); PG8_BAR; PG8_SCHED;
            PG8_LDA(At, 1, 1); PG8_STAGE(PG8_SB(1, 0), b3, voffB); PG8_STAGE(PG8_SB(1, 1), b3 + hstepB, voffB); PG8_STAGE(PG8_SA(1, 0), a3, voffA);
            PG8_WAIT_V(8); PG8_WAIT_L(0); PG8_BAR; PG8_MMA(1, 0, At, B0); PG8_MMA(1, 1, At, B1); PG8_BAR; PG8_SCHED;
        }
        if constexpr (ALIGN_EPI) { if (wr == 0) PG8_BAR; }
        E(acc, cur, wr, wc, fr, fq);
        if (!has_next) break;
        if constexpr (Epi::HAS_INIT) { E.init(acc, nxt, wr, wc, fr, fq); }
        else {
#pragma unroll
        for (int a = 0; a < 2; ++a)
#pragma unroll
            for (int b = 0; b < 2; ++b)
#pragma unroll
                for (int m = 0; m < 4; ++m)
#pragma unroll
                    for (int n = 0; n < 2; ++n) acc[a][b][m][n] = (f32x4){0.f, 0.f, 0.f, 0.f};
        }
        cur = nxt; cA = nA; cB = nB; ++ui;
        if constexpr (ALIGN_EPI) { if (wr == 1) PG8_BAR; }
    }
    PG8_WAIT_V(0);
    if constexpr (!ALIGN_EPI) { if (wr == 0) PG8_BAR; }
    PG8_BAR;
#undef PG8_SA
#undef PG8_SB
#undef PG8_STAGE
#undef PG8_LDA
#undef PG8_LDB
#undef PG8_MMA
#undef PG8_WAIT_V
#undef PG8_WAIT_L
#undef PG8_BAR
#undef PG8_SCHED
}
}

#define XB_TMO      128
#define XB_XCNT(j)  (256  + 64 * (j))
#define XB_XSUB(j)  (1280 + 64 * (j))
#define XB_XGEN(j)  (2304 + 64 * (j))
#define XB_TOP      3328
#define XB_TOPGEN   3392
#define XCD_BAR_WORDS 3456
#define XB_SPIN_CAP (1u << 18)
__device__ __forceinline__ unsigned xb_ld(unsigned* p)              { return __hip_atomic_load(p, __ATOMIC_RELAXED, __HIP_MEMORY_SCOPE_AGENT); }
__device__ __forceinline__ unsigned xb_add(unsigned* p, unsigned v) { return __hip_atomic_fetch_add(p, v, __ATOMIC_RELAXED, __HIP_MEMORY_SCOPE_AGENT); }
__device__ __forceinline__ unsigned xb_xcc_id() { return (unsigned)__builtin_amdgcn_s_getreg((3 << 11) | 20) & 0xFu; }
#define XB_SPIN(cond, bar) do { unsigned _sp = 0; while (cond) { __builtin_amdgcn_s_sleep(1); \
    if ((++_sp & 255u) == 0u) { if (xb_ld(&(bar)[XB_TMO])) break; if (_sp > XB_SPIN_CAP) { atomicAdd(&(bar)[XB_TMO], 1u); break; } } } } while (0)
struct XcdBarrier { unsigned* bar; unsigned x; volatile LAS unsigned* st; };
__device__ __forceinline__ XcdBarrier xcd_barrier_post(unsigned* bar, volatile LAS unsigned* st) {
    XcdBarrier b; b.bar = bar; b.x = xb_xcc_id(); b.st = st;
    if (threadIdx.x == 0) (void)xb_add(&bar[XB_XCNT(b.x)], 1u);
    return b;
}
__device__ __forceinline__ void xcd_barrier_complete(unsigned* bar, unsigned x, unsigned& nloc, unsigned& nx) {
    const unsigned G = gridDim.x * gridDim.y * gridDim.z;
    unsigned sum, cnt, mine, sp = 0u;
    for (;;) {
        sum = 0u; cnt = 0u; mine = 0u;
#pragma unroll
        for (unsigned j = 0; j < 16; ++j) { const unsigned c = xb_ld(&bar[XB_XCNT(j)]); sum += c; cnt += (c > 0u) ? 1u : 0u; mine = (j == x) ? c : mine; }
        if (sum == G) break;
        __builtin_amdgcn_s_sleep(1);
        if ((++sp & 255u) == 0u) { if (xb_ld(&bar[XB_TMO])) break; if (sp > XB_SPIN_CAP) { atomicAdd(&bar[XB_TMO], 1u); break; } }
    }
    nloc = mine > 0u ? mine : 1u; nx = cnt > 0u ? cnt : 1u;
}
__device__ __forceinline__ void xcd_barrier(const XcdBarrier& b) {
    asm volatile("s_waitcnt vmcnt(0)" ::: "memory");
    __syncthreads();
    if (threadIdx.x == 0) {
        unsigned* bar = b.bar;
        __builtin_amdgcn_s_waitcnt(0);
        unsigned nloc = b.st[0], nx = b.st[1];
        if (nloc == 0u) { xcd_barrier_complete(bar, b.x, nloc, nx); b.st[0] = nloc; b.st[1] = nx; }
        const unsigned old = xb_add(&bar[XB_XSUB(b.x)], 1u);
        const unsigned gen = old / nloc;
        if (old + 1u == (gen + 1u) * nloc) {
            __builtin_amdgcn_fence(__ATOMIC_RELEASE, "agent");
            asm volatile("s_waitcnt vmcnt(0)" ::: "memory");
            const unsigned og = xb_add(&bar[XB_TOP], 1u);
            const unsigned tg = og / nx;
            if (og + 1u == (tg + 1u) * nx) xb_add(&bar[XB_TOPGEN], 1u);
            else XB_SPIN(xb_ld(&bar[XB_TOPGEN]) == tg, bar);
            __builtin_amdgcn_fence(__ATOMIC_ACQUIRE, "agent");
            xb_add(&bar[XB_XGEN(b.x)], 1u);
            asm volatile("s_waitcnt vmcnt(0)" ::: "memory");
        } else {
            XB_SPIN(xb_ld(&bar[XB_XGEN(b.x)]) == gen, bar);
            __builtin_amdgcn_fence(__ATOMIC_ACQUIRE, "agent");
            asm volatile("s_waitcnt vmcnt(0)" ::: "memory");
        }
    }
    __syncthreads();
}

struct Args {
    const float* x; const float* norm1_w; const float* w_in; const float* conv_w; const float* conv_b; const float* igate_b; const float* fgate_b;
    const float* q_norm_w; const float* k_norm_w; const float* mlstm_norm_w; const float* attn_norm_w; const float* w_out; const float* norm2_w;
    const float* w_gate; const float* w_up; const float* w_down;
    float* out; unsigned char* ws; int dry; int pad;
};

struct TItem { const float* W; bf16* WT; const float* kscale; int ldw, K, nsrc0, ndst0, k0; };
__device__ __forceinline__ void titem_load(const TItem& t, f32x4 (&v)[8], int lane) {
    const float* src = t.W + (size_t)(t.k0 + (lane >> 3)) * t.ldw + t.nsrc0 + (lane & 7) * 4;
#pragma unroll
    for (int i = 0; i < 8; ++i) v[i] = __builtin_nontemporal_load((const f32x4*)(src + (size_t)(8 * i) * t.ldw));
}
__device__ __forceinline__ void titem_finish(const TItem& t, const f32x4 (&v)[8], LAS float* scr, int lane) {
#pragma unroll
    for (int i = 0; i < 8; ++i) { const int kk = 8 * i + (lane >> 3); const float sc = t.kscale ? t.kscale[t.k0 + kk] : 1.0f; LAS float* d = scr + kk * 33 + (lane & 7) * 4;
        d[0] = v[i][0] * sc; d[1] = v[i][1] * sc; d[2] = v[i][2] * sc; d[3] = v[i][3] * sc; }
    LDS_WAIT(); asm volatile("" ::: "memory");
    const int c = lane & 7;
#pragma unroll
    for (int j = 0; j < 4; ++j) { const int n = (lane >> 3) + 8 * j; const LAS float* s = scr + (8 * c) * 33 + n;
        u32x4 o; o.x = cvtpk(s[0 * 33], s[1 * 33]); o.y = cvtpk(s[2 * 33], s[3 * 33]); o.z = cvtpk(s[4 * 33], s[5 * 33]); o.w = cvtpk(s[6 * 33], s[7 * 33]);
        *(u32x4*)(t.WT + (size_t)(t.ndst0 + n) * t.K + t.k0 + 8 * c) = o; }
    LDS_WAIT(); asm volatile("" ::: "memory");
}
__device__ __forceinline__ int win_src_col(int nd) {
    if (nd < 1024) return nd;
    if (nd < 2048) return nd + 1024;
    if (nd < 3072) return nd - 1024;
    return nd + 8;
}


__device__ __forceinline__ float scan_add64(float v, int lane) {
#pragma unroll
    for (int o = 1; o < 64; o <<= 1) { const float t = __shfl_up(v, o); if (lane >= o) v += t; }
    return v;
}
__device__ __forceinline__ float scan_max64(float v, int lane) {
#pragma unroll
    for (int o = 1; o < 64; o <<= 1) { const float t = __shfl_up(v, o); if (lane >= o) v = fmaxf(v, t); }
    return v;
}
__device__ __forceinline__ void conv_issue(const bf16* proj, int b, int c, int col0, int tid, u32x4 (&raw)[2][4]) {
    const int rr = tid >> 4, cc = (tid & 15) * 8;
#pragma unroll
    for (int half = 0; half < 2; ++half)
#pragma unroll
        for (int j = 0; j < 4; ++j) { const int tt = c * 64 + rr + 32 * half - 3 + j; const int ttc = tt < 0 ? 0 : tt;
            raw[half][j] = *(const u32x4*)(proj + (size_t)(b * SEQ + ttc) * NPROJ + col0 + cc); }
}
template <bool ROWW>
__device__ __forceinline__ void conv_finish(const u32x4 (&raw)[2][4], const float* conv_w, const float* conv_b, int c, int ch0, float rscale, float wlane, LAS unsigned char* tile, int tid) {
    const int rr = tid >> 4, cc = (tid & 15) * 8;
    float w[4][8], bb[8];
#pragma unroll
    for (int j = 0; j < 4; ++j) { const f32x4 w0 = *(const f32x4*)(conv_w + j * 1024 + ch0 + cc), w1 = *(const f32x4*)(conv_w + j * 1024 + ch0 + cc + 4);
        w[j][0] = w0[0]; w[j][1] = w0[1]; w[j][2] = w0[2]; w[j][3] = w0[3]; w[j][4] = w1[0]; w[j][5] = w1[1]; w[j][6] = w1[2]; w[j][7] = w1[3]; }
    { const f32x4 b0 = *(const f32x4*)(conv_b + ch0 + cc), b1 = *(const f32x4*)(conv_b + ch0 + cc + 4);
      bb[0] = b0[0]; bb[1] = b0[1]; bb[2] = b0[2]; bb[3] = b0[3]; bb[4] = b1[0]; bb[5] = b1[1]; bb[6] = b1[2]; bb[7] = b1[3]; }
#pragma unroll
    for (int half = 0; half < 2; ++half) {
        const int l = rr + 32 * half, t = c * 64 + l;
        float y[8];
#pragma unroll
        for (int e = 0; e < 8; ++e) y[e] = bb[e];
#pragma unroll
        for (int j = 0; j < 4; ++j) { const bool inb = (t - 3 + j) >= 0; u32x4 rz = raw[half][j];
            rz.x = inb ? rz.x : 0u; rz.y = inb ? rz.y : 0u; rz.z = inb ? rz.z : 0u; rz.w = inb ? rz.w : 0u;
            float x[8]; unpack8(rz, x);
#pragma unroll
            for (int e = 0; e < 8; ++e) y[e] += w[j][e] * x[e]; }
        float sc = rscale;
        if (ROWW) sc *= __shfl(wlane, l);
#pragma unroll
        for (int e = 0; e < 8; ++e) y[e] = y[e] * __builtin_amdgcn_rcpf(1.0f + __expf(-y[e])) * sc;
        *(LAS u32x4*)(tile + l * 288 + cc * 2) = pack8(y);
    }
}
__device__ __forceinline__ void v_issue(const bf16* proj, int b, int c, int h, int tid, u32x4 (&vv)[4]) {
#pragma unroll
    for (int p = 0; p < 4; ++p) { const int row = p * 16 + (tid >> 5), ch = tid & 31;
        vv[p] = *(const u32x4*)(proj + (size_t)(b * SEQ + c * 64 + row) * NPROJ + PC_MV + h * 256 + ch * 8); }
}
__device__ __forceinline__ void v_store(const u32x4 (&vv)[4], LAS unsigned char* tile, int tid) {
#pragma unroll
    for (int p = 0; p < 4; ++p) { const int row = p * 16 + (tid >> 5), ch = tid & 31;
        *(LAS u32x4*)(tile + row * 544 + ch * 16) = vv[p]; }
}

__device__ __forceinline__ void q_prep(const bf16* qrow, const float* rcos, const float* rsin, const float* qnw, int tq, int g, bf16x8 (&qf)[4]) {
    float q[4][8]; float ss = 0.f;
#pragma unroll
    for (int ks = 0; ks < 4; ++ks) { const u32x4 raw = *(const u32x4*)(qrow + 32 * ks + 8 * g); unpack8(raw, q[ks]);
#pragma unroll
        for (int e = 0; e < 8; ++e) ss += q[ks][e] * q[ks][e]; }
    ss = xg_sum(ss);
    const float rq = __builtin_amdgcn_rsqf(ss * (1.0f / 128.0f) + NORM_EPS);
#pragma unroll
    for (int ks = 0; ks < 2; ++ks) {
        const int c0 = 32 * ks + 8 * g;
#pragma unroll
        for (int e4 = 0; e4 < 2; ++e4) {
            const f32x4 cs = *(const f32x4*)(rcos + tq * 64 + c0 + 4 * e4), sn = *(const f32x4*)(rsin + tq * 64 + c0 + 4 * e4);
            const f32x4 w1 = *(const f32x4*)(qnw + c0 + 4 * e4), w2 = *(const f32x4*)(qnw + 64 + c0 + 4 * e4);
#pragma unroll
            for (int e = 0; e < 4; ++e) { const float y1 = q[ks][4 * e4 + e] * rq * w1[e], y2 = q[ks + 2][4 * e4 + e] * rq * w2[e];
                q[ks][4 * e4 + e] = y1 * cs[e] - y2 * sn[e]; q[ks + 2][4 * e4 + e] = y2 * cs[e] + y1 * sn[e]; }
        }
    }
#pragma unroll
    for (int ks = 0; ks < 4; ++ks) { const u32x4 w = pack8(q[ks]); qf[ks] = __builtin_bit_cast(bf16x8, w); }
}
struct AUnit { int b, h, d, r, n; bf16* po0; float* pl0; };
template <bool FINAL>
__device__ __forceinline__ void attn_pair(bf16* proj, const float* rcos, const float* rsin, const float* qnw, const float* knw, const float* anw, const AUnit& ua, const AUnit& ub,
                                          LAS unsigned char* lds_all, bf16* po1, float* pl1, int tid_in, bool dry) {
    int tid = tid_in; asm volatile("" : "+v"(tid));
    const int lane = tid & 63, wave = __builtin_amdgcn_readfirstlane(tid >> 6);
    const int team = wave >> 2, w4 = wave & 3;
    const int b = team ? ub.b : ua.b, h = team ? ub.h : ua.h, d = team ? ub.d : ua.d, r = team ? ub.r : ua.r, n = team ? ub.n : ua.n;
    bf16* po0 = team ? ub.po0 : ua.po0; float* pl0 = team ? ub.pl0 : ua.pl0;
    LAS unsigned char* lds = lds_all + team * 36864;
    const int j = lane & 15, g = lane >> 4, qp = j >> 2, p = lane & 3;
    const int tt = tid & 255, srow = tt >> 4, sch = tt & 15;
    const bf16* kcol = proj + (size_t)b * SEQ * NPROJ + PC_AK + h * 128 + sch * 8;
    const bf16* vcol = kcol + (PC_AV - PC_AK);
    const int kt0 = (n == 0) ? 4 : 0;
    const int sub0 = 128 * (n - 1) + srow;
    u32x4 rk[2][2], rv[2][2];
#define AT_ISSUE(set, t) do { const int tc_ = ((t) < 8) ? (t) : 7; _Pragma("unroll") for (int hh_ = 0; hh_ < 2; ++hh_) { const size_t tok_ = (size_t)((sub0 + 32 * tc_ + 16 * hh_) * d + r); \
        rk[set][hh_] = *(const u32x4*)(kcol + tok_ * NPROJ); rv[set][hh_] = *(const u32x4*)(vcol + tok_ * NPROJ); } } while (0)
#define AT_WRITE(set, t) do { LAS unsigned char* Kn_ = lds + ((t) & 1) * 18432; _Pragma("unroll") for (int hh_ = 0; hh_ < 2; ++hh_) { \
        *(LAS u32x4*)(Kn_ + (srow + 16 * hh_) * 288 + sch * 16) = rk[set][hh_]; *(LAS u32x4*)(Kn_ + 9216 + (srow + 16 * hh_) * 288 + sch * 16) = rv[set][hh_]; } } while (0)
#define WG_BAR() do { asm volatile("s_waitcnt lgkmcnt(0)" ::: "memory"); __builtin_amdgcn_s_barrier(); asm volatile("" ::: "memory"); } while (0)
    AT_ISSUE(0, kt0); AT_ISSUE(1, kt0 + 1);
    bf16x8 qf[2][4]; int qi[2]; int tq[2];
    const int G0 = w4, G1 = 7 - w4;
    qi[0] = 16 * G0 + j; qi[1] = 16 * G1 + j; tq[0] = (128 * n + qi[0]) * d + r; tq[1] = (128 * n + qi[1]) * d + r;
    const int lo0 = G0 >> 1, lo1 = G1 >> 1;
#pragma unroll
    for (int gi = 0; gi < 2; ++gi) { const bf16* qrow = proj + (size_t)(b * SEQ + tq[gi]) * NPROJ + PC_AQ + h * 128 + 8 * g;
#pragma unroll
        for (int ks = 0; ks < 4; ++ks) qf[gi][ks] = *(const bf16x8*)(qrow + 32 * ks); }
    AT_WRITE(0, kt0);
    for (int kb_ = 0; kb_ < kt0; ++kb_) WG_BAR();
    WG_BAR();
    float mref;
    { const float bq = wave_max(fmaxf(fabsf(qnw[lane]), fabsf(qnw[64 + lane]))), bk = wave_max(fmaxf(fabsf(knw[lane]), fabsf(knw[64 + lane])));
      mref = fminf(128.0f * 1.02f * 0.08838834764831845f * 1.4426950408889634f * bq * bk, 60.0f); }
    float l_run[2] = {0.f, 0.f};
    f32x4 o[2][8];
    if (FINAL) {
#pragma unroll
        for (int gi = 0; gi < 2; ++gi) { const size_t trow = (size_t)(b * SEQ + tq[gi]);
            const float l0 = pl0[trow * 8 + h], l1 = pl1[trow * 8 + h];
            const float a0 = __builtin_amdgcn_exp2f(l0 - mref), a1 = __builtin_amdgcn_exp2f(l1 - mref);
            l_run[gi] = (g == 0) ? a0 + a1 : 0.f;
            const bf16* p0 = po0 + trow * 1024 + h * 128 + g * 8; const bf16* p1 = po1 + trow * 1024 + h * 128 + g * 8;
#pragma unroll
            for (int np = 0; np < 4; ++np) { const u32x4 x0 = *(const u32x4*)(p0 + 32 * np), x1 = *(const u32x4*)(p1 + 32 * np); float f0[8], f1[8]; unpack8(x0, f0); unpack8(x1, f1);
#pragma unroll
                for (int e = 0; e < 4; ++e) { o[gi][2 * np][e] = a0 * f0[e] + a1 * f1[e]; o[gi][2 * np + 1][e] = a0 * f0[4 + e] + a1 * f1[4 + e]; } }
        }
    } else {
#pragma unroll
        for (int gi = 0; gi < 2; ++gi)
#pragma unroll
            for (int nf = 0; nf < 8; ++nf) o[gi][nf] = (f32x4){0.f, 0.f, 0.f, 0.f};
    }
    const float SC = 0.08838834764831845f * 1.4426950408889634f;
    const float nmref = -mref;
#define AT_SM(gi, kt, s0, s1) do { \
                float x[8]; float ps = 0.f; \
                _Pragma("unroll") for (int e = 0; e < 8; ++e) { const int kj = 32 * (kt) + 16 * (e >> 2) + 4 * g + (e & 3); const float sv = (e < 4) ? s0[e & 3] : s1[e & 3]; \
                    const bool valid = (kj >= qi[gi]) && (kj <= qi[gi] + 128); \
                    const float pe = __builtin_amdgcn_exp2f(__builtin_fmaf(sv, SC, nmref)); \
                    x[e] = valid ? pe : 0.f; ps += x[e]; } \
                l_run[gi] += ps; \
                const u32x4 pw = pack8(x); pb[gi] = __builtin_bit_cast(bf16x8, pw); } while (0)
#define AT_ONE(gi, kt) do { \
            f32x4 sA = {0.f, 0.f, 0.f, 0.f}, sB = {0.f, 0.f, 0.f, 0.f}; \
            _Pragma("unroll") for (int ks = 0; ks < 4; ++ks) { \
                const bf16x8 k0 = *(const LAS bf16x8*)(Kt + j * 288 + (32 * ks + 8 * g) * 2), k1 = *(const LAS bf16x8*)(Kt + (16 + j) * 288 + (32 * ks + 8 * g) * 2); \
                sA = MFMA16(k0, qf[gi][ks], sA); sB = MFMA16(k1, qf[gi][ks], sB); } \
            bf16x8 pb[2]; AT_SM(gi, kt, sA, sB); \
            _Pragma("unroll") for (int nf = 0; nf < 8; ++nf) { \
                const s16x4 a0 = vtr(Vt + (4 * g + qp) * 288 + (16 * nf + 4 * p) * 2), a1 = vtr(Vt + (16 + 4 * g + qp) * 288 + (16 * nf + 4 * p) * 2); \
                o[gi][nf] = MFMA16(cat4(a0, a1), pb[gi], o[gi][nf]); } } while (0)
#define AT_STEP(kt, setn, setw) do { \
        LAS unsigned char* Kt = lds + ((kt) & 1) * 18432; LAS unsigned char* Vt = Kt + 9216; \
        AT_ISSUE(setn, (kt) + 2); \
        const bool act0 = (kt) >= lo0 && (kt) <= lo0 + 4, act1 = (kt) >= lo1 && (kt) <= lo1 + 4; \
        if (act0 && act1) { \
            f32x4 sA[2], sB[2]; sA[0] = (f32x4){0.f, 0.f, 0.f, 0.f}; sA[1] = sA[0]; sB[0] = sA[0]; sB[1] = sA[0]; \
            _Pragma("unroll") for (int ks = 0; ks < 4; ++ks) { \
                const bf16x8 k0 = *(const LAS bf16x8*)(Kt + j * 288 + (32 * ks + 8 * g) * 2), k1 = *(const LAS bf16x8*)(Kt + (16 + j) * 288 + (32 * ks + 8 * g) * 2); \
                sA[0] = MFMA16(k0, qf[0][ks], sA[0]); sB[0] = MFMA16(k1, qf[0][ks], sB[0]); sA[1] = MFMA16(k0, qf[1][ks], sA[1]); sB[1] = MFMA16(k1, qf[1][ks], sB[1]); } \
            bf16x8 pb[2]; \
            AT_SM(0, kt, sA[0], sB[0]); AT_SM(1, kt, sA[1], sB[1]); \
            _Pragma("unroll") for (int nf = 0; nf < 8; ++nf) { \
                const s16x4 a0 = vtr(Vt + (4 * g + qp) * 288 + (16 * nf + 4 * p) * 2), a1 = vtr(Vt + (16 + 4 * g + qp) * 288 + (16 * nf + 4 * p) * 2); \
                const bf16x8 vf = cat4(a0, a1); \
                o[0][nf] = MFMA16(vf, pb[0], o[0][nf]); o[1][nf] = MFMA16(vf, pb[1], o[1][nf]); } \
        } else if (act0) { AT_ONE(0, kt); } else if (act1) { AT_ONE(1, kt); } \
        if ((kt) + 1 < 8) AT_WRITE(setw, (kt) + 1); \
        WG_BAR(); } while (0)
#pragma unroll 1
    for (int kt = kt0; kt < 8; kt += 2) { AT_STEP(kt, 0, 1); AT_STEP(kt + 1, 1, 0); }
#undef AT_STEP
#undef AT_ONE
#undef AT_SM
#undef AT_ISSUE
#undef AT_WRITE
#pragma unroll
    for (int gi = 0; gi < 2; ++gi) {
        float lr = l_run[gi]; lr = xg_sum(lr);
        const float inv = __builtin_amdgcn_rcpf(lr);
        const float lse2 = mref + __log2f(lr);
        const size_t trow = (size_t)(b * SEQ + tq[gi]);
        if (!FINAL) {
            bf16* pp = po0 + trow * 1024 + h * 128 + g * 8;
#pragma unroll
            for (int np = 0; np < 4; ++np) { const f32x4 va = o[gi][2 * np] * inv, vb = o[gi][2 * np + 1] * inv; u32x4 ww; ww.x = cvtpk(va[0], va[1]); ww.y = cvtpk(va[2], va[3]); ww.z = cvtpk(vb[0], vb[1]); ww.w = cvtpk(vb[2], vb[3]);
                if (!dry) *(u32x4*)(pp + 32 * np) = ww; }
            if (g == 0 && !dry) pl0[trow * 8 + h] = lse2;
        } else {
            bf16* qrow = proj + trow * NPROJ + PC_AQ + h * 128;
            float ss = 0.f;
#pragma unroll
            for (int nf = 0; nf < 8; ++nf) { const f32x4 v = o[gi][nf] * inv; o[gi][nf] = v; ss += (v[0] * v[0] + v[1] * v[1]) + (v[2] * v[2] + v[3] * v[3]); }
            ss = xg_sum(ss);
            const float rn = __builtin_amdgcn_rsqf(ss * (1.0f / 128.0f) + NORM_EPS);
#pragma unroll
            for (int nf = 0; nf < 8; ++nf) { const int e = 16 * nf + 4 * g; const f32x4 w = *(const f32x4*)(anw + h * 128 + e); const f32x4 v = o[gi][nf] * rn * w;
                u32x2 ww; ww.x = cvtpk(v[0], v[1]); ww.y = cvtpk(v[2], v[3]); if (!dry) *(u32x2*)(qrow + e) = ww; }
        }
    }
}

#ifndef PROBE_PHASE
#define PROBE_PHASE -1
#endif
#define REP_BEGIN(k) for (int rep_ = (PROBE_PHASE == (k)) ? 0 : 1; rep_ < 2; ++rep_) { const bool dry = (rep_ == 0) && (a.dry != 0); (void)dry; \
    int tid = threadIdx.x; asm volatile("" : "+v"(tid)); const int lane = tid & 63, wave = __builtin_amdgcn_readfirstlane(tid >> 6); \
    const int gw = vcu * NWAVES + wave, gt = vcu * (NWAVES * 64) + tid; (void)lane; (void)wave; (void)gw; (void)gt;
#define REP_END }

__global__ void __launch_bounds__(NWAVES * 64, 2) hymba_fwd(Args a) {
    extern __shared__ __attribute__((aligned(16))) unsigned char lds_raw[];
    LAS unsigned char* lds = (LAS unsigned char*)lds_raw;
    volatile LAS unsigned* MISC = (volatile LAS unsigned*)(lds + MISC_OFF);
    const int tid = threadIdx.x, lane = tid & 63, wave = __builtin_amdgcn_readfirstlane(tid >> 6);
    const int G = gridDim.x; const int bx = blockIdx.x; const int vcu = (G % 8 == 0) ? (bx % 8) * (G / 8) + bx / 8 : bx;
    unsigned char* ws = a.ws;
    unsigned* ctl = (unsigned*)(ws + WS_CTL);
    float* gli = (float*)(ws + WS_GLI); float* glf = (float*)(ws + WS_GLF); float* sumsq = (float*)(ws + WS_SUMSQ);
    float* msc_g = (float*)(ws + WS_MSC); float* msc_ml = msc_g + 512; float* msc_mp = msc_g + 1024;
    float* ncb = (float*)(ws + WS_NC);
    float* rcos = (float*)(ws + WS_COS); float* rsin = (float*)(ws + WS_SIN);
    bf16* WinT = (bf16*)(ws + WS_WIN); bf16* kvT = (bf16*)(ws + WS_KV); bf16* Ub = (bf16*)(ws + WS_U); bf16* H1b = (bf16*)(ws + WS_U);
    bf16* proj = (bf16*)(ws + WS_PROJ); bf16* FF = (bf16*)(ws + WS_PROJ);
    bf16* op0 = (bf16*)(ws + WS_OP0); bf16* op1 = (bf16*)(ws + WS_OP1); float* pl0 = (float*)(ws + WS_PL0); float* pl1 = (float*)(ws + WS_PL1);
    bf16* WoutT = (bf16*)(ws + WS_WOUT); bf16* WguT = (bf16*)(ws + WS_WGU); bf16* WdnT = (bf16*)(ws + WS_WDN);

    for (int u = tid; u < (LDS_BYTES - MISC_OFF) / 4; u += NWAVES * 64) ((LAS unsigned*)(lds + MISC_OFF))[u] = 0u;
    __syncthreads();
    XcdBarrier bar = xcd_barrier_post(ctl + CW_BAR, MISC + 8);
    const int NGW = G * NWAVES, NGT = G * NWAVES * 64;

    REP_BEGIN(0)
        for (int i = gt; i < MTOK; i += NGT) sumsq[i] = 0.f;
        for (int i = gt; i < SEQ * 64; i += NGT) {
            const int pos = i >> 6, fi = i & 63;
            const float invf = (float)exp2(-(double)fi * (13.287712379549449 / 64.0));
            const float ang = (float)pos * invf;
            const double rev = (double)ang * 0.15915494309189535; const double fr_ = rev - rint(rev);
            const float ar = (float)(fr_ * 6.283185307179586);
            rcos[i] = cosf(ar); rsin[i] = sinf(ar);
        }
        {
            LAS float* scr = (LAS float*)(lds + wave * 16384);
            constexpr int I_IN = (DM / 64) * (NPROJ / 32), I_OUT = (DM / 64) * (DM / 32), I_GU = (DM / 64) * (NGU / 32), I_DN = (DFF / 64) * (DM / 32);
            constexpr int NITEMS = I_IN + I_OUT + I_GU;
            auto decode = [&](int it) -> TItem {
                TItem t; int r = it;
                if (r < I_IN) { const int nblk = NPROJ / 32, kb = r / nblk, nb = r % nblk; t = TItem{a.w_in, WinT, nullptr, INW, DM, win_src_col(nb * 32), nb * 32, kb * 64}; return t; } r -= I_IN;
                if (r < I_OUT) { const int nblk = DM / 32, kb = r / nblk, nb = r % nblk; t = TItem{a.w_out, WoutT, nullptr, DM, DM, nb * 32, nb * 32, kb * 64}; return t; } r -= I_OUT;
                { const int nblk = NGU / 32, kb = r / nblk, nb = r % nblk; const int nd = nb * 32, pn = nd >> 8, j = nd & 255;
                    t = TItem{(j < 128) ? a.w_gate : a.w_up, WguT, a.norm2_w, DFF, DM, pn * 128 + (j & 127), nd, kb * 64}; return t; }
            };
            int it = gw;
            if (it < NITEMS) {
                TItem cur = decode(it); f32x4 vc[8]; titem_load(cur, vc, lane);
                for (;;) {
                    const int nx = it + NGW; const bool more = nx < NITEMS;
                    TItem nt = cur; f32x4 vn[8];
                    if (more) { nt = decode(nx); titem_load(nt, vn, lane); }
                    titem_finish(cur, vc, scr, lane);
                    if (!more) break;
                    cur = nt; it = nx;
#pragma unroll
                    for (int i = 0; i < 8; ++i) vc[i] = vn[i];
                }
            }
        }
        __syncthreads();
        LAS float* wg = (LAS float*)lds;
        for (int k = tid; k < DM; k += NWAVES * 64) { const f32x4 g0 = *(const f32x4*)(a.w_in + (size_t)k * INW + 3072), g1 = *(const f32x4*)(a.w_in + (size_t)k * INW + 3076);
            wg[0 * DM + k] = g0[0]; wg[1 * DM + k] = g0[1]; wg[2 * DM + k] = g0[2]; wg[3 * DM + k] = g0[3];
            wg[4 * DM + k] = g1[0]; wg[5 * DM + k] = g1[1]; wg[6 * DM + k] = g1[2]; wg[7 * DM + k] = g1[3]; }
        __syncthreads();
        for (int m = gw; m < MTOK; m += NGW) {
            const f32x4* xr = (const f32x4*)(a.x + (size_t)m * DM) + lane; const f32x4* wr_ = (const f32x4*)a.norm1_w + lane;
            f32x4 v[8]; float s = 0.f;
#pragma unroll
            for (int j = 0; j < 8; ++j) { v[j] = __builtin_nontemporal_load(xr + 64 * j); s += (v[j][0] * v[j][0] + v[j][1] * v[j][1]) + (v[j][2] * v[j][2] + v[j][3] * v[j][3]); }
            const float rstd = __builtin_amdgcn_rsqf(wave_sum(s) * (1.0f / DM) + NORM_EPS);
            u32x2* o8 = (u32x2*)(Ub + (size_t)m * DM) + lane;
#pragma unroll
            for (int j = 0; j < 8; ++j) { v[j] = v[j] * rstd * wr_[64 * j]; u32x2 w; w.x = cvtpk(v[j][0], v[j][1]); w.y = cvtpk(v[j][2], v[j][3]); o8[64 * j] = w; }
            float z = 0.f;
#pragma unroll 1
            for (int gi = 0; gi < 8; ++gi) { float t = 0.f;
#pragma unroll
                for (int j = 0; j < 8; ++j) { const f32x4 w4 = *(const LAS f32x4*)(wg + gi * DM + 256 * j + 4 * lane); t += (v[j][0] * w4[0] + v[j][1] * w4[1]) + (v[j][2] * w4[2] + v[j][3] * w4[3]); }
                t = wave_sum(t); z = (lane == gi) ? t : z; }
            if (lane < 8) {
                const int hh = lane & 3;
                if (lane < 4) { gli[m * 4 + hh] = 15.0f * tanhf((z + a.igate_b[hh]) * (1.0f / 15.0f)); }
                else { const float fp = 15.0f * tanhf((z + a.fgate_b[hh]) * (1.0f / 15.0f)); glf[m * 4 + hh] = -log1pf(expf(-fp)); }
            }
        }
    REP_END
    xcd_barrier(bar);

    REP_BEGIN(1)
        pg8::Gemm g{Ub, WinT, MTOK, NPROJ, DM, DM}; pg8::StaticOrder S; S.init(MTOK, NPROJ, G, bx);
        pg8::EpiBf16 E{proj, NPROJ};
        pg8::gemm_phase<pg8::EpiBf16, true>(lds, g, S, E);
    REP_END
    xcd_barrier(bar);

    REP_BEGIN(2)
        {
            const int c0 = 4 * (tid & 15), rstride = NGT >> 4;
            for (int which = 0; which < 2; ++which) {
                const float* nw = which ? a.k_norm_w : a.q_norm_w; const int colb = which ? PC_AK : PC_AQ;
                const f32x4 w1 = *(const f32x4*)(nw + c0), w2 = *(const f32x4*)(nw + 64 + c0);
                for (int idx0 = gt >> 4; idx0 < MTOK * 8; idx0 += 4 * rstride) {
                    u32x2 r1[4], r2[4]; f32x4 cs[4], sn[4];
#pragma unroll
                    for (int q = 0; q < 4; ++q) { const int idx = idx0 + q * rstride;
                        if (idx < MTOK * 8) { const int m = idx >> 3, hh = idx & 7, pos = m & (SEQ - 1); const bf16* kp = proj + (size_t)m * NPROJ + colb + hh * 128;
                            r1[q] = *(const u32x2*)(kp + c0); r2[q] = *(const u32x2*)(kp + 64 + c0); cs[q] = *(const f32x4*)(rcos + pos * 64 + c0); sn[q] = *(const f32x4*)(rsin + pos * 64 + c0); } }
#pragma unroll
                    for (int q = 0; q < 4; ++q) { const int idx = idx0 + q * rstride;
                        if (idx < MTOK * 8) { const int m = idx >> 3, hh = idx & 7; bf16* kp = proj + (size_t)m * NPROJ + colb + hh * 128;
                            float x1[4] = {bf_lo(r1[q].x), bf_hi(r1[q].x), bf_lo(r1[q].y), bf_hi(r1[q].y)}, x2[4] = {bf_lo(r2[q].x), bf_hi(r2[q].x), bf_lo(r2[q].y), bf_hi(r2[q].y)};
                            float ss = 0.f;
#pragma unroll
                            for (int e = 0; e < 4; ++e) ss += x1[e] * x1[e] + x2[e] * x2[e];
                            ss = row16_sum(ss);
                            const float rk = __builtin_amdgcn_rsqf(ss * (1.0f / 128.0f) + NORM_EPS);
                            float o1[4], o2[4];
#pragma unroll
                            for (int e = 0; e < 4; ++e) { const float y1 = x1[e] * rk * w1[e], y2 = x2[e] * rk * w2[e]; o1[e] = y1 * cs[q][e] - y2 * sn[q][e]; o2[e] = y2 * cs[q][e] + y1 * sn[q][e]; }
                            u32x2 wv; wv.x = cvtpk(o1[0], o1[1]); wv.y = cvtpk(o1[2], o1[3]); if (!dry) *(u32x2*)(kp + c0) = wv;
                            wv.x = cvtpk(o2[0], o2[1]); wv.y = cvtpk(o2[2], o2[3]); if (!dry) *(u32x2*)(kp + 64 + c0) = wv; } }
                }
            }
        }
        LAS unsigned char* KW = lds; LAS unsigned char* VT = lds + 18432;
        const int g = lane >> 4, qp = (lane & 15) >> 2, p = lane & 3;
        for (int u = vcu; u < 512; u += G) {
            const int b = u >> 8, h = (u >> 6) & 3, c = u & 63;
            const int tok = b * SEQ + c * 64 + lane;
            const float li = gli[tok * 4 + h], lf = glf[tok * 4 + h];
            u32x4 rawk[2][4], vv[4];
            conv_issue(proj, b, c, PC_MK + h * 128, tid, rawk);
            v_issue(proj, b, c, h, tid, vv);
            const float cf = scan_add64(lf, lane);
            const float gsum = __shfl(cf, 63);
            const float av = gsum - cf + li;
            const float ml = wave_max(av);
            const float wst = __expf(av - ml);
            if (tid == 0) { msc_g[u] = gsum; msc_ml[u] = ml; }
            conv_finish<true>(rawk, a.conv_w, a.conv_b, c, 512 + h * 128, 1.0f, wst, KW, tid);
            v_store(vv, VT, tid);
            __syncthreads();
            f32x4 acc[8][2];
#pragma unroll
            for (int df = 0; df < 8; ++df) { acc[df][0] = (f32x4){0.f, 0.f, 0.f, 0.f}; acc[df][1] = (f32x4){0.f, 0.f, 0.f, 0.f}; }
#pragma unroll
            for (int kk = 0; kk < 2; ++kk) {
                bf16x8 bfr[2];
#pragma unroll
                for (int ef = 0; ef < 2; ++ef) { const int col = 32 * wave + 16 * ef + 4 * p;
                    bfr[ef] = cat4(vtr(VT + (32 * kk + 4 * g + qp) * 544 + col * 2), vtr(VT + (32 * kk + 16 + 4 * g + qp) * 544 + col * 2)); }
#pragma unroll
                for (int df = 0; df < 8; ++df) { const int col = 16 * df + 4 * p;
                    const bf16x8 af = cat4(vtr(KW + (32 * kk + 4 * g + qp) * 288 + col * 2), vtr(KW + (32 * kk + 16 + 4 * g + qp) * 288 + col * 2));
                    acc[df][0] = MFMA16(af, bfr[0], acc[df][0]); acc[df][1] = MFMA16(af, bfr[1], acc[df][1]); }
            }
#pragma unroll
            for (int ef = 0; ef < 2; ++ef) { const int e = 32 * wave + 16 * ef + (lane & 15);
#pragma unroll
                for (int df = 0; df < 8; ++df) { const f32x4 v = acc[df][ef]; u32x2 w; w.x = cvtpk(v[0], v[1]); w.y = cvtpk(v[2], v[3]);
                    *(u32x2*)(kvT + ((size_t)u * 256 + e) * 128 + 16 * df + 4 * g) = w; } }
            if (tid < 128) { float nsum = 0.f;
#pragma unroll 8
                for (int l = 0; l < 64; ++l) nsum += __uint_as_float((unsigned)(*(const LAS unsigned short*)(KW + l * 288 + tid * 2)) << 16);
                ncb[u * 128 + tid] = nsum; }
            __syncthreads();
        }
    REP_END
    xcd_barrier(bar);

    REP_BEGIN(3)
        LAS float* sg = (LAS float*)lds; LAS float* sml = sg + 512;
        for (int i = tid; i < 512; i += NWAVES * 64) { sg[i] = msc_g[i]; sml[i] = msc_ml[i]; }
        __syncthreads();
        for (int id = gt; id < 8 * 16384; id += NGT) {
            const int bh = id >> 14, pi = id & 16383;
            unsigned* base = (unsigned*)kvT + (size_t)bh * 64 * 16384 + pi;
            float c0 = 0.f, c1 = 0.f, m = 0.f;
#pragma unroll 1
            for (int cb = 0; cb < 64; cb += 32) {
                unsigned xv[32];
#pragma unroll
                for (int i = 0; i < 32; ++i) xv[i] = base[(size_t)(cb + i) * 16384];
#pragma unroll
                for (int i = 0; i < 32; ++i) {
                    const float gg = sg[bh * 64 + cb + i], ml = sml[bh * 64 + cb + i];
                    const float mn = fmaxf(gg + m, ml), so = __expf(gg + m - mn), sn = __expf(ml - mn);
                    if (!dry) base[(size_t)(cb + i) * 16384] = cvtpk(c0, c1);
                    c0 = so * c0 + sn * bf_lo(xv[i]); c1 = so * c1 + sn * bf_hi(xv[i]); m = mn;
                }
            }
        }
        for (int id = gt; id < 8 * 128; id += NGT) {
            const int bh = id >> 7, dd = id & 127; float n = 0.f, m = 0.f;
            float* nb_ = ncb + (size_t)bh * 64 * 128 + dd;
#pragma unroll 1
            for (int cb = 0; cb < 64; cb += 32) {
                float xv[32];
#pragma unroll
                for (int i = 0; i < 32; ++i) xv[i] = nb_[(cb + i) * 128];
#pragma unroll
                for (int i = 0; i < 32; ++i) {
                    const float gg = sg[bh * 64 + cb + i], ml = sml[bh * 64 + cb + i];
                    const float mn = fmaxf(gg + m, ml), so = __expf(gg + m - mn), sn = __expf(ml - mn);
                    if (!dry) nb_[(cb + i) * 128] = n;
                    if (dd == 0) msc_mp[bh * 64 + cb + i] = m;
                    n = so * n + sn * xv[i]; m = mn;
                }
            }
        }
        __syncthreads();
    REP_END
    REP_BEGIN(4)
        for (int pidx = vcu; pidx < 512; pidx += G) {
            AUnit ua, ub;
            { const int u = pidx; ua = AUnit{u >> 8, (u >> 5) & 7, 4, (u >> 3) & 3, u & 7, op0, pl0}; }
            { const int v = pidx; const int bb = v >> 8; ub = AUnit{bb, (v >> 5) & 7, 16, (v >> 1) & 15, (v ^ bb) & 1, op1, pl1}; }
            attn_pair<false>(proj, rcos, rsin, a.q_norm_w, a.k_norm_w, a.attn_norm_w, ua, ub, lds, nullptr, nullptr, tid, dry);
        }
    REP_END
    xcd_barrier(bar);

    REP_BEGIN(5)
        LAS unsigned char* QT = lds; LAS unsigned char* KT = lds + 18432; LAS unsigned char* VT = lds + 36864;
        LAS float* NP = (LAS float*)(lds + 71680); LAS float* XCH = (LAS float*)(lds + 72192); LAS unsigned char* CP = lds + 72704;
        const int j = lane & 15, g = lane >> 4, qp = j >> 2, p = lane & 3;
        const int tf = wave & 3, eh = wave >> 2;
        for (int u = vcu; u < 512; u += G) {
            const int b = u >> 8, h = (u >> 6) & 3, c = u & 63;
            const int tok = b * SEQ + c * 64 + lane;
            const float li = gli[tok * 4 + h], lf = glf[tok * 4 + h];
            const float mprev = msc_mp[u];
            const bf16* csrc = kvT + (size_t)u * 256 * 128 + (size_t)(tid >> 4) * 128 + (tid & 15) * 8;
            u32x4 rawq[2][4], rawk[2][4], vv[4], cv[8];
            conv_issue(proj, b, c, PC_MQ + h * 128, tid, rawq);
            conv_issue(proj, b, c, PC_MK + h * 128, tid, rawk);
            v_issue(proj, b, c, h, tid, vv);
#pragma unroll
            for (int it = 0; it < 8; ++it) cv[it] = *(const u32x4*)(csrc + (size_t)it * 32 * 128);
            float npv = 0.f; if (tid < 128) npv = ncb[u * 128 + tid];
            const float cf = scan_add64(lf, lane);
            const float bvec = li - cf;
            const float pm = scan_max64(bvec, lane);
            const float Mv = fmaxf(mprev, pm);
            const float wiv = __expf(mprev - Mv), emtv = __expf(-cf - Mv);
            conv_finish<false>(rawq, a.conv_w, a.conv_b, c, h * 128, 0.08838834764831845f, 0.f, QT, tid);
            conv_finish<false>(rawk, a.conv_w, a.conv_b, c, 512 + h * 128, 1.0f, 0.f, KT, tid);
            v_store(vv, VT, tid);
#pragma unroll
            for (int it = 0; it < 8; ++it) *(LAS u32x4*)(CP + (it * 32 + (tid >> 4)) * 288 + (tid & 15) * 16) = cv[it];
            const int t_ = 16 * (wave & 3) + j;
            const bf16* orow_ = proj + (size_t)(b * SEQ + c * 64 + t_) * NPROJ;
            u32x2 mo_pre[8];
#pragma unroll
            for (int ef = 0; ef < 8; ++ef) mo_pre[ef] = *(const u32x2*)(orow_ + PC_MO + h * 256 + 128 * eh + 16 * ef + 4 * g);
            if (tid < 128) NP[tid] = npv;
            __syncthreads();
            const int t = 16 * tf + j;
            const float M_t = __shfl(Mv, t), wi_t = __shfl(wiv, t), emt_t = __shfl(emtv, t);
            bf16x8 qf[4];
#pragma unroll
            for (int ks = 0; ks < 4; ++ks) qf[ks] = *(const LAS bf16x8*)(QT + t * 288 + (32 * ks + 8 * g) * 2);
            float sp[4][4]; float rowsum = 0.f;
#pragma unroll
            for (int sf = 0; sf < 4; ++sf) {
                f32x4 sa = {0.f, 0.f, 0.f, 0.f};
#pragma unroll
                for (int ks = 0; ks < 4; ++ks) { const bf16x8 kfr = *(const LAS bf16x8*)(KT + (16 * sf + j) * 288 + (32 * ks + 8 * g) * 2); sa = MFMA16(kfr, qf[ks], sa); }
#pragma unroll
                for (int rg = 0; rg < 4; ++rg) { const int sidx = 16 * sf + 4 * g + rg; const float bs = __shfl(bvec, sidx);
                    const float pv = (sidx <= t) ? __expf(bs - M_t) : 0.f; sp[sf][rg] = sa[rg] * pv; rowsum += sp[sf][rg]; }
            }
            bf16x8 pb[2];
#pragma unroll
            for (int kk = 0; kk < 2; ++kk) { float tmp[8] = {sp[2 * kk][0], sp[2 * kk][1], sp[2 * kk][2], sp[2 * kk][3], sp[2 * kk + 1][0], sp[2 * kk + 1][1], sp[2 * kk + 1][2], sp[2 * kk + 1][3]};
                const u32x4 w = pack8(tmp); pb[kk] = __builtin_bit_cast(bf16x8, w); }
            f32x4 ai[8], ae[8];
#pragma unroll
            for (int ef = 0; ef < 8; ++ef) { ai[ef] = (f32x4){0.f, 0.f, 0.f, 0.f}; ae[ef] = (f32x4){0.f, 0.f, 0.f, 0.f}; }
#pragma unroll
            for (int kk = 0; kk < 2; ++kk) {
#pragma unroll
                for (int ef = 0; ef < 8; ++ef) { const int col = 128 * eh + 16 * ef + 4 * p;
                    const bf16x8 af = cat4(vtr(VT + (32 * kk + 4 * g + qp) * 544 + col * 2), vtr(VT + (32 * kk + 16 + 4 * g + qp) * 544 + col * 2));
                    ai[ef] = MFMA16(af, pb[kk], ai[ef]); }
            }
#pragma unroll
            for (int ef = 0; ef < 8; ++ef) {
#pragma unroll
                for (int ks = 0; ks < 4; ++ks) { const bf16x8 cfr = *(const LAS bf16x8*)(CP + (128 * eh + 16 * ef + j) * 288 + (32 * ks + 8 * g) * 2); ae[ef] = MFMA16(cfr, qf[ks], ae[ef]); }
            }
            float qn = 0.f;
#pragma unroll
            for (int ks = 0; ks < 4; ++ks) { float qv[8]; unpack8(__builtin_bit_cast(u32x4, qf[ks]), qv);
#pragma unroll
                for (int e = 0; e < 8; ++e) qn += qv[e] * NP[32 * ks + 8 * g + e]; }
            qn = xg_sum(qn);
            rowsum = xg_sum(rowsum);
            const float den = wi_t * qn + rowsum;
            const float dinv = __builtin_amdgcn_rcpf(fmaxf(fabsf(den), emt_t));
            float ssq = 0.f;
#pragma unroll
            for (int ef = 0; ef < 8; ++ef) { ai[ef] = (ae[ef] * wi_t + ai[ef]) * dinv; ssq += (ai[ef][0] * ai[ef][0] + ai[ef][1] * ai[ef][1]) + (ai[ef][2] * ai[ef][2] + ai[ef][3] * ai[ef][3]); }
            ssq = xg_sum(ssq);
            if (g == 0) XCH[eh * 64 + t] = ssq;
            __syncthreads();
            const float rn = __builtin_amdgcn_rsqf((XCH[t] + XCH[64 + t]) * (1.0f / 256.0f) + NORM_EPS);
            bf16* orow = proj + (size_t)(b * SEQ + c * 64 + t) * NPROJ;
#pragma unroll
            for (int ef = 0; ef < 8; ++ef) { const int e = 128 * eh + 16 * ef + 4 * g;
                const f32x4 nw = *(const f32x4*)(a.mlstm_norm_w + h * 256 + e);
                const u32x2 mo = mo_pre[ef];
                const float mof[4] = {bf_lo(mo.x), bf_hi(mo.x), bf_lo(mo.y), bf_hi(mo.y)};
                float r4[4];
#pragma unroll
                for (int e2 = 0; e2 < 4; ++e2) r4[e2] = ai[ef][e2] * rn * nw[e2] * __builtin_amdgcn_rcpf(1.0f + __expf(-mof[e2]));
                u32x2 w; w.x = cvtpk(r4[0], r4[1]); w.y = cvtpk(r4[2], r4[3]); if (!dry) *(u32x2*)(orow + PC_MV + h * 256 + e) = w; }
            __syncthreads();
        }
        for (int pidx = vcu; pidx < 256; pidx += G) {
            const AUnit ua{0, (pidx >> 5) & 7, 1, 0, pidx & 31, op0, pl0}, ub{1, (pidx >> 5) & 7, 1, 0, pidx & 31, op0, pl0};
            attn_pair<true>(proj, rcos, rsin, a.q_norm_w, a.k_norm_w, a.attn_norm_w, ua, ub, lds, op1, pl1, tid, dry);
        }
    REP_END
    xcd_barrier(bar);

    REP_BEGIN(6)
        pg8::Gemm g{proj + PC_MV, WoutT, MTOK, DM, DM, NPROJ}; pg8::StaticOrder S; S.init(MTOK, DM, G, bx);
        pg8::EpiRes1 E{a.x, a.out, H1b, sumsq, DM, dry};
        pg8::gemm_phase<pg8::EpiRes1, false>(lds, g, S, E);
    REP_END
    xcd_barrier(bar);

    REP_BEGIN(7)
        pg8::Gemm g{H1b, WguT, MTOK, NGU, DM, DM}; pg8::StaticOrder S; S.init(MTOK, NGU, G, bx);
        LAS float* rsl = (LAS float*)(lds + RING_BYTES);
        { pg8::Unit uu; for (int i = 0; i < 8 && S.next(i, uu); ++i) if (tid < 256) rsl[i * 256 + tid] = __builtin_amdgcn_rsqf(sumsq[uu.pm * 256 + tid] * (1.0f / DM) + NORM_EPS); }
        __syncthreads();
        pg8::EpiSwiGLU E{FF, DFF, rsl, sumsq};
        pg8::gemm_phase<pg8::EpiSwiGLU, true>(lds, g, S, E);
        if (rep_ == 1) {
            const int nfull = (MTOK / 256) * (NGU / 256) - 5 * G;
            const int nidle = G - nfull;
            if (G == 256 ? (bx >= nfull) : true) {
                LAS float* scr = (LAS float*)(lds + wave * 16384);
                constexpr int I_DN = (DFF / 64) * (DM / 32);
                const int w0 = (G == 256) ? (bx - nfull) * NWAVES + wave : gw, nw = (G == 256) ? nidle * NWAVES : NGW;
                for (int it = w0; it < I_DN; it += nw) { const int nblk = DM / 32, kb = it / nblk, nb = it % nblk;
                    const TItem t{a.w_down, WdnT, nullptr, DM, DFF, nb * 32, nb * 32, kb * 64}; f32x4 v[8]; titem_load(t, v, lane); titem_finish(t, v, scr, lane); }
            }
        }
    REP_END
    xcd_barrier(bar);

    REP_BEGIN(8)
        pg8::Gemm g{FF, WdnT, MTOK, DM, DFF, DFF}; pg8::StaticOrder S; S.init(MTOK, DM, G, bx);
        pg8::EpiRes2 E{H1b, a.out, DM, dry};
        pg8::gemm_phase<pg8::EpiRes2, false>(lds, g, S, E);
    REP_END
}

extern "C" void kernel_launch(void* const* d_in, const int* in_sizes, int n_in, void* d_out, int out_size, void* d_ws, size_t ws_size, hipStream_t stream) {
    static int grid = 0;
    if (grid == 0) {
        if (n_in != 16 || in_sizes[0] != MTOK * DM || out_size != MTOK * DM || ws_size < WS_END) { fprintf(stderr, "kernel_launch: unexpected shapes (n_in %d in0 %d out %d ws %zu)\n", n_in, n_in > 0 ? in_sizes[0] : -1, out_size, ws_size); grid = -1; return; }
        int dev = 0, cus = 0;
        if (hipGetDevice(&dev) != hipSuccess || hipDeviceGetAttribute(&cus, hipDeviceAttributeMultiprocessorCount, dev) != hipSuccess || cus <= 0) cus = 256;
        if (hipFuncSetAttribute((const void*)hymba_fwd, hipFuncAttributeMaxDynamicSharedMemorySize, LDS_BYTES) != hipSuccess) { fprintf(stderr, "kernel_launch: hipFuncSetAttribute failed\n"); grid = -1; return; }
        (void)hipGetLastError();
        grid = cus;
    }
    if (grid < 0) return;
    if (hipMemsetAsync((char*)d_ws + WS_CTL, 0, CTL_ZERO_BYTES, stream) != hipSuccess) { fprintf(stderr, "kernel_launch: memset failed\n"); return; }
    Args a{};
    a.x = (const float*)d_in[0]; a.norm1_w = (const float*)d_in[1]; a.w_in = (const float*)d_in[2]; a.conv_w = (const float*)d_in[3]; a.conv_b = (const float*)d_in[4];
    a.igate_b = (const float*)d_in[5]; a.fgate_b = (const float*)d_in[6]; a.q_norm_w = (const float*)d_in[7]; a.k_norm_w = (const float*)d_in[8];
    a.mlstm_norm_w = (const float*)d_in[9]; a.attn_norm_w = (const float*)d_in[10]; a.w_out = (const float*)d_in[11]; a.norm2_w = (const float*)d_in[12];
    a.w_gate = (const float*)d_in[13]; a.w_up = (const float*)d_in[14]; a.w_down = (const float*)d_in[15];
    a.out = (float*)d_out; a.ws = (unsigned char*)d_ws; a.dry = (PROBE_PHASE >= 0) ? 1 : 0;
    hipLaunchKernelGGL(hymba_fwd, dim3(grid), dim3(NWAVES * 64), LDS_BYTES, stream, a);
}
```

```cpp
#include <hip/hip_runtime.h>
#include <cstdio>
#include <cstdint>

#define LAS __attribute__((address_space(3)))
#define GAS __attribute__((address_space(1)))
typedef unsigned short bf16;
typedef short bf16x8 __attribute__((ext_vector_type(8)));
typedef short s16x4 __attribute__((ext_vector_type(4)));
typedef float f32x4 __attribute__((ext_vector_type(4)));
typedef float f32x2 __attribute__((ext_vector_type(2)));
typedef unsigned u32x4 __attribute__((ext_vector_type(4)));
typedef unsigned u32x2 __attribute__((ext_vector_type(2)));
typedef __bf16 bf16x2_t __attribute__((ext_vector_type(2)));

constexpr int BATCH = 2, SEQ = 4096, DM = 2048, MTOK = BATCH * SEQ;
constexpr int INW = 6152, NPROJ = 6144, DFF = 5632, NGU = 2 * DFF;
constexpr int PC_MQ = 0, PC_MK = 512, PC_MO = 1024, PC_MV = 2048, PC_AQ = 3072, PC_AK = 4096, PC_AV = 5120;
constexpr float NORM_EPS = 1e-6f;
constexpr int NWAVES = 8;

constexpr size_t MiB = 1u << 20;
constexpr size_t WS_CTL = 0, CTL_ZERO_BYTES = 32 * 1024;
constexpr size_t WS_GLI = 1 * MiB;
constexpr size_t WS_GLF = WS_GLI + 128 * 1024;
constexpr size_t WS_SUMSQ = WS_GLF + 128 * 1024;
constexpr size_t WS_MSC = WS_SUMSQ + 32 * 1024;
constexpr size_t WS_NC = WS_MSC + 8 * 1024;
constexpr size_t WS_COS = 2 * MiB, WS_SIN = 3 * MiB;
constexpr size_t WS_WIN = 6 * MiB;
constexpr size_t WS_KV = 6 * MiB;
constexpr size_t WS_U = 30 * MiB;
constexpr size_t WS_PROJ = 62 * MiB;
constexpr size_t WS_WOUT = 158 * MiB;
constexpr size_t WS_WGU = 166 * MiB;
constexpr size_t WS_WDN = 210 * MiB;
constexpr size_t WS_OP0 = 38 * MiB;
constexpr size_t WS_OP1 = 232 * MiB;
constexpr size_t WS_PL0 = 248 * MiB, WS_PL1 = WS_PL0 + 256 * 1024;
constexpr size_t WS_END = 249 * MiB;
constexpr int CW_BAR = 4096;

constexpr int RING_BYTES = 131072;
constexpr int MISC_OFF = 147456 - 256;
constexpr int LDS_BYTES = 147456;

__device__ __forceinline__ unsigned cvtpk(float lo, float hi) { f32x2 v = {lo, hi}; bf16x2_t b = __builtin_convertvector(v, bf16x2_t); return __builtin_bit_cast(unsigned, b); }
__device__ __forceinline__ float bf_lo(unsigned w) { return __uint_as_float(w << 16); }
__device__ __forceinline__ float bf_hi(unsigned w) { return __uint_as_float(w & 0xffff0000u); }
__device__ __forceinline__ void unpack8(u32x4 w, float* f) { f[0] = bf_lo(w.x); f[1] = bf_hi(w.x); f[2] = bf_lo(w.y); f[3] = bf_hi(w.y); f[4] = bf_lo(w.z); f[5] = bf_hi(w.z); f[6] = bf_lo(w.w); f[7] = bf_hi(w.w); }
__device__ __forceinline__ u32x4 pack8(const float* f) { u32x4 w; w.x = cvtpk(f[0], f[1]); w.y = cvtpk(f[2], f[3]); w.z = cvtpk(f[4], f[5]); w.w = cvtpk(f[6], f[7]); return w; }
#define DPP_MOV_F(v, ctrl) __uint_as_float((unsigned)__builtin_amdgcn_mov_dpp((int)__float_as_uint(v), (ctrl), 0xf, 0xf, true))
__device__ __forceinline__ float row16_sum(float v) { v += DPP_MOV_F(v, 0xB1); v += DPP_MOV_F(v, 0x4E); v += DPP_MOV_F(v, 0x124); v += DPP_MOV_F(v, 0x128); return v; }
__device__ __forceinline__ float x16_sum(float v) { const auto r = __builtin_amdgcn_permlane16_swap(__float_as_uint(v), __float_as_uint(v), false, false); return __uint_as_float(r[0]) + __uint_as_float(r[1]); }
__device__ __forceinline__ float x32_sum(float v) { const auto r = __builtin_amdgcn_permlane32_swap(__float_as_uint(v), __float_as_uint(v), false, false); return __uint_as_float(r[0]) + __uint_as_float(r[1]); }
__device__ __forceinline__ float x16_max(float v) { const auto r = __builtin_amdgcn_permlane16_swap(__float_as_uint(v), __float_as_uint(v), false, false); return fmaxf(__uint_as_float(r[0]), __uint_as_float(r[1])); }
__device__ __forceinline__ float x32_max(float v) { const auto r = __builtin_amdgcn_permlane32_swap(__float_as_uint(v), __float_as_uint(v), false, false); return fmaxf(__uint_as_float(r[0]), __uint_as_float(r[1])); }
__device__ __forceinline__ float xg_sum(float v) { return x32_sum(x16_sum(v)); }
__device__ __forceinline__ float xg_max(float v) { return x32_max(x16_max(v)); }
__device__ __forceinline__ float wave_sum(float v) { return xg_sum(row16_sum(v)); }
__device__ __forceinline__ float wave_max(float v) {
#pragma unroll
    for (int o = 1; o < 64; o <<= 1) v = fmaxf(v, __shfl_xor(v, o));
    return v;
}
__device__ __forceinline__ s16x4 vtr(const LAS unsigned char* p) { return __builtin_bit_cast(s16x4, __builtin_amdgcn_ds_read_tr16_b64_v4i16((LAS s16x4*)p)); }
__device__ __forceinline__ bf16x8 cat4(s16x4 a, s16x4 b) { return (bf16x8){a[0], a[1], a[2], a[3], b[0], b[1], b[2], b[3]}; }
#define LDS_WAIT() asm volatile("s_waitcnt lgkmcnt(0)" ::: "memory")
#define VM_WAIT() asm volatile("s_waitcnt vmcnt(0)" ::: "memory")
#define SBAR() __builtin_amdgcn_sched_barrier(0)
#define MFMA16(a, b, c) __builtin_amdgcn_mfma_f32_16x16x32_bf16((a), (b), (c), 0, 0, 0)

namespace pg8 {
constexpr int BM = 256, BK = 64, HALF = 128, HTB = HALF * BK * 2, STAGE_BYTES = 8 * HTB, NXCD = 8, WGM = 8;
__host__ __device__ __forceinline__ int lds_byte(int r, int c) { const int st = (r >> 4) * 2 + (c >> 5), rr = r & 15, cc = c & 31, ob = rr * 64 + cc * 2; return st * 1024 + (ob ^ (((ob >> 9) & 1) << 5)); }
__host__ __device__ __forceinline__ void stage_rc(int b, int& R, int& C) { const int st = b / 1024, sb = b % 1024, swz = sb ^ (((sb >> 9) & 1) << 5); R = (st >> 1) * 16 + swz / 64; C = (st & 1) * 32 + (swz % 64) / 2; }
__host__ __device__ __forceinline__ int perm32(int rho) { const int n = rho >> 4, i = rho & 15; return 8 * (i >> 2) + 4 * n + (i & 3); }
struct Unit { int pm, pn, ord; };
struct Gemm { const bf16* A; const bf16* Bt; int M, N, K, lda; };
struct StaticOrder {
    int nM, nN, nwg, G, c;
    __device__ void init(int M, int N, int G_, int c_) { nM = M / BM; nN = N / BM; nwg = nM * nN; G = G_; c = c_; }
    __device__ bool next(int i, Unit& u) const {
        const long L = (long)i * G + c; if (L >= nwg) return false; u.ord = i;
        int wgid = (int)L; { const int q = nwg / NXCD, r = nwg % NXCD, xcd = wgid % NXCD, off = wgid / NXCD; wgid = (xcd < r ? xcd * (q + 1) : r * (q + 1) + (xcd - r) * q) + off; }
        const int nig = WGM * nN, gid = wgid / nig, fm = gid * WGM, gsz = (nM - fm) < WGM ? (nM - fm) : WGM;
        u.pm = fm + ((wgid % nig) % gsz); u.pn = (wgid % nig) / gsz; return true;
    }
};
struct EpiBf16 {
    static constexpr bool PERM = true, HAS_INIT = false;
    bf16* O; int ldc;
    __device__ __forceinline__ void operator()(const f32x4 (&acc)[2][2][4][2], const Unit& u, int wr, int wc, int fr, int fq) const {
        const int row0 = u.pm * BM + wr * 64 + fr, col0 = u.pn * BM + wc * 32 + 8 * fq;
#pragma unroll
        for (int ai = 0; ai < 2; ++ai)
#pragma unroll
            for (int m = 0; m < 4; ++m) { bf16* rowp = O + (size_t)(row0 + ai * HALF + m * 16) * ldc + col0;
#pragma unroll
                for (int bj = 0; bj < 2; ++bj) { const f32x4 v0 = acc[ai][bj][m][0], v1 = acc[ai][bj][m][1];
                    u32x4 w; w.x = cvtpk(v0[0], v0[1]); w.y = cvtpk(v0[2], v0[3]); w.z = cvtpk(v1[0], v1[1]); w.w = cvtpk(v1[2], v1[3]);
                    *(u32x4*)(rowp + bj * HALF) = w; } }
    }
};
struct EpiRes1 {
    static constexpr bool PERM = false, HAS_INIT = true;
    const float* xres; float* out; bf16* h1b; float* sumsq; int ldc; bool dry;
    __device__ __forceinline__ void init(f32x4 (&acc)[2][2][4][2], const Unit& u, int wr, int wc, int fr, int fq) const {
        const int col0 = u.pn * BM + wc * 32 + 4 * fq;
#pragma unroll
        for (int ai = 0; ai < 2; ++ai)
#pragma unroll
            for (int m = 0; m < 4; ++m) { const size_t off = (size_t)(u.pm * BM + ai * HALF + wr * 64 + m * 16 + fr) * ldc + col0;
#pragma unroll
                for (int bj = 0; bj < 2; ++bj)
#pragma unroll
                    for (int n = 0; n < 2; ++n) acc[ai][bj][m][n] = __builtin_nontemporal_load((const f32x4*)(xres + off + bj * HALF + n * 16)); }
    }
    __device__ __forceinline__ void operator()(const f32x4 (&acc)[2][2][4][2], const Unit& u, int wr, int wc, int fr, int fq) const {
        const int col0 = u.pn * BM + wc * 32 + 4 * fq;
#pragma unroll
        for (int ai = 0; ai < 2; ++ai)
#pragma unroll
            for (int m = 0; m < 4; ++m) { const int row = u.pm * BM + ai * HALF + wr * 64 + m * 16 + fr; const size_t off = (size_t)row * ldc + col0; float ss = 0.f;
#pragma unroll
                for (int bj = 0; bj < 2; ++bj)
#pragma unroll
                    for (int n = 0; n < 2; ++n) { const size_t o2 = off + bj * HALF + n * 16; const f32x4 h = acc[ai][bj][m][n];
                        u32x2 w; w.x = cvtpk(h[0], h[1]); w.y = cvtpk(h[2], h[3]); if (!dry) { *(u32x2*)(h1b + o2) = w; }
                        ss += (h[0] * h[0] + h[1] * h[1]) + (h[2] * h[2] + h[3] * h[3]); }
                ss = xg_sum(ss);
                if (fq == 0 && !dry) atomicAdd(sumsq + row, ss); }
    }
};
struct EpiSwiGLU {
    static constexpr bool PERM = true, HAS_INIT = false;
    bf16* O; int ldc; const LAS float* rsl; const float* sumsq;
    __device__ __forceinline__ void operator()(const f32x4 (&acc)[2][2][4][2], const Unit& u, int wr, int wc, int fr, int fq) const {
        const int col0 = u.pn * HALF + wc * 32 + 8 * fq;
#pragma unroll
        for (int ai = 0; ai < 2; ++ai)
#pragma unroll
            for (int m = 0; m < 4; ++m) { const int rl = ai * HALF + wr * 64 + m * 16 + fr; const int row = u.pm * BM + rl;
                const float rs = (u.ord < 8) ? rsl[u.ord * 256 + rl] : __builtin_amdgcn_rsqf(sumsq[row] * (1.0f / DM) + NORM_EPS);
                float f[8];
#pragma unroll
                for (int n = 0; n < 2; ++n)
#pragma unroll
                    for (int j = 0; j < 4; ++j) { const float g = acc[ai][0][m][n][j] * rs, up = acc[ai][1][m][n][j] * rs; f[n * 4 + j] = g * __builtin_amdgcn_rcpf(1.0f + __expf(-g)) * up; }
                *(u32x4*)(O + (size_t)row * ldc + col0) = pack8(f); }
    }
};
struct EpiRes2 {
    static constexpr bool PERM = false, HAS_INIT = true;
    const bf16* h1b; float* out; int ldc; bool dry;
    __device__ __forceinline__ void init(f32x4 (&acc)[2][2][4][2], const Unit& u, int wr, int wc, int fr, int fq) const {
        const int col0 = u.pn * BM + wc * 32 + 4 * fq;
#pragma unroll
        for (int ai = 0; ai < 2; ++ai)
#pragma unroll
            for (int m = 0; m < 4; ++m) { const size_t off = (size_t)(u.pm * BM + ai * HALF + wr * 64 + m * 16 + fr) * ldc + col0;
#pragma unroll
                for (int bj = 0; bj < 2; ++bj)
#pragma unroll
                    for (int n = 0; n < 2; ++n) { const u32x2 w = __builtin_nontemporal_load((const u32x2*)(h1b + off + bj * HALF + n * 16)); acc[ai][bj][m][n] = (f32x4){bf_lo(w.x), bf_hi(w.x), bf_lo(w.y), bf_hi(w.y)}; } }
    }
    __device__ __forceinline__ void operator()(const f32x4 (&acc)[2][2][4][2], const Unit& u, int wr, int wc, int fr, int fq) const {
        const int col0 = u.pn * BM + wc * 32 + 4 * fq;
#pragma unroll
        for (int ai = 0; ai < 2; ++ai)
#pragma unroll
            for (int m = 0; m < 4; ++m) { const size_t off = (size_t)(u.pm * BM + ai * HALF + wr * 64 + m * 16 + fr) * ldc + col0;
#pragma unroll
                for (int bj = 0; bj < 2; ++bj)
#pragma unroll
                    for (int n = 0; n < 2; ++n) { if (!dry) __builtin_nontemporal_store(acc[ai][bj][m][n], (f32x4*)(out + off + bj * HALF + n * 16)); } }
    }
};

template <class Epi, bool ALIGN_EPI>
__device__ __forceinline__ void gemm_phase(LAS unsigned char* lds, const Gemm g, const StaticOrder& S, const Epi& E) {
    int tid = threadIdx.x; asm volatile("" : "+v"(tid));
    const int wid = __builtin_amdgcn_readfirstlane(tid >> 6), lane = tid & 63, wr = wid >> 2, wc = wid & 3, fr = lane & 15, fq = lane >> 4;
    const int K = g.K, nt = K / BK;
    unsigned voffA[2], voffB[2];
#pragma unroll
    for (int i = 0; i < 2; ++i) { int R, C; stage_rc(tid * 16 + i * 8192, R, C); const int Rb = Epi::PERM ? ((R & ~31) + perm32(R & 31)) : R;
        voffA[i] = (unsigned)(R * g.lda + C) * 2u; voffB[i] = (unsigned)(Rb * K + C) * 2u; }
    const size_t kstep = (size_t)(BK * 2);
    const size_t hstepA = (size_t)HALF * g.lda * 2, hstepB = (size_t)HALF * K * 2;
    const size_t tstepA = 2 * hstepA, tstepB = 2 * hstepB;
    const unsigned ldsw = (unsigned)wid * 1024u;
    const int aoff = lds_byte(wr * 64 + fr, fq * 8), boff = lds_byte(wc * 32 + fr, fq * 8);
#define PG8_SA(b, h) (((b) * 2 + (h)) * HTB)
#define PG8_SB(b, h) ((4 + (b) * 2 + (h)) * HTB)
#define PG8_STAGE(bufoff, gbase, voff) do { _Pragma("unroll") for (int _i = 0; _i < 2; ++_i) \
        __builtin_amdgcn_global_load_lds((const unsigned*)((const char*)(gbase) + (voff)[_i]), (LAS unsigned*)(lds + (bufoff) + ldsw + _i * 8192), 16, 0, 0); } while (0)
#define PG8_LDA(dst, b, h) do { _Pragma("unroll") for (int m = 0; m < 4; ++m) _Pragma("unroll") for (int k = 0; k < 2; ++k) dst[m][k] = *(const LAS bf16x8*)(lds + PG8_SA(b, h) + aoff + m * 2048 + k * 1024); } while (0)
#define PG8_LDB(dst, b, h) do { _Pragma("unroll") for (int n = 0; n < 2; ++n) _Pragma("unroll") for (int k = 0; k < 2; ++k) dst[n][k] = *(const LAS bf16x8*)(lds + PG8_SB(b, h) + boff + n * 2048 + k * 1024); } while (0)
#define PG8_MMA(ai, bj, At, Bt) do { __builtin_amdgcn_s_setprio(1); _Pragma("unroll") for (int m = 0; m < 4; ++m) _Pragma("unroll") for (int n = 0; n < 2; ++n) _Pragma("unroll") for (int k = 0; k < 2; ++k) \
        acc[ai][bj][m][n] = __builtin_amdgcn_mfma_f32_16x16x32_bf16(Bt[n][k], At[m][k], acc[ai][bj][m][n], 0, 0, 0); __builtin_amdgcn_s_setprio(0); } while (0)
#define PG8_WAIT_V(n) asm volatile("s_waitcnt vmcnt(" #n ")" ::: "memory")
#define PG8_WAIT_L(n) asm volatile("s_waitcnt lgkmcnt(" #n ")" ::: "memory")
#define PG8_BAR __builtin_amdgcn_s_barrier()
#define PG8_SCHED __builtin_amdgcn_sched_barrier(0)
    Unit cur, nxt; int ui = 0;
    if (!S.next(0, cur)) return;
    f32x4 acc[2][2][4][2];
    if constexpr (Epi::HAS_INIT) { E.init(acc, cur, wr, wc, fr, fq); }
    else {
#pragma unroll
    for (int a = 0; a < 2; ++a)
#pragma unroll
        for (int b = 0; b < 2; ++b)
#pragma unroll
            for (int m = 0; m < 4; ++m)
#pragma unroll
                for (int n = 0; n < 2; ++n) acc[a][b][m][n] = (f32x4){0.f, 0.f, 0.f, 0.f};
    }
    bf16x8 At[4][2], B0[2][2], B1[2][2];
    const char* cA = (const char*)g.A + (size_t)cur.pm * tstepA; const char* cB = (const char*)g.Bt + (size_t)cur.pn * tstepB;
    PG8_STAGE(PG8_SB(0, 0), cB, voffB); PG8_STAGE(PG8_SB(0, 1), cB + hstepB, voffB); PG8_STAGE(PG8_SA(0, 0), cA, voffA); PG8_STAGE(PG8_SA(0, 1), cA + hstepA, voffA);
    if (wr == 1) PG8_BAR;
    PG8_WAIT_V(2); PG8_BAR;
    PG8_STAGE(PG8_SB(1, 0), cB + kstep, voffB); PG8_STAGE(PG8_SA(1, 0), cA + kstep, voffA); PG8_STAGE(PG8_SB(1, 1), cB + hstepB + kstep, voffB);
    PG8_WAIT_V(6); PG8_BAR;
    for (;;) {
        const bool has_next = S.next(ui + 1, nxt);
        const char* nA = has_next ? (const char*)g.A + (size_t)nxt.pm * tstepA : cA; const char* nB = has_next ? (const char*)g.Bt + (size_t)nxt.pn * tstepB : cB;
        for (int t = 0; t < nt; t += 2) {
            const bool last = (t == nt - 2);
            const char* a1 = cA + (size_t)(t + 1) * kstep;
            const char* a2 = last ? nA : cA + (size_t)(t + 2) * kstep; const char* b2 = last ? nB : cB + (size_t)(t + 2) * kstep;
            const char* a3 = a2 + kstep; const char* b3 = b2 + kstep;
            PG8_LDB(B0, 0, 0); PG8_LDB(B1, 0, 1); PG8_SCHED; PG8_LDA(At, 0, 0); PG8_STAGE(PG8_SA(1, 1), a1 + hstepA, voffA);
            PG8_WAIT_V(8); PG8_WAIT_L(0); PG8_BAR; PG8_MMA(0, 0, At, B0); PG8_MMA(0, 1, At, B1); PG8_BAR; PG8_SCHED;
            PG8_LDA(At, 0, 1); PG8_STAGE(PG8_SB(0, 0), b2, voffB); PG8_STAGE(PG8_SB(0, 1), b2 + hstepB, voffB); PG8_STAGE(PG8_SA(0, 0), a2, voffA);
            PG8_WAIT_V(8); PG8_WAIT_L(0); PG8_BAR; PG8_MMA(1, 0, At, B0); PG8_MMA(1, 1, At, B1); PG8_BAR; PG8_SCHED;
            PG8_LDB(B0, 1, 0); PG8_LDB(B1, 1, 1); PG8_SCHED; PG8_LDA(At, 1, 0); PG8_STAGE(PG8_SA(0, 1), a2 + hstepA, voffA);
            PG8_WAIT_V(8); PG8_WAIT_L(0); PG8_BAR; PG8_MMA(0, 0, At, B0); PG8_MMA(0, 1, At, B1); PG8_BAR; PG8_SCHED;
            PG8_LDA(At, 1, 1); PG8_STAGE(PG8_SB(1, 0), b3, voffB); PG8_STAGE(PG8_SB(1, 1), b3 + hstepB, voffB); PG8_STAGE(PG8_SA(1, 0), a3, voffA);
            PG8_WAIT_V(8); PG8_WAIT_L(0); PG8_BAR; PG8_MMA(1, 0, At, B0); PG8_MMA(1, 1, At, B1); PG8_BAR; PG8_SCHED;
        }
        if constexpr (ALIGN_EPI) { if (wr == 0) PG8_BAR; }
        E(acc, cur, wr, wc, fr, fq);
        if (!has_next) break;
        if constexpr (Epi::HAS_INIT) { E.init(acc, nxt, wr, wc, fr, fq); }
        else {
#pragma unroll
        for (int a = 0; a < 2; ++a)
#pragma unroll
            for (int b = 0; b < 2; ++b)
#pragma unroll
                for (int m = 0; m < 4; ++m)
#pragma unroll
                    for (int n = 0; n < 2; ++n) acc[a][b][m][n] = (f32x4){0.f, 0.f, 0.f, 0.f};
        }
        cur = nxt; cA = nA; cB = nB; ++ui;
        if constexpr (ALIGN_EPI) { if (wr == 1) PG8_BAR; }
    }
    PG8_WAIT_V(0);
    if constexpr (!ALIGN_EPI) { if (wr == 0) PG8_BAR; }
    PG8_BAR;
#undef PG8_SA
#undef PG8_SB
#undef PG8_STAGE
#undef PG8_LDA
#undef PG8_LDB
#undef PG8_MMA
#undef PG8_WAIT_V
#undef PG8_WAIT_L
#undef PG8_BAR
#undef PG8_SCHED
}
}

#define XB_TMO      128
#define XB_XCNT(j)  (256  + 64 * (j))
#define XB_XSUB(j)  (1280 + 64 * (j))
#define XB_XGEN(j)  (2304 + 64 * (j))
#define XB_TOP      3328
#define XB_TOPGEN   3392
#define XCD_BAR_WORDS 3456
#define XB_SPIN_CAP (1u << 18)
__device__ __forceinline__ unsigned xb_ld(unsigned* p)              { return __hip_atomic_load(p, __ATOMIC_RELAXED, __HIP_MEMORY_SCOPE_AGENT); }
__device__ __forceinline__ unsigned xb_add(unsigned* p, unsigned v) { return __hip_atomic_fetch_add(p, v, __ATOMIC_RELAXED, __HIP_MEMORY_SCOPE_AGENT); }
__device__ __forceinline__ unsigned xb_xcc_id() { return (unsigned)__builtin_amdgcn_s_getreg((3 << 11) | 20) & 0xFu; }
#define XB_SPIN(cond, bar) do { unsigned _sp = 0; while (cond) { __builtin_amdgcn_s_sleep(1); \
    if ((++_sp & 255u) == 0u) { if (xb_ld(&(bar)[XB_TMO])) break; if (_sp > XB_SPIN_CAP) { atomicAdd(&(bar)[XB_TMO], 1u); break; } } } } while (0)
struct XcdBarrier { unsigned* bar; unsigned x; volatile LAS unsigned* st; };
__device__ __forceinline__ XcdBarrier xcd_barrier_post(unsigned* bar, volatile LAS unsigned* st) {
    XcdBarrier b; b.bar = bar; b.x = xb_xcc_id(); b.st = st;
    if (threadIdx.x == 0) (void)xb_add(&bar[XB_XCNT(b.x)], 1u);
    return b;
}
__device__ __forceinline__ void xcd_barrier_complete(unsigned* bar, unsigned x, unsigned& nloc, unsigned& nx) {
    const unsigned G = gridDim.x * gridDim.y * gridDim.z;
    unsigned sum, cnt, mine, sp = 0u;
    for (;;) {
        sum = 0u; cnt = 0u; mine = 0u;
#pragma unroll
        for (unsigned j = 0; j < 16; ++j) { const unsigned c = xb_ld(&bar[XB_XCNT(j)]); sum += c; cnt += (c > 0u) ? 1u : 0u; mine = (j == x) ? c : mine; }
        if (sum == G) break;
        __builtin_amdgcn_s_sleep(1);
        if ((++sp & 255u) == 0u) { if (xb_ld(&bar[XB_TMO])) break; if (sp > XB_SPIN_CAP) { atomicAdd(&bar[XB_TMO], 1u); break; } }
    }
    nloc = mine > 0u ? mine : 1u; nx = cnt > 0u ? cnt : 1u;
}
__device__ __forceinline__ void xcd_barrier(const XcdBarrier& b) {
    asm volatile("s_waitcnt vmcnt(0)" ::: "memory");
    __syncthreads();
    if (threadIdx.x == 0) {
        unsigned* bar = b.bar;
        __builtin_amdgcn_s_waitcnt(0);
        unsigned nloc = b.st[0], nx = b.st[1];
        if (nloc == 0u) { xcd_barrier_complete(bar, b.x, nloc, nx); b.st[0] = nloc; b.st[1] = nx; }
        const unsigned old = xb_add(&bar[XB_XSUB(b.x)], 1u);
        const unsigned gen = old / nloc;
        if (old + 1u == (gen + 1u) * nloc) {
            __builtin_amdgcn_fence(__ATOMIC_RELEASE, "agent");
            asm volatile("s_waitcnt vmcnt(0)" ::: "memory");
            const unsigned og = xb_add(&bar[XB_TOP], 1u);
            const unsigned tg = og / nx;
            if (og + 1u == (tg + 1u) * nx) xb_add(&bar[XB_TOPGEN], 1u);
            else XB_SPIN(xb_ld(&bar[XB_TOPGEN]) == tg, bar);
            __builtin_amdgcn_fence(__ATOMIC_ACQUIRE, "agent");
            xb_add(&bar[XB_XGEN(b.x)], 1u);
            asm volatile("s_waitcnt vmcnt(0)" ::: "memory");
        } else {
            XB_SPIN(xb_ld(&bar[XB_XGEN(b.x)]) == gen, bar);
            __builtin_amdgcn_fence(__ATOMIC_ACQUIRE, "agent");
            asm volatile("s_waitcnt vmcnt(0)" ::: "memory");
        }
    }
    __syncthreads();
}

struct Args {
    const float* x; const float* norm1_w; const float* w_in; const float* conv_w; const float* conv_b; const float* igate_b; const float* fgate_b;
    const float* q_norm_w; const float* k_norm_w; const float* mlstm_norm_w; const float* attn_norm_w; const float* w_out; const float* norm2_w;
    const float* w_gate; const float* w_up; const float* w_down;
    float* out; unsigned char* ws; int dry; int pad;
};

struct TItem { const float* W; bf16* WT; const float* kscale; int ldw, K, nsrc0, ndst0, k0; };
__device__ __forceinline__ void titem_load(const TItem& t, f32x4 (&v)[8], int lane) {
    const float* src = t.W + (size_t)(t.k0 + (lane >> 3)) * t.ldw + t.nsrc0 + (lane & 7) * 4;
#pragma unroll
    for (int i = 0; i < 8; ++i) v[i] = __builtin_nontemporal_load((const f32x4*)(src + (size_t)(8 * i) * t.ldw));
}
__device__ __forceinline__ void titem_finish(const TItem& t, const f32x4 (&v)[8], LAS float* scr, int lane) {
#pragma unroll
    for (int i = 0; i < 8; ++i) { const int kk = 8 * i + (lane >> 3); const float sc = t.kscale ? t.kscale[t.k0 + kk] : 1.0f; LAS float* d = scr + kk * 33 + (lane & 7) * 4;
        d[0] = v[i][0] * sc; d[1] = v[i][1] * sc; d[2] = v[i][2] * sc; d[3] = v[i][3] * sc; }
    LDS_WAIT(); asm volatile("" ::: "memory");
    const int c = lane & 7;
#pragma unroll
    for (int j = 0; j < 4; ++j) { const int n = (lane >> 3) + 8 * j; const LAS float* s = scr + (8 * c) * 33 + n;
        u32x4 o; o.x = cvtpk(s[0 * 33], s[1 * 33]); o.y = cvtpk(s[2 * 33], s[3 * 33]); o.z = cvtpk(s[4 * 33], s[5 * 33]); o.w = cvtpk(s[6 * 33], s[7 * 33]);
        *(u32x4*)(t.WT + (size_t)(t.ndst0 + n) * t.K + t.k0 + 8 * c) = o; }
    LDS_WAIT(); asm volatile("" ::: "memory");
}
__device__ __forceinline__ int win_src_col(int nd) {
    if (nd < 1024) return nd;
    if (nd < 2048) return nd + 1024;
    if (nd < 3072) return nd - 1024;
    return nd + 8;
}


__device__ __forceinline__ float scan_add64(float v, int lane) {
#pragma unroll
    for (int o = 1; o < 64; o <<= 1) { const float t = __shfl_up(v, o); if (lane >= o) v += t; }
    return v;
}
__device__ __forceinline__ float scan_max64(float v, int lane) {
#pragma unroll
    for (int o = 1; o < 64; o <<= 1) { const float t = __shfl_up(v, o); if (lane >= o) v = fmaxf(v, t); }
    return v;
}
__device__ __forceinline__ void conv_issue(const bf16* proj, int b, int c, int col0, int tid, u32x4 (&raw)[2][4]) {
    const int rr = tid >> 4, cc = (tid & 15) * 8;
#pragma unroll
    for (int half = 0; half < 2; ++half)
#pragma unroll
        for (int j = 0; j < 4; ++j) { const int tt = c * 64 + rr + 32 * half - 3 + j; const int ttc = tt < 0 ? 0 : tt;
            raw[half][j] = *(const u32x4*)(proj + (size_t)(b * SEQ + ttc) * NPROJ + col0 + cc); }
}
template <bool ROWW>
__device__ __forceinline__ void conv_finish(const u32x4 (&raw)[2][4], const float* conv_w, const float* conv_b, int c, int ch0, float rscale, float wlane, LAS unsigned char* tile, int tid) {
    const int rr = tid >> 4, cc = (tid & 15) * 8;
    float w[4][8], bb[8];
#pragma unroll
    for (int j = 0; j < 4; ++j) { const f32x4 w0 = *(const f32x4*)(conv_w + j * 1024 + ch0 + cc), w1 = *(const f32x4*)(conv_w + j * 1024 + ch0 + cc + 4);
        w[j][0] = w0[0]; w[j][1] = w0[1]; w[j][2] = w0[2]; w[j][3] = w0[3]; w[j][4] = w1[0]; w[j][5] = w1[1]; w[j][6] = w1[2]; w[j][7] = w1[3]; }
    { const f32x4 b0 = *(const f32x4*)(conv_b + ch0 + cc), b1 = *(const f32x4*)(conv_b + ch0 + cc + 4);
      bb[0] = b0[0]; bb[1] = b0[1]; bb[2] = b0[2]; bb[3] = b0[3]; bb[4] = b1[0]; bb[5] = b1[1]; bb[6] = b1[2]; bb[7] = b1[3]; }
#pragma unroll
    for (int half = 0; half < 2; ++half) {
        const int l = rr + 32 * half, t = c * 64 + l;
        float y[8];
#pragma unroll
        for (int e = 0; e < 8; ++e) y[e] = bb[e];
#pragma unroll
        for (int j = 0; j < 4; ++j) { const bool inb = (t - 3 + j) >= 0; u32x4 rz = raw[half][j];
            rz.x = inb ? rz.x : 0u; rz.y = inb ? rz.y : 0u; rz.z = inb ? rz.z : 0u; rz.w = inb ? rz.w : 0u;
            float x[8]; unpack8(rz, x);
#pragma unroll
            for (int e = 0; e < 8; ++e) y[e] += w[j][e] * x[e]; }
        float sc = rscale;
        if (ROWW) sc *= __shfl(wlane, l);
#pragma unroll
        for (int e = 0; e < 8; ++e) y[e] = y[e] * __builtin_amdgcn_rcpf(1.0f + __expf(-y[e])) * sc;
        *(LAS u32x4*)(tile + l * 288 + cc * 2) = pack8(y);
    }
}
__device__ __forceinline__ void v_issue(const bf16* proj, int b, int c, int h, int tid, u32x4 (&vv)[4]) {
#pragma unroll
    for (int p = 0; p < 4; ++p) { const int row = p * 16 + (tid >> 5), ch = tid & 31;
        vv[p] = *(const u32x4*)(proj + (size_t)(b * SEQ + c * 64 + row) * NPROJ + PC_MV + h * 256 + ch * 8); }
}
__device__ __forceinline__ void v_store(const u32x4 (&vv)[4], LAS unsigned char* tile, int tid) {
#pragma unroll
    for (int p = 0; p < 4; ++p) { const int row = p * 16 + (tid >> 5), ch = tid & 31;
        *(LAS u32x4*)(tile + row * 544 + ch * 16) = vv[p]; }
}

__device__ __forceinline__ void q_prep(const bf16* qrow, const float* rcos, const float* rsin, const float* qnw, int tq, int g, bf16x8 (&qf)[4]) {
    float q[4][8]; float ss = 0.f;
#pragma unroll
    for (int ks = 0; ks < 4; ++ks) { const u32x4 raw = *(const u32x4*)(qrow + 32 * ks + 8 * g); unpack8(raw, q[ks]);
#pragma unroll
        for (int e = 0; e < 8; ++e) ss += q[ks][e] * q[ks][e]; }
    ss = xg_sum(ss);
    const float rq = __builtin_amdgcn_rsqf(ss * (1.0f / 128.0f) + NORM_EPS);
#pragma unroll
    for (int ks = 0; ks < 2; ++ks) {
        const int c0 = 32 * ks + 8 * g;
#pragma unroll
        for (int e4 = 0; e4 < 2; ++e4) {
            const f32x4 cs = *(const f32x4*)(rcos + tq * 64 + c0 + 4 * e4), sn = *(const f32x4*)(rsin + tq * 64 + c0 + 4 * e4);
            const f32x4 w1 = *(const f32x4*)(qnw + c0 + 4 * e4), w2 = *(const f32x4*)(qnw + 64 + c0 + 4 * e4);
#pragma unroll
            for (int e = 0; e < 4; ++e) { const float y1 = q[ks][4 * e4 + e] * rq * w1[e], y2 = q[ks + 2][4 * e4 + e] * rq * w2[e];
                q[ks][4 * e4 + e] = y1 * cs[e] - y2 * sn[e]; q[ks + 2][4 * e4 + e] = y2 * cs[e] + y1 * sn[e]; }
        }
    }
#pragma unroll
    for (int ks = 0; ks < 4; ++ks) { const u32x4 w = pack8(q[ks]); qf[ks] = __builtin_bit_cast(bf16x8, w); }
}
struct AUnit { int b, h, d, r, n; bf16* po0; float* pl0; };
template <bool FINAL>
__device__ __forceinline__ void attn_pair(bf16* proj, const float* rcos, const float* rsin, const float* qnw, const float* knw, const float* anw, const AUnit& ua, const AUnit& ub,
                                          LAS unsigned char* lds_all, bf16* po1, float* pl1, int tid_in, bool dry) {
    int tid = tid_in; asm volatile("" : "+v"(tid));
    const int lane = tid & 63, wave = __builtin_amdgcn_readfirstlane(tid >> 6);
    const int team = wave >> 2, w4 = wave & 3;
    const int b = team ? ub.b : ua.b, h = team ? ub.h : ua.h, d = team ? ub.d : ua.d, r = team ? ub.r : ua.r, n = team ? ub.n : ua.n;
    bf16* po0 = team ? ub.po0 : ua.po0; float* pl0 = team ? ub.pl0 : ua.pl0;
    LAS unsigned char* lds = lds_all + team * 36864;
    const int j = lane & 15, g = lane >> 4, qp = j >> 2, p = lane & 3;
    const int tt = tid & 255, srow = tt >> 4, sch = tt & 15;
    const bf16* kcol = proj + (size_t)b * SEQ * NPROJ + PC_AK + h * 128 + sch * 8;
    const bf16* vcol = kcol + (PC_AV - PC_AK);
    const int kt0 = (n == 0) ? 4 : 0;
    const int sub0 = 128 * (n - 1) + srow;
    u32x4 rk[2][2], rv[2][2];
#define AT_ISSUE(set, t) do { const int tc_ = ((t) < 8) ? (t) : 7; _Pragma("unroll") for (int hh_ = 0; hh_ < 2; ++hh_) { const size_t tok_ = (size_t)((sub0 + 32 * tc_ + 16 * hh_) * d + r); \
        rk[set][hh_] = *(const u32x4*)(kcol + tok_ * NPROJ); rv[set][hh_] = *(const u32x4*)(vcol + tok_ * NPROJ); } } while (0)
#define AT_WRITE(set, t) do { LAS unsigned char* Kn_ = lds + ((t) & 1) * 18432; _Pragma("unroll") for (int hh_ = 0; hh_ < 2; ++hh_) { \
        *(LAS u32x4*)(Kn_ + (srow + 16 * hh_) * 288 + sch * 16) = rk[set][hh_]; *(LAS u32x4*)(Kn_ + 9216 + (srow + 16 * hh_) * 288 + sch * 16) = rv[set][hh_]; } } while (0)
#define WG_BAR() do { asm volatile("s_waitcnt lgkmcnt(0)" ::: "memory"); __builtin_amdgcn_s_barrier(); asm volatile("" ::: "memory"); } while (0)
    AT_ISSUE(0, kt0); AT_ISSUE(1, kt0 + 1);
    bf16x8 qf[2][4]; int qi[2]; int tq[2];
    const int G0 = w4, G1 = 7 - w4;
    qi[0] = 16 * G0 + j; qi[1] = 16 * G1 + j; tq[0] = (128 * n + qi[0]) * d + r; tq[1] = (128 * n + qi[1]) * d + r;
    const int lo0 = G0 >> 1, lo1 = G1 >> 1;
#pragma unroll
    for (int gi = 0; gi < 2; ++gi) { const bf16* qrow = proj + (size_t)(b * SEQ + tq[gi]) * NPROJ + PC_AQ + h * 128 + 8 * g;
#pragma unroll
        for (int ks = 0; ks < 4; ++ks) qf[gi][ks] = *(const bf16x8*)(qrow + 32 * ks); }
    AT_WRITE(0, kt0);
    for (int kb_ = 0; kb_ < kt0; ++kb_) WG_BAR();
    WG_BAR();
    float mref;
    { const float bq = wave_max(fmaxf(fabsf(qnw[lane]), fabsf(qnw[64 + lane]))), bk = wave_max(fmaxf(fabsf(knw[lane]), fabsf(knw[64 + lane])));
      mref = fminf(128.0f * 1.02f * 0.08838834764831845f * 1.4426950408889634f * bq * bk, 60.0f); }
    float l_run[2] = {0.f, 0.f};
    f32x4 o[2][8];
    if (FINAL) {
#pragma unroll
        for (int gi = 0; gi < 2; ++gi) { const size_t trow = (size_t)(b * SEQ + tq[gi]);
            const float l0 = pl0[trow * 8 + h], l1 = pl1[trow * 8 + h];
            const float a0 = __builtin_amdgcn_exp2f(l0 - mref), a1 = __builtin_amdgcn_exp2f(l1 - mref);
            l_run[gi] = (g == 0) ? a0 + a1 : 0.f;
            const bf16* p0 = po0 + trow * 1024 + h * 128 + g * 8; const bf16* p1 = po1 + trow * 1024 + h * 128 + g * 8;
#pragma unroll
            for (int np = 0; np < 4; ++np) { const u32x4 x0 = *(const u32x4*)(p0 + 32 * np), x1 = *(const u32x4*)(p1 + 32 * np); float f0[8], f1[8]; unpack8(x0, f0); unpack8(x1, f1);
#pragma unroll
                for (int e = 0; e < 4; ++e) { o[gi][2 * np][e] = a0 * f0[e] + a1 * f1[e]; o[gi][2 * np + 1][e] = a0 * f0[4 + e] + a1 * f1[4 + e]; } }
        }
    } else {
#pragma unroll
        for (int gi = 0; gi < 2; ++gi)
#pragma unroll
            for (int nf = 0; nf < 8; ++nf) o[gi][nf] = (f32x4){0.f, 0.f, 0.f, 0.f};
    }
    const float SC = 0.08838834764831845f * 1.4426950408889634f;
    const float nmref = -mref;
#define AT_SM(gi, kt, s0, s1) do { \
                float x[8]; float ps = 0.f; \
                _Pragma("unroll") for (int e = 0; e < 8; ++e) { const int kj = 32 * (kt) + 16 * (e >> 2) + 4 * g + (e & 3); const float sv = (e < 4) ? s0[e & 3] : s1[e & 3]; \
                    const bool valid = (kj >= qi[gi]) && (kj <= qi[gi] + 128); \
                    const float pe = __builtin_amdgcn_exp2f(__builtin_fmaf(sv, SC, nmref)); \
                    x[e] = valid ? pe : 0.f; ps += x[e]; } \
                l_run[gi] += ps; \
                const u32x4 pw = pack8(x); pb[gi] = __builtin_bit_cast(bf16x8, pw); } while (0)
#define AT_ONE(gi, kt) do { \
            f32x4 sA = {0.f, 0.f, 0.f, 0.f}, sB = {0.f, 0.f, 0.f, 0.f}; \
            _Pragma("unroll") for (int ks = 0; ks < 4; ++ks) { \
                const bf16x8 k0 = *(const LAS bf16x8*)(Kt + j * 288 + (32 * ks + 8 * g) * 2), k1 = *(const LAS bf16x8*)(Kt + (16 + j) * 288 + (32 * ks + 8 * g) * 2); \
                sA = MFMA16(k0, qf[gi][ks], sA); sB = MFMA16(k1, qf[gi][ks], sB); } \
            bf16x8 pb[2]; AT_SM(gi, kt, sA, sB); \
            _Pragma("unroll") for (int nf = 0; nf < 8; ++nf) { \
                const s16x4 a0 = vtr(Vt + (4 * g + qp) * 288 + (16 * nf + 4 * p) * 2), a1 = vtr(Vt + (16 + 4 * g + qp) * 288 + (16 * nf + 4 * p) * 2); \
                o[gi][nf] = MFMA16(cat4(a0, a1), pb[gi], o[gi][nf]); } } while (0)
#define AT_STEP(kt, setn, setw) do { \
        LAS unsigned char* Kt = lds + ((kt) & 1) * 18432; LAS unsigned char* Vt = Kt + 9216; \
        AT_ISSUE(setn, (kt) + 2); \
        const bool act0 = (kt) >= lo0 && (kt) <= lo0 + 4, act1 = (kt) >= lo1 && (kt) <= lo1 + 4; \
        if (act0 && act1) { \
            f32x4 sA[2], sB[2]; sA[0] = (f32x4){0.f, 0.f, 0.f, 0.f}; sA[1] = sA[0]; sB[0] = sA[0]; sB[1] = sA[0]; \
            _Pragma("unroll") for (int ks = 0; ks < 4; ++ks) { \
                const bf16x8 k0 = *(const LAS bf16x8*)(Kt + j * 288 + (32 * ks + 8 * g) * 2), k1 = *(const LAS bf16x8*)(Kt + (16 + j) * 288 + (32 * ks + 8 * g) * 2); \
                sA[0] = MFMA16(k0, qf[0][ks], sA[0]); sB[0] = MFMA16(k1, qf[0][ks], sB[0]); sA[1] = MFMA16(k0, qf[1][ks], sA[1]); sB[1] = MFMA16(k1, qf[1][ks], sB[1]); } \
            bf16x8 pb[2]; \
            AT_SM(0, kt, sA[0], sB[0]); AT_SM(1, kt, sA[1], sB[1]); \
            _Pragma("unroll") for (int nf = 0; nf < 8; ++nf) { \
                const s16x4 a0 = vtr(Vt + (4 * g + qp) * 288 + (16 * nf + 4 * p) * 2), a1 = vtr(Vt + (16 + 4 * g + qp) * 288 + (16 * nf + 4 * p) * 2); \
                const bf16x8 vf = cat4(a0, a1); \
                o[0][nf] = MFMA16(vf, pb[0], o[0][nf]); o[1][nf] = MFMA16(vf, pb[1], o[1][nf]); } \
        } else if (act0) { AT_ONE(0, kt); } else if (act1) { AT_ONE(1, kt); } \
        if ((kt) + 1 < 8) AT_WRITE(setw, (kt) + 1); \
        WG_BAR(); } while (0)
#pragma unroll 1
    for (int kt = kt0; kt < 8; kt += 2) { AT_STEP(kt, 0, 1); AT_STEP(kt + 1, 1, 0); }
#undef AT_STEP
#undef AT_ONE
#undef AT_SM
#undef AT_ISSUE
#undef AT_WRITE
#pragma unroll
    for (int gi = 0; gi < 2; ++gi) {
        float lr = l_run[gi]; lr = xg_sum(lr);
        const float inv = __builtin_amdgcn_rcpf(lr);
        const float lse2 = mref + __log2f(lr);
        const size_t trow = (size_t)(b * SEQ + tq[gi]);
        if (!FINAL) {
            bf16* pp = po0 + trow * 1024 + h * 128 + g * 8;
#pragma unroll
            for (int np = 0; np < 4; ++np) { const f32x4 va = o[gi][2 * np] * inv, vb = o[gi][2 * np + 1] * inv; u32x4 ww; ww.x = cvtpk(va[0], va[1]); ww.y = cvtpk(va[2], va[3]); ww.z = cvtpk(vb[0], vb[1]); ww.w = cvtpk(vb[2], vb[3]);
                if (!dry) *(u32x4*)(pp + 32 * np) = ww; }
            if (g == 0 && !dry) pl0[trow * 8 + h] = lse2;
        } else {
            bf16* qrow = proj + trow * NPROJ + PC_AQ + h * 128;
            float ss = 0.f;
#pragma unroll
            for (int nf = 0; nf < 8; ++nf) { const f32x4 v = o[gi][nf] * inv; o[gi][nf] = v; ss += (v[0] * v[0] + v[1] * v[1]) + (v[2] * v[2] + v[3] * v[3]); }
            ss = xg_sum(ss);
            const float rn = __builtin_amdgcn_rsqf(ss * (1.0f / 128.0f) + NORM_EPS);
#pragma unroll
            for (int nf = 0; nf < 8; ++nf) { const int e = 16 * nf + 4 * g; const f32x4 w = *(const f32x4*)(anw + h * 128 + e); const f32x4 v = o[gi][nf] * rn * w;
                u32x2 ww; ww.x = cvtpk(v[0], v[1]); ww.y = cvtpk(v[2], v[3]); if (!dry) *(u32x2*)(qrow + e) = ww; }
        }
    }
}

#ifndef PROBE_PHASE
#define PROBE_PHASE -1
#endif
#define REP_BEGIN(k) for (int rep_ = (PROBE_PHASE == (k)) ? 0 : 1; rep_ < 2; ++rep_) { const bool dry = (rep_ == 0) && (a.dry != 0); (void)dry; \
    int tid = threadIdx.x; asm volatile("" : "+v"(tid)); const int lane = tid & 63, wave = __builtin_amdgcn_readfirstlane(tid >> 6); \
    const int gw = vcu * NWAVES + wave, gt = vcu * (NWAVES * 64) + tid; (void)lane; (void)wave; (void)gw; (void)gt;
#define REP_END }

__global__ void __launch_bounds__(NWAVES * 64, 2) hymba_fwd(Args a) {
    extern __shared__ __attribute__((aligned(16))) unsigned char lds_raw[];
    LAS unsigned char* lds = (LAS unsigned char*)lds_raw;
    volatile LAS unsigned* MISC = (volatile LAS unsigned*)(lds + MISC_OFF);
    const int tid = threadIdx.x, lane = tid & 63, wave = __builtin_amdgcn_readfirstlane(tid >> 6);
    const int G = gridDim.x; const int bx = blockIdx.x; const int vcu = (G % 8 == 0) ? (bx % 8) * (G / 8) + bx / 8 : bx;
    unsigned char* ws = a.ws;
    unsigned* ctl = (unsigned*)(ws + WS_CTL);
    float* gli = (float*)(ws + WS_GLI); float* glf = (float*)(ws + WS_GLF); float* sumsq = (float*)(ws + WS_SUMSQ);
    float* msc_g = (float*)(ws + WS_MSC); float* msc_ml = msc_g + 512; float* msc_mp = msc_g + 1024;
    float* ncb = (float*)(ws + WS_NC);
    float* rcos = (float*)(ws + WS_COS); float* rsin = (float*)(ws + WS_SIN);
    bf16* WinT = (bf16*)(ws + WS_WIN); bf16* kvT = (bf16*)(ws + WS_KV); bf16* Ub = (bf16*)(ws + WS_U); bf16* H1b = (bf16*)(ws + WS_U);
    bf16* proj = (bf16*)(ws + WS_PROJ); bf16* FF = (bf16*)(ws + WS_PROJ);
    bf16* op0 = (bf16*)(ws + WS_OP0); bf16* op1 = (bf16*)(ws + WS_OP1); float* pl0 = (float*)(ws + WS_PL0); float* pl1 = (float*)(ws + WS_PL1);
    bf16* WoutT = (bf16*)(ws + WS_WOUT); bf16* WguT = (bf16*)(ws + WS_WGU); bf16* WdnT = (bf16*)(ws + WS_WDN);

    for (int u = tid; u < (LDS_BYTES - MISC_OFF) / 4; u += NWAVES * 64) ((LAS unsigned*)(lds + MISC_OFF))[u] = 0u;
    __syncthreads();
    XcdBarrier bar = xcd_barrier_post(ctl + CW_BAR, MISC + 8);
    const int NGW = G * NWAVES, NGT = G * NWAVES * 64;

    REP_BEGIN(0)
        for (int i = gt; i < MTOK; i += NGT) sumsq[i] = 0.f;
        for (int i = gt; i < SEQ * 64; i += NGT) {
            const int pos = i >> 6, fi = i & 63;
            const float invf = (float)exp2(-(double)fi * (13.287712379549449 / 64.0));
            const float ang = (float)pos * invf;
            const double rev = (double)ang * 0.15915494309189535; const double fr_ = rev - rint(rev);
            const float ar = (float)(fr_ * 6.283185307179586);
            rcos[i] = cosf(ar); rsin[i] = sinf(ar);
        }
        {
            LAS float* scr = (LAS float*)(lds + wave * 16384);
            constexpr int I_IN = (DM / 64) * (NPROJ / 32), I_OUT = (DM / 64) * (DM / 32), I_GU = (DM / 64) * (NGU / 32), I_DN = (DFF / 64) * (DM / 32);
            constexpr int NITEMS = I_IN + I_OUT + I_GU;
            auto decode = [&](int it) -> TItem {
                TItem t; int r = it;
                if (r < I_IN) { const int nblk = NPROJ / 32, kb = r / nblk, nb = r % nblk; t = TItem{a.w_in, WinT, nullptr, INW, DM, win_src_col(nb * 32), nb * 32, kb * 64}; return t; } r -= I_IN;
                if (r < I_OUT) { const int nblk = DM / 32, kb = r / nblk, nb = r % nblk; t = TItem{a.w_out, WoutT, nullptr, DM, DM, nb * 32, nb * 32, kb * 64}; return t; } r -= I_OUT;
                { const int nblk = NGU / 32, kb = r / nblk, nb = r % nblk; const int nd = nb * 32, pn = nd >> 8, j = nd & 255;
                    t = TItem{(j < 128) ? a.w_gate : a.w_up, WguT, a.norm2_w, DFF, DM, pn * 128 + (j & 127), nd, kb * 64}; return t; }
            };
            int it = gw;
            if (it < NITEMS) {
                TItem cur = decode(it); f32x4 vc[8]; titem_load(cur, vc, lane);
                for (;;) {
                    const int nx = it + NGW; const bool more = nx < NITEMS;
                    TItem nt = cur; f32x4 vn[8];
                    if (more) { nt = decode(nx); titem_load(nt, vn, lane); }
                    titem_finish(cur, vc, scr, lane);
                    if (!more) break;
                    cur = nt; it = nx;
#pragma unroll
                    for (int i = 0; i < 8; ++i) vc[i] = vn[i];
                }
            }
        }
        __syncthreads();
        LAS float* wg = (LAS float*)lds;
        for (int k = tid; k < DM; k += NWAVES * 64) { const f32x4 g0 = *(const f32x4*)(a.w_in + (size_t)k * INW + 3072), g1 = *(const f32x4*)(a.w_in + (size_t)k * INW + 3076);
            wg[0 * DM + k] = g0[0]; wg[1 * DM + k] = g0[1]; wg[2 * DM + k] = g0[2]; wg[3 * DM + k] = g0[3];
            wg[4 * DM + k] = g1[0]; wg[5 * DM + k] = g1[1]; wg[6 * DM + k] = g1[2]; wg[7 * DM + k] = g1[3]; }
        __syncthreads();
        for (int m = gw; m < MTOK; m += NGW) {
            const f32x4* xr = (const f32x4*)(a.x + (size_t)m * DM) + lane; const f32x4* wr_ = (const f32x4*)a.norm1_w + lane;
            f32x4 v[8]; float s = 0.f;
#pragma unroll
            for (int j = 0; j < 8; ++j) { v[j] = __builtin_nontemporal_load(xr + 64 * j); s += (v[j][0] * v[j][0] + v[j][1] * v[j][1]) + (v[j][2] * v[j][2] + v[j][3] * v[j][3]); }
            const float rstd = __builtin_amdgcn_rsqf(wave_sum(s) * (1.0f / DM) + NORM_EPS);
            u32x2* o8 = (u32x2*)(Ub + (size_t)m * DM) + lane;
#pragma unroll
            for (int j = 0; j < 8; ++j) { v[j] = v[j] * rstd * wr_[64 * j]; u32x2 w; w.x = cvtpk(v[j][0], v[j][1]); w.y = cvtpk(v[j][2], v[j][3]); o8[64 * j] = w; }
            float z = 0.f;
#pragma unroll 1
            for (int gi = 0; gi < 8; ++gi) { float t = 0.f;
#pragma unroll
                for (int j = 0; j < 8; ++j) { const f32x4 w4 = *(const LAS f32x4*)(wg + gi * DM + 256 * j + 4 * lane); t += (v[j][0] * w4[0] + v[j][1] * w4[1]) + (v[j][2] * w4[2] + v[j][3] * w4[3]); }
                t = wave_sum(t); z = (lane == gi) ? t : z; }
            if (lane < 8) {
                const int hh = lane & 3;
                if (lane < 4) { gli[m * 4 + hh] = 15.0f * tanhf((z + a.igate_b[hh]) * (1.0f / 15.0f)); }
                else { const float fp = 15.0f * tanhf((z + a.fgate_b[hh]) * (1.0f / 15.0f)); glf[m * 4 + hh] = -log1pf(expf(-fp)); }
            }
        }
    REP_END
    xcd_barrier(bar);

    REP_BEGIN(1)
        pg8::Gemm g{Ub, WinT, MTOK, NPROJ, DM, DM}; pg8::StaticOrder S; S.init(MTOK, NPROJ, G, bx);
        pg8::EpiBf16 E{proj, NPROJ};
        pg8::gemm_phase<pg8::EpiBf16, true>(lds, g, S, E);
    REP_END
    xcd_barrier(bar);

    REP_BEGIN(2)
        {
            const int c0 = 4 * (tid & 15), rstride = NGT >> 4;
            for (int which = 0; which < 2; ++which) {
                const float* nw = which ? a.k_norm_w : a.q_norm_w; const int colb = which ? PC_AK : PC_AQ;
                const f32x4 w1 = *(const f32x4*)(nw + c0), w2 = *(const f32x4*)(nw + 64 + c0);
                for (int idx0 = gt >> 4; idx0 < MTOK * 8; idx0 += 4 * rstride) {
                    u32x2 r1[4], r2[4]; f32x4 cs[4], sn[4];
#pragma unroll
                    for (int q = 0; q < 4; ++q) { const int idx = idx0 + q * rstride;
                        if (idx < MTOK * 8) { const int m = idx >> 3, hh = idx & 7, pos = m & (SEQ - 1); const bf16* kp = proj + (size_t)m * NPROJ + colb + hh * 128;
                            r1[q] = *(const u32x2*)(kp + c0); r2[q] = *(const u32x2*)(kp + 64 + c0); cs[q] = *(const f32x4*)(rcos + pos * 64 + c0); sn[q] = *(const f32x4*)(rsin + pos * 64 + c0); } }
#pragma unroll
                    for (int q = 0; q < 4; ++q) { const int idx = idx0 + q * rstride;
                        if (idx < MTOK * 8) { const int m = idx >> 3, hh = idx & 7; bf16* kp = proj + (size_t)m * NPROJ + colb + hh * 128;
                            float x1[4] = {bf_lo(r1[q].x), bf_hi(r1[q].x), bf_lo(r1[q].y), bf_hi(r1[q].y)}, x2[4] = {bf_lo(r2[q].x), bf_hi(r2[q].x), bf_lo(r2[q].y), bf_hi(r2[q].y)};
                            float ss = 0.f;
#pragma unroll
                            for (int e = 0; e < 4; ++e) ss += x1[e] * x1[e] + x2[e] * x2[e];
                            ss = row16_sum(ss);
                            const float rk = __builtin_amdgcn_rsqf(ss * (1.0f / 128.0f) + NORM_EPS);
                            float o1[4], o2[4];
#pragma unroll
                            for (int e = 0; e < 4; ++e) { const float y1 = x1[e] * rk * w1[e], y2 = x2[e] * rk * w2[e]; o1[e] = y1 * cs[q][e] - y2 * sn[q][e]; o2[e] = y2 * cs[q][e] + y1 * sn[q][e]; }
                            u32x2 wv; wv.x = cvtpk(o1[0], o1[1]); wv.y = cvtpk(o1[2], o1[3]); if (!dry) *(u32x2*)(kp + c0) = wv;
                            wv.x = cvtpk(o2[0], o2[1]); wv.y = cvtpk(o2[2], o2[3]); if (!dry) *(u32x2*)(kp + 64 + c0) = wv; } }
                }
            }
        }
        LAS unsigned char* KW = lds; LAS unsigned char* VT = lds + 36864;
        const int g = lane >> 4, qp = (lane & 15) >> 2, p = lane & 3;
        for (int u = vcu; u < 256; u += G) {
            const int b = u >> 7, h = (u >> 5) & 3, c0 = 2 * (u & 31);
            const int tok = b * SEQ + c0 * 64 + lane;
            const float liA = gli[tok * 4 + h], lfA = glf[tok * 4 + h], liB = gli[(tok + 64) * 4 + h], lfB = glf[(tok + 64) * 4 + h];
            u32x4 rawA[2][4], rawB[2][4], vA[4], vB[4];
            conv_issue(proj, b, c0, PC_MK + h * 128, tid, rawA); v_issue(proj, b, c0, h, tid, vA);
            conv_issue(proj, b, c0 + 1, PC_MK + h * 128, tid, rawB); v_issue(proj, b, c0 + 1, h, tid, vB);
            const float cfA = scan_add64(lfA, lane), cfB = scan_add64(lfB, lane);
            const float gA = __shfl(cfA, 63), gB = __shfl(cfB, 63);
            const float avA = gA - cfA + liA + gB, avB = gB - cfB + liB;
            const float ml = wave_max(fmaxf(avA, avB));
            const float wA = __expf(avA - ml), wB = __expf(avB - ml);
            if (tid == 0) { msc_g[u] = gA + gB; msc_ml[u] = ml; }
            conv_finish<true>(rawA, a.conv_w, a.conv_b, c0, 512 + h * 128, 1.0f, wA, KW, tid); v_store(vA, VT, tid);
            conv_finish<true>(rawB, a.conv_w, a.conv_b, c0 + 1, 512 + h * 128, 1.0f, wB, KW + 64 * 288, tid); v_store(vB, VT + 64 * 544, tid);
            __syncthreads();
            f32x4 acc[8][2];
#pragma unroll
            for (int df = 0; df < 8; ++df) { acc[df][0] = (f32x4){0.f, 0.f, 0.f, 0.f}; acc[df][1] = (f32x4){0.f, 0.f, 0.f, 0.f}; }
#pragma unroll
            for (int kk = 0; kk < 4; ++kk) {
                bf16x8 bfr[2];
#pragma unroll
                for (int ef = 0; ef < 2; ++ef) { const int col = 32 * wave + 16 * ef + 4 * p;
                    bfr[ef] = cat4(vtr(VT + (32 * kk + 4 * g + qp) * 544 + col * 2), vtr(VT + (32 * kk + 16 + 4 * g + qp) * 544 + col * 2)); }
#pragma unroll
                for (int df = 0; df < 8; ++df) { const int col = 16 * df + 4 * p;
                    const bf16x8 af = cat4(vtr(KW + (32 * kk + 4 * g + qp) * 288 + col * 2), vtr(KW + (32 * kk + 16 + 4 * g + qp) * 288 + col * 2));
                    acc[df][0] = MFMA16(af, bfr[0], acc[df][0]); acc[df][1] = MFMA16(af, bfr[1], acc[df][1]); }
            }
#pragma unroll
            for (int ef = 0; ef < 2; ++ef) { const int e = 32 * wave + 16 * ef + (lane & 15);
#pragma unroll
                for (int df = 0; df < 8; ++df) { const f32x4 v = acc[df][ef]; u32x2 w; w.x = cvtpk(v[0], v[1]); w.y = cvtpk(v[2], v[3]);
                    *(u32x2*)(kvT + ((size_t)u * 256 + e) * 128 + 16 * df + 4 * g) = w; } }
            if (tid < 128) { float nsum = 0.f;
#pragma unroll 8
                for (int l = 0; l < 128; ++l) nsum += __uint_as_float((unsigned)(*(const LAS unsigned short*)(KW + l * 288 + tid * 2)) << 16);
                ncb[u * 128 + tid] = nsum; }
            __syncthreads();
        }
    REP_END
    xcd_barrier(bar);

    REP_BEGIN(3)
        LAS float* sg = (LAS float*)lds; LAS float* sml = sg + 256;
        for (int i = tid; i < 256; i += NWAVES * 64) { sg[i] = msc_g[i]; sml[i] = msc_ml[i]; }
        __syncthreads();
        for (int id = gt; id < 8 * 16384; id += NGT) {
            const int bh = id >> 14, pi = id & 16383;
            unsigned* base = (unsigned*)kvT + (size_t)bh * 32 * 16384 + pi;
            float c0 = 0.f, c1 = 0.f, m = 0.f;
            unsigned xv[32];
#pragma unroll
            for (int i = 0; i < 32; ++i) xv[i] = base[(size_t)i * 16384];
#pragma unroll
            for (int i = 0; i < 32; ++i) {
                const float gg = sg[bh * 32 + i], ml = sml[bh * 32 + i];
                const float mn = fmaxf(gg + m, ml), so = __expf(gg + m - mn), sn = __expf(ml - mn);
                if (!dry) base[(size_t)i * 16384] = cvtpk(c0, c1);
                c0 = so * c0 + sn * bf_lo(xv[i]); c1 = so * c1 + sn * bf_hi(xv[i]); m = mn;
            }
        }
        for (int id = gt; id < 8 * 128; id += NGT) {
            const int bh = id >> 7, dd = id & 127; float n = 0.f, m = 0.f;
            float* nb_ = ncb + (size_t)bh * 32 * 128 + dd;
            float xv[32];
#pragma unroll
            for (int i = 0; i < 32; ++i) xv[i] = nb_[i * 128];
#pragma unroll
            for (int i = 0; i < 32; ++i) {
                const float gg = sg[bh * 32 + i], ml = sml[bh * 32 + i];
                const float mn = fmaxf(gg + m, ml), so = __expf(gg + m - mn), sn = __expf(ml - mn);
                if (!dry) nb_[i * 128] = n;
                if (dd == 0) msc_mp[bh * 32 + i] = m;
                n = so * n + sn * xv[i]; m = mn;
            }
        }
        __syncthreads();
    REP_END
    REP_BEGIN(4)
        for (int pidx = vcu; pidx < 512; pidx += G) {
            AUnit ua, ub;
            { const int u = pidx; ua = AUnit{u >> 8, (u >> 5) & 7, 4, (u >> 3) & 3, u & 7, op0, pl0}; }
            { const int v = pidx; const int bb = v >> 8; ub = AUnit{bb, (v >> 5) & 7, 16, (v >> 1) & 15, (v ^ bb) & 1, op1, pl1}; }
            attn_pair<false>(proj, rcos, rsin, a.q_norm_w, a.k_norm_w, a.attn_norm_w, ua, ub, lds, nullptr, nullptr, tid, dry);
        }
    REP_END
    xcd_barrier(bar);

    REP_BEGIN(5)
        LAS unsigned char* QT = lds; LAS unsigned char* KT = lds + 18432; LAS unsigned char* VT = lds + 36864;
        LAS float* NP = (LAS float*)(lds + 71680); LAS float* XCH = (LAS float*)(lds + 72192); LAS unsigned char* CP = lds + 72704;
        LAS float* WL = (LAS float*)(lds + 146432);
        const int j = lane & 15, g = lane >> 4, qp = j >> 2, p = lane & 3;
        const int tf = wave & 3, eh = wave >> 2;
        for (int u = vcu; u < 256; u += G) {
            const int b = u >> 7, h = (u >> 5) & 3;
            float mprev = msc_mp[u];
            const bf16* csrc = kvT + (size_t)u * 256 * 128 + (size_t)(tid >> 4) * 128 + (tid & 15) * 8;
#pragma unroll
            for (int hh = 0; hh < 2; ++hh) {
                const int c = 2 * (u & 31) + hh;
                const int tok = b * SEQ + c * 64 + lane;
                const float li = gli[tok * 4 + h], lf = glf[tok * 4 + h];
                u32x4 rawq[2][4], rawk[2][4], vv[4], cv[8];
                conv_issue(proj, b, c, PC_MQ + h * 128, tid, rawq);
                conv_issue(proj, b, c, PC_MK + h * 128, tid, rawk);
                v_issue(proj, b, c, h, tid, vv);
                float npv = 0.f;
                if (hh == 0) { if (tid < 128) npv = ncb[u * 128 + tid]; }
                const float cf = scan_add64(lf, lane);
                const float bvec = li - cf;
                const float pm = scan_max64(bvec, lane);
                const float Mv = fmaxf(mprev, pm);
                const float wiv = __expf(mprev - Mv), emtv = __expf(-cf - Mv);
                float so_u = 0.f, m_u = 0.f;
                if (hh == 0) {
                    const float gsum = __shfl(cf, 63);
                    const float av = gsum + bvec;
                    const float mlA = wave_max(av);
                    m_u = fmaxf(gsum + mprev, mlA);
                    so_u = __expf(gsum + mprev - m_u);
                    if (wave == 0) WL[lane] = __expf(av - mlA) * __expf(mlA - m_u);
                }
                conv_finish<false>(rawq, a.conv_w, a.conv_b, c, h * 128, 0.08838834764831845f, 0.f, QT, tid);
                if (hh == 0) {
#pragma unroll
                    for (int it = 0; it < 8; ++it) cv[it] = *(const u32x4*)(csrc + (size_t)it * 32 * 128);
                }
                conv_finish<false>(rawk, a.conv_w, a.conv_b, c, 512 + h * 128, 1.0f, 0.f, KT, tid);
                v_store(vv, VT, tid);
                if (hh == 0) {
#pragma unroll
                    for (int it = 0; it < 8; ++it) *(LAS u32x4*)(CP + (it * 32 + (tid >> 4)) * 288 + (tid & 15) * 16) = cv[it];
                    if (tid < 128) NP[tid] = npv;
                }
                const int t_ = 16 * (wave & 3) + j;
                const bf16* orow_ = proj + (size_t)(b * SEQ + c * 64 + t_) * NPROJ;
                u32x2 mo_pre[8];
#pragma unroll
                for (int ef = 0; ef < 8; ++ef) mo_pre[ef] = *(const u32x2*)(orow_ + PC_MO + h * 256 + 128 * eh + 16 * ef + 4 * g);
                __syncthreads();
                const int t = 16 * tf + j;
                const float M_t = __shfl(Mv, t), wi_t = __shfl(wiv, t), emt_t = __shfl(emtv, t);
                bf16x8 qf[4];
#pragma unroll
                for (int ks = 0; ks < 4; ++ks) qf[ks] = *(const LAS bf16x8*)(QT + t * 288 + (32 * ks + 8 * g) * 2);
                float sp[4][4]; float rowsum = 0.f;
#pragma unroll
                for (int sf = 0; sf < 4; ++sf) {
                    f32x4 sa = {0.f, 0.f, 0.f, 0.f};
#pragma unroll
                    for (int ks = 0; ks < 4; ++ks) { const bf16x8 kfr = *(const LAS bf16x8*)(KT + (16 * sf + j) * 288 + (32 * ks + 8 * g) * 2); sa = MFMA16(kfr, qf[ks], sa); }
#pragma unroll
                    for (int rg = 0; rg < 4; ++rg) { const int sidx = 16 * sf + 4 * g + rg; const float bs = __shfl(bvec, sidx);
                        const float pv = (sidx <= t) ? __expf(bs - M_t) : 0.f; sp[sf][rg] = sa[rg] * pv; rowsum += sp[sf][rg]; }
                }
                bf16x8 pb[2];
#pragma unroll
                for (int kk = 0; kk < 2; ++kk) { float tmp[8] = {sp[2 * kk][0], sp[2 * kk][1], sp[2 * kk][2], sp[2 * kk][3], sp[2 * kk + 1][0], sp[2 * kk + 1][1], sp[2 * kk + 1][2], sp[2 * kk + 1][3]};
                    const u32x4 w = pack8(tmp); pb[kk] = __builtin_bit_cast(bf16x8, w); }
                f32x4 ai[8], ae[8];
#pragma unroll
                for (int ef = 0; ef < 8; ++ef) { ai[ef] = (f32x4){0.f, 0.f, 0.f, 0.f}; ae[ef] = (f32x4){0.f, 0.f, 0.f, 0.f}; }
#pragma unroll
                for (int kk = 0; kk < 2; ++kk) {
#pragma unroll
                    for (int ef = 0; ef < 8; ++ef) { const int col = 128 * eh + 16 * ef + 4 * p;
                        const bf16x8 af = cat4(vtr(VT + (32 * kk + 4 * g + qp) * 544 + col * 2), vtr(VT + (32 * kk + 16 + 4 * g + qp) * 544 + col * 2));
                        ai[ef] = MFMA16(af, pb[kk], ai[ef]); }
                }
#pragma unroll
                for (int ef = 0; ef < 8; ++ef) {
#pragma unroll
                    for (int ks = 0; ks < 4; ++ks) { const bf16x8 cfr = *(const LAS bf16x8*)(CP + (128 * eh + 16 * ef + j) * 288 + (32 * ks + 8 * g) * 2); ae[ef] = MFMA16(cfr, qf[ks], ae[ef]); }
                }
                float qn = 0.f;
#pragma unroll
                for (int ks = 0; ks < 4; ++ks) { float qv[8]; unpack8(__builtin_bit_cast(u32x4, qf[ks]), qv);
#pragma unroll
                    for (int e = 0; e < 8; ++e) qn += qv[e] * NP[32 * ks + 8 * g + e]; }
                qn = xg_sum(qn);
                rowsum = xg_sum(rowsum);
                const float den = wi_t * qn + rowsum;
                const float dinv = __builtin_amdgcn_rcpf(fmaxf(fabsf(den), emt_t));
                float ssq = 0.f;
#pragma unroll
                for (int ef = 0; ef < 8; ++ef) { ai[ef] = (ae[ef] * wi_t + ai[ef]) * dinv; ssq += (ai[ef][0] * ai[ef][0] + ai[ef][1] * ai[ef][1]) + (ai[ef][2] * ai[ef][2] + ai[ef][3] * ai[ef][3]); }
                ssq = xg_sum(ssq);
                if (g == 0) XCH[eh * 64 + t] = ssq;
                __syncthreads();
                const float rn = __builtin_amdgcn_rsqf((XCH[t] + XCH[64 + t]) * (1.0f / 256.0f) + NORM_EPS);
                bf16* orow = proj + (size_t)(b * SEQ + c * 64 + t) * NPROJ;
#pragma unroll
                for (int ef = 0; ef < 8; ++ef) { const int e = 128 * eh + 16 * ef + 4 * g;
                    const f32x4 nw = *(const f32x4*)(a.mlstm_norm_w + h * 256 + e);
                    const u32x2 mo = mo_pre[ef];
                    const float mof[4] = {bf_lo(mo.x), bf_hi(mo.x), bf_lo(mo.y), bf_hi(mo.y)};
                    float r4[4];
#pragma unroll
                    for (int e2 = 0; e2 < 4; ++e2) r4[e2] = ai[ef][e2] * rn * nw[e2] * __builtin_amdgcn_rcpf(1.0f + __expf(-mof[e2]));
                    u32x2 w; w.x = cvtpk(r4[0], r4[1]); w.y = cvtpk(r4[2], r4[3]); if (!dry) *(u32x2*)(orow + PC_MV + h * 256 + e) = w; }
                if (hh == 0) {
                    f32x4 acc[8][2]; f32x4 accn = {0.f, 0.f, 0.f, 0.f};
#pragma unroll
                    for (int df = 0; df < 8; ++df) { acc[df][0] = (f32x4){0.f, 0.f, 0.f, 0.f}; acc[df][1] = (f32x4){0.f, 0.f, 0.f, 0.f}; }
#pragma unroll
                    for (int kk = 0; kk < 2; ++kk) {
                        const f32x4 wlo = *(const LAS f32x4*)(WL + 32 * kk + 4 * g), whi = *(const LAS f32x4*)(WL + 32 * kk + 16 + 4 * g);
                        const float wrow[8] = {wlo[0], wlo[1], wlo[2], wlo[3], whi[0], whi[1], whi[2], whi[3]};
                        bf16x8 bfr[2];
#pragma unroll
                        for (int ef = 0; ef < 2; ++ef) { const int col = 32 * wave + 16 * ef + 4 * p;
                            const bf16x8 raw = cat4(vtr(VT + (32 * kk + 4 * g + qp) * 544 + col * 2), vtr(VT + (32 * kk + 16 + 4 * g + qp) * 544 + col * 2));
                            float fv[8]; unpack8(__builtin_bit_cast(u32x4, raw), fv);
#pragma unroll
                            for (int e = 0; e < 8; ++e) fv[e] *= wrow[e];
                            const u32x4 pw = pack8(fv); bfr[ef] = __builtin_bit_cast(bf16x8, pw); }
                        float wc0[8];
#pragma unroll
                        for (int e = 0; e < 8; ++e) wc0[e] = (j == 0) ? wrow[e] : 0.f;
                        const u32x4 pwn = pack8(wc0); const bf16x8 bwn = __builtin_bit_cast(bf16x8, pwn);
#pragma unroll
                        for (int df = 0; df < 8; ++df) { const int col = 16 * df + 4 * p;
                            const bf16x8 af = cat4(vtr(KT + (32 * kk + 4 * g + qp) * 288 + col * 2), vtr(KT + (32 * kk + 16 + 4 * g + qp) * 288 + col * 2));
                            acc[df][0] = MFMA16(af, bfr[0], acc[df][0]); acc[df][1] = MFMA16(af, bfr[1], acc[df][1]);
                            if (df == wave) accn = MFMA16(af, bwn, accn); }
                    }
#pragma unroll
                    for (int ef = 0; ef < 2; ++ef) { const int e = 32 * wave + 16 * ef + j;
#pragma unroll
                        for (int df = 0; df < 8; ++df) { LAS u32x2* cp_ = (LAS u32x2*)(CP + e * 288 + (16 * df + 4 * g) * 2); const u32x2 old = *cp_; const f32x4 v = acc[df][ef];
                            u32x2 w; w.x = cvtpk(so_u * bf_lo(old.x) + v[0], so_u * bf_hi(old.x) + v[1]); w.y = cvtpk(so_u * bf_lo(old.y) + v[2], so_u * bf_hi(old.y) + v[3]); *cp_ = w; } }
                    if (j == 0) {
#pragma unroll
                        for (int rg = 0; rg < 4; ++rg) { const int d_ = 16 * wave + 4 * g + rg; NP[d_] = so_u * NP[d_] + accn[rg]; } }
                    mprev = m_u;
                }
                __syncthreads();
            }
        }
        for (int pidx = vcu; pidx < 256; pidx += G) {
            const AUnit ua{0, (pidx >> 5) & 7, 1, 0, pidx & 31, op0, pl0}, ub{1, (pidx >> 5) & 7, 1, 0, pidx & 31, op0, pl0};
            attn_pair<true>(proj, rcos, rsin, a.q_norm_w, a.k_norm_w, a.attn_norm_w, ua, ub, lds, op1, pl1, tid, dry);
        }
    REP_END
    xcd_barrier(bar);

    REP_BEGIN(6)
        pg8::Gemm g{proj + PC_MV, WoutT, MTOK, DM, DM, NPROJ}; pg8::StaticOrder S; S.init(MTOK, DM, G, bx);
        pg8::EpiRes1 E{a.x, a.out, H1b, sumsq, DM, dry};
        pg8::gemm_phase<pg8::EpiRes1, false>(lds, g, S, E);
    REP_END
    xcd_barrier(bar);

    REP_BEGIN(7)
        pg8::Gemm g{H1b, WguT, MTOK, NGU, DM, DM}; pg8::StaticOrder S; S.init(MTOK, NGU, G, bx);
        LAS float* rsl = (LAS float*)(lds + RING_BYTES);
        { pg8::Unit uu; for (int i = 0; i < 8 && S.next(i, uu); ++i) if (tid < 256) rsl[i * 256 + tid] = __builtin_amdgcn_rsqf(sumsq[uu.pm * 256 + tid] * (1.0f / DM) + NORM_EPS); }
        __syncthreads();
        pg8::EpiSwiGLU E{FF, DFF, rsl, sumsq};
        pg8::gemm_phase<pg8::EpiSwiGLU, true>(lds, g, S, E);
        if (rep_ == 1) {
            const int nfull = (MTOK / 256) * (NGU / 256) - 5 * G;
            const int nidle = G - nfull;
            if (G == 256 ? (bx >= nfull) : true) {
                LAS float* scr = (LAS float*)(lds + wave * 16384);
                constexpr int I_DN = (DFF / 64) * (DM / 32);
                const int w0 = (G == 256) ? (bx - nfull) * NWAVES + wave : gw, nw = (G == 256) ? nidle * NWAVES : NGW;
                for (int it = w0; it < I_DN; it += nw) { const int nblk = DM / 32, kb = it / nblk, nb = it % nblk;
                    const TItem t{a.w_down, WdnT, nullptr, DM, DFF, nb * 32, nb * 32, kb * 64}; f32x4 v[8]; titem_load(t, v, lane); titem_finish(t, v, scr, lane); }
            }
        }
    REP_END
    xcd_barrier(bar);

    REP_BEGIN(8)
        pg8::Gemm g{FF, WdnT, MTOK, DM, DFF, DFF}; pg8::StaticOrder S; S.init(MTOK, DM, G, bx);
        pg8::EpiRes2 E{H1b, a.out, DM, dry};
        pg8::gemm_phase<pg8::EpiRes2, false>(lds, g, S, E);
    REP_END
}

extern "C" void kernel_launch(void* const* d_in, const int* in_sizes, int n_in, void* d_out, int out_size, void* d_ws, size_t ws_size, hipStream_t stream) {
    static int grid = 0;
    if (grid == 0) {
        if (n_in != 16 || in_sizes[0] != MTOK * DM || out_size != MTOK * DM || ws_size < WS_END) { fprintf(stderr, "kernel_launch: unexpected shapes (n_in %d in0 %d out %d ws %zu)\n", n_in, n_in > 0 ? in_sizes[0] : -1, out_size, ws_size); grid = -1; return; }
        int dev = 0, cus = 0;
        if (hipGetDevice(&dev) != hipSuccess || hipDeviceGetAttribute(&cus, hipDeviceAttributeMultiprocessorCount, dev) != hipSuccess || cus <= 0) cus = 256;
        if (hipFuncSetAttribute((const void*)hymba_fwd, hipFuncAttributeMaxDynamicSharedMemorySize, LDS_BYTES) != hipSuccess) { fprintf(stderr, "kernel_launch: hipFuncSetAttribute failed\n"); grid = -1; return; }
        (void)hipGetLastError();
        grid = cus;
    }
    if (grid < 0) return;
    if (hipMemsetAsync((char*)d_ws + WS_CTL, 0, CTL_ZERO_BYTES, stream) != hipSuccess) { fprintf(stderr, "kernel_launch: memset failed\n"); return; }
    Args a{};
    a.x = (const float*)d_in[0]; a.norm1_w = (const float*)d_in[1]; a.w_in = (const float*)d_in[2]; a.conv_w = (const float*)d_in[3]; a.conv_b = (const float*)d_in[4];
    a.igate_b = (const float*)d_in[5]; a.fgate_b = (const float*)d_in[6]; a.q_norm_w = (const float*)d_in[7]; a.k_norm_w = (const float*)d_in[8];
    a.mlstm_norm_w = (const float*)d_in[9]; a.attn_norm_w = (const float*)d_in[10]; a.w_out = (const float*)d_in[11]; a.norm2_w = (const float*)d_in[12];
    a.w_gate = (const float*)d_in[13]; a.w_up = (const float*)d_in[14]; a.w_down = (const float*)d_in[15];
    a.out = (float*)d_out; a.ws = (unsigned char*)d_ws; a.dry = (PROBE_PHASE >= 0) ? 1 : 0;
    hipLaunchKernelGGL(hymba_fwd, dim3(grid), dim3(NWAVES * 64), LDS_BYTES, stream, a);
}
```

```cpp
#include <hip/hip_runtime.h>
#include <cstdio>
#include <cstdint>

#define LAS __attribute__((address_space(3)))
#define GAS __attribute__((address_space(1)))
typedef unsigned short bf16;
typedef short bf16x8 __attribute__((ext_vector_type(8)));
typedef short s16x4 __attribute__((ext_vector_type(4)));
typedef float f32x4 __attribute__((ext_vector_type(4)));
typedef float f32x2 __attribute__((ext_vector_type(2)));
typedef unsigned u32x4 __attribute__((ext_vector_type(4)));
typedef unsigned u32x2 __attribute__((ext_vector_type(2)));
typedef __bf16 bf16x2_t __attribute__((ext_vector_type(2)));

constexpr int BATCH = 2, SEQ = 4096, DM = 2048, MTOK = BATCH * SEQ;
constexpr int INW = 6152, NPROJ = 6144, DFF = 5632, NGU = 2 * DFF;
constexpr int PC_MQ = 0, PC_MK = 512, PC_MO = 1024, PC_MV = 2048, PC_AQ = 3072, PC_AK = 4096, PC_AV = 5120;
constexpr float NORM_EPS = 1e-6f;
constexpr int NWAVES = 8;

constexpr size_t MiB = 1u << 20;
constexpr size_t WS_CTL = 0, CTL_ZERO_BYTES = 32 * 1024;
constexpr size_t WS_GLI = 1 * MiB;
constexpr size_t WS_GLF = WS_GLI + 128 * 1024;
constexpr size_t WS_SUMSQ = WS_GLF + 128 * 1024;
constexpr size_t WS_MSC = WS_SUMSQ + 32 * 1024;
constexpr size_t WS_NC = WS_MSC + 8 * 1024;
constexpr size_t WS_COS = 2 * MiB, WS_SIN = 3 * MiB;
constexpr size_t WS_WIN = 6 * MiB;
constexpr size_t WS_KV = 6 * MiB;
constexpr size_t WS_U = 30 * MiB;
constexpr size_t WS_PROJ = 62 * MiB;
constexpr size_t WS_WOUT = 158 * MiB;
constexpr size_t WS_WGU = 166 * MiB;
constexpr size_t WS_WDN = 210 * MiB;
constexpr size_t WS_OP0 = 38 * MiB;
constexpr size_t WS_OP1 = 232 * MiB;
constexpr size_t WS_PL0 = 248 * MiB, WS_PL1 = WS_PL0 + 256 * 1024;
constexpr size_t WS_END = 249 * MiB;
constexpr int CW_BAR = 4096;

constexpr int RING_BYTES = 131072;
constexpr int MISC_OFF = 147456 - 256;
constexpr int LDS_BYTES = 147456;

__device__ __forceinline__ unsigned cvtpk(float lo, float hi) { f32x2 v = {lo, hi}; bf16x2_t b = __builtin_convertvector(v, bf16x2_t); return __builtin_bit_cast(unsigned, b); }
__device__ __forceinline__ float bf_lo(unsigned w) { return __uint_as_float(w << 16); }
__device__ __forceinline__ float bf_hi(unsigned w) { return __uint_as_float(w & 0xffff0000u); }
__device__ __forceinline__ void unpack8(u32x4 w, float* f) { f[0] = bf_lo(w.x); f[1] = bf_hi(w.x); f[2] = bf_lo(w.y); f[3] = bf_hi(w.y); f[4] = bf_lo(w.z); f[5] = bf_hi(w.z); f[6] = bf_lo(w.w); f[7] = bf_hi(w.w); }
__device__ __forceinline__ u32x4 pack8(const float* f) { u32x4 w; w.x = cvtpk(f[0], f[1]); w.y = cvtpk(f[2], f[3]); w.z = cvtpk(f[4], f[5]); w.w = cvtpk(f[6], f[7]); return w; }
#define DPP_MOV_F(v, ctrl) __uint_as_float((unsigned)__builtin_amdgcn_mov_dpp((int)__float_as_uint(v), (ctrl), 0xf, 0xf, true))
__device__ __forceinline__ float row16_sum(float v) { v += DPP_MOV_F(v, 0xB1); v += DPP_MOV_F(v, 0x4E); v += DPP_MOV_F(v, 0x124); v += DPP_MOV_F(v, 0x128); return v; }
__device__ __forceinline__ float x16_sum(float v) { const auto r = __builtin_amdgcn_permlane16_swap(__float_as_uint(v), __float_as_uint(v), false, false); return __uint_as_float(r[0]) + __uint_as_float(r[1]); }
__device__ __forceinline__ float x32_sum(float v) { const auto r = __builtin_amdgcn_permlane32_swap(__float_as_uint(v), __float_as_uint(v), false, false); return __uint_as_float(r[0]) + __uint_as_float(r[1]); }
__device__ __forceinline__ float x16_max(float v) { const auto r = __builtin_amdgcn_permlane16_swap(__float_as_uint(v), __float_as_uint(v), false, false); return fmaxf(__uint_as_float(r[0]), __uint_as_float(r[1])); }
__device__ __forceinline__ float x32_max(float v) { const auto r = __builtin_amdgcn_permlane32_swap(__float_as_uint(v), __float_as_uint(v), false, false); return fmaxf(__uint_as_float(r[0]), __uint_as_float(r[1])); }
__device__ __forceinline__ float xg_sum(float v) { return x32_sum(x16_sum(v)); }
__device__ __forceinline__ float xg_max(float v) { return x32_max(x16_max(v)); }
__device__ __forceinline__ float wave_sum(float v) { return xg_sum(row16_sum(v)); }
__device__ __forceinline__ float wave_max(float v) {
#pragma unroll
    for (int o = 1; o < 64; o <<= 1) v = fmaxf(v, __shfl_xor(v, o));
    return v;
}
__device__ __forceinline__ s16x4 vtr(const LAS unsigned char* p) { return __builtin_bit_cast(s16x4, __builtin_amdgcn_ds_read_tr16_b64_v4i16((LAS s16x4*)p)); }
__device__ __forceinline__ bf16x8 cat4(s16x4 a, s16x4 b) { return (bf16x8){a[0], a[1], a[2], a[3], b[0], b[1], b[2], b[3]}; }
#define LDS_WAIT() asm volatile("s_waitcnt lgkmcnt(0)" ::: "memory")
#define VM_WAIT() asm volatile("s_waitcnt vmcnt(0)" ::: "memory")
#define SBAR() __builtin_amdgcn_sched_barrier(0)
#define MFMA16(a, b, c) __builtin_amdgcn_mfma_f32_16x16x32_bf16((a), (b), (c), 0, 0, 0)

namespace pg8 {
constexpr int BM = 256, BK = 64, HALF = 128, HTB = HALF * BK * 2, STAGE_BYTES = 8 * HTB, NXCD = 8, WGM = 8;
__host__ __device__ __forceinline__ int lds_byte(int r, int c) { const int st = (r >> 4) * 2 + (c >> 5), rr = r & 15, cc = c & 31, ob = rr * 64 + cc * 2; return st * 1024 + (ob ^ (((ob >> 9) & 1) << 5)); }
__host__ __device__ __forceinline__ void stage_rc(int b, int& R, int& C) { const int st = b / 1024, sb = b % 1024, swz = sb ^ (((sb >> 9) & 1) << 5); R = (st >> 1) * 16 + swz / 64; C = (st & 1) * 32 + (swz % 64) / 2; }
__host__ __device__ __forceinline__ int perm32(int rho) { const int n = rho >> 4, i = rho & 15; return 8 * (i >> 2) + 4 * n + (i & 3); }
struct Unit { int pm, pn, ord; };
struct Gemm { const bf16* A; const bf16* Bt; int M, N, K, lda; };
struct StaticOrder {
    int nM, nN, nwg, G, c;
    __device__ void init(int M, int N, int G_, int c_) { nM = M / BM; nN = N / BM; nwg = nM * nN; G = G_; c = c_; }
    __device__ bool next(int i, Unit& u) const {
        const long L = (long)i * G + c; if (L >= nwg) return false; u.ord = i;
        int wgid = (int)L; { const int q = nwg / NXCD, r = nwg % NXCD, xcd = wgid % NXCD, off = wgid / NXCD; wgid = (xcd < r ? xcd * (q + 1) : r * (q + 1) + (xcd - r) * q) + off; }
        const int nig = WGM * nN, gid = wgid / nig, fm = gid * WGM, gsz = (nM - fm) < WGM ? (nM - fm) : WGM;
        u.pm = fm + ((wgid % nig) % gsz); u.pn = (wgid % nig) / gsz; return true;
    }
};
struct EpiBf16 {
    static constexpr bool PERM = true, HAS_INIT = false;
    bf16* O; int ldc;
    __device__ __forceinline__ void operator()(const f32x4 (&acc)[2][2][4][2], const Unit& u, int wr, int wc, int fr, int fq) const {
        const int row0 = u.pm * BM + wr * 64 + fr, col0 = u.pn * BM + wc * 32 + 8 * fq;
#pragma unroll
        for (int ai = 0; ai < 2; ++ai)
#pragma unroll
            for (int m = 0; m < 4; ++m) { bf16* rowp = O + (size_t)(row0 + ai * HALF + m * 16) * ldc + col0;
#pragma unroll
                for (int bj = 0; bj < 2; ++bj) { const f32x4 v0 = acc[ai][bj][m][0], v1 = acc[ai][bj][m][1];
                    u32x4 w; w.x = cvtpk(v0[0], v0[1]); w.y = cvtpk(v0[2], v0[3]); w.z = cvtpk(v1[0], v1[1]); w.w = cvtpk(v1[2], v1[3]);
                    *(u32x4*)(rowp + bj * HALF) = w; } }
    }
};
struct EpiRes1 {
    static constexpr bool PERM = false, HAS_INIT = true;
    const float* xres; float* out; bf16* h1b; float* sumsq; int ldc; bool dry;
    __device__ __forceinline__ void init(f32x4 (&acc)[2][2][4][2], const Unit& u, int wr, int wc, int fr, int fq) const {
        const int col0 = u.pn * BM + wc * 32 + 4 * fq;
#pragma unroll
        for (int ai = 0; ai < 2; ++ai)
#pragma unroll
            for (int m = 0; m < 4; ++m) { const size_t off = (size_t)(u.pm * BM + ai * HALF + wr * 64 + m * 16 + fr) * ldc + col0;
#pragma unroll
                for (int bj = 0; bj < 2; ++bj)
#pragma unroll
                    for (int n = 0; n < 2; ++n) acc[ai][bj][m][n] = __builtin_nontemporal_load((const f32x4*)(xres + off + bj * HALF + n * 16)); }
    }
    __device__ __forceinline__ void operator()(const f32x4 (&acc)[2][2][4][2], const Unit& u, int wr, int wc, int fr, int fq) const {
        const int col0 = u.pn * BM + wc * 32 + 4 * fq;
#pragma unroll
        for (int ai = 0; ai < 2; ++ai)
#pragma unroll
            for (int m = 0; m < 4; ++m) { const int row = u.pm * BM + ai * HALF + wr * 64 + m * 16 + fr; const size_t off = (size_t)row * ldc + col0; float ss = 0.f;
#pragma unroll
                for (int bj = 0; bj < 2; ++bj)
#pragma unroll
                    for (int n = 0; n < 2; ++n) { const size_t o2 = off + bj * HALF + n * 16; const f32x4 h = acc[ai][bj][m][n];
                        u32x2 w; w.x = cvtpk(h[0], h[1]); w.y = cvtpk(h[2], h[3]); if (!dry) { *(u32x2*)(h1b + o2) = w; }
                        ss += (h[0] * h[0] + h[1] * h[1]) + (h[2] * h[2] + h[3] * h[3]); }
                ss = xg_sum(ss);
                if (fq == 0 && !dry) atomicAdd(sumsq + row, ss); }
    }
};
struct EpiSwiGLU {
    static constexpr bool PERM = true, HAS_INIT = false;
    bf16* O; int ldc; const LAS float* rsl; const float* sumsq;
    __device__ __forceinline__ void operator()(const f32x4 (&acc)[2][2][4][2], const Unit& u, int wr, int wc, int fr, int fq) const {
        const int col0 = u.pn * HALF + wc * 32 + 8 * fq;
#pragma unroll
        for (int ai = 0; ai < 2; ++ai)
#pragma unroll
            for (int m = 0; m < 4; ++m) { const int rl = ai * HALF + wr * 64 + m * 16 + fr; const int row = u.pm * BM + rl;
                const float rs = (u.ord < 8) ? rsl[u.ord * 256 + rl] : __builtin_amdgcn_rsqf(sumsq[row] * (1.0f / DM) + NORM_EPS);
                float f[8];
#pragma unroll
                for (int n = 0; n < 2; ++n)
#pragma unroll
                    for (int j = 0; j < 4; ++j) { const float g = acc[ai][0][m][n][j] * rs, up = acc[ai][1][m][n][j] * rs; f[n * 4 + j] = g * __builtin_amdgcn_rcpf(1.0f + __expf(-g)) * up; }
                *(u32x4*)(O + (size_t)row * ldc + col0) = pack8(f); }
    }
};
struct EpiRes2 {
    static constexpr bool PERM = false, HAS_INIT = true;
    const bf16* h1b; float* out; int ldc; bool dry;
    __device__ __forceinline__ void init(f32x4 (&acc)[2][2][4][2], const Unit& u, int wr, int wc, int fr, int fq) const {
        const int col0 = u.pn * BM + wc * 32 + 4 * fq;
#pragma unroll
        for (int ai = 0; ai < 2; ++ai)
#pragma unroll
            for (int m = 0; m < 4; ++m) { const size_t off = (size_t)(u.pm * BM + ai * HALF + wr * 64 + m * 16 + fr) * ldc + col0;
#pragma unroll
                for (int bj = 0; bj < 2; ++bj)
#pragma unroll
                    for (int n = 0; n < 2; ++n) { const u32x2 w = __builtin_nontemporal_load((const u32x2*)(h1b + off + bj * HALF + n * 16)); acc[ai][bj][m][n] = (f32x4){bf_lo(w.x), bf_hi(w.x), bf_lo(w.y), bf_hi(w.y)}; } }
    }
    __device__ __forceinline__ void operator()(const f32x4 (&acc)[2][2][4][2], const Unit& u, int wr, int wc, int fr, int fq) const {
        const int col0 = u.pn * BM + wc * 32 + 4 * fq;
#pragma unroll
        for (int ai = 0; ai < 2; ++ai)
#pragma unroll
            for (int m = 0; m < 4; ++m) { const size_t off = (size_t)(u.pm * BM + ai * HALF + wr * 64 + m * 16 + fr) * ldc + col0;
#pragma unroll
                for (int bj = 0; bj < 2; ++bj)
#pragma unroll
                    for (int n = 0; n < 2; ++n) { if (!dry) __builtin_nontemporal_store(acc[ai][bj][m][n], (f32x4*)(out + off + bj * HALF + n * 16)); } }
    }
};

template <class Epi, bool ALIGN_EPI>
__device__ __forceinline__ void gemm_phase(LAS unsigned char* lds, const Gemm g, const StaticOrder& S, const Epi& E) {
    int tid = threadIdx.x; asm volatile("" : "+v"(tid));
    const int wid = __builtin_amdgcn_readfirstlane(tid >> 6), lane = tid & 63, wr = wid >> 2, wc = wid & 3, fr = lane & 15, fq = lane >> 4;
    const int K = g.K, nt = K / BK;
    unsigned voffA[2], voffB[2];
#pragma unroll
    for (int i = 0; i < 2; ++i) { int R, C; stage_rc(tid * 16 + i * 8192, R, C); const int Rb = Epi::PERM ? ((R & ~31) + perm32(R & 31)) : R;
        voffA[i] = (unsigned)(R * g.lda + C) * 2u; voffB[i] = (unsigned)(Rb * K + C) * 2u; }
    const size_t kstep = (size_t)(BK * 2);
    const size_t hstepA = (size_t)HALF * g.lda * 2, hstepB = (size_t)HALF * K * 2;
    const size_t tstepA = 2 * hstepA, tstepB = 2 * hstepB;
    const unsigned ldsw = (unsigned)wid * 1024u;
    const int aoff = lds_byte(wr * 64 + fr, fq * 8), boff = lds_byte(wc * 32 + fr, fq * 8);
#define PG8_SA(b, h) (((b) * 2 + (h)) * HTB)
#define PG8_SB(b, h) ((4 + (b) * 2 + (h)) * HTB)
#define PG8_STAGE(bufoff, gbase, voff) do { _Pragma("unroll") for (int _i = 0; _i < 2; ++_i) \
        __builtin_amdgcn_global_load_lds((const unsigned*)((const char*)(gbase) + (voff)[_i]), (LAS unsigned*)(lds + (bufoff) + ldsw + _i * 8192), 16, 0, 0); } while (0)
#define PG8_LDA(dst, b, h) do { _Pragma("unroll") for (int m = 0; m < 4; ++m) _Pragma("unroll") for (int k = 0; k < 2; ++k) dst[m][k] = *(const LAS bf16x8*)(lds + PG8_SA(b, h) + aoff + m * 2048 + k * 1024); } while (0)
#define PG8_LDB(dst, b, h) do { _Pragma("unroll") for (int n = 0; n < 2; ++n) _Pragma("unroll") for (int k = 0; k < 2; ++k) dst[n][k] = *(const LAS bf16x8*)(lds + PG8_SB(b, h) + boff + n * 2048 + k * 1024); } while (0)
#define PG8_MMA(ai, bj, At, Bt) do { __builtin_amdgcn_s_setprio(1); _Pragma("unroll") for (int m = 0; m < 4; ++m) _Pragma("unroll") for (int n = 0; n < 2; ++n) _Pragma("unroll") for (int k = 0; k < 2; ++k) \
        acc[ai][bj][m][n] = __builtin_amdgcn_mfma_f32_16x16x32_bf16(Bt[n][k], At[m][k], acc[ai][bj][m][n], 0, 0, 0); __builtin_amdgcn_s_setprio(0); } while (0)
#define PG8_WAIT_V(n) asm volatile("s_waitcnt vmcnt(" #n ")" ::: "memory")
#define PG8_WAIT_L(n) asm volatile("s_waitcnt lgkmcnt(" #n ")" ::: "memory")
#define PG8_BAR __builtin_amdgcn_s_barrier()
#define PG8_SCHED __builtin_amdgcn_sched_barrier(0)
    Unit cur, nxt; int ui = 0;
    if (!S.next(0, cur)) return;
    f32x4 acc[2][2][4][2];
    if constexpr (Epi::HAS_INIT) { E.init(acc, cur, wr, wc, fr, fq); }
    else {
#pragma unroll
    for (int a = 0; a < 2; ++a)
#pragma unroll
        for (int b = 0; b < 2; ++b)
#pragma unroll
            for (int m = 0; m < 4; ++m)
#pragma unroll
                for (int n = 0; n < 2; ++n) acc[a][b][m][n] = (f32x4){0.f, 0.f, 0.f, 0.f};
    }
    bf16x8 At[4][2], B0[2][2], B1[2][2];
    const char* cA = (const char*)g.A + (size_t)cur.pm * tstepA; const char* cB = (const char*)g.Bt + (size_t)cur.pn * tstepB;
    PG8_STAGE(PG8_SB(0, 0), cB, voffB); PG8_STAGE(PG8_SB(0, 1), cB + hstepB, voffB); PG8_STAGE(PG8_SA(0, 0), cA, voffA); PG8_STAGE(PG8_SA(0, 1), cA + hstepA, voffA);
    if (wr == 1) PG8_BAR;
    PG8_WAIT_V(2); PG8_BAR;
    PG8_STAGE(PG8_SB(1, 0), cB + kstep, voffB); PG8_STAGE(PG8_SA(1, 0), cA + kstep, voffA); PG8_STAGE(PG8_SB(1, 1), cB + hstepB + kstep, voffB);
    PG8_WAIT_V(6); PG8_BAR;
    for (;;) {
        const bool has_next = S.next(ui + 1, nxt);
        const char* nA = has_next ? (const char*)g.A + (size_t)nxt.pm * tstepA : cA; const char* nB = has_next ? (const char*)g.Bt + (size_t)nxt.pn * tstepB : cB;
        for (int t = 0; t < nt; t += 2) {
            const bool last = (t == nt - 2);
            const char* a1 = cA + (size_t)(t + 1) * kstep;
            const char* a2 = last ? nA : cA + (size_t)(t + 2) * kstep; const char* b2 = last ? nB : cB + (size_t)(t + 2) * kstep;
            const char* a3 = a2 + kstep; const char* b3 = b2 + kstep;
            PG8_LDB(B0, 0, 0); PG8_LDB(B1, 0, 1); PG8_SCHED; PG8_LDA(At, 0, 0); PG8_STAGE(PG8_SA(1, 1), a1 + hstepA, voffA);
            PG8_WAIT_V(8); PG8_WAIT_L(0); PG8_BAR; PG8_MMA(0, 0, At, B0); PG8_MMA(0, 1, At, B1); PG8_BAR; PG8_SCHED;
            PG8_LDA(At, 0, 1); PG8_STAGE(PG8_SB(0, 0), b2, voffB); PG8_STAGE(PG8_SB(0, 1), b2 + hstepB, voffB); PG8_STAGE(PG8_SA(0, 0), a2, voffA);
            PG8_WAIT_V(8); PG8_WAIT_L(0); PG8_BAR; PG8_MMA(1, 0, At, B0); PG8_MMA(1, 1, At, B1); PG8_BAR; PG8_SCHED;
            PG8_LDB(B0, 1, 0); PG8_LDB(B1, 1, 1); PG8_SCHED; PG8_LDA(At, 1, 0); PG8_STAGE(PG8_SA(0, 1), a2 + hstepA, voffA);
            PG8_WAIT_V(8); PG8_WAIT_L(0); PG8_BAR; PG8_MMA(0, 0, At, B0); PG8_MMA(0, 1, At, B1); PG8_BAR; PG8_SCHED;
            PG8_LDA(At, 1, 1); PG8_STAGE(PG8_SB(1, 0), b3, voffB); PG8_STAGE(PG8_SB(1, 1), b3 + hstepB, voffB); PG8_STAGE(PG8_SA(1, 0), a3, voffA);
            PG8_WAIT_V(8); PG8_WAIT_L(0); PG8_BAR; PG8_MMA(1, 0, At, B0); PG8_MMA(1, 1, At, B1); PG8_BAR; PG8_SCHED;
        }
        if constexpr (ALIGN_EPI) { if (wr == 0) PG8_BAR; }
        E(acc, cur, wr, wc, fr, fq);
        if (!has_next) break;
        if constexpr (Epi::HAS_INIT) { E.init(acc, nxt, wr, wc, fr, fq); }
        else {
#pragma unroll
        for (int a = 0; a < 2; ++a)
#pragma unroll
            for (int b = 0; b < 2; ++b)
#pragma unroll
                for (int m = 0; m < 4; ++m)
#pragma unroll
                    for (int n = 0; n < 2; ++n) acc[a][b][m][n] = (f32x4){0.f, 0.f, 0.f, 0.f};
        }
        cur = nxt; cA = nA; cB = nB; ++ui;
        if constexpr (ALIGN_EPI) { if (wr == 1) PG8_BAR; }
    }
    PG8_WAIT_V(0);
    if constexpr (!ALIGN_EPI) { if (wr == 0) PG8_BAR; }
    PG8_BAR;
#undef PG8_SA
#undef PG8_SB
#undef PG8_STAGE
#undef PG8_LDA
#undef PG8_LDB
#undef PG8_MMA
#undef PG8_WAIT_V
#undef PG8_WAIT_L
#undef PG8_BAR
#undef PG8_SCHED
}
}

#define XB_TMO      128
#define XB_XCNT(j)  (256  + 64 * (j))
#define XB_XSUB(j)  (1280 + 64 * (j))
#define XB_XGEN(j)  (2304 + 64 * (j))
#define XB_TOP      3328
#define XB_TOPGEN   3392
#define XCD_BAR_WORDS 3456
#define XB_SPIN_CAP (1u << 18)
__device__ __forceinline__ unsigned xb_ld(unsigned* p)              { return __hip_atomic_load(p, __ATOMIC_RELAXED, __HIP_MEMORY_SCOPE_AGENT); }
__device__ __forceinline__ unsigned xb_add(unsigned* p, unsigned v) { return __hip_atomic_fetch_add(p, v, __ATOMIC_RELAXED, __HIP_MEMORY_SCOPE_AGENT); }
__device__ __forceinline__ unsigned xb_xcc_id() { return (unsigned)__builtin_amdgcn_s_getreg((3 << 11) | 20) & 0xFu; }
#define XB_SPIN(cond, bar) do { unsigned _sp = 0; while (cond) { __builtin_amdgcn_s_sleep(1); \
    if ((++_sp & 255u) == 0u) { if (xb_ld(&(bar)[XB_TMO])) break; if (_sp > XB_SPIN_CAP) { atomicAdd(&(bar)[XB_TMO], 1u); break; } } } } while (0)
struct XcdBarrier { unsigned* bar; unsigned x; volatile LAS unsigned* st; };
__device__ __forceinline__ XcdBarrier xcd_barrier_post(unsigned* bar, volatile LAS unsigned* st) {
    XcdBarrier b; b.bar = bar; b.x = xb_xcc_id(); b.st = st;
    if (threadIdx.x == 0) (void)xb_add(&bar[XB_XCNT(b.x)], 1u);
    return b;
}
__device__ __forceinline__ void xcd_barrier_complete(unsigned* bar, unsigned x, unsigned& nloc, unsigned& nx) {
    const unsigned G = gridDim.x * gridDim.y * gridDim.z;
    unsigned sum, cnt, mine, sp = 0u;
    for (;;) {
        sum = 0u; cnt = 0u; mine = 0u;
#pragma unroll
        for (unsigned j = 0; j < 16; ++j) { const unsigned c = xb_ld(&bar[XB_XCNT(j)]); sum += c; cnt += (c > 0u) ? 1u : 0u; mine = (j == x) ? c : mine; }
        if (sum == G) break;
        __builtin_amdgcn_s_sleep(1);
        if ((++sp & 255u) == 0u) { if (xb_ld(&bar[XB_TMO])) break; if (sp > XB_SPIN_CAP) { atomicAdd(&bar[XB_TMO], 1u); break; } }
    }
    nloc = mine > 0u ? mine : 1u; nx = cnt > 0u ? cnt : 1u;
}
__device__ __forceinline__ void xcd_barrier(const XcdBarrier& b) {
    asm volatile("s_waitcnt vmcnt(0)" ::: "memory");
    __syncthreads();
    if (threadIdx.x == 0) {
        unsigned* bar = b.bar;
        __builtin_amdgcn_s_waitcnt(0);
        unsigned nloc = b.st[0], nx = b.st[1];
        if (nloc == 0u) { xcd_barrier_complete(bar, b.x, nloc, nx); b.st[0] = nloc; b.st[1] = nx; }
        const unsigned old = xb_add(&bar[XB_XSUB(b.x)], 1u);
        const unsigned gen = old / nloc;
        if (old + 1u == (gen + 1u) * nloc) {
            __builtin_amdgcn_fence(__ATOMIC_RELEASE, "agent");
            asm volatile("s_waitcnt vmcnt(0)" ::: "memory");
            const unsigned og = xb_add(&bar[XB_TOP], 1u);
            const unsigned tg = og / nx;
            if (og + 1u == (tg + 1u) * nx) xb_add(&bar[XB_TOPGEN], 1u);
            else XB_SPIN(xb_ld(&bar[XB_TOPGEN]) == tg, bar);
            __builtin_amdgcn_fence(__ATOMIC_ACQUIRE, "agent");
            xb_add(&bar[XB_XGEN(b.x)], 1u);
            asm volatile("s_waitcnt vmcnt(0)" ::: "memory");
        } else {
            XB_SPIN(xb_ld(&bar[XB_XGEN(b.x)]) == gen, bar);
            __builtin_amdgcn_fence(__ATOMIC_ACQUIRE, "agent");
            asm volatile("s_waitcnt vmcnt(0)" ::: "memory");
        }
    }
    __syncthreads();
}

struct Args {
    const float* x; const float* norm1_w; const float* w_in; const float* conv_w; const float* conv_b; const float* igate_b; const float* fgate_b;
    const float* q_norm_w; const float* k_norm_w; const float* mlstm_norm_w; const float* attn_norm_w; const float* w_out; const float* norm2_w;
    const float* w_gate; const float* w_up; const float* w_down;
    float* out; unsigned char* ws; int dry; int pad;
};

struct TItem { const float* W; bf16* WT; const float* kscale; int ldw, K, nsrc0, ndst0, k0; };
__device__ __forceinline__ void titem_load(const TItem& t, f32x4 (&v)[8], int lane) {
    const float* src = t.W + (size_t)(t.k0 + (lane >> 3)) * t.ldw + t.nsrc0 + (lane & 7) * 4;
#pragma unroll
    for (int i = 0; i < 8; ++i) v[i] = __builtin_nontemporal_load((const f32x4*)(src + (size_t)(8 * i) * t.ldw));
}
__device__ __forceinline__ void titem_finish(const TItem& t, const f32x4 (&v)[8], LAS float* scr, int lane) {
#pragma unroll
    for (int i = 0; i < 8; ++i) { const int kk = 8 * i + (lane >> 3); const float sc = t.kscale ? t.kscale[t.k0 + kk] : 1.0f; LAS float* d = scr + kk * 33 + (lane & 7) * 4;
        d[0] = v[i][0] * sc; d[1] = v[i][1] * sc; d[2] = v[i][2] * sc; d[3] = v[i][3] * sc; }
    LDS_WAIT(); asm volatile("" ::: "memory");
    const int c = lane & 7;
#pragma unroll
    for (int j = 0; j < 4; ++j) { const int n = (lane >> 3) + 8 * j; const LAS float* s = scr + (8 * c) * 33 + n;
        u32x4 o; o.x = cvtpk(s[0 * 33], s[1 * 33]); o.y = cvtpk(s[2 * 33], s[3 * 33]); o.z = cvtpk(s[4 * 33], s[5 * 33]); o.w = cvtpk(s[6 * 33], s[7 * 33]);
        *(u32x4*)(t.WT + (size_t)(t.ndst0 + n) * t.K + t.k0 + 8 * c) = o; }
    LDS_WAIT(); asm volatile("" ::: "memory");
}
__device__ __forceinline__ int win_src_col(int nd) {
    if (nd < 1024) return nd;
    if (nd < 2048) return nd + 1024;
    if (nd < 3072) return nd - 1024;
    return nd + 8;
}


__device__ __forceinline__ float scan_add64(float v, int lane) {
#pragma unroll
    for (int o = 1; o < 64; o <<= 1) { const float t = __shfl_up(v, o); if (lane >= o) v += t; }
    return v;
}
__device__ __forceinline__ float scan_max64(float v, int lane) {
#pragma unroll
    for (int o = 1; o < 64; o <<= 1) { const float t = __shfl_up(v, o); if (lane >= o) v = fmaxf(v, t); }
    return v;
}
__device__ __forceinline__ void conv_issue(const bf16* proj, int b, int c, int col0, int tid, u32x4 (&raw)[2][4]) {
    const int rr = tid >> 4, cc = (tid & 15) * 8;
#pragma unroll
    for (int half = 0; half < 2; ++half)
#pragma unroll
        for (int j = 0; j < 4; ++j) { const int tt = c * 64 + rr + 32 * half - 3 + j; const int ttc = tt < 0 ? 0 : tt;
            raw[half][j] = *(const u32x4*)(proj + (size_t)(b * SEQ + ttc) * NPROJ + col0 + cc); }
}
template <bool ROWW>
__device__ __forceinline__ void conv_finish(const u32x4 (&raw)[2][4], const float* conv_w, const float* conv_b, int c, int ch0, float rscale, float wlane, LAS unsigned char* tile, int tid) {
    const int rr = tid >> 4, cc = (tid & 15) * 8;
    float w[4][8], bb[8];
#pragma unroll
    for (int j = 0; j < 4; ++j) { const f32x4 w0 = *(const f32x4*)(conv_w + j * 1024 + ch0 + cc), w1 = *(const f32x4*)(conv_w + j * 1024 + ch0 + cc + 4);
        w[j][0] = w0[0]; w[j][1] = w0[1]; w[j][2] = w0[2]; w[j][3] = w0[3]; w[j][4] = w1[0]; w[j][5] = w1[1]; w[j][6] = w1[2]; w[j][7] = w1[3]; }
    { const f32x4 b0 = *(const f32x4*)(conv_b + ch0 + cc), b1 = *(const f32x4*)(conv_b + ch0 + cc + 4);
      bb[0] = b0[0]; bb[1] = b0[1]; bb[2] = b0[2]; bb[3] = b0[3]; bb[4] = b1[0]; bb[5] = b1[1]; bb[6] = b1[2]; bb[7] = b1[3]; }
#pragma unroll
    for (int half = 0; half < 2; ++half) {
        const int l = rr + 32 * half, t = c * 64 + l;
        float y[8];
#pragma unroll
        for (int e = 0; e < 8; ++e) y[e] = bb[e];
#pragma unroll
        for (int j = 0; j < 4; ++j) { const bool inb = (t - 3 + j) >= 0; u32x4 rz = raw[half][j];
            rz.x = inb ? rz.x : 0u; rz.y = inb ? rz.y : 0u; rz.z = inb ? rz.z : 0u; rz.w = inb ? rz.w : 0u;
            float x[8]; unpack8(rz, x);
#pragma unroll
            for (int e = 0; e < 8; ++e) y[e] += w[j][e] * x[e]; }
        float sc = rscale;
        if (ROWW) sc *= __shfl(wlane, l);
#pragma unroll
        for (int e = 0; e < 8; ++e) y[e] = y[e] * __builtin_amdgcn_rcpf(1.0f + __expf(-y[e])) * sc;
        *(LAS u32x4*)(tile + l * 288 + cc * 2) = pack8(y);
    }
}
__device__ __forceinline__ void v_issue(const bf16* proj, int b, int c, int h, int tid, u32x4 (&vv)[4]) {
#pragma unroll
    for (int p = 0; p < 4; ++p) { const int row = p * 16 + (tid >> 5), ch = tid & 31;
        vv[p] = *(const u32x4*)(proj + (size_t)(b * SEQ + c * 64 + row) * NPROJ + PC_MV + h * 256 + ch * 8); }
}
__device__ __forceinline__ void v_store(const u32x4 (&vv)[4], LAS unsigned char* tile, int tid) {
#pragma unroll
    for (int p = 0; p < 4; ++p) { const int row = p * 16 + (tid >> 5), ch = tid & 31;
        *(LAS u32x4*)(tile + row * 544 + ch * 16) = vv[p]; }
}

__device__ __forceinline__ void q_prep(const bf16* qrow, const float* rcos, const float* rsin, const float* qnw, int tq, int g, bf16x8 (&qf)[4]) {
    float q[4][8]; float ss = 0.f;
#pragma unroll
    for (int ks = 0; ks < 4; ++ks) { const u32x4 raw = *(const u32x4*)(qrow + 32 * ks + 8 * g); unpack8(raw, q[ks]);
#pragma unroll
        for (int e = 0; e < 8; ++e) ss += q[ks][e] * q[ks][e]; }
    ss = xg_sum(ss);
    const float rq = __builtin_amdgcn_rsqf(ss * (1.0f / 128.0f) + NORM_EPS);
#pragma unroll
    for (int ks = 0; ks < 2; ++ks) {
        const int c0 = 32 * ks + 8 * g;
#pragma unroll
        for (int e4 = 0; e4 < 2; ++e4) {
            const f32x4 cs = *(const f32x4*)(rcos + tq * 64 + c0 + 4 * e4), sn = *(const f32x4*)(rsin + tq * 64 + c0 + 4 * e4);
            const f32x4 w1 = *(const f32x4*)(qnw + c0 + 4 * e4), w2 = *(const f32x4*)(qnw + 64 + c0 + 4 * e4);
#pragma unroll
            for (int e = 0; e < 4; ++e) { const float y1 = q[ks][4 * e4 + e] * rq * w1[e], y2 = q[ks + 2][4 * e4 + e] * rq * w2[e];
                q[ks][4 * e4 + e] = y1 * cs[e] - y2 * sn[e]; q[ks + 2][4 * e4 + e] = y2 * cs[e] + y1 * sn[e]; }
        }
    }
#pragma unroll
    for (int ks = 0; ks < 4; ++ks) { const u32x4 w = pack8(q[ks]); qf[ks] = __builtin_bit_cast(bf16x8, w); }
}
struct AUnit { int b, h, d, r, n; bf16* po0; float* pl0; };
template <bool FINAL>
__device__ __forceinline__ void attn_pair(bf16* proj, const float* rcos, const float* rsin, const float* qnw, float mref, const float* anw, const AUnit& ua, const AUnit& ub,
                                          LAS unsigned char* lds_all, bf16* po1, float* pl1, int tid_in, bool dry) {
    int tid = tid_in; asm volatile("" : "+v"(tid));
    const int lane = tid & 63, wave = __builtin_amdgcn_readfirstlane(tid >> 6);
    const int team = wave >> 2, w4 = wave & 3;
    const int b = team ? ub.b : ua.b, h = team ? ub.h : ua.h, d = team ? ub.d : ua.d, r = team ? ub.r : ua.r, n = team ? ub.n : ua.n;
    bf16* po0 = team ? ub.po0 : ua.po0; float* pl0 = team ? ub.pl0 : ua.pl0;
    LAS unsigned char* lds = lds_all + team * 36864;
    const int j = lane & 15, g = lane >> 4, qp = j >> 2, p = lane & 3;
    const int tt = tid & 255, srow = tt >> 4, sch = tt & 15;
    const bf16* kcol = proj + (size_t)b * SEQ * NPROJ + PC_AK + h * 128 + sch * 8;
    const bf16* vcol = kcol + (PC_AV - PC_AK);
    const int kt0 = (n == 0) ? 4 : 0;
    const int sub0 = 128 * (n - 1) + srow;
    u32x4 rk[2][2], rv[2][2];
#define AT_ISSUE(set, t) do { const int tc_ = ((t) < 8) ? (t) : 7; _Pragma("unroll") for (int hh_ = 0; hh_ < 2; ++hh_) { const size_t tok_ = (size_t)((sub0 + 32 * tc_ + 16 * hh_) * d + r); \
        rk[set][hh_] = *(const u32x4*)(kcol + tok_ * NPROJ); rv[set][hh_] = *(const u32x4*)(vcol + tok_ * NPROJ); } } while (0)
#define AT_WRITE(set, t) do { LAS unsigned char* Kn_ = lds + ((t) & 1) * 18432; _Pragma("unroll") for (int hh_ = 0; hh_ < 2; ++hh_) { \
        *(LAS u32x4*)(Kn_ + (srow + 16 * hh_) * 288 + sch * 16) = rk[set][hh_]; *(LAS u32x4*)(Kn_ + 9216 + (srow + 16 * hh_) * 288 + sch * 16) = rv[set][hh_]; } } while (0)
#define WG_BAR() do { asm volatile("s_waitcnt lgkmcnt(0)" ::: "memory"); __builtin_amdgcn_s_barrier(); asm volatile("" ::: "memory"); } while (0)
    AT_ISSUE(0, kt0); AT_ISSUE(1, kt0 + 1);
    bf16x8 qf[2][4]; int qi[2]; int tq[2];
    const int G0 = w4, G1 = 7 - w4;
    qi[0] = 16 * G0 + j; qi[1] = 16 * G1 + j; tq[0] = (128 * n + qi[0]) * d + r; tq[1] = (128 * n + qi[1]) * d + r;
    const int lo0 = G0 >> 1, lo1 = G1 >> 1;
#pragma unroll
    for (int gi = 0; gi < 2; ++gi) { const bf16* qrow = proj + (size_t)(b * SEQ + tq[gi]) * NPROJ + PC_AQ + h * 128 + 8 * g;
#pragma unroll
        for (int ks = 0; ks < 4; ++ks) qf[gi][ks] = *(const bf16x8*)(qrow + 32 * ks); }
    AT_WRITE(0, kt0);
    for (int kb_ = 0; kb_ < kt0; ++kb_) WG_BAR();
    WG_BAR();
    float l_run[2] = {0.f, 0.f};
    f32x4 o[2][8];
    if (FINAL) {
#pragma unroll
        for (int gi = 0; gi < 2; ++gi) { const size_t trow = (size_t)(b * SEQ + tq[gi]);
            const float l0 = pl0[trow * 8 + h], l1 = pl1[trow * 8 + h];
            const float a0 = __builtin_amdgcn_exp2f(l0 - mref), a1 = __builtin_amdgcn_exp2f(l1 - mref);
            l_run[gi] = (g == 0) ? a0 + a1 : 0.f;
            const bf16* p0 = po0 + trow * 1024 + h * 128 + g * 8; const bf16* p1 = po1 + trow * 1024 + h * 128 + g * 8;
#pragma unroll
            for (int np = 0; np < 4; ++np) { const u32x4 x0 = *(const u32x4*)(p0 + 32 * np), x1 = *(const u32x4*)(p1 + 32 * np); float f0[8], f1[8]; unpack8(x0, f0); unpack8(x1, f1);
#pragma unroll
                for (int e = 0; e < 4; ++e) { o[gi][2 * np][e] = a0 * f0[e] + a1 * f1[e]; o[gi][2 * np + 1][e] = a0 * f0[4 + e] + a1 * f1[4 + e]; } }
        }
    } else {
#pragma unroll
        for (int gi = 0; gi < 2; ++gi)
#pragma unroll
            for (int nf = 0; nf < 8; ++nf) o[gi][nf] = (f32x4){0.f, 0.f, 0.f, 0.f};
    }
    const float SC = 0.08838834764831845f * 1.4426950408889634f;
    const float nmref = -mref;
#define AT_SM(gi, kt, s0, s1) do { \
                float x[8]; float ps = 0.f; \
                _Pragma("unroll") for (int e = 0; e < 8; ++e) { const int kj = 32 * (kt) + 16 * (e >> 2) + 4 * g + (e & 3); const float sv = (e < 4) ? s0[e & 3] : s1[e & 3]; \
                    const bool valid = (kj >= qi[gi]) && (kj <= qi[gi] + 128); \
                    const float pe = __builtin_amdgcn_exp2f(__builtin_fmaf(sv, SC, nmref)); \
                    x[e] = valid ? pe : 0.f; ps += x[e]; } \
                l_run[gi] += ps; \
                const u32x4 pw = pack8(x); pb[gi] = __builtin_bit_cast(bf16x8, pw); } while (0)
#define AT_ONE(gi, kt) do { \
            f32x4 sA = {0.f, 0.f, 0.f, 0.f}, sB = {0.f, 0.f, 0.f, 0.f}; \
            _Pragma("unroll") for (int ks = 0; ks < 4; ++ks) { \
                const bf16x8 k0 = *(const LAS bf16x8*)(Kt + j * 288 + (32 * ks + 8 * g) * 2), k1 = *(const LAS bf16x8*)(Kt + (16 + j) * 288 + (32 * ks + 8 * g) * 2); \
                sA = MFMA16(k0, qf[gi][ks], sA); sB = MFMA16(k1, qf[gi][ks], sB); } \
            bf16x8 pb[2]; AT_SM(gi, kt, sA, sB); \
            _Pragma("unroll") for (int nf = 0; nf < 8; ++nf) { \
                const s16x4 a0 = vtr(Vt + (4 * g + qp) * 288 + (16 * nf + 4 * p) * 2), a1 = vtr(Vt + (16 + 4 * g + qp) * 288 + (16 * nf + 4 * p) * 2); \
                o[gi][nf] = MFMA16(cat4(a0, a1), pb[gi], o[gi][nf]); } } while (0)
#define AT_STEP(kt, setn, setw) do { \
        LAS unsigned char* Kt = lds + ((kt) & 1) * 18432; LAS unsigned char* Vt = Kt + 9216; \
        AT_ISSUE(setn, (kt) + 2); \
        const bool act0 = (kt) >= lo0 && (kt) <= lo0 + 4, act1 = (kt) >= lo1 && (kt) <= lo1 + 4; \
        if (act0 && act1) { \
            f32x4 sA[2], sB[2]; sA[0] = (f32x4){0.f, 0.f, 0.f, 0.f}; sA[1] = sA[0]; sB[0] = sA[0]; sB[1] = sA[0]; \
            _Pragma("unroll") for (int ks = 0; ks < 4; ++ks) { \
                const bf16x8 k0 = *(const LAS bf16x8*)(Kt + j * 288 + (32 * ks + 8 * g) * 2), k1 = *(const LAS bf16x8*)(Kt + (16 + j) * 288 + (32 * ks + 8 * g) * 2); \
                sA[0] = MFMA16(k0, qf[0][ks], sA[0]); sB[0] = MFMA16(k1, qf[0][ks], sB[0]); sA[1] = MFMA16(k0, qf[1][ks], sA[1]); sB[1] = MFMA16(k1, qf[1][ks], sB[1]); } \
            bf16x8 pb[2]; \
            AT_SM(0, kt, sA[0], sB[0]); AT_SM(1, kt, sA[1], sB[1]); \
            _Pragma("unroll") for (int nf = 0; nf < 8; ++nf) { \
                const s16x4 a0 = vtr(Vt + (4 * g + qp) * 288 + (16 * nf + 4 * p) * 2), a1 = vtr(Vt + (16 + 4 * g + qp) * 288 + (16 * nf + 4 * p) * 2); \
                const bf16x8 vf = cat4(a0, a1); \
                o[0][nf] = MFMA16(vf, pb[0], o[0][nf]); o[1][nf] = MFMA16(vf, pb[1], o[1][nf]); } \
        } else if (act0) { AT_ONE(0, kt); } else if (act1) { AT_ONE(1, kt); } \
        if ((kt) + 1 < 8) AT_WRITE(setw, (kt) + 1); \
        WG_BAR(); } while (0)
#pragma unroll 1
    for (int kt = kt0; kt < 8; kt += 2) { AT_STEP(kt, 0, 1); AT_STEP(kt + 1, 1, 0); }
#undef AT_STEP
#undef AT_ONE
#undef AT_SM
#undef AT_ISSUE
#undef AT_WRITE
    f32x4 anwv[8];
    if (FINAL) {
#pragma unroll
        for (int nf = 0; nf < 8; ++nf) anwv[nf] = *(const f32x4*)(anw + h * 128 + 16 * nf + 4 * g);
    }
#pragma unroll
    for (int gi = 0; gi < 2; ++gi) {
        float lr = l_run[gi]; lr = xg_sum(lr);
        const float inv = __builtin_amdgcn_rcpf(lr);
        const float lse2 = mref + __log2f(lr);
        const size_t trow = (size_t)(b * SEQ + tq[gi]);
        if (!FINAL) {
            bf16* pp = po0 + trow * 1024 + h * 128 + g * 8;
#pragma unroll
            for (int np = 0; np < 4; ++np) { const f32x4 va = o[gi][2 * np] * inv, vb = o[gi][2 * np + 1] * inv; u32x4 ww; ww.x = cvtpk(va[0], va[1]); ww.y = cvtpk(va[2], va[3]); ww.z = cvtpk(vb[0], vb[1]); ww.w = cvtpk(vb[2], vb[3]);
                if (!dry) *(u32x4*)(pp + 32 * np) = ww; }
            if (g == 0 && !dry) pl0[trow * 8 + h] = lse2;
        } else {
            bf16* qrow = proj + trow * NPROJ + PC_AQ + h * 128;
            float ss = 0.f;
#pragma unroll
            for (int nf = 0; nf < 8; ++nf) { const f32x4 v = o[gi][nf] * inv; o[gi][nf] = v; ss += (v[0] * v[0] + v[1] * v[1]) + (v[2] * v[2] + v[3] * v[3]); }
            ss = xg_sum(ss);
            const float rn = __builtin_amdgcn_rsqf(ss * (1.0f / 128.0f) + NORM_EPS);
#pragma unroll
            for (int nf = 0; nf < 8; ++nf) { const int e = 16 * nf + 4 * g; const f32x4 w = anwv[nf]; const f32x4 v = o[gi][nf] * rn * w;
                u32x2 ww; ww.x = cvtpk(v[0], v[1]); ww.y = cvtpk(v[2], v[3]); if (!dry) *(u32x2*)(qrow + e) = ww; }
        }
    }
}

#ifndef PROBE_PHASE
#define PROBE_PHASE -1
#endif
#define REP_BEGIN(k) for (int rep_ = (PROBE_PHASE == (k)) ? 0 : 1; rep_ < 2; ++rep_) { const bool dry = (rep_ == 0) && (a.dry != 0); (void)dry; \
    int tid = threadIdx.x; asm volatile("" : "+v"(tid)); const int lane = tid & 63, wave = __builtin_amdgcn_readfirstlane(tid >> 6); \
    const int gw = vcu * NWAVES + wave, gt = vcu * (NWAVES * 64) + tid; (void)lane; (void)wave; (void)gw; (void)gt;
#define REP_END }

__global__ void __launch_bounds__(NWAVES * 64, 2) hymba_fwd(Args a) {
    extern __shared__ __attribute__((aligned(16))) unsigned char lds_raw[];
    LAS unsigned char* lds = (LAS unsigned char*)lds_raw;
    volatile LAS unsigned* MISC = (volatile LAS unsigned*)(lds + MISC_OFF);
    const int tid = threadIdx.x, lane = tid & 63, wave = __builtin_amdgcn_readfirstlane(tid >> 6);
    const int G = gridDim.x; const int bx = blockIdx.x; const int vcu = (G % 8 == 0) ? (bx % 8) * (G / 8) + bx / 8 : bx;
    unsigned char* ws = a.ws;
    unsigned* ctl = (unsigned*)(ws + WS_CTL);
    float* gli = (float*)(ws + WS_GLI); float* glf = (float*)(ws + WS_GLF); float* sumsq = (float*)(ws + WS_SUMSQ);
    float* msc_g = (float*)(ws + WS_MSC); float* msc_ml = msc_g + 512; float* msc_mp = msc_g + 1024;
    float* ncb = (float*)(ws + WS_NC);
    float* rcos = (float*)(ws + WS_COS); float* rsin = (float*)(ws + WS_SIN);
    bf16* WinT = (bf16*)(ws + WS_WIN); bf16* kvT = (bf16*)(ws + WS_KV); bf16* Ub = (bf16*)(ws + WS_U); bf16* H1b = (bf16*)(ws + WS_U);
    bf16* proj = (bf16*)(ws + WS_PROJ); bf16* FF = (bf16*)(ws + WS_PROJ);
    bf16* op0 = (bf16*)(ws + WS_OP0); bf16* op1 = (bf16*)(ws + WS_OP1); float* pl0 = (float*)(ws + WS_PL0); float* pl1 = (float*)(ws + WS_PL1);
    bf16* WoutT = (bf16*)(ws + WS_WOUT); bf16* WguT = (bf16*)(ws + WS_WGU); bf16* WdnT = (bf16*)(ws + WS_WDN);

    for (int u = tid; u < (LDS_BYTES - MISC_OFF) / 4; u += NWAVES * 64) ((LAS unsigned*)(lds + MISC_OFF))[u] = 0u;
    __syncthreads();
    XcdBarrier bar = xcd_barrier_post(ctl + CW_BAR, MISC + 8);
    const int NGW = G * NWAVES, NGT = G * NWAVES * 64;

    REP_BEGIN(0)
        for (int i = gt; i < MTOK; i += NGT) sumsq[i] = 0.f;
        for (int i = gt; i < SEQ * 64; i += NGT) {
            const int pos = i >> 6, fi = i & 63;
            const float invf = (float)exp2(-(double)fi * (13.287712379549449 / 64.0));
            const float ang = (float)pos * invf;
            const double rev = (double)ang * 0.15915494309189535; const double fr_ = rev - rint(rev);
            const float ar = (float)(fr_ * 6.283185307179586);
            rcos[i] = cosf(ar); rsin[i] = sinf(ar);
        }
        {
            LAS float* scr = (LAS float*)(lds + wave * 16384);
            constexpr int I_IN = (DM / 64) * (NPROJ / 32), I_OUT = (DM / 64) * (DM / 32), I_GU = (DM / 64) * (NGU / 32), I_DN = (DFF / 64) * (DM / 32);
            constexpr int NITEMS = I_IN + I_OUT + I_GU;
            auto decode = [&](int it) -> TItem {
                TItem t; int r = it;
                if (r < I_IN) { const int nblk = NPROJ / 32, kb = r / nblk, nb = r % nblk; t = TItem{a.w_in, WinT, nullptr, INW, DM, win_src_col(nb * 32), nb * 32, kb * 64}; return t; } r -= I_IN;
                if (r < I_OUT) { const int nblk = DM / 32, kb = r / nblk, nb = r % nblk; t = TItem{a.w_out, WoutT, nullptr, DM, DM, nb * 32, nb * 32, kb * 64}; return t; } r -= I_OUT;
                { const int nblk = NGU / 32, kb = r / nblk, nb = r % nblk; const int nd = nb * 32, pn = nd >> 8, j = nd & 255;
                    t = TItem{(j < 128) ? a.w_gate : a.w_up, WguT, a.norm2_w, DFF, DM, pn * 128 + (j & 127), nd, kb * 64}; return t; }
            };
            int it = gw;
            if (it < NITEMS) {
                TItem cur = decode(it); f32x4 vc[8]; titem_load(cur, vc, lane);
                for (;;) {
                    const int nx = it + NGW; const bool more = nx < NITEMS;
                    TItem nt = cur; f32x4 vn[8];
                    if (more) { nt = decode(nx); titem_load(nt, vn, lane); }
                    titem_finish(cur, vc, scr, lane);
                    if (!more) break;
                    cur = nt; it = nx;
#pragma unroll
                    for (int i = 0; i < 8; ++i) vc[i] = vn[i];
                }
            }
        }
        __syncthreads();
        LAS float* wg = (LAS float*)lds;
        for (int k = tid; k < DM; k += NWAVES * 64) { const f32x4 g0 = *(const f32x4*)(a.w_in + (size_t)k * INW + 3072), g1 = *(const f32x4*)(a.w_in + (size_t)k * INW + 3076);
            wg[0 * DM + k] = g0[0]; wg[1 * DM + k] = g0[1]; wg[2 * DM + k] = g0[2]; wg[3 * DM + k] = g0[3];
            wg[4 * DM + k] = g1[0]; wg[5 * DM + k] = g1[1]; wg[6 * DM + k] = g1[2]; wg[7 * DM + k] = g1[3]; }
        __syncthreads();
        f32x4 w1v[8];
#pragma unroll
        for (int j = 0; j < 8; ++j) w1v[j] = ((const f32x4*)a.norm1_w)[lane + 64 * j];
        for (int m = gw; m < MTOK; m += NGW) {
            const f32x4* xr = (const f32x4*)(a.x + (size_t)m * DM) + lane;
            f32x4 v[8]; float s = 0.f;
#pragma unroll
            for (int j = 0; j < 8; ++j) { v[j] = __builtin_nontemporal_load(xr + 64 * j); s += (v[j][0] * v[j][0] + v[j][1] * v[j][1]) + (v[j][2] * v[j][2] + v[j][3] * v[j][3]); }
            const float rstd = __builtin_amdgcn_rsqf(wave_sum(s) * (1.0f / DM) + NORM_EPS);
            u32x2* o8 = (u32x2*)(Ub + (size_t)m * DM) + lane;
#pragma unroll
            for (int j = 0; j < 8; ++j) { v[j] = v[j] * rstd * w1v[j]; u32x2 w; w.x = cvtpk(v[j][0], v[j][1]); w.y = cvtpk(v[j][2], v[j][3]); o8[64 * j] = w; }
            float z = 0.f;
#pragma unroll 1
            for (int gi = 0; gi < 8; ++gi) { float t = 0.f;
#pragma unroll
                for (int j = 0; j < 8; ++j) { const f32x4 w4 = *(const LAS f32x4*)(wg + gi * DM + 256 * j + 4 * lane); t += (v[j][0] * w4[0] + v[j][1] * w4[1]) + (v[j][2] * w4[2] + v[j][3] * w4[3]); }
                t = wave_sum(t); z = (lane == gi) ? t : z; }
            if (lane < 8) {
                const int hh = lane & 3;
                if (lane < 4) { gli[m * 4 + hh] = 15.0f * tanhf((z + a.igate_b[hh]) * (1.0f / 15.0f)); }
                else { const float fp = 15.0f * tanhf((z + a.fgate_b[hh]) * (1.0f / 15.0f)); glf[m * 4 + hh] = -log1pf(expf(-fp)); }
            }
        }
    REP_END
    xcd_barrier(bar);

    REP_BEGIN(1)
        pg8::Gemm g{Ub, WinT, MTOK, NPROJ, DM, DM}; pg8::StaticOrder S; S.init(MTOK, NPROJ, G, bx);
        pg8::EpiBf16 E{proj, NPROJ};
        pg8::gemm_phase<pg8::EpiBf16, true>(lds, g, S, E);
    REP_END
    xcd_barrier(bar);

    REP_BEGIN(2)
        {
            const int c0 = 4 * (tid & 15), rstride = NGT >> 4;
            for (int which = 0; which < 2; ++which) {
                const float* nw = which ? a.k_norm_w : a.q_norm_w; const int colb = which ? PC_AK : PC_AQ;
                const f32x4 w1 = *(const f32x4*)(nw + c0), w2 = *(const f32x4*)(nw + 64 + c0);
                for (int idx0 = gt >> 4; idx0 < MTOK * 8; idx0 += 4 * rstride) {
                    u32x2 r1[4], r2[4]; f32x4 cs[4], sn[4];
#pragma unroll
                    for (int q = 0; q < 4; ++q) { const int idx = idx0 + q * rstride;
                        if (idx < MTOK * 8) { const int m = idx >> 3, hh = idx & 7, pos = m & (SEQ - 1); const bf16* kp = proj + (size_t)m * NPROJ + colb + hh * 128;
                            r1[q] = *(const u32x2*)(kp + c0); r2[q] = *(const u32x2*)(kp + 64 + c0); cs[q] = *(const f32x4*)(rcos + pos * 64 + c0); sn[q] = *(const f32x4*)(rsin + pos * 64 + c0); } }
#pragma unroll
                    for (int q = 0; q < 4; ++q) { const int idx = idx0 + q * rstride;
                        if (idx < MTOK * 8) { const int m = idx >> 3, hh = idx & 7; bf16* kp = proj + (size_t)m * NPROJ + colb + hh * 128;
                            float x1[4] = {bf_lo(r1[q].x), bf_hi(r1[q].x), bf_lo(r1[q].y), bf_hi(r1[q].y)}, x2[4] = {bf_lo(r2[q].x), bf_hi(r2[q].x), bf_lo(r2[q].y), bf_hi(r2[q].y)};
                            float ss = 0.f;
#pragma unroll
                            for (int e = 0; e < 4; ++e) ss += x1[e] * x1[e] + x2[e] * x2[e];
                            ss = row16_sum(ss);
                            const float rk = __builtin_amdgcn_rsqf(ss * (1.0f / 128.0f) + NORM_EPS);
                            float o1[4], o2[4];
#pragma unroll
                            for (int e = 0; e < 4; ++e) { const float y1 = x1[e] * rk * w1[e], y2 = x2[e] * rk * w2[e]; o1[e] = y1 * cs[q][e] - y2 * sn[q][e]; o2[e] = y2 * cs[q][e] + y1 * sn[q][e]; }
                            u32x2 wv; wv.x = cvtpk(o1[0], o1[1]); wv.y = cvtpk(o1[2], o1[3]); if (!dry) *(u32x2*)(kp + c0) = wv;
                            wv.x = cvtpk(o2[0], o2[1]); wv.y = cvtpk(o2[2], o2[3]); if (!dry) *(u32x2*)(kp + 64 + c0) = wv; } }
                }
            }
        }
        LAS unsigned char* KW = lds; LAS unsigned char* VT = lds + 36864;
        const int g = lane >> 4, qp = (lane & 15) >> 2, p = lane & 3;
        for (int u = vcu; u < 256; u += G) {
            const int b = u >> 7, h = (u >> 5) & 3, c0 = 2 * (u & 31);
            const int tok = b * SEQ + c0 * 64 + lane;
            const float liA = gli[tok * 4 + h], lfA = glf[tok * 4 + h], liB = gli[(tok + 64) * 4 + h], lfB = glf[(tok + 64) * 4 + h];
            u32x4 rawA[2][4], rawB[2][4], vA[4], vB[4];
            conv_issue(proj, b, c0, PC_MK + h * 128, tid, rawA); v_issue(proj, b, c0, h, tid, vA);
            conv_issue(proj, b, c0 + 1, PC_MK + h * 128, tid, rawB); v_issue(proj, b, c0 + 1, h, tid, vB);
            const float cfA = scan_add64(lfA, lane), cfB = scan_add64(lfB, lane);
            const float gA = __shfl(cfA, 63), gB = __shfl(cfB, 63);
            const float avA = gA - cfA + liA + gB, avB = gB - cfB + liB;
            const float ml = wave_max(fmaxf(avA, avB));
            const float wA = __expf(avA - ml), wB = __expf(avB - ml);
            if (tid == 0) { msc_g[u] = gA + gB; msc_ml[u] = ml; }
            conv_finish<true>(rawA, a.conv_w, a.conv_b, c0, 512 + h * 128, 1.0f, wA, KW, tid); v_store(vA, VT, tid);
            conv_finish<true>(rawB, a.conv_w, a.conv_b, c0 + 1, 512 + h * 128, 1.0f, wB, KW + 64 * 288, tid); v_store(vB, VT + 64 * 544, tid);
            __syncthreads();
            f32x4 acc[8][2];
#pragma unroll
            for (int df = 0; df < 8; ++df) { acc[df][0] = (f32x4){0.f, 0.f, 0.f, 0.f}; acc[df][1] = (f32x4){0.f, 0.f, 0.f, 0.f}; }
#pragma unroll
            for (int kk = 0; kk < 4; ++kk) {
                bf16x8 bfr[2];
#pragma unroll
                for (int ef = 0; ef < 2; ++ef) { const int col = 32 * wave + 16 * ef + 4 * p;
                    bfr[ef] = cat4(vtr(VT + (32 * kk + 4 * g + qp) * 544 + col * 2), vtr(VT + (32 * kk + 16 + 4 * g + qp) * 544 + col * 2)); }
#pragma unroll
                for (int df = 0; df < 8; ++df) { const int col = 16 * df + 4 * p;
                    const bf16x8 af = cat4(vtr(KW + (32 * kk + 4 * g + qp) * 288 + col * 2), vtr(KW + (32 * kk + 16 + 4 * g + qp) * 288 + col * 2));
                    acc[df][0] = MFMA16(af, bfr[0], acc[df][0]); acc[df][1] = MFMA16(af, bfr[1], acc[df][1]); }
            }
#pragma unroll
            for (int ef = 0; ef < 2; ++ef) { const int e = 32 * wave + 16 * ef + (lane & 15);
#pragma unroll
                for (int df = 0; df < 8; ++df) { const f32x4 v = acc[df][ef]; u32x2 w; w.x = cvtpk(v[0], v[1]); w.y = cvtpk(v[2], v[3]);
                    *(u32x2*)(kvT + ((size_t)u * 256 + e) * 128 + 16 * df + 4 * g) = w; } }
            if (tid < 128) { float nsum = 0.f;
#pragma unroll 8
                for (int l = 0; l < 128; ++l) nsum += __uint_as_float((unsigned)(*(const LAS unsigned short*)(KW + l * 288 + tid * 2)) << 16);
                ncb[u * 128 + tid] = nsum; }
            __syncthreads();
        }
    REP_END
    xcd_barrier(bar);

    REP_BEGIN(3)
        LAS float* sg = (LAS float*)lds; LAS float* sml = sg + 256;
        for (int i = tid; i < 256; i += NWAVES * 64) { sg[i] = msc_g[i]; sml[i] = msc_ml[i]; }
        __syncthreads();
        for (int id = gt; id < 8 * 16384; id += NGT) {
            const int bh = id >> 14, pi = id & 16383;
            unsigned* base = (unsigned*)kvT + (size_t)bh * 32 * 16384 + pi;
            float c0 = 0.f, c1 = 0.f, m = 0.f;
            unsigned xv[32];
#pragma unroll
            for (int i = 0; i < 32; ++i) xv[i] = base[(size_t)i * 16384];
#pragma unroll
            for (int i = 0; i < 32; ++i) {
                const float gg = sg[bh * 32 + i], ml = sml[bh * 32 + i];
                const float mn = fmaxf(gg + m, ml), so = __expf(gg + m - mn), sn = __expf(ml - mn);
                if (!dry) base[(size_t)i * 16384] = cvtpk(c0, c1);
                c0 = so * c0 + sn * bf_lo(xv[i]); c1 = so * c1 + sn * bf_hi(xv[i]); m = mn;
            }
        }
        for (int id = gt; id < 8 * 128; id += NGT) {
            const int bh = id >> 7, dd = id & 127; float n = 0.f, m = 0.f;
            float* nb_ = ncb + (size_t)bh * 32 * 128 + dd;
            float xv[32];
#pragma unroll
            for (int i = 0; i < 32; ++i) xv[i] = nb_[i * 128];
#pragma unroll
            for (int i = 0; i < 32; ++i) {
                const float gg = sg[bh * 32 + i], ml = sml[bh * 32 + i];
                const float mn = fmaxf(gg + m, ml), so = __expf(gg + m - mn), sn = __expf(ml - mn);
                if (!dry) nb_[i * 128] = n;
                if (dd == 0) msc_mp[bh * 32 + i] = m;
                n = so * n + sn * xv[i]; m = mn;
            }
        }
        __syncthreads();
    REP_END
    REP_BEGIN(4)
        float mref;
        { const float bq = wave_max(fmaxf(fabsf(a.q_norm_w[lane]), fabsf(a.q_norm_w[64 + lane]))), bk = wave_max(fmaxf(fabsf(a.k_norm_w[lane]), fabsf(a.k_norm_w[64 + lane])));
          mref = fminf(128.0f * 1.02f * 0.08838834764831845f * 1.4426950408889634f * bq * bk, 60.0f); }
        for (int pidx = vcu; pidx < 512; pidx += G) {
            AUnit ua, ub;
            { const int u = pidx; ua = AUnit{u >> 8, (u >> 5) & 7, 4, (u >> 3) & 3, u & 7, op0, pl0}; }
            { const int v = pidx; const int bb = v >> 8; ub = AUnit{bb, (v >> 5) & 7, 16, (v >> 1) & 15, (v ^ bb) & 1, op1, pl1}; }
            attn_pair<false>(proj, rcos, rsin, a.q_norm_w, mref, a.attn_norm_w, ua, ub, lds, nullptr, nullptr, tid, dry);
        }
    REP_END
    xcd_barrier(bar);

    REP_BEGIN(5)
        float mref;
        { const float bq = wave_max(fmaxf(fabsf(a.q_norm_w[lane]), fabsf(a.q_norm_w[64 + lane]))), bk = wave_max(fmaxf(fabsf(a.k_norm_w[lane]), fabsf(a.k_norm_w[64 + lane])));
          mref = fminf(128.0f * 1.02f * 0.08838834764831845f * 1.4426950408889634f * bq * bk, 60.0f); }
        LAS unsigned char* QT = lds; LAS unsigned char* KT = lds + 18432; LAS unsigned char* VT = lds + 36864;
        LAS float* NP = (LAS float*)(lds + 71680); LAS float* XCH = (LAS float*)(lds + 72192); LAS unsigned char* CP = lds + 72704;
        LAS float* WL = (LAS float*)(lds + 146432);
        const int j = lane & 15, g = lane >> 4, qp = j >> 2, p = lane & 3;
        const int tf = wave & 3, eh = wave >> 2;
        for (int u = vcu; u < 256; u += G) {
            const int b = u >> 7, h = (u >> 5) & 3;
            float mprev = msc_mp[u];
            const bf16* csrc = kvT + (size_t)u * 256 * 128 + (size_t)(tid >> 4) * 128 + (tid & 15) * 8;
#pragma unroll
            for (int hh = 0; hh < 2; ++hh) {
                const int c = 2 * (u & 31) + hh;
                const int tok = b * SEQ + c * 64 + lane;
                const float li = gli[tok * 4 + h], lf = glf[tok * 4 + h];
                u32x4 rawq[2][4], rawk[2][4], vv[4], cv[8];
                conv_issue(proj, b, c, PC_MQ + h * 128, tid, rawq);
                conv_issue(proj, b, c, PC_MK + h * 128, tid, rawk);
                v_issue(proj, b, c, h, tid, vv);
                float npv = 0.f;
                if (hh == 0) { if (tid < 128) npv = ncb[u * 128 + tid]; }
                const float cf = scan_add64(lf, lane);
                const float bvec = li - cf;
                const float pm = scan_max64(bvec, lane);
                const float Mv = fmaxf(mprev, pm);
                const float wiv = __expf(mprev - Mv), emtv = __expf(-cf - Mv);
                float so_u = 0.f, m_u = 0.f;
                if (hh == 0) {
                    const float gsum = __shfl(cf, 63);
                    const float av = gsum + bvec;
                    const float mlA = wave_max(av);
                    m_u = fmaxf(gsum + mprev, mlA);
                    so_u = __expf(gsum + mprev - m_u);
                    if (wave == 0) WL[lane] = __expf(av - mlA) * __expf(mlA - m_u);
                }
                conv_finish<false>(rawq, a.conv_w, a.conv_b, c, h * 128, 0.08838834764831845f, 0.f, QT, tid);
                if (hh == 0) {
#pragma unroll
                    for (int it = 0; it < 8; ++it) cv[it] = *(const u32x4*)(csrc + (size_t)it * 32 * 128);
                }
                conv_finish<false>(rawk, a.conv_w, a.conv_b, c, 512 + h * 128, 1.0f, 0.f, KT, tid);
                v_store(vv, VT, tid);
                if (hh == 0) {
#pragma unroll
                    for (int it = 0; it < 8; ++it) *(LAS u32x4*)(CP + (it * 32 + (tid >> 4)) * 288 + (tid & 15) * 16) = cv[it];
                    if (tid < 128) NP[tid] = npv;
                }
                const int t_ = 16 * (wave & 3) + j;
                const bf16* orow_ = proj + (size_t)(b * SEQ + c * 64 + t_) * NPROJ;
                u32x2 mo_pre[8];
#pragma unroll
                for (int ef = 0; ef < 8; ++ef) mo_pre[ef] = *(const u32x2*)(orow_ + PC_MO + h * 256 + 128 * eh + 16 * ef + 4 * g);
                __syncthreads();
                const int t = 16 * tf + j;
                const float M_t = __shfl(Mv, t), wi_t = __shfl(wiv, t), emt_t = __shfl(emtv, t);
                bf16x8 qf[4];
#pragma unroll
                for (int ks = 0; ks < 4; ++ks) qf[ks] = *(const LAS bf16x8*)(QT + t * 288 + (32 * ks + 8 * g) * 2);
                float sp[4][4]; float rowsum = 0.f;
#pragma unroll
                for (int sf = 0; sf < 4; ++sf) {
                    f32x4 sa = {0.f, 0.f, 0.f, 0.f};
#pragma unroll
                    for (int ks = 0; ks < 4; ++ks) { const bf16x8 kfr = *(const LAS bf16x8*)(KT + (16 * sf + j) * 288 + (32 * ks + 8 * g) * 2); sa = MFMA16(kfr, qf[ks], sa); }
#pragma unroll
                    for (int rg = 0; rg < 4; ++rg) { const int sidx = 16 * sf + 4 * g + rg; const float bs = __shfl(bvec, sidx);
                        const float pv = (sidx <= t) ? __expf(bs - M_t) : 0.f; sp[sf][rg] = sa[rg] * pv; rowsum += sp[sf][rg]; }
                }
                bf16x8 pb[2];
#pragma unroll
                for (int kk = 0; kk < 2; ++kk) { float tmp[8] = {sp[2 * kk][0], sp[2 * kk][1], sp[2 * kk][2], sp[2 * kk][3], sp[2 * kk + 1][0], sp[2 * kk + 1][1], sp[2 * kk + 1][2], sp[2 * kk + 1][3]};
                    const u32x4 w = pack8(tmp); pb[kk] = __builtin_bit_cast(bf16x8, w); }
                f32x4 ai[8], ae[8];
#pragma unroll
                for (int ef = 0; ef < 8; ++ef) { ai[ef] = (f32x4){0.f, 0.f, 0.f, 0.f}; ae[ef] = (f32x4){0.f, 0.f, 0.f, 0.f}; }
#pragma unroll
                for (int kk = 0; kk < 2; ++kk) {
#pragma unroll
                    for (int ef = 0; ef < 8; ++ef) { const int col = 128 * eh + 16 * ef + 4 * p;
                        const bf16x8 af = cat4(vtr(VT + (32 * kk + 4 * g + qp) * 544 + col * 2), vtr(VT + (32 * kk + 16 + 4 * g + qp) * 544 + col * 2));
                        ai[ef] = MFMA16(af, pb[kk], ai[ef]); }
                }
#pragma unroll
                for (int ef = 0; ef < 8; ++ef) {
#pragma unroll
                    for (int ks = 0; ks < 4; ++ks) { const bf16x8 cfr = *(const LAS bf16x8*)(CP + (128 * eh + 16 * ef + j) * 288 + (32 * ks + 8 * g) * 2); ae[ef] = MFMA16(cfr, qf[ks], ae[ef]); }
                }
                float qn = 0.f;
#pragma unroll
                for (int ks = 0; ks < 4; ++ks) { float qv[8]; unpack8(__builtin_bit_cast(u32x4, qf[ks]), qv);
#pragma unroll
                    for (int e = 0; e < 8; ++e) qn += qv[e] * NP[32 * ks + 8 * g + e]; }
                qn = xg_sum(qn);
                rowsum = xg_sum(rowsum);
                const float den = wi_t * qn + rowsum;
                const float dinv = __builtin_amdgcn_rcpf(fmaxf(fabsf(den), emt_t));
                float ssq = 0.f;
#pragma unroll
                for (int ef = 0; ef < 8; ++ef) { ai[ef] = (ae[ef] * wi_t + ai[ef]) * dinv; ssq += (ai[ef][0] * ai[ef][0] + ai[ef][1] * ai[ef][1]) + (ai[ef][2] * ai[ef][2] + ai[ef][3] * ai[ef][3]); }
                f32x4 nwv[8];
#pragma unroll
                for (int ef = 0; ef < 8; ++ef) nwv[ef] = *(const f32x4*)(a.mlstm_norm_w + h * 256 + 128 * eh + 16 * ef + 4 * g);
                ssq = xg_sum(ssq);
                if (g == 0) XCH[eh * 64 + t] = ssq;
                __syncthreads();
                const float rn = __builtin_amdgcn_rsqf((XCH[t] + XCH[64 + t]) * (1.0f / 256.0f) + NORM_EPS);
                bf16* orow = proj + (size_t)(b * SEQ + c * 64 + t) * NPROJ;
#pragma unroll
                for (int ef = 0; ef < 8; ++ef) { const int e = 128 * eh + 16 * ef + 4 * g;
                    const f32x4 nw = nwv[ef];
                    const u32x2 mo = mo_pre[ef];
                    const float mof[4] = {bf_lo(mo.x), bf_hi(mo.x), bf_lo(mo.y), bf_hi(mo.y)};
                    float r4[4];
#pragma unroll
                    for (int e2 = 0; e2 < 4; ++e2) r4[e2] = ai[ef][e2] * rn * nw[e2] * __builtin_amdgcn_rcpf(1.0f + __expf(-mof[e2]));
                    u32x2 w; w.x = cvtpk(r4[0], r4[1]); w.y = cvtpk(r4[2], r4[3]); if (!dry) *(u32x2*)(orow + PC_MV + h * 256 + e) = w; }
                if (hh == 0) {
                    f32x4 acc[8][2]; f32x4 accn = {0.f, 0.f, 0.f, 0.f};
#pragma unroll
                    for (int df = 0; df < 8; ++df) { acc[df][0] = (f32x4){0.f, 0.f, 0.f, 0.f}; acc[df][1] = (f32x4){0.f, 0.f, 0.f, 0.f}; }
#pragma unroll
                    for (int kk = 0; kk < 2; ++kk) {
                        const f32x4 wlo = *(const LAS f32x4*)(WL + 32 * kk + 4 * g), whi = *(const LAS f32x4*)(WL + 32 * kk + 16 + 4 * g);
                        const float wrow[8] = {wlo[0], wlo[1], wlo[2], wlo[3], whi[0], whi[1], whi[2], whi[3]};
                        bf16x8 bfr[2];
#pragma unroll
                        for (int ef = 0; ef < 2; ++ef) { const int col = 32 * wave + 16 * ef + 4 * p;
                            const bf16x8 raw = cat4(vtr(VT + (32 * kk + 4 * g + qp) * 544 + col * 2), vtr(VT + (32 * kk + 16 + 4 * g + qp) * 544 + col * 2));
                            float fv[8]; unpack8(__builtin_bit_cast(u32x4, raw), fv);
#pragma unroll
                            for (int e = 0; e < 8; ++e) fv[e] *= wrow[e];
                            const u32x4 pw = pack8(fv); bfr[ef] = __builtin_bit_cast(bf16x8, pw); }
                        float wc0[8];
#pragma unroll
                        for (int e = 0; e < 8; ++e) wc0[e] = (j == 0) ? wrow[e] : 0.f;
                        const u32x4 pwn = pack8(wc0); const bf16x8 bwn = __builtin_bit_cast(bf16x8, pwn);
#pragma unroll
                        for (int df = 0; df < 8; ++df) { const int col = 16 * df + 4 * p;
                            const bf16x8 af = cat4(vtr(KT + (32 * kk + 4 * g + qp) * 288 + col * 2), vtr(KT + (32 * kk + 16 + 4 * g + qp) * 288 + col * 2));
                            acc[df][0] = MFMA16(af, bfr[0], acc[df][0]); acc[df][1] = MFMA16(af, bfr[1], acc[df][1]);
                            if (df == wave) accn = MFMA16(af, bwn, accn); }
                    }
#pragma unroll
                    for (int ef = 0; ef < 2; ++ef) { const int e = 32 * wave + 16 * ef + j;
#pragma unroll
                        for (int df = 0; df < 8; ++df) { LAS u32x2* cp_ = (LAS u32x2*)(CP + e * 288 + (16 * df + 4 * g) * 2); const u32x2 old = *cp_; const f32x4 v = acc[df][ef];
                            u32x2 w; w.x = cvtpk(so_u * bf_lo(old.x) + v[0], so_u * bf_hi(old.x) + v[1]); w.y = cvtpk(so_u * bf_lo(old.y) + v[2], so_u * bf_hi(old.y) + v[3]); *cp_ = w; } }
                    if (j == 0) {
#pragma unroll
                        for (int rg = 0; rg < 4; ++rg) { const int d_ = 16 * wave + 4 * g + rg; NP[d_] = so_u * NP[d_] + accn[rg]; } }
                    mprev = m_u;
                }
                __syncthreads();
            }
        }
        for (int pidx = vcu; pidx < 256; pidx += G) {
            const AUnit ua{0, (pidx >> 5) & 7, 1, 0, pidx & 31, op0, pl0}, ub{1, (pidx >> 5) & 7, 1, 0, pidx & 31, op0, pl0};
            attn_pair<true>(proj, rcos, rsin, a.q_norm_w, mref, a.attn_norm_w, ua, ub, lds, op1, pl1, tid, dry);
        }
    REP_END
    xcd_barrier(bar);

    REP_BEGIN(6)
        pg8::Gemm g{proj + PC_MV, WoutT, MTOK, DM, DM, NPROJ}; pg8::StaticOrder S; S.init(MTOK, DM, G, bx);
        pg8::EpiRes1 E{a.x, a.out, H1b, sumsq, DM, dry};
        pg8::gemm_phase<pg8::EpiRes1, false>(lds, g, S, E);
    REP_END
    xcd_barrier(bar);

    REP_BEGIN(7)
        pg8::Gemm g{H1b, WguT, MTOK, NGU, DM, DM}; pg8::StaticOrder S; S.init(MTOK, NGU, G, bx);
        LAS float* rsl = (LAS float*)(lds + RING_BYTES);
        {
            float sv[8]; unsigned okm = 0u;
#pragma unroll
            for (int i = 0; i < 8; ++i) { pg8::Unit uu; const bool ok = S.next(i, uu); okm |= (ok ? 1u : 0u) << i; sv[i] = sumsq[(ok ? uu.pm : 0) * 256 + (tid & 255)]; }
#pragma unroll
            for (int i = 0; i < 8; ++i) if (tid < 256 && ((okm >> i) & 1u)) rsl[i * 256 + tid] = __builtin_amdgcn_rsqf(sv[i] * (1.0f / DM) + NORM_EPS);
        }
        __syncthreads();
        pg8::EpiSwiGLU E{FF, DFF, rsl, sumsq};
        pg8::gemm_phase<pg8::EpiSwiGLU, true>(lds, g, S, E);
        if (rep_ == 1) {
            const int nfull = (MTOK / 256) * (NGU / 256) - 5 * G;
            const int nidle = G - nfull;
            if (G == 256 ? (bx >= nfull) : true) {
                LAS float* scr = (LAS float*)(lds + wave * 16384);
                constexpr int I_DN = (DFF / 64) * (DM / 32);
                const int w0 = (G == 256) ? (bx - nfull) * NWAVES + wave : gw, nw = (G == 256) ? nidle * NWAVES : NGW;
                for (int it = w0; it < I_DN; it += nw) { const int nblk = DM / 32, kb = it / nblk, nb = it % nblk;
                    const TItem t{a.w_down, WdnT, nullptr, DM, DFF, nb * 32, nb * 32, kb * 64}; f32x4 v[8]; titem_load(t, v, lane); titem_finish(t, v, scr, lane); }
            }
        }
    REP_END
    xcd_barrier(bar);

    REP_BEGIN(8)
        pg8::Gemm g{FF, WdnT, MTOK, DM, DFF, DFF}; pg8::StaticOrder S; S.init(MTOK, DM, G, bx);
        pg8::EpiRes2 E{H1b, a.out, DM, dry};
        pg8::gemm_phase<pg8::EpiRes2, false>(lds, g, S, E);
    REP_END
}

extern "C" void kernel_launch(void* const* d_in, const int* in_sizes, int n_in, void* d_out, int out_size, void* d_ws, size_t ws_size, hipStream_t stream) {
    static int grid = 0;
    if (grid == 0) {
        if (n_in != 16 || in_sizes[0] != MTOK * DM || out_size != MTOK * DM || ws_size < WS_END) { fprintf(stderr, "kernel_launch: unexpected shapes (n_in %d in0 %d out %d ws %zu)\n", n_in, n_in > 0 ? in_sizes[0] : -1, out_size, ws_size); grid = -1; return; }
        int dev = 0, cus = 0;
        if (hipGetDevice(&dev) != hipSuccess || hipDeviceGetAttribute(&cus, hipDeviceAttributeMultiprocessorCount, dev) != hipSuccess || cus <= 0) cus = 256;
        if (hipFuncSetAttribute((const void*)hymba_fwd, hipFuncAttributeMaxDynamicSharedMemorySize, LDS_BYTES) != hipSuccess) { fprintf(stderr, "kernel_launch: hipFuncSetAttribute failed\n"); grid = -1; return; }
        (void)hipGetLastError();
        grid = cus;
    }
    if (grid < 0) return;
    if (hipMemsetAsync((char*)d_ws + WS_CTL, 0, CTL_ZERO_BYTES, stream) != hipSuccess) { fprintf(stderr, "kernel_launch: memset failed\n"); return; }
    Args a{};
    a.x = (const float*)d_in[0]; a.norm1_w = (const float*)d_in[1]; a.w_in = (const float*)d_in[2]; a.conv_w = (const float*)d_in[3]; a.conv_b = (const float*)d_in[4];
    a.igate_b = (const float*)d_in[5]; a.fgate_b = (const float*)d_in[6]; a.q_norm_w = (const float*)d_in[7]; a.k_norm_w = (const float*)d_in[8];
    a.mlstm_norm_w = (const float*)d_in[9]; a.attn_norm_w = (const float*)d_in[10]; a.w_out = (const float*)d_in[11]; a.norm2_w = (const float*)d_in[12];
    a.w_gate = (const float*)d_in[13]; a.w_up = (const float*)d_in[14]; a.w_down = (const float*)d_in[15];
    a.out = (float*)d_out; a.ws = (unsigned char*)d_ws; a.dry = (PROBE_PHASE >= 0) ? 1 : 0;
    hipLaunchKernelGGL(hymba_fwd, dim3(grid), dim3(NWAVES * 64), LDS_BYTES, stream, a);
}
```

```cpp
#include <hip/hip_runtime.h>
#include <cstdio>
#include <cstdint>

#define LAS __attribute__((address_space(3)))
#define GAS __attribute__((address_space(1)))
typedef unsigned short bf16;
typedef short bf16x8 __attribute__((ext_vector_type(8)));
typedef short s16x4 __attribute__((ext_vector_type(4)));
typedef float f32x4 __attribute__((ext_vector_type(4)));
typedef float f32x2 __attribute__((ext_vector_type(2)));
typedef unsigned u32x4 __attribute__((ext_vector_type(4)));
typedef unsigned u32x2 __attribute__((ext_vector_type(2)));
typedef __bf16 bf16x2_t __attribute__((ext_vector_type(2)));

constexpr int BATCH = 2, SEQ = 4096, DM = 2048, MTOK = BATCH * SEQ;
constexpr int INW = 6152, NPROJ = 6144, DFF = 5632, NGU = 2 * DFF;
constexpr int PC_MQ = 0, PC_MK = 512, PC_MO = 1024, PC_MV = 2048, PC_AQ = 3072, PC_AK = 4096, PC_AV = 5120;
constexpr float NORM_EPS = 1e-6f;
constexpr int NWAVES = 8;

constexpr size_t MiB = 1u << 20;
constexpr size_t WS_CTL = 0, CTL_ZERO_BYTES = 32 * 1024;
constexpr size_t WS_GLI = 1 * MiB;
constexpr size_t WS_GLF = WS_GLI + 128 * 1024;
constexpr size_t WS_SUMSQ = WS_GLF + 128 * 1024;
constexpr size_t WS_MSC = WS_SUMSQ + 32 * 1024;
constexpr size_t WS_NC = WS_MSC + 8 * 1024;
constexpr size_t WS_COS = 2 * MiB, WS_SIN = 3 * MiB;
constexpr size_t WS_WIN = 6 * MiB;
constexpr size_t WS_KV = 6 * MiB;
constexpr size_t WS_U = 30 * MiB;
constexpr size_t WS_PROJ = 62 * MiB;
constexpr size_t WS_WOUT = 158 * MiB;
constexpr size_t WS_WGU = 166 * MiB;
constexpr size_t WS_WDN = 210 * MiB;
constexpr size_t WS_OP0 = 38 * MiB;
constexpr size_t WS_OP1 = 232 * MiB;
constexpr size_t WS_PL0 = 248 * MiB, WS_PL1 = WS_PL0 + 256 * 1024;
constexpr size_t WS_END = 249 * MiB;
constexpr int CW_BAR = 4096;

constexpr int RING_BYTES = 131072;
constexpr int MISC_OFF = 147456 - 256;
constexpr int LDS_BYTES = 147456;

__device__ __forceinline__ unsigned cvtpk(float lo, float hi) { f32x2 v = {lo, hi}; bf16x2_t b = __builtin_convertvector(v, bf16x2_t); return __builtin_bit_cast(unsigned, b); }
__device__ __forceinline__ float bf_lo(unsigned w) { return __uint_as_float(w << 16); }
__device__ __forceinline__ float bf_hi(unsigned w) { return __uint_as_float(w & 0xffff0000u); }
__device__ __forceinline__ void unpack8(u32x4 w, float* f) { f[0] = bf_lo(w.x); f[1] = bf_hi(w.x); f[2] = bf_lo(w.y); f[3] = bf_hi(w.y); f[4] = bf_lo(w.z); f[5] = bf_hi(w.z); f[6] = bf_lo(w.w); f[7] = bf_hi(w.w); }
__device__ __forceinline__ u32x4 pack8(const float* f) { u32x4 w; w.x = cvtpk(f[0], f[1]); w.y = cvtpk(f[2], f[3]); w.z = cvtpk(f[4], f[5]); w.w = cvtpk(f[6], f[7]); return w; }
#define DPP_MOV_F(v, ctrl) __uint_as_float((unsigned)__builtin_amdgcn_mov_dpp((int)__float_as_uint(v), (ctrl), 0xf, 0xf, true))
__device__ __forceinline__ float row16_sum(float v) { v += DPP_MOV_F(v, 0xB1); v += DPP_MOV_F(v, 0x4E); v += DPP_MOV_F(v, 0x124); v += DPP_MOV_F(v, 0x128); return v; }
__device__ __forceinline__ float x16_sum(float v) { const auto r = __builtin_amdgcn_permlane16_swap(__float_as_uint(v), __float_as_uint(v), false, false); return __uint_as_float(r[0]) + __uint_as_float(r[1]); }
__device__ __forceinline__ float x32_sum(float v) { const auto r = __builtin_amdgcn_permlane32_swap(__float_as_uint(v), __float_as_uint(v), false, false); return __uint_as_float(r[0]) + __uint_as_float(r[1]); }
__device__ __forceinline__ float x16_max(float v) { const auto r = __builtin_amdgcn_permlane16_swap(__float_as_uint(v), __float_as_uint(v), false, false); return fmaxf(__uint_as_float(r[0]), __uint_as_float(r[1])); }
__device__ __forceinline__ float x32_max(float v) { const auto r = __builtin_amdgcn_permlane32_swap(__float_as_uint(v), __float_as_uint(v), false, false); return fmaxf(__uint_as_float(r[0]), __uint_as_float(r[1])); }
__device__ __forceinline__ float xg_sum(float v) { return x32_sum(x16_sum(v)); }
__device__ __forceinline__ float xg_max(float v) { return x32_max(x16_max(v)); }
__device__ __forceinline__ float wave_sum(float v) { return xg_sum(row16_sum(v)); }
__device__ __forceinline__ float wave_max(float v) {
#pragma unroll
    for (int o = 1; o < 64; o <<= 1) v = fmaxf(v, __shfl_xor(v, o));
    return v;
}
__device__ __forceinline__ s16x4 vtr(const LAS unsigned char* p) { return __builtin_bit_cast(s16x4, __builtin_amdgcn_ds_read_tr16_b64_v4i16((LAS s16x4*)p)); }
__device__ __forceinline__ bf16x8 cat4(s16x4 a, s16x4 b) { return (bf16x8){a[0], a[1], a[2], a[3], b[0], b[1], b[2], b[3]}; }
#define LDS_WAIT() asm volatile("s_waitcnt lgkmcnt(0)" ::: "memory")
#define VM_WAIT() asm volatile("s_waitcnt vmcnt(0)" ::: "memory")
#define SBAR() __builtin_amdgcn_sched_barrier(0)
#define MFMA16(a, b, c) __builtin_amdgcn_mfma_f32_16x16x32_bf16((a), (b), (c), 0, 0, 0)

namespace pg8 {
constexpr int BM = 256, BK = 64, HALF = 128, HTB = HALF * BK * 2, STAGE_BYTES = 8 * HTB, NXCD = 8, WGM = 8;
__host__ __device__ __forceinline__ int lds_byte(int r, int c) { const int st = (r >> 4) * 2 + (c >> 5), rr = r & 15, cc = c & 31, ob = rr * 64 + cc * 2; return st * 1024 + (ob ^ (((ob >> 9) & 1) << 5)); }
__host__ __device__ __forceinline__ void stage_rc(int b, int& R, int& C) { const int st = b / 1024, sb = b % 1024, swz = sb ^ (((sb >> 9) & 1) << 5); R = (st >> 1) * 16 + swz / 64; C = (st & 1) * 32 + (swz % 64) / 2; }
__host__ __device__ __forceinline__ int perm32(int rho) { const int n = rho >> 4, i = rho & 15; return 8 * (i >> 2) + 4 * n + (i & 3); }
struct Unit { int pm, pn, ord; };
struct Gemm { const bf16* A; const bf16* Bt; int M, N, K, lda; };
struct StaticOrder {
    int nM, nN, nwg, G, c;
    __device__ void init(int M, int N, int G_, int c_) { nM = M / BM; nN = N / BM; nwg = nM * nN; G = G_; c = c_; }
    __device__ bool next(int i, Unit& u) const {
        const long L = (long)i * G + c; if (L >= nwg) return false; u.ord = i;
        int wgid = (int)L; { const int q = nwg / NXCD, r = nwg % NXCD, xcd = wgid % NXCD, off = wgid / NXCD; wgid = (xcd < r ? xcd * (q + 1) : r * (q + 1) + (xcd - r) * q) + off; }
        const int nig = WGM * nN, gid = wgid / nig, fm = gid * WGM, gsz = (nM - fm) < WGM ? (nM - fm) : WGM;
        u.pm = fm + ((wgid % nig) % gsz); u.pn = (wgid % nig) / gsz; return true;
    }
};
struct EpiBf16 {
    static constexpr bool PERM = true, HAS_INIT = false;
    bf16* O; int ldc;
    __device__ __forceinline__ void operator()(const f32x4 (&acc)[2][2][4][2], const Unit& u, int wr, int wc, int fr, int fq) const {
        const int row0 = u.pm * BM + wr * 64 + fr, col0 = u.pn * BM + wc * 32 + 8 * fq;
#pragma unroll
        for (int ai = 0; ai < 2; ++ai)
#pragma unroll
            for (int m = 0; m < 4; ++m) { bf16* rowp = O + (size_t)(row0 + ai * HALF + m * 16) * ldc + col0;
#pragma unroll
                for (int bj = 0; bj < 2; ++bj) { const f32x4 v0 = acc[ai][bj][m][0], v1 = acc[ai][bj][m][1];
                    u32x4 w; w.x = cvtpk(v0[0], v0[1]); w.y = cvtpk(v0[2], v0[3]); w.z = cvtpk(v1[0], v1[1]); w.w = cvtpk(v1[2], v1[3]);
                    *(u32x4*)(rowp + bj * HALF) = w; } }
    }
};
struct EpiRes1 {
    static constexpr bool PERM = false, HAS_INIT = true;
    const float* xres; float* out; bf16* h1b; float* sumsq; int ldc; bool dry;
    __device__ __forceinline__ void init(f32x4 (&acc)[2][2][4][2], const Unit& u, int wr, int wc, int fr, int fq) const {
        const int col0 = u.pn * BM + wc * 32 + 4 * fq;
#pragma unroll
        for (int ai = 0; ai < 2; ++ai)
#pragma unroll
            for (int m = 0; m < 4; ++m) { const size_t off = (size_t)(u.pm * BM + ai * HALF + wr * 64 + m * 16 + fr) * ldc + col0;
#pragma unroll
                for (int bj = 0; bj < 2; ++bj)
#pragma unroll
                    for (int n = 0; n < 2; ++n) acc[ai][bj][m][n] = __builtin_nontemporal_load((const f32x4*)(xres + off + bj * HALF + n * 16)); }
    }
    __device__ __forceinline__ void operator()(const f32x4 (&acc)[2][2][4][2], const Unit& u, int wr, int wc, int fr, int fq) const {
        const int col0 = u.pn * BM + wc * 32 + 4 * fq;
#pragma unroll
        for (int ai = 0; ai < 2; ++ai)
#pragma unroll
            for (int m = 0; m < 4; ++m) { const int row = u.pm * BM + ai * HALF + wr * 64 + m * 16 + fr; const size_t off = (size_t)row * ldc + col0; float ss = 0.f;
#pragma unroll
                for (int bj = 0; bj < 2; ++bj)
#pragma unroll
                    for (int n = 0; n < 2; ++n) { const size_t o2 = off + bj * HALF + n * 16; const f32x4 h = acc[ai][bj][m][n];
                        u32x2 w; w.x = cvtpk(h[0], h[1]); w.y = cvtpk(h[2], h[3]); if (!dry) { *(u32x2*)(h1b + o2) = w; }
                        ss += (h[0] * h[0] + h[1] * h[1]) + (h[2] * h[2] + h[3] * h[3]); }
                ss = xg_sum(ss);
                if (fq == 0 && !dry) atomicAdd(sumsq + row, ss); }
    }
};
struct EpiSwiGLU {
    static constexpr bool PERM = true, HAS_INIT = false;
    bf16* O; int ldc; const LAS float* rsl; const float* sumsq;
    __device__ __forceinline__ void operator()(const f32x4 (&acc)[2][2][4][2], const Unit& u, int wr, int wc, int fr, int fq) const {
        const int col0 = u.pn * HALF + wc * 32 + 8 * fq;
#pragma unroll
        for (int ai = 0; ai < 2; ++ai)
#pragma unroll
            for (int m = 0; m < 4; ++m) { const int rl = ai * HALF + wr * 64 + m * 16 + fr; const int row = u.pm * BM + rl;
                const float rs = (u.ord < 8) ? rsl[u.ord * 256 + rl] : __builtin_amdgcn_rsqf(sumsq[row] * (1.0f / DM) + NORM_EPS);
                float f[8];
#pragma unroll
                for (int n = 0; n < 2; ++n)
#pragma unroll
                    for (int j = 0; j < 4; ++j) { const float g = acc[ai][0][m][n][j] * rs, up = acc[ai][1][m][n][j] * rs; f[n * 4 + j] = g * __builtin_amdgcn_rcpf(1.0f + __expf(-g)) * up; }
                *(u32x4*)(O + (size_t)row * ldc + col0) = pack8(f); }
    }
};
struct EpiRes2 {
    static constexpr bool PERM = false, HAS_INIT = true;
    const bf16* h1b; float* out; int ldc; bool dry;
    __device__ __forceinline__ void init(f32x4 (&acc)[2][2][4][2], const Unit& u, int wr, int wc, int fr, int fq) const {
        const int col0 = u.pn * BM + wc * 32 + 4 * fq;
#pragma unroll
        for (int ai = 0; ai < 2; ++ai)
#pragma unroll
            for (int m = 0; m < 4; ++m) { const size_t off = (size_t)(u.pm * BM + ai * HALF + wr * 64 + m * 16 + fr) * ldc + col0;
#pragma unroll
                for (int bj = 0; bj < 2; ++bj)
#pragma unroll
                    for (int n = 0; n < 2; ++n) { const u32x2 w = __builtin_nontemporal_load((const u32x2*)(h1b + off + bj * HALF + n * 16)); acc[ai][bj][m][n] = (f32x4){bf_lo(w.x), bf_hi(w.x), bf_lo(w.y), bf_hi(w.y)}; } }
    }
    __device__ __forceinline__ void operator()(const f32x4 (&acc)[2][2][4][2], const Unit& u, int wr, int wc, int fr, int fq) const {
        const int col0 = u.pn * BM + wc * 32 + 4 * fq;
#pragma unroll
        for (int ai = 0; ai < 2; ++ai)
#pragma unroll
            for (int m = 0; m < 4; ++m) { const size_t off = (size_t)(u.pm * BM + ai * HALF + wr * 64 + m * 16 + fr) * ldc + col0;
#pragma unroll
                for (int bj = 0; bj < 2; ++bj)
#pragma unroll
                    for (int n = 0; n < 2; ++n) { if (!dry) __builtin_nontemporal_store(acc[ai][bj][m][n], (f32x4*)(out + off + bj * HALF + n * 16)); } }
    }
};

template <class Epi, bool ALIGN_EPI>
__device__ __forceinline__ void gemm_phase(LAS unsigned char* lds, const Gemm g, const StaticOrder& S, const Epi& E) {
    int tid = threadIdx.x; asm volatile("" : "+v"(tid));
    const int wid = __builtin_amdgcn_readfirstlane(tid >> 6), lane = tid & 63, wr = wid >> 2, wc = wid & 3, fr = lane & 15, fq = lane >> 4;
    const int K = g.K, nt = K / BK;
    unsigned voffA[2], voffB[2];
#pragma unroll
    for (int i = 0; i < 2; ++i) { int R, C; stage_rc(tid * 16 + i * 8192, R, C); const int Rb = Epi::PERM ? ((R & ~31) + perm32(R & 31)) : R;
        voffA[i] = (unsigned)(R * g.lda + C) * 2u; voffB[i] = (unsigned)(Rb * K + C) * 2u; }
    const size_t kstep = (size_t)(BK * 2);
    const size_t hstepA = (size_t)HALF * g.lda * 2, hstepB = (size_t)HALF * K * 2;
    const size_t tstepA = 2 * hstepA, tstepB = 2 * hstepB;
    const unsigned ldsw = (unsigned)wid * 1024u;
    const int aoff = lds_byte(wr * 64 + fr, fq * 8), boff = lds_byte(wc * 32 + fr, fq * 8);
#define PG8_SA(b, h) (((b) * 2 + (h)) * HTB)
#define PG8_SB(b, h) ((4 + (b) * 2 + (h)) * HTB)
#define PG8_STAGE(bufoff, gbase, voff) do { _Pragma("unroll") for (int _i = 0; _i < 2; ++_i) \
        __builtin_amdgcn_global_load_lds((const unsigned*)((const char*)(gbase) + (voff)[_i]), (LAS unsigned*)(lds + (bufoff) + ldsw + _i * 8192), 16, 0, 0); } while (0)
#define PG8_LDA(dst, b, h) do { _Pragma("unroll") for (int m = 0; m < 4; ++m) _Pragma("unroll") for (int k = 0; k < 2; ++k) dst[m][k] = *(const LAS bf16x8*)(lds + PG8_SA(b, h) + aoff + m * 2048 + k * 1024); } while (0)
#define PG8_LDB(dst, b, h) do { _Pragma("unroll") for (int n = 0; n < 2; ++n) _Pragma("unroll") for (int k = 0; k < 2; ++k) dst[n][k] = *(const LAS bf16x8*)(lds + PG8_SB(b, h) + boff + n * 2048 + k * 1024); } while (0)
#define PG8_MMA(ai, bj, At, Bt) do { __builtin_amdgcn_s_setprio(1); _Pragma("unroll") for (int m = 0; m < 4; ++m) _Pragma("unroll") for (int n = 0; n < 2; ++n) _Pragma("unroll") for (int k = 0; k < 2; ++k) \
        acc[ai][bj][m][n] = __builtin_amdgcn_mfma_f32_16x16x32_bf16(Bt[n][k], At[m][k], acc[ai][bj][m][n], 0, 0, 0); __builtin_amdgcn_s_setprio(0); } while (0)
#define PG8_WAIT_V(n) asm volatile("s_waitcnt vmcnt(" #n ")" ::: "memory")
#define PG8_WAIT_L(n) asm volatile("s_waitcnt lgkmcnt(" #n ")" ::: "memory")
#define PG8_BAR __builtin_amdgcn_s_barrier()
#define PG8_SCHED __builtin_amdgcn_sched_barrier(0)
    Unit cur, nxt; int ui = 0;
    if (!S.next(0, cur)) return;
    f32x4 acc[2][2][4][2];
    if constexpr (Epi::HAS_INIT) { E.init(acc, cur, wr, wc, fr, fq); }
    else {
#pragma unroll
    for (int a = 0; a < 2; ++a)
#pragma unroll
        for (int b = 0; b < 2; ++b)
#pragma unroll
            for (int m = 0; m < 4; ++m)
#pragma unroll
                for (int n = 0; n < 2; ++n) acc[a][b][m][n] = (f32x4){0.f, 0.f, 0.f, 0.f};
    }
    bf16x8 At[4][2], B0[2][2], B1[2][2];
    const char* cA = (const char*)g.A + (size_t)cur.pm * tstepA; const char* cB = (const char*)g.Bt + (size_t)cur.pn * tstepB;
    PG8_STAGE(PG8_SB(0, 0), cB, voffB); PG8_STAGE(PG8_SB(0, 1), cB + hstepB, voffB); PG8_STAGE(PG8_SA(0, 0), cA, voffA); PG8_STAGE(PG8_SA(0, 1), cA + hstepA, voffA);
    if (wr == 1) PG8_BAR;
    PG8_WAIT_V(2); PG8_BAR;
    PG8_STAGE(PG8_SB(1, 0), cB + kstep, voffB); PG8_STAGE(PG8_SA(1, 0), cA + kstep, voffA); PG8_STAGE(PG8_SB(1, 1), cB + hstepB + kstep, voffB);
    PG8_WAIT_V(6); PG8_BAR;
    for (;;) {
        const bool has_next = S.next(ui + 1, nxt);
        const char* nA = has_next ? (const char*)g.A + (size_t)nxt.pm * tstepA : cA; const char* nB = has_next ? (const char*)g.Bt + (size_t)nxt.pn * tstepB : cB;
        for (int t = 0; t < nt; t += 2) {
            const bool last = (t == nt - 2);
            const char* a1 = cA + (size_t)(t + 1) * kstep;
            const char* a2 = last ? nA : cA + (size_t)(t + 2) * kstep; const char* b2 = last ? nB : cB + (size_t)(t + 2) * kstep;
            const char* a3 = a2 + kstep; const char* b3 = b2 + kstep;
            PG8_LDB(B0, 0, 0); PG8_LDB(B1, 0, 1); PG8_SCHED; PG8_LDA(At, 0, 0); PG8_STAGE(PG8_SA(1, 1), a1 + hstepA, voffA);
            PG8_WAIT_V(8); PG8_WAIT_L(0); PG8_BAR; PG8_MMA(0, 0, At, B0); PG8_MMA(0, 1, At, B1); PG8_BAR; PG8_SCHED;
            PG8_LDA(At, 0, 1); PG8_STAGE(PG8_SB(0, 0), b2, voffB); PG8_STAGE(PG8_SB(0, 1), b2 + hstepB, voffB); PG8_STAGE(PG8_SA(0, 0), a2, voffA);
            PG8_WAIT_V(8); PG8_WAIT_L(0); PG8_BAR; PG8_MMA(1, 0, At, B0); PG8_MMA(1, 1, At, B1); PG8_BAR; PG8_SCHED;
            PG8_LDB(B0, 1, 0); PG8_LDB(B1, 1, 1); PG8_SCHED; PG8_LDA(At, 1, 0); PG8_STAGE(PG8_SA(0, 1), a2 + hstepA, voffA);
            PG8_WAIT_V(8); PG8_WAIT_L(0); PG8_BAR; PG8_MMA(0, 0, At, B0); PG8_MMA(0, 1, At, B1); PG8_BAR; PG8_SCHED;
            PG8_LDA(At, 1, 1); PG8_STAGE(PG8_SB(1, 0), b3, voffB); PG8_STAGE(PG8_SB(1, 1), b3 + hstepB, voffB); PG8_STAGE(PG8_SA(1, 0), a3, voffA);
            PG8_WAIT_V(8); PG8_WAIT_L(0); PG8_BAR; PG8_MMA(1, 0, At, B0); PG8_MMA(1, 1, At, B1); PG8_BAR; PG8_SCHED;
        }
        if constexpr (ALIGN_EPI) { if (wr == 0) PG8_BAR; }
        E(acc, cur, wr, wc, fr, fq);
        if (!has_next) break;
        if constexpr (Epi::HAS_INIT) { E.init(acc, nxt, wr, wc, fr, fq); }
        else {
#pragma unroll
        for (int a = 0; a < 2; ++a)
#pragma unroll
            for (int b = 0; b < 2; ++b)
#pragma unroll
                for (int m = 0; m < 4; ++m)
#pragma unroll
                    for (int n = 0; n < 2; ++n) acc[a][b][m][n] = (f32x4){0.f, 0.f, 0.f, 0.f};
        }
        cur = nxt; cA = nA; cB = nB; ++ui;
        if constexpr (ALIGN_EPI) { if (wr == 1) PG8_BAR; }
    }
    PG8_WAIT_V(0);
    if constexpr (!ALIGN_EPI) { if (wr == 0) PG8_BAR; }
    PG8_BAR;
#undef PG8_SA
#undef PG8_SB
#undef PG8_STAGE
#undef PG8_LDA
#undef PG8_LDB
#undef PG8_MMA
#undef PG8_WAIT_V
#undef PG8_WAIT_L
#undef PG8_BAR
#undef PG8_SCHED
}
}

#define XB_TMO      128
#define XB_XCNT(j)  (256  + 64 * (j))
#define XB_XSUB(j)  (1280 + 64 * (j))
#define XB_XGEN(j)  (2304 + 64 * (j))
#define XB_TOP      3328
#define XB_TOPGEN   3392
#define XCD_BAR_WORDS 3456
#define XB_SPIN_CAP (1u << 18)
__device__ __forceinline__ unsigned xb_ld(unsigned* p)              { return __hip_atomic_load(p, __ATOMIC_RELAXED, __HIP_MEMORY_SCOPE_AGENT); }
__device__ __forceinline__ unsigned xb_add(unsigned* p, unsigned v) { return __hip_atomic_fetch_add(p, v, __ATOMIC_RELAXED, __HIP_MEMORY_SCOPE_AGENT); }
__device__ __forceinline__ unsigned xb_xcc_id() { return (unsigned)__builtin_amdgcn_s_getreg((3 << 11) | 20) & 0xFu; }
#define XB_SPIN(cond, bar) do { unsigned _sp = 0; while (cond) { __builtin_amdgcn_s_sleep(1); \
    if ((++_sp & 255u) == 0u) { if (xb_ld(&(bar)[XB_TMO])) break; if (_sp > XB_SPIN_CAP) { atomicAdd(&(bar)[XB_TMO], 1u); break; } } } } while (0)
struct XcdBarrier { unsigned* bar; unsigned x; volatile LAS unsigned* st; };
__device__ __forceinline__ XcdBarrier xcd_barrier_post(unsigned* bar, volatile LAS unsigned* st) {
    XcdBarrier b; b.bar = bar; b.x = xb_xcc_id(); b.st = st;
    if (threadIdx.x == 0) (void)xb_add(&bar[XB_XCNT(b.x)], 1u);
    return b;
}
__device__ __forceinline__ void xcd_barrier_complete(unsigned* bar, unsigned x, unsigned& nloc, unsigned& nx) {
    const unsigned G = gridDim.x * gridDim.y * gridDim.z;
    unsigned sum, cnt, mine, sp = 0u;
    for (;;) {
        sum = 0u; cnt = 0u; mine = 0u;
#pragma unroll
        for (unsigned j = 0; j < 16; ++j) { const unsigned c = xb_ld(&bar[XB_XCNT(j)]); sum += c; cnt += (c > 0u) ? 1u : 0u; mine = (j == x) ? c : mine; }
        if (sum == G) break;
        __builtin_amdgcn_s_sleep(1);
        if ((++sp & 255u) == 0u) { if (xb_ld(&bar[XB_TMO])) break; if (sp > XB_SPIN_CAP) { atomicAdd(&bar[XB_TMO], 1u); break; } }
    }
    nloc = mine > 0u ? mine : 1u; nx = cnt > 0u ? cnt : 1u;
}
__device__ __forceinline__ void xcd_barrier(const XcdBarrier& b) {
    asm volatile("s_waitcnt vmcnt(0)" ::: "memory");
    __syncthreads();
    if (threadIdx.x == 0) {
        unsigned* bar = b.bar;
        __builtin_amdgcn_s_waitcnt(0);
        unsigned nloc = b.st[0], nx = b.st[1];
        if (nloc == 0u) { xcd_barrier_complete(bar, b.x, nloc, nx); b.st[0] = nloc; b.st[1] = nx; }
        const unsigned old = xb_add(&bar[XB_XSUB(b.x)], 1u);
        const unsigned gen = old / nloc;
        if (old + 1u == (gen + 1u) * nloc) {
            __builtin_amdgcn_fence(__ATOMIC_RELEASE, "agent");
            asm volatile("s_waitcnt vmcnt(0)" ::: "memory");
            const unsigned og = xb_add(&bar[XB_TOP], 1u);
            const unsigned tg = og / nx;
            if (og + 1u == (tg + 1u) * nx) xb_add(&bar[XB_TOPGEN], 1u);
            else XB_SPIN(xb_ld(&bar[XB_TOPGEN]) == tg, bar);
            __builtin_amdgcn_fence(__ATOMIC_ACQUIRE, "agent");
            xb_add(&bar[XB_XGEN(b.x)], 1u);
            asm volatile("s_waitcnt vmcnt(0)" ::: "memory");
        } else {
            XB_SPIN(xb_ld(&bar[XB_XGEN(b.x)]) == gen, bar);
            __builtin_amdgcn_fence(__ATOMIC_ACQUIRE, "agent");
            asm volatile("s_waitcnt vmcnt(0)" ::: "memory");
        }
    }
    __syncthreads();
}

struct Args {
    const float* x; const float* norm1_w; const float* w_in; const float* conv_w; const float* conv_b; const float* igate_b; const float* fgate_b;
    const float* q_norm_w; const float* k_norm_w; const float* mlstm_norm_w; const float* attn_norm_w; const float* w_out; const float* norm2_w;
    const float* w_gate; const float* w_up; const float* w_down;
    float* out; unsigned char* ws; int dry; int pad;
};

struct TItem { const float* W; bf16* WT; const float* kscale; int ldw, K, nsrc0, ndst0, k0, kperm; };
__device__ __forceinline__ void titem_load(const TItem& t, f32x4 (&v)[8], float (&ks)[8], const float* ksafe, int lane) {
    const float* src = t.W + (size_t)t.k0 * t.ldw + t.nsrc0 + (lane & 7) * 4;
    const float* kp = (t.kscale ? t.kscale : ksafe) + t.k0 + (lane >> 3);
#pragma unroll
    for (int i = 0; i < 8; ++i) { const int kk = 8 * i + (lane >> 3); const int kr = t.kperm ? (32 * (kk >> 5) + 16 * ((kk >> 2) & 1) + 4 * ((kk >> 3) & 3) + (kk & 3)) : kk;
        v[i] = __builtin_nontemporal_load((const f32x4*)(src + (size_t)kr * t.ldw)); ks[i] = kp[8 * i]; }
}
__device__ __forceinline__ void titem_finish(const TItem& t, const f32x4 (&v)[8], const float (&ks)[8], LAS float* scr, int lane) {
#pragma unroll
    for (int i = 0; i < 8; ++i) { const int kk = 8 * i + (lane >> 3); const float sc = t.kscale ? ks[i] : 1.0f; LAS float* d = scr + kk * 33 + (lane & 7) * 4;
        d[0] = v[i][0] * sc; d[1] = v[i][1] * sc; d[2] = v[i][2] * sc; d[3] = v[i][3] * sc; }
    LDS_WAIT(); asm volatile("" ::: "memory");
    const int c = lane & 7;
#pragma unroll
    for (int j = 0; j < 4; ++j) { const int n = (lane >> 3) + 8 * j; const LAS float* s = scr + (8 * c) * 33 + n;
        u32x4 o; o.x = cvtpk(s[0 * 33], s[1 * 33]); o.y = cvtpk(s[2 * 33], s[3 * 33]); o.z = cvtpk(s[4 * 33], s[5 * 33]); o.w = cvtpk(s[6 * 33], s[7 * 33]);
        *(u32x4*)(t.WT + (size_t)(t.ndst0 + n) * t.K + t.k0 + 8 * c) = o; }
    LDS_WAIT(); asm volatile("" ::: "memory");
}
__device__ __forceinline__ int win_src_col(int nd) {
    if (nd < 1024) return nd;
    if (nd < 2048) return nd + 1024;
    if (nd < 3072) return nd - 1024;
    return nd + 8;
}


__device__ __forceinline__ float scan_add64(float v, int lane) {
#pragma unroll
    for (int o = 1; o < 64; o <<= 1) { const float t = __shfl_up(v, o); if (lane >= o) v += t; }
    return v;
}
__device__ __forceinline__ float scan_max64(float v, int lane) {
#pragma unroll
    for (int o = 1; o < 64; o <<= 1) { const float t = __shfl_up(v, o); if (lane >= o) v = fmaxf(v, t); }
    return v;
}
__device__ __forceinline__ void conv_issue(const bf16* proj, int b, int c, int col0, int tid, u32x4 (&raw)[2][4]) {
    const int rr = tid >> 4, cc = (tid & 15) * 8;
#pragma unroll
    for (int half = 0; half < 2; ++half)
#pragma unroll
        for (int j = 0; j < 4; ++j) { const int tt = c * 64 + rr + 32 * half - 3 + j; const int ttc = tt < 0 ? 0 : tt;
            raw[half][j] = *(const u32x4*)(proj + (size_t)(b * SEQ + ttc) * NPROJ + col0 + cc); }
}
template <bool ROWW>
__device__ __forceinline__ void conv_finish(const u32x4 (&raw)[2][4], const float* conv_w, const float* conv_b, int c, int ch0, float rscale, float wlane, LAS unsigned char* tile, int tid) {
    const int rr = tid >> 4, cc = (tid & 15) * 8;
    float w[4][8], bb[8];
#pragma unroll
    for (int j = 0; j < 4; ++j) { const f32x4 w0 = *(const f32x4*)(conv_w + j * 1024 + ch0 + cc), w1 = *(const f32x4*)(conv_w + j * 1024 + ch0 + cc + 4);
        w[j][0] = w0[0]; w[j][1] = w0[1]; w[j][2] = w0[2]; w[j][3] = w0[3]; w[j][4] = w1[0]; w[j][5] = w1[1]; w[j][6] = w1[2]; w[j][7] = w1[3]; }
    { const f32x4 b0 = *(const f32x4*)(conv_b + ch0 + cc), b1 = *(const f32x4*)(conv_b + ch0 + cc + 4);
      bb[0] = b0[0]; bb[1] = b0[1]; bb[2] = b0[2]; bb[3] = b0[3]; bb[4] = b1[0]; bb[5] = b1[1]; bb[6] = b1[2]; bb[7] = b1[3]; }
#pragma unroll
    for (int half = 0; half < 2; ++half) {
        const int l = rr + 32 * half, t = c * 64 + l;
        float y[8];
#pragma unroll
        for (int e = 0; e < 8; ++e) y[e] = bb[e];
#pragma unroll
        for (int j = 0; j < 4; ++j) { const bool inb = (t - 3 + j) >= 0; u32x4 rz = raw[half][j];
            rz.x = inb ? rz.x : 0u; rz.y = inb ? rz.y : 0u; rz.z = inb ? rz.z : 0u; rz.w = inb ? rz.w : 0u;
            float x[8]; unpack8(rz, x);
#pragma unroll
            for (int e = 0; e < 8; ++e) y[e] += w[j][e] * x[e]; }
        float sc = rscale;
        if (ROWW) sc *= __shfl(wlane, l);
#pragma unroll
        for (int e = 0; e < 8; ++e) y[e] = y[e] * __builtin_amdgcn_rcpf(1.0f + __expf(-y[e])) * sc;
        *(LAS u32x4*)(tile + l * 288 + cc * 2) = pack8(y);
    }
}
__device__ __forceinline__ void v_issue(const bf16* proj, int b, int c, int h, int tid, u32x4 (&vv)[4]) {
#pragma unroll
    for (int p = 0; p < 4; ++p) { const int row = p * 16 + (tid >> 5), ch = tid & 31;
        vv[p] = *(const u32x4*)(proj + (size_t)(b * SEQ + c * 64 + row) * NPROJ + PC_MV + h * 256 + ch * 8); }
}
__device__ __forceinline__ void v_store(const u32x4 (&vv)[4], LAS unsigned char* tile, int tid) {
#pragma unroll
    for (int p = 0; p < 4; ++p) { const int row = p * 16 + (tid >> 5), ch = tid & 31;
        *(LAS u32x4*)(tile + row * 544 + ch * 16) = vv[p]; }
}

__device__ __forceinline__ void q_prep(const bf16* qrow, const float* rcos, const float* rsin, const float* qnw, int tq, int g, bf16x8 (&qf)[4]) {
    float q[4][8]; float ss = 0.f;
#pragma unroll
    for (int ks = 0; ks < 4; ++ks) { const u32x4 raw = *(const u32x4*)(qrow + 32 * ks + 8 * g); unpack8(raw, q[ks]);
#pragma unroll
        for (int e = 0; e < 8; ++e) ss += q[ks][e] * q[ks][e]; }
    ss = xg_sum(ss);
    const float rq = __builtin_amdgcn_rsqf(ss * (1.0f / 128.0f) + NORM_EPS);
#pragma unroll
    for (int ks = 0; ks < 2; ++ks) {
        const int c0 = 32 * ks + 8 * g;
#pragma unroll
        for (int e4 = 0; e4 < 2; ++e4) {
            const f32x4 cs = *(const f32x4*)(rcos + tq * 64 + c0 + 4 * e4), sn = *(const f32x4*)(rsin + tq * 64 + c0 + 4 * e4);
            const f32x4 w1 = *(const f32x4*)(qnw + c0 + 4 * e4), w2 = *(const f32x4*)(qnw + 64 + c0 + 4 * e4);
#pragma unroll
            for (int e = 0; e < 4; ++e) { const float y1 = q[ks][4 * e4 + e] * rq * w1[e], y2 = q[ks + 2][4 * e4 + e] * rq * w2[e];
                q[ks][4 * e4 + e] = y1 * cs[e] - y2 * sn[e]; q[ks + 2][4 * e4 + e] = y2 * cs[e] + y1 * sn[e]; }
        }
    }
#pragma unroll
    for (int ks = 0; ks < 4; ++ks) { const u32x4 w = pack8(q[ks]); qf[ks] = __builtin_bit_cast(bf16x8, w); }
}
struct AUnit { int b, h, d, r, n; bf16* po0; float* pl0; };
template <bool FINAL>
__device__ __forceinline__ void attn_pair(bf16* proj, const float* rcos, const float* rsin, const float* qnw, float mref, const float* anw, const AUnit& ua, const AUnit& ub,
                                          LAS unsigned char* lds_all, bf16* po1, float* pl1, int tid_in, bool dry) {
    int tid = tid_in; asm volatile("" : "+v"(tid));
    const int lane = tid & 63, wave = __builtin_amdgcn_readfirstlane(tid >> 6);
    const int team = wave >> 2, w4 = wave & 3;
    const int b = team ? ub.b : ua.b, h = team ? ub.h : ua.h, d = team ? ub.d : ua.d, r = team ? ub.r : ua.r, n = team ? ub.n : ua.n;
    bf16* po0 = team ? ub.po0 : ua.po0; float* pl0 = team ? ub.pl0 : ua.pl0;
    LAS unsigned char* lds = lds_all + team * 36864;
    const int j = lane & 15, g = lane >> 4, qp = j >> 2, p = lane & 3;
    const int tt = tid & 255, srow = tt >> 4, sch = tt & 15;
    const bf16* kcol = proj + (size_t)b * SEQ * NPROJ + PC_AK + h * 128 + sch * 8;
    const bf16* vcol = kcol + (PC_AV - PC_AK);
    const int kt0 = (n == 0) ? 4 : 0;
    const int sub0 = 128 * (n - 1) + srow;
    u32x4 rk[2][2], rv[2][2];
#define AT_ISSUE(set, t) do { const int tc_ = ((t) < 8) ? (t) : 7; _Pragma("unroll") for (int hh_ = 0; hh_ < 2; ++hh_) { const size_t tok_ = (size_t)((sub0 + 32 * tc_ + 16 * hh_) * d + r); \
        rk[set][hh_] = *(const u32x4*)(kcol + tok_ * NPROJ); rv[set][hh_] = *(const u32x4*)(vcol + tok_ * NPROJ); } } while (0)
#define AT_WRITE(set, t) do { LAS unsigned char* Kn_ = lds + ((t) & 1) * 18432; _Pragma("unroll") for (int hh_ = 0; hh_ < 2; ++hh_) { \
        *(LAS u32x4*)(Kn_ + (srow + 16 * hh_) * 288 + sch * 16) = rk[set][hh_]; *(LAS u32x4*)(Kn_ + 9216 + (srow + 16 * hh_) * 288 + sch * 16) = rv[set][hh_]; } } while (0)
#define WG_BAR() do { asm volatile("s_waitcnt lgkmcnt(0)" ::: "memory"); __builtin_amdgcn_s_barrier(); asm volatile("" ::: "memory"); } while (0)
    AT_ISSUE(0, kt0); AT_ISSUE(1, kt0 + 1);
    bf16x8 qf[2][4]; int qi[2]; int tq[2];
    const int G0 = w4, G1 = 7 - w4;
    qi[0] = 16 * G0 + j; qi[1] = 16 * G1 + j; tq[0] = (128 * n + qi[0]) * d + r; tq[1] = (128 * n + qi[1]) * d + r;
    const int lo0 = G0 >> 1, lo1 = G1 >> 1;
#pragma unroll
    for (int gi = 0; gi < 2; ++gi) { const bf16* qrow = proj + (size_t)(b * SEQ + tq[gi]) * NPROJ + PC_AQ + h * 128 + 8 * g;
#pragma unroll
        for (int ks = 0; ks < 4; ++ks) qf[gi][ks] = *(const bf16x8*)(qrow + 32 * ks); }
    AT_WRITE(0, kt0);
    for (int kb_ = 0; kb_ < kt0; ++kb_) WG_BAR();
    WG_BAR();
    float l_run[2] = {0.f, 0.f};
    f32x4 o[2][8];
    if (FINAL) {
#pragma unroll
        for (int gi = 0; gi < 2; ++gi) { const size_t trow = (size_t)(b * SEQ + tq[gi]);
            const float l0 = pl0[trow * 8 + h], l1 = pl1[trow * 8 + h];
            const float a0 = __builtin_amdgcn_exp2f(l0 - mref), a1 = __builtin_amdgcn_exp2f(l1 - mref);
            l_run[gi] = (g == 0) ? a0 + a1 : 0.f;
            const bf16* p0 = po0 + trow * 1024 + h * 128 + g * 8; const bf16* p1 = po1 + trow * 1024 + h * 128 + g * 8;
#pragma unroll
            for (int np = 0; np < 4; ++np) { const u32x4 x0 = *(const u32x4*)(p0 + 32 * np), x1 = *(const u32x4*)(p1 + 32 * np); float f0[8], f1[8]; unpack8(x0, f0); unpack8(x1, f1);
#pragma unroll
                for (int e = 0; e < 4; ++e) { o[gi][2 * np][e] = a0 * f0[e] + a1 * f1[e]; o[gi][2 * np + 1][e] = a0 * f0[4 + e] + a1 * f1[4 + e]; } }
        }
    } else {
#pragma unroll
        for (int gi = 0; gi < 2; ++gi)
#pragma unroll
            for (int nf = 0; nf < 8; ++nf) o[gi][nf] = (f32x4){0.f, 0.f, 0.f, 0.f};
    }
    const float SC = 0.08838834764831845f * 1.4426950408889634f;
    const float nmref = -mref;
#define AT_SM(gi, kt, s0, s1) do { \
                float x[8]; float ps = 0.f; \
                _Pragma("unroll") for (int e = 0; e < 8; ++e) { const int kj = 32 * (kt) + 16 * (e >> 2) + 4 * g + (e & 3); const float sv = (e < 4) ? s0[e & 3] : s1[e & 3]; \
                    const bool valid = (kj >= qi[gi]) && (kj <= qi[gi] + 128); \
                    const float pe = __builtin_amdgcn_exp2f(__builtin_fmaf(sv, SC, nmref)); \
                    x[e] = valid ? pe : 0.f; ps += x[e]; } \
                l_run[gi] += ps; \
                const u32x4 pw = pack8(x); pb[gi] = __builtin_bit_cast(bf16x8, pw); } while (0)
#define AT_ONE(gi, kt) do { \
            f32x4 sA = {0.f, 0.f, 0.f, 0.f}, sB = {0.f, 0.f, 0.f, 0.f}; \
            _Pragma("unroll") for (int ks = 0; ks < 4; ++ks) { \
                const bf16x8 k0 = *(const LAS bf16x8*)(Kt + j * 288 + (32 * ks + 8 * g) * 2), k1 = *(const LAS bf16x8*)(Kt + (16 + j) * 288 + (32 * ks + 8 * g) * 2); \
                sA = MFMA16(k0, qf[gi][ks], sA); sB = MFMA16(k1, qf[gi][ks], sB); } \
            bf16x8 pb[2]; AT_SM(gi, kt, sA, sB); \
            _Pragma("unroll") for (int nf = 0; nf < 8; ++nf) { \
                const s16x4 a0 = vtr(Vt + (4 * g + qp) * 288 + (16 * nf + 4 * p) * 2), a1 = vtr(Vt + (16 + 4 * g + qp) * 288 + (16 * nf + 4 * p) * 2); \
                o[gi][nf] = MFMA16(cat4(a0, a1), pb[gi], o[gi][nf]); } } while (0)
#define AT_STEP(kt, setn, setw) do { \
        LAS unsigned char* Kt = lds + ((kt) & 1) * 18432; LAS unsigned char* Vt = Kt + 9216; \
        AT_ISSUE(setn, (kt) + 2); \
        const bool act0 = (kt) >= lo0 && (kt) <= lo0 + 4, act1 = (kt) >= lo1 && (kt) <= lo1 + 4; \
        if (act0 && act1) { \
            f32x4 sA[2], sB[2]; sA[0] = (f32x4){0.f, 0.f, 0.f, 0.f}; sA[1] = sA[0]; sB[0] = sA[0]; sB[1] = sA[0]; \
            _Pragma("unroll") for (int ks = 0; ks < 4; ++ks) { \
                const bf16x8 k0 = *(const LAS bf16x8*)(Kt + j * 288 + (32 * ks + 8 * g) * 2), k1 = *(const LAS bf16x8*)(Kt + (16 + j) * 288 + (32 * ks + 8 * g) * 2); \
                sA[0] = MFMA16(k0, qf[0][ks], sA[0]); sB[0] = MFMA16(k1, qf[0][ks], sB[0]); sA[1] = MFMA16(k0, qf[1][ks], sA[1]); sB[1] = MFMA16(k1, qf[1][ks], sB[1]); } \
            bf16x8 pb[2]; \
            AT_SM(0, kt, sA[0], sB[0]); AT_SM(1, kt, sA[1], sB[1]); \
            _Pragma("unroll") for (int nf = 0; nf < 8; ++nf) { \
                const s16x4 a0 = vtr(Vt + (4 * g + qp) * 288 + (16 * nf + 4 * p) * 2), a1 = vtr(Vt + (16 + 4 * g + qp) * 288 + (16 * nf + 4 * p) * 2); \
                const bf16x8 vf = cat4(a0, a1); \
                o[0][nf] = MFMA16(vf, pb[0], o[0][nf]); o[1][nf] = MFMA16(vf, pb[1], o[1][nf]); } \
        } else if (act0) { AT_ONE(0, kt); } else if (act1) { AT_ONE(1, kt); } \
        if ((kt) + 1 < 8) AT_WRITE(setw, (kt) + 1); \
        WG_BAR(); } while (0)
#pragma unroll 1
    for (int kt = kt0; kt < 8; kt += 2) { AT_STEP(kt, 0, 1); AT_STEP(kt + 1, 1, 0); }
#undef AT_STEP
#undef AT_ONE
#undef AT_SM
#undef AT_ISSUE
#undef AT_WRITE
    f32x4 anwv[8];
    if (FINAL) {
#pragma unroll
        for (int nf = 0; nf < 8; ++nf) anwv[nf] = *(const f32x4*)(anw + h * 128 + 16 * nf + 4 * g);
    }
#pragma unroll
    for (int gi = 0; gi < 2; ++gi) {
        float lr = l_run[gi]; lr = xg_sum(lr);
        const float inv = __builtin_amdgcn_rcpf(lr);
        const float lse2 = mref + __log2f(lr);
        const size_t trow = (size_t)(b * SEQ + tq[gi]);
        if (!FINAL) {
            bf16* pp = po0 + trow * 1024 + h * 128 + g * 8;
#pragma unroll
            for (int np = 0; np < 4; ++np) { const f32x4 va = o[gi][2 * np] * inv, vb = o[gi][2 * np + 1] * inv; u32x4 ww; ww.x = cvtpk(va[0], va[1]); ww.y = cvtpk(va[2], va[3]); ww.z = cvtpk(vb[0], vb[1]); ww.w = cvtpk(vb[2], vb[3]);
                if (!dry) *(u32x4*)(pp + 32 * np) = ww; }
            if (g == 0 && !dry) pl0[trow * 8 + h] = lse2;
        } else {
            bf16* qrow = proj + trow * NPROJ + PC_AQ + h * 128;
            float ss = 0.f;
#pragma unroll
            for (int nf = 0; nf < 8; ++nf) { const f32x4 v = o[gi][nf] * inv; o[gi][nf] = v; ss += (v[0] * v[0] + v[1] * v[1]) + (v[2] * v[2] + v[3] * v[3]); }
            ss = xg_sum(ss);
            const float rn = __builtin_amdgcn_rsqf(ss * (1.0f / 128.0f) + NORM_EPS);
#pragma unroll
            for (int np = 0; np < 4; ++np) { const f32x4 va = o[gi][2 * np] * rn * anwv[2 * np], vb = o[gi][2 * np + 1] * rn * anwv[2 * np + 1];
                u32x4 ww; ww.x = cvtpk(va[0], va[1]); ww.y = cvtpk(va[2], va[3]); ww.z = cvtpk(vb[0], vb[1]); ww.w = cvtpk(vb[2], vb[3]); if (!dry) *(u32x4*)(qrow + 32 * np + 8 * g) = ww; }
        }
    }
}

#ifndef PROBE_PHASE
#define PROBE_PHASE -1
#endif
#define REP_BEGIN(k) for (int rep_ = (PROBE_PHASE == (k)) ? 0 : 1; rep_ < 2; ++rep_) { const bool dry = (rep_ == 0) && (a.dry != 0); (void)dry; \
    int tid = threadIdx.x; asm volatile("" : "+v"(tid)); const int lane = tid & 63, wave = __builtin_amdgcn_readfirstlane(tid >> 6); \
    const int gw = vcu * NWAVES + wave, gt = vcu * (NWAVES * 64) + tid; (void)lane; (void)wave; (void)gw; (void)gt;
#define REP_END }

__global__ void __launch_bounds__(NWAVES * 64, 2) hymba_fwd(Args a) {
    extern __shared__ __attribute__((aligned(16))) unsigned char lds_raw[];
    LAS unsigned char* lds = (LAS unsigned char*)lds_raw;
    volatile LAS unsigned* MISC = (volatile LAS unsigned*)(lds + MISC_OFF);
    const int tid = threadIdx.x, lane = tid & 63, wave = __builtin_amdgcn_readfirstlane(tid >> 6);
    const int G = gridDim.x; const int bx = blockIdx.x; const int vcu = (G % 8 == 0) ? (bx % 8) * (G / 8) + bx / 8 : bx;
    unsigned char* ws = a.ws;
    unsigned* ctl = (unsigned*)(ws + WS_CTL);
    float* gli = (float*)(ws + WS_GLI); float* glf = (float*)(ws + WS_GLF); float* sumsq = (float*)(ws + WS_SUMSQ);
    float* msc_g = (float*)(ws + WS_MSC); float* msc_ml = msc_g + 512; float* msc_mp = msc_g + 1024;
    float* ncb = (float*)(ws + WS_NC);
    float* rcos = (float*)(ws + WS_COS); float* rsin = (float*)(ws + WS_SIN);
    bf16* WinT = (bf16*)(ws + WS_WIN); bf16* kvT = (bf16*)(ws + WS_KV); bf16* Ub = (bf16*)(ws + WS_U); bf16* H1b = (bf16*)(ws + WS_U);
    bf16* proj = (bf16*)(ws + WS_PROJ); bf16* FF = (bf16*)(ws + WS_PROJ);
    bf16* op0 = (bf16*)(ws + WS_OP0); bf16* op1 = (bf16*)(ws + WS_OP1); float* pl0 = (float*)(ws + WS_PL0); float* pl1 = (float*)(ws + WS_PL1);
    bf16* WoutT = (bf16*)(ws + WS_WOUT); bf16* WguT = (bf16*)(ws + WS_WGU); bf16* WdnT = (bf16*)(ws + WS_WDN);

    for (int u = tid; u < (LDS_BYTES - MISC_OFF) / 4; u += NWAVES * 64) ((LAS unsigned*)(lds + MISC_OFF))[u] = 0u;
    __syncthreads();
    XcdBarrier bar = xcd_barrier_post(ctl + CW_BAR, MISC + 8);
    const int NGW = G * NWAVES, NGT = G * NWAVES * 64;

    REP_BEGIN(0)
        for (int i = gt; i < MTOK; i += NGT) sumsq[i] = 0.f;
        for (int i = gt; i < SEQ * 64; i += NGT) {
            const int pos = i >> 6, fi = i & 63;
            const float invf = (float)exp2(-(double)fi * (13.287712379549449 / 64.0));
            const float ang = (float)pos * invf;
            const double rev = (double)ang * 0.15915494309189535; const double fr_ = rev - rint(rev);
            const float ar = (float)(fr_ * 6.283185307179586);
            rcos[i] = cosf(ar); rsin[i] = sinf(ar);
        }
        {
            LAS float* scr = (LAS float*)(lds + wave * 16384);
            constexpr int I_IN = (DM / 64) * (NPROJ / 32), I_OUT = (DM / 64) * (DM / 32), I_GU = (DM / 64) * (NGU / 32), I_DN = (DFF / 64) * (DM / 32);
            constexpr int NITEMS = I_IN + I_OUT + I_GU;
            auto decode = [&](int it) -> TItem {
                TItem t; int r = it;
                if (r < I_IN) { const int nblk = NPROJ / 32, kb = r / nblk, nb = r % nblk; t = TItem{a.w_in, WinT, nullptr, INW, DM, win_src_col(nb * 32), nb * 32, kb * 64, 0}; return t; } r -= I_IN;
                if (r < I_OUT) { const int nblk = DM / 32, kb = r / nblk, nb = r % nblk; t = TItem{a.w_out, WoutT, nullptr, DM, DM, nb * 32, nb * 32, kb * 64, 1}; return t; } r -= I_OUT;
                { const int nblk = NGU / 32, kb = r / nblk, nb = r % nblk; const int nd = nb * 32, pn = nd >> 8, j = nd & 255;
                    t = TItem{(j < 128) ? a.w_gate : a.w_up, WguT, a.norm2_w, DFF, DM, pn * 128 + (j & 127), nd, kb * 64, 0}; return t; }
            };
            int it = gw;
            if (it < NITEMS) {
                TItem cur = decode(it); f32x4 vc[8]; float kc[8]; titem_load(cur, vc, kc, a.norm2_w, lane);
                for (;;) {
                    const int nx = it + NGW; const bool more = nx < NITEMS;
                    f32x4 vn[8]; float kn[8];
                    const TItem nt = decode(more ? nx : it); titem_load(nt, vn, kn, a.norm2_w, lane);
                    titem_finish(cur, vc, kc, scr, lane);
                    if (!more) break;
                    cur = nt; it = nx;
#pragma unroll
                    for (int i = 0; i < 8; ++i) { vc[i] = vn[i]; kc[i] = kn[i]; }
                }
            }
        }
        __syncthreads();
        LAS float* wg = (LAS float*)lds;
        for (int k = tid; k < DM; k += NWAVES * 64) { const f32x4 g0 = *(const f32x4*)(a.w_in + (size_t)k * INW + 3072), g1 = *(const f32x4*)(a.w_in + (size_t)k * INW + 3076);
            wg[0 * DM + k] = g0[0]; wg[1 * DM + k] = g0[1]; wg[2 * DM + k] = g0[2]; wg[3 * DM + k] = g0[3];
            wg[4 * DM + k] = g1[0]; wg[5 * DM + k] = g1[1]; wg[6 * DM + k] = g1[2]; wg[7 * DM + k] = g1[3]; }
        __syncthreads();
        f32x4 w1v[8];
#pragma unroll
        for (int j = 0; j < 8; ++j) w1v[j] = ((const f32x4*)a.norm1_w)[lane + 64 * j];
        for (int m = gw; m < MTOK; m += NGW) {
            const f32x4* xr = (const f32x4*)(a.x + (size_t)m * DM) + lane;
            f32x4 v[8]; float s = 0.f;
#pragma unroll
            for (int j = 0; j < 8; ++j) { v[j] = __builtin_nontemporal_load(xr + 64 * j); s += (v[j][0] * v[j][0] + v[j][1] * v[j][1]) + (v[j][2] * v[j][2] + v[j][3] * v[j][3]); }
            const float rstd = __builtin_amdgcn_rsqf(wave_sum(s) * (1.0f / DM) + NORM_EPS);
            u32x2* o8 = (u32x2*)(Ub + (size_t)m * DM) + lane;
#pragma unroll
            for (int j = 0; j < 8; ++j) { v[j] = v[j] * rstd * w1v[j]; u32x2 w; w.x = cvtpk(v[j][0], v[j][1]); w.y = cvtpk(v[j][2], v[j][3]); o8[64 * j] = w; }
            float z = 0.f;
#pragma unroll 1
            for (int gi = 0; gi < 8; ++gi) { float t = 0.f;
#pragma unroll
                for (int j = 0; j < 8; ++j) { const f32x4 w4 = *(const LAS f32x4*)(wg + gi * DM + 256 * j + 4 * lane); t += (v[j][0] * w4[0] + v[j][1] * w4[1]) + (v[j][2] * w4[2] + v[j][3] * w4[3]); }
                t = wave_sum(t); z = (lane == gi) ? t : z; }
            if (lane < 8) {
                const int hh = lane & 3;
                if (lane < 4) { gli[m * 4 + hh] = 15.0f * tanhf((z + a.igate_b[hh]) * (1.0f / 15.0f)); }
                else { const float fp = 15.0f * tanhf((z + a.fgate_b[hh]) * (1.0f / 15.0f)); glf[m * 4 + hh] = -log1pf(expf(-fp)); }
            }
        }
    REP_END
    xcd_barrier(bar);

    REP_BEGIN(1)
        pg8::Gemm g{Ub, WinT, MTOK, NPROJ, DM, DM}; pg8::StaticOrder S; S.init(MTOK, NPROJ, G, bx);
        pg8::EpiBf16 E{proj, NPROJ};
        pg8::gemm_phase<pg8::EpiBf16, true>(lds, g, S, E);
    REP_END
    xcd_barrier(bar);

    REP_BEGIN(2)
        {
            const int c0 = 4 * (tid & 15), rstride = NGT >> 4;
            for (int which = 0; which < 2; ++which) {
                const float* nw = which ? a.k_norm_w : a.q_norm_w; const int colb = which ? PC_AK : PC_AQ;
                const f32x4 w1 = *(const f32x4*)(nw + c0), w2 = *(const f32x4*)(nw + 64 + c0);
                for (int idx0 = gt >> 4; idx0 < MTOK * 8; idx0 += 4 * rstride) {
                    u32x2 r1[4], r2[4]; f32x4 cs[4], sn[4];
#pragma unroll
                    for (int q = 0; q < 4; ++q) { const int idx = idx0 + q * rstride;
                        if (idx < MTOK * 8) { const int m = idx >> 3, hh = idx & 7, pos = m & (SEQ - 1); const bf16* kp = proj + (size_t)m * NPROJ + colb + hh * 128;
                            r1[q] = *(const u32x2*)(kp + c0); r2[q] = *(const u32x2*)(kp + 64 + c0); cs[q] = *(const f32x4*)(rcos + pos * 64 + c0); sn[q] = *(const f32x4*)(rsin + pos * 64 + c0); } }
#pragma unroll
                    for (int q = 0; q < 4; ++q) { const int idx = idx0 + q * rstride;
                        if (idx < MTOK * 8) { const int m = idx >> 3, hh = idx & 7; bf16* kp = proj + (size_t)m * NPROJ + colb + hh * 128;
                            float x1[4] = {bf_lo(r1[q].x), bf_hi(r1[q].x), bf_lo(r1[q].y), bf_hi(r1[q].y)}, x2[4] = {bf_lo(r2[q].x), bf_hi(r2[q].x), bf_lo(r2[q].y), bf_hi(r2[q].y)};
                            float ss = 0.f;
#pragma unroll
                            for (int e = 0; e < 4; ++e) ss += x1[e] * x1[e] + x2[e] * x2[e];
                            ss = row16_sum(ss);
                            const float rk = __builtin_amdgcn_rsqf(ss * (1.0f / 128.0f) + NORM_EPS);
                            float o1[4], o2[4];
#pragma unroll
                            for (int e = 0; e < 4; ++e) { const float y1 = x1[e] * rk * w1[e], y2 = x2[e] * rk * w2[e]; o1[e] = y1 * cs[q][e] - y2 * sn[q][e]; o2[e] = y2 * cs[q][e] + y1 * sn[q][e]; }
                            u32x2 wv; wv.x = cvtpk(o1[0], o1[1]); wv.y = cvtpk(o1[2], o1[3]); if (!dry) *(u32x2*)(kp + c0) = wv;
                            wv.x = cvtpk(o2[0], o2[1]); wv.y = cvtpk(o2[2], o2[3]); if (!dry) *(u32x2*)(kp + 64 + c0) = wv; } }
                }
            }
        }
        LAS unsigned char* KW = lds; LAS unsigned char* VT = lds + 36864;
        const int g = lane >> 4, qp = (lane & 15) >> 2, p = lane & 3;
        for (int u = vcu; u < 256; u += G) {
            const int b = u >> 7, h = (u >> 5) & 3, c0 = 2 * (u & 31);
            const int tok = b * SEQ + c0 * 64 + lane;
            const float liA = gli[tok * 4 + h], lfA = glf[tok * 4 + h], liB = gli[(tok + 64) * 4 + h], lfB = glf[(tok + 64) * 4 + h];
            u32x4 rawA[2][4], rawB[2][4], vA[4], vB[4];
            conv_issue(proj, b, c0, PC_MK + h * 128, tid, rawA); v_issue(proj, b, c0, h, tid, vA);
            conv_issue(proj, b, c0 + 1, PC_MK + h * 128, tid, rawB); v_issue(proj, b, c0 + 1, h, tid, vB);
            const float cfA = scan_add64(lfA, lane), cfB = scan_add64(lfB, lane);
            const float gA = __shfl(cfA, 63), gB = __shfl(cfB, 63);
            const float avA = gA - cfA + liA + gB, avB = gB - cfB + liB;
            const float ml = wave_max(fmaxf(avA, avB));
            const float wA = __expf(avA - ml), wB = __expf(avB - ml);
            if (tid == 0) { msc_g[u] = gA + gB; msc_ml[u] = ml; }
            conv_finish<true>(rawA, a.conv_w, a.conv_b, c0, 512 + h * 128, 1.0f, wA, KW, tid); v_store(vA, VT, tid);
            conv_finish<true>(rawB, a.conv_w, a.conv_b, c0 + 1, 512 + h * 128, 1.0f, wB, KW + 64 * 288, tid); v_store(vB, VT + 64 * 544, tid);
            __syncthreads();
            f32x4 acc[8][2];
#pragma unroll
            for (int df = 0; df < 8; ++df) { acc[df][0] = (f32x4){0.f, 0.f, 0.f, 0.f}; acc[df][1] = (f32x4){0.f, 0.f, 0.f, 0.f}; }
#pragma unroll
            for (int kk = 0; kk < 4; ++kk) {
                bf16x8 bfr[2];
#pragma unroll
                for (int ef = 0; ef < 2; ++ef) { const int col = 32 * wave + 16 * ef + 4 * p;
                    bfr[ef] = cat4(vtr(VT + (32 * kk + 4 * g + qp) * 544 + col * 2), vtr(VT + (32 * kk + 16 + 4 * g + qp) * 544 + col * 2)); }
#pragma unroll
                for (int df = 0; df < 8; ++df) { const int col = 16 * df + 4 * p;
                    const bf16x8 af = cat4(vtr(KW + (32 * kk + 4 * g + qp) * 288 + col * 2), vtr(KW + (32 * kk + 16 + 4 * g + qp) * 288 + col * 2));
                    acc[df][0] = MFMA16(af, bfr[0], acc[df][0]); acc[df][1] = MFMA16(af, bfr[1], acc[df][1]); }
            }
#pragma unroll
            for (int ef = 0; ef < 2; ++ef) { const int e = 32 * wave + 16 * ef + (lane & 15);
#pragma unroll
                for (int df = 0; df < 8; ++df) { const f32x4 v = acc[df][ef]; u32x2 w; w.x = cvtpk(v[0], v[1]); w.y = cvtpk(v[2], v[3]);
                    *(u32x2*)(kvT + ((size_t)u * 256 + e) * 128 + 16 * df + 4 * g) = w; } }
            if (tid < 128) { float nsum = 0.f;
#pragma unroll 8
                for (int l = 0; l < 128; ++l) nsum += __uint_as_float((unsigned)(*(const LAS unsigned short*)(KW + l * 288 + tid * 2)) << 16);
                ncb[u * 128 + tid] = nsum; }
            __syncthreads();
        }
    REP_END
    xcd_barrier(bar);

    REP_BEGIN(3)
        LAS float* sg = (LAS float*)lds; LAS float* sml = sg + 256;
        for (int i = tid; i < 256; i += NWAVES * 64) { sg[i] = msc_g[i]; sml[i] = msc_ml[i]; }
        __syncthreads();
        for (int id = gt; id < 8 * 16384; id += NGT) {
            const int bh = id >> 14, pi = id & 16383;
            unsigned* base = (unsigned*)kvT + (size_t)bh * 32 * 16384 + pi;
            float c0 = 0.f, c1 = 0.f, m = 0.f;
            unsigned xv[32];
#pragma unroll
            for (int i = 0; i < 32; ++i) xv[i] = base[(size_t)i * 16384];
#pragma unroll
            for (int i = 0; i < 32; ++i) {
                const float gg = sg[bh * 32 + i], ml = sml[bh * 32 + i];
                const float mn = fmaxf(gg + m, ml), so = __expf(gg + m - mn), sn = __expf(ml - mn);
                if (!dry) base[(size_t)i * 16384] = cvtpk(c0, c1);
                c0 = so * c0 + sn * bf_lo(xv[i]); c1 = so * c1 + sn * bf_hi(xv[i]); m = mn;
            }
        }
        for (int id = gt; id < 8 * 128; id += NGT) {
            const int bh = id >> 7, dd = id & 127; float n = 0.f, m = 0.f;
            float* nb_ = ncb + (size_t)bh * 32 * 128 + dd;
            float xv[32];
#pragma unroll
            for (int i = 0; i < 32; ++i) xv[i] = nb_[i * 128];
#pragma unroll
            for (int i = 0; i < 32; ++i) {
                const float gg = sg[bh * 32 + i], ml = sml[bh * 32 + i];
                const float mn = fmaxf(gg + m, ml), so = __expf(gg + m - mn), sn = __expf(ml - mn);
                if (!dry) nb_[i * 128] = n;
                if (dd == 0) msc_mp[bh * 32 + i] = m;
                n = so * n + sn * xv[i]; m = mn;
            }
        }
        __syncthreads();
    REP_END
    REP_BEGIN(4)
        float mref;
        { const float bq = wave_max(fmaxf(fabsf(a.q_norm_w[lane]), fabsf(a.q_norm_w[64 + lane]))), bk = wave_max(fmaxf(fabsf(a.k_norm_w[lane]), fabsf(a.k_norm_w[64 + lane])));
          mref = fminf(128.0f * 1.02f * 0.08838834764831845f * 1.4426950408889634f * bq * bk, 60.0f); }
        for (int pidx = vcu; pidx < 512; pidx += G) {
            AUnit ua, ub;
            { const int u = pidx; ua = AUnit{u >> 8, (u >> 5) & 7, 4, (u >> 3) & 3, u & 7, op0, pl0}; }
            { const int v = pidx; const int bb = v >> 8; ub = AUnit{bb, (v >> 5) & 7, 16, (v >> 1) & 15, (v ^ bb) & 1, op1, pl1}; }
            attn_pair<false>(proj, rcos, rsin, a.q_norm_w, mref, a.attn_norm_w, ua, ub, lds, nullptr, nullptr, tid, dry);
        }
    REP_END
    xcd_barrier(bar);

    REP_BEGIN(5)
        float mref;
        { const float bq = wave_max(fmaxf(fabsf(a.q_norm_w[lane]), fabsf(a.q_norm_w[64 + lane]))), bk = wave_max(fmaxf(fabsf(a.k_norm_w[lane]), fabsf(a.k_norm_w[64 + lane])));
          mref = fminf(128.0f * 1.02f * 0.08838834764831845f * 1.4426950408889634f * bq * bk, 60.0f); }
        LAS unsigned char* QT = lds; LAS unsigned char* KT = lds + 18432; LAS unsigned char* VT = lds + 36864;
        LAS float* NP = (LAS float*)(lds + 71680); LAS float* XCH = (LAS float*)(lds + 72192); LAS unsigned char* CP = lds + 72704;
        LAS float* WL = (LAS float*)(lds + 146432);
        const int j = lane & 15, g = lane >> 4, qp = j >> 2, p = lane & 3;
        const int tf = wave & 3, eh = wave >> 2;
        for (int u = vcu; u < 256; u += G) {
            const int b = u >> 7, h = (u >> 5) & 3;
            float mprev = msc_mp[u];
            const bf16* csrc = kvT + (size_t)u * 256 * 128 + (size_t)(tid >> 4) * 128 + (tid & 15) * 8;
#pragma unroll
            for (int hh = 0; hh < 2; ++hh) {
                const int c = 2 * (u & 31) + hh;
                const int tok = b * SEQ + c * 64 + lane;
                const float li = gli[tok * 4 + h], lf = glf[tok * 4 + h];
                u32x4 rawq[2][4], rawk[2][4], vv[4], cv[8];
                conv_issue(proj, b, c, PC_MQ + h * 128, tid, rawq);
                conv_issue(proj, b, c, PC_MK + h * 128, tid, rawk);
                v_issue(proj, b, c, h, tid, vv);
                float npv = 0.f;
                if (hh == 0) { if (tid < 128) npv = ncb[u * 128 + tid]; }
                const float cf = scan_add64(lf, lane);
                const float bvec = li - cf;
                const float pm = scan_max64(bvec, lane);
                const float Mv = fmaxf(mprev, pm);
                const float wiv = __expf(mprev - Mv), emtv = __expf(-cf - Mv);
                float so_u = 0.f, m_u = 0.f;
                if (hh == 0) {
                    const float gsum = __shfl(cf, 63);
                    const float av = gsum + bvec;
                    const float mlA = wave_max(av);
                    m_u = fmaxf(gsum + mprev, mlA);
                    so_u = __expf(gsum + mprev - m_u);
                    if (wave == 0) WL[lane] = __expf(av - mlA) * __expf(mlA - m_u);
                }
                conv_finish<false>(rawq, a.conv_w, a.conv_b, c, h * 128, 0.08838834764831845f, 0.f, QT, tid);
                if (hh == 0) {
#pragma unroll
                    for (int it = 0; it < 8; ++it) cv[it] = *(const u32x4*)(csrc + (size_t)it * 32 * 128);
                }
                conv_finish<false>(rawk, a.conv_w, a.conv_b, c, 512 + h * 128, 1.0f, 0.f, KT, tid);
                v_store(vv, VT, tid);
                if (hh == 0) {
#pragma unroll
                    for (int it = 0; it < 8; ++it) *(LAS u32x4*)(CP + (it * 32 + (tid >> 4)) * 288 + (tid & 15) * 16) = cv[it];
                    if (tid < 128) NP[tid] = npv;
                }
                const int t_ = 16 * (wave & 3) + j;
                const bf16* orow_ = proj + (size_t)(b * SEQ + c * 64 + t_) * NPROJ;
                u32x2 mo_pre[8];
#pragma unroll
                for (int ef = 0; ef < 8; ++ef) mo_pre[ef] = *(const u32x2*)(orow_ + PC_MO + h * 256 + 128 * eh + 16 * ef + 4 * g);
                __syncthreads();
                const int t = 16 * tf + j;
                const float M_t = __shfl(Mv, t), wi_t = __shfl(wiv, t), emt_t = __shfl(emtv, t);
                bf16x8 qf[4];
#pragma unroll
                for (int ks = 0; ks < 4; ++ks) qf[ks] = *(const LAS bf16x8*)(QT + t * 288 + (32 * ks + 8 * g) * 2);
                float sp[4][4]; float rowsum = 0.f;
#pragma unroll
                for (int sf = 0; sf < 4; ++sf) {
                    f32x4 sa = {0.f, 0.f, 0.f, 0.f};
#pragma unroll
                    for (int ks = 0; ks < 4; ++ks) { const bf16x8 kfr = *(const LAS bf16x8*)(KT + (16 * sf + j) * 288 + (32 * ks + 8 * g) * 2); sa = MFMA16(kfr, qf[ks], sa); }
#pragma unroll
                    for (int rg = 0; rg < 4; ++rg) { const int sidx = 16 * sf + 4 * g + rg; const float bs = __shfl(bvec, sidx);
                        const float pv = (sidx <= t) ? __expf(bs - M_t) : 0.f; sp[sf][rg] = sa[rg] * pv; rowsum += sp[sf][rg]; }
                }
                bf16x8 pb[2];
#pragma unroll
                for (int kk = 0; kk < 2; ++kk) { float tmp[8] = {sp[2 * kk][0], sp[2 * kk][1], sp[2 * kk][2], sp[2 * kk][3], sp[2 * kk + 1][0], sp[2 * kk + 1][1], sp[2 * kk + 1][2], sp[2 * kk + 1][3]};
                    const u32x4 w = pack8(tmp); pb[kk] = __builtin_bit_cast(bf16x8, w); }
                f32x4 ai[8], ae[8];
#pragma unroll
                for (int ef = 0; ef < 8; ++ef) { ai[ef] = (f32x4){0.f, 0.f, 0.f, 0.f}; ae[ef] = (f32x4){0.f, 0.f, 0.f, 0.f}; }
#pragma unroll
                for (int kk = 0; kk < 2; ++kk) {
#pragma unroll
                    for (int ef = 0; ef < 8; ++ef) { const int col = 128 * eh + 16 * ef + 4 * p;
                        const bf16x8 af = cat4(vtr(VT + (32 * kk + 4 * g + qp) * 544 + col * 2), vtr(VT + (32 * kk + 16 + 4 * g + qp) * 544 + col * 2));
                        ai[ef] = MFMA16(af, pb[kk], ai[ef]); }
                }
#pragma unroll
                for (int ef = 0; ef < 8; ++ef) {
#pragma unroll
                    for (int ks = 0; ks < 4; ++ks) { const bf16x8 cfr = *(const LAS bf16x8*)(CP + (128 * eh + 16 * ef + j) * 288 + (32 * ks + 8 * g) * 2); ae[ef] = MFMA16(cfr, qf[ks], ae[ef]); }
                }
                float qn = 0.f;
#pragma unroll
                for (int ks = 0; ks < 4; ++ks) { float qv[8]; unpack8(__builtin_bit_cast(u32x4, qf[ks]), qv);
#pragma unroll
                    for (int e = 0; e < 8; ++e) qn += qv[e] * NP[32 * ks + 8 * g + e]; }
                qn = xg_sum(qn);
                rowsum = xg_sum(rowsum);
                const float den = wi_t * qn + rowsum;
                const float dinv = __builtin_amdgcn_rcpf(fmaxf(fabsf(den), emt_t));
                float ssq = 0.f;
#pragma unroll
                for (int ef = 0; ef < 8; ++ef) { ai[ef] = (ae[ef] * wi_t + ai[ef]) * dinv; ssq += (ai[ef][0] * ai[ef][0] + ai[ef][1] * ai[ef][1]) + (ai[ef][2] * ai[ef][2] + ai[ef][3] * ai[ef][3]); }
                f32x4 nwv[8];
#pragma unroll
                for (int ef = 0; ef < 8; ++ef) nwv[ef] = *(const f32x4*)(a.mlstm_norm_w + h * 256 + 128 * eh + 16 * ef + 4 * g);
                ssq = xg_sum(ssq);
                if (g == 0) XCH[eh * 64 + t] = ssq;
                __syncthreads();
                const float rn = __builtin_amdgcn_rsqf((XCH[t] + XCH[64 + t]) * (1.0f / 256.0f) + NORM_EPS);
                bf16* orow = proj + (size_t)(b * SEQ + c * 64 + t) * NPROJ;
#pragma unroll
                for (int k2 = 0; k2 < 4; ++k2) { float r8[8];
#pragma unroll
                    for (int hi = 0; hi < 2; ++hi) { const int ef = 2 * k2 + hi; const f32x4 nw = nwv[ef]; const u32x2 mo = mo_pre[ef];
                        const float mof[4] = {bf_lo(mo.x), bf_hi(mo.x), bf_lo(mo.y), bf_hi(mo.y)};
#pragma unroll
                        for (int e2 = 0; e2 < 4; ++e2) r8[4 * hi + e2] = ai[ef][e2] * rn * nw[e2] * __builtin_amdgcn_rcpf(1.0f + __expf(-mof[e2])); }
                    if (!dry) *(u32x4*)(orow + PC_MV + h * 256 + 128 * eh + 32 * k2 + 8 * g) = pack8(r8); }
                if (hh == 0) {
                    f32x4 acc[8][2]; f32x4 accn = {0.f, 0.f, 0.f, 0.f};
#pragma unroll
                    for (int df = 0; df < 8; ++df) { acc[df][0] = (f32x4){0.f, 0.f, 0.f, 0.f}; acc[df][1] = (f32x4){0.f, 0.f, 0.f, 0.f}; }
#pragma unroll
                    for (int kk = 0; kk < 2; ++kk) {
                        const f32x4 wlo = *(const LAS f32x4*)(WL + 32 * kk + 4 * g), whi = *(const LAS f32x4*)(WL + 32 * kk + 16 + 4 * g);
                        const float wrow[8] = {wlo[0], wlo[1], wlo[2], wlo[3], whi[0], whi[1], whi[2], whi[3]};
                        bf16x8 bfr[2];
#pragma unroll
                        for (int ef = 0; ef < 2; ++ef) { const int col = 32 * wave + 16 * ef + 4 * p;
                            const bf16x8 raw = cat4(vtr(VT + (32 * kk + 4 * g + qp) * 544 + col * 2), vtr(VT + (32 * kk + 16 + 4 * g + qp) * 544 + col * 2));
                            float fv[8]; unpack8(__builtin_bit_cast(u32x4, raw), fv);
#pragma unroll
                            for (int e = 0; e < 8; ++e) fv[e] *= wrow[e];
                            const u32x4 pw = pack8(fv); bfr[ef] = __builtin_bit_cast(bf16x8, pw); }
                        float wc0[8];
#pragma unroll
                        for (int e = 0; e < 8; ++e) wc0[e] = (j == 0) ? wrow[e] : 0.f;
                        const u32x4 pwn = pack8(wc0); const bf16x8 bwn = __builtin_bit_cast(bf16x8, pwn);
#pragma unroll
                        for (int df = 0; df < 8; ++df) { const int col = 16 * df + 4 * p;
                            const bf16x8 af = cat4(vtr(KT + (32 * kk + 4 * g + qp) * 288 + col * 2), vtr(KT + (32 * kk + 16 + 4 * g + qp) * 288 + col * 2));
                            acc[df][0] = MFMA16(af, bfr[0], acc[df][0]); acc[df][1] = MFMA16(af, bfr[1], acc[df][1]);
                            if (df == wave) accn = MFMA16(af, bwn, accn); }
                    }
#pragma unroll
                    for (int ef = 0; ef < 2; ++ef) { const int e = 32 * wave + 16 * ef + j;
#pragma unroll
                        for (int df = 0; df < 8; ++df) { LAS u32x2* cp_ = (LAS u32x2*)(CP + e * 288 + (16 * df + 4 * g) * 2); const u32x2 old = *cp_; const f32x4 v = acc[df][ef];
                            u32x2 w; w.x = cvtpk(so_u * bf_lo(old.x) + v[0], so_u * bf_hi(old.x) + v[1]); w.y = cvtpk(so_u * bf_lo(old.y) + v[2], so_u * bf_hi(old.y) + v[3]); *cp_ = w; } }
                    if (j == 0) {
#pragma unroll
                        for (int rg = 0; rg < 4; ++rg) { const int d_ = 16 * wave + 4 * g + rg; NP[d_] = so_u * NP[d_] + accn[rg]; } }
                    mprev = m_u;
                }
                __syncthreads();
            }
        }
        for (int pidx = vcu; pidx < 256; pidx += G) {
            const AUnit ua{0, (pidx >> 5) & 7, 1, 0, pidx & 31, op0, pl0}, ub{1, (pidx >> 5) & 7, 1, 0, pidx & 31, op0, pl0};
            attn_pair<true>(proj, rcos, rsin, a.q_norm_w, mref, a.attn_norm_w, ua, ub, lds, op1, pl1, tid, dry);
        }
    REP_END
    xcd_barrier(bar);

    REP_BEGIN(6)
        pg8::Gemm g{proj + PC_MV, WoutT, MTOK, DM, DM, NPROJ}; pg8::StaticOrder S; S.init(MTOK, DM, G, bx);
        pg8::EpiRes1 E{a.x, a.out, H1b, sumsq, DM, dry};
        pg8::gemm_phase<pg8::EpiRes1, false>(lds, g, S, E);
    REP_END
    xcd_barrier(bar);

    REP_BEGIN(7)
        pg8::Gemm g{H1b, WguT, MTOK, NGU, DM, DM}; pg8::StaticOrder S; S.init(MTOK, NGU, G, bx);
        LAS float* rsl = (LAS float*)(lds + RING_BYTES);
        {
            float sv[8]; unsigned okm = 0u;
#pragma unroll
            for (int i = 0; i < 8; ++i) { pg8::Unit uu; const bool ok = S.next(i, uu); okm |= (ok ? 1u : 0u) << i; sv[i] = sumsq[(ok ? uu.pm : 0) * 256 + (tid & 255)]; }
#pragma unroll
            for (int i = 0; i < 8; ++i) if (tid < 256 && ((okm >> i) & 1u)) rsl[i * 256 + tid] = __builtin_amdgcn_rsqf(sv[i] * (1.0f / DM) + NORM_EPS);
        }
        __syncthreads();
        pg8::EpiSwiGLU E{FF, DFF, rsl, sumsq};
        pg8::gemm_phase<pg8::EpiSwiGLU, true>(lds, g, S, E);
        if (rep_ == 1) {
            const int nfull = (MTOK / 256) * (NGU / 256) - 5 * G;
            const int nidle = G - nfull;
            if (G == 256 ? (bx >= nfull) : true) {
                LAS float* scr = (LAS float*)(lds + wave * 16384);
                constexpr int I_DN = (DFF / 64) * (DM / 32);
                const int w0 = (G == 256) ? (bx - nfull) * NWAVES + wave : gw, nw = (G == 256) ? nidle * NWAVES : NGW;
                for (int it = w0; it < I_DN; it += nw) { const int nblk = DM / 32, kb = it / nblk, nb = it % nblk;
                    const TItem t{a.w_down, WdnT, nullptr, DM, DFF, nb * 32, nb * 32, kb * 64, 0}; f32x4 v[8]; float kq[8]; titem_load(t, v, kq, a.norm2_w, lane); titem_finish(t, v, kq, scr, lane); }
            }
        }
    REP_END
    xcd_barrier(bar);

    REP_BEGIN(8)
        pg8::Gemm g{FF, WdnT, MTOK, DM, DFF, DFF}; pg8::StaticOrder S; S.init(MTOK, DM, G, bx);
        pg8::EpiRes2 E{H1b, a.out, DM, dry};
        pg8::gemm_phase<pg8::EpiRes2, false>(lds, g, S, E);
    REP_END
}

extern "C" void kernel_launch(void* const* d_in, const int* in_sizes, int n_in, void* d_out, int out_size, void* d_ws, size_t ws_size, hipStream_t stream) {
    static int grid = 0;
    if (grid == 0) {
        if (n_in != 16 || in_sizes[0] != MTOK * DM || out_size != MTOK * DM || ws_size < WS_END) { fprintf(stderr, "kernel_launch: unexpected shapes (n_in %d in0 %d out %d ws %zu)\n", n_in, n_in > 0 ? in_sizes[0] : -1, out_size, ws_size); grid = -1; return; }
        int dev = 0, cus = 0;
        if (hipGetDevice(&dev) != hipSuccess || hipDeviceGetAttribute(&cus, hipDeviceAttributeMultiprocessorCount, dev) != hipSuccess || cus <= 0) cus = 256;
        if (hipFuncSetAttribute((const void*)hymba_fwd, hipFuncAttributeMaxDynamicSharedMemorySize, LDS_BYTES) != hipSuccess) { fprintf(stderr, "kernel_launch: hipFuncSetAttribute failed\n"); grid = -1; return; }
        (void)hipGetLastError();
        grid = cus;
    }
    if (grid < 0) return;
    if (hipMemsetAsync((char*)d_ws + WS_CTL, 0, CTL_ZERO_BYTES, stream) != hipSuccess) { fprintf(stderr, "kernel_launch: memset failed\n"); return; }
    Args a{};
    a.x = (const float*)d_in[0]; a.norm1_w = (const float*)d_in[1]; a.w_in = (const float*)d_in[2]; a.conv_w = (const float*)d_in[3]; a.conv_b = (const float*)d_in[4];
    a.igate_b = (const float*)d_in[5]; a.fgate_b = (const float*)d_in[6]; a.q_norm_w = (const float*)d_in[7]; a.k_norm_w = (const float*)d_in[8];
    a.mlstm_norm_w = (const float*)d_in[9]; a.attn_norm_w = (const float*)d_in[10]; a.w_out = (const float*)d_in[11]; a.norm2_w = (const float*)d_in[12];
    a.w_gate = (const float*)d_in[13]; a.w_up = (const float*)d_in[14]; a.w_down = (const float*)d_in[15];
    a.out = (float*)d_out; a.ws = (unsigned char*)d_ws; a.dry = (PROBE_PHASE >= 0) ? 1 : 0;
    hipLaunchKernelGGL(hymba_fwd, dim3(grid), dim3(NWAVES * 64), LDS_BYTES, stream, a);
}
```

```cpp
#include <hip/hip_runtime.h>
#include <cstdio>
#include <cstdint>

#define LAS __attribute__((address_space(3)))
#define GAS __attribute__((address_space(1)))
typedef unsigned short bf16;
typedef short bf16x8 __attribute__((ext_vector_type(8)));
typedef short s16x4 __attribute__((ext_vector_type(4)));
typedef float f32x4 __attribute__((ext_vector_type(4)));
typedef float f32x2 __attribute__((ext_vector_type(2)));
typedef unsigned u32x4 __attribute__((ext_vector_type(4)));
typedef unsigned u32x2 __attribute__((ext_vector_type(2)));
typedef __bf16 bf16x2_t __attribute__((ext_vector_type(2)));

constexpr int BATCH = 2, SEQ = 4096, DM = 2048, MTOK = BATCH * SEQ;
constexpr int INW = 6152, NPROJ = 6144, DFF = 5632, NGU = 2 * DFF;
constexpr int PC_MQ = 0, PC_MK = 512, PC_MO = 1024, PC_MV = 2048, PC_AQ = 3072, PC_AK = 4096, PC_AV = 5120;
constexpr float NORM_EPS = 1e-6f;
constexpr int NWAVES = 8;

constexpr size_t MiB = 1u << 20;
constexpr size_t WS_CTL = 0, CTL_ZERO_BYTES = 32 * 1024;
constexpr size_t WS_GLI = 1 * MiB;
constexpr size_t WS_GLF = WS_GLI + 128 * 1024;
constexpr size_t WS_SUMSQ = WS_GLF + 128 * 1024;
constexpr size_t WS_MSC = WS_SUMSQ + 32 * 1024;
constexpr size_t WS_NC = WS_MSC + 8 * 1024;
constexpr size_t WS_COS = 2 * MiB, WS_SIN = 3 * MiB;
constexpr size_t WS_RSTD = 5 * MiB;
constexpr size_t WS_WIN = 6 * MiB;
constexpr size_t WS_KV = 6 * MiB;
constexpr size_t WS_U = 30 * MiB;
constexpr size_t WS_PROJ = 62 * MiB;
constexpr size_t WS_WOUT = 158 * MiB;
constexpr size_t WS_WGU = 166 * MiB;
constexpr size_t WS_WDN = 210 * MiB;
constexpr size_t WS_OP0 = 210 * MiB;
constexpr size_t WS_OP1 = 232 * MiB;
constexpr size_t WS_PL0 = 248 * MiB, WS_PL1 = WS_PL0 + 256 * 1024;
constexpr size_t WS_END = 249 * MiB;
constexpr int CW_BAR = 4096;

constexpr int RING_BYTES = 131072;
constexpr int MISC_OFF = 147456 - 256;
constexpr int LDS_BYTES = 151552;

__device__ __forceinline__ unsigned cvtpk(float lo, float hi) { f32x2 v = {lo, hi}; bf16x2_t b = __builtin_convertvector(v, bf16x2_t); return __builtin_bit_cast(unsigned, b); }
__device__ __forceinline__ float bf_lo(unsigned w) { return __uint_as_float(w << 16); }
__device__ __forceinline__ float bf_hi(unsigned w) { return __uint_as_float(w & 0xffff0000u); }
__device__ __forceinline__ void unpack8(u32x4 w, float* f) { f[0] = bf_lo(w.x); f[1] = bf_hi(w.x); f[2] = bf_lo(w.y); f[3] = bf_hi(w.y); f[4] = bf_lo(w.z); f[5] = bf_hi(w.z); f[6] = bf_lo(w.w); f[7] = bf_hi(w.w); }
__device__ __forceinline__ u32x4 pack8(const float* f) { u32x4 w; w.x = cvtpk(f[0], f[1]); w.y = cvtpk(f[2], f[3]); w.z = cvtpk(f[4], f[5]); w.w = cvtpk(f[6], f[7]); return w; }
#define DPP_MOV_F(v, ctrl) __uint_as_float((unsigned)__builtin_amdgcn_mov_dpp((int)__float_as_uint(v), (ctrl), 0xf, 0xf, true))
__device__ __forceinline__ float row16_sum(float v) { v += DPP_MOV_F(v, 0xB1); v += DPP_MOV_F(v, 0x4E); v += DPP_MOV_F(v, 0x124); v += DPP_MOV_F(v, 0x128); return v; }
__device__ __forceinline__ float x16_sum(float v) { const auto r = __builtin_amdgcn_permlane16_swap(__float_as_uint(v), __float_as_uint(v), false, false); return __uint_as_float(r[0]) + __uint_as_float(r[1]); }
__device__ __forceinline__ float x32_sum(float v) { const auto r = __builtin_amdgcn_permlane32_swap(__float_as_uint(v), __float_as_uint(v), false, false); return __uint_as_float(r[0]) + __uint_as_float(r[1]); }
__device__ __forceinline__ float x16_max(float v) { const auto r = __builtin_amdgcn_permlane16_swap(__float_as_uint(v), __float_as_uint(v), false, false); return fmaxf(__uint_as_float(r[0]), __uint_as_float(r[1])); }
__device__ __forceinline__ float x32_max(float v) { const auto r = __builtin_amdgcn_permlane32_swap(__float_as_uint(v), __float_as_uint(v), false, false); return fmaxf(__uint_as_float(r[0]), __uint_as_float(r[1])); }
__device__ __forceinline__ float xg_sum(float v) { return x32_sum(x16_sum(v)); }
__device__ __forceinline__ float xg_max(float v) { return x32_max(x16_max(v)); }
__device__ __forceinline__ float wave_sum(float v) { return xg_sum(row16_sum(v)); }
__device__ __forceinline__ float wave_max(float v) {
#pragma unroll
    for (int o = 1; o < 64; o <<= 1) v = fmaxf(v, __shfl_xor(v, o));
    return v;
}
__device__ __forceinline__ s16x4 vtr(const LAS unsigned char* p) { return __builtin_bit_cast(s16x4, __builtin_amdgcn_ds_read_tr16_b64_v4i16((LAS s16x4*)p)); }
__device__ __forceinline__ bf16x8 cat4(s16x4 a, s16x4 b) { return (bf16x8){a[0], a[1], a[2], a[3], b[0], b[1], b[2], b[3]}; }
#define LDS_WAIT() asm volatile("s_waitcnt lgkmcnt(0)" ::: "memory")
#define VTR_ASM(dst, addr, off) asm volatile("ds_read_b64_tr_b16 %0, %1 offset:%2" : "=v"(dst) : "v"(addr), "n"(off))
#define VTR_WAIT16(a, b) asm volatile("s_waitcnt lgkmcnt(0)" : "+v"(a[0]), "+v"(a[1]), "+v"(a[2]), "+v"(a[3]), "+v"(a[4]), "+v"(a[5]), "+v"(a[6]), "+v"(a[7]), \
                                                             "+v"(b[0]), "+v"(b[1]), "+v"(b[2]), "+v"(b[3]), "+v"(b[4]), "+v"(b[5]), "+v"(b[6]), "+v"(b[7]))
#define VM_WAIT() asm volatile("s_waitcnt vmcnt(0)" ::: "memory")
#define SBAR() __builtin_amdgcn_sched_barrier(0)
#define MFMA16(a, b, c) __builtin_amdgcn_mfma_f32_16x16x32_bf16((a), (b), (c), 0, 0, 0)

namespace pg8 {
constexpr int BM = 256, BK = 64, HALF = 128, HTB = HALF * BK * 2, STAGE_BYTES = 8 * HTB, NXCD = 8, WGM = 8;
__host__ __device__ __forceinline__ int lds_byte(int r, int c) { const int st = (r >> 4) * 2 + (c >> 5), rr = r & 15, cc = c & 31, ob = rr * 64 + cc * 2; return st * 1024 + (ob ^ (((ob >> 9) & 1) << 5)); }
__host__ __device__ __forceinline__ void stage_rc(int b, int& R, int& C) { const int st = b / 1024, sb = b % 1024, swz = sb ^ (((sb >> 9) & 1) << 5); R = (st >> 1) * 16 + swz / 64; C = (st & 1) * 32 + (swz % 64) / 2; }
__host__ __device__ __forceinline__ int perm32(int rho) { const int n = rho >> 4, i = rho & 15; return 8 * (i >> 2) + 4 * n + (i & 3); }
struct Unit { int pm, pn, ord; };
struct Gemm { const bf16* A; const bf16* Bt; int M, N, K, lda; };
struct StaticOrder {
    int nM, nN, nwg, G, c;
    __device__ void init(int M, int N, int G_, int c_) { nM = M / BM; nN = N / BM; nwg = nM * nN; G = G_; c = c_; }
    __device__ bool next(int i, Unit& u) const {
        const long L = (long)i * G + c; if (L >= nwg) return false; u.ord = i;
        int wgid = (int)L; { const int q = nwg / NXCD, r = nwg % NXCD, xcd = wgid % NXCD, off = wgid / NXCD; wgid = (xcd < r ? xcd * (q + 1) : r * (q + 1) + (xcd - r) * q) + off; }
        const int nig = WGM * nN, gid = wgid / nig, fm = gid * WGM, gsz = (nM - fm) < WGM ? (nM - fm) : WGM;
        u.pm = fm + ((wgid % nig) % gsz); u.pn = (wgid % nig) / gsz; return true;
    }
};
struct EpiBf16 {
    static constexpr bool PERM = true, HAS_INIT = false;
    bf16* O; int ldc; const LAS float* rsl; const float* rstd;
    __device__ __forceinline__ void operator()(const f32x4 (&acc)[2][2][4][2], const Unit& u, int wr, int wc, int fr, int fq) const {
        const int row0 = u.pm * BM + wr * 64 + fr, col0 = u.pn * BM + wc * 32 + 8 * fq;
#pragma unroll
        for (int ai = 0; ai < 2; ++ai)
#pragma unroll
            for (int m = 0; m < 4; ++m) { bf16* rowp = O + (size_t)(row0 + ai * HALF + m * 16) * ldc + col0;
                const float rs = (u.ord < 8) ? rsl[u.ord * 256 + ai * HALF + wr * 64 + m * 16 + fr] : rstd[row0 + ai * HALF + m * 16];
#pragma unroll
                for (int bj = 0; bj < 2; ++bj) { const f32x4 v0 = acc[ai][bj][m][0] * rs, v1 = acc[ai][bj][m][1] * rs;
                    u32x4 w; w.x = cvtpk(v0[0], v0[1]); w.y = cvtpk(v0[2], v0[3]); w.z = cvtpk(v1[0], v1[1]); w.w = cvtpk(v1[2], v1[3]);
                    *(u32x4*)(rowp + bj * HALF) = w; } }
    }
};
struct EpiRes1 {
    static constexpr bool PERM = false, HAS_INIT = true;
    const bf16* xres; float* out; bf16* h1b; float* sumsq; int ldc; bool dry;
    __device__ __forceinline__ void init(f32x4 (&acc)[2][2][4][2], const Unit& u, int wr, int wc, int fr, int fq) const {
        const int col0 = u.pn * BM + wc * 32 + ((fq & 1) ? 16 + 4 * (fq - 1) : 4 * fq);
#pragma unroll
        for (int ai = 0; ai < 2; ++ai)
#pragma unroll
            for (int m = 0; m < 4; ++m) { const size_t off = (size_t)(u.pm * BM + ai * HALF + wr * 64 + m * 16 + fr) * ldc + col0;
#pragma unroll
                for (int bj = 0; bj < 2; ++bj) { const u32x4 w = __builtin_nontemporal_load((const u32x4*)(xres + off + bj * HALF));
                    const auto sx = __builtin_amdgcn_permlane16_swap(w.x, w.z, false, false);
                    const auto sy = __builtin_amdgcn_permlane16_swap(w.y, w.w, false, false);
                    acc[ai][bj][m][0] = (f32x4){bf_lo(sx[0]), bf_hi(sx[0]), bf_lo(sy[0]), bf_hi(sy[0])};
                    acc[ai][bj][m][1] = (f32x4){bf_lo(sx[1]), bf_hi(sx[1]), bf_lo(sy[1]), bf_hi(sy[1])}; } }
    }
    __device__ __forceinline__ void operator()(const f32x4 (&acc)[2][2][4][2], const Unit& u, int wr, int wc, int fr, int fq) const {
        const int col0 = u.pn * BM + wc * 32 + 4 * fq;
#pragma unroll
        for (int ai = 0; ai < 2; ++ai)
#pragma unroll
            for (int m = 0; m < 4; ++m) { const int row = u.pm * BM + ai * HALF + wr * 64 + m * 16 + fr; const size_t off = (size_t)row * ldc + col0; float ss = 0.f;
#pragma unroll
                for (int bj = 0; bj < 2; ++bj) { const f32x4 h0 = acc[ai][bj][m][0], h1 = acc[ai][bj][m][1];
                    const auto sx = __builtin_amdgcn_permlane16_swap(cvtpk(h0[0], h0[1]), cvtpk(h1[0], h1[1]), false, false);
                    const auto sy = __builtin_amdgcn_permlane16_swap(cvtpk(h0[2], h0[3]), cvtpk(h1[2], h1[3]), false, false);
                    u32x4 w; w.x = sx[0]; w.y = sy[0]; w.z = sx[1]; w.w = sy[1];
                    if (!dry) { *(u32x4*)(h1b + (size_t)row * ldc + u.pn * BM + bj * HALF + wc * 32 + ((fq & 1) ? 16 + 4 * (fq - 1) : 4 * fq)) = w; }
                    ss += ((h0[0] * h0[0] + h0[1] * h0[1]) + (h0[2] * h0[2] + h0[3] * h0[3])) + ((h1[0] * h1[0] + h1[1] * h1[1]) + (h1[2] * h1[2] + h1[3] * h1[3])); }
                ss = xg_sum(ss);
                if (fq == 0 && !dry) atomicAdd(sumsq + row, ss); }
    }
};
struct EpiSwiGLU {
    static constexpr bool PERM = true, HAS_INIT = false;
    bf16* O; int ldc; const LAS float* rsl; const float* sumsq;
    __device__ __forceinline__ void operator()(const f32x4 (&acc)[2][2][4][2], const Unit& u, int wr, int wc, int fr, int fq) const {
        const int col0 = u.pn * HALF + wc * 32 + 8 * fq;
#pragma unroll
        for (int ai = 0; ai < 2; ++ai)
#pragma unroll
            for (int m = 0; m < 4; ++m) { const int rl = ai * HALF + wr * 64 + m * 16 + fr; const int row = u.pm * BM + rl;
                const float rs = (u.ord < 8) ? rsl[u.ord * 256 + rl] : __builtin_amdgcn_rsqf(sumsq[row] * (1.0f / DM) + NORM_EPS);
                float f[8];
#pragma unroll
                for (int n = 0; n < 2; ++n)
#pragma unroll
                    for (int j = 0; j < 4; ++j) { const float g = acc[ai][0][m][n][j] * rs, up = acc[ai][1][m][n][j] * rs; f[n * 4 + j] = g * __builtin_amdgcn_rcpf(1.0f + __expf(-g)) * up; }
                *(u32x4*)(O + (size_t)row * ldc + col0) = pack8(f); }
    }
};
struct EpiRes2 {
    static constexpr bool PERM = false, HAS_INIT = true;
    const bf16* h1b; float* out; int ldc; bool dry;
    __device__ __forceinline__ void init(f32x4 (&acc)[2][2][4][2], const Unit& u, int wr, int wc, int fr, int fq) const {
        const int col0 = u.pn * BM + wc * 32 + 4 * fq;
#pragma unroll
        for (int ai = 0; ai < 2; ++ai)
#pragma unroll
            for (int m = 0; m < 4; ++m) { const size_t off = (size_t)(u.pm * BM + ai * HALF + wr * 64 + m * 16 + fr) * ldc + col0;
#pragma unroll
                for (int bj = 0; bj < 2; ++bj) {
                    const u32x4 w = __builtin_nontemporal_load((const u32x4*)(h1b + off - 4 * fq + bj * HALF + ((fq & 1) ? 16 + 4 * (fq - 1) : 4 * fq)));
                    const auto sx = __builtin_amdgcn_permlane16_swap(w.x, w.z, false, false);
                    const auto sy = __builtin_amdgcn_permlane16_swap(w.y, w.w, false, false);
                    acc[ai][bj][m][0] = (f32x4){bf_lo(sx[0]), bf_hi(sx[0]), bf_lo(sy[0]), bf_hi(sy[0])};
                    acc[ai][bj][m][1] = (f32x4){bf_lo(sx[1]), bf_hi(sx[1]), bf_lo(sy[1]), bf_hi(sy[1])}; } }
    }
    __device__ __forceinline__ void operator()(const f32x4 (&acc)[2][2][4][2], const Unit& u, int wr, int wc, int fr, int fq) const {
        const int col0 = u.pn * BM + wc * 32 + 4 * fq;
#pragma unroll
        for (int ai = 0; ai < 2; ++ai)
#pragma unroll
            for (int m = 0; m < 4; ++m) { const size_t off = (size_t)(u.pm * BM + ai * HALF + wr * 64 + m * 16 + fr) * ldc + col0;
#pragma unroll
                for (int bj = 0; bj < 2; ++bj)
#pragma unroll
                    for (int n = 0; n < 2; ++n) { if (!dry) *(f32x4*)(out + off + bj * HALF + n * 16) = acc[ai][bj][m][n]; } }
    }
};

template <class Epi, bool ALIGN_EPI>
__device__ __forceinline__ void gemm_phase(LAS unsigned char* lds, const Gemm g, const StaticOrder& S, const Epi& E) {
    int tid = threadIdx.x; asm volatile("" : "+v"(tid));
    const int wid = __builtin_amdgcn_readfirstlane(tid >> 6), lane = tid & 63, wr = wid >> 2, wc = wid & 3, fr = lane & 15, fq = lane >> 4;
    const int K = g.K, nt = K / BK;
    unsigned voffA[2], voffB[2];
#pragma unroll
    for (int i = 0; i < 2; ++i) { int R, C; stage_rc(tid * 16 + i * 8192, R, C); const int Rb = Epi::PERM ? ((R & ~31) + perm32(R & 31)) : R;
        voffA[i] = (unsigned)(R * g.lda + C) * 2u; voffB[i] = (unsigned)(Rb * K + C) * 2u; }
    const size_t kstep = (size_t)(BK * 2);
    const size_t hstepA = (size_t)HALF * g.lda * 2, hstepB = (size_t)HALF * K * 2;
    const size_t tstepA = 2 * hstepA, tstepB = 2 * hstepB;
    const unsigned ldsw = (unsigned)wid * 1024u;
    const int aoff = lds_byte(wr * 64 + fr, fq * 8), boff = lds_byte(wc * 32 + fr, fq * 8);
#define PG8_SA(b, h) (((b) * 2 + (h)) * HTB)
#define PG8_SB(b, h) ((4 + (b) * 2 + (h)) * HTB)
#define PG8_STAGE(bufoff, gbase, voff) do { _Pragma("unroll") for (int _i = 0; _i < 2; ++_i) \
        __builtin_amdgcn_global_load_lds((const unsigned*)((const char*)(gbase) + (voff)[_i]), (LAS unsigned*)(lds + (bufoff) + ldsw + _i * 8192), 16, 0, 0); } while (0)
#define PG8_LDA(dst, b, h) do { _Pragma("unroll") for (int m = 0; m < 4; ++m) _Pragma("unroll") for (int k = 0; k < 2; ++k) dst[m][k] = *(const LAS bf16x8*)(lds + PG8_SA(b, h) + aoff + m * 2048 + k * 1024); } while (0)
#define PG8_LDB(dst, b, h) do { _Pragma("unroll") for (int n = 0; n < 2; ++n) _Pragma("unroll") for (int k = 0; k < 2; ++k) dst[n][k] = *(const LAS bf16x8*)(lds + PG8_SB(b, h) + boff + n * 2048 + k * 1024); } while (0)
#define PG8_MMA(ai, bj, At, Bt) do { __builtin_amdgcn_s_setprio(1); _Pragma("unroll") for (int m = 0; m < 4; ++m) _Pragma("unroll") for (int n = 0; n < 2; ++n) _Pragma("unroll") for (int k = 0; k < 2; ++k) \
        acc[ai][bj][m][n] = __builtin_amdgcn_mfma_f32_16x16x32_bf16(Bt[n][k], At[m][k], acc[ai][bj][m][n], 0, 0, 0); __builtin_amdgcn_s_setprio(0); } while (0)
#define PG8_WAIT_V(n) asm volatile("s_waitcnt vmcnt(" #n ")" ::: "memory")
#define PG8_WAIT_L(n) asm volatile("s_waitcnt lgkmcnt(" #n ")" ::: "memory")
#define PG8_BAR __builtin_amdgcn_s_barrier()
#define PG8_SCHED __builtin_amdgcn_sched_barrier(0)
    Unit cur, nxt; int ui = 0;
    if (!S.next(0, cur)) return;
    f32x4 acc[2][2][4][2];
    if constexpr (Epi::HAS_INIT) { E.init(acc, cur, wr, wc, fr, fq); }
    else {
#pragma unroll
    for (int a = 0; a < 2; ++a)
#pragma unroll
        for (int b = 0; b < 2; ++b)
#pragma unroll
            for (int m = 0; m < 4; ++m)
#pragma unroll
                for (int n = 0; n < 2; ++n) acc[a][b][m][n] = (f32x4){0.f, 0.f, 0.f, 0.f};
    }
    bf16x8 At[4][2], B0[2][2], B1[2][2];
    const char* cA = (const char*)g.A + (size_t)cur.pm * tstepA; const char* cB = (const char*)g.Bt + (size_t)cur.pn * tstepB;
    PG8_STAGE(PG8_SB(0, 0), cB, voffB); PG8_STAGE(PG8_SB(0, 1), cB + hstepB, voffB); PG8_STAGE(PG8_SA(0, 0), cA, voffA); PG8_STAGE(PG8_SA(0, 1), cA + hstepA, voffA);
    if (wr == 1) PG8_BAR;
    PG8_WAIT_V(2); PG8_BAR;
    PG8_STAGE(PG8_SB(1, 0), cB + kstep, voffB); PG8_STAGE(PG8_SA(1, 0), cA + kstep, voffA); PG8_STAGE(PG8_SB(1, 1), cB + hstepB + kstep, voffB);
    PG8_WAIT_V(6); PG8_BAR;
    for (;;) {
        const bool has_next = S.next(ui + 1, nxt);
        const char* nA = has_next ? (const char*)g.A + (size_t)nxt.pm * tstepA : cA; const char* nB = has_next ? (const char*)g.Bt + (size_t)nxt.pn * tstepB : cB;
        for (int t = 0; t < nt; t += 2) {
            const bool last = (t == nt - 2);
            const char* a1 = cA + (size_t)(t + 1) * kstep;
            const char* a2 = last ? nA : cA + (size_t)(t + 2) * kstep; const char* b2 = last ? nB : cB + (size_t)(t + 2) * kstep;
            const char* a3 = a2 + kstep; const char* b3 = b2 + kstep;
            PG8_LDB(B0, 0, 0); PG8_LDB(B1, 0, 1); PG8_SCHED; PG8_LDA(At, 0, 0); PG8_STAGE(PG8_SA(1, 1), a1 + hstepA, voffA);
            PG8_WAIT_V(8); PG8_WAIT_L(0); PG8_BAR; PG8_MMA(0, 0, At, B0); PG8_MMA(0, 1, At, B1); PG8_BAR; PG8_SCHED;
            PG8_LDA(At, 0, 1); PG8_STAGE(PG8_SB(0, 0), b2, voffB); PG8_STAGE(PG8_SB(0, 1), b2 + hstepB, voffB); PG8_STAGE(PG8_SA(0, 0), a2, voffA);
            PG8_WAIT_V(8); PG8_WAIT_L(0); PG8_BAR; PG8_MMA(1, 0, At, B0); PG8_MMA(1, 1, At, B1); PG8_BAR; PG8_SCHED;
            PG8_LDB(B0, 1, 0); PG8_LDB(B1, 1, 1); PG8_SCHED; PG8_LDA(At, 1, 0); PG8_STAGE(PG8_SA(0, 1), a2 + hstepA, voffA);
            PG8_WAIT_V(8); PG8_WAIT_L(0); PG8_BAR; PG8_MMA(0, 0, At, B0); PG8_MMA(0, 1, At, B1); PG8_BAR; PG8_SCHED;
            PG8_LDA(At, 1, 1); PG8_STAGE(PG8_SB(1, 0), b3, voffB); PG8_STAGE(PG8_SB(1, 1), b3 + hstepB, voffB); PG8_STAGE(PG8_SA(1, 0), a3, voffA);
            PG8_WAIT_V(8); PG8_WAIT_L(0); PG8_BAR; PG8_MMA(1, 0, At, B0); PG8_MMA(1, 1, At, B1); PG8_BAR; PG8_SCHED;
        }
        if constexpr (ALIGN_EPI) { if (wr == 0) PG8_BAR; }
        E(acc, cur, wr, wc, fr, fq);
        if (!has_next) break;
        if constexpr (Epi::HAS_INIT) { E.init(acc, nxt, wr, wc, fr, fq); }
        else {
#pragma unroll
        for (int a = 0; a < 2; ++a)
#pragma unroll
            for (int b = 0; b < 2; ++b)
#pragma unroll
                for (int m = 0; m < 4; ++m)
#pragma unroll
                    for (int n = 0; n < 2; ++n) acc[a][b][m][n] = (f32x4){0.f, 0.f, 0.f, 0.f};
        }
        cur = nxt; cA = nA; cB = nB; ++ui;
        if constexpr (ALIGN_EPI) { if (wr == 1) PG8_BAR; }
    }
    PG8_WAIT_V(0);
    if constexpr (!ALIGN_EPI) { if (wr == 0) PG8_BAR; }
    PG8_BAR;
#undef PG8_SA
#undef PG8_SB
#undef PG8_STAGE
#undef PG8_LDA
#undef PG8_LDB
#undef PG8_MMA
#undef PG8_WAIT_V
#undef PG8_WAIT_L
#undef PG8_BAR
#undef PG8_SCHED
}
}

#define XB_TMO      128
#define XB_XCNT(j)  (256  + 64 * (j))
#define XB_XSUB(j)  (1280 + 64 * (j))
#define XB_XGEN(j)  (2304 + 64 * (j))
#define XB_TOP      3328
#define XB_TOPGEN   3392
#define XCD_BAR_WORDS 3456
#define XB_SPIN_CAP (1u << 18)
__device__ __forceinline__ unsigned xb_ld(unsigned* p)              { return __hip_atomic_load(p, __ATOMIC_RELAXED, __HIP_MEMORY_SCOPE_AGENT); }
__device__ __forceinline__ unsigned xb_add(unsigned* p, unsigned v) { return __hip_atomic_fetch_add(p, v, __ATOMIC_RELAXED, __HIP_MEMORY_SCOPE_AGENT); }
__device__ __forceinline__ unsigned xb_xcc_id() { return (unsigned)__builtin_amdgcn_s_getreg((3 << 11) | 20) & 0xFu; }
#define XB_SPIN(cond, bar) do { unsigned _sp = 0; while (cond) { __builtin_amdgcn_s_sleep(1); \
    if ((++_sp & 255u) == 0u) { if (xb_ld(&(bar)[XB_TMO])) break; if (_sp > XB_SPIN_CAP) { atomicAdd(&(bar)[XB_TMO], 1u); break; } } } } while (0)
struct XcdBarrier { unsigned* bar; unsigned x; volatile LAS unsigned* st; };
__device__ __forceinline__ XcdBarrier xcd_barrier_post(unsigned* bar, volatile LAS unsigned* st) {
    XcdBarrier b; b.bar = bar; b.x = xb_xcc_id(); b.st = st;
    if (threadIdx.x == 0) (void)xb_add(&bar[XB_XCNT(b.x)], 1u);
    return b;
}
__device__ __forceinline__ void xcd_barrier_complete(unsigned* bar, unsigned x, unsigned& nloc, unsigned& nx) {
    const unsigned G = gridDim.x * gridDim.y * gridDim.z;
    unsigned sum, cnt, mine, sp = 0u;
    for (;;) {
        sum = 0u; cnt = 0u; mine = 0u;
#pragma unroll
        for (unsigned j = 0; j < 16; ++j) { const unsigned c = xb_ld(&bar[XB_XCNT(j)]); sum += c; cnt += (c > 0u) ? 1u : 0u; mine = (j == x) ? c : mine; }
        if (sum == G) break;
        __builtin_amdgcn_s_sleep(1);
        if ((++sp & 255u) == 0u) { if (xb_ld(&bar[XB_TMO])) break; if (sp > XB_SPIN_CAP) { atomicAdd(&bar[XB_TMO], 1u); break; } }
    }
    nloc = mine > 0u ? mine : 1u; nx = cnt > 0u ? cnt : 1u;
}
__device__ __forceinline__ void xcd_barrier(const XcdBarrier& b) {
    asm volatile("s_waitcnt vmcnt(0)" ::: "memory");
    __syncthreads();
    if (threadIdx.x == 0) {
        unsigned* bar = b.bar;
        __builtin_amdgcn_s_waitcnt(0);
        unsigned nloc = b.st[0], nx = b.st[1];
        if (nloc == 0u) { xcd_barrier_complete(bar, b.x, nloc, nx); b.st[0] = nloc; b.st[1] = nx; }
        __builtin_amdgcn_fence(__ATOMIC_ACQUIRE, "agent");
        const unsigned old = xb_add(&bar[XB_XSUB(b.x)], 1u);
        const unsigned gen = old / nloc;
        if (old + 1u == (gen + 1u) * nloc) {
            __builtin_amdgcn_fence(__ATOMIC_RELEASE, "agent");
            asm volatile("s_waitcnt vmcnt(0)" ::: "memory");
            const unsigned og = xb_add(&bar[XB_TOP], 1u);
            const unsigned tg = og / nx;
            if (og + 1u == (tg + 1u) * nx) xb_add(&bar[XB_TOPGEN], 1u);
            else XB_SPIN(xb_ld(&bar[XB_TOPGEN]) == tg, bar);
            xb_add(&bar[XB_XGEN(b.x)], 1u);
            asm volatile("s_waitcnt vmcnt(0)" ::: "memory");
        } else {
            XB_SPIN(xb_ld(&bar[XB_TOPGEN]) == gen, bar);
            asm volatile("s_waitcnt vmcnt(0)" ::: "memory");
        }
    }
    __syncthreads();
}

struct Args {
    const float* x; const float* norm1_w; const float* w_in; const float* conv_w; const float* conv_b; const float* igate_b; const float* fgate_b;
    const float* q_norm_w; const float* k_norm_w; const float* mlstm_norm_w; const float* attn_norm_w; const float* w_out; const float* norm2_w;
    const float* w_gate; const float* w_up; const float* w_down;
    float* out; unsigned char* ws; int dry; int pad;
};

struct TItem { const float* W; bf16* WT; const float* kscale; int ldw, K, nsrc0, ndst0, k0, kperm; };
__device__ __forceinline__ void titem_load(const TItem& t, f32x4 (&v)[8], float (&ks)[8], const float* ksafe, int lane) {
    const float* src = t.W + (size_t)t.k0 * t.ldw + t.nsrc0 + (lane & 7) * 4;
    const float* kp = (t.kscale ? t.kscale : ksafe) + t.k0 + (lane >> 3);
#pragma unroll
    for (int i = 0; i < 8; ++i) { const int kk = 8 * i + (lane >> 3); const int kr = t.kperm ? (32 * (kk >> 5) + 16 * ((kk >> 2) & 1) + 4 * ((kk >> 3) & 3) + (kk & 3)) : kk;
        v[i] = __builtin_nontemporal_load((const f32x4*)(src + (size_t)kr * t.ldw)); ks[i] = kp[8 * i]; }
}
__device__ __forceinline__ void titem_finish(const TItem& t, const f32x4 (&v)[8], const float (&ks)[8], LAS float* scr, int lane) {
#pragma unroll
    for (int i = 0; i < 8; ++i) { const int kk = 8 * i + (lane >> 3); const float sc = t.kscale ? ks[i] : 1.0f; LAS float* d = scr + kk * 33 + (lane & 7) * 4;
        d[0] = v[i][0] * sc; d[1] = v[i][1] * sc; d[2] = v[i][2] * sc; d[3] = v[i][3] * sc; }
    LDS_WAIT(); asm volatile("" ::: "memory");
    const int c = lane & 7;
#pragma unroll
    for (int j = 0; j < 4; ++j) { const int n = (lane >> 3) + 8 * j; const LAS float* s = scr + (8 * c) * 33 + n;
        u32x4 o; o.x = cvtpk(s[0 * 33], s[1 * 33]); o.y = cvtpk(s[2 * 33], s[3 * 33]); o.z = cvtpk(s[4 * 33], s[5 * 33]); o.w = cvtpk(s[6 * 33], s[7 * 33]);
        *(u32x4*)(t.WT + (size_t)(t.ndst0 + n) * t.K + t.k0 + 8 * c) = o; }
    LDS_WAIT(); asm volatile("" ::: "memory");
}
__device__ __forceinline__ int win_src_col(int nd) {
    if (nd < 1024) return nd;
    if (nd < 2048) return nd + 1024;
    if (nd < 3072) return nd - 1024;
    return nd + 8;
}


__device__ __forceinline__ float scan_add64(float v, int lane) {
#pragma unroll
    for (int o = 1; o < 64; o <<= 1) { const float t = __shfl_up(v, o); if (lane >= o) v += t; }
    return v;
}
__device__ __forceinline__ float scan_max64(float v, int lane) {
#pragma unroll
    for (int o = 1; o < 64; o <<= 1) { const float t = __shfl_up(v, o); if (lane >= o) v = fmaxf(v, t); }
    return v;
}
__device__ __forceinline__ void conv_issue(const bf16* proj, int b, int c, int col0, int tid, u32x4 (&raw)[2][4]) {
    const int rr = tid >> 4, cc = (tid & 15) * 8;
#pragma unroll
    for (int half = 0; half < 2; ++half)
#pragma unroll
        for (int j = 0; j < 4; ++j) { const int tt = c * 64 + rr + 32 * half - 3 + j; const int ttc = tt < 0 ? 0 : tt;
            raw[half][j] = *(const u32x4*)(proj + (size_t)(b * SEQ + ttc) * NPROJ + col0 + cc); }
}
template <bool ROWW>
__device__ __forceinline__ void conv_finish(const u32x4 (&raw)[2][4], const float* conv_w, const float* conv_b, int c, int ch0, float rscale, float wlane, LAS unsigned char* tile, int tid) {
    const int rr = tid >> 4, cc = (tid & 15) * 8;
    float w[4][8], bb[8];
#pragma unroll
    for (int j = 0; j < 4; ++j) { const f32x4 w0 = *(const f32x4*)(conv_w + j * 1024 + ch0 + cc), w1 = *(const f32x4*)(conv_w + j * 1024 + ch0 + cc + 4);
        w[j][0] = w0[0]; w[j][1] = w0[1]; w[j][2] = w0[2]; w[j][3] = w0[3]; w[j][4] = w1[0]; w[j][5] = w1[1]; w[j][6] = w1[2]; w[j][7] = w1[3]; }
    { const f32x4 b0 = *(const f32x4*)(conv_b + ch0 + cc), b1 = *(const f32x4*)(conv_b + ch0 + cc + 4);
      bb[0] = b0[0]; bb[1] = b0[1]; bb[2] = b0[2]; bb[3] = b0[3]; bb[4] = b1[0]; bb[5] = b1[1]; bb[6] = b1[2]; bb[7] = b1[3]; }
#pragma unroll
    for (int half = 0; half < 2; ++half) {
        const int l = rr + 32 * half, t = c * 64 + l;
        float y[8];
#pragma unroll
        for (int e = 0; e < 8; ++e) y[e] = bb[e];
#pragma unroll
        for (int j = 0; j < 4; ++j) { const bool inb = (t - 3 + j) >= 0; u32x4 rz = raw[half][j];
            rz.x = inb ? rz.x : 0u; rz.y = inb ? rz.y : 0u; rz.z = inb ? rz.z : 0u; rz.w = inb ? rz.w : 0u;
            float x[8]; unpack8(rz, x);
#pragma unroll
            for (int e = 0; e < 8; ++e) y[e] += w[j][e] * x[e]; }
        float sc = rscale;
        if (ROWW) sc *= __shfl(wlane, l);
#pragma unroll
        for (int e = 0; e < 8; ++e) y[e] = y[e] * __builtin_amdgcn_rcpf(1.0f + __expf(-y[e])) * sc;
        *(LAS u32x4*)(tile + l * 288 + cc * 2) = pack8(y);
    }
}
__device__ __forceinline__ void v_issue(const bf16* proj, int b, int c, int h, int tid, u32x4 (&vv)[4]) {
#pragma unroll
    for (int p = 0; p < 4; ++p) { const int row = p * 16 + (tid >> 5), ch = tid & 31;
        vv[p] = *(const u32x4*)(proj + (size_t)(b * SEQ + c * 64 + row) * NPROJ + PC_MV + h * 256 + ch * 8); }
}
__device__ __forceinline__ void v_store(const u32x4 (&vv)[4], LAS unsigned char* tile, int tid) {
#pragma unroll
    for (int p = 0; p < 4; ++p) { const int row = p * 16 + (tid >> 5), ch = tid & 31;
        *(LAS u32x4*)(tile + row * 544 + ch * 16) = vv[p]; }
}

struct AUnit { int b, h, d, r, n; bf16* po0; float* pl0; };
template <bool FINAL>
__device__ __forceinline__ void attn_pair(bf16* proj, const float* rcos, const float* rsin, const float* qnw, float mref, const float* anw, const AUnit& ua, const AUnit& ub,
                                          LAS unsigned char* lds_all, bf16* po1, float* pl1, int tid_in, bool dry) {
    int tid = tid_in; asm volatile("" : "+v"(tid));
    const int lane = tid & 63, wave = __builtin_amdgcn_readfirstlane(tid >> 6);
    const int team = wave >> 2, w4 = wave & 3;
    const int b = team ? ub.b : ua.b, h = team ? ub.h : ua.h, d = team ? ub.d : ua.d, r = team ? ub.r : ua.r, n = team ? ub.n : ua.n;
    bf16* po0 = team ? ub.po0 : ua.po0; float* pl0 = team ? ub.pl0 : ua.pl0;
    LAS unsigned char* lds = lds_all + team * 65536;
    const int j = lane & 15, g = lane >> 4, qp = j >> 2, p = lane & 3;
    const int kt0 = (n == 0) ? 4 : 0;
    const int l4 = lane >> 4, pc = lane & 15;
    const bf16* kbase = proj + (size_t)b * SEQ * NPROJ + PC_AK + h * 128;
#define AT_DMA(t, slot) do { const int tc_ = ((t) < 8) ? (t) : 7; LAS unsigned char* slot_ = lds + (slot) * 16384; \
        _Pragma("unroll") for (int i_ = 0; i_ < 2; ++i_) { const int q_ = 2 * w4 + i_; const int row_ = 4 * q_ + l4; \
            const bf16* kr_ = kbase + (size_t)((128 * (n - 1) + 32 * tc_ + row_) * d + r) * NPROJ; \
            __builtin_amdgcn_global_load_lds((const unsigned*)(kr_ + 8 * (pc ^ (row_ & 15))), (LAS unsigned*)(slot_ + q_ * 1024), 16, 0, 0); \
            __builtin_amdgcn_global_load_lds((const unsigned*)(kr_ + (PC_AV - PC_AK) + 8 * (pc ^ ((row_ & 7) << 1))), (LAS unsigned*)(slot_ + 8192 + q_ * 1024), 16, 0, 0); } } while (0)
#define WG_BAR() do { asm volatile("s_waitcnt lgkmcnt(0)" ::: "memory"); __builtin_amdgcn_s_barrier(); asm volatile("" ::: "memory"); } while (0)
    AT_DMA(kt0, 0); AT_DMA(kt0 + 1, 1); AT_DMA(kt0 + 2, 2);
    bf16x8 qf[2][4]; int qi[2]; int tq[2];
    const int G0 = w4, G1 = 7 - w4;
    qi[0] = 16 * G0 + j; qi[1] = 16 * G1 + j; tq[0] = (128 * n + qi[0]) * d + r; tq[1] = (128 * n + qi[1]) * d + r;
    const int lo0 = G0 >> 1, lo1 = G1 >> 1;
#pragma unroll
    for (int gi = 0; gi < 2; ++gi) { const bf16* qrow = proj + (size_t)(b * SEQ + tq[gi]) * NPROJ + PC_AQ + h * 128 + 8 * g;
#pragma unroll
        for (int ks = 0; ks < 4; ++ks) qf[gi][ks] = *(const bf16x8*)(qrow + 32 * ks); }
    for (int kb_ = 0; kb_ < kt0; ++kb_) WG_BAR();
    float l_run[2] = {0.f, 0.f};
    f32x4 o[2][8];
    if (FINAL) {
#pragma unroll
        for (int gi = 0; gi < 2; ++gi) { const size_t trow = (size_t)(b * SEQ + tq[gi]);
            const float l0 = pl0[trow * 8 + h], l1 = pl1[trow * 8 + h];
            const float a0 = __builtin_amdgcn_exp2f(l0 - mref), a1 = __builtin_amdgcn_exp2f(l1 - mref);
            l_run[gi] = (g == 0) ? a0 + a1 : 0.f;
            const bf16* p0 = po0 + trow * 1024 + h * 128 + g * 8; const bf16* p1 = po1 + trow * 1024 + h * 128 + g * 8;
#pragma unroll
            for (int np = 0; np < 4; ++np) { const u32x4 x0 = *(const u32x4*)(p0 + 32 * np), x1 = *(const u32x4*)(p1 + 32 * np); float f0[8], f1[8]; unpack8(x0, f0); unpack8(x1, f1);
#pragma unroll
                for (int e = 0; e < 4; ++e) { o[gi][2 * np][e] = a0 * f0[e] + a1 * f1[e]; o[gi][2 * np + 1][e] = a0 * f0[4 + e] + a1 * f1[4 + e]; } }
        }
    } else {
#pragma unroll
        for (int gi = 0; gi < 2; ++gi)
#pragma unroll
            for (int nf = 0; nf < 8; ++nf) o[gi][nf] = (f32x4){0.f, 0.f, 0.f, 0.f};
    }
    const float SC = 0.08838834764831845f * 1.4426950408889634f;
    const float nmref = -mref;
#define AT_SM(gi, kt, s0, s1) do { \
                float x[8]; float ps = 0.f; \
                _Pragma("unroll") for (int e = 0; e < 8; ++e) { const int kj = 32 * (kt) + 16 * (e >> 2) + 4 * g + (e & 3); const float sv = (e < 4) ? s0[e & 3] : s1[e & 3]; \
                    const bool valid = (kj >= qi[gi]) && (kj <= qi[gi] + 128); \
                    const float pe = __builtin_amdgcn_exp2f(__builtin_fmaf(sv, SC, nmref)); \
                    x[e] = valid ? pe : 0.f; ps += x[e]; } \
                l_run[gi] += ps; \
                const u32x4 pw = pack8(x); pb[gi] = __builtin_bit_cast(bf16x8, pw); } while (0)
#define AT_ONE(gi, kt, sl) do { \
            f32x4 sA = {0.f, 0.f, 0.f, 0.f}, sB = {0.f, 0.f, 0.f, 0.f}; \
            _Pragma("unroll") for (int ks = 0; ks < 4; ++ks) { \
                const bf16x8 k0 = *(const LAS bf16x8*)(Kt + j * 256 + (((4 * ks + g) ^ j) << 4)), k1 = *(const LAS bf16x8*)(Kt + (16 + j) * 256 + (((4 * ks + g) ^ j) << 4)); \
                sA = MFMA16(k0, qf[gi][ks], sA); sB = MFMA16(k1, qf[gi][ks], sB); } \
            s16x4 va_[8], vb_[8]; \
            _Pragma("unroll") for (int nf = 0; nf < 8; ++nf) { const unsigned ad_ = vaddr_ + (((2 * nf + (p >> 1)) ^ vsw_) << 4); VTR_ASM(va_[nf], ad_, (sl) * 16384 + 8192); VTR_ASM(vb_[nf], ad_, (sl) * 16384 + 8192 + 4096); } \
            bf16x8 pb[2]; AT_SM(gi, kt, sA, sB); \
            VTR_WAIT16(va_, vb_); \
            _Pragma("unroll") for (int nf = 0; nf < 8; ++nf) o[gi][nf] = MFMA16(cat4(va_[nf], vb_[nf]), pb[gi], o[gi][nf]); } while (0)
#define AT_STEP(kt, sl) do { \
        LAS unsigned char* Kt = lds + (sl) * 16384; LAS unsigned char* Vt = Kt + 8192; \
        asm volatile("s_waitcnt vmcnt(8)" ::: "memory");        \
        WG_BAR();                                               \
        const bool act0 = (kt) >= lo0 && (kt) <= lo0 + 4, act1 = (kt) >= lo1 && (kt) <= lo1 + 4; \
        if (act0 && act1) { \
            f32x4 sA[2], sB[2]; sA[0] = (f32x4){0.f, 0.f, 0.f, 0.f}; sA[1] = sA[0]; sB[0] = sA[0]; sB[1] = sA[0]; \
            _Pragma("unroll") for (int ks = 0; ks < 4; ++ks) { \
                const bf16x8 k0 = *(const LAS bf16x8*)(Kt + j * 256 + (((4 * ks + g) ^ j) << 4)), k1 = *(const LAS bf16x8*)(Kt + (16 + j) * 256 + (((4 * ks + g) ^ j) << 4)); \
                sA[0] = MFMA16(k0, qf[0][ks], sA[0]); sB[0] = MFMA16(k1, qf[0][ks], sB[0]); sA[1] = MFMA16(k0, qf[1][ks], sA[1]); sB[1] = MFMA16(k1, qf[1][ks], sB[1]); } \
            s16x4 va_[8], vb_[8]; \
            _Pragma("unroll") for (int nf = 0; nf < 8; ++nf) { const unsigned ad_ = vaddr_ + (((2 * nf + (p >> 1)) ^ vsw_) << 4); VTR_ASM(va_[nf], ad_, (sl) * 16384 + 8192); VTR_ASM(vb_[nf], ad_, (sl) * 16384 + 8192 + 4096); } \
            bf16x8 pb[2]; \
            AT_SM(0, kt, sA[0], sB[0]); AT_SM(1, kt, sA[1], sB[1]); \
            VTR_WAIT16(va_, vb_); \
            _Pragma("unroll") for (int nf = 0; nf < 8; ++nf) { const bf16x8 vf = cat4(va_[nf], vb_[nf]); \
                o[0][nf] = MFMA16(vf, pb[0], o[0][nf]); o[1][nf] = MFMA16(vf, pb[1], o[1][nf]); } \
        } else if (act0) { AT_ONE(0, kt, sl); } else if (act1) { AT_ONE(1, kt, sl); } \
        AT_DMA((kt) + 3, ((sl) + 3) & 3);                      \
        } while (0)
    const int vsw_ = ((4 * g + qp) & 7) << 1;
    const unsigned vaddr_ = (unsigned)(size_t)lds + (unsigned)((4 * g + qp) * 256 + (p & 1) * 8);
#pragma unroll 1
    for (int kt = kt0; kt < 8; kt += 4) { AT_STEP(kt, 0); AT_STEP(kt + 1, 1); AT_STEP(kt + 2, 2); AT_STEP(kt + 3, 3); }
    asm volatile("s_waitcnt vmcnt(0)" ::: "memory");
    WG_BAR();
#undef AT_STEP
#undef AT_ONE
#undef AT_SM
#undef AT_DMA
    f32x4 anwv[8];
    if (FINAL) {
#pragma unroll
        for (int nf = 0; nf < 8; ++nf) anwv[nf] = *(const f32x4*)(anw + h * 128 + 16 * nf + 4 * g);
    }
#pragma unroll
    for (int gi = 0; gi < 2; ++gi) {
        float lr = l_run[gi]; lr = xg_sum(lr);
        const float inv = __builtin_amdgcn_rcpf(lr);
        const float lse2 = mref + __log2f(lr);
        const size_t trow = (size_t)(b * SEQ + tq[gi]);
        if (!FINAL) {
            bf16* pp = po0 + trow * 1024 + h * 128 + g * 8;
#pragma unroll
            for (int np = 0; np < 4; ++np) { const f32x4 va = o[gi][2 * np] * inv, vb = o[gi][2 * np + 1] * inv; u32x4 ww; ww.x = cvtpk(va[0], va[1]); ww.y = cvtpk(va[2], va[3]); ww.z = cvtpk(vb[0], vb[1]); ww.w = cvtpk(vb[2], vb[3]);
                if (!dry) *(u32x4*)(pp + 32 * np) = ww; }
            if (g == 0 && !dry) pl0[trow * 8 + h] = lse2;
        } else {
            bf16* qrow = proj + trow * NPROJ + PC_AQ + h * 128;
            float ss = 0.f;
#pragma unroll
            for (int nf = 0; nf < 8; ++nf) { const f32x4 v = o[gi][nf] * inv; o[gi][nf] = v; ss += (v[0] * v[0] + v[1] * v[1]) + (v[2] * v[2] + v[3] * v[3]); }
            ss = xg_sum(ss);
            const float rn = __builtin_amdgcn_rsqf(ss * (1.0f / 128.0f) + NORM_EPS);
#pragma unroll
            for (int np = 0; np < 4; ++np) { const f32x4 va = o[gi][2 * np] * rn * anwv[2 * np], vb = o[gi][2 * np + 1] * rn * anwv[2 * np + 1];
                u32x4 ww; ww.x = cvtpk(va[0], va[1]); ww.y = cvtpk(va[2], va[3]); ww.z = cvtpk(vb[0], vb[1]); ww.w = cvtpk(vb[2], vb[3]); if (!dry) *(u32x4*)(qrow + 32 * np + 8 * g) = ww; }
        }
    }
}

#ifndef PROBE_PHASE
#define PROBE_PHASE -1
#endif
#define REP_BEGIN(k) for (int rep_ = (PROBE_PHASE == (k)) ? 0 : 1; rep_ < 2; ++rep_) { const bool dry = (rep_ == 0) && (a.dry != 0); (void)dry; \
    int tid = threadIdx.x; asm volatile("" : "+v"(tid)); const int lane = tid & 63, wave = __builtin_amdgcn_readfirstlane(tid >> 6); \
    const int gw = vcu * NWAVES + wave, gt = vcu * (NWAVES * 64) + tid; (void)lane; (void)wave; (void)gw; (void)gt;
#define REP_END }

__global__ void __launch_bounds__(NWAVES * 64, 2) hymba_fwd(Args a) {
    extern __shared__ __attribute__((aligned(16))) unsigned char lds_raw[];
    LAS unsigned char* lds = (LAS unsigned char*)lds_raw;
    volatile LAS unsigned* MISC = (volatile LAS unsigned*)(lds + MISC_OFF);
    const int tid = threadIdx.x, lane = tid & 63, wave = __builtin_amdgcn_readfirstlane(tid >> 6);
    const int G = gridDim.x; const int bx = blockIdx.x; const int vcu = (G % 8 == 0) ? (bx % 8) * (G / 8) + bx / 8 : bx;
    unsigned char* ws = a.ws;
    unsigned* ctl = (unsigned*)(ws + WS_CTL);
    float* gli = (float*)(ws + WS_GLI); float* glf = (float*)(ws + WS_GLF); float* sumsq = (float*)(ws + WS_SUMSQ); float* rstdb = (float*)(ws + WS_RSTD);
    float* msc_g = (float*)(ws + WS_MSC); float* msc_ml = msc_g + 512; float* msc_mp = msc_g + 1024;
    float* ncb = (float*)(ws + WS_NC);
    float* rcos = (float*)(ws + WS_COS); float* rsin = (float*)(ws + WS_SIN);
    bf16* WinT = (bf16*)(ws + WS_WIN); bf16* kvT = (bf16*)(ws + WS_KV); bf16* Ub = (bf16*)(ws + WS_U); bf16* H1b = (bf16*)(ws + WS_U);
    bf16* proj = (bf16*)(ws + WS_PROJ); bf16* FF = (bf16*)(ws + WS_PROJ);
    bf16* op0 = (bf16*)(ws + WS_OP0); bf16* op1 = (bf16*)(ws + WS_OP1); float* pl0 = (float*)(ws + WS_PL0); float* pl1 = (float*)(ws + WS_PL1);
    bf16* WoutT = (bf16*)(ws + WS_WOUT); bf16* WguT = (bf16*)(ws + WS_WGU); bf16* WdnT = (bf16*)(ws + WS_WDN);

    for (int u = tid; u < (LDS_BYTES - MISC_OFF) / 4; u += NWAVES * 64) ((LAS unsigned*)(lds + MISC_OFF))[u] = 0u;
    __syncthreads();
    XcdBarrier bar = xcd_barrier_post(ctl + CW_BAR, MISC + 8);
    const int NGW = G * NWAVES, NGT = G * NWAVES * 64;

    REP_BEGIN(0)
        for (int i = gt; i < MTOK; i += NGT) sumsq[i] = 0.f;
        {
            LAS float* scr = (LAS float*)(lds + wave * 16384);
            constexpr int I_IN = (DM / 64) * (NPROJ / 32), I_OUT = (DM / 64) * (DM / 32), I_GU = (DM / 64) * (NGU / 32), I_DN = (DFF / 64) * (DM / 32);
            constexpr int NITEMS = I_IN + I_OUT + I_GU;
            auto decode = [&](int it) -> TItem {
                TItem t; int r = it;
                if (r < I_IN) { const int nblk = NPROJ / 32, kb = r / nblk, nb = r % nblk; t = TItem{a.w_in, WinT, a.norm1_w, INW, DM, win_src_col(nb * 32), nb * 32, kb * 64, 0}; return t; } r -= I_IN;
                if (r < I_OUT) { const int nblk = DM / 32, kb = r / nblk, nb = r % nblk; t = TItem{a.w_out, WoutT, nullptr, DM, DM, nb * 32, nb * 32, kb * 64, 1}; return t; } r -= I_OUT;
                { const int nblk = NGU / 32, kb = r / nblk, nb = r % nblk; const int nd = nb * 32, pn = nd >> 8, j = nd & 255;
                    t = TItem{(j < 128) ? a.w_gate : a.w_up, WguT, a.norm2_w, DFF, DM, pn * 128 + (j & 127), nd, kb * 64, 0}; return t; }
            };
            int it = gw;
            if (it < NITEMS) {
                TItem cur = decode(it); f32x4 vc[8]; float kc[8]; titem_load(cur, vc, kc, a.norm2_w, lane);
                for (;;) {
                    const int nx = it + NGW; const bool more = nx < NITEMS;
                    f32x4 vn[8]; float kn[8];
                    const TItem nt = decode(more ? nx : it); titem_load(nt, vn, kn, a.norm2_w, lane);
                    titem_finish(cur, vc, kc, scr, lane);
                    if (!more) break;
                    cur = nt; it = nx;
#pragma unroll
                    for (int i = 0; i < 8; ++i) { vc[i] = vn[i]; kc[i] = kn[i]; }
                }
            }
        }
        __syncthreads();
        LAS float* wg = (LAS float*)lds;
        for (int k = tid; k < DM; k += NWAVES * 64) { const f32x4 g0 = *(const f32x4*)(a.w_in + (size_t)k * INW + 3072), g1 = *(const f32x4*)(a.w_in + (size_t)k * INW + 3076);
            wg[0 * DM + k] = g0[0]; wg[1 * DM + k] = g0[1]; wg[2 * DM + k] = g0[2]; wg[3 * DM + k] = g0[3];
            wg[4 * DM + k] = g1[0]; wg[5 * DM + k] = g1[1]; wg[6 * DM + k] = g1[2]; wg[7 * DM + k] = g1[3]; }
        __syncthreads();
        f32x4 w1v[8];
#pragma unroll
        for (int j = 0; j < 8; ++j) w1v[j] = ((const f32x4*)a.norm1_w)[lane + 64 * j];
        for (int m = gw; m < MTOK; m += NGW) {
            const f32x4* xr = (const f32x4*)(a.x + (size_t)m * DM) + lane;
            f32x4 v[8]; float s = 0.f;
#pragma unroll
            for (int j = 0; j < 8; ++j) { v[j] = __builtin_nontemporal_load(xr + 64 * j); s += (v[j][0] * v[j][0] + v[j][1] * v[j][1]) + (v[j][2] * v[j][2] + v[j][3] * v[j][3]); }
            const float rstd = __builtin_amdgcn_rsqf(wave_sum(s) * (1.0f / DM) + NORM_EPS);
            u32x2* o8 = (u32x2*)(Ub + (size_t)m * DM) + lane;
#pragma unroll
            for (int j = 0; j < 8; ++j) { u32x2 w; w.x = cvtpk(v[j][0], v[j][1]); w.y = cvtpk(v[j][2], v[j][3]); o8[64 * j] = w; v[j] = v[j] * rstd * w1v[j]; }
            if (lane == 0) rstdb[m] = rstd;
            float z = 0.f;
#pragma unroll 1
            for (int gi = 0; gi < 8; ++gi) { float t = 0.f;
#pragma unroll
                for (int j = 0; j < 8; ++j) { const f32x4 w4 = *(const LAS f32x4*)(wg + gi * DM + 256 * j + 4 * lane); t += (v[j][0] * w4[0] + v[j][1] * w4[1]) + (v[j][2] * w4[2] + v[j][3] * w4[3]); }
                t = wave_sum(t); z = (lane == gi) ? t : z; }
            if (lane < 8) {
                const int hh = lane & 3;
                if (lane < 4) { gli[m * 4 + hh] = 15.0f * tanhf((z + a.igate_b[hh]) * (1.0f / 15.0f)); }
                else { const float fp = 15.0f * tanhf((z + a.fgate_b[hh]) * (1.0f / 15.0f)); glf[m * 4 + hh] = -log1pf(expf(-fp)); }
            }
        }
        for (int i = gt; i < SEQ * 64; i += NGT) {
            const int pos = i >> 6, fi = i & 63;
            const float invf = (float)exp2(-(double)fi * (13.287712379549449 / 64.0));
            const float ang = (float)pos * invf;
            const double rev = (double)ang * 0.15915494309189535; const double fr_ = rev - rint(rev);
            const float ar = (float)(fr_ * 6.283185307179586);
            rcos[i] = cosf(ar); rsin[i] = sinf(ar);
        }
    REP_END
    xcd_barrier(bar);

    REP_BEGIN(1)
        pg8::Gemm g{Ub, WinT, MTOK, NPROJ, DM, DM}; pg8::StaticOrder S; S.init(MTOK, NPROJ, G, bx);
        LAS float* rsl = (LAS float*)(lds + RING_BYTES);
        {   float sv[8]; unsigned okm = 0u;
#pragma unroll
            for (int i = 0; i < 8; ++i) { pg8::Unit uu; const bool ok = S.next(i, uu); okm |= (ok ? 1u : 0u) << i; sv[i] = rstdb[(ok ? uu.pm : 0) * 256 + (tid & 255)]; }
#pragma unroll
            for (int i = 0; i < 8; ++i) if (tid < 256 && ((okm >> i) & 1u)) rsl[i * 256 + tid] = sv[i];
        }
        __syncthreads();
        pg8::EpiBf16 E{proj, NPROJ, rsl, rstdb};
        pg8::gemm_phase<pg8::EpiBf16, true>(lds, g, S, E);
    REP_END
    xcd_barrier(bar);

    REP_BEGIN(2)
        {
            const int c0 = 4 * (tid & 15), rstride = NGT >> 4;
            for (int which = 0; which < 2; ++which) {
                const float* nw = which ? a.k_norm_w : a.q_norm_w; const int colb = which ? PC_AK : PC_AQ;
                const f32x4 w1 = *(const f32x4*)(nw + c0), w2 = *(const f32x4*)(nw + 64 + c0);
                for (int idx0 = gt >> 4; idx0 < MTOK * 8; idx0 += 4 * rstride) {
                    u32x2 r1[4], r2[4]; f32x4 cs[4], sn[4];
#pragma unroll
                    for (int q = 0; q < 4; ++q) { const int idx = idx0 + q * rstride;
                        if (idx < MTOK * 8) { const int m = idx >> 3, hh = idx & 7, pos = m & (SEQ - 1); const bf16* kp = proj + (size_t)m * NPROJ + colb + hh * 128;
                            r1[q] = *(const u32x2*)(kp + c0); r2[q] = *(const u32x2*)(kp + 64 + c0); cs[q] = *(const f32x4*)(rcos + pos * 64 + c0); sn[q] = *(const f32x4*)(rsin + pos * 64 + c0); } }
#pragma unroll
                    for (int q = 0; q < 4; ++q) { const int idx = idx0 + q * rstride;
                        if (idx < MTOK * 8) { const int m = idx >> 3, hh = idx & 7; bf16* kp = proj + (size_t)m * NPROJ + colb + hh * 128;
                            float x1[4] = {bf_lo(r1[q].x), bf_hi(r1[q].x), bf_lo(r1[q].y), bf_hi(r1[q].y)}, x2[4] = {bf_lo(r2[q].x), bf_hi(r2[q].x), bf_lo(r2[q].y), bf_hi(r2[q].y)};
                            float ss = 0.f;
#pragma unroll
                            for (int e = 0; e < 4; ++e) ss += x1[e] * x1[e] + x2[e] * x2[e];
                            ss = row16_sum(ss);
                            const float rk = __builtin_amdgcn_rsqf(ss * (1.0f / 128.0f) + NORM_EPS);
                            float o1[4], o2[4];
#pragma unroll
                            for (int e = 0; e < 4; ++e) { const float y1 = x1[e] * rk * w1[e], y2 = x2[e] * rk * w2[e]; o1[e] = y1 * cs[q][e] - y2 * sn[q][e]; o2[e] = y2 * cs[q][e] + y1 * sn[q][e]; }
                            u32x2 wv; wv.x = cvtpk(o1[0], o1[1]); wv.y = cvtpk(o1[2], o1[3]); if (!dry) *(u32x2*)(kp + c0) = wv;
                            wv.x = cvtpk(o2[0], o2[1]); wv.y = cvtpk(o2[2], o2[3]); if (!dry) *(u32x2*)(kp + 64 + c0) = wv; } }
                }
            }
        }
        LAS unsigned char* KW = lds; LAS unsigned char* VT = lds + 36864;
        const int g = lane >> 4, qp = (lane & 15) >> 2, p = lane & 3;
        for (int u = vcu; u < 256; u += G) {
            const int b = u >> 7, h = (u >> 5) & 3, c0 = 2 * (u & 31);
            const int tok = b * SEQ + c0 * 64 + lane;
            const float liA = gli[tok * 4 + h], lfA = glf[tok * 4 + h], liB = gli[(tok + 64) * 4 + h], lfB = glf[(tok + 64) * 4 + h];
            u32x4 rawA[2][4], rawB[2][4], vA[4], vB[4];
            conv_issue(proj, b, c0, PC_MK + h * 128, tid, rawA); v_issue(proj, b, c0, h, tid, vA);
            conv_issue(proj, b, c0 + 1, PC_MK + h * 128, tid, rawB); v_issue(proj, b, c0 + 1, h, tid, vB);
            const float cfA = scan_add64(lfA, lane), cfB = scan_add64(lfB, lane);
            const float gA = __shfl(cfA, 63), gB = __shfl(cfB, 63);
            const float avA = gA - cfA + liA + gB, avB = gB - cfB + liB;
            const float ml = wave_max(fmaxf(avA, avB));
            const float wA = __expf(avA - ml), wB = __expf(avB - ml);
            if (tid == 0) { msc_g[u] = gA + gB; msc_ml[u] = ml; }
            conv_finish<true>(rawA, a.conv_w, a.conv_b, c0, 512 + h * 128, 1.0f, wA, KW, tid); v_store(vA, VT, tid);
            conv_finish<true>(rawB, a.conv_w, a.conv_b, c0 + 1, 512 + h * 128, 1.0f, wB, KW + 64 * 288, tid); v_store(vB, VT + 64 * 544, tid);
            __syncthreads();
            f32x4 acc[8][2]; f32x4 accn = {0.f, 0.f, 0.f, 0.f};
            const unsigned one2 = ((lane & 15) == 0) ? 0x3F803F80u : 0u; const bf16x8 bones = __builtin_bit_cast(bf16x8, (u32x4){one2, one2, one2, one2});
#pragma unroll
            for (int df = 0; df < 8; ++df) { acc[df][0] = (f32x4){0.f, 0.f, 0.f, 0.f}; acc[df][1] = (f32x4){0.f, 0.f, 0.f, 0.f}; }
#pragma unroll
            for (int kk = 0; kk < 4; ++kk) {
                bf16x8 bfr[2];
#pragma unroll
                for (int ef = 0; ef < 2; ++ef) { const int col = 32 * wave + 16 * ef + 4 * p;
                    bfr[ef] = cat4(vtr(VT + (32 * kk + 4 * g + qp) * 544 + col * 2), vtr(VT + (32 * kk + 16 + 4 * g + qp) * 544 + col * 2)); }
#pragma unroll
                for (int df = 0; df < 8; ++df) { const int col = 16 * df + 4 * p;
                    const bf16x8 af = cat4(vtr(KW + (32 * kk + 4 * g + qp) * 288 + col * 2), vtr(KW + (32 * kk + 16 + 4 * g + qp) * 288 + col * 2));
                    acc[df][0] = MFMA16(af, bfr[0], acc[df][0]); acc[df][1] = MFMA16(af, bfr[1], acc[df][1]);
                    if (df == wave) accn = MFMA16(af, bones, accn); }
            }
            if ((lane & 15) == 0) *(f32x4*)(ncb + u * 128 + 16 * wave + 4 * g) = accn;
            __syncthreads();
#pragma unroll
            for (int ef = 0; ef < 2; ++ef) { const int e = 32 * wave + 16 * ef + (lane & 15);
#pragma unroll
                for (int df = 0; df < 8; ++df) { const f32x4 v = acc[df][ef]; u32x2 w; w.x = cvtpk(v[0], v[1]); w.y = cvtpk(v[2], v[3]);
                    *(LAS u32x2*)(lds + e * 272 + (16 * df + 4 * g) * 2) = w; } }
            __syncthreads();
#pragma unroll
            for (int i = 0; i < 8; ++i) { const int c_ = tid + 512 * i; const int row = c_ >> 4, ch = c_ & 15;
                *(u32x4*)(kvT + ((size_t)u * 256 + row) * 128 + ch * 8) = *(const LAS u32x4*)(lds + row * 272 + ch * 16); }
            __syncthreads();
        }
    REP_END
    xcd_barrier(bar);

    REP_BEGIN(3)
        LAS float* sg = (LAS float*)lds; LAS float* sml = sg + 256;
        for (int i = tid; i < 256; i += NWAVES * 64) { sg[i] = msc_g[i]; sml[i] = msc_ml[i]; }
        __syncthreads();
        for (int id = gt; id < 8 * 16384; id += NGT) {
            const int bh = id >> 14, pi = id & 16383;
            unsigned* base = (unsigned*)kvT + (size_t)bh * 32 * 16384 + pi;
            float c0 = 0.f, c1 = 0.f, m = 0.f;
            unsigned xv[32];
#pragma unroll
            for (int i = 0; i < 32; ++i) xv[i] = base[(size_t)i * 16384];
#pragma unroll
            for (int i = 0; i < 32; ++i) {
                const float gg = sg[bh * 32 + i], ml = sml[bh * 32 + i];
                const float mn = fmaxf(gg + m, ml), so = __expf(gg + m - mn), sn = __expf(ml - mn);
                if (!dry) base[(size_t)i * 16384] = cvtpk(c0, c1);
                c0 = so * c0 + sn * bf_lo(xv[i]); c1 = so * c1 + sn * bf_hi(xv[i]); m = mn;
            }
        }
        for (int id = gt; id < 8 * 128; id += NGT) {
            const int bh = id >> 7, dd = id & 127; float n = 0.f, m = 0.f;
            float* nb_ = ncb + (size_t)bh * 32 * 128 + dd;
            float xv[32];
#pragma unroll
            for (int i = 0; i < 32; ++i) xv[i] = nb_[i * 128];
#pragma unroll
            for (int i = 0; i < 32; ++i) {
                const float gg = sg[bh * 32 + i], ml = sml[bh * 32 + i];
                const float mn = fmaxf(gg + m, ml), so = __expf(gg + m - mn), sn = __expf(ml - mn);
                if (!dry) nb_[i * 128] = n;
                if (dd == 0) msc_mp[bh * 32 + i] = m;
                n = so * n + sn * xv[i]; m = mn;
            }
        }
        __syncthreads();
    REP_END
    REP_BEGIN(4)
        float mref;
        { const float bq = wave_max(fmaxf(fabsf(a.q_norm_w[lane]), fabsf(a.q_norm_w[64 + lane]))), bk = wave_max(fmaxf(fabsf(a.k_norm_w[lane]), fabsf(a.k_norm_w[64 + lane])));
          mref = fminf(128.0f * 1.02f * 0.08838834764831845f * 1.4426950408889634f * bq * bk, 60.0f); }
        for (int pidx = vcu; pidx < 512; pidx += G) {
            AUnit ua, ub;
            { const int u = pidx; ua = AUnit{u >> 8, (u >> 5) & 7, 4, (u >> 3) & 3, u & 7, op0, pl0}; }
            { const int v = pidx; const int bb = v >> 8; ub = AUnit{bb, (v >> 5) & 7, 16, (v >> 1) & 15, (v ^ bb) & 1, op1, pl1}; }
            attn_pair<false>(proj, rcos, rsin, a.q_norm_w, mref, a.attn_norm_w, ua, ub, lds, nullptr, nullptr, tid, dry);
        }
    REP_END
    xcd_barrier(bar);

    REP_BEGIN(5)
        float mref;
        { const float bq = wave_max(fmaxf(fabsf(a.q_norm_w[lane]), fabsf(a.q_norm_w[64 + lane]))), bk = wave_max(fmaxf(fabsf(a.k_norm_w[lane]), fabsf(a.k_norm_w[64 + lane])));
          mref = fminf(128.0f * 1.02f * 0.08838834764831845f * 1.4426950408889634f * bq * bk, 60.0f); }
        LAS unsigned char* QT = lds; LAS unsigned char* KT = lds + 18432; LAS unsigned char* VT = lds + 36864;
        LAS float* NP = (LAS float*)(lds + 71680); LAS float* XCH = (LAS float*)(lds + 72192); LAS unsigned char* CP = lds + 72704;
        LAS float* RS = (LAS float*)(lds + 147456);
        LAS float* WL = (LAS float*)(lds + 146432);
        const int j = lane & 15, g = lane >> 4, qp = j >> 2, p = lane & 3;
        const int tf = wave & 3, eh = wave >> 2;
        for (int u = vcu; u < 256; u += G) {
            const int b = u >> 7, h = (u >> 5) & 3;
            float mprev = msc_mp[u];
            const bf16* csrc = kvT + (size_t)u * 256 * 128 + (size_t)(tid >> 4) * 128 + (tid & 15) * 8;
#pragma unroll
            for (int hh = 0; hh < 2; ++hh) {
                const int c = 2 * (u & 31) + hh;
                const int tok = b * SEQ + c * 64 + lane;
                const float li = gli[tok * 4 + h], lf = glf[tok * 4 + h];
                u32x4 rawq[2][4], rawk[2][4], vv[4], cv[8];
                conv_issue(proj, b, c, PC_MQ + h * 128, tid, rawq);
                conv_issue(proj, b, c, PC_MK + h * 128, tid, rawk);
                v_issue(proj, b, c, h, tid, vv);
                float npv = 0.f;
                if (hh == 0) { if (tid < 128) npv = ncb[u * 128 + tid]; }
                const float cf = scan_add64(lf, lane);
                const float bvec = li - cf;
                const float pm = scan_max64(bvec, lane);
                const float Mv = fmaxf(mprev, pm);
                const float wiv = __expf(mprev - Mv), emtv = __expf(-cf - Mv);
                if (wave == 0) { RS[lane] = bvec; RS[64 + lane] = Mv; RS[128 + lane] = wiv; RS[192 + lane] = emtv; }
                float so_u = 0.f, m_u = 0.f;
                if (hh == 0) {
                    const float gsum = __shfl(cf, 63);
                    const float av = gsum + bvec;
                    const float mlA = wave_max(av);
                    m_u = fmaxf(gsum + mprev, mlA);
                    so_u = __expf(gsum + mprev - m_u);
                    if (wave == 0) WL[lane] = __expf(av - mlA) * __expf(mlA - m_u);
                }
                conv_finish<false>(rawq, a.conv_w, a.conv_b, c, h * 128, 0.08838834764831845f, 0.f, QT, tid);
                if (hh == 0) {
#pragma unroll
                    for (int it = 0; it < 8; ++it) cv[it] = *(const u32x4*)(csrc + (size_t)it * 32 * 128);
                }
                conv_finish<false>(rawk, a.conv_w, a.conv_b, c, 512 + h * 128, 1.0f, 0.f, KT, tid);
                v_store(vv, VT, tid);
                if (hh == 0) {
#pragma unroll
                    for (int it = 0; it < 8; ++it) *(LAS u32x4*)(CP + (it * 32 + (tid >> 4)) * 288 + (tid & 15) * 16) = cv[it];
                    if (tid < 128) NP[tid] = npv;
                }
                const int t_ = 16 * (wave & 3) + j;
                const bf16* orow_ = proj + (size_t)(b * SEQ + c * 64 + t_) * NPROJ;
                u32x2 mo_pre[8];
#pragma unroll
                for (int ef = 0; ef < 8; ++ef) mo_pre[ef] = *(const u32x2*)(orow_ + PC_MO + h * 256 + 128 * eh + 16 * ef + 4 * g);
                __syncthreads();
                const int t = 16 * tf + j;
                const float M_t = RS[64 + t], wi_t = RS[128 + t], emt_t = RS[192 + t];
                bf16x8 qf[4];
#pragma unroll
                for (int ks = 0; ks < 4; ++ks) qf[ks] = *(const LAS bf16x8*)(QT + t * 288 + (32 * ks + 8 * g) * 2);
                float sp[4][4]; float rowsum = 0.f;
#pragma unroll
                for (int sf = 0; sf < 4; ++sf) {
                    f32x4 sa = {0.f, 0.f, 0.f, 0.f};
#pragma unroll
                    for (int ks = 0; ks < 4; ++ks) { const bf16x8 kfr = *(const LAS bf16x8*)(KT + (16 * sf + j) * 288 + (32 * ks + 8 * g) * 2); sa = MFMA16(kfr, qf[ks], sa); }
                    const f32x4 bs4 = *(const LAS f32x4*)(RS + 16 * sf + 4 * g);
#pragma unroll
                    for (int rg = 0; rg < 4; ++rg) { const int sidx = 16 * sf + 4 * g + rg; const float bs = bs4[rg];
                        const float pv = (sidx <= t) ? __expf(bs - M_t) : 0.f; sp[sf][rg] = sa[rg] * pv; rowsum += sp[sf][rg]; }
                }
                bf16x8 pb[2];
#pragma unroll
                for (int kk = 0; kk < 2; ++kk) { float tmp[8] = {sp[2 * kk][0], sp[2 * kk][1], sp[2 * kk][2], sp[2 * kk][3], sp[2 * kk + 1][0], sp[2 * kk + 1][1], sp[2 * kk + 1][2], sp[2 * kk + 1][3]};
                    const u32x4 w = pack8(tmp); pb[kk] = __builtin_bit_cast(bf16x8, w); }
                f32x4 ai[8], ae[8];
#pragma unroll
                for (int ef = 0; ef < 8; ++ef) { ai[ef] = (f32x4){0.f, 0.f, 0.f, 0.f}; ae[ef] = (f32x4){0.f, 0.f, 0.f, 0.f}; }
#pragma unroll
                for (int kk = 0; kk < 2; ++kk) {
#pragma unroll
                    for (int ef = 0; ef < 8; ++ef) { const int col = 128 * eh + 16 * ef + 4 * p;
                        const bf16x8 af = cat4(vtr(VT + (32 * kk + 4 * g + qp) * 544 + col * 2), vtr(VT + (32 * kk + 16 + 4 * g + qp) * 544 + col * 2));
                        ai[ef] = MFMA16(af, pb[kk], ai[ef]); }
                }
#pragma unroll
                for (int ef = 0; ef < 8; ++ef) {
#pragma unroll
                    for (int ks = 0; ks < 4; ++ks) { const bf16x8 cfr = *(const LAS bf16x8*)(CP + (128 * eh + 16 * ef + j) * 288 + (32 * ks + 8 * g) * 2); ae[ef] = MFMA16(cfr, qf[ks], ae[ef]); }
                }
                float qn = 0.f;
#pragma unroll
                for (int ks = 0; ks < 4; ++ks) { float qv[8]; unpack8(__builtin_bit_cast(u32x4, qf[ks]), qv);
#pragma unroll
                    for (int e = 0; e < 8; ++e) qn += qv[e] * NP[32 * ks + 8 * g + e]; }
                qn = xg_sum(qn);
                rowsum = xg_sum(rowsum);
                const float den = wi_t * qn + rowsum;
                const float dinv = __builtin_amdgcn_rcpf(fmaxf(fabsf(den), emt_t));
                float ssq = 0.f;
#pragma unroll
                for (int ef = 0; ef < 8; ++ef) { ai[ef] = (ae[ef] * wi_t + ai[ef]) * dinv; ssq += (ai[ef][0] * ai[ef][0] + ai[ef][1] * ai[ef][1]) + (ai[ef][2] * ai[ef][2] + ai[ef][3] * ai[ef][3]); }
                f32x4 nwv[8];
#pragma unroll
                for (int ef = 0; ef < 8; ++ef) nwv[ef] = *(const f32x4*)(a.mlstm_norm_w + h * 256 + 128 * eh + 16 * ef + 4 * g);
                ssq = xg_sum(ssq);
                if (g == 0) XCH[eh * 64 + t] = ssq;
                __syncthreads();
                const float rn = __builtin_amdgcn_rsqf((XCH[t] + XCH[64 + t]) * (1.0f / 256.0f) + NORM_EPS);
                bf16* orow = proj + (size_t)(b * SEQ + c * 64 + t) * NPROJ;
#pragma unroll
                for (int k2 = 0; k2 < 4; ++k2) { float r8[8];
#pragma unroll
                    for (int hi = 0; hi < 2; ++hi) { const int ef = 2 * k2 + hi; const f32x4 nw = nwv[ef]; const u32x2 mo = mo_pre[ef];
                        const float mof[4] = {bf_lo(mo.x), bf_hi(mo.x), bf_lo(mo.y), bf_hi(mo.y)};
#pragma unroll
                        for (int e2 = 0; e2 < 4; ++e2) r8[4 * hi + e2] = ai[ef][e2] * rn * nw[e2] * __builtin_amdgcn_rcpf(1.0f + __expf(-mof[e2])); }
                    if (!dry) *(u32x4*)(orow + PC_MV + h * 256 + 128 * eh + 32 * k2 + 8 * g) = pack8(r8); }
                if (hh == 0) {
                    f32x4 acc[8][2]; f32x4 accn = {0.f, 0.f, 0.f, 0.f};
#pragma unroll
                    for (int df = 0; df < 8; ++df) { acc[df][0] = (f32x4){0.f, 0.f, 0.f, 0.f}; acc[df][1] = (f32x4){0.f, 0.f, 0.f, 0.f}; }
#pragma unroll
                    for (int kk = 0; kk < 2; ++kk) {
                        const f32x4 wlo = *(const LAS f32x4*)(WL + 32 * kk + 4 * g), whi = *(const LAS f32x4*)(WL + 32 * kk + 16 + 4 * g);
                        const float wrow[8] = {wlo[0], wlo[1], wlo[2], wlo[3], whi[0], whi[1], whi[2], whi[3]};
                        bf16x8 bfr[2];
#pragma unroll
                        for (int ef = 0; ef < 2; ++ef) { const int col = 32 * wave + 16 * ef + 4 * p;
                            const bf16x8 raw = cat4(vtr(VT + (32 * kk + 4 * g + qp) * 544 + col * 2), vtr(VT + (32 * kk + 16 + 4 * g + qp) * 544 + col * 2));
                            float fv[8]; unpack8(__builtin_bit_cast(u32x4, raw), fv);
#pragma unroll
                            for (int e = 0; e < 8; ++e) fv[e] *= wrow[e];
                            const u32x4 pw = pack8(fv); bfr[ef] = __builtin_bit_cast(bf16x8, pw); }
                        float wc0[8];
#pragma unroll
                        for (int e = 0; e < 8; ++e) wc0[e] = (j == 0) ? wrow[e] : 0.f;
                        const u32x4 pwn = pack8(wc0); const bf16x8 bwn = __builtin_bit_cast(bf16x8, pwn);
#pragma unroll
                        for (int df = 0; df < 8; ++df) { const int col = 16 * df + 4 * p;
                            const bf16x8 af = cat4(vtr(KT + (32 * kk + 4 * g + qp) * 288 + col * 2), vtr(KT + (32 * kk + 16 + 4 * g + qp) * 288 + col * 2));
                            acc[df][0] = MFMA16(af, bfr[0], acc[df][0]); acc[df][1] = MFMA16(af, bfr[1], acc[df][1]);
                            if (df == wave) accn = MFMA16(af, bwn, accn); }
                    }
#pragma unroll
                    for (int ef = 0; ef < 2; ++ef) { const int e = 32 * wave + 16 * ef + j;
#pragma unroll
                        for (int df = 0; df < 8; ++df) { LAS u32x2* cp_ = (LAS u32x2*)(CP + e * 288 + (16 * df + 4 * g) * 2); const u32x2 old = *cp_; const f32x4 v = acc[df][ef];
                            u32x2 w; w.x = cvtpk(so_u * bf_lo(old.x) + v[0], so_u * bf_hi(old.x) + v[1]); w.y = cvtpk(so_u * bf_lo(old.y) + v[2], so_u * bf_hi(old.y) + v[3]); *cp_ = w; } }
                    if (j == 0) {
#pragma unroll
                        for (int rg = 0; rg < 4; ++rg) { const int d_ = 16 * wave + 4 * g + rg; NP[d_] = so_u * NP[d_] + accn[rg]; } }
                    mprev = m_u;
                }
                __syncthreads();
            }
        }
        for (int pidx = vcu; pidx < 256; pidx += G) {
            const AUnit ua{0, (pidx >> 5) & 7, 1, 0, pidx & 31, op0, pl0}, ub{1, (pidx >> 5) & 7, 1, 0, pidx & 31, op0, pl0};
            attn_pair<true>(proj, rcos, rsin, a.q_norm_w, mref, a.attn_norm_w, ua, ub, lds, op1, pl1, tid, dry);
        }
    REP_END
    xcd_barrier(bar);

    REP_BEGIN(6)
        pg8::Gemm g{proj + PC_MV, WoutT, MTOK, DM, DM, NPROJ}; pg8::StaticOrder S; S.init(MTOK, DM, G, bx);
        pg8::EpiRes1 E{Ub, a.out, H1b, sumsq, DM, dry};
        pg8::gemm_phase<pg8::EpiRes1, false>(lds, g, S, E);
    REP_END
    xcd_barrier(bar);

    REP_BEGIN(7)
        pg8::Gemm g{H1b, WguT, MTOK, NGU, DM, DM}; pg8::StaticOrder S; S.init(MTOK, NGU, G, bx);
        LAS float* rsl = (LAS float*)(lds + RING_BYTES);
        {
            float sv[8]; unsigned okm = 0u;
#pragma unroll
            for (int i = 0; i < 8; ++i) { pg8::Unit uu; const bool ok = S.next(i, uu); okm |= (ok ? 1u : 0u) << i; sv[i] = sumsq[(ok ? uu.pm : 0) * 256 + (tid & 255)]; }
#pragma unroll
            for (int i = 0; i < 8; ++i) if (tid < 256 && ((okm >> i) & 1u)) rsl[i * 256 + tid] = __builtin_amdgcn_rsqf(sv[i] * (1.0f / DM) + NORM_EPS);
        }
        __syncthreads();
        pg8::EpiSwiGLU E{FF, DFF, rsl, sumsq};
        pg8::gemm_phase<pg8::EpiSwiGLU, true>(lds, g, S, E);
        if (rep_ == 1) {
            const int nfull = (MTOK / 256) * (NGU / 256) - 5 * G;
            const int nidle = G - nfull;
            if (G == 256 ? (bx >= nfull) : true) {
                LAS float* scr = (LAS float*)(lds + wave * 16384);
                constexpr int I_DN = (DFF / 64) * (DM / 32);
                const int w0 = (G == 256) ? (bx - nfull) * NWAVES + wave : gw, nw = (G == 256) ? nidle * NWAVES : NGW;
                for (int it = w0; it < I_DN; it += nw) { const int nblk = DM / 32, kb = it / nblk, nb = it % nblk;
                    const TItem t{a.w_down, WdnT, nullptr, DM, DFF, nb * 32, nb * 32, kb * 64, 0}; f32x4 v[8]; float kq[8]; titem_load(t, v, kq, a.norm2_w, lane); titem_finish(t, v, kq, scr, lane); }
            }
        }
    REP_END
    xcd_barrier(bar);

    REP_BEGIN(8)
        pg8::Gemm g{FF, WdnT, MTOK, DM, DFF, DFF}; pg8::StaticOrder S; S.init(MTOK, DM, G, bx);
        pg8::EpiRes2 E{H1b, a.out, DM, dry};
        pg8::gemm_phase<pg8::EpiRes2, false>(lds, g, S, E);
    REP_END
}

extern "C" void kernel_launch(void* const* d_in, const int* in_sizes, int n_in, void* d_out, int out_size, void* d_ws, size_t ws_size, hipStream_t stream) {
    static int grid = 0;
    if (grid == 0) {
        if (n_in != 16 || in_sizes[0] != MTOK * DM || out_size != MTOK * DM || ws_size < WS_END) { fprintf(stderr, "kernel_launch: unexpected shapes (n_in %d in0 %d out %d ws %zu)\n", n_in, n_in > 0 ? in_sizes[0] : -1, out_size, ws_size); grid = -1; return; }
        int dev = 0, cus = 0;
        if (hipGetDevice(&dev) != hipSuccess || hipDeviceGetAttribute(&cus, hipDeviceAttributeMultiprocessorCount, dev) != hipSuccess || cus <= 0) cus = 256;
        if (hipFuncSetAttribute((const void*)hymba_fwd, hipFuncAttributeMaxDynamicSharedMemorySize, LDS_BYTES) != hipSuccess) { fprintf(stderr, "kernel_launch: hipFuncSetAttribute failed\n"); grid = -1; return; }
        (void)hipGetLastError();
        grid = cus;
    }
    if (grid < 0) return;
    if (hipMemsetAsync((char*)d_ws + WS_CTL, 0, CTL_ZERO_BYTES, stream) != hipSuccess) { fprintf(stderr, "kernel_launch: memset failed\n"); return; }
    Args a{};
    a.x = (const float*)d_in[0]; a.norm1_w = (const float*)d_in[1]; a.w_in = (const float*)d_in[2]; a.conv_w = (const float*)d_in[3]; a.conv_b = (const float*)d_in[4];
    a.igate_b = (const float*)d_in[5]; a.fgate_b = (const float*)d_in[6]; a.q_norm_w = (const float*)d_in[7]; a.k_norm_w = (const float*)d_in[8];
    a.mlstm_norm_w = (const float*)d_in[9]; a.attn_norm_w = (const float*)d_in[10]; a.w_out = (const float*)d_in[11]; a.norm2_w = (const float*)d_in[12];
    a.w_gate = (const float*)d_in[13]; a.w_up = (const float*)d_in[14]; a.w_down = (const float*)d_in[15];
    a.out = (float*)d_out; a.ws = (unsigned char*)d_ws; a.dry = (PROBE_PHASE >= 0) ? 1 : 0;
    hipLaunchKernelGGL(hymba_fwd, dim3(grid), dim3(NWAVES * 64), LDS_BYTES, stream, a);
}
```
